# Optimizing an MI355X kernel written in HIP

```python
import jax, jax.numpy as jnp
from jax import lax
import numpy as np

D_MODEL = 1024
BATCH = 16
SEQ = 2048
DEPTH = 1

SB_HEADS = 8
SB_HEAD_DIM = 64
SB_WIDTH = SB_HEADS * SB_HEAD_DIM
SB_BLOCK = 128
ML_HEADS = 4
ML_HEAD_DIM = 128
ML_WIDTH = ML_HEADS * ML_HEAD_DIM
ML_CHUNK = 64
CONV_WIDTH = 4
PEER_HEADS = 8
PEER_N_KEYS = 128
PEER_N_EXPERTS = PEER_N_KEYS * PEER_N_KEYS
PEER_QUERY_DIM = 256
PEER_HALF = PEER_QUERY_DIM // 2
PEER_TOPK = 16
PEER_TOKEN_BLOCK = 128

RMS_EPS = 1e-6

O_SB = 3 * SB_WIDTH
O_MLQK = O_SB + 2 * ML_WIDTH
O_MLV = O_MLQK + ML_WIDTH
O_MLO = O_MLV + ML_WIDTH
O_MLIF = O_MLO + 2 * ML_HEADS
IN_COLS = O_MLIF + 2 * D_MODEL

kernel_name = 'hybrid_sba_mlstm_peer'


def rmsnorm(x, w):
    xf = x.astype(jnp.float32)
    y = xf * lax.rsqrt(jnp.mean(xf * xf, axis=-1, keepdims=True) + RMS_EPS) * w.astype(jnp.float32)
    return y.astype(x.dtype)


def causal_short_conv(x, w, b):
    K = w.shape[0]
    S = x.shape[1]
    xp = jnp.pad(x, ((0, 0), (K - 1, 0), (0, 0)))
    y = xp[:, 0:S] * w[0]
    for j in range(1, K):
        y = y + xp[:, j:j + S] * w[j]
    return y + b


def stick_breaking_attention(q, k, v):
    S = q.shape[2]
    scale = SB_HEAD_DIM ** -0.5
    outs = []
    for blk in range(S // SB_BLOCK):
        start = blk * SB_BLOCK
        end = start + SB_BLOCK
        qb = q[:, :, start:end]
        kb = k[:, :, :end]
        vb = v[:, :, :end]
        z = jnp.einsum('bhtd,bhsd->bhts', qb, kb) * scale
        t_pos = start + jnp.arange(SB_BLOCK)[:, None]
        s_pos = jnp.arange(end)[None, :]
        causal = s_pos < t_pos
        sp = jnp.where(causal, jax.nn.softplus(z), 0.0)
        sp_next = jnp.concatenate([sp[..., 1:], jnp.zeros_like(sp[..., :1])], axis=-1)
        suffix = lax.cumsum(sp_next, axis=3, reverse=True)
        w = jnp.where(causal, jnp.exp(jax.nn.log_sigmoid(z) - suffix), 0.0)
        outs.append(jnp.einsum('bhts,bhsd->bhtd', w, vb))
    return jnp.concatenate(outs, axis=2)


def _to_chunks(a):
    B, H, S = a.shape[:3]
    a = a.reshape((B, H, S // ML_CHUNK, ML_CHUNK) + a.shape[3:])
    return jnp.moveaxis(a, 2, 0)


def mlstm_chunkwise(q, k, v, i_pre, f_pre):
    B, H, S, D = q.shape
    logf = jax.nn.log_sigmoid(f_pre)
    tri = jnp.tril(jnp.ones((ML_CHUNK, ML_CHUNK), dtype=bool))

    def step(carry, inp):
        C, n, m = carry
        qc, kc, vc, ic, lfc = inp
        b = jnp.cumsum(lfc, axis=-1)
        dmat = jnp.where(tri, b[..., :, None] - b[..., None, :] + ic[..., None, :], -jnp.inf)
        inter = b + m[..., None]
        m_t = jnp.maximum(inter, jnp.max(dmat, axis=-1))
        w_intra = jnp.exp(dmat - m_t[..., None])
        w_inter = jnp.exp(inter - m_t)
        s = jnp.einsum('bhtd,bhsd->bhts', qc, kc) * w_intra
        num = jnp.einsum('bhts,bhsd->bhtd', s, vc) + w_inter[..., None] * jnp.einsum('bhtd,bhde->bhte', qc, C)
        den = jnp.sum(s, axis=-1) + w_inter * jnp.einsum('bhtd,bhd->bht', qc, n)
        h = num / jnp.maximum(jnp.abs(den), jnp.exp(-m_t))[..., None]
        b_last = b[..., -1]
        g = b_last[..., None] - b + ic
        m_new = jnp.maximum(b_last + m, jnp.max(g, axis=-1))
        decay = jnp.exp(b_last + m - m_new)
        wk = jnp.exp(g - m_new[..., None])
        C_new = decay[..., None, None] * C + jnp.einsum('bhs,bhsd,bhse->bhde', wk, kc, vc)
        n_new = decay[..., None] * n + jnp.einsum('bhs,bhsd->bhd', wk, kc)
        return (C_new, n_new, m_new), h

    init = (jnp.zeros((B, H, D, D), jnp.float32), jnp.zeros((B, H, D), jnp.float32), jnp.zeros((B, H), jnp.float32))
    xs = (_to_chunks(q), _to_chunks(k), _to_chunks(v), _to_chunks(i_pre), _to_chunks(logf))
    _, hs = lax.scan(step, init, xs)
    return jnp.moveaxis(hs, 0, 2).reshape(B, H, S, D)


def hybrid_mixer(xn, w_in, conv_w, conv_b, b_igate, b_fgate, mlstm_norm_w, w_branch_sb, w_branch_ml, w_out):
    B, S, _ = xn.shape
    proj = xn @ w_in
    sb_qkv, ml_qk, ml_v, ml_o, ml_if, gates = jnp.split(proj, [O_SB, O_MLQK, O_MLV, O_MLO, O_MLIF], axis=-1)

    sb = sb_qkv.astype(jnp.float32).reshape(B, S, 3, SB_HEADS, SB_HEAD_DIM).transpose(2, 0, 3, 1, 4)
    y_sb = stick_breaking_attention(sb[0], sb[1], sb[2])
    y_sb = y_sb.transpose(0, 2, 1, 3).reshape(B, S, SB_WIDTH)

    qk = jax.nn.silu(causal_short_conv(ml_qk, conv_w, conv_b)).astype(jnp.float32)
    q_m, k_m = jnp.split(qk, 2, axis=-1)
    to_heads = lambda a: a.reshape(B, S, ML_HEADS, ML_HEAD_DIM).transpose(0, 2, 1, 3)
    q_m = to_heads(q_m)
    k_m = to_heads(k_m) * (ML_HEAD_DIM ** -0.5)
    v_m = to_heads(ml_v.astype(jnp.float32))
    ml_if = ml_if.astype(jnp.float32)
    i_pre = (ml_if[..., :ML_HEADS] + b_igate.astype(jnp.float32)).transpose(0, 2, 1)
    f_pre = (ml_if[..., ML_HEADS:] + b_fgate.astype(jnp.float32)).transpose(0, 2, 1)
    h = mlstm_chunkwise(q_m, k_m, v_m, i_pre, f_pre)
    h = h * lax.rsqrt(jnp.mean(h * h, axis=-1, keepdims=True) + RMS_EPS) * mlstm_norm_w.astype(jnp.float32).reshape(ML_HEADS, 1, ML_HEAD_DIM)
    y_ml = jax.nn.sigmoid(ml_o.astype(jnp.float32)) * h.transpose(0, 2, 1, 3).reshape(B, S, ML_WIDTH)

    g_sb, g_ml = jnp.split(gates.astype(jnp.float32), 2, axis=-1)
    merged = jax.nn.sigmoid(g_sb) * (y_sb @ w_branch_sb) + jax.nn.sigmoid(g_ml) * (y_ml @ w_branch_ml)
    return (merged @ w_out).astype(xn.dtype)


def peer(xn, w_query, keys1, keys2, expert_u, expert_v):
    B, S, D = xn.shape
    T = B * S
    xt = xn.reshape(T, D)
    q = (xt @ w_query).astype(jnp.float32).reshape(T, PEER_HEADS, 2, PEER_HALF)
    s1 = jnp.einsum('thd,hkd->thk', q[:, :, 0], keys1.astype(jnp.float32))
    s2 = jnp.einsum('thd,hkd->thk', q[:, :, 1], keys2.astype(jnp.float32))
    v1, i1 = lax.top_k(s1, PEER_TOPK)
    v2, i2 = lax.top_k(s2, PEER_TOPK)
    cand = (v1[..., :, None] + v2[..., None, :]).reshape(T, PEER_HEADS, PEER_TOPK * PEER_TOPK)
    top_s, top_c = lax.top_k(cand, PEER_TOPK)
    e_idx = jnp.take_along_axis(i1, top_c // PEER_TOPK, axis=-1) * PEER_N_KEYS + jnp.take_along_axis(i2, top_c % PEER_TOPK, axis=-1)
    gate = jax.nn.softmax(top_s, axis=-1)
    n_sel = PEER_HEADS * PEER_TOPK
    idx = e_idx.reshape(T // PEER_TOKEN_BLOCK, PEER_TOKEN_BLOCK, n_sel)
    gts = gate.reshape(T // PEER_TOKEN_BLOCK, PEER_TOKEN_BLOCK, n_sel)
    xb = xt.reshape(T // PEER_TOKEN_BLOCK, PEER_TOKEN_BLOCK, D)

    def block_fn(args):
        xc, ic, gc = args
        u = expert_u[ic].astype(jnp.float32)
        act = jax.nn.gelu(jnp.einsum('ckd,cd->ck', u, xc.astype(jnp.float32)), approximate=False)
        return jnp.einsum('ck,ckd->cd', gc * act, expert_v[ic].astype(jnp.float32))

    out = lax.map(block_fn, (xb, idx, gts))
    return out.reshape(B, S, D).astype(xn.dtype)


def setup_inputs(seed: int = 0) -> dict:
    key = jax.random.key(seed)
    ks = jax.random.split(key, 18)
    f32 = jnp.float32
    nrm = lambda k, shape: jax.random.normal(k, shape, f32)
    return {
        'x': nrm(ks[0], (BATCH, SEQ, D_MODEL)),
        'norm_mix_w': 1.0 + 0.02 * nrm(ks[1], (DEPTH, D_MODEL)),
        'w_in': nrm(ks[2], (DEPTH, D_MODEL, IN_COLS)) * D_MODEL ** -0.5,
        'conv_w': nrm(ks[3], (DEPTH, CONV_WIDTH, 2 * ML_WIDTH)) * CONV_WIDTH ** -0.5,
        'conv_b': 0.02 * nrm(ks[4], (DEPTH, 2 * ML_WIDTH)),
        'b_igate': 0.1 * nrm(ks[5], (DEPTH, ML_HEADS)),
        'b_fgate': 3.0 + 3.0 * jax.random.uniform(ks[6], (DEPTH, ML_HEADS), f32),
        'mlstm_norm_w': 1.0 + 0.02 * nrm(ks[7], (DEPTH, ML_WIDTH)),
        'w_branch_sb': nrm(ks[8], (DEPTH, SB_WIDTH, D_MODEL)) * SB_WIDTH ** -0.5,
        'w_branch_ml': nrm(ks[9], (DEPTH, ML_WIDTH, D_MODEL)) * ML_WIDTH ** -0.5,
        'w_out': nrm(ks[10], (DEPTH, D_MODEL, D_MODEL)) * D_MODEL ** -0.5,
        'norm_ffn_w': 1.0 + 0.02 * nrm(ks[11], (DEPTH, D_MODEL)),
        'peer_w_query': nrm(ks[12], (DEPTH, D_MODEL, PEER_HEADS * PEER_QUERY_DIM)) * D_MODEL ** -0.5,
        'peer_keys1': nrm(ks[13], (DEPTH, PEER_HEADS, PEER_N_KEYS, PEER_HALF)) * PEER_HALF ** -0.5,
        'peer_keys2': nrm(ks[14], (DEPTH, PEER_HEADS, PEER_N_KEYS, PEER_HALF)) * PEER_HALF ** -0.5,
        'peer_u': nrm(ks[15], (DEPTH, PEER_N_EXPERTS, D_MODEL)) * D_MODEL ** -0.5,
        'peer_v': 0.5 * nrm(ks[16], (DEPTH, PEER_N_EXPERTS, D_MODEL)),
        'norm_final_w': 1.0 + 0.02 * nrm(ks[17], (D_MODEL,)),
    }


def reference(x, norm_mix_w, w_in, conv_w, conv_b, b_igate, b_fgate, mlstm_norm_w, w_branch_sb, w_branch_ml, w_out, norm_ffn_w, peer_w_query, peer_keys1, peer_keys2, peer_u, peer_v, norm_final_w):
    h = x
    for l in range(DEPTH):
        xn = rmsnorm(h, norm_mix_w[l])
        h = h + hybrid_mixer(xn, w_in[l], conv_w[l], conv_b[l], b_igate[l], b_fgate[l], mlstm_norm_w[l], w_branch_sb[l], w_branch_ml[l], w_out[l]).astype(h.dtype)
        hn = rmsnorm(h, norm_ffn_w[l])
        h = h + peer(hn, peer_w_query[l], peer_keys1[l], peer_keys2[l], peer_u[l], peer_v[l]).astype(h.dtype)
    return rmsnorm(h, norm_final_w)
```

```cpp
#include <hip/hip_runtime.h>
#include <cstdio>
#include <cstdint>
namespace pg8 {
#define PG8_LAS __attribute__((address_space(3)))
typedef unsigned short bf16_t;
typedef short bf16x8 __attribute__((ext_vector_type(8)));
typedef float f32x4 __attribute__((ext_vector_type(4)));
typedef unsigned u32x4 __attribute__((ext_vector_type(4)));
constexpr int BM = 256, BK = 64, HALF = 128, HTB = HALF * BK * 2  , STAGE_BYTES = 8 * HTB, NXCD = 8, WGM = 8;

__host__ __device__ __forceinline__ int lds_byte(int r, int c) { const int st = (r >> 4) * 2 + (c >> 5), rr = r & 15, cc = c & 31, ob = rr * 64 + cc * 2; return st * 1024 + (ob ^ (((ob >> 9) & 1) << 5)); }
__host__ __device__ __forceinline__ void stage_rc(int b, int& R, int& C) { const int st = b / 1024, sb = b % 1024, swz = sb ^ (((sb >> 9) & 1) << 5); R = (st >> 1) * 16 + swz / 64; C = (st & 1) * 32 + (swz % 64) / 2; }
__host__ __device__ __forceinline__ int perm32(int rho) { const int n = rho >> 4, i = rho & 15; return 8 * (i >> 2) + 4 * n + (i & 3); }

struct Unit { int pm, pn; };
struct Gemm { const bf16_t* A; const bf16_t* Bt; int M, N, K; };

struct StaticOrder {
    int nM, nN, nwg, G, c;
    __host__ __device__ void init(int M, int N, int G_, int c_) { nM = M / BM; nN = N / BM; nwg = nM * nN; G = G_; c = c_; }
    __host__ __device__ bool next(int i, Unit& u) const {
        const long L = (long)i * G + c; if (L >= nwg) return false;
        int wgid = (int)L; { const int q = nwg / NXCD, r = nwg % NXCD, xcd = wgid % NXCD, off = wgid / NXCD; wgid = (xcd < r ? xcd * (q + 1) : r * (q + 1) + (xcd - r) * q) + off; }
        const int nig = WGM * nN, gid = wgid / nig, fm = gid * WGM, gsz = (nM - fm) < WGM ? (nM - fm) : WGM;
        u.pm = fm + ((wgid % nig) % gsz); u.pn = (wgid % nig) / gsz; return true;
    }
    __device__ __forceinline__ void a_ready(const Unit&) const {}
    __device__ __forceinline__ void done(const Unit&) const {}
};

__device__ __forceinline__ unsigned cvt_pk_bf16(float lo, float hi) { unsigned r; asm volatile("v_cvt_pk_bf16_f32 %0, %1, %2" : "=v"(r) : "v"(lo), "v"(hi)); return r; }
template <class Epi, class Sched, bool ALIGN_EPI = false, bool SP2 = false>
__device__ __forceinline__ void gemm_phase(PG8_LAS unsigned char* lds, const Gemm g, const Sched& S, const Epi& E) {
    const int tid = threadIdx.x, wid = __builtin_amdgcn_readfirstlane(tid >> 6), lane = tid & 63, wr = wid >> 2, wc = wid & 3, fr = lane & 15, fq = lane >> 4;
    const int K = g.K, nt = K / BK;
    unsigned voffA[2], voffB[2];
#pragma unroll
    for (int i = 0; i < 2; ++i) { int R, C; stage_rc(tid * 16 + i * 8192, R, C); const int Rb = Epi::PERM ? ((R & ~31) + perm32(R & 31)) : R;
        voffA[i] = (unsigned)(R * K + C) * 2u; voffB[i] = (unsigned)(Rb * K + C) * 2u; }
    const size_t kstep = (size_t)(BK * 2);
    const size_t hstep = (size_t)HALF * K * 2;
    const size_t tstep = 2 * hstep;
    const unsigned ldsw = (unsigned)wid * 1024u;
    const int aoff = lds_byte(wr * 64 + fr, fq * 8), boff = lds_byte(wc * 32 + fr, fq * 8);
#define PG8_SA(b, h) (((b) * 2 + (h)) * HTB)
#define PG8_SB(b, h) ((4 + (b) * 2 + (h)) * HTB)
#define PG8_STAGE(bufoff, gbase, voff) do { _Pragma("unroll") for (int _i = 0; _i < 2; ++_i) \
        __builtin_amdgcn_global_load_lds((const unsigned*)((const char*)(gbase) + (voff)[_i]), (PG8_LAS unsigned*)(lds + (bufoff) + ldsw + _i * 8192), 16, 0, 0); } while (0)
#define PG8_LDA(dst, b, h) do { _Pragma("unroll") for (int m = 0; m < 4; ++m) _Pragma("unroll") for (int k = 0; k < 2; ++k) dst[m][k] = *(const PG8_LAS bf16x8*)(lds + PG8_SA(b, h) + aoff + m * 2048 + k * 1024); } while (0)
#define PG8_LDB(dst, b, h) do { _Pragma("unroll") for (int n = 0; n < 2; ++n) _Pragma("unroll") for (int k = 0; k < 2; ++k) dst[n][k] = *(const PG8_LAS bf16x8*)(lds + PG8_SB(b, h) + boff + n * 2048 + k * 1024); } while (0)
#define PG8_MMA(ai, bj, At, Bt) do { __builtin_amdgcn_s_setprio(1); _Pragma("unroll") for (int m = 0; m < 4; ++m) _Pragma("unroll") for (int n = 0; n < 2; ++n) _Pragma("unroll") for (int k = 0; k < 2; ++k) \
        acc[ai][bj][m][n] = __builtin_amdgcn_mfma_f32_16x16x32_bf16(Bt[n][k], At[m][k], acc[ai][bj][m][n], 0, 0, 0); __builtin_amdgcn_s_setprio(0); } while (0)
#define PG8_WAIT_V(n) asm volatile("s_waitcnt vmcnt(" #n ")" ::: "memory")
#define PG8_WAIT_L(n) asm volatile("s_waitcnt lgkmcnt(" #n ")" ::: "memory")
#define PG8_BAR __builtin_amdgcn_s_barrier()
#define PG8_SCHED __builtin_amdgcn_sched_barrier(0)
    Unit cur, nxt; int ui = 0;
    if (!S.next(0, cur)) return;
    f32x4 acc[2][2][4][2];
#pragma unroll
    for (int a = 0; a < 2; ++a)
#pragma unroll
        for (int b = 0; b < 2; ++b)
#pragma unroll
            for (int m = 0; m < 4; ++m)
#pragma unroll
                for (int n = 0; n < 2; ++n) acc[a][b][m][n] = (f32x4){0.f, 0.f, 0.f, 0.f};
    bf16x8 At[4][2], B0[2][2], B1[2][2];
    const char* cA = (const char*)g.A + (size_t)cur.pm * tstep; const char* cB = (const char*)g.Bt + (size_t)cur.pn * tstep;
    S.a_ready(cur);
    if constexpr (SP2) {
        PG8_STAGE(PG8_SB(0, 0), cB, voffB); PG8_STAGE(PG8_SB(0, 1), cB + hstep, voffB); PG8_STAGE(PG8_SA(0, 0), cA, voffA); PG8_STAGE(PG8_SA(0, 1), cA + hstep, voffA);
        if (wr == 1) PG8_BAR;
        PG8_WAIT_V(2); PG8_BAR;
        PG8_STAGE(PG8_SB(1, 0), cB + kstep, voffB); PG8_STAGE(PG8_SA(1, 0), cA + kstep, voffA); PG8_STAGE(PG8_SB(1, 1), cB + hstep + kstep, voffB);
        PG8_WAIT_V(6); PG8_BAR;
    } else {
        PG8_STAGE(PG8_SB(0, 0), cB, voffB); PG8_STAGE(PG8_SA(0, 0), cA, voffA); PG8_STAGE(PG8_SB(0, 1), cB + hstep, voffB); PG8_STAGE(PG8_SA(0, 1), cA + hstep, voffA);
        if (wr == 1) PG8_BAR;
        PG8_WAIT_V(4); PG8_BAR;
        PG8_STAGE(PG8_SB(1, 0), cB + kstep, voffB); PG8_STAGE(PG8_SA(1, 0), cA + kstep, voffA); PG8_STAGE(PG8_SB(1, 1), cB + hstep + kstep, voffB);
        PG8_WAIT_V(6); PG8_BAR;
    }
    for (;;) {
        const bool has_next = S.next(ui + 1, nxt);
        const char* nA = has_next ? (const char*)g.A + (size_t)nxt.pm * tstep : cA; const char* nB = has_next ? (const char*)g.Bt + (size_t)nxt.pn * tstep : cB;
        for (int t = 0; t < nt; t += 2) {
            const bool last = (t == nt - 2);
            const char* a1 = cA + (size_t)(t + 1) * kstep;
            const char* a2 = last ? nA : cA + (size_t)(t + 2) * kstep; const char* b2 = last ? nB : cB + (size_t)(t + 2) * kstep;
            const char* a3 = a2 + kstep; const char* b3 = b2 + kstep;
            if (last && has_next) S.a_ready(nxt);
            if constexpr (SP2) {
            PG8_LDB(B0, 0, 0); PG8_LDB(B1, 0, 1); PG8_SCHED; PG8_LDA(At, 0, 0); PG8_STAGE(PG8_SA(1, 1), a1 + hstep, voffA);
            PG8_WAIT_V(8); PG8_WAIT_L(0); PG8_BAR; PG8_MMA(0, 0, At, B0); PG8_MMA(0, 1, At, B1); PG8_BAR; PG8_SCHED;
            PG8_LDA(At, 0, 1); PG8_STAGE(PG8_SB(0, 0), b2, voffB); PG8_STAGE(PG8_SB(0, 1), b2 + hstep, voffB); PG8_STAGE(PG8_SA(0, 0), a2, voffA);
            PG8_WAIT_V(8); PG8_WAIT_L(0); PG8_BAR; PG8_MMA(1, 0, At, B0); PG8_MMA(1, 1, At, B1); PG8_BAR; PG8_SCHED;
            PG8_LDB(B0, 1, 0); PG8_LDB(B1, 1, 1); PG8_SCHED; PG8_LDA(At, 1, 0); PG8_STAGE(PG8_SA(0, 1), a2 + hstep, voffA);
            PG8_WAIT_V(8); PG8_WAIT_L(0); PG8_BAR; PG8_MMA(0, 0, At, B0); PG8_MMA(0, 1, At, B1); PG8_BAR; PG8_SCHED;
            PG8_LDA(At, 1, 1); PG8_STAGE(PG8_SB(1, 0), b3, voffB); PG8_STAGE(PG8_SB(1, 1), b3 + hstep, voffB); PG8_STAGE(PG8_SA(1, 0), a3, voffA);
            PG8_WAIT_V(8); PG8_WAIT_L(0); PG8_BAR; PG8_MMA(1, 0, At, B0); PG8_MMA(1, 1, At, B1); PG8_BAR; PG8_SCHED;
            } else {
            PG8_LDB(B0, 0, 0); PG8_SCHED; PG8_LDA(At, 0, 0); PG8_STAGE(PG8_SA(1, 1), a1 + hstep, voffA);
            PG8_WAIT_L(8); PG8_BAR; PG8_WAIT_L(0); PG8_MMA(0, 0, At, B0); PG8_BAR; PG8_SCHED;
            PG8_LDB(B1, 0, 1); PG8_STAGE(PG8_SB(0, 0), b2, voffB);
            PG8_BAR; PG8_WAIT_L(0); PG8_MMA(0, 1, At, B1); PG8_BAR;
            PG8_LDA(At, 0, 1); PG8_STAGE(PG8_SA(0, 0), a2, voffA);
            PG8_BAR; PG8_WAIT_L(0); PG8_MMA(1, 0, At, B0); PG8_BAR; PG8_SCHED;
            PG8_STAGE(PG8_SB(0, 1), b2 + hstep, voffB);
            PG8_WAIT_V(6); PG8_BAR; PG8_MMA(1, 1, At, B1); PG8_BAR;
            PG8_LDB(B0, 1, 0); PG8_SCHED; PG8_LDA(At, 1, 0); PG8_STAGE(PG8_SA(0, 1), a2 + hstep, voffA);
            PG8_WAIT_L(8); PG8_BAR; PG8_WAIT_L(0); PG8_MMA(0, 0, At, B0); PG8_BAR; PG8_SCHED;
            PG8_LDB(B1, 1, 1); PG8_STAGE(PG8_SB(1, 0), b3, voffB);
            PG8_BAR; PG8_WAIT_L(0); PG8_MMA(0, 1, At, B1); PG8_BAR;
            PG8_LDA(At, 1, 1); PG8_STAGE(PG8_SA(1, 0), a3, voffA);
            PG8_BAR; PG8_WAIT_L(0); PG8_MMA(1, 0, At, B0); PG8_BAR; PG8_SCHED;
            PG8_STAGE(PG8_SB(1, 1), b3 + hstep, voffB);
            PG8_WAIT_V(6); PG8_BAR; PG8_MMA(1, 1, At, B1); PG8_BAR;
            }
        }
        if constexpr (ALIGN_EPI) { if (wr == 0) PG8_BAR; }
        if constexpr (!Epi::AFTER_DRAIN) { E(acc, cur, wr, wc, fr, fq); S.done(cur); }
        if (!has_next) break;
#pragma unroll
        for (int a = 0; a < 2; ++a)
#pragma unroll
            for (int b = 0; b < 2; ++b)
#pragma unroll
                for (int m = 0; m < 4; ++m)
#pragma unroll
                    for (int n = 0; n < 2; ++n) acc[a][b][m][n] = (f32x4){0.f, 0.f, 0.f, 0.f};
        cur = nxt; cA = nA; cB = nB; ++ui;
        if constexpr (ALIGN_EPI) { if (wr == 1) PG8_BAR; }
    }
    PG8_WAIT_V(0);
    if constexpr (!ALIGN_EPI) { if (wr == 0) PG8_BAR; }
    PG8_BAR;
    if constexpr (Epi::AFTER_DRAIN) { E.fused(acc, cur, wr, wc, fr, fq, lds, wid, lane); S.done(cur); }
#undef PG8_SA
#undef PG8_SB
#undef PG8_STAGE
#undef PG8_LDA
#undef PG8_LDB
#undef PG8_MMA
#undef PG8_WAIT_V
#undef PG8_WAIT_L
#undef PG8_BAR
#undef PG8_SCHED
}
}

#ifndef MK_PER_PHASE
#define MK_PER_PHASE 0
#endif
#ifndef USE_PG8
#define USE_PG8 0
#endif
constexpr int NWAVES = 8, NTHR = 512;

constexpr int B_ = 16, S_ = 2048, D_ = 1024, T_ = B_ * S_;
constexpr int INC = 5640, NPROJ = 5632;
constexpr int NEXP = 16384;
constexpr float EPS = 1e-6f;

constexpr size_t MiB = 1u << 20;
constexpr size_t WS_CTL = 0, CTL_ZERO_BYTES = 1 * MiB;
constexpr size_t WS_W1T = 2 * MiB, WS_WSBT = 13 * MiB, WS_WMLT = 14 * MiB, WS_WOUTT = 15 * MiB, WS_WCT = 17 * MiB, WS_IFG = 21 * MiB;
constexpr size_t WS_U16 = 24 * MiB, WS_V16 = 56 * MiB;
constexpr size_t WS_XN = 88 * MiB, WS_YSB = 88 * MiB, WS_YML = 120 * MiB;
constexpr size_t WS_SBQKV = 152 * MiB, WS_MLQK = 248 * MiB, WS_MLV = 312 * MiB, WS_MLO = 344 * MiB, WS_GATES = 376 * MiB;
constexpr size_t WS_MERGED = 216 * MiB, WS_H = 88 * MiB, WS_HN = 216 * MiB, WS_IDX = 280 * MiB, WS_GATE = 296 * MiB, WS_SC = 312 * MiB;
constexpr size_t WS_END = 504 * MiB;
constexpr int CW_BAR = 4096;

constexpr int RING_OFF = 0, RING_BYTES = 131072;
constexpr int LDSCTL_OFF = RING_BYTES, MISC_OFF = LDSCTL_OFF + 320;
constexpr int LDS_BYTES = 147456;

#define GAS __attribute__((address_space(1)))
#define LAS __attribute__((address_space(3)))
typedef unsigned short bf16;
typedef unsigned v4u __attribute__((ext_vector_type(4)));
typedef unsigned v2u __attribute__((ext_vector_type(2)));
typedef float f32x4 __attribute__((ext_vector_type(4)));
#define LDS_WAIT() asm volatile("s_waitcnt lgkmcnt(0)" ::: "memory")
#define VM_WAIT() asm volatile("s_waitcnt vmcnt(0)" ::: "memory")
__device__ __forceinline__ unsigned f2bf(float f) { unsigned u = __builtin_bit_cast(unsigned, f); return (u + 0x7fffu + ((u >> 16) & 1u)) >> 16; }
__device__ __forceinline__ unsigned pk2(float lo, float hi) { return f2bf(lo) | (f2bf(hi) << 16); }
__device__ __forceinline__ float bflo(unsigned u) { return __builtin_bit_cast(float, u << 16); }
__device__ __forceinline__ float bfhi(unsigned u) { return __builtin_bit_cast(float, u & 0xffff0000u); }
__device__ __forceinline__ float bf2f(bf16 b) { return __builtin_bit_cast(float, (unsigned)b << 16); }
__device__ __forceinline__ float sigmoidf_(float x) { return 1.f / (1.f + __expf(-x)); }
__device__ __forceinline__ float wave_sum(float v) {
#pragma unroll
    for (int o = 1; o < 64; o <<= 1) v += __shfl_xor(v, o);
    return v;
}
__device__ __forceinline__ unsigned wave_max_u(unsigned v) {
#pragma unroll
    for (int o = 1; o < 64; o <<= 1) { const unsigned w = (unsigned)__shfl_xor((int)v, o); v = v > w ? v : w; }
    return v;
}
struct F8 { float v[8]; };
__device__ __forceinline__ void unpack8(const v4u& u, float (&f)[8]) {
    f[0] = bflo(u.x); f[1] = bfhi(u.x); f[2] = bflo(u.y); f[3] = bfhi(u.y); f[4] = bflo(u.z); f[5] = bfhi(u.z); f[6] = bflo(u.w); f[7] = bfhi(u.w);
}
__device__ __forceinline__ v4u pack8(const float (&f)[8]) { v4u o; o.x = pk2(f[0], f[1]); o.y = pk2(f[2], f[3]); o.z = pk2(f[4], f[5]); o.w = pk2(f[6], f[7]); return o; }

#define XB_TMO      128
#define XB_XCNT(j)  (256  + 64 * (j))
#define XB_XSUB(j)  (1280 + 64 * (j))
#define XB_XGEN(j)  (2304 + 64 * (j))
#define XB_TOP      3328
#define XB_TOPGEN   3392
#define XCD_BAR_WORDS 3456
#define XB_SPIN_CAP (1u << 24)

__device__ __forceinline__ unsigned xb_ld(unsigned* p)              { return __hip_atomic_load(p, __ATOMIC_RELAXED, __HIP_MEMORY_SCOPE_AGENT); }
__device__ __forceinline__ unsigned xb_add(unsigned* p, unsigned v) { return __hip_atomic_fetch_add(p, v, __ATOMIC_RELAXED, __HIP_MEMORY_SCOPE_AGENT); }
__device__ __forceinline__ unsigned xb_xcc_id() { return (unsigned)__builtin_amdgcn_s_getreg((3 << 11) | 20) & 0xFu; }
#define XB_SPIN(cond, bar) do { unsigned _sp = 0; while (cond) { __builtin_amdgcn_s_sleep(1); \
    if ((++_sp & 255u) == 0u) { if (xb_ld(&(bar)[XB_TMO])) break; if (_sp > XB_SPIN_CAP) { atomicAdd(&(bar)[XB_TMO], 1u); break; } } } } while (0)

struct XcdBarrier {
    unsigned* bar; unsigned x;
    volatile LAS unsigned* st;
};

__device__ __forceinline__ XcdBarrier xcd_barrier_post(unsigned* bar, volatile LAS unsigned* st) {
    XcdBarrier b; b.bar = bar; b.x = xb_xcc_id(); b.st = st;
    if (threadIdx.x == 0) (void)xb_add(&bar[XB_XCNT(b.x)], 1u);
    return b;
}
__device__ __forceinline__ void xcd_barrier_complete(unsigned* bar, unsigned x, unsigned& nloc, unsigned& nx) {
    const unsigned G = gridDim.x * gridDim.y * gridDim.z;
    unsigned sum, cnt, mine, sp = 0u;
    for (;;) {
        sum = 0u; cnt = 0u; mine = 0u;
#pragma unroll
        for (unsigned j = 0; j < 16; ++j) { const unsigned c = xb_ld(&bar[XB_XCNT(j)]); sum += c; cnt += (c > 0u) ? 1u : 0u; mine = (j == x) ? c : mine; }
        if (sum == G) break;
        __builtin_amdgcn_s_sleep(1);
        if ((++sp & 255u) == 0u) { if (xb_ld(&bar[XB_TMO])) break; if (sp > XB_SPIN_CAP) { atomicAdd(&bar[XB_TMO], 1u); break; } }
    }
    nloc = mine > 0u ? mine : 1u; nx = cnt > 0u ? cnt : 1u;
}

__device__ __forceinline__ void xcd_barrier(const XcdBarrier& b) {
    asm volatile("s_waitcnt vmcnt(0)" ::: "memory");
    __syncthreads();
    if (threadIdx.x == 0) {
        unsigned* bar = b.bar;
        __builtin_amdgcn_s_waitcnt(0);
        unsigned nloc = b.st[0], nx = b.st[1];
        if (nloc == 0u) { xcd_barrier_complete(bar, b.x, nloc, nx); b.st[0] = nloc; b.st[1] = nx; }
        const unsigned old = xb_add(&bar[XB_XSUB(b.x)], 1u);
        const unsigned gen = old / nloc;
        if (old + 1u == (gen + 1u) * nloc) {
            __builtin_amdgcn_fence(__ATOMIC_RELEASE, "agent");
            asm volatile("s_waitcnt vmcnt(0)" ::: "memory");
            const unsigned og = xb_add(&bar[XB_TOP], 1u);
            const unsigned tg = og / nx;
            if (og + 1u == (tg + 1u) * nx) xb_add(&bar[XB_TOPGEN], 1u);
            else XB_SPIN(xb_ld(&bar[XB_TOPGEN]) == tg, bar);
            __builtin_amdgcn_fence(__ATOMIC_ACQUIRE, "agent");
            xb_add(&bar[XB_XGEN(b.x)], 1u);
            asm volatile("s_waitcnt vmcnt(0)" ::: "memory");
        } else {
            XB_SPIN(xb_ld(&bar[XB_XGEN(b.x)]) == gen, bar);
            __builtin_amdgcn_fence(__ATOMIC_ACQUIRE, "agent");
            asm volatile("s_waitcnt vmcnt(0)" ::: "memory");
        }
    }
    __syncthreads();
}

struct EpiProj {
    bf16 *sbqkv, *mlqk, *mlv, *mlo, *gates;
    __device__ __forceinline__ void operator()(int row, int col, const F8& a) const {
        bf16* dst;
        if (col < 1536) dst = sbqkv + (size_t)row * 1536 + col;
        else if (col < 2560) dst = mlqk + (size_t)row * 1024 + (col - 1536);
        else if (col < 3072) dst = mlv + (size_t)row * 512 + (col - 2560);
        else if (col < 3584) dst = mlo + (size_t)row * 512 + (col - 3072);
        else dst = gates + (size_t)row * 2048 + (col - 3584);
        *(v4u*)dst = pack8(a.v);
    }
};
struct EpiMergeA {
    bf16* merged; const bf16* gates;
    __device__ __forceinline__ void operator()(int row, int col, const F8& a) const {
        float g[8], o[8]; unpack8(*(const v4u*)(gates + (size_t)row * 2048 + col), g);
#pragma unroll
        for (int i = 0; i < 8; ++i) o[i] = sigmoidf_(g[i]) * a.v[i];
        *(v4u*)(merged + (size_t)row * 1024 + col) = pack8(o);
    }
};
struct EpiMergeB {
    bf16* merged; const bf16* gates;
    __device__ __forceinline__ void operator()(int row, int col, const F8& a) const {
        float g[8], o[8]; unpack8(*(const v4u*)(gates + (size_t)row * 2048 + 1024 + col), g);
        unpack8(*(const v4u*)(merged + (size_t)row * 1024 + col), o);
#pragma unroll
        for (int i = 0; i < 8; ++i) o[i] += sigmoidf_(g[i]) * a.v[i];
        *(v4u*)(merged + (size_t)row * 1024 + col) = pack8(o);
    }
};
struct EpiH {
    float* h; const float* x;
    __device__ __forceinline__ void operator()(int row, int col, const F8& a) const {
        const f32x4 x0 = *(const f32x4*)(x + (size_t)row * 1024 + col), x1 = *(const f32x4*)(x + (size_t)row * 1024 + col + 4);
        *(f32x4*)(h + (size_t)row * 1024 + col) = (f32x4){x0.x + a.v[0], x0.y + a.v[1], x0.z + a.v[2], x0.w + a.v[3]};
        *(f32x4*)(h + (size_t)row * 1024 + col + 4) = (f32x4){x1.x + a.v[4], x1.y + a.v[5], x1.z + a.v[6], x1.w + a.v[7]};
    }
};
struct EpiF32 {
    float* o; int ldc;
    __device__ __forceinline__ void operator()(int row, int col, const F8& a) const {
        *(f32x4*)(o + (size_t)row * ldc + col) = (f32x4){a.v[0], a.v[1], a.v[2], a.v[3]};
        *(f32x4*)(o + (size_t)row * ldc + col + 4) = (f32x4){a.v[4], a.v[5], a.v[6], a.v[7]};
    }
};

template <class E> struct EpiAdapt {
    static constexpr bool PERM = true, AFTER_DRAIN = false;
    E e;
    __device__ __forceinline__ void operator()(const pg8::f32x4 (&acc)[2][2][4][2], const pg8::Unit& u, int wr, int wc, int fr, int fq) const {
#pragma unroll
        for (int ai = 0; ai < 2; ++ai)
#pragma unroll
            for (int m = 0; m < 4; ++m) {
                const int row = u.pm * 256 + ai * 128 + wr * 64 + m * 16 + fr;
#pragma unroll
                for (int bj = 0; bj < 2; ++bj) {
                    const int col = u.pn * 256 + bj * 128 + wc * 32 + 8 * fq;
                    F8 a; const pg8::f32x4 v0 = acc[ai][bj][m][0], v1 = acc[ai][bj][m][1];
                    a.v[0] = v0[0]; a.v[1] = v0[1]; a.v[2] = v0[2]; a.v[3] = v0[3]; a.v[4] = v1[0]; a.v[5] = v1[1]; a.v[6] = v1[2]; a.v[7] = v1[3];
                    e(row, col, a);
                }
            }
    }
};

template <class E>
__device__ __forceinline__ void simple_gemm(LAS unsigned char* lds, const bf16* A, const bf16* Bt, int M, int N, int K, const E& e) {
    LAS float* As = (LAS float*)lds;
    LAS float* Bs = As + 32 * 132;
    const int tid = threadIdx.x, ty = tid >> 4, tx = tid & 15;
    const int ntn = N / 128, ntiles = (M / 128) * ntn;
    for (int tile = blockIdx.x; tile < ntiles; tile += gridDim.x) {
        const int tm = tile / ntn, tn = tile % ntn;
        float acc[4][8];
#pragma unroll
        for (int i = 0; i < 4; ++i)
#pragma unroll
            for (int j = 0; j < 8; ++j) acc[i][j] = 0.f;
        for (int k0 = 0; k0 < K; k0 += 32) {
            {
                const int r = tid >> 2, kq = (tid & 3) * 8;
                float fa[8], fb[8];
                unpack8(*(const v4u*)(A + (size_t)(tm * 128 + r) * K + k0 + kq), fa);
                unpack8(*(const v4u*)(Bt + (size_t)(tn * 128 + r) * K + k0 + kq), fb);
#pragma unroll
                for (int i = 0; i < 8; ++i) { As[(kq + i) * 132 + r] = fa[i]; Bs[(kq + i) * 132 + r] = fb[i]; }
            }
            __syncthreads();
#pragma unroll 8
            for (int k = 0; k < 32; ++k) {
                const f32x4 a4 = *(const LAS f32x4*)(As + k * 132 + ty * 4);
                const f32x4 b0 = *(const LAS f32x4*)(Bs + k * 132 + tx * 8), b1 = *(const LAS f32x4*)(Bs + k * 132 + tx * 8 + 4);
                const float av[4] = {a4.x, a4.y, a4.z, a4.w};
                const float bv[8] = {b0.x, b0.y, b0.z, b0.w, b1.x, b1.y, b1.z, b1.w};
#pragma unroll
                for (int i = 0; i < 4; ++i)
#pragma unroll
                    for (int j = 0; j < 8; ++j) acc[i][j] += av[i] * bv[j];
            }
            __syncthreads();
        }
#pragma unroll
        for (int i = 0; i < 4; ++i) {
            F8 a;
#pragma unroll
            for (int j = 0; j < 8; ++j) a.v[j] = acc[i][j];
            e(tm * 128 + ty * 4 + i, tn * 128 + tx * 8, a);
        }
    }
}

template <class E>
__device__ __forceinline__ void gemm(LAS unsigned char* lds, const bf16* A, const bf16* Bt, int M, int N, int K, const E& e) {
#if USE_PG8
    pg8::Gemm g{A, Bt, M, N, K}; pg8::StaticOrder S; S.init(M, N, (int)gridDim.x, (int)blockIdx.x);
    EpiAdapt<E> ea{e};
    pg8::gemm_phase<EpiAdapt<E>, pg8::StaticOrder, true, true>(lds, g, S, ea);
#else
    simple_gemm<E>(lds, A, Bt, M, N, K, e);
#endif
}

__device__ __forceinline__ void transpose_item(const float* W, int ldw, int K, bf16* WT, int src_col0, int dst_row0, LAS float* scr, int kb, int lane) {
    const int k0 = 64 * kb;
#pragma unroll 8
    for (int i = 0; i < 32; ++i) { const int kk = 2 * i + (lane >> 5); scr[kk * 33 + (lane & 31)] = W[(size_t)(k0 + kk) * ldw + src_col0 + (lane & 31)]; }
    LDS_WAIT(); asm volatile("" ::: "memory");
    const int c = lane & 7;
#pragma unroll
    for (int j = 0; j < 4; ++j) { const int n = (lane >> 3) + 8 * j; const LAS float* s = scr + (8 * c) * 33 + n;
        v4u o; o.x = pk2(s[0 * 33], s[1 * 33]); o.y = pk2(s[2 * 33], s[3 * 33]); o.z = pk2(s[4 * 33], s[5 * 33]); o.w = pk2(s[6 * 33], s[7 * 33]);
        *(v4u*)(WT + (size_t)(dst_row0 + n) * K + k0 + 8 * c) = o; }
    LDS_WAIT(); asm volatile("" ::: "memory");
}

struct P {
    const float *x, *norm_mix_w, *w_in, *conv_w, *conv_b, *b_i, *b_f, *ml_norm_w, *w_sb, *w_ml, *w_out, *norm_ffn_w, *w_query, *keys1, *keys2, *peer_u, *peer_v, *norm_final_w;
    float* out; unsigned char* ws;
};

__device__ __forceinline__ void p0_prologue(const P& p, LAS unsigned char* lds, int wave, int lane) {
    LAS float* scr = (LAS float*)(lds + wave * 16384);
    const int gw = blockIdx.x * NWAVES + wave, NGW = gridDim.x * NWAVES;
    bf16* W1T = (bf16*)(p.ws + WS_W1T); bf16* WSBT = (bf16*)(p.ws + WS_WSBT); bf16* WMLT = (bf16*)(p.ws + WS_WMLT); bf16* WOUTT = (bf16*)(p.ws + WS_WOUTT); bf16* WCT = (bf16*)(p.ws + WS_WCT);
    constexpr int I_1 = 16 * 176, I_SB = 8 * 32, I_ML = 8 * 32, I_O = 16 * 32, NT = I_1 + I_SB + I_ML + I_O;
    for (int it = gw; it < NT; it += NGW) {
        int r = it;
        if (r < I_1) { const int kb = r / 176, nb = r % 176, n0 = nb * 32; transpose_item(p.w_in, INC, 1024, W1T, n0 < 3584 ? n0 : n0 + 8, n0, scr, kb, lane); continue; } r -= I_1;
        if (r < I_SB) { const int kb = r / 32, nb = r % 32; transpose_item(p.w_sb, 1024, 512, WSBT, nb * 32, nb * 32, scr, kb, lane); continue; } r -= I_SB;
        if (r < I_ML) { const int kb = r / 32, nb = r % 32; transpose_item(p.w_ml, 1024, 512, WMLT, nb * 32, nb * 32, scr, kb, lane); continue; } r -= I_ML;
        { const int kb = r / 32, nb = r % 32; transpose_item(p.w_out, 1024, 1024, WOUTT, nb * 32, nb * 32, scr, kb, lane); }
    }
    for (int it = gw; it < 2048 * 16; it += NGW) {
        const int col = it >> 4, kb = it & 15, head = col >> 8, half = (col >> 7) & 1, key = col & 127, k = kb * 64 + lane;
        const float* kr = (half ? p.keys2 : p.keys1) + ((size_t)head * 128 + key) * 128;
        const float* wq = p.w_query + (size_t)k * 2048 + head * 256 + half * 128;
        float acc = 0.f;
#pragma unroll 4
        for (int d = 0; d < 128; d += 4) { const f32x4 a = *(const f32x4*)(wq + d), b = *(const f32x4*)(kr + d); acc += a.x * b.x + a.y * b.y + a.z * b.z + a.w * b.w; }
        WCT[(size_t)col * 1024 + k] = (bf16)f2bf(acc);
    }
    bf16* XN = (bf16*)(p.ws + WS_XN); float* IFG = (float*)(p.ws + WS_IFG);
    for (int m = gw; m < T_; m += NGW) {
        const f32x4* xr = (const f32x4*)(p.x + (size_t)m * 1024) + lane;
        const f32x4* wr = (const f32x4*)p.norm_mix_w + lane;
        f32x4 v[4]; float ss = 0.f;
#pragma unroll
        for (int j = 0; j < 4; ++j) { v[j] = xr[64 * j]; ss += (v[j].x * v[j].x + v[j].y * v[j].y) + (v[j].z * v[j].z + v[j].w * v[j].w); }
        const float rstd = 1.f / sqrtf(wave_sum(ss) * (1.f / 1024.f) + EPS);
        float g[8];
#pragma unroll
        for (int i = 0; i < 8; ++i) g[i] = 0.f;
        v2u* o8 = (v2u*)(XN + (size_t)m * 1024) + lane;
#pragma unroll
        for (int j = 0; j < 4; ++j) {
            const f32x4 w = wr[64 * j];
            const float y[4] = {v[j].x * rstd * w.x, v[j].y * rstd * w.y, v[j].z * rstd * w.z, v[j].w * rstd * w.w};
            o8[64 * j] = (v2u){pk2(y[0], y[1]), pk2(y[2], y[3])};
#pragma unroll
            for (int q = 0; q < 4; ++q) {
                const int k = 256 * j + 4 * lane + q;
                const f32x4 w0 = *(const f32x4*)(p.w_in + (size_t)k * INC + 3584), w1 = *(const f32x4*)(p.w_in + (size_t)k * INC + 3588);
                g[0] += y[q] * w0.x; g[1] += y[q] * w0.y; g[2] += y[q] * w0.z; g[3] += y[q] * w0.w;
                g[4] += y[q] * w1.x; g[5] += y[q] * w1.y; g[6] += y[q] * w1.z; g[7] += y[q] * w1.w;
            }
        }
#pragma unroll
        for (int i = 0; i < 8; ++i) g[i] = wave_sum(g[i]);
        if (lane == 0) {
#pragma unroll
            for (int i = 0; i < 4; ++i) { IFG[(size_t)m * 8 + i] = g[i] + p.b_i[i]; IFG[(size_t)m * 8 + 4 + i] = g[4 + i] + p.b_f[i]; }
        }
    }
    {
        const size_t n8 = (size_t)NEXP * 1024 / 8, gt = (size_t)blockIdx.x * NTHR + threadIdx.x, NG = (size_t)gridDim.x * NTHR;
        v4u* U16 = (v4u*)(p.ws + WS_U16); v4u* V16 = (v4u*)(p.ws + WS_V16);
        for (size_t i = gt; i < n8; i += NG) {
            const f32x4 a = ((const f32x4*)p.peer_u)[2 * i], b = ((const f32x4*)p.peer_u)[2 * i + 1];
            U16[i] = (v4u){pk2(a.x, a.y), pk2(a.z, a.w), pk2(b.x, b.y), pk2(b.z, b.w)};
            const f32x4 c = ((const f32x4*)p.peer_v)[2 * i], d = ((const f32x4*)p.peer_v)[2 * i + 1];
            V16[i] = (v4u){pk2(c.x, c.y), pk2(c.z, c.w), pk2(d.x, d.y), pk2(d.z, d.w)};
        }
    }
}

__device__ __forceinline__ void mlstm_item(const P& p, LAS unsigned char* lds, int item, int tid, int wave, int lane) {
    const int bh = item >> 2, es = item & 3, b = bh >> 2, h = bh & 3, e0 = es * 32;
    LAS float* qs = (LAS float*)lds;
    LAS float* ks = qs + 64 * 132;
    LAS float* vs = ks + 64 * 132;
    LAS float* sw = vs + 64 * 33;
    LAS float* Cs = sw + 64 * 65;
    LAS float* ns = Cs + 128 * 33;
    LAS float* a_s = ns + 128;
    LAS float* M_s = a_s + 64;
    LAS float* bc_s = M_s + 64;
    LAS float* wk_s = bc_s + 64;
    LAS float* misc = wk_s + 64;
    const bf16* MLQK = (const bf16*)(p.ws + WS_MLQK); const bf16* MLV = (const bf16*)(p.ws + WS_MLV); const float* IFG = (const float*)(p.ws + WS_IFG);
    bf16* HML = (bf16*)(p.ws + WS_YML);
    for (int i = tid; i < 128 * 33; i += NTHR) Cs[i] = 0.f;
    if (tid < 128) ns[tid] = 0.f;
    if (tid == 0) misc[0] = 0.f;
    __syncthreads();
    const int e = tid & 31, g = tid >> 5;
    for (int c = 0; c < 32; ++c) {
        const int tok0 = b * S_ + c * 64;
        if (wave == 0) {
            const int tok = tok0 + lane;
            const float ip = IFG[(size_t)tok * 8 + h], fp = IFG[(size_t)tok * 8 + 4 + h];
            const float lf = fminf(fp, 0.f) - log1pf(expf(-fabsf(fp)));
            float bc = lf;
#pragma unroll
            for (int o = 1; o < 64; o <<= 1) { const float t2 = __shfl_up(bc, o); if (lane >= o) bc += t2; }
            const float a = ip - bc; float pm = a;
#pragma unroll
            for (int o = 1; o < 64; o <<= 1) { const float t2 = __shfl_up(pm, o); if (lane >= o) pm = fmaxf(pm, t2); }
            const float M = fmaxf(misc[0], pm);
            const float M63 = __shfl(M, 63);
            a_s[lane] = a; M_s[lane] = M; bc_s[lane] = bc; wk_s[lane] = expf(a - M63);
        }
        for (int idx = tid; idx < 64 * 128; idx += NTHR) {
            const int t = idx >> 7, d = idx & 127, chq = h * 128 + d, chk = 512 + h * 128 + d;
            float aq = p.conv_b[chq], ak = p.conv_b[chk];
#pragma unroll
            for (int j = 0; j < 4; ++j) {
                const int pos = c * 64 + t - 3 + j;
                if (pos >= 0) { const size_t row = (size_t)(b * S_ + pos) * 1024; aq += p.conv_w[j * 1024 + chq] * bf2f(MLQK[row + chq]); ak += p.conv_w[j * 1024 + chk] * bf2f(MLQK[row + chk]); }
            }
            qs[t * 132 + d] = aq * sigmoidf_(aq);
            ks[t * 132 + d] = ak * sigmoidf_(ak) * 0.08838834764831845f;
        }
        for (int idx = tid; idx < 64 * 32; idx += NTHR) { const int t = idx >> 5, ee = idx & 31; vs[t * 33 + ee] = bf2f(MLV[(size_t)(tok0 + t) * 512 + h * 128 + e0 + ee]); }
        __syncthreads();
        for (int idx = tid; idx < 4096; idx += NTHR) {
            const int t = idx >> 6, s = idx & 63; float val = 0.f;
            if (s <= t) { float dot = 0.f;
#pragma unroll 8
                for (int d = 0; d < 128; ++d) dot += qs[t * 132 + d] * ks[s * 132 + d];
                val = dot * expf(a_s[s] - M_s[t]); }
            sw[t * 65 + s] = val;
        }
        __syncthreads();
        const float mprev = misc[0];
#pragma unroll 1
        for (int i = 0; i < 4; ++i) {
            const int t = g * 4 + i; float qC = 0.f, qn = 0.f, sv = 0.f, ssum = 0.f;
#pragma unroll 8
            for (int d = 0; d < 128; ++d) { const float qv = qs[t * 132 + d]; qC += qv * Cs[d * 33 + e]; qn += qv * ns[d]; }
#pragma unroll 8
            for (int s = 0; s < 64; ++s) { const float w = sw[t * 65 + s]; sv += w * vs[s * 33 + e]; ssum += w; }
            const float winter = expf(mprev - M_s[t]);
            const float num = sv + winter * qC, den = ssum + winter * qn;
            const float hv = num / fmaxf(fabsf(den), expf(-(bc_s[t] + M_s[t])));
            HML[(size_t)(tok0 + t) * 512 + h * 128 + e0 + e] = (bf16)f2bf(hv);
        }
        __syncthreads();
        {
            const float decay = expf(mprev - M_s[63]);
#pragma unroll 1
            for (int i = 0; i < 8; ++i) { const int d = g * 8 + i; float acc = 0.f;
#pragma unroll 8
                for (int s = 0; s < 64; ++s) acc += wk_s[s] * ks[s * 132 + d] * vs[s * 33 + e];
                Cs[d * 33 + e] = decay * Cs[d * 33 + e] + acc; }
            if (tid < 128) { float acc = 0.f;
#pragma unroll 8
                for (int s = 0; s < 64; ++s) acc += wk_s[s] * ks[s * 132 + tid];
                ns[tid] = decay * ns[tid] + acc; }
        }
        __syncthreads();
        if (tid == 0) misc[0] = bc_s[63] + M_s[63];
    }
    __syncthreads();
}

__device__ __forceinline__ void sba_item(const P& p, int item, int tid, int wave) {
    const int bh = item >> 2, qb = item & 3, b = bh >> 3, h = bh & 7;
    const bf16* QKV = (const bf16*)(p.ws + WS_SBQKV); bf16* YSB = (bf16*)(p.ws + WS_YSB);
    const int t = qb * 512 + tid; const size_t tok = (size_t)b * S_ + t;
    float q[64], acc[64];
    {
        const v4u* qp = (const v4u*)(QKV + tok * 1536 + h * 64);
#pragma unroll
        for (int j = 0; j < 8; ++j) { float f[8]; unpack8(qp[j], f);
#pragma unroll
            for (int i = 0; i < 8; ++i) { q[8 * j + i] = f[i]; acc[8 * j + i] = 0.f; } }
    }
    float suffix = 0.f;
    const int tmax = qb * 512 + wave * 64 + 63;
    for (int s = tmax - 1; s >= 0; --s) {
        const v4u* kp = (const v4u*)(QKV + ((size_t)b * S_ + s) * 1536 + 512 + h * 64);
        float dot = 0.f;
#pragma unroll
        for (int j = 0; j < 8; ++j) { float f[8]; unpack8(kp[j], f);
#pragma unroll
            for (int i = 0; i < 8; ++i) dot += q[8 * j + i] * f[i]; }
        const float z = dot * 0.125f;
        const float sp = fmaxf(z, 0.f) + log1pf(expf(-fabsf(z)));
        const bool active = s < t;
        const float w = active ? expf(z - sp - suffix) : 0.f;
        suffix += active ? sp : 0.f;
        const v4u* vp = kp + 64;
#pragma unroll
        for (int j = 0; j < 8; ++j) { float f[8]; unpack8(vp[j], f);
#pragma unroll
            for (int i = 0; i < 8; ++i) acc[8 * j + i] += w * f[i]; }
        if (__all(suffix > 104.f)) break;
    }
    v4u* op = (v4u*)(YSB + tok * 512 + h * 64);
#pragma unroll
    for (int j = 0; j < 8; ++j) { float f[8];
#pragma unroll
        for (int i = 0; i < 8; ++i) f[i] = acc[8 * j + i];
        op[j] = pack8(f); }
}

__device__ __forceinline__ void p3_yml(const P& p, int wave, int lane) {
    const int gw = blockIdx.x * NWAVES + wave, NGW = gridDim.x * NWAVES;
    bf16* YML = (bf16*)(p.ws + WS_YML); const bf16* MLO = (const bf16*)(p.ws + WS_MLO);
    for (int m = gw; m < T_; m += NGW) {
        float hv[8], ov[8], o[8];
        unpack8(*(const v4u*)(YML + (size_t)m * 512 + lane * 8), hv); unpack8(*(const v4u*)(MLO + (size_t)m * 512 + lane * 8), ov);
        float ss = 0.f;
#pragma unroll
        for (int i = 0; i < 8; ++i) ss += hv[i] * hv[i];
        ss += __shfl_xor(ss, 1); ss += __shfl_xor(ss, 2); ss += __shfl_xor(ss, 4); ss += __shfl_xor(ss, 8);
        const float rstd = 1.f / sqrtf(ss * (1.f / 128.f) + EPS);
        const f32x4 w0 = *(const f32x4*)(p.ml_norm_w + lane * 8), w1 = *(const f32x4*)(p.ml_norm_w + lane * 8 + 4);
        const float wv[8] = {w0.x, w0.y, w0.z, w0.w, w1.x, w1.y, w1.z, w1.w};
#pragma unroll
        for (int i = 0; i < 8; ++i) o[i] = sigmoidf_(ov[i]) * hv[i] * rstd * wv[i];
        *(v4u*)(YML + (size_t)m * 512 + lane * 8) = pack8(o);
    }
}

__device__ __forceinline__ void p6_hn(const P& p, int wave, int lane) {
    const int gw = blockIdx.x * NWAVES + wave, NGW = gridDim.x * NWAVES;
    const float* H = (const float*)(p.ws + WS_H); bf16* HN = (bf16*)(p.ws + WS_HN);
    for (int m = gw; m < T_; m += NGW) {
        const f32x4* xr = (const f32x4*)(H + (size_t)m * 1024) + lane; const f32x4* wr = (const f32x4*)p.norm_ffn_w + lane;
        f32x4 v[4]; float ss = 0.f;
#pragma unroll
        for (int j = 0; j < 4; ++j) { v[j] = xr[64 * j]; ss += (v[j].x * v[j].x + v[j].y * v[j].y) + (v[j].z * v[j].z + v[j].w * v[j].w); }
        const float rstd = 1.f / sqrtf(wave_sum(ss) * (1.f / 1024.f) + EPS);
        v2u* o8 = (v2u*)(HN + (size_t)m * 1024) + lane;
#pragma unroll
        for (int j = 0; j < 4; ++j) { const f32x4 w = wr[64 * j]; o8[64 * j] = (v2u){pk2(v[j].x * rstd * w.x, v[j].y * rstd * w.y), pk2(v[j].z * rstd * w.z, v[j].w * rstd * w.w)}; }
    }
}

__device__ __forceinline__ unsigned ord_key(float f) { const unsigned u = __builtin_bit_cast(unsigned, f); return (u & 0x80000000u) ? ~u : (u | 0x80000000u); }
__device__ __forceinline__ float ord_val(unsigned k) { const unsigned u = (k & 0x80000000u) ? (k & 0x7fffffffu) : ~k; return __builtin_bit_cast(float, u); }
__device__ __forceinline__ void p8_topk(const P& p, int hh, int wave, int lane) {
    const int gw = blockIdx.x * NWAVES + wave, NGW = gridDim.x * NWAVES;
    const float* SC = (const float*)(p.ws + WS_SC); int* IDX = (int*)(p.ws + WS_IDX); float* GATE = (float*)(p.ws + WS_GATE);
    for (int it = gw; it < T_ * 4; it += NGW) {
        const int m = it >> 2, hl = it & 3, head = hh * 4 + hl;
        const float* sr = SC + (size_t)m * 1024 + hl * 256;
        unsigned mine[2];
#pragma unroll
        for (int half = 0; half < 2; ++half) {
            unsigned ka = (ord_key(sr[half * 128 + lane]) & ~0x7fu) | (unsigned)(127 - lane);
            unsigned kb = (ord_key(sr[half * 128 + 64 + lane]) & ~0x7fu) | (unsigned)(127 - (64 + lane));
            unsigned mk = 0u;
#pragma unroll 1
            for (int k = 0; k < 16; ++k) {
                const unsigned mx = wave_max_u(ka > kb ? ka : kb);
                if (ka == mx) ka = 0u; if (kb == mx) kb = 0u;
                if (lane == k) mk = mx;
            }
            mine[half] = mk;
        }
        unsigned ck[4];
#pragma unroll
        for (int j = 0; j < 4; ++j) {
            const int c = lane + 64 * j, a = c >> 4, bb = c & 15;
            const float v1 = ord_val((unsigned)__shfl((int)mine[0], a) & ~0x7fu), v2 = ord_val((unsigned)__shfl((int)mine[1], bb) & ~0x7fu);
            ck[j] = (ord_key(v1 + v2) & ~0xffu) | (unsigned)(255 - c);
        }
        unsigned tk = 0u;
#pragma unroll 1
        for (int k = 0; k < 16; ++k) {
            unsigned mx = ck[0] > ck[1] ? ck[0] : ck[1]; const unsigned m2 = ck[2] > ck[3] ? ck[2] : ck[3]; mx = mx > m2 ? mx : m2;
            mx = wave_max_u(mx);
#pragma unroll
            for (int j = 0; j < 4; ++j) if (ck[j] == mx) ck[j] = 0u;
            if (lane == k) tk = mx;
        }
        const float sv = ord_val(tk & ~0xffu);
        const int c = 255 - (int)(tk & 0xffu), a = (c >> 4) & 15, bb = c & 15;
        const int i1 = 127 - (int)((unsigned)__shfl((int)mine[0], a) & 0x7fu), i2 = 127 - (int)((unsigned)__shfl((int)mine[1], bb) & 0x7fu);
        const float s0 = __shfl(sv, 0);
        const float pe = lane < 16 ? expf(sv - s0) : 0.f;
        const float den = wave_sum(pe);
        if (lane < 16) { IDX[(size_t)m * 128 + head * 16 + lane] = i1 * 128 + i2; GATE[(size_t)m * 128 + head * 16 + lane] = pe / den; }
    }
}

__device__ __forceinline__ float gelu_erf(float x) { return 0.5f * x * (1.f + erff(x * 0.70710678118654752f)); }
__device__ __forceinline__ void p9_peer(const P& p, int wave, int lane) {
    const int gw = blockIdx.x * NWAVES + wave, NGW = gridDim.x * NWAVES;
    const float* H = (const float*)(p.ws + WS_H); const bf16* HN = (const bf16*)(p.ws + WS_HN);
    const int* IDX = (const int*)(p.ws + WS_IDX); const float* GATE = (const float*)(p.ws + WS_GATE);
    const bf16* U16 = (const bf16*)(p.ws + WS_U16); const bf16* V16 = (const bf16*)(p.ws + WS_V16);
    for (int m = gw; m < T_; m += NGW) {
        float xv[16], acc[16];
        { float f[8]; unpack8(*(const v4u*)(HN + (size_t)m * 1024 + lane * 8), f);
#pragma unroll
          for (int i = 0; i < 8; ++i) xv[i] = f[i];
          unpack8(*(const v4u*)(HN + (size_t)m * 1024 + 512 + lane * 8), f);
#pragma unroll
          for (int i = 0; i < 8; ++i) xv[8 + i] = f[i]; }
#pragma unroll
        for (int i = 0; i < 16; ++i) acc[i] = 0.f;
        const int myidx0 = IDX[(size_t)m * 128 + lane], myidx1 = IDX[(size_t)m * 128 + 64 + lane];
        const float myg0 = GATE[(size_t)m * 128 + lane], myg1 = GATE[(size_t)m * 128 + 64 + lane];
#pragma unroll 1
        for (int j0 = 0; j0 < 128; j0 += 4) {
            float dots[4]; int ei[4]; float gi[4];
#pragma unroll
            for (int u = 0; u < 4; ++u) {
                const int j = j0 + u;
                ei[u] = __shfl(j < 64 ? myidx0 : myidx1, j & 63); gi[u] = __shfl(j < 64 ? myg0 : myg1, j & 63);
                float f[8], d = 0.f;
                unpack8(*(const v4u*)(U16 + (size_t)ei[u] * 1024 + lane * 8), f);
#pragma unroll
                for (int i = 0; i < 8; ++i) d += f[i] * xv[i];
                unpack8(*(const v4u*)(U16 + (size_t)ei[u] * 1024 + 512 + lane * 8), f);
#pragma unroll
                for (int i = 0; i < 8; ++i) d += f[i] * xv[8 + i];
                dots[u] = d;
            }
#pragma unroll
            for (int u = 0; u < 4; ++u) dots[u] = wave_sum(dots[u]);
#pragma unroll
            for (int u = 0; u < 4; ++u) {
                const float coef = gi[u] * gelu_erf(dots[u]);
                float f[8];
                unpack8(*(const v4u*)(V16 + (size_t)ei[u] * 1024 + lane * 8), f);
#pragma unroll
                for (int i = 0; i < 8; ++i) acc[i] += coef * f[i];
                unpack8(*(const v4u*)(V16 + (size_t)ei[u] * 1024 + 512 + lane * 8), f);
#pragma unroll
                for (int i = 0; i < 8; ++i) acc[8 + i] += coef * f[i];
            }
        }
        float y[16], ss = 0.f;
#pragma unroll
        for (int hb = 0; hb < 2; ++hb) {
            const f32x4 h0 = *(const f32x4*)(H + (size_t)m * 1024 + hb * 512 + lane * 8), h1 = *(const f32x4*)(H + (size_t)m * 1024 + hb * 512 + lane * 8 + 4);
            y[hb * 8 + 0] = h0.x + acc[hb * 8 + 0]; y[hb * 8 + 1] = h0.y + acc[hb * 8 + 1]; y[hb * 8 + 2] = h0.z + acc[hb * 8 + 2]; y[hb * 8 + 3] = h0.w + acc[hb * 8 + 3];
            y[hb * 8 + 4] = h1.x + acc[hb * 8 + 4]; y[hb * 8 + 5] = h1.y + acc[hb * 8 + 5]; y[hb * 8 + 6] = h1.z + acc[hb * 8 + 6]; y[hb * 8 + 7] = h1.w + acc[hb * 8 + 7];
        }
#pragma unroll
        for (int i = 0; i < 16; ++i) ss += y[i] * y[i];
        const float rstd = 1.f / sqrtf(wave_sum(ss) * (1.f / 1024.f) + EPS);
#pragma unroll
        for (int hb = 0; hb < 2; ++hb) {
            const f32x4 w0 = *(const f32x4*)(p.norm_final_w + hb * 512 + lane * 8), w1 = *(const f32x4*)(p.norm_final_w + hb * 512 + lane * 8 + 4);
            *(f32x4*)(p.out + (size_t)m * 1024 + hb * 512 + lane * 8) = (f32x4){y[hb * 8 + 0] * rstd * w0.x, y[hb * 8 + 1] * rstd * w0.y, y[hb * 8 + 2] * rstd * w0.z, y[hb * 8 + 3] * rstd * w0.w};
            *(f32x4*)(p.out + (size_t)m * 1024 + hb * 512 + lane * 8 + 4) = (f32x4){y[hb * 8 + 4] * rstd * w1.x, y[hb * 8 + 5] * rstd * w1.y, y[hb * 8 + 6] * rstd * w1.z, y[hb * 8 + 7] * rstd * w1.w};
        }
    }
}

constexpr int N_PHASES = 12;
struct Args { P p; int ph_lo, ph_hi; };
__global__ void __launch_bounds__(NTHR, 2) fwd_kernel(Args args) {
    extern __shared__ __attribute__((aligned(16))) unsigned char lds_raw[];
    LAS unsigned char* lds = (LAS unsigned char*)lds_raw;
    const P& p = args.p;
    const int tid = threadIdx.x, lane = tid & 63, wave = __builtin_amdgcn_readfirstlane(tid >> 6);
    volatile LAS unsigned* MISC = (volatile LAS unsigned*)(lds + MISC_OFF);
    for (int u = tid; u < (LDS_BYTES - LDSCTL_OFF) / 4; u += NTHR) ((LAS unsigned*)(lds + LDSCTL_OFF))[u] = 0u;
    __syncthreads();
    XcdBarrier bar; bar.bar = (unsigned*)(p.ws + WS_CTL) + CW_BAR; bar.x = 0; bar.st = nullptr;
#if !MK_PER_PHASE
    bar = xcd_barrier_post((unsigned*)(p.ws + WS_CTL) + CW_BAR, MISC + 8);
#endif
    const int lo = args.ph_lo, hi = args.ph_hi;
#define IN(k) (lo <= (k) && (k) < hi)
#define SEAM(k) do { if (IN(k) && IN((k) + 1)) xcd_barrier(bar); } while (0)

    if (IN(0)) { p0_prologue(p, lds, wave, lane); } SEAM(0);
    if (IN(1)) {
        EpiProj e{(bf16*)(p.ws + WS_SBQKV), (bf16*)(p.ws + WS_MLQK), (bf16*)(p.ws + WS_MLV), (bf16*)(p.ws + WS_MLO), (bf16*)(p.ws + WS_GATES)};
        gemm<EpiProj>(lds, (const bf16*)(p.ws + WS_XN), (const bf16*)(p.ws + WS_W1T), T_, NPROJ, 1024, e);
    } SEAM(1);
    if (IN(2)) {
        for (int it = blockIdx.x; it < 256; it += gridDim.x) mlstm_item(p, lds, it, tid, wave, lane);
        for (int it = blockIdx.x; it < 512; it += gridDim.x) sba_item(p, it, tid, wave);
    } SEAM(2);
    if (IN(3)) { p3_yml(p, wave, lane); } SEAM(3);
    if (IN(4)) {
        EpiMergeA ea{(bf16*)(p.ws + WS_MERGED), (const bf16*)(p.ws + WS_GATES)};
        gemm<EpiMergeA>(lds, (const bf16*)(p.ws + WS_YSB), (const bf16*)(p.ws + WS_WSBT), T_, 1024, 512, ea);
        VM_WAIT(); __syncthreads();
        EpiMergeB eb{(bf16*)(p.ws + WS_MERGED), (const bf16*)(p.ws + WS_GATES)};
        gemm<EpiMergeB>(lds, (const bf16*)(p.ws + WS_YML), (const bf16*)(p.ws + WS_WMLT), T_, 1024, 512, eb);
    } SEAM(4);
    if (IN(5)) {
        EpiH e{(float*)(p.ws + WS_H), p.x};
        gemm<EpiH>(lds, (const bf16*)(p.ws + WS_MERGED), (const bf16*)(p.ws + WS_WOUTT), T_, 1024, 1024, e);
    } SEAM(5);
    if (IN(6)) { p6_hn(p, wave, lane); } SEAM(6);
    if (IN(7)) { EpiF32 e{(float*)(p.ws + WS_SC), 1024}; gemm<EpiF32>(lds, (const bf16*)(p.ws + WS_HN), (const bf16*)(p.ws + WS_WCT), T_, 1024, 1024, e); } SEAM(7);
    if (IN(8)) { p8_topk(p, 0, wave, lane); } SEAM(8);
    if (IN(9)) { EpiF32 e{(float*)(p.ws + WS_SC), 1024}; gemm<EpiF32>(lds, (const bf16*)(p.ws + WS_HN), (const bf16*)(p.ws + WS_WCT) + (size_t)1024 * 1024, T_, 1024, 1024, e); } SEAM(9);
    if (IN(10)) { p8_topk(p, 1, wave, lane); } SEAM(10);
    if (IN(11)) { p9_peer(p, wave, lane); }
#undef IN
#undef SEAM
}

extern "C" void kernel_launch(void* const* d_in, const int* in_sizes, int n_in, void* d_out, int out_size, void* d_ws, size_t ws_size, hipStream_t stream) {
    static int grid = 0;
    if (grid == 0) {
        if (n_in != 18 || in_sizes[0] != T_ * D_ || out_size != T_ * D_ || ws_size < WS_END) {
            fprintf(stderr, "kernel_launch: unexpected problem (n_in %d, in0 %d, out %d, ws %zu); nothing launched\n", n_in, n_in > 0 ? in_sizes[0] : -1, out_size, ws_size); grid = -1; return; }
        int dev = 0, cus = 0, per_cu = 0;
        if (hipGetDevice(&dev) != hipSuccess || hipDeviceGetAttribute(&cus, hipDeviceAttributeMultiprocessorCount, dev) != hipSuccess) { grid = -1; return; }
        if (hipFuncSetAttribute((const void*)fwd_kernel, hipFuncAttributeMaxDynamicSharedMemorySize, LDS_BYTES) != hipSuccess) { fprintf(stderr, "kernel_launch: hipFuncSetAttribute failed\n"); grid = -1; return; }
        if (hipOccupancyMaxActiveBlocksPerMultiprocessor(&per_cu, (const void*)fwd_kernel, NTHR, LDS_BYTES) != hipSuccess || per_cu < 1)
            fprintf(stderr, "kernel_launch: note: occupancy query reports %d workgroups per CU\n", per_cu);
        (void)hipGetLastError();
        grid = cus;
    }
    if (grid < 0) return;
    if (hipMemsetAsync((char*)d_ws + WS_CTL, 0, CTL_ZERO_BYTES, stream) != hipSuccess) { fprintf(stderr, "kernel_launch: memset failed\n"); return; }
    Args a{};
    const float** pp = (const float**)&a.p;
    for (int i = 0; i < 18; ++i) pp[i] = (const float*)d_in[i];
    a.p.out = (float*)d_out; a.p.ws = (unsigned char*)d_ws;
#if MK_PER_PHASE
    for (int ph = 0; ph < N_PHASES; ++ph) {
        a.ph_lo = ph; a.ph_hi = ph + 1;
        hipLaunchKernelGGL(fwd_kernel, dim3(grid), dim3(NTHR), LDS_BYTES, stream, a);
    }
#else
    a.ph_lo = 0; a.ph_hi = N_PHASES;
    hipLaunchKernelGGL(fwd_kernel, dim3(grid), dim3(NTHR), LDS_BYTES, stream, a);
#endif
    const hipError_t le = hipPeekAtLastError();
    if (le != hipSuccess) fprintf(stderr, "kernel_launch: launch failed: %s\n", hipGetErrorName(le));
}
```

```cpp
#include <hip/hip_runtime.h>
#include <cstdio>
#include <cstdint>
namespace pg8 {
#define PG8_LAS __attribute__((address_space(3)))
typedef unsigned short bf16_t;
typedef short bf16x8 __attribute__((ext_vector_type(8)));
typedef float f32x4 __attribute__((ext_vector_type(4)));
typedef unsigned u32x4 __attribute__((ext_vector_type(4)));
constexpr int BM = 256, BK = 64, HALF = 128, HTB = HALF * BK * 2  , STAGE_BYTES = 8 * HTB, NXCD = 8, WGM = 8;

__host__ __device__ __forceinline__ int lds_byte(int r, int c) { const int st = (r >> 4) * 2 + (c >> 5), rr = r & 15, cc = c & 31, ob = rr * 64 + cc * 2; return st * 1024 + (ob ^ (((ob >> 9) & 1) << 5)); }
__host__ __device__ __forceinline__ void stage_rc(int b, int& R, int& C) { const int st = b / 1024, sb = b % 1024, swz = sb ^ (((sb >> 9) & 1) << 5); R = (st >> 1) * 16 + swz / 64; C = (st & 1) * 32 + (swz % 64) / 2; }
__host__ __device__ __forceinline__ int perm32(int rho) { const int n = rho >> 4, i = rho & 15; return 8 * (i >> 2) + 4 * n + (i & 3); }

struct Unit { int pm, pn; };
struct Gemm { const bf16_t* A; const bf16_t* Bt; int M, N, K; };

struct StaticOrder {
    int nM, nN, nwg, G, c;
    __host__ __device__ void init(int M, int N, int G_, int c_) { nM = M / BM; nN = N / BM; nwg = nM * nN; G = G_; c = c_; }
    __host__ __device__ bool next(int i, Unit& u) const {
        const long L = (long)i * G + c; if (L >= nwg) return false;
        int wgid = (int)L; { const int q = nwg / NXCD, r = nwg % NXCD, xcd = wgid % NXCD, off = wgid / NXCD; wgid = (xcd < r ? xcd * (q + 1) : r * (q + 1) + (xcd - r) * q) + off; }
        const int nig = WGM * nN, gid = wgid / nig, fm = gid * WGM, gsz = (nM - fm) < WGM ? (nM - fm) : WGM;
        u.pm = fm + ((wgid % nig) % gsz); u.pn = (wgid % nig) / gsz; return true;
    }
    __device__ __forceinline__ void a_ready(const Unit&) const {}
    __device__ __forceinline__ void done(const Unit&) const {}
};

__device__ __forceinline__ unsigned cvt_pk_bf16(float lo, float hi) { unsigned r; asm volatile("v_cvt_pk_bf16_f32 %0, %1, %2" : "=v"(r) : "v"(lo), "v"(hi)); return r; }
template <class Epi, class Sched, bool ALIGN_EPI = false, bool SP2 = false>
__device__ __forceinline__ void gemm_phase(PG8_LAS unsigned char* lds, const Gemm g, const Sched& S, const Epi& E) {
    const int tid = threadIdx.x, wid = __builtin_amdgcn_readfirstlane(tid >> 6), lane = tid & 63, wr = wid >> 2, wc = wid & 3, fr = lane & 15, fq = lane >> 4;
    const int K = g.K, nt = K / BK;
    unsigned voffA[2], voffB[2];
#pragma unroll
    for (int i = 0; i < 2; ++i) { int R, C; stage_rc(tid * 16 + i * 8192, R, C); const int Rb = Epi::PERM ? ((R & ~31) + perm32(R & 31)) : R;
        voffA[i] = (unsigned)(R * K + C) * 2u; voffB[i] = (unsigned)(Rb * K + C) * 2u; }
    const size_t kstep = (size_t)(BK * 2);
    const size_t hstep = (size_t)HALF * K * 2;
    const size_t tstep = 2 * hstep;
    const unsigned ldsw = (unsigned)wid * 1024u;
    const int aoff = lds_byte(wr * 64 + fr, fq * 8), boff = lds_byte(wc * 32 + fr, fq * 8);
#define PG8_SA(b, h) (((b) * 2 + (h)) * HTB)
#define PG8_SB(b, h) ((4 + (b) * 2 + (h)) * HTB)
#define PG8_STAGE(bufoff, gbase, voff) do { _Pragma("unroll") for (int _i = 0; _i < 2; ++_i) \
        __builtin_amdgcn_global_load_lds((const unsigned*)((const char*)(gbase) + (voff)[_i]), (PG8_LAS unsigned*)(lds + (bufoff) + ldsw + _i * 8192), 16, 0, 0); } while (0)
#define PG8_LDA(dst, b, h) do { _Pragma("unroll") for (int m = 0; m < 4; ++m) _Pragma("unroll") for (int k = 0; k < 2; ++k) dst[m][k] = *(const PG8_LAS bf16x8*)(lds + PG8_SA(b, h) + aoff + m * 2048 + k * 1024); } while (0)
#define PG8_LDB(dst, b, h) do { _Pragma("unroll") for (int n = 0; n < 2; ++n) _Pragma("unroll") for (int k = 0; k < 2; ++k) dst[n][k] = *(const PG8_LAS bf16x8*)(lds + PG8_SB(b, h) + boff + n * 2048 + k * 1024); } while (0)
#define PG8_MMA(ai, bj, At, Bt) do { __builtin_amdgcn_s_setprio(1); _Pragma("unroll") for (int m = 0; m < 4; ++m) _Pragma("unroll") for (int n = 0; n < 2; ++n) _Pragma("unroll") for (int k = 0; k < 2; ++k) \
        acc[ai][bj][m][n] = __builtin_amdgcn_mfma_f32_16x16x32_bf16(Bt[n][k], At[m][k], acc[ai][bj][m][n], 0, 0, 0); __builtin_amdgcn_s_setprio(0); } while (0)
#define PG8_WAIT_V(n) asm volatile("s_waitcnt vmcnt(" #n ")" ::: "memory")
#define PG8_WAIT_L(n) asm volatile("s_waitcnt lgkmcnt(" #n ")" ::: "memory")
#define PG8_BAR __builtin_amdgcn_s_barrier()
#define PG8_SCHED __builtin_amdgcn_sched_barrier(0)
    Unit cur, nxt; int ui = 0;
    if (!S.next(0, cur)) return;
    f32x4 acc[2][2][4][2];
#pragma unroll
    for (int a = 0; a < 2; ++a)
#pragma unroll
        for (int b = 0; b < 2; ++b)
#pragma unroll
            for (int m = 0; m < 4; ++m)
#pragma unroll
                for (int n = 0; n < 2; ++n) acc[a][b][m][n] = (f32x4){0.f, 0.f, 0.f, 0.f};
    bf16x8 At[4][2], B0[2][2], B1[2][2];
    const char* cA = (const char*)g.A + (size_t)cur.pm * tstep; const char* cB = (const char*)g.Bt + (size_t)cur.pn * tstep;
    S.a_ready(cur);
    if constexpr (SP2) {
        PG8_STAGE(PG8_SB(0, 0), cB, voffB); PG8_STAGE(PG8_SB(0, 1), cB + hstep, voffB); PG8_STAGE(PG8_SA(0, 0), cA, voffA); PG8_STAGE(PG8_SA(0, 1), cA + hstep, voffA);
        if (wr == 1) PG8_BAR;
        PG8_WAIT_V(2); PG8_BAR;
        PG8_STAGE(PG8_SB(1, 0), cB + kstep, voffB); PG8_STAGE(PG8_SA(1, 0), cA + kstep, voffA); PG8_STAGE(PG8_SB(1, 1), cB + hstep + kstep, voffB);
        PG8_WAIT_V(6); PG8_BAR;
    } else {
        PG8_STAGE(PG8_SB(0, 0), cB, voffB); PG8_STAGE(PG8_SA(0, 0), cA, voffA); PG8_STAGE(PG8_SB(0, 1), cB + hstep, voffB); PG8_STAGE(PG8_SA(0, 1), cA + hstep, voffA);
        if (wr == 1) PG8_BAR;
        PG8_WAIT_V(4); PG8_BAR;
        PG8_STAGE(PG8_SB(1, 0), cB + kstep, voffB); PG8_STAGE(PG8_SA(1, 0), cA + kstep, voffA); PG8_STAGE(PG8_SB(1, 1), cB + hstep + kstep, voffB);
        PG8_WAIT_V(6); PG8_BAR;
    }
    for (;;) {
        const bool has_next = S.next(ui + 1, nxt);
        const char* nA = has_next ? (const char*)g.A + (size_t)nxt.pm * tstep : cA; const char* nB = has_next ? (const char*)g.Bt + (size_t)nxt.pn * tstep : cB;
        for (int t = 0; t < nt; t += 2) {
            const bool last = (t == nt - 2);
            const char* a1 = cA + (size_t)(t + 1) * kstep;
            const char* a2 = last ? nA : cA + (size_t)(t + 2) * kstep; const char* b2 = last ? nB : cB + (size_t)(t + 2) * kstep;
            const char* a3 = a2 + kstep; const char* b3 = b2 + kstep;
            if (last && has_next) S.a_ready(nxt);
            if constexpr (SP2) {
            PG8_LDB(B0, 0, 0); PG8_LDB(B1, 0, 1); PG8_SCHED; PG8_LDA(At, 0, 0); PG8_STAGE(PG8_SA(1, 1), a1 + hstep, voffA);
            PG8_WAIT_V(8); PG8_WAIT_L(0); PG8_BAR; PG8_MMA(0, 0, At, B0); PG8_MMA(0, 1, At, B1); PG8_BAR; PG8_SCHED;
            PG8_LDA(At, 0, 1); PG8_STAGE(PG8_SB(0, 0), b2, voffB); PG8_STAGE(PG8_SB(0, 1), b2 + hstep, voffB); PG8_STAGE(PG8_SA(0, 0), a2, voffA);
            PG8_WAIT_V(8); PG8_WAIT_L(0); PG8_BAR; PG8_MMA(1, 0, At, B0); PG8_MMA(1, 1, At, B1); PG8_BAR; PG8_SCHED;
            PG8_LDB(B0, 1, 0); PG8_LDB(B1, 1, 1); PG8_SCHED; PG8_LDA(At, 1, 0); PG8_STAGE(PG8_SA(0, 1), a2 + hstep, voffA);
            PG8_WAIT_V(8); PG8_WAIT_L(0); PG8_BAR; PG8_MMA(0, 0, At, B0); PG8_MMA(0, 1, At, B1); PG8_BAR; PG8_SCHED;
            PG8_LDA(At, 1, 1); PG8_STAGE(PG8_SB(1, 0), b3, voffB); PG8_STAGE(PG8_SB(1, 1), b3 + hstep, voffB); PG8_STAGE(PG8_SA(1, 0), a3, voffA);
            PG8_WAIT_V(8); PG8_WAIT_L(0); PG8_BAR; PG8_MMA(1, 0, At, B0); PG8_MMA(1, 1, At, B1); PG8_BAR; PG8_SCHED;
            } else {
            PG8_LDB(B0, 0, 0); PG8_SCHED; PG8_LDA(At, 0, 0); PG8_STAGE(PG8_SA(1, 1), a1 + hstep, voffA);
            PG8_WAIT_L(8); PG8_BAR; PG8_WAIT_L(0); PG8_MMA(0, 0, At, B0); PG8_BAR; PG8_SCHED;
            PG8_LDB(B1, 0, 1); PG8_STAGE(PG8_SB(0, 0), b2, voffB);
            PG8_BAR; PG8_WAIT_L(0); PG8_MMA(0, 1, At, B1); PG8_BAR;
            PG8_LDA(At, 0, 1); PG8_STAGE(PG8_SA(0, 0), a2, voffA);
            PG8_BAR; PG8_WAIT_L(0); PG8_MMA(1, 0, At, B0); PG8_BAR; PG8_SCHED;
            PG8_STAGE(PG8_SB(0, 1), b2 + hstep, voffB);
            PG8_WAIT_V(6); PG8_BAR; PG8_MMA(1, 1, At, B1); PG8_BAR;
            PG8_LDB(B0, 1, 0); PG8_SCHED; PG8_LDA(At, 1, 0); PG8_STAGE(PG8_SA(0, 1), a2 + hstep, voffA);
            PG8_WAIT_L(8); PG8_BAR; PG8_WAIT_L(0); PG8_MMA(0, 0, At, B0); PG8_BAR; PG8_SCHED;
            PG8_LDB(B1, 1, 1); PG8_STAGE(PG8_SB(1, 0), b3, voffB);
            PG8_BAR; PG8_WAIT_L(0); PG8_MMA(0, 1, At, B1); PG8_BAR;
            PG8_LDA(At, 1, 1); PG8_STAGE(PG8_SA(1, 0), a3, voffA);
            PG8_BAR; PG8_WAIT_L(0); PG8_MMA(1, 0, At, B0); PG8_BAR; PG8_SCHED;
            PG8_STAGE(PG8_SB(1, 1), b3 + hstep, voffB);
            PG8_WAIT_V(6); PG8_BAR; PG8_MMA(1, 1, At, B1); PG8_BAR;
            }
        }
        if constexpr (ALIGN_EPI) { if (wr == 0) PG8_BAR; }
        if constexpr (!Epi::AFTER_DRAIN) { E(acc, cur, wr, wc, fr, fq); S.done(cur); }
        if (!has_next) break;
#pragma unroll
        for (int a = 0; a < 2; ++a)
#pragma unroll
            for (int b = 0; b < 2; ++b)
#pragma unroll
                for (int m = 0; m < 4; ++m)
#pragma unroll
                    for (int n = 0; n < 2; ++n) acc[a][b][m][n] = (f32x4){0.f, 0.f, 0.f, 0.f};
        cur = nxt; cA = nA; cB = nB; ++ui;
        if constexpr (ALIGN_EPI) { if (wr == 1) PG8_BAR; }
    }
    PG8_WAIT_V(0);
    if constexpr (!ALIGN_EPI) { if (wr == 0) PG8_BAR; }
    PG8_BAR;
    if constexpr (Epi::AFTER_DRAIN) { E.fused(acc, cur, wr, wc, fr, fq, lds, wid, lane); S.done(cur); }
#undef PG8_SA
#undef PG8_SB
#undef PG8_STAGE
#undef PG8_LDA
#undef PG8_LDB
#undef PG8_MMA
#undef PG8_WAIT_V
#undef PG8_WAIT_L
#undef PG8_BAR
#undef PG8_SCHED
}
}

#ifndef MK_PER_PHASE
#define MK_PER_PHASE 0
#endif
#ifndef USE_PG8
#define USE_PG8 1
#endif
constexpr int NWAVES = 8, NTHR = 512;

constexpr int B_ = 16, S_ = 2048, D_ = 1024, T_ = B_ * S_;
constexpr int INC = 5640, NPROJ = 5632;
constexpr int NEXP = 16384;
constexpr float EPS = 1e-6f;

constexpr size_t MiB = 1u << 20;
constexpr size_t WS_CTL = 0, CTL_ZERO_BYTES = 1 * MiB;
constexpr size_t WS_W1T = 2 * MiB, WS_WSBT = 13 * MiB, WS_WMLT = 14 * MiB, WS_WOUTT = 15 * MiB, WS_WCT = 17 * MiB, WS_IFG = 21 * MiB;
constexpr size_t WS_U16 = 24 * MiB, WS_V16 = 56 * MiB;
constexpr size_t WS_XN = 88 * MiB, WS_YSB = 88 * MiB, WS_YML = 120 * MiB;
constexpr size_t WS_SBQKV = 152 * MiB, WS_MLQK = 248 * MiB, WS_MLV = 312 * MiB, WS_MLO = 344 * MiB, WS_GATES = 376 * MiB;
constexpr size_t WS_MERGED = 216 * MiB, WS_H = 88 * MiB, WS_HN = 216 * MiB, WS_IDX = 280 * MiB, WS_GATE = 296 * MiB, WS_SC = 312 * MiB;
constexpr size_t WS_END = 504 * MiB;
constexpr int CW_BAR = 4096;

constexpr int RING_OFF = 0, RING_BYTES = 131072;
constexpr int LDSCTL_OFF = RING_BYTES, MISC_OFF = LDSCTL_OFF + 320;
constexpr int LDS_BYTES = 147456;

#define GAS __attribute__((address_space(1)))
#define LAS __attribute__((address_space(3)))
typedef unsigned short bf16;
typedef unsigned v4u __attribute__((ext_vector_type(4)));
typedef unsigned v2u __attribute__((ext_vector_type(2)));
typedef float f32x4 __attribute__((ext_vector_type(4)));
#define LDS_WAIT() asm volatile("s_waitcnt lgkmcnt(0)" ::: "memory")
#define VM_WAIT() asm volatile("s_waitcnt vmcnt(0)" ::: "memory")
__device__ __forceinline__ unsigned f2bf(float f) { unsigned u = __builtin_bit_cast(unsigned, f); return (u + 0x7fffu + ((u >> 16) & 1u)) >> 16; }
__device__ __forceinline__ unsigned pk2(float lo, float hi) { return f2bf(lo) | (f2bf(hi) << 16); }
__device__ __forceinline__ float bflo(unsigned u) { return __builtin_bit_cast(float, u << 16); }
__device__ __forceinline__ float bfhi(unsigned u) { return __builtin_bit_cast(float, u & 0xffff0000u); }
__device__ __forceinline__ float bf2f(bf16 b) { return __builtin_bit_cast(float, (unsigned)b << 16); }
__device__ __forceinline__ float sigmoidf_(float x) { return 1.f / (1.f + __expf(-x)); }
__device__ __forceinline__ float wave_sum(float v) {
#pragma unroll
    for (int o = 1; o < 64; o <<= 1) v += __shfl_xor(v, o);
    return v;
}
__device__ __forceinline__ unsigned wave_max_u(unsigned v) {
#pragma unroll
    for (int o = 1; o < 64; o <<= 1) { const unsigned w = (unsigned)__shfl_xor((int)v, o); v = v > w ? v : w; }
    return v;
}
struct F8 { float v[8]; };
__device__ __forceinline__ void unpack8(const v4u& u, float (&f)[8]) {
    f[0] = bflo(u.x); f[1] = bfhi(u.x); f[2] = bflo(u.y); f[3] = bfhi(u.y); f[4] = bflo(u.z); f[5] = bfhi(u.z); f[6] = bflo(u.w); f[7] = bfhi(u.w);
}
__device__ __forceinline__ v4u pack8(const float (&f)[8]) { v4u o; o.x = pk2(f[0], f[1]); o.y = pk2(f[2], f[3]); o.z = pk2(f[4], f[5]); o.w = pk2(f[6], f[7]); return o; }

#define XB_TMO      128
#define XB_XCNT(j)  (256  + 64 * (j))
#define XB_XSUB(j)  (1280 + 64 * (j))
#define XB_XGEN(j)  (2304 + 64 * (j))
#define XB_TOP      3328
#define XB_TOPGEN   3392
#define XCD_BAR_WORDS 3456
#define XB_SPIN_CAP (1u << 24)

__device__ __forceinline__ unsigned xb_ld(unsigned* p)              { return __hip_atomic_load(p, __ATOMIC_RELAXED, __HIP_MEMORY_SCOPE_AGENT); }
__device__ __forceinline__ unsigned xb_add(unsigned* p, unsigned v) { return __hip_atomic_fetch_add(p, v, __ATOMIC_RELAXED, __HIP_MEMORY_SCOPE_AGENT); }
__device__ __forceinline__ unsigned xb_xcc_id() { return (unsigned)__builtin_amdgcn_s_getreg((3 << 11) | 20) & 0xFu; }
#define XB_SPIN(cond, bar) do { unsigned _sp = 0; while (cond) { __builtin_amdgcn_s_sleep(1); \
    if ((++_sp & 255u) == 0u) { if (xb_ld(&(bar)[XB_TMO])) break; if (_sp > XB_SPIN_CAP) { atomicAdd(&(bar)[XB_TMO], 1u); break; } } } } while (0)

struct XcdBarrier {
    unsigned* bar; unsigned x;
    volatile LAS unsigned* st;
};

__device__ __forceinline__ XcdBarrier xcd_barrier_post(unsigned* bar, volatile LAS unsigned* st) {
    XcdBarrier b; b.bar = bar; b.x = xb_xcc_id(); b.st = st;
    if (threadIdx.x == 0) (void)xb_add(&bar[XB_XCNT(b.x)], 1u);
    return b;
}
__device__ __forceinline__ void xcd_barrier_complete(unsigned* bar, unsigned x, unsigned& nloc, unsigned& nx) {
    const unsigned G = gridDim.x * gridDim.y * gridDim.z;
    unsigned sum, cnt, mine, sp = 0u;
    for (;;) {
        sum = 0u; cnt = 0u; mine = 0u;
#pragma unroll
        for (unsigned j = 0; j < 16; ++j) { const unsigned c = xb_ld(&bar[XB_XCNT(j)]); sum += c; cnt += (c > 0u) ? 1u : 0u; mine = (j == x) ? c : mine; }
        if (sum == G) break;
        __builtin_amdgcn_s_sleep(1);
        if ((++sp & 255u) == 0u) { if (xb_ld(&bar[XB_TMO])) break; if (sp > XB_SPIN_CAP) { atomicAdd(&bar[XB_TMO], 1u); break; } }
    }
    nloc = mine > 0u ? mine : 1u; nx = cnt > 0u ? cnt : 1u;
}

__device__ __forceinline__ void xcd_barrier(const XcdBarrier& b) {
    asm volatile("s_waitcnt vmcnt(0)" ::: "memory");
    __syncthreads();
    if (threadIdx.x == 0) {
        unsigned* bar = b.bar;
        __builtin_amdgcn_s_waitcnt(0);
        unsigned nloc = b.st[0], nx = b.st[1];
        if (nloc == 0u) { xcd_barrier_complete(bar, b.x, nloc, nx); b.st[0] = nloc; b.st[1] = nx; }
        const unsigned old = xb_add(&bar[XB_XSUB(b.x)], 1u);
        const unsigned gen = old / nloc;
        if (old + 1u == (gen + 1u) * nloc) {
            __builtin_amdgcn_fence(__ATOMIC_RELEASE, "agent");
            asm volatile("s_waitcnt vmcnt(0)" ::: "memory");
            const unsigned og = xb_add(&bar[XB_TOP], 1u);
            const unsigned tg = og / nx;
            if (og + 1u == (tg + 1u) * nx) xb_add(&bar[XB_TOPGEN], 1u);
            else XB_SPIN(xb_ld(&bar[XB_TOPGEN]) == tg, bar);
            __builtin_amdgcn_fence(__ATOMIC_ACQUIRE, "agent");
            xb_add(&bar[XB_XGEN(b.x)], 1u);
            asm volatile("s_waitcnt vmcnt(0)" ::: "memory");
        } else {
            XB_SPIN(xb_ld(&bar[XB_XGEN(b.x)]) == gen, bar);
            __builtin_amdgcn_fence(__ATOMIC_ACQUIRE, "agent");
            asm volatile("s_waitcnt vmcnt(0)" ::: "memory");
        }
    }
    __syncthreads();
}

struct EpiProj {
    bf16 *sbqkv, *mlqk, *mlv, *mlo, *gates;
    __device__ __forceinline__ void operator()(int row, int col, const F8& a) const {
        bf16* dst;
        if (col < 1536) dst = sbqkv + (size_t)row * 1536 + col;
        else if (col < 2560) dst = mlqk + (size_t)row * 1024 + (col - 1536);
        else if (col < 3072) dst = mlv + (size_t)row * 512 + (col - 2560);
        else if (col < 3584) dst = mlo + (size_t)row * 512 + (col - 3072);
        else dst = gates + (size_t)row * 2048 + (col - 3584);
        *(v4u*)dst = pack8(a.v);
    }
};
struct EpiMergeA {
    bf16* merged; const bf16* gates;
    __device__ __forceinline__ void operator()(int row, int col, const F8& a) const {
        float g[8], o[8]; unpack8(*(const v4u*)(gates + (size_t)row * 2048 + col), g);
#pragma unroll
        for (int i = 0; i < 8; ++i) o[i] = sigmoidf_(g[i]) * a.v[i];
        *(v4u*)(merged + (size_t)row * 1024 + col) = pack8(o);
    }
};
struct EpiMergeB {
    bf16* merged; const bf16* gates;
    __device__ __forceinline__ void operator()(int row, int col, const F8& a) const {
        float g[8], o[8]; unpack8(*(const v4u*)(gates + (size_t)row * 2048 + 1024 + col), g);
        unpack8(*(const v4u*)(merged + (size_t)row * 1024 + col), o);
#pragma unroll
        for (int i = 0; i < 8; ++i) o[i] += sigmoidf_(g[i]) * a.v[i];
        *(v4u*)(merged + (size_t)row * 1024 + col) = pack8(o);
    }
};
struct EpiH {
    float* h; const float* x;
    __device__ __forceinline__ void operator()(int row, int col, const F8& a) const {
        const f32x4 x0 = *(const f32x4*)(x + (size_t)row * 1024 + col), x1 = *(const f32x4*)(x + (size_t)row * 1024 + col + 4);
        *(f32x4*)(h + (size_t)row * 1024 + col) = (f32x4){x0.x + a.v[0], x0.y + a.v[1], x0.z + a.v[2], x0.w + a.v[3]};
        *(f32x4*)(h + (size_t)row * 1024 + col + 4) = (f32x4){x1.x + a.v[4], x1.y + a.v[5], x1.z + a.v[6], x1.w + a.v[7]};
    }
};
struct EpiF32 {
    float* o; int ldc;
    __device__ __forceinline__ void operator()(int row, int col, const F8& a) const {
        *(f32x4*)(o + (size_t)row * ldc + col) = (f32x4){a.v[0], a.v[1], a.v[2], a.v[3]};
        *(f32x4*)(o + (size_t)row * ldc + col + 4) = (f32x4){a.v[4], a.v[5], a.v[6], a.v[7]};
    }
};

template <class E> struct EpiAdapt {
    static constexpr bool PERM = true, AFTER_DRAIN = false;
    E e;
    __device__ __forceinline__ void operator()(const pg8::f32x4 (&acc)[2][2][4][2], const pg8::Unit& u, int wr, int wc, int fr, int fq) const {
#pragma unroll
        for (int ai = 0; ai < 2; ++ai)
#pragma unroll
            for (int m = 0; m < 4; ++m) {
                const int row = u.pm * 256 + ai * 128 + wr * 64 + m * 16 + fr;
#pragma unroll
                for (int bj = 0; bj < 2; ++bj) {
                    const int col = u.pn * 256 + bj * 128 + wc * 32 + 8 * fq;
                    F8 a; const pg8::f32x4 v0 = acc[ai][bj][m][0], v1 = acc[ai][bj][m][1];
                    a.v[0] = v0[0]; a.v[1] = v0[1]; a.v[2] = v0[2]; a.v[3] = v0[3]; a.v[4] = v1[0]; a.v[5] = v1[1]; a.v[6] = v1[2]; a.v[7] = v1[3];
                    e(row, col, a);
                }
            }
    }
};

template <class E>
__device__ __forceinline__ void simple_gemm(LAS unsigned char* lds, const bf16* A, const bf16* Bt, int M, int N, int K, const E& e) {
    LAS float* As = (LAS float*)lds;
    LAS float* Bs = As + 32 * 132;
    const int tid = threadIdx.x, ty = tid >> 4, tx = tid & 15;
    const int ntn = N / 128, ntiles = (M / 128) * ntn;
    for (int tile = blockIdx.x; tile < ntiles; tile += gridDim.x) {
        const int tm = tile / ntn, tn = tile % ntn;
        float acc[4][8];
#pragma unroll
        for (int i = 0; i < 4; ++i)
#pragma unroll
            for (int j = 0; j < 8; ++j) acc[i][j] = 0.f;
        for (int k0 = 0; k0 < K; k0 += 32) {
            {
                const int r = tid >> 2, kq = (tid & 3) * 8;
                float fa[8], fb[8];
                unpack8(*(const v4u*)(A + (size_t)(tm * 128 + r) * K + k0 + kq), fa);
                unpack8(*(const v4u*)(Bt + (size_t)(tn * 128 + r) * K + k0 + kq), fb);
#pragma unroll
                for (int i = 0; i < 8; ++i) { As[(kq + i) * 132 + r] = fa[i]; Bs[(kq + i) * 132 + r] = fb[i]; }
            }
            __syncthreads();
#pragma unroll 8
            for (int k = 0; k < 32; ++k) {
                const f32x4 a4 = *(const LAS f32x4*)(As + k * 132 + ty * 4);
                const f32x4 b0 = *(const LAS f32x4*)(Bs + k * 132 + tx * 8), b1 = *(const LAS f32x4*)(Bs + k * 132 + tx * 8 + 4);
                const float av[4] = {a4.x, a4.y, a4.z, a4.w};
                const float bv[8] = {b0.x, b0.y, b0.z, b0.w, b1.x, b1.y, b1.z, b1.w};
#pragma unroll
                for (int i = 0; i < 4; ++i)
#pragma unroll
                    for (int j = 0; j < 8; ++j) acc[i][j] += av[i] * bv[j];
            }
            __syncthreads();
        }
#pragma unroll
        for (int i = 0; i < 4; ++i) {
            F8 a;
#pragma unroll
            for (int j = 0; j < 8; ++j) a.v[j] = acc[i][j];
            e(tm * 128 + ty * 4 + i, tn * 128 + tx * 8, a);
        }
    }
}

template <class E>
__device__ __forceinline__ void gemm(LAS unsigned char* lds, const bf16* A, const bf16* Bt, int M, int N, int K, const E& e) {
#if USE_PG8
    pg8::Gemm g{A, Bt, M, N, K}; pg8::StaticOrder S; S.init(M, N, (int)gridDim.x, (int)blockIdx.x);
    EpiAdapt<E> ea{e};
    pg8::gemm_phase<EpiAdapt<E>, pg8::StaticOrder, true, true>(lds, g, S, ea);
#else
    simple_gemm<E>(lds, A, Bt, M, N, K, e);
#endif
}

__device__ __forceinline__ void transpose_item(const float* W, int ldw, int K, bf16* WT, int src_col0, int dst_row0, LAS float* scr, int kb, int lane) {
    const int k0 = 64 * kb;
#pragma unroll 8
    for (int i = 0; i < 32; ++i) { const int kk = 2 * i + (lane >> 5); scr[kk * 33 + (lane & 31)] = W[(size_t)(k0 + kk) * ldw + src_col0 + (lane & 31)]; }
    LDS_WAIT(); asm volatile("" ::: "memory");
    const int c = lane & 7;
#pragma unroll
    for (int j = 0; j < 4; ++j) { const int n = (lane >> 3) + 8 * j; const LAS float* s = scr + (8 * c) * 33 + n;
        v4u o; o.x = pk2(s[0 * 33], s[1 * 33]); o.y = pk2(s[2 * 33], s[3 * 33]); o.z = pk2(s[4 * 33], s[5 * 33]); o.w = pk2(s[6 * 33], s[7 * 33]);
        *(v4u*)(WT + (size_t)(dst_row0 + n) * K + k0 + 8 * c) = o; }
    LDS_WAIT(); asm volatile("" ::: "memory");
}

struct P {
    const float *x, *norm_mix_w, *w_in, *conv_w, *conv_b, *b_i, *b_f, *ml_norm_w, *w_sb, *w_ml, *w_out, *norm_ffn_w, *w_query, *keys1, *keys2, *peer_u, *peer_v, *norm_final_w;
    float* out; unsigned char* ws;
};

__device__ __forceinline__ void p0_prologue(const P& p, LAS unsigned char* lds, int wave, int lane) {
    LAS float* scr = (LAS float*)(lds + wave * 16384);
    const int gw = blockIdx.x * NWAVES + wave, NGW = gridDim.x * NWAVES;
    bf16* W1T = (bf16*)(p.ws + WS_W1T); bf16* WSBT = (bf16*)(p.ws + WS_WSBT); bf16* WMLT = (bf16*)(p.ws + WS_WMLT); bf16* WOUTT = (bf16*)(p.ws + WS_WOUTT); bf16* WCT = (bf16*)(p.ws + WS_WCT);
    constexpr int I_1 = 16 * 176, I_SB = 8 * 32, I_ML = 8 * 32, I_O = 16 * 32, NT = I_1 + I_SB + I_ML + I_O;
    for (int it = gw; it < NT; it += NGW) {
        int r = it;
        if (r < I_1) { const int kb = r / 176, nb = r % 176, n0 = nb * 32; transpose_item(p.w_in, INC, 1024, W1T, n0 < 3584 ? n0 : n0 + 8, n0, scr, kb, lane); continue; } r -= I_1;
        if (r < I_SB) { const int kb = r / 32, nb = r % 32; transpose_item(p.w_sb, 1024, 512, WSBT, nb * 32, nb * 32, scr, kb, lane); continue; } r -= I_SB;
        if (r < I_ML) { const int kb = r / 32, nb = r % 32; transpose_item(p.w_ml, 1024, 512, WMLT, nb * 32, nb * 32, scr, kb, lane); continue; } r -= I_ML;
        { const int kb = r / 32, nb = r % 32; transpose_item(p.w_out, 1024, 1024, WOUTT, nb * 32, nb * 32, scr, kb, lane); }
    }
    for (int it = gw; it < 2048 * 16; it += NGW) {
        const int col = it >> 4, kb = it & 15, head = col >> 8, half = (col >> 7) & 1, key = col & 127, k = kb * 64 + lane;
        const float* kr = (half ? p.keys2 : p.keys1) + ((size_t)head * 128 + key) * 128;
        const float* wq = p.w_query + (size_t)k * 2048 + head * 256 + half * 128;
        float acc = 0.f;
#pragma unroll 4
        for (int d = 0; d < 128; d += 4) { const f32x4 a = *(const f32x4*)(wq + d), b = *(const f32x4*)(kr + d); acc += a.x * b.x + a.y * b.y + a.z * b.z + a.w * b.w; }
        WCT[(size_t)col * 1024 + k] = (bf16)f2bf(acc);
    }
    bf16* XN = (bf16*)(p.ws + WS_XN); float* IFG = (float*)(p.ws + WS_IFG);
    for (int m = gw; m < T_; m += NGW) {
        const f32x4* xr = (const f32x4*)(p.x + (size_t)m * 1024) + lane;
        const f32x4* wr = (const f32x4*)p.norm_mix_w + lane;
        f32x4 v[4]; float ss = 0.f;
#pragma unroll
        for (int j = 0; j < 4; ++j) { v[j] = xr[64 * j]; ss += (v[j].x * v[j].x + v[j].y * v[j].y) + (v[j].z * v[j].z + v[j].w * v[j].w); }
        const float rstd = 1.f / sqrtf(wave_sum(ss) * (1.f / 1024.f) + EPS);
        float g[8];
#pragma unroll
        for (int i = 0; i < 8; ++i) g[i] = 0.f;
        v2u* o8 = (v2u*)(XN + (size_t)m * 1024) + lane;
#pragma unroll
        for (int j = 0; j < 4; ++j) {
            const f32x4 w = wr[64 * j];
            const float y[4] = {v[j].x * rstd * w.x, v[j].y * rstd * w.y, v[j].z * rstd * w.z, v[j].w * rstd * w.w};
            o8[64 * j] = (v2u){pk2(y[0], y[1]), pk2(y[2], y[3])};
#pragma unroll
            for (int q = 0; q < 4; ++q) {
                const int k = 256 * j + 4 * lane + q;
                const f32x4 w0 = *(const f32x4*)(p.w_in + (size_t)k * INC + 3584), w1 = *(const f32x4*)(p.w_in + (size_t)k * INC + 3588);
                g[0] += y[q] * w0.x; g[1] += y[q] * w0.y; g[2] += y[q] * w0.z; g[3] += y[q] * w0.w;
                g[4] += y[q] * w1.x; g[5] += y[q] * w1.y; g[6] += y[q] * w1.z; g[7] += y[q] * w1.w;
            }
        }
#pragma unroll
        for (int i = 0; i < 8; ++i) g[i] = wave_sum(g[i]);
        if (lane == 0) {
#pragma unroll
            for (int i = 0; i < 4; ++i) { IFG[(size_t)m * 8 + i] = g[i] + p.b_i[i]; IFG[(size_t)m * 8 + 4 + i] = g[4 + i] + p.b_f[i]; }
        }
    }
    {
        const size_t n8 = (size_t)NEXP * 1024 / 8, gt = (size_t)blockIdx.x * NTHR + threadIdx.x, NG = (size_t)gridDim.x * NTHR;
        v4u* U16 = (v4u*)(p.ws + WS_U16); v4u* V16 = (v4u*)(p.ws + WS_V16);
        for (size_t i = gt; i < n8; i += NG) {
            const f32x4 a = ((const f32x4*)p.peer_u)[2 * i], b = ((const f32x4*)p.peer_u)[2 * i + 1];
            U16[i] = (v4u){pk2(a.x, a.y), pk2(a.z, a.w), pk2(b.x, b.y), pk2(b.z, b.w)};
            const f32x4 c = ((const f32x4*)p.peer_v)[2 * i], d = ((const f32x4*)p.peer_v)[2 * i + 1];
            V16[i] = (v4u){pk2(c.x, c.y), pk2(c.z, c.w), pk2(d.x, d.y), pk2(d.z, d.w)};
        }
    }
}

__device__ __forceinline__ void mlstm_item(const P& p, LAS unsigned char* lds, int item, int tid, int wave, int lane) {
    const int bh = item >> 2, es = item & 3, b = bh >> 2, h = bh & 3, e0 = es * 32;
    LAS float* qs = (LAS float*)lds;
    LAS float* ks = qs + 64 * 132;
    LAS float* vs = ks + 64 * 132;
    LAS float* sw = vs + 64 * 33;
    LAS float* Cs = sw + 64 * 65;
    LAS float* ns = Cs + 128 * 33;
    LAS float* a_s = ns + 128;
    LAS float* M_s = a_s + 64;
    LAS float* bc_s = M_s + 64;
    LAS float* wk_s = bc_s + 64;
    LAS float* misc = wk_s + 64;
    const bf16* MLQK = (const bf16*)(p.ws + WS_MLQK); const bf16* MLV = (const bf16*)(p.ws + WS_MLV); const float* IFG = (const float*)(p.ws + WS_IFG);
    bf16* HML = (bf16*)(p.ws + WS_YML);
    for (int i = tid; i < 128 * 33; i += NTHR) Cs[i] = 0.f;
    if (tid < 128) ns[tid] = 0.f;
    if (tid == 0) misc[0] = 0.f;
    __syncthreads();
    const int e = tid & 31, g = tid >> 5;
    for (int c = 0; c < 32; ++c) {
        const int tok0 = b * S_ + c * 64;
        if (wave == 0) {
            const int tok = tok0 + lane;
            const float ip = IFG[(size_t)tok * 8 + h], fp = IFG[(size_t)tok * 8 + 4 + h];
            const float lf = fminf(fp, 0.f) - log1pf(expf(-fabsf(fp)));
            float bc = lf;
#pragma unroll
            for (int o = 1; o < 64; o <<= 1) { const float t2 = __shfl_up(bc, o); if (lane >= o) bc += t2; }
            const float a = ip - bc; float pm = a;
#pragma unroll
            for (int o = 1; o < 64; o <<= 1) { const float t2 = __shfl_up(pm, o); if (lane >= o) pm = fmaxf(pm, t2); }
            const float M = fmaxf(misc[0], pm);
            const float M63 = __shfl(M, 63);
            a_s[lane] = a; M_s[lane] = M; bc_s[lane] = bc; wk_s[lane] = expf(a - M63);
        }
        for (int idx = tid; idx < 64 * 128; idx += NTHR) {
            const int t = idx >> 7, d = idx & 127, chq = h * 128 + d, chk = 512 + h * 128 + d;
            float aq = p.conv_b[chq], ak = p.conv_b[chk];
#pragma unroll
            for (int j = 0; j < 4; ++j) {
                const int pos = c * 64 + t - 3 + j;
                if (pos >= 0) { const size_t row = (size_t)(b * S_ + pos) * 1024; aq += p.conv_w[j * 1024 + chq] * bf2f(MLQK[row + chq]); ak += p.conv_w[j * 1024 + chk] * bf2f(MLQK[row + chk]); }
            }
            qs[t * 132 + d] = aq * sigmoidf_(aq);
            ks[t * 132 + d] = ak * sigmoidf_(ak) * 0.08838834764831845f;
        }
        for (int idx = tid; idx < 64 * 32; idx += NTHR) { const int t = idx >> 5, ee = idx & 31; vs[t * 33 + ee] = bf2f(MLV[(size_t)(tok0 + t) * 512 + h * 128 + e0 + ee]); }
        __syncthreads();
        for (int idx = tid; idx < 4096; idx += NTHR) {
            const int t = idx >> 6, s = idx & 63; float val = 0.f;
            if (s <= t) { float dot = 0.f;
#pragma unroll 8
                for (int d = 0; d < 128; ++d) dot += qs[t * 132 + d] * ks[s * 132 + d];
                val = dot * expf(a_s[s] - M_s[t]); }
            sw[t * 65 + s] = val;
        }
        __syncthreads();
        const float mprev = misc[0];
#pragma unroll 1
        for (int i = 0; i < 4; ++i) {
            const int t = g * 4 + i; float qC = 0.f, qn = 0.f, sv = 0.f, ssum = 0.f;
#pragma unroll 8
            for (int d = 0; d < 128; ++d) { const float qv = qs[t * 132 + d]; qC += qv * Cs[d * 33 + e]; qn += qv * ns[d]; }
#pragma unroll 8
            for (int s = 0; s < 64; ++s) { const float w = sw[t * 65 + s]; sv += w * vs[s * 33 + e]; ssum += w; }
            const float winter = expf(mprev - M_s[t]);
            const float num = sv + winter * qC, den = ssum + winter * qn;
            const float hv = num / fmaxf(fabsf(den), expf(-(bc_s[t] + M_s[t])));
            HML[(size_t)(tok0 + t) * 512 + h * 128 + e0 + e] = (bf16)f2bf(hv);
        }
        __syncthreads();
        {
            const float decay = expf(mprev - M_s[63]);
#pragma unroll 1
            for (int i = 0; i < 8; ++i) { const int d = g * 8 + i; float acc = 0.f;
#pragma unroll 8
                for (int s = 0; s < 64; ++s) acc += wk_s[s] * ks[s * 132 + d] * vs[s * 33 + e];
                Cs[d * 33 + e] = decay * Cs[d * 33 + e] + acc; }
            if (tid < 128) { float acc = 0.f;
#pragma unroll 8
                for (int s = 0; s < 64; ++s) acc += wk_s[s] * ks[s * 132 + tid];
                ns[tid] = decay * ns[tid] + acc; }
        }
        __syncthreads();
        if (tid == 0) misc[0] = bc_s[63] + M_s[63];
    }
    __syncthreads();
}

__device__ __forceinline__ void sba_item(const P& p, int item, int tid, int wave) {
    const int bh = item >> 2, qb = item & 3, b = bh >> 3, h = bh & 7;
    const bf16* QKV = (const bf16*)(p.ws + WS_SBQKV); bf16* YSB = (bf16*)(p.ws + WS_YSB);
    const int t = qb * 512 + tid; const size_t tok = (size_t)b * S_ + t;
    float q[64], acc[64];
    {
        const v4u* qp = (const v4u*)(QKV + tok * 1536 + h * 64);
#pragma unroll
        for (int j = 0; j < 8; ++j) { float f[8]; unpack8(qp[j], f);
#pragma unroll
            for (int i = 0; i < 8; ++i) { q[8 * j + i] = f[i]; acc[8 * j + i] = 0.f; } }
    }
    float suffix = 0.f;
    const int tmax = qb * 512 + wave * 64 + 63;
    for (int s = tmax - 1; s >= 0; --s) {
        const v4u* kp = (const v4u*)(QKV + ((size_t)b * S_ + s) * 1536 + 512 + h * 64);
        float dot = 0.f;
#pragma unroll
        for (int j = 0; j < 8; ++j) { float f[8]; unpack8(kp[j], f);
#pragma unroll
            for (int i = 0; i < 8; ++i) dot += q[8 * j + i] * f[i]; }
        const float z = dot * 0.125f;
        const float sp = fmaxf(z, 0.f) + log1pf(expf(-fabsf(z)));
        const bool active = s < t;
        const float w = active ? expf(z - sp - suffix) : 0.f;
        suffix += active ? sp : 0.f;
        const v4u* vp = kp + 64;
#pragma unroll
        for (int j = 0; j < 8; ++j) { float f[8]; unpack8(vp[j], f);
#pragma unroll
            for (int i = 0; i < 8; ++i) acc[8 * j + i] += w * f[i]; }
        if (__all(suffix > 104.f)) break;
    }
    v4u* op = (v4u*)(YSB + tok * 512 + h * 64);
#pragma unroll
    for (int j = 0; j < 8; ++j) { float f[8];
#pragma unroll
        for (int i = 0; i < 8; ++i) f[i] = acc[8 * j + i];
        op[j] = pack8(f); }
}

__device__ __forceinline__ void p3_yml(const P& p, int wave, int lane) {
    const int gw = blockIdx.x * NWAVES + wave, NGW = gridDim.x * NWAVES;
    bf16* YML = (bf16*)(p.ws + WS_YML); const bf16* MLO = (const bf16*)(p.ws + WS_MLO);
    for (int m = gw; m < T_; m += NGW) {
        float hv[8], ov[8], o[8];
        unpack8(*(const v4u*)(YML + (size_t)m * 512 + lane * 8), hv); unpack8(*(const v4u*)(MLO + (size_t)m * 512 + lane * 8), ov);
        float ss = 0.f;
#pragma unroll
        for (int i = 0; i < 8; ++i) ss += hv[i] * hv[i];
        ss += __shfl_xor(ss, 1); ss += __shfl_xor(ss, 2); ss += __shfl_xor(ss, 4); ss += __shfl_xor(ss, 8);
        const float rstd = 1.f / sqrtf(ss * (1.f / 128.f) + EPS);
        const f32x4 w0 = *(const f32x4*)(p.ml_norm_w + lane * 8), w1 = *(const f32x4*)(p.ml_norm_w + lane * 8 + 4);
        const float wv[8] = {w0.x, w0.y, w0.z, w0.w, w1.x, w1.y, w1.z, w1.w};
#pragma unroll
        for (int i = 0; i < 8; ++i) o[i] = sigmoidf_(ov[i]) * hv[i] * rstd * wv[i];
        *(v4u*)(YML + (size_t)m * 512 + lane * 8) = pack8(o);
    }
}

__device__ __forceinline__ void p6_hn(const P& p, int wave, int lane) {
    const int gw = blockIdx.x * NWAVES + wave, NGW = gridDim.x * NWAVES;
    const float* H = (const float*)(p.ws + WS_H); bf16* HN = (bf16*)(p.ws + WS_HN);
    for (int m = gw; m < T_; m += NGW) {
        const f32x4* xr = (const f32x4*)(H + (size_t)m * 1024) + lane; const f32x4* wr = (const f32x4*)p.norm_ffn_w + lane;
        f32x4 v[4]; float ss = 0.f;
#pragma unroll
        for (int j = 0; j < 4; ++j) { v[j] = xr[64 * j]; ss += (v[j].x * v[j].x + v[j].y * v[j].y) + (v[j].z * v[j].z + v[j].w * v[j].w); }
        const float rstd = 1.f / sqrtf(wave_sum(ss) * (1.f / 1024.f) + EPS);
        v2u* o8 = (v2u*)(HN + (size_t)m * 1024) + lane;
#pragma unroll
        for (int j = 0; j < 4; ++j) { const f32x4 w = wr[64 * j]; o8[64 * j] = (v2u){pk2(v[j].x * rstd * w.x, v[j].y * rstd * w.y), pk2(v[j].z * rstd * w.z, v[j].w * rstd * w.w)}; }
    }
}

__device__ __forceinline__ unsigned ord_key(float f) { const unsigned u = __builtin_bit_cast(unsigned, f); return (u & 0x80000000u) ? ~u : (u | 0x80000000u); }
__device__ __forceinline__ float ord_val(unsigned k) { const unsigned u = (k & 0x80000000u) ? (k & 0x7fffffffu) : ~k; return __builtin_bit_cast(float, u); }
__device__ __forceinline__ void p8_topk(const P& p, int hh, int wave, int lane) {
    const int gw = blockIdx.x * NWAVES + wave, NGW = gridDim.x * NWAVES;
    const float* SC = (const float*)(p.ws + WS_SC); int* IDX = (int*)(p.ws + WS_IDX); float* GATE = (float*)(p.ws + WS_GATE);
    for (int it = gw; it < T_ * 4; it += NGW) {
        const int m = it >> 2, hl = it & 3, head = hh * 4 + hl;
        const float* sr = SC + (size_t)m * 1024 + hl * 256;
        unsigned mine[2];
#pragma unroll
        for (int half = 0; half < 2; ++half) {
            unsigned ka = (ord_key(sr[half * 128 + lane]) & ~0x7fu) | (unsigned)(127 - lane);
            unsigned kb = (ord_key(sr[half * 128 + 64 + lane]) & ~0x7fu) | (unsigned)(127 - (64 + lane));
            unsigned mk = 0u;
#pragma unroll 1
            for (int k = 0; k < 16; ++k) {
                const unsigned mx = wave_max_u(ka > kb ? ka : kb);
                if (ka == mx) ka = 0u; if (kb == mx) kb = 0u;
                if (lane == k) mk = mx;
            }
            mine[half] = mk;
        }
        unsigned ck[4];
#pragma unroll
        for (int j = 0; j < 4; ++j) {
            const int c = lane + 64 * j, a = c >> 4, bb = c & 15;
            const float v1 = ord_val((unsigned)__shfl((int)mine[0], a) & ~0x7fu), v2 = ord_val((unsigned)__shfl((int)mine[1], bb) & ~0x7fu);
            ck[j] = (ord_key(v1 + v2) & ~0xffu) | (unsigned)(255 - c);
        }
        unsigned tk = 0u;
#pragma unroll 1
        for (int k = 0; k < 16; ++k) {
            unsigned mx = ck[0] > ck[1] ? ck[0] : ck[1]; const unsigned m2 = ck[2] > ck[3] ? ck[2] : ck[3]; mx = mx > m2 ? mx : m2;
            mx = wave_max_u(mx);
#pragma unroll
            for (int j = 0; j < 4; ++j) if (ck[j] == mx) ck[j] = 0u;
            if (lane == k) tk = mx;
        }
        const float sv = ord_val(tk & ~0xffu);
        const int c = 255 - (int)(tk & 0xffu), a = (c >> 4) & 15, bb = c & 15;
        const int i1 = 127 - (int)((unsigned)__shfl((int)mine[0], a) & 0x7fu), i2 = 127 - (int)((unsigned)__shfl((int)mine[1], bb) & 0x7fu);
        const float s0 = __shfl(sv, 0);
        const float pe = lane < 16 ? expf(sv - s0) : 0.f;
        const float den = wave_sum(pe);
        if (lane < 16) { IDX[(size_t)m * 128 + head * 16 + lane] = i1 * 128 + i2; GATE[(size_t)m * 128 + head * 16 + lane] = pe / den; }
    }
}

__device__ __forceinline__ float gelu_erf(float x) { return 0.5f * x * (1.f + erff(x * 0.70710678118654752f)); }
__device__ __forceinline__ void p9_peer(const P& p, int wave, int lane) {
    const int gw = blockIdx.x * NWAVES + wave, NGW = gridDim.x * NWAVES;
    const float* H = (const float*)(p.ws + WS_H); const bf16* HN = (const bf16*)(p.ws + WS_HN);
    const int* IDX = (const int*)(p.ws + WS_IDX); const float* GATE = (const float*)(p.ws + WS_GATE);
    const bf16* U16 = (const bf16*)(p.ws + WS_U16); const bf16* V16 = (const bf16*)(p.ws + WS_V16);
    for (int m = gw; m < T_; m += NGW) {
        float xv[16], acc[16];
        { float f[8]; unpack8(*(const v4u*)(HN + (size_t)m * 1024 + lane * 8), f);
#pragma unroll
          for (int i = 0; i < 8; ++i) xv[i] = f[i];
          unpack8(*(const v4u*)(HN + (size_t)m * 1024 + 512 + lane * 8), f);
#pragma unroll
          for (int i = 0; i < 8; ++i) xv[8 + i] = f[i]; }
#pragma unroll
        for (int i = 0; i < 16; ++i) acc[i] = 0.f;
        const int myidx0 = IDX[(size_t)m * 128 + lane], myidx1 = IDX[(size_t)m * 128 + 64 + lane];
        const float myg0 = GATE[(size_t)m * 128 + lane], myg1 = GATE[(size_t)m * 128 + 64 + lane];
#pragma unroll 1
        for (int j0 = 0; j0 < 128; j0 += 4) {
            float dots[4]; int ei[4]; float gi[4];
#pragma unroll
            for (int u = 0; u < 4; ++u) {
                const int j = j0 + u;
                ei[u] = __shfl(j < 64 ? myidx0 : myidx1, j & 63); gi[u] = __shfl(j < 64 ? myg0 : myg1, j & 63);
                float f[8], d = 0.f;
                unpack8(*(const v4u*)(U16 + (size_t)ei[u] * 1024 + lane * 8), f);
#pragma unroll
                for (int i = 0; i < 8; ++i) d += f[i] * xv[i];
                unpack8(*(const v4u*)(U16 + (size_t)ei[u] * 1024 + 512 + lane * 8), f);
#pragma unroll
                for (int i = 0; i < 8; ++i) d += f[i] * xv[8 + i];
                dots[u] = d;
            }
#pragma unroll
            for (int u = 0; u < 4; ++u) dots[u] = wave_sum(dots[u]);
#pragma unroll
            for (int u = 0; u < 4; ++u) {
                const float coef = gi[u] * gelu_erf(dots[u]);
                float f[8];
                unpack8(*(const v4u*)(V16 + (size_t)ei[u] * 1024 + lane * 8), f);
#pragma unroll
                for (int i = 0; i < 8; ++i) acc[i] += coef * f[i];
                unpack8(*(const v4u*)(V16 + (size_t)ei[u] * 1024 + 512 + lane * 8), f);
#pragma unroll
                for (int i = 0; i < 8; ++i) acc[8 + i] += coef * f[i];
            }
        }
        float y[16], ss = 0.f;
#pragma unroll
        for (int hb = 0; hb < 2; ++hb) {
            const f32x4 h0 = *(const f32x4*)(H + (size_t)m * 1024 + hb * 512 + lane * 8), h1 = *(const f32x4*)(H + (size_t)m * 1024 + hb * 512 + lane * 8 + 4);
            y[hb * 8 + 0] = h0.x + acc[hb * 8 + 0]; y[hb * 8 + 1] = h0.y + acc[hb * 8 + 1]; y[hb * 8 + 2] = h0.z + acc[hb * 8 + 2]; y[hb * 8 + 3] = h0.w + acc[hb * 8 + 3];
            y[hb * 8 + 4] = h1.x + acc[hb * 8 + 4]; y[hb * 8 + 5] = h1.y + acc[hb * 8 + 5]; y[hb * 8 + 6] = h1.z + acc[hb * 8 + 6]; y[hb * 8 + 7] = h1.w + acc[hb * 8 + 7];
        }
#pragma unroll
        for (int i = 0; i < 16; ++i) ss += y[i] * y[i];
        const float rstd = 1.f / sqrtf(wave_sum(ss) * (1.f / 1024.f) + EPS);
#pragma unroll
        for (int hb = 0; hb < 2; ++hb) {
            const f32x4 w0 = *(const f32x4*)(p.norm_final_w + hb * 512 + lane * 8), w1 = *(const f32x4*)(p.norm_final_w + hb * 512 + lane * 8 + 4);
            *(f32x4*)(p.out + (size_t)m * 1024 + hb * 512 + lane * 8) = (f32x4){y[hb * 8 + 0] * rstd * w0.x, y[hb * 8 + 1] * rstd * w0.y, y[hb * 8 + 2] * rstd * w0.z, y[hb * 8 + 3] * rstd * w0.w};
            *(f32x4*)(p.out + (size_t)m * 1024 + hb * 512 + lane * 8 + 4) = (f32x4){y[hb * 8 + 4] * rstd * w1.x, y[hb * 8 + 5] * rstd * w1.y, y[hb * 8 + 6] * rstd * w1.z, y[hb * 8 + 7] * rstd * w1.w};
        }
    }
}

constexpr int N_PHASES = 12;
struct Args { P p; int ph_lo, ph_hi; };
__global__ void __launch_bounds__(NTHR, 2) fwd_kernel(Args args) {
    extern __shared__ __attribute__((aligned(16))) unsigned char lds_raw[];
    LAS unsigned char* lds = (LAS unsigned char*)lds_raw;
    const P& p = args.p;
    const int tid = threadIdx.x, lane = tid & 63, wave = __builtin_amdgcn_readfirstlane(tid >> 6);
    volatile LAS unsigned* MISC = (volatile LAS unsigned*)(lds + MISC_OFF);
    for (int u = tid; u < (LDS_BYTES - LDSCTL_OFF) / 4; u += NTHR) ((LAS unsigned*)(lds + LDSCTL_OFF))[u] = 0u;
    __syncthreads();
    XcdBarrier bar; bar.bar = (unsigned*)(p.ws + WS_CTL) + CW_BAR; bar.x = 0; bar.st = nullptr;
#if !MK_PER_PHASE
    bar = xcd_barrier_post((unsigned*)(p.ws + WS_CTL) + CW_BAR, MISC + 8);
#endif
    const int lo = args.ph_lo, hi = args.ph_hi;
#define IN(k) (lo <= (k) && (k) < hi)
#define SEAM(k) do { if (IN(k) && IN((k) + 1)) xcd_barrier(bar); } while (0)

    if (IN(0)) { p0_prologue(p, lds, wave, lane); } SEAM(0);
    if (IN(1)) {
        EpiProj e{(bf16*)(p.ws + WS_SBQKV), (bf16*)(p.ws + WS_MLQK), (bf16*)(p.ws + WS_MLV), (bf16*)(p.ws + WS_MLO), (bf16*)(p.ws + WS_GATES)};
        gemm<EpiProj>(lds, (const bf16*)(p.ws + WS_XN), (const bf16*)(p.ws + WS_W1T), T_, NPROJ, 1024, e);
    } SEAM(1);
    if (IN(2)) {
        for (int it = blockIdx.x; it < 256; it += gridDim.x) mlstm_item(p, lds, it, tid, wave, lane);
        for (int it = blockIdx.x; it < 512; it += gridDim.x) sba_item(p, it, tid, wave);
    } SEAM(2);
    if (IN(3)) { p3_yml(p, wave, lane); } SEAM(3);
    if (IN(4)) {
        EpiMergeA ea{(bf16*)(p.ws + WS_MERGED), (const bf16*)(p.ws + WS_GATES)};
        gemm<EpiMergeA>(lds, (const bf16*)(p.ws + WS_YSB), (const bf16*)(p.ws + WS_WSBT), T_, 1024, 512, ea);
        VM_WAIT(); __syncthreads();
        EpiMergeB eb{(bf16*)(p.ws + WS_MERGED), (const bf16*)(p.ws + WS_GATES)};
        gemm<EpiMergeB>(lds, (const bf16*)(p.ws + WS_YML), (const bf16*)(p.ws + WS_WMLT), T_, 1024, 512, eb);
    } SEAM(4);
    if (IN(5)) {
        EpiH e{(float*)(p.ws + WS_H), p.x};
        gemm<EpiH>(lds, (const bf16*)(p.ws + WS_MERGED), (const bf16*)(p.ws + WS_WOUTT), T_, 1024, 1024, e);
    } SEAM(5);
    if (IN(6)) { p6_hn(p, wave, lane); } SEAM(6);
    if (IN(7)) { EpiF32 e{(float*)(p.ws + WS_SC), 1024}; gemm<EpiF32>(lds, (const bf16*)(p.ws + WS_HN), (const bf16*)(p.ws + WS_WCT), T_, 1024, 1024, e); } SEAM(7);
    if (IN(8)) { p8_topk(p, 0, wave, lane); } SEAM(8);
    if (IN(9)) { EpiF32 e{(float*)(p.ws + WS_SC), 1024}; gemm<EpiF32>(lds, (const bf16*)(p.ws + WS_HN), (const bf16*)(p.ws + WS_WCT) + (size_t)1024 * 1024, T_, 1024, 1024, e); } SEAM(9);
    if (IN(10)) { p8_topk(p, 1, wave, lane); } SEAM(10);
    if (IN(11)) { p9_peer(p, wave, lane); }
#undef IN
#undef SEAM
}

extern "C" void kernel_launch(void* const* d_in, const int* in_sizes, int n_in, void* d_out, int out_size, void* d_ws, size_t ws_size, hipStream_t stream) {
    static int grid = 0;
    if (grid == 0) {
        if (n_in != 18 || in_sizes[0] != T_ * D_ || out_size != T_ * D_ || ws_size < WS_END) {
            fprintf(stderr, "kernel_launch: unexpected problem (n_in %d, in0 %d, out %d, ws %zu); nothing launched\n", n_in, n_in > 0 ? in_sizes[0] : -1, out_size, ws_size); grid = -1; return; }
        int dev = 0, cus = 0, per_cu = 0;
        if (hipGetDevice(&dev) != hipSuccess || hipDeviceGetAttribute(&cus, hipDeviceAttributeMultiprocessorCount, dev) != hipSuccess) { grid = -1; return; }
        if (hipFuncSetAttribute((const void*)fwd_kernel, hipFuncAttributeMaxDynamicSharedMemorySize, LDS_BYTES) != hipSuccess) { fprintf(stderr, "kernel_launch: hipFuncSetAttribute failed\n"); grid = -1; return; }
        if (hipOccupancyMaxActiveBlocksPerMultiprocessor(&per_cu, (const void*)fwd_kernel, NTHR, LDS_BYTES) != hipSuccess || per_cu < 1)
            fprintf(stderr, "kernel_launch: note: occupancy query reports %d workgroups per CU\n", per_cu);
        (void)hipGetLastError();
        grid = cus;
    }
    if (grid < 0) return;
    if (hipMemsetAsync((char*)d_ws + WS_CTL, 0, CTL_ZERO_BYTES, stream) != hipSuccess) { fprintf(stderr, "kernel_launch: memset failed\n"); return; }
    Args a{};
    const float** pp = (const float**)&a.p;
    for (int i = 0; i < 18; ++i) pp[i] = (const float*)d_in[i];
    a.p.out = (float*)d_out; a.p.ws = (unsigned char*)d_ws;
#if MK_PER_PHASE
    for (int ph = 0; ph < N_PHASES; ++ph) {
        a.ph_lo = ph; a.ph_hi = ph + 1;
        hipLaunchKernelGGL(fwd_kernel, dim3(grid), dim3(NTHR), LDS_BYTES, stream, a);
    }
#else
    a.ph_lo = 0; a.ph_hi = N_PHASES;
    hipLaunchKernelGGL(fwd_kernel, dim3(grid), dim3(NTHR), LDS_BYTES, stream, a);
#endif
    const hipError_t le = hipPeekAtLastError();
    if (le != hipSuccess) fprintf(stderr, "kernel_launch: launch failed: %s\n", hipGetErrorName(le));
}
```

```cpp
#include <hip/hip_runtime.h>
#include <cstdio>
#include <cstdint>
namespace pg8 {
#define PG8_LAS __attribute__((address_space(3)))
typedef unsigned short bf16_t;
typedef short bf16x8 __attribute__((ext_vector_type(8)));
typedef float f32x4 __attribute__((ext_vector_type(4)));
typedef unsigned u32x4 __attribute__((ext_vector_type(4)));
constexpr int BM = 256, BK = 64, HALF = 128, HTB = HALF * BK * 2  , STAGE_BYTES = 8 * HTB, NXCD = 8, WGM = 8;

__host__ __device__ __forceinline__ int lds_byte(int r, int c) { const int st = (r >> 4) * 2 + (c >> 5), rr = r & 15, cc = c & 31, ob = rr * 64 + cc * 2; return st * 1024 + (ob ^ (((ob >> 9) & 1) << 5)); }
__host__ __device__ __forceinline__ void stage_rc(int b, int& R, int& C) { const int st = b / 1024, sb = b % 1024, swz = sb ^ (((sb >> 9) & 1) << 5); R = (st >> 1) * 16 + swz / 64; C = (st & 1) * 32 + (swz % 64) / 2; }
__host__ __device__ __forceinline__ int perm32(int rho) { const int n = rho >> 4, i = rho & 15; return 8 * (i >> 2) + 4 * n + (i & 3); }

struct Unit { int pm, pn; };
struct Gemm { const bf16_t* A; const bf16_t* Bt; int M, N, K; };

struct StaticOrder {
    int nM, nN, nwg, G, c;
    __host__ __device__ void init(int M, int N, int G_, int c_) { nM = M / BM; nN = N / BM; nwg = nM * nN; G = G_; c = c_; }
    __host__ __device__ bool next(int i, Unit& u) const {
        const long L = (long)i * G + c; if (L >= nwg) return false;
        int wgid = (int)L; { const int q = nwg / NXCD, r = nwg % NXCD, xcd = wgid % NXCD, off = wgid / NXCD; wgid = (xcd < r ? xcd * (q + 1) : r * (q + 1) + (xcd - r) * q) + off; }
        const int nig = WGM * nN, gid = wgid / nig, fm = gid * WGM, gsz = (nM - fm) < WGM ? (nM - fm) : WGM;
        u.pm = fm + ((wgid % nig) % gsz); u.pn = (wgid % nig) / gsz; return true;
    }
    __device__ __forceinline__ void a_ready(const Unit&) const {}
    __device__ __forceinline__ void done(const Unit&) const {}
};

__device__ __forceinline__ unsigned cvt_pk_bf16(float lo, float hi) { unsigned r; asm volatile("v_cvt_pk_bf16_f32 %0, %1, %2" : "=v"(r) : "v"(lo), "v"(hi)); return r; }
template <class Epi, class Sched, bool ALIGN_EPI = false, bool SP2 = false>
__device__ __forceinline__ void gemm_phase(PG8_LAS unsigned char* lds, const Gemm g, const Sched& S, const Epi& E) {
    const int tid = threadIdx.x, wid = __builtin_amdgcn_readfirstlane(tid >> 6), lane = tid & 63, wr = wid >> 2, wc = wid & 3, fr = lane & 15, fq = lane >> 4;
    const int K = g.K, nt = K / BK;
    unsigned voffA[2], voffB[2];
#pragma unroll
    for (int i = 0; i < 2; ++i) { int R, C; stage_rc(tid * 16 + i * 8192, R, C); const int Rb = Epi::PERM ? ((R & ~31) + perm32(R & 31)) : R;
        voffA[i] = (unsigned)(R * K + C) * 2u; voffB[i] = (unsigned)(Rb * K + C) * 2u; }
    const size_t kstep = (size_t)(BK * 2);
    const size_t hstep = (size_t)HALF * K * 2;
    const size_t tstep = 2 * hstep;
    const unsigned ldsw = (unsigned)wid * 1024u;
    const int aoff = lds_byte(wr * 64 + fr, fq * 8), boff = lds_byte(wc * 32 + fr, fq * 8);
#define PG8_SA(b, h) (((b) * 2 + (h)) * HTB)
#define PG8_SB(b, h) ((4 + (b) * 2 + (h)) * HTB)
#define PG8_STAGE(bufoff, gbase, voff) do { _Pragma("unroll") for (int _i = 0; _i < 2; ++_i) \
        __builtin_amdgcn_global_load_lds((const unsigned*)((const char*)(gbase) + (voff)[_i]), (PG8_LAS unsigned*)(lds + (bufoff) + ldsw + _i * 8192), 16, 0, 0); } while (0)
#define PG8_LDA(dst, b, h) do { _Pragma("unroll") for (int m = 0; m < 4; ++m) _Pragma("unroll") for (int k = 0; k < 2; ++k) dst[m][k] = *(const PG8_LAS bf16x8*)(lds + PG8_SA(b, h) + aoff + m * 2048 + k * 1024); } while (0)
#define PG8_LDB(dst, b, h) do { _Pragma("unroll") for (int n = 0; n < 2; ++n) _Pragma("unroll") for (int k = 0; k < 2; ++k) dst[n][k] = *(const PG8_LAS bf16x8*)(lds + PG8_SB(b, h) + boff + n * 2048 + k * 1024); } while (0)
#define PG8_MMA(ai, bj, At, Bt) do { __builtin_amdgcn_s_setprio(1); _Pragma("unroll") for (int m = 0; m < 4; ++m) _Pragma("unroll") for (int n = 0; n < 2; ++n) _Pragma("unroll") for (int k = 0; k < 2; ++k) \
        acc[ai][bj][m][n] = __builtin_amdgcn_mfma_f32_16x16x32_bf16(Bt[n][k], At[m][k], acc[ai][bj][m][n], 0, 0, 0); __builtin_amdgcn_s_setprio(0); } while (0)
#define PG8_WAIT_V(n) asm volatile("s_waitcnt vmcnt(" #n ")" ::: "memory")
#define PG8_WAIT_L(n) asm volatile("s_waitcnt lgkmcnt(" #n ")" ::: "memory")
#define PG8_BAR __builtin_amdgcn_s_barrier()
#define PG8_SCHED __builtin_amdgcn_sched_barrier(0)
    Unit cur, nxt; int ui = 0;
    if (!S.next(0, cur)) return;
    f32x4 acc[2][2][4][2];
#pragma unroll
    for (int a = 0; a < 2; ++a)
#pragma unroll
        for (int b = 0; b < 2; ++b)
#pragma unroll
            for (int m = 0; m < 4; ++m)
#pragma unroll
                for (int n = 0; n < 2; ++n) acc[a][b][m][n] = (f32x4){0.f, 0.f, 0.f, 0.f};
    bf16x8 At[4][2], B0[2][2], B1[2][2];
    const char* cA = (const char*)g.A + (size_t)cur.pm * tstep; const char* cB = (const char*)g.Bt + (size_t)cur.pn * tstep;
    S.a_ready(cur);
    if constexpr (SP2) {
        PG8_STAGE(PG8_SB(0, 0), cB, voffB); PG8_STAGE(PG8_SB(0, 1), cB + hstep, voffB); PG8_STAGE(PG8_SA(0, 0), cA, voffA); PG8_STAGE(PG8_SA(0, 1), cA + hstep, voffA);
        if (wr == 1) PG8_BAR;
        PG8_WAIT_V(2); PG8_BAR;
        PG8_STAGE(PG8_SB(1, 0), cB + kstep, voffB); PG8_STAGE(PG8_SA(1, 0), cA + kstep, voffA); PG8_STAGE(PG8_SB(1, 1), cB + hstep + kstep, voffB);
        PG8_WAIT_V(6); PG8_BAR;
    } else {
        PG8_STAGE(PG8_SB(0, 0), cB, voffB); PG8_STAGE(PG8_SA(0, 0), cA, voffA); PG8_STAGE(PG8_SB(0, 1), cB + hstep, voffB); PG8_STAGE(PG8_SA(0, 1), cA + hstep, voffA);
        if (wr == 1) PG8_BAR;
        PG8_WAIT_V(4); PG8_BAR;
        PG8_STAGE(PG8_SB(1, 0), cB + kstep, voffB); PG8_STAGE(PG8_SA(1, 0), cA + kstep, voffA); PG8_STAGE(PG8_SB(1, 1), cB + hstep + kstep, voffB);
        PG8_WAIT_V(6); PG8_BAR;
    }
    for (;;) {
        const bool has_next = S.next(ui + 1, nxt);
        const char* nA = has_next ? (const char*)g.A + (size_t)nxt.pm * tstep : cA; const char* nB = has_next ? (const char*)g.Bt + (size_t)nxt.pn * tstep : cB;
        for (int t = 0; t < nt; t += 2) {
            const bool last = (t == nt - 2);
            const char* a1 = cA + (size_t)(t + 1) * kstep;
            const char* a2 = last ? nA : cA + (size_t)(t + 2) * kstep; const char* b2 = last ? nB : cB + (size_t)(t + 2) * kstep;
            const char* a3 = a2 + kstep; const char* b3 = b2 + kstep;
            if (last && has_next) S.a_ready(nxt);
            if constexpr (SP2) {
            PG8_LDB(B0, 0, 0); PG8_LDB(B1, 0, 1); PG8_SCHED; PG8_LDA(At, 0, 0); PG8_STAGE(PG8_SA(1, 1), a1 + hstep, voffA);
            PG8_WAIT_V(8); PG8_WAIT_L(0); PG8_BAR; PG8_MMA(0, 0, At, B0); PG8_MMA(0, 1, At, B1); PG8_BAR; PG8_SCHED;
            PG8_LDA(At, 0, 1); PG8_STAGE(PG8_SB(0, 0), b2, voffB); PG8_STAGE(PG8_SB(0, 1), b2 + hstep, voffB); PG8_STAGE(PG8_SA(0, 0), a2, voffA);
            PG8_WAIT_V(8); PG8_WAIT_L(0); PG8_BAR; PG8_MMA(1, 0, At, B0); PG8_MMA(1, 1, At, B1); PG8_BAR; PG8_SCHED;
            PG8_LDB(B0, 1, 0); PG8_LDB(B1, 1, 1); PG8_SCHED; PG8_LDA(At, 1, 0); PG8_STAGE(PG8_SA(0, 1), a2 + hstep, voffA);
            PG8_WAIT_V(8); PG8_WAIT_L(0); PG8_BAR; PG8_MMA(0, 0, At, B0); PG8_MMA(0, 1, At, B1); PG8_BAR; PG8_SCHED;
            PG8_LDA(At, 1, 1); PG8_STAGE(PG8_SB(1, 0), b3, voffB); PG8_STAGE(PG8_SB(1, 1), b3 + hstep, voffB); PG8_STAGE(PG8_SA(1, 0), a3, voffA);
            PG8_WAIT_V(8); PG8_WAIT_L(0); PG8_BAR; PG8_MMA(1, 0, At, B0); PG8_MMA(1, 1, At, B1); PG8_BAR; PG8_SCHED;
            } else {
            PG8_LDB(B0, 0, 0); PG8_SCHED; PG8_LDA(At, 0, 0); PG8_STAGE(PG8_SA(1, 1), a1 + hstep, voffA);
            PG8_WAIT_L(8); PG8_BAR; PG8_WAIT_L(0); PG8_MMA(0, 0, At, B0); PG8_BAR; PG8_SCHED;
            PG8_LDB(B1, 0, 1); PG8_STAGE(PG8_SB(0, 0), b2, voffB);
            PG8_BAR; PG8_WAIT_L(0); PG8_MMA(0, 1, At, B1); PG8_BAR;
            PG8_LDA(At, 0, 1); PG8_STAGE(PG8_SA(0, 0), a2, voffA);
            PG8_BAR; PG8_WAIT_L(0); PG8_MMA(1, 0, At, B0); PG8_BAR; PG8_SCHED;
            PG8_STAGE(PG8_SB(0, 1), b2 + hstep, voffB);
            PG8_WAIT_V(6); PG8_BAR; PG8_MMA(1, 1, At, B1); PG8_BAR;
            PG8_LDB(B0, 1, 0); PG8_SCHED; PG8_LDA(At, 1, 0); PG8_STAGE(PG8_SA(0, 1), a2 + hstep, voffA);
            PG8_WAIT_L(8); PG8_BAR; PG8_WAIT_L(0); PG8_MMA(0, 0, At, B0); PG8_BAR; PG8_SCHED;
            PG8_LDB(B1, 1, 1); PG8_STAGE(PG8_SB(1, 0), b3, voffB);
            PG8_BAR; PG8_WAIT_L(0); PG8_MMA(0, 1, At, B1); PG8_BAR;
            PG8_LDA(At, 1, 1); PG8_STAGE(PG8_SA(1, 0), a3, voffA);
            PG8_BAR; PG8_WAIT_L(0); PG8_MMA(1, 0, At, B0); PG8_BAR; PG8_SCHED;
            PG8_STAGE(PG8_SB(1, 1), b3 + hstep, voffB);
            PG8_WAIT_V(6); PG8_BAR; PG8_MMA(1, 1, At, B1); PG8_BAR;
            }
        }
        if constexpr (ALIGN_EPI) { if (wr == 0) PG8_BAR; }
        if constexpr (!Epi::AFTER_DRAIN) { E(acc, cur, wr, wc, fr, fq); S.done(cur); }
        if (!has_next) break;
#pragma unroll
        for (int a = 0; a < 2; ++a)
#pragma unroll
            for (int b = 0; b < 2; ++b)
#pragma unroll
                for (int m = 0; m < 4; ++m)
#pragma unroll
                    for (int n = 0; n < 2; ++n) acc[a][b][m][n] = (f32x4){0.f, 0.f, 0.f, 0.f};
        cur = nxt; cA = nA; cB = nB; ++ui;
        if constexpr (ALIGN_EPI) { if (wr == 1) PG8_BAR; }
    }
    PG8_WAIT_V(0);
    if constexpr (!ALIGN_EPI) { if (wr == 0) PG8_BAR; }
    PG8_BAR;
    if constexpr (Epi::AFTER_DRAIN) { E.fused(acc, cur, wr, wc, fr, fq, lds, wid, lane); S.done(cur); }
#undef PG8_SA
#undef PG8_SB
#undef PG8_STAGE
#undef PG8_LDA
#undef PG8_LDB
#undef PG8_MMA
#undef PG8_WAIT_V
#undef PG8_WAIT_L
#undef PG8_BAR
#undef PG8_SCHED
}
}

#ifndef MK_PER_PHASE
#define MK_PER_PHASE 0
#endif
#ifndef USE_PG8
#define USE_PG8 1
#endif
constexpr int NWAVES = 8, NTHR = 512;

constexpr int B_ = 16, S_ = 2048, D_ = 1024, T_ = B_ * S_;
constexpr int INC = 5640, NPROJ = 5632;
constexpr int NEXP = 16384;
constexpr float EPS = 1e-6f;

constexpr size_t MiB = 1u << 20;
constexpr size_t WS_CTL = 0, CTL_ZERO_BYTES = 1 * MiB;
constexpr size_t WS_W1T = 2 * MiB, WS_WSBT = 13 * MiB, WS_WMLT = 14 * MiB, WS_WOUTT = 15 * MiB, WS_WCT = 17 * MiB, WS_IFG = 21 * MiB;
constexpr size_t WS_U16 = 24 * MiB, WS_V16 = 56 * MiB;
constexpr size_t WS_XN = 88 * MiB, WS_YSB = 88 * MiB, WS_YML = 120 * MiB;
constexpr size_t WS_SBQKV = 152 * MiB  , WS_VT = 216 * MiB  , WS_MLQK = 248 * MiB, WS_MLV = 312 * MiB, WS_MLO = 344 * MiB, WS_GATES = 376 * MiB;
constexpr size_t WS_MERGED = 216 * MiB, WS_H = 88 * MiB, WS_HN = 216 * MiB, WS_IDX = 280 * MiB, WS_GATE = 296 * MiB, WS_SC = 312 * MiB;
constexpr size_t WS_END = 504 * MiB;
constexpr int CW_BAR = 4096, CW_Q = 8192;

constexpr int RING_OFF = 0, RING_BYTES = 131072;
constexpr int LDSCTL_OFF = RING_BYTES, MISC_OFF = LDSCTL_OFF + 320;
constexpr int LDS_BYTES = 147456;

#define GAS __attribute__((address_space(1)))
#define LAS __attribute__((address_space(3)))
typedef unsigned short bf16;
typedef unsigned v4u __attribute__((ext_vector_type(4)));
typedef unsigned v2u __attribute__((ext_vector_type(2)));
typedef float f32x4 __attribute__((ext_vector_type(4)));
#define LDS_WAIT() asm volatile("s_waitcnt lgkmcnt(0)" ::: "memory")
#define VM_WAIT() asm volatile("s_waitcnt vmcnt(0)" ::: "memory")
__device__ __forceinline__ unsigned f2bf(float f) { unsigned u = __builtin_bit_cast(unsigned, f); return (u + 0x7fffu + ((u >> 16) & 1u)) >> 16; }
__device__ __forceinline__ unsigned pk2(float lo, float hi) { return f2bf(lo) | (f2bf(hi) << 16); }
__device__ __forceinline__ float bflo(unsigned u) { return __builtin_bit_cast(float, u << 16); }
__device__ __forceinline__ float bfhi(unsigned u) { return __builtin_bit_cast(float, u & 0xffff0000u); }
__device__ __forceinline__ float bf2f(bf16 b) { return __builtin_bit_cast(float, (unsigned)b << 16); }
__device__ __forceinline__ float sigmoidf_(float x) { return 1.f / (1.f + __expf(-x)); }
__device__ __forceinline__ float wave_sum(float v) {
#pragma unroll
    for (int o = 1; o < 64; o <<= 1) v += __shfl_xor(v, o);
    return v;
}
__device__ __forceinline__ unsigned wave_max_u(unsigned v) {
#pragma unroll
    for (int o = 1; o < 64; o <<= 1) { const unsigned w = (unsigned)__shfl_xor((int)v, o); v = v > w ? v : w; }
    return v;
}
struct F8 { float v[8]; };
__device__ __forceinline__ void unpack8(const v4u& u, float (&f)[8]) {
    f[0] = bflo(u.x); f[1] = bfhi(u.x); f[2] = bflo(u.y); f[3] = bfhi(u.y); f[4] = bflo(u.z); f[5] = bfhi(u.z); f[6] = bflo(u.w); f[7] = bfhi(u.w);
}
__device__ __forceinline__ v4u pack8(const float (&f)[8]) { v4u o; o.x = pk2(f[0], f[1]); o.y = pk2(f[2], f[3]); o.z = pk2(f[4], f[5]); o.w = pk2(f[6], f[7]); return o; }

#define XB_TMO      128
#define XB_XCNT(j)  (256  + 64 * (j))
#define XB_XSUB(j)  (1280 + 64 * (j))
#define XB_XGEN(j)  (2304 + 64 * (j))
#define XB_TOP      3328
#define XB_TOPGEN   3392
#define XCD_BAR_WORDS 3456
#define XB_SPIN_CAP (1u << 24)

__device__ __forceinline__ unsigned xb_ld(unsigned* p)              { return __hip_atomic_load(p, __ATOMIC_RELAXED, __HIP_MEMORY_SCOPE_AGENT); }
__device__ __forceinline__ unsigned xb_add(unsigned* p, unsigned v) { return __hip_atomic_fetch_add(p, v, __ATOMIC_RELAXED, __HIP_MEMORY_SCOPE_AGENT); }
__device__ __forceinline__ unsigned xb_xcc_id() { return (unsigned)__builtin_amdgcn_s_getreg((3 << 11) | 20) & 0xFu; }
#define XB_SPIN(cond, bar) do { unsigned _sp = 0; while (cond) { __builtin_amdgcn_s_sleep(1); \
    if ((++_sp & 255u) == 0u) { if (xb_ld(&(bar)[XB_TMO])) break; if (_sp > XB_SPIN_CAP) { atomicAdd(&(bar)[XB_TMO], 1u); break; } } } } while (0)

struct XcdBarrier {
    unsigned* bar; unsigned x;
    volatile LAS unsigned* st;
};

__device__ __forceinline__ XcdBarrier xcd_barrier_post(unsigned* bar, volatile LAS unsigned* st) {
    XcdBarrier b; b.bar = bar; b.x = xb_xcc_id(); b.st = st;
    if (threadIdx.x == 0) (void)xb_add(&bar[XB_XCNT(b.x)], 1u);
    return b;
}
__device__ __forceinline__ void xcd_barrier_complete(unsigned* bar, unsigned x, unsigned& nloc, unsigned& nx) {
    const unsigned G = gridDim.x * gridDim.y * gridDim.z;
    unsigned sum, cnt, mine, sp = 0u;
    for (;;) {
        sum = 0u; cnt = 0u; mine = 0u;
#pragma unroll
        for (unsigned j = 0; j < 16; ++j) { const unsigned c = xb_ld(&bar[XB_XCNT(j)]); sum += c; cnt += (c > 0u) ? 1u : 0u; mine = (j == x) ? c : mine; }
        if (sum == G) break;
        __builtin_amdgcn_s_sleep(1);
        if ((++sp & 255u) == 0u) { if (xb_ld(&bar[XB_TMO])) break; if (sp > XB_SPIN_CAP) { atomicAdd(&bar[XB_TMO], 1u); break; } }
    }
    nloc = mine > 0u ? mine : 1u; nx = cnt > 0u ? cnt : 1u;
}

__device__ __forceinline__ void xcd_barrier(const XcdBarrier& b) {
    asm volatile("s_waitcnt vmcnt(0)" ::: "memory");
    __syncthreads();
    if (threadIdx.x == 0) {
        unsigned* bar = b.bar;
        __builtin_amdgcn_s_waitcnt(0);
        unsigned nloc = b.st[0], nx = b.st[1];
        if (nloc == 0u) { xcd_barrier_complete(bar, b.x, nloc, nx); b.st[0] = nloc; b.st[1] = nx; }
        const unsigned old = xb_add(&bar[XB_XSUB(b.x)], 1u);
        const unsigned gen = old / nloc;
        if (old + 1u == (gen + 1u) * nloc) {
            __builtin_amdgcn_fence(__ATOMIC_RELEASE, "agent");
            asm volatile("s_waitcnt vmcnt(0)" ::: "memory");
            const unsigned og = xb_add(&bar[XB_TOP], 1u);
            const unsigned tg = og / nx;
            if (og + 1u == (tg + 1u) * nx) xb_add(&bar[XB_TOPGEN], 1u);
            else XB_SPIN(xb_ld(&bar[XB_TOPGEN]) == tg, bar);
            __builtin_amdgcn_fence(__ATOMIC_ACQUIRE, "agent");
            xb_add(&bar[XB_XGEN(b.x)], 1u);
            asm volatile("s_waitcnt vmcnt(0)" ::: "memory");
        } else {
            XB_SPIN(xb_ld(&bar[XB_XGEN(b.x)]) == gen, bar);
            __builtin_amdgcn_fence(__ATOMIC_ACQUIRE, "agent");
            asm volatile("s_waitcnt vmcnt(0)" ::: "memory");
        }
    }
    __syncthreads();
}

struct EpiProj {
    bf16 *sbqk, *vt, *mlqk, *mlv, *mlo, *gates;
    __device__ __forceinline__ void operator()(int row, int col, const F8& a) const {
        bf16* dst;
        if (col < 1024) dst = sbqk + (size_t)row * 1024 + col;
        else if (col < 1536) {
            const int c = col - 1024, hh = c >> 6, d = c & 63, b = row >> 11, sq = row & 2047;
            bf16* vp = vt + ((size_t)(b * 8 + hh) * 64 + d) * 2048 + sq;
#pragma unroll
            for (int i = 0; i < 8; ++i) vp[(size_t)i * 2048] = (bf16)f2bf(a.v[i]);
            return;
        }
        else if (col < 2560) dst = mlqk + (size_t)row * 1024 + (col - 1536);
        else if (col < 3072) dst = mlv + (size_t)row * 512 + (col - 2560);
        else if (col < 3584) dst = mlo + (size_t)row * 512 + (col - 3072);
        else dst = gates + (size_t)row * 2048 + (col - 3584);
        *(v4u*)dst = pack8(a.v);
    }
};
struct EpiMergeA {
    bf16* merged; const bf16* gates;
    __device__ __forceinline__ void operator()(int row, int col, const F8& a) const {
        float g[8], o[8]; unpack8(*(const v4u*)(gates + (size_t)row * 2048 + col), g);
#pragma unroll
        for (int i = 0; i < 8; ++i) o[i] = sigmoidf_(g[i]) * a.v[i];
        *(v4u*)(merged + (size_t)row * 1024 + col) = pack8(o);
    }
};
struct EpiMergeB {
    bf16* merged; const bf16* gates;
    __device__ __forceinline__ void operator()(int row, int col, const F8& a) const {
        float g[8], o[8]; unpack8(*(const v4u*)(gates + (size_t)row * 2048 + 1024 + col), g);
        unpack8(*(const v4u*)(merged + (size_t)row * 1024 + col), o);
#pragma unroll
        for (int i = 0; i < 8; ++i) o[i] += sigmoidf_(g[i]) * a.v[i];
        *(v4u*)(merged + (size_t)row * 1024 + col) = pack8(o);
    }
};
struct EpiH {
    float* h; const float* x;
    __device__ __forceinline__ void operator()(int row, int col, const F8& a) const {
        const f32x4 x0 = *(const f32x4*)(x + (size_t)row * 1024 + col), x1 = *(const f32x4*)(x + (size_t)row * 1024 + col + 4);
        *(f32x4*)(h + (size_t)row * 1024 + col) = (f32x4){x0.x + a.v[0], x0.y + a.v[1], x0.z + a.v[2], x0.w + a.v[3]};
        *(f32x4*)(h + (size_t)row * 1024 + col + 4) = (f32x4){x1.x + a.v[4], x1.y + a.v[5], x1.z + a.v[6], x1.w + a.v[7]};
    }
};
struct EpiF32 {
    float* o; int ldc;
    __device__ __forceinline__ void operator()(int row, int col, const F8& a) const {
        *(f32x4*)(o + (size_t)row * ldc + col) = (f32x4){a.v[0], a.v[1], a.v[2], a.v[3]};
        *(f32x4*)(o + (size_t)row * ldc + col + 4) = (f32x4){a.v[4], a.v[5], a.v[6], a.v[7]};
    }
};

template <class E> struct EpiAdapt {
    static constexpr bool PERM = true, AFTER_DRAIN = false;
    E e;
    __device__ __forceinline__ void operator()(const pg8::f32x4 (&acc)[2][2][4][2], const pg8::Unit& u, int wr, int wc, int fr, int fq) const {
#pragma unroll
        for (int ai = 0; ai < 2; ++ai)
#pragma unroll
            for (int m = 0; m < 4; ++m) {
                const int row = u.pm * 256 + ai * 128 + wr * 64 + m * 16 + fr;
#pragma unroll
                for (int bj = 0; bj < 2; ++bj) {
                    const int col = u.pn * 256 + bj * 128 + wc * 32 + 8 * fq;
                    F8 a; const pg8::f32x4 v0 = acc[ai][bj][m][0], v1 = acc[ai][bj][m][1];
                    a.v[0] = v0[0]; a.v[1] = v0[1]; a.v[2] = v0[2]; a.v[3] = v0[3]; a.v[4] = v1[0]; a.v[5] = v1[1]; a.v[6] = v1[2]; a.v[7] = v1[3];
                    e(row, col, a);
                }
            }
    }
};

template <class E>
__device__ __forceinline__ void simple_gemm(LAS unsigned char* lds, const bf16* A, const bf16* Bt, int M, int N, int K, const E& e) {
    LAS float* As = (LAS float*)lds;
    LAS float* Bs = As + 32 * 132;
    const int tid = threadIdx.x, ty = tid >> 4, tx = tid & 15;
    const int ntn = N / 128, ntiles = (M / 128) * ntn;
    for (int tile = blockIdx.x; tile < ntiles; tile += gridDim.x) {
        const int tm = tile / ntn, tn = tile % ntn;
        float acc[4][8];
#pragma unroll
        for (int i = 0; i < 4; ++i)
#pragma unroll
            for (int j = 0; j < 8; ++j) acc[i][j] = 0.f;
        for (int k0 = 0; k0 < K; k0 += 32) {
            {
                const int r = tid >> 2, kq = (tid & 3) * 8;
                float fa[8], fb[8];
                unpack8(*(const v4u*)(A + (size_t)(tm * 128 + r) * K + k0 + kq), fa);
                unpack8(*(const v4u*)(Bt + (size_t)(tn * 128 + r) * K + k0 + kq), fb);
#pragma unroll
                for (int i = 0; i < 8; ++i) { As[(kq + i) * 132 + r] = fa[i]; Bs[(kq + i) * 132 + r] = fb[i]; }
            }
            __syncthreads();
#pragma unroll 8
            for (int k = 0; k < 32; ++k) {
                const f32x4 a4 = *(const LAS f32x4*)(As + k * 132 + ty * 4);
                const f32x4 b0 = *(const LAS f32x4*)(Bs + k * 132 + tx * 8), b1 = *(const LAS f32x4*)(Bs + k * 132 + tx * 8 + 4);
                const float av[4] = {a4.x, a4.y, a4.z, a4.w};
                const float bv[8] = {b0.x, b0.y, b0.z, b0.w, b1.x, b1.y, b1.z, b1.w};
#pragma unroll
                for (int i = 0; i < 4; ++i)
#pragma unroll
                    for (int j = 0; j < 8; ++j) acc[i][j] += av[i] * bv[j];
            }
            __syncthreads();
        }
#pragma unroll
        for (int i = 0; i < 4; ++i) {
            F8 a;
#pragma unroll
            for (int j = 0; j < 8; ++j) a.v[j] = acc[i][j];
            e(tm * 128 + ty * 4 + i, tn * 128 + tx * 8, a);
        }
    }
}

template <class E>
__device__ __forceinline__ void gemm(LAS unsigned char* lds, const bf16* A, const bf16* Bt, int M, int N, int K, const E& e) {
#if USE_PG8
    pg8::Gemm g{A, Bt, M, N, K}; pg8::StaticOrder S; S.init(M, N, (int)gridDim.x, (int)blockIdx.x);
    EpiAdapt<E> ea{e};
    pg8::gemm_phase<EpiAdapt<E>, pg8::StaticOrder, true, true>(lds, g, S, ea);
#else
    simple_gemm<E>(lds, A, Bt, M, N, K, e);
#endif
}

__device__ __forceinline__ void transpose_item(const float* W, int ldw, int K, bf16* WT, int src_col0, int dst_row0, LAS float* scr, int kb, int lane) {
    const int k0 = 64 * kb;
#pragma unroll 8
    for (int i = 0; i < 32; ++i) { const int kk = 2 * i + (lane >> 5); scr[kk * 33 + (lane & 31)] = W[(size_t)(k0 + kk) * ldw + src_col0 + (lane & 31)]; }
    LDS_WAIT(); asm volatile("" ::: "memory");
    const int c = lane & 7;
#pragma unroll
    for (int j = 0; j < 4; ++j) { const int n = (lane >> 3) + 8 * j; const LAS float* s = scr + (8 * c) * 33 + n;
        v4u o; o.x = pk2(s[0 * 33], s[1 * 33]); o.y = pk2(s[2 * 33], s[3 * 33]); o.z = pk2(s[4 * 33], s[5 * 33]); o.w = pk2(s[6 * 33], s[7 * 33]);
        *(v4u*)(WT + (size_t)(dst_row0 + n) * K + k0 + 8 * c) = o; }
    LDS_WAIT(); asm volatile("" ::: "memory");
}

struct P {
    const float *x, *norm_mix_w, *w_in, *conv_w, *conv_b, *b_i, *b_f, *ml_norm_w, *w_sb, *w_ml, *w_out, *norm_ffn_w, *w_query, *keys1, *keys2, *peer_u, *peer_v, *norm_final_w;
    float* out; unsigned char* ws;
};

__device__ __forceinline__ void p0_prologue(const P& p, LAS unsigned char* lds, int wave, int lane) {
    LAS float* scr = (LAS float*)(lds + wave * 16384);
    const int gw = blockIdx.x * NWAVES + wave, NGW = gridDim.x * NWAVES;
    bf16* W1T = (bf16*)(p.ws + WS_W1T); bf16* WSBT = (bf16*)(p.ws + WS_WSBT); bf16* WMLT = (bf16*)(p.ws + WS_WMLT); bf16* WOUTT = (bf16*)(p.ws + WS_WOUTT); bf16* WCT = (bf16*)(p.ws + WS_WCT);
    constexpr int I_1 = 16 * 176, I_SB = 8 * 32, I_ML = 8 * 32, I_O = 16 * 32, NT = I_1 + I_SB + I_ML + I_O;
    for (int it = gw; it < NT; it += NGW) {
        int r = it;
        if (r < I_1) { const int kb = r / 176, nb = r % 176, n0 = nb * 32; transpose_item(p.w_in, INC, 1024, W1T, n0 < 3584 ? n0 : n0 + 8, n0, scr, kb, lane); continue; } r -= I_1;
        if (r < I_SB) { const int kb = r / 32, nb = r % 32; transpose_item(p.w_sb, 1024, 512, WSBT, nb * 32, nb * 32, scr, kb, lane); continue; } r -= I_SB;
        if (r < I_ML) { const int kb = r / 32, nb = r % 32; transpose_item(p.w_ml, 1024, 512, WMLT, nb * 32, nb * 32, scr, kb, lane); continue; } r -= I_ML;
        { const int kb = r / 32, nb = r % 32; transpose_item(p.w_out, 1024, 1024, WOUTT, nb * 32, nb * 32, scr, kb, lane); }
    }
    for (int it = gw; it < 2048 * 16; it += NGW) {
        const int col = it >> 4, kb = it & 15, head = col >> 8, half = (col >> 7) & 1, key = col & 127, k = kb * 64 + lane;
        const float* kr = (half ? p.keys2 : p.keys1) + ((size_t)head * 128 + key) * 128;
        const float* wq = p.w_query + (size_t)k * 2048 + head * 256 + half * 128;
        float acc = 0.f;
#pragma unroll 4
        for (int d = 0; d < 128; d += 4) { const f32x4 a = *(const f32x4*)(wq + d), b = *(const f32x4*)(kr + d); acc += a.x * b.x + a.y * b.y + a.z * b.z + a.w * b.w; }
        WCT[(size_t)col * 1024 + k] = (bf16)f2bf(acc);
    }
    bf16* XN = (bf16*)(p.ws + WS_XN); float* IFG = (float*)(p.ws + WS_IFG);
    for (int m = gw; m < T_; m += NGW) {
        const f32x4* xr = (const f32x4*)(p.x + (size_t)m * 1024) + lane;
        const f32x4* wr = (const f32x4*)p.norm_mix_w + lane;
        f32x4 v[4]; float ss = 0.f;
#pragma unroll
        for (int j = 0; j < 4; ++j) { v[j] = xr[64 * j]; ss += (v[j].x * v[j].x + v[j].y * v[j].y) + (v[j].z * v[j].z + v[j].w * v[j].w); }
        const float rstd = 1.f / sqrtf(wave_sum(ss) * (1.f / 1024.f) + EPS);
        float g[8];
#pragma unroll
        for (int i = 0; i < 8; ++i) g[i] = 0.f;
        v2u* o8 = (v2u*)(XN + (size_t)m * 1024) + lane;
#pragma unroll
        for (int j = 0; j < 4; ++j) {
            const f32x4 w = wr[64 * j];
            const float y[4] = {v[j].x * rstd * w.x, v[j].y * rstd * w.y, v[j].z * rstd * w.z, v[j].w * rstd * w.w};
            o8[64 * j] = (v2u){pk2(y[0], y[1]), pk2(y[2], y[3])};
#pragma unroll
            for (int q = 0; q < 4; ++q) {
                const int k = 256 * j + 4 * lane + q;
                const f32x4 w0 = *(const f32x4*)(p.w_in + (size_t)k * INC + 3584), w1 = *(const f32x4*)(p.w_in + (size_t)k * INC + 3588);
                g[0] += y[q] * w0.x; g[1] += y[q] * w0.y; g[2] += y[q] * w0.z; g[3] += y[q] * w0.w;
                g[4] += y[q] * w1.x; g[5] += y[q] * w1.y; g[6] += y[q] * w1.z; g[7] += y[q] * w1.w;
            }
        }
#pragma unroll
        for (int i = 0; i < 8; ++i) g[i] = wave_sum(g[i]);
        if (lane == 0) {
#pragma unroll
            for (int i = 0; i < 4; ++i) { IFG[(size_t)m * 8 + i] = g[i] + p.b_i[i]; IFG[(size_t)m * 8 + 4 + i] = g[4 + i] + p.b_f[i]; }
        }
    }
    {
        const size_t n8 = (size_t)NEXP * 1024 / 8, gt = (size_t)blockIdx.x * NTHR + threadIdx.x, NG = (size_t)gridDim.x * NTHR;
        v4u* U16 = (v4u*)(p.ws + WS_U16); v4u* V16 = (v4u*)(p.ws + WS_V16);
        for (size_t i = gt; i < n8; i += NG) {
            const f32x4 a = ((const f32x4*)p.peer_u)[2 * i], b = ((const f32x4*)p.peer_u)[2 * i + 1];
            U16[i] = (v4u){pk2(a.x, a.y), pk2(a.z, a.w), pk2(b.x, b.y), pk2(b.z, b.w)};
            const f32x4 c = ((const f32x4*)p.peer_v)[2 * i], d = ((const f32x4*)p.peer_v)[2 * i + 1];
            V16[i] = (v4u){pk2(c.x, c.y), pk2(c.z, c.w), pk2(d.x, d.y), pk2(d.z, d.w)};
        }
    }
}

typedef short bf16x8 __attribute__((ext_vector_type(8)));
typedef float f32x16 __attribute__((ext_vector_type(16)));
typedef float f32x2_t __attribute__((ext_vector_type(2))); typedef __bf16 bf16x2_t __attribute__((ext_vector_type(2)));
__device__ __forceinline__ unsigned cvtpk(float lo, float hi) { f32x2_t v = {lo, hi}; bf16x2_t b = __builtin_convertvector(v, bf16x2_t); return __builtin_bit_cast(unsigned, b); }
#define MFMA32(a, b, c) __builtin_amdgcn_mfma_f32_32x32x16_bf16((a), (b), (c), 0, 0, 0)
__device__ __forceinline__ int crow(int reg, int hh) { return (reg & 3) + 8 * (reg >> 2) + 4 * hh; }
template <int S> __device__ __forceinline__ bf16x8 pack_step(const f32x16& x) {
    v4u p; p.x = cvtpk(x[8 * S], x[8 * S + 1]); p.y = cvtpk(x[8 * S + 2], x[8 * S + 3]); p.z = cvtpk(x[8 * S + 4], x[8 * S + 5]); p.w = cvtpk(x[8 * S + 6], x[8 * S + 7]);
    return __builtin_bit_cast(bf16x8, p);
}
__device__ __forceinline__ bf16x8 frag2(const v2u& lo, const v2u& hi) { v4u p; p.x = lo.x; p.y = lo.y; p.z = hi.x; p.w = hi.y; return __builtin_bit_cast(bf16x8, p); }
__device__ __forceinline__ f32x16 zero16() { f32x16 z; for (int i = 0; i < 16; ++i) z[i] = 0.f; return z; }


constexpr int ML_QS = 0, ML_KS = 17408, ML_KWT = 34816, ML_VTL = 53248, ML_PS = 71680, ML_CT = 80896, ML_SCAL = 115712, ML_SSP = 118272, ML_QN = ML_SSP + 512, ML_F1 = ML_QN + 256, ML_F2 = ML_F1 + 256, ML_NV = ML_F2 + 256;
static_assert(ML_NV + 512 <= RING_BYTES, "mLSTM LDS map");
__device__ __forceinline__ void mlstm_scal(const float* IFG, int b, int h, int c, LAS float* sc, float& m_carry, int lane) {
    const size_t tok = (size_t)b * S_ + c * 64 + lane;
    const float ip = IFG[tok * 8 + h], fp = IFG[tok * 8 + 4 + h];
    const float lf = fminf(fp, 0.f) - log1pf(expf(-fabsf(fp)));
    float bc = lf;
#pragma unroll
    for (int o = 1; o < 64; o <<= 1) { const float t2 = __shfl_up(bc, o); if (lane >= o) bc += t2; }
    const float a = ip - bc; float pm = a;
#pragma unroll
    for (int o = 1; o < 64; o <<= 1) { const float t2 = __shfl_up(pm, o); if (lane >= o) pm = fmaxf(pm, t2); }
    const float M = fmaxf(m_carry, pm);
    const float M63 = __shfl(M, 63), bc63 = __shfl(bc, 63);
    sc[lane] = a; sc[64 + lane] = M; sc[128 + lane] = expf(a - M63); sc[192 + lane] = expf(m_carry - M); sc[256 + lane] = expf(-(bc + M));
    m_carry = bc63 + M63;
}
__device__ __forceinline__ void mlstm_item(const P& p, LAS unsigned char* lds, int item, int tid, int wave, int lane) {
    const int b = item >> 2, h = item & 3;
    const int r = lane & 31, hh = lane >> 5, et = wave & 3, th = wave >> 2;
    const bf16* MLQK = (const bf16*)(p.ws + WS_MLQK); const bf16* MLV = (const bf16*)(p.ws + WS_MLV); const float* IFG = (const float*)(p.ws + WS_IFG);
    bf16* HML = (bf16*)(p.ws + WS_YML);
    LAS float* SCAL = (LAS float*)(lds + ML_SCAL); LAS float* SSP = (LAS float*)(lds + ML_SSP); LAS float* QN = (LAS float*)(lds + ML_QN);
    LAS float* F1 = (LAS float*)(lds + ML_F1); LAS float* F2 = (LAS float*)(lds + ML_F2); LAS float* NV = (LAS float*)(lds + ML_NV);
    const int grp = tid & 31, rs = tid >> 5;
    const bool isk = grp >= 16;
    const int dch = 8 * (grp & 15);
    const int ch0 = (isk ? 512 : 0) + h * 128 + dch;
    float cw[4][8], cb[8];
#pragma unroll
    for (int i = 0; i < 8; ++i) { cb[i] = p.conv_b[ch0 + i];
#pragma unroll
        for (int j = 0; j < 4; ++j) cw[j][i] = p.conv_w[j * 1024 + ch0 + i]; }
    for (int i = tid; i < (128 * 136 * 2) / 4; i += NTHR) ((LAS unsigned*)(lds + ML_CT))[i] = 0u;
    if (tid < 128) NV[tid] = 0.f;
    f32x16 accC[2]; accC[0] = zero16(); accC[1] = zero16();
    float m_carry = 0.f;
    if (wave == 3) mlstm_scal(IFG, b, h, 0, SCAL, m_carry, lane);
    __syncthreads();
    for (int c = 0; c < 32; ++c) {
        const size_t tok0 = (size_t)b * S_ + c * 64;
        LAS float* sc = SCAL + (c & 1) * 320;
        {
            v4u xr[7];
#pragma unroll
            for (int k = 0; k < 7; ++k) { const int pos = c * 64 + 4 * rs + k - 3;
                xr[k] = pos >= 0 ? *(const v4u*)(MLQK + ((size_t)b * S_ + pos) * 1024 + ch0) : (v4u){0u, 0u, 0u, 0u}; }
            const int eg = tid & 15, sl = tid >> 4;
            const v4u v0 = *(const v4u*)(MLV + (tok0 + sl) * 512 + h * 128 + 8 * eg), v1 = *(const v4u*)(MLV + (tok0 + sl + 32) * 512 + h * 128 + 8 * eg);
#pragma unroll
            for (int tt = 0; tt < 4; ++tt) {
                float y[8];
#pragma unroll
                for (int i = 0; i < 8; ++i) y[i] = cb[i];
#pragma unroll
                for (int j = 0; j < 4; ++j) { float f[8]; unpack8(xr[tt + j], f);
#pragma unroll
                    for (int i = 0; i < 8; ++i) y[i] += cw[j][i] * f[i]; }
                const int t = 4 * rs + tt;
#pragma unroll
                for (int i = 0; i < 8; ++i) y[i] = y[i] * sigmoidf_(y[i]);
                if (!isk) { *(LAS v4u*)(lds + ML_QS + t * 272 + dch * 2) = pack8(y); }
                else {
#pragma unroll
                    for (int i = 0; i < 8; ++i) y[i] *= 0.08838834764831845f;
                    *(LAS v4u*)(lds + ML_KS + t * 272 + dch * 2) = pack8(y);
                    const float wk = sc[128 + t];
#pragma unroll
                    for (int i = 0; i < 8; ++i) *(LAS bf16*)(lds + ML_KWT + (dch + i) * 144 + t * 2) = (bf16)f2bf(y[i] * wk);
                }
            }
            {
                const unsigned vv0[4] = {v0.x, v0.y, v0.z, v0.w}, vv1[4] = {v1.x, v1.y, v1.z, v1.w};
#pragma unroll
                for (int i = 0; i < 4; ++i) {
                    *(LAS bf16*)(lds + ML_VTL + (8 * eg + 2 * i) * 144 + sl * 2) = (bf16)(vv0[i] & 0xffffu);
                    *(LAS bf16*)(lds + ML_VTL + (8 * eg + 2 * i + 1) * 144 + sl * 2) = (bf16)(vv0[i] >> 16);
                    *(LAS bf16*)(lds + ML_VTL + (8 * eg + 2 * i) * 144 + (sl + 32) * 2) = (bf16)(vv1[i] & 0xffffu);
                    *(LAS bf16*)(lds + ML_VTL + (8 * eg + 2 * i + 1) * 144 + (sl + 32) * 2) = (bf16)(vv1[i] >> 16);
                }
            }
        }
        __syncthreads();
        f32x16 acc_inter = zero16();
        if (wave < 3) {
            const int tt = wave > 0 ? 1 : 0, st = wave == 2 ? 1 : 0;
            f32x16 zt = zero16();
#pragma unroll
            for (int ks = 0; ks < 8; ++ks) {
                const bf16x8 ka = *(const LAS bf16x8*)(lds + ML_KS + (32 * st + r) * 272 + 32 * ks + 16 * hh);
                const bf16x8 qb = *(const LAS bf16x8*)(lds + ML_QS + (32 * tt + r) * 272 + 32 * ks + 16 * hh);
                zt = MFMA32(ka, qb, zt);
            }
            const int t = 32 * tt + r; const float Mt = sc[64 + t];
            float ps = 0.f;
#pragma unroll
            for (int g = 0; g < 4; ++g) {
                const f32x4 av = *(const LAS f32x4*)(sc + 32 * st + 8 * g + 4 * hh);
                float pv[4];
#pragma unroll
                for (int q = 0; q < 4; ++q) { const int sidx = 32 * st + 8 * g + 4 * hh + q;
                    const float wgt = sidx <= t ? expf(av[q] - Mt) : 0.f; pv[q] = zt[4 * g + q] * wgt; ps += pv[q]; }
                *(LAS v2u*)(lds + ML_PS + t * 144 + (32 * st + 8 * g + 4 * hh) * 2) = (v2u){cvtpk(pv[0], pv[1]), cvtpk(pv[2], pv[3])};
            }
            ps += __shfl_xor(ps, 32);
            if (hh == 0) { SSP[st * 64 + t] = ps; if (wave == 0) SSP[64 + t] = 0.f; }
        }
        if (wave == 3 && c + 1 < 32) mlstm_scal(IFG, b, h, c + 1, SCAL + ((c + 1) & 1) * 320, m_carry, lane);
#pragma unroll
        for (int ks = 0; ks < 8; ++ks) {
            const bf16x8 qa = *(const LAS bf16x8*)(lds + ML_QS + (32 * th + r) * 272 + 32 * ks + 16 * hh);
            const bf16x8 cbf = *(const LAS bf16x8*)(lds + ML_CT + (32 * et + r) * 272 + 32 * ks + 16 * hh);
            acc_inter = MFMA32(qa, cbf, acc_inter);
        }
        {
            const int t = tid >> 3, part = tid & 7;
            float f[8], sum = 0.f;
            { const v4u tq = *(const LAS v4u*)(lds + ML_QS + t * 272 + part * 32); unpack8(tq, f); }
#pragma unroll
            for (int i = 0; i < 8; ++i) sum += f[i] * NV[16 * part + i];
            { const v4u tq = *(const LAS v4u*)(lds + ML_QS + t * 272 + part * 32 + 16); unpack8(tq, f); }
#pragma unroll
            for (int i = 0; i < 8; ++i) sum += f[i] * NV[16 * part + 8 + i];
            sum += __shfl_xor(sum, 1); sum += __shfl_xor(sum, 2); sum += __shfl_xor(sum, 4);
            if (part == 0) QN[t] = sum;
        }
        __syncthreads();
        f32x16 acc_intra = zero16();
#pragma unroll
        for (int ks = 0; ks < 4; ++ks) {
            if (ks < 2 || th == 1) {
                const bf16x8 pa = *(const LAS bf16x8*)(lds + ML_PS + (32 * th + r) * 144 + 32 * ks + 16 * hh);
                const bf16x8 vb = *(const LAS bf16x8*)(lds + ML_VTL + (32 * et + r) * 144 + 32 * ks + 16 * hh);
                acc_intra = MFMA32(pa, vb, acc_intra);
            }
        }
        if (tid < 64) {
            const float wi = sc[192 + tid];
            const float den = SSP[tid] + SSP[64 + tid] + wi * QN[tid];
            const float f1 = 1.f / fmaxf(fabsf(den), sc[256 + tid]);
            F1[tid] = f1; F2[tid] = wi * f1;
        }
        const float decay = sc[192 + 63];
#pragma unroll
        for (int dt = 0; dt < 2; ++dt) {
#pragma unroll
            for (int i = 0; i < 16; ++i) accC[dt][i] *= decay;
#pragma unroll
            for (int ks = 0; ks < 4; ++ks) {
                const bf16x8 ka = *(const LAS bf16x8*)(lds + ML_KWT + (64 * th + 32 * dt + r) * 144 + 32 * ks + 16 * hh);
                const bf16x8 vb = *(const LAS bf16x8*)(lds + ML_VTL + (32 * et + r) * 144 + 32 * ks + 16 * hh);
                accC[dt] = MFMA32(ka, vb, accC[dt]);
            }
        }
        {
            const int d = tid >> 2, part = tid & 3;
            float f[8], sum = 0.f;
            { const v4u tq = *(const LAS v4u*)(lds + ML_KWT + d * 144 + part * 32); unpack8(tq, f); }
#pragma unroll
            for (int i = 0; i < 8; ++i) sum += f[i];
            { const v4u tq = *(const LAS v4u*)(lds + ML_KWT + d * 144 + part * 32 + 16); unpack8(tq, f); }
#pragma unroll
            for (int i = 0; i < 8; ++i) sum += f[i];
            sum += __shfl_xor(sum, 1); sum += __shfl_xor(sum, 2);
            if (part == 0) NV[d] = decay * NV[d] + sum;
        }
        __syncthreads();
        {
            bf16* hp = HML + (tok0 + 32 * th) * 512 + h * 128 + 32 * et + r;
#pragma unroll
            for (int g = 0; g < 4; ++g) {
                const f32x4 f1v = *(const LAS f32x4*)(F1 + 32 * th + 8 * g + 4 * hh), f2v = *(const LAS f32x4*)(F2 + 32 * th + 8 * g + 4 * hh);
#pragma unroll
                for (int q = 0; q < 4; ++q) { const int tl = 8 * g + 4 * hh + q;
                    hp[(size_t)tl * 512] = (bf16)f2bf(acc_intra[4 * g + q] * f1v[q] + acc_inter[4 * g + q] * f2v[q]); }
            }
#pragma unroll
            for (int dt = 0; dt < 2; ++dt)
#pragma unroll
                for (int g = 0; g < 4; ++g)
                    *(LAS v2u*)(lds + ML_CT + (32 * et + r) * 272 + (64 * th + 32 * dt + 8 * g + 4 * hh) * 2) = (v2u){cvtpk(accC[dt][4 * g], accC[dt][4 * g + 1]), cvtpk(accC[dt][4 * g + 2], accC[dt][4 * g + 3])};
        }
    }
    __syncthreads();
}

__device__ __forceinline__ void sba_wave_item(const bf16* __restrict__ QK, const bf16* __restrict__ VT, bf16* __restrict__ YSB, int b, int h, int qt, int lane) {
    const int r = lane & 31, hh = lane >> 5, t0 = qt * 32;
    const size_t rowbase = (size_t)b * S_;
    bf16x8 qf[4];
    {
        const bf16* qp = QK + (rowbase + t0 + r) * 1024 + h * 64 + 8 * hh;
#pragma unroll
        for (int ks = 0; ks < 4; ++ks) qf[ks] = *(const bf16x8*)(qp + 16 * ks);
    }
    bf16x8 tri[2];
#pragma unroll
    for (int s2 = 0; s2 < 2; ++s2)
#pragma unroll
        for (int j = 0; j < 8; ++j) { const int rho = 16 * s2 + 8 * (j >> 2) + 4 * hh + (j & 3); tri[s2][j] = (rho > r) ? (short)0x3F80 : (short)0; }
    f32x16 o0 = zero16(), o1 = zero16();
    float carry = 0.f;
    const bf16* kbase = QK + rowbase * 1024 + 512 + h * 64 + 8 * hh + (size_t)r * 1024;
    const bf16* vbase = VT + ((size_t)(b * 8 + h) * 64 + r) * 2048 + 4 * hh;
    bf16x8 kf[4]; v2u vl[2][2], vh[2][2];
#pragma unroll
    for (int ks = 0; ks < 4; ++ks) kf[ks] = *(const bf16x8*)(kbase + (size_t)t0 * 1024 + 16 * ks);
#pragma unroll
    for (int dt = 0; dt < 2; ++dt)
#pragma unroll
        for (int s2 = 0; s2 < 2; ++s2) { const bf16* vp = vbase + (size_t)dt * 32 * 2048 + t0 + 16 * s2; vl[dt][s2] = *(const v2u*)vp; vh[dt][s2] = *(const v2u*)(vp + 8); }
    for (int s0 = t0; s0 >= 0; s0 -= 32) {
        bf16x8 kn[4]; v2u vln[2][2], vhn[2][2];
        const int sn = s0 >= 32 ? s0 - 32 : 0;
#pragma unroll
        for (int ks = 0; ks < 4; ++ks) kn[ks] = *(const bf16x8*)(kbase + (size_t)sn * 1024 + 16 * ks);
#pragma unroll
        for (int dt = 0; dt < 2; ++dt)
#pragma unroll
            for (int s2 = 0; s2 < 2; ++s2) { const bf16* vp = vbase + (size_t)dt * 32 * 2048 + sn + 16 * s2; vln[dt][s2] = *(const v2u*)vp; vhn[dt][s2] = *(const v2u*)(vp + 8); }
        f32x16 z = zero16();
#pragma unroll
        for (int ks = 0; ks < 4; ++ks) z = MFMA32(kf[ks], qf[ks], z);
        const bool diag = (s0 == t0);
        f32x16 sp; float rs = 0.f;
#pragma unroll
        for (int i = 0; i < 16; ++i) {
            const float zz = z[i] * 0.125f;
            const bool valid = !diag || (crow(i, hh) < r);
            float spv = fmaxf(zz, 0.f) + __logf(1.f + __expf(-fabsf(zz)));
            spv = valid ? spv : 0.f;
            sp[i] = spv; rs += spv; z[i] = zz - spv;
        }
        f32x16 suf = zero16();
        suf = MFMA32(tri[0], pack_step<0>(sp), suf);
        suf = MFMA32(tri[1], pack_step<1>(sp), suf);
        f32x16 w;
#pragma unroll
        for (int i = 0; i < 16; ++i) {
            const bool valid = !diag || (crow(i, hh) < r);
            const float lw = z[i] - suf[i] - carry;
            w[i] = valid ? __expf(lw) : 0.f;
        }
        rs += __shfl_xor(rs, 32);
        carry += rs;
        const bf16x8 pa0 = pack_step<0>(w), pa1 = pack_step<1>(w);
        o0 = MFMA32(pa0, frag2(vl[0][0], vh[0][0]), o0); o0 = MFMA32(pa1, frag2(vl[0][1], vh[0][1]), o0);
        o1 = MFMA32(pa0, frag2(vl[1][0], vh[1][0]), o1); o1 = MFMA32(pa1, frag2(vl[1][1], vh[1][1]), o1);
        if (__all(carry > 104.f)) break;
#pragma unroll
        for (int ks = 0; ks < 4; ++ks) kf[ks] = kn[ks];
#pragma unroll
        for (int dt = 0; dt < 2; ++dt)
#pragma unroll
            for (int s2 = 0; s2 < 2; ++s2) { vl[dt][s2] = vln[dt][s2]; vh[dt][s2] = vhn[dt][s2]; }
    }
    bf16* op = YSB + (rowbase + t0) * 512 + h * 64 + r;
#pragma unroll
    for (int i = 0; i < 16; ++i) { const int t = crow(i, hh); op[(size_t)t * 512] = (bf16)f2bf(o0[i]); op[(size_t)t * 512 + 32] = (bf16)f2bf(o1[i]); }
}
__device__ __forceinline__ void sba_item(const P& p, int item, int wave, int lane) {
    const int bh = item >> 3, qb = item & 7, b = bh >> 3, h = bh & 7;
    sba_wave_item((const bf16*)(p.ws + WS_SBQKV), (const bf16*)(p.ws + WS_VT), (bf16*)(p.ws + WS_YSB), b, h, qb * 8 + wave, lane);
}

__device__ __forceinline__ void p3_yml(const P& p, int wave, int lane) {
    const int gw = blockIdx.x * NWAVES + wave, NGW = gridDim.x * NWAVES;
    bf16* YML = (bf16*)(p.ws + WS_YML); const bf16* MLO = (const bf16*)(p.ws + WS_MLO);
    for (int m = gw; m < T_; m += NGW) {
        float hv[8], ov[8], o[8];
        unpack8(*(const v4u*)(YML + (size_t)m * 512 + lane * 8), hv); unpack8(*(const v4u*)(MLO + (size_t)m * 512 + lane * 8), ov);
        float ss = 0.f;
#pragma unroll
        for (int i = 0; i < 8; ++i) ss += hv[i] * hv[i];
        ss += __shfl_xor(ss, 1); ss += __shfl_xor(ss, 2); ss += __shfl_xor(ss, 4); ss += __shfl_xor(ss, 8);
        const float rstd = 1.f / sqrtf(ss * (1.f / 128.f) + EPS);
        const f32x4 w0 = *(const f32x4*)(p.ml_norm_w + lane * 8), w1 = *(const f32x4*)(p.ml_norm_w + lane * 8 + 4);
        const float wv[8] = {w0.x, w0.y, w0.z, w0.w, w1.x, w1.y, w1.z, w1.w};
#pragma unroll
        for (int i = 0; i < 8; ++i) o[i] = sigmoidf_(ov[i]) * hv[i] * rstd * wv[i];
        *(v4u*)(YML + (size_t)m * 512 + lane * 8) = pack8(o);
    }
}

__device__ __forceinline__ void p6_hn(const P& p, int wave, int lane) {
    const int gw = blockIdx.x * NWAVES + wave, NGW = gridDim.x * NWAVES;
    const float* H = (const float*)(p.ws + WS_H); bf16* HN = (bf16*)(p.ws + WS_HN);
    for (int m = gw; m < T_; m += NGW) {
        const f32x4* xr = (const f32x4*)(H + (size_t)m * 1024) + lane; const f32x4* wr = (const f32x4*)p.norm_ffn_w + lane;
        f32x4 v[4]; float ss = 0.f;
#pragma unroll
        for (int j = 0; j < 4; ++j) { v[j] = xr[64 * j]; ss += (v[j].x * v[j].x + v[j].y * v[j].y) + (v[j].z * v[j].z + v[j].w * v[j].w); }
        const float rstd = 1.f / sqrtf(wave_sum(ss) * (1.f / 1024.f) + EPS);
        v2u* o8 = (v2u*)(HN + (size_t)m * 1024) + lane;
#pragma unroll
        for (int j = 0; j < 4; ++j) { const f32x4 w = wr[64 * j]; o8[64 * j] = (v2u){pk2(v[j].x * rstd * w.x, v[j].y * rstd * w.y), pk2(v[j].z * rstd * w.z, v[j].w * rstd * w.w)}; }
    }
}

__device__ __forceinline__ unsigned ord_key(float f) { const unsigned u = __builtin_bit_cast(unsigned, f); return (u & 0x80000000u) ? ~u : (u | 0x80000000u); }
__device__ __forceinline__ float ord_val(unsigned k) { const unsigned u = (k & 0x80000000u) ? (k & 0x7fffffffu) : ~k; return __builtin_bit_cast(float, u); }
__device__ __forceinline__ void p8_topk(const P& p, int hh, int wave, int lane) {
    const int gw = blockIdx.x * NWAVES + wave, NGW = gridDim.x * NWAVES;
    const float* SC = (const float*)(p.ws + WS_SC); int* IDX = (int*)(p.ws + WS_IDX); float* GATE = (float*)(p.ws + WS_GATE);
    for (int it = gw; it < T_ * 4; it += NGW) {
        const int m = it >> 2, hl = it & 3, head = hh * 4 + hl;
        const float* sr = SC + (size_t)m * 1024 + hl * 256;
        unsigned mine[2];
#pragma unroll
        for (int half = 0; half < 2; ++half) {
            unsigned ka = (ord_key(sr[half * 128 + lane]) & ~0x7fu) | (unsigned)(127 - lane);
            unsigned kb = (ord_key(sr[half * 128 + 64 + lane]) & ~0x7fu) | (unsigned)(127 - (64 + lane));
            unsigned mk = 0u;
#pragma unroll 1
            for (int k = 0; k < 16; ++k) {
                const unsigned mx = wave_max_u(ka > kb ? ka : kb);
                if (ka == mx) ka = 0u; if (kb == mx) kb = 0u;
                if (lane == k) mk = mx;
            }
            mine[half] = mk;
        }
        unsigned ck[4];
#pragma unroll
        for (int j = 0; j < 4; ++j) {
            const int c = lane + 64 * j, a = c >> 4, bb = c & 15;
            const float v1 = ord_val((unsigned)__shfl((int)mine[0], a) & ~0x7fu), v2 = ord_val((unsigned)__shfl((int)mine[1], bb) & ~0x7fu);
            ck[j] = (ord_key(v1 + v2) & ~0xffu) | (unsigned)(255 - c);
        }
        unsigned tk = 0u;
#pragma unroll 1
        for (int k = 0; k < 16; ++k) {
            unsigned mx = ck[0] > ck[1] ? ck[0] : ck[1]; const unsigned m2 = ck[2] > ck[3] ? ck[2] : ck[3]; mx = mx > m2 ? mx : m2;
            mx = wave_max_u(mx);
#pragma unroll
            for (int j = 0; j < 4; ++j) if (ck[j] == mx) ck[j] = 0u;
            if (lane == k) tk = mx;
        }
        const float sv = ord_val(tk & ~0xffu);
        const int c = 255 - (int)(tk & 0xffu), a = (c >> 4) & 15, bb = c & 15;
        const int i1 = 127 - (int)((unsigned)__shfl((int)mine[0], a) & 0x7fu), i2 = 127 - (int)((unsigned)__shfl((int)mine[1], bb) & 0x7fu);
        const float s0 = __shfl(sv, 0);
        const float pe = lane < 16 ? expf(sv - s0) : 0.f;
        const float den = wave_sum(pe);
        if (lane < 16) { IDX[(size_t)m * 128 + head * 16 + lane] = i1 * 128 + i2; GATE[(size_t)m * 128 + head * 16 + lane] = pe / den; }
    }
}

__device__ __forceinline__ float gelu_erf(float x) { return 0.5f * x * (1.f + erff(x * 0.70710678118654752f)); }
__device__ __forceinline__ void p9_peer(const P& p, int wave, int lane) {
    const int gw = blockIdx.x * NWAVES + wave, NGW = gridDim.x * NWAVES;
    const float* H = (const float*)(p.ws + WS_H); const bf16* HN = (const bf16*)(p.ws + WS_HN);
    const int* IDX = (const int*)(p.ws + WS_IDX); const float* GATE = (const float*)(p.ws + WS_GATE);
    const bf16* U16 = (const bf16*)(p.ws + WS_U16); const bf16* V16 = (const bf16*)(p.ws + WS_V16);
    for (int m = gw; m < T_; m += NGW) {
        float xv[16], acc[16];
        { float f[8]; unpack8(*(const v4u*)(HN + (size_t)m * 1024 + lane * 8), f);
#pragma unroll
          for (int i = 0; i < 8; ++i) xv[i] = f[i];
          unpack8(*(const v4u*)(HN + (size_t)m * 1024 + 512 + lane * 8), f);
#pragma unroll
          for (int i = 0; i < 8; ++i) xv[8 + i] = f[i]; }
#pragma unroll
        for (int i = 0; i < 16; ++i) acc[i] = 0.f;
        const int myidx0 = IDX[(size_t)m * 128 + lane], myidx1 = IDX[(size_t)m * 128 + 64 + lane];
        const float myg0 = GATE[(size_t)m * 128 + lane], myg1 = GATE[(size_t)m * 128 + 64 + lane];
#pragma unroll 1
        for (int j0 = 0; j0 < 128; j0 += 4) {
            float dots[4]; int ei[4]; float gi[4];
#pragma unroll
            for (int u = 0; u < 4; ++u) {
                const int j = j0 + u;
                ei[u] = __shfl(j < 64 ? myidx0 : myidx1, j & 63); gi[u] = __shfl(j < 64 ? myg0 : myg1, j & 63);
                float f[8], d = 0.f;
                unpack8(*(const v4u*)(U16 + (size_t)ei[u] * 1024 + lane * 8), f);
#pragma unroll
                for (int i = 0; i < 8; ++i) d += f[i] * xv[i];
                unpack8(*(const v4u*)(U16 + (size_t)ei[u] * 1024 + 512 + lane * 8), f);
#pragma unroll
                for (int i = 0; i < 8; ++i) d += f[i] * xv[8 + i];
                dots[u] = d;
            }
#pragma unroll
            for (int u = 0; u < 4; ++u) dots[u] = wave_sum(dots[u]);
#pragma unroll
            for (int u = 0; u < 4; ++u) {
                const float coef = gi[u] * gelu_erf(dots[u]);
                float f[8];
                unpack8(*(const v4u*)(V16 + (size_t)ei[u] * 1024 + lane * 8), f);
#pragma unroll
                for (int i = 0; i < 8; ++i) acc[i] += coef * f[i];
                unpack8(*(const v4u*)(V16 + (size_t)ei[u] * 1024 + 512 + lane * 8), f);
#pragma unroll
                for (int i = 0; i < 8; ++i) acc[8 + i] += coef * f[i];
            }
        }
        float y[16], ss = 0.f;
#pragma unroll
        for (int hb = 0; hb < 2; ++hb) {
            const f32x4 h0 = *(const f32x4*)(H + (size_t)m * 1024 + hb * 512 + lane * 8), h1 = *(const f32x4*)(H + (size_t)m * 1024 + hb * 512 + lane * 8 + 4);
            y[hb * 8 + 0] = h0.x + acc[hb * 8 + 0]; y[hb * 8 + 1] = h0.y + acc[hb * 8 + 1]; y[hb * 8 + 2] = h0.z + acc[hb * 8 + 2]; y[hb * 8 + 3] = h0.w + acc[hb * 8 + 3];
            y[hb * 8 + 4] = h1.x + acc[hb * 8 + 4]; y[hb * 8 + 5] = h1.y + acc[hb * 8 + 5]; y[hb * 8 + 6] = h1.z + acc[hb * 8 + 6]; y[hb * 8 + 7] = h1.w + acc[hb * 8 + 7];
        }
#pragma unroll
        for (int i = 0; i < 16; ++i) ss += y[i] * y[i];
        const float rstd = 1.f / sqrtf(wave_sum(ss) * (1.f / 1024.f) + EPS);
#pragma unroll
        for (int hb = 0; hb < 2; ++hb) {
            const f32x4 w0 = *(const f32x4*)(p.norm_final_w + hb * 512 + lane * 8), w1 = *(const f32x4*)(p.norm_final_w + hb * 512 + lane * 8 + 4);
            *(f32x4*)(p.out + (size_t)m * 1024 + hb * 512 + lane * 8) = (f32x4){y[hb * 8 + 0] * rstd * w0.x, y[hb * 8 + 1] * rstd * w0.y, y[hb * 8 + 2] * rstd * w0.z, y[hb * 8 + 3] * rstd * w0.w};
            *(f32x4*)(p.out + (size_t)m * 1024 + hb * 512 + lane * 8 + 4) = (f32x4){y[hb * 8 + 4] * rstd * w1.x, y[hb * 8 + 5] * rstd * w1.y, y[hb * 8 + 6] * rstd * w1.z, y[hb * 8 + 7] * rstd * w1.w};
        }
    }
}

constexpr int N_PHASES = 12;
struct Args { P p; int ph_lo, ph_hi; };
__global__ void __launch_bounds__(NTHR, 2) fwd_kernel(Args args) {
    extern __shared__ __attribute__((aligned(16))) unsigned char lds_raw[];
    LAS unsigned char* lds = (LAS unsigned char*)lds_raw;
    const P& p = args.p;
    const int tid = threadIdx.x, lane = tid & 63, wave = __builtin_amdgcn_readfirstlane(tid >> 6);
    volatile LAS unsigned* MISC = (volatile LAS unsigned*)(lds + MISC_OFF);
    for (int u = tid; u < (LDS_BYTES - LDSCTL_OFF) / 4; u += NTHR) ((LAS unsigned*)(lds + LDSCTL_OFF))[u] = 0u;
    __syncthreads();
    XcdBarrier bar; bar.bar = (unsigned*)(p.ws + WS_CTL) + CW_BAR; bar.x = 0; bar.st = nullptr;
#if !MK_PER_PHASE
    bar = xcd_barrier_post((unsigned*)(p.ws + WS_CTL) + CW_BAR, MISC + 8);
#endif
    const int lo = args.ph_lo, hi = args.ph_hi;
#define IN(k) (lo <= (k) && (k) < hi)
#define SEAM(k) do { if (IN(k) && IN((k) + 1)) xcd_barrier(bar); } while (0)

#ifndef PROBE_REP
#define PROBE_REP -1
#endif
#define REP(k) ((PROBE_REP == (k)) ? 2 : 1)
    if (IN(0)) {
#pragma unroll 1
        for (int r = 0; r < REP(0); ++r) p0_prologue(p, lds, wave, lane); } SEAM(0);
    if (IN(1)) {
#pragma unroll 1
      for (int r = 0; r < REP(1); ++r) {
        EpiProj e{(bf16*)(p.ws + WS_SBQKV), (bf16*)(p.ws + WS_VT), (bf16*)(p.ws + WS_MLQK), (bf16*)(p.ws + WS_MLV), (bf16*)(p.ws + WS_MLO), (bf16*)(p.ws + WS_GATES)};
        gemm<EpiProj>(lds, (const bf16*)(p.ws + WS_XN), (const bf16*)(p.ws + WS_W1T), T_, NPROJ, 1024, e); }
    } SEAM(1);
    if (IN(2)) {
        for (int it = blockIdx.x; it < 64; it += gridDim.x) mlstm_item(p, lds, it, tid, wave, lane);
        unsigned* qctr = (unsigned*)(p.ws + WS_CTL) + CW_Q;
        for (;;) {
            if (tid == 0) MISC[12] = __hip_atomic_fetch_add(qctr, 1u, __ATOMIC_RELAXED, __HIP_MEMORY_SCOPE_AGENT);
            __syncthreads();
            const unsigned it = MISC[12];
            __syncthreads();
            if (it >= 1024u) break;
            sba_item(p, (int)it, wave, lane);
        }
    } SEAM(2);
    if (IN(3)) { p3_yml(p, wave, lane); } SEAM(3);
    if (IN(4)) {
        EpiMergeA ea{(bf16*)(p.ws + WS_MERGED), (const bf16*)(p.ws + WS_GATES)};
        gemm<EpiMergeA>(lds, (const bf16*)(p.ws + WS_YSB), (const bf16*)(p.ws + WS_WSBT), T_, 1024, 512, ea);
        VM_WAIT(); __syncthreads();
        EpiMergeB eb{(bf16*)(p.ws + WS_MERGED), (const bf16*)(p.ws + WS_GATES)};
        gemm<EpiMergeB>(lds, (const bf16*)(p.ws + WS_YML), (const bf16*)(p.ws + WS_WMLT), T_, 1024, 512, eb);
    } SEAM(4);
    if (IN(5)) {
#pragma unroll 1
      for (int r = 0; r < REP(5); ++r) {
        EpiH e{(float*)(p.ws + WS_H), p.x};
        gemm<EpiH>(lds, (const bf16*)(p.ws + WS_MERGED), (const bf16*)(p.ws + WS_WOUTT), T_, 1024, 1024, e); }
    } SEAM(5);
    if (IN(6)) { p6_hn(p, wave, lane); } SEAM(6);
    if (IN(7)) { EpiF32 e{(float*)(p.ws + WS_SC), 1024}; gemm<EpiF32>(lds, (const bf16*)(p.ws + WS_HN), (const bf16*)(p.ws + WS_WCT), T_, 1024, 1024, e); } SEAM(7);
    if (IN(8)) {
#pragma unroll 1
        for (int r = 0; r < REP(8); ++r) p8_topk(p, 0, wave, lane); } SEAM(8);
    if (IN(9)) { EpiF32 e{(float*)(p.ws + WS_SC), 1024}; gemm<EpiF32>(lds, (const bf16*)(p.ws + WS_HN), (const bf16*)(p.ws + WS_WCT) + (size_t)1024 * 1024, T_, 1024, 1024, e); } SEAM(9);
    if (IN(10)) { p8_topk(p, 1, wave, lane); } SEAM(10);
    if (IN(11)) {
#pragma unroll 1
        for (int r = 0; r < REP(11); ++r) p9_peer(p, wave, lane); }
#undef IN
#undef SEAM
}

extern "C" void kernel_launch(void* const* d_in, const int* in_sizes, int n_in, void* d_out, int out_size, void* d_ws, size_t ws_size, hipStream_t stream) {
    static int grid = 0;
    if (grid == 0) {
        if (n_in != 18 || in_sizes[0] != T_ * D_ || out_size != T_ * D_ || ws_size < WS_END) {
            fprintf(stderr, "kernel_launch: unexpected problem (n_in %d, in0 %d, out %d, ws %zu); nothing launched\n", n_in, n_in > 0 ? in_sizes[0] : -1, out_size, ws_size); grid = -1; return; }
        int dev = 0, cus = 0, per_cu = 0;
        if (hipGetDevice(&dev) != hipSuccess || hipDeviceGetAttribute(&cus, hipDeviceAttributeMultiprocessorCount, dev) != hipSuccess) { grid = -1; return; }
        if (hipFuncSetAttribute((const void*)fwd_kernel, hipFuncAttributeMaxDynamicSharedMemorySize, LDS_BYTES) != hipSuccess) { fprintf(stderr, "kernel_launch: hipFuncSetAttribute failed\n"); grid = -1; return; }
        if (hipOccupancyMaxActiveBlocksPerMultiprocessor(&per_cu, (const void*)fwd_kernel, NTHR, LDS_BYTES) != hipSuccess || per_cu < 1)
            fprintf(stderr, "kernel_launch: note: occupancy query reports %d workgroups per CU\n", per_cu);
        (void)hipGetLastError();
        grid = cus;
    }
    if (grid < 0) return;
    if (hipMemsetAsync((char*)d_ws + WS_CTL, 0, CTL_ZERO_BYTES, stream) != hipSuccess) { fprintf(stderr, "kernel_launch: memset failed\n"); return; }
    Args a{};
    const float** pp = (const float**)&a.p;
    for (int i = 0; i < 18; ++i) pp[i] = (const float*)d_in[i];
    a.p.out = (float*)d_out; a.p.ws = (unsigned char*)d_ws;
#if MK_PER_PHASE
    for (int ph = 0; ph < N_PHASES; ++ph) {
        a.ph_lo = ph; a.ph_hi = ph + 1;
        hipLaunchKernelGGL(fwd_kernel, dim3(grid), dim3(NTHR), LDS_BYTES, stream, a);
    }
#else
    a.ph_lo = 0; a.ph_hi = N_PHASES;
    hipLaunchKernelGGL(fwd_kernel, dim3(grid), dim3(NTHR), LDS_BYTES, stream, a);
#endif
    const hipError_t le = hipPeekAtLastError();
    if (le != hipSuccess) fprintf(stderr, "kernel_launch: launch failed: %s\n", hipGetErrorName(le));
}
```

```cpp
#include <hip/hip_runtime.h>
#include <cstdio>
#include <cstdint>
namespace pg8 {
#define PG8_LAS __attribute__((address_space(3)))
typedef unsigned short bf16_t;
typedef short bf16x8 __attribute__((ext_vector_type(8)));
typedef float f32x4 __attribute__((ext_vector_type(4)));
typedef unsigned u32x4 __attribute__((ext_vector_type(4)));
constexpr int BM = 256, BK = 64, HALF = 128, HTB = HALF * BK * 2  , STAGE_BYTES = 8 * HTB, NXCD = 8, WGM = 8;

__host__ __device__ __forceinline__ int lds_byte(int r, int c) { const int st = (r >> 4) * 2 + (c >> 5), rr = r & 15, cc = c & 31, ob = rr * 64 + cc * 2; return st * 1024 + (ob ^ (((ob >> 9) & 1) << 5)); }
__host__ __device__ __forceinline__ void stage_rc(int b, int& R, int& C) { const int st = b / 1024, sb = b % 1024, swz = sb ^ (((sb >> 9) & 1) << 5); R = (st >> 1) * 16 + swz / 64; C = (st & 1) * 32 + (swz % 64) / 2; }
__host__ __device__ __forceinline__ int perm32(int rho) { const int n = rho >> 4, i = rho & 15; return 8 * (i >> 2) + 4 * n + (i & 3); }

struct Unit { int pm, pn; };
struct Gemm { const bf16_t* A; const bf16_t* Bt; int M, N, K; };

struct StaticOrder {
    int nM, nN, nwg, G, c;
    __host__ __device__ void init(int M, int N, int G_, int c_) { nM = M / BM; nN = N / BM; nwg = nM * nN; G = G_; c = c_; }
    __host__ __device__ bool next(int i, Unit& u) const {
        const long L = (long)i * G + c; if (L >= nwg) return false;
        int wgid = (int)L; { const int q = nwg / NXCD, r = nwg % NXCD, xcd = wgid % NXCD, off = wgid / NXCD; wgid = (xcd < r ? xcd * (q + 1) : r * (q + 1) + (xcd - r) * q) + off; }
        const int nig = WGM * nN, gid = wgid / nig, fm = gid * WGM, gsz = (nM - fm) < WGM ? (nM - fm) : WGM;
        u.pm = fm + ((wgid % nig) % gsz); u.pn = (wgid % nig) / gsz; return true;
    }
    __device__ __forceinline__ void a_ready(const Unit&) const {}
    __device__ __forceinline__ void done(const Unit&) const {}
};

__device__ __forceinline__ unsigned cvt_pk_bf16(float lo, float hi) { unsigned r; asm volatile("v_cvt_pk_bf16_f32 %0, %1, %2" : "=v"(r) : "v"(lo), "v"(hi)); return r; }
template <class Epi, class Sched, bool ALIGN_EPI = false, bool SP2 = false>
__device__ __forceinline__ void gemm_phase(PG8_LAS unsigned char* lds, const Gemm g, const Sched& S, const Epi& E) {
    const int tid = threadIdx.x, wid = __builtin_amdgcn_readfirstlane(tid >> 6), lane = tid & 63, wr = wid >> 2, wc = wid & 3, fr = lane & 15, fq = lane >> 4;
    const int K = g.K, nt = K / BK;
    unsigned voffA[2], voffB[2];
#pragma unroll
    for (int i = 0; i < 2; ++i) { int R, C; stage_rc(tid * 16 + i * 8192, R, C); const int Rb = Epi::PERM ? ((R & ~31) + perm32(R & 31)) : R;
        voffA[i] = (unsigned)(R * K + C) * 2u; voffB[i] = (unsigned)(Rb * K + C) * 2u; }
    const size_t kstep = (size_t)(BK * 2);
    const size_t hstep = (size_t)HALF * K * 2;
    const size_t tstep = 2 * hstep;
    const unsigned ldsw = (unsigned)wid * 1024u;
    const int aoff = lds_byte(wr * 64 + fr, fq * 8), boff = lds_byte(wc * 32 + fr, fq * 8);
#define PG8_SA(b, h) (((b) * 2 + (h)) * HTB)
#define PG8_SB(b, h) ((4 + (b) * 2 + (h)) * HTB)
#define PG8_STAGE(bufoff, gbase, voff) do { _Pragma("unroll") for (int _i = 0; _i < 2; ++_i) \
        __builtin_amdgcn_global_load_lds((const unsigned*)((const char*)(gbase) + (voff)[_i]), (PG8_LAS unsigned*)(lds + (bufoff) + ldsw + _i * 8192), 16, 0, 0); } while (0)
#define PG8_LDA(dst, b, h) do { _Pragma("unroll") for (int m = 0; m < 4; ++m) _Pragma("unroll") for (int k = 0; k < 2; ++k) dst[m][k] = *(const PG8_LAS bf16x8*)(lds + PG8_SA(b, h) + aoff + m * 2048 + k * 1024); } while (0)
#define PG8_LDB(dst, b, h) do { _Pragma("unroll") for (int n = 0; n < 2; ++n) _Pragma("unroll") for (int k = 0; k < 2; ++k) dst[n][k] = *(const PG8_LAS bf16x8*)(lds + PG8_SB(b, h) + boff + n * 2048 + k * 1024); } while (0)
#define PG8_MMA(ai, bj, At, Bt) do { __builtin_amdgcn_s_setprio(1); _Pragma("unroll") for (int m = 0; m < 4; ++m) _Pragma("unroll") for (int n = 0; n < 2; ++n) _Pragma("unroll") for (int k = 0; k < 2; ++k) \
        acc[ai][bj][m][n] = __builtin_amdgcn_mfma_f32_16x16x32_bf16(Bt[n][k], At[m][k], acc[ai][bj][m][n], 0, 0, 0); __builtin_amdgcn_s_setprio(0); } while (0)
#define PG8_WAIT_V(n) asm volatile("s_waitcnt vmcnt(" #n ")" ::: "memory")
#define PG8_WAIT_L(n) asm volatile("s_waitcnt lgkmcnt(" #n ")" ::: "memory")
#define PG8_BAR __builtin_amdgcn_s_barrier()
#define PG8_SCHED __builtin_amdgcn_sched_barrier(0)
    Unit cur, nxt; int ui = 0;
    if (!S.next(0, cur)) return;
    f32x4 acc[2][2][4][2];
#pragma unroll
    for (int a = 0; a < 2; ++a)
#pragma unroll
        for (int b = 0; b < 2; ++b)
#pragma unroll
            for (int m = 0; m < 4; ++m)
#pragma unroll
                for (int n = 0; n < 2; ++n) acc[a][b][m][n] = (f32x4){0.f, 0.f, 0.f, 0.f};
    bf16x8 At[4][2], B0[2][2], B1[2][2];
    const char* cA = (const char*)g.A + (size_t)cur.pm * tstep; const char* cB = (const char*)g.Bt + (size_t)cur.pn * tstep;
    S.a_ready(cur);
    if constexpr (SP2) {
        PG8_STAGE(PG8_SB(0, 0), cB, voffB); PG8_STAGE(PG8_SB(0, 1), cB + hstep, voffB); PG8_STAGE(PG8_SA(0, 0), cA, voffA); PG8_STAGE(PG8_SA(0, 1), cA + hstep, voffA);
        if (wr == 1) PG8_BAR;
        PG8_WAIT_V(2); PG8_BAR;
        PG8_STAGE(PG8_SB(1, 0), cB + kstep, voffB); PG8_STAGE(PG8_SA(1, 0), cA + kstep, voffA); PG8_STAGE(PG8_SB(1, 1), cB + hstep + kstep, voffB);
        PG8_WAIT_V(6); PG8_BAR;
    } else {
        PG8_STAGE(PG8_SB(0, 0), cB, voffB); PG8_STAGE(PG8_SA(0, 0), cA, voffA); PG8_STAGE(PG8_SB(0, 1), cB + hstep, voffB); PG8_STAGE(PG8_SA(0, 1), cA + hstep, voffA);
        if (wr == 1) PG8_BAR;
        PG8_WAIT_V(4); PG8_BAR;
        PG8_STAGE(PG8_SB(1, 0), cB + kstep, voffB); PG8_STAGE(PG8_SA(1, 0), cA + kstep, voffA); PG8_STAGE(PG8_SB(1, 1), cB + hstep + kstep, voffB);
        PG8_WAIT_V(6); PG8_BAR;
    }
    for (;;) {
        const bool has_next = S.next(ui + 1, nxt);
        const char* nA = has_next ? (const char*)g.A + (size_t)nxt.pm * tstep : cA; const char* nB = has_next ? (const char*)g.Bt + (size_t)nxt.pn * tstep : cB;
        for (int t = 0; t < nt; t += 2) {
            const bool last = (t == nt - 2);
            const char* a1 = cA + (size_t)(t + 1) * kstep;
            const char* a2 = last ? nA : cA + (size_t)(t + 2) * kstep; const char* b2 = last ? nB : cB + (size_t)(t + 2) * kstep;
            const char* a3 = a2 + kstep; const char* b3 = b2 + kstep;
            if (last && has_next) S.a_ready(nxt);
            if constexpr (SP2) {
            PG8_LDB(B0, 0, 0); PG8_LDB(B1, 0, 1); PG8_SCHED; PG8_LDA(At, 0, 0); PG8_STAGE(PG8_SA(1, 1), a1 + hstep, voffA);
            PG8_WAIT_V(8); PG8_WAIT_L(0); PG8_BAR; PG8_MMA(0, 0, At, B0); PG8_MMA(0, 1, At, B1); PG8_BAR; PG8_SCHED;
            PG8_LDA(At, 0, 1); PG8_STAGE(PG8_SB(0, 0), b2, voffB); PG8_STAGE(PG8_SB(0, 1), b2 + hstep, voffB); PG8_STAGE(PG8_SA(0, 0), a2, voffA);
            PG8_WAIT_V(8); PG8_WAIT_L(0); PG8_BAR; PG8_MMA(1, 0, At, B0); PG8_MMA(1, 1, At, B1); PG8_BAR; PG8_SCHED;
            PG8_LDB(B0, 1, 0); PG8_LDB(B1, 1, 1); PG8_SCHED; PG8_LDA(At, 1, 0); PG8_STAGE(PG8_SA(0, 1), a2 + hstep, voffA);
            PG8_WAIT_V(8); PG8_WAIT_L(0); PG8_BAR; PG8_MMA(0, 0, At, B0); PG8_MMA(0, 1, At, B1); PG8_BAR; PG8_SCHED;
            PG8_LDA(At, 1, 1); PG8_STAGE(PG8_SB(1, 0), b3, voffB); PG8_STAGE(PG8_SB(1, 1), b3 + hstep, voffB); PG8_STAGE(PG8_SA(1, 0), a3, voffA);
            PG8_WAIT_V(8); PG8_WAIT_L(0); PG8_BAR; PG8_MMA(1, 0, At, B0); PG8_MMA(1, 1, At, B1); PG8_BAR; PG8_SCHED;
            } else {
            PG8_LDB(B0, 0, 0); PG8_SCHED; PG8_LDA(At, 0, 0); PG8_STAGE(PG8_SA(1, 1), a1 + hstep, voffA);
            PG8_WAIT_L(8); PG8_BAR; PG8_WAIT_L(0); PG8_MMA(0, 0, At, B0); PG8_BAR; PG8_SCHED;
            PG8_LDB(B1, 0, 1); PG8_STAGE(PG8_SB(0, 0), b2, voffB);
            PG8_BAR; PG8_WAIT_L(0); PG8_MMA(0, 1, At, B1); PG8_BAR;
            PG8_LDA(At, 0, 1); PG8_STAGE(PG8_SA(0, 0), a2, voffA);
            PG8_BAR; PG8_WAIT_L(0); PG8_MMA(1, 0, At, B0); PG8_BAR; PG8_SCHED;
            PG8_STAGE(PG8_SB(0, 1), b2 + hstep, voffB);
            PG8_WAIT_V(6); PG8_BAR; PG8_MMA(1, 1, At, B1); PG8_BAR;
            PG8_LDB(B0, 1, 0); PG8_SCHED; PG8_LDA(At, 1, 0); PG8_STAGE(PG8_SA(0, 1), a2 + hstep, voffA);
            PG8_WAIT_L(8); PG8_BAR; PG8_WAIT_L(0); PG8_MMA(0, 0, At, B0); PG8_BAR; PG8_SCHED;
            PG8_LDB(B1, 1, 1); PG8_STAGE(PG8_SB(1, 0), b3, voffB);
            PG8_BAR; PG8_WAIT_L(0); PG8_MMA(0, 1, At, B1); PG8_BAR;
            PG8_LDA(At, 1, 1); PG8_STAGE(PG8_SA(1, 0), a3, voffA);
            PG8_BAR; PG8_WAIT_L(0); PG8_MMA(1, 0, At, B0); PG8_BAR; PG8_SCHED;
            PG8_STAGE(PG8_SB(1, 1), b3 + hstep, voffB);
            PG8_WAIT_V(6); PG8_BAR; PG8_MMA(1, 1, At, B1); PG8_BAR;
            }
        }
        if constexpr (ALIGN_EPI) { if (wr == 0) PG8_BAR; }
        if constexpr (!Epi::AFTER_DRAIN) { E(acc, cur, wr, wc, fr, fq); S.done(cur); }
        if (!has_next) break;
#pragma unroll
        for (int a = 0; a < 2; ++a)
#pragma unroll
            for (int b = 0; b < 2; ++b)
#pragma unroll
                for (int m = 0; m < 4; ++m)
#pragma unroll
                    for (int n = 0; n < 2; ++n) acc[a][b][m][n] = (f32x4){0.f, 0.f, 0.f, 0.f};
        cur = nxt; cA = nA; cB = nB; ++ui;
        if constexpr (ALIGN_EPI) { if (wr == 1) PG8_BAR; }
    }
    PG8_WAIT_V(0);
    if constexpr (!ALIGN_EPI) { if (wr == 0) PG8_BAR; }
    PG8_BAR;
    if constexpr (Epi::AFTER_DRAIN) { E.fused(acc, cur, wr, wc, fr, fq, lds, wid, lane); S.done(cur); }
#undef PG8_SA
#undef PG8_SB
#undef PG8_STAGE
#undef PG8_LDA
#undef PG8_LDB
#undef PG8_MMA
#undef PG8_WAIT_V
#undef PG8_WAIT_L
#undef PG8_BAR
#undef PG8_SCHED
}
}

#ifndef MK_PER_PHASE
#define MK_PER_PHASE 0
#endif
#ifndef USE_PG8
#define USE_PG8 1
#endif
constexpr int NWAVES = 8, NTHR = 512;

constexpr int B_ = 16, S_ = 2048, D_ = 1024, T_ = B_ * S_;
constexpr int INC = 5640, NPROJ = 5632;
constexpr int NEXP = 16384;
constexpr float EPS = 1e-6f;

constexpr size_t MiB = 1u << 20;
constexpr size_t WS_CTL = 0, CTL_ZERO_BYTES = 1 * MiB;
constexpr size_t WS_W1T = 2 * MiB, WS_WSBT = 13 * MiB, WS_WMLT = 14 * MiB, WS_WOUTT = 15 * MiB, WS_WCT = 17 * MiB, WS_IFG = 21 * MiB;
constexpr size_t WS_U16 = 24 * MiB, WS_V16 = 56 * MiB;
constexpr size_t WS_XN = 88 * MiB, WS_YSB = 88 * MiB, WS_YML = 120 * MiB;
constexpr size_t WS_SBQKV = 152 * MiB  , WS_VT = 216 * MiB  , WS_MLQK = 248 * MiB, WS_MLV = 312 * MiB, WS_MLO = 344 * MiB, WS_GATES = 376 * MiB;
constexpr size_t WS_MERGED = 216 * MiB, WS_H = 88 * MiB, WS_HN = 216 * MiB, WS_IDX = 280 * MiB, WS_GATE = 296 * MiB, WS_SC = 312 * MiB;
constexpr size_t WS_END = 504 * MiB;
constexpr int CW_BAR = 4096, CW_Q = 8192;

constexpr int RING_OFF = 0, RING_BYTES = 131072;
constexpr int LDSCTL_OFF = RING_BYTES, MISC_OFF = LDSCTL_OFF + 320;
constexpr int LDS_BYTES = 147456;

#define GAS __attribute__((address_space(1)))
#define LAS __attribute__((address_space(3)))
typedef unsigned short bf16;
typedef unsigned v4u __attribute__((ext_vector_type(4)));
typedef unsigned v2u __attribute__((ext_vector_type(2)));
typedef float f32x4 __attribute__((ext_vector_type(4)));
#define LDS_WAIT() asm volatile("s_waitcnt lgkmcnt(0)" ::: "memory")
#define VM_WAIT() asm volatile("s_waitcnt vmcnt(0)" ::: "memory")
__device__ __forceinline__ unsigned f2bf(float f) { unsigned u = __builtin_bit_cast(unsigned, f); return (u + 0x7fffu + ((u >> 16) & 1u)) >> 16; }
__device__ __forceinline__ unsigned pk2(float lo, float hi) { return f2bf(lo) | (f2bf(hi) << 16); }
__device__ __forceinline__ float bflo(unsigned u) { return __builtin_bit_cast(float, u << 16); }
__device__ __forceinline__ float bfhi(unsigned u) { return __builtin_bit_cast(float, u & 0xffff0000u); }
__device__ __forceinline__ float bf2f(bf16 b) { return __builtin_bit_cast(float, (unsigned)b << 16); }
__device__ __forceinline__ float sigmoidf_(float x) { return 1.f / (1.f + __expf(-x)); }
__device__ __forceinline__ float wave_sum(float v) {
#pragma unroll
    for (int o = 1; o < 64; o <<= 1) v += __shfl_xor(v, o);
    return v;
}
__device__ __forceinline__ unsigned wave_max_u(unsigned v) {
#pragma unroll
    for (int o = 1; o < 64; o <<= 1) { const unsigned w = (unsigned)__shfl_xor((int)v, o); v = v > w ? v : w; }
    return v;
}
struct F8 { float v[8]; };
__device__ __forceinline__ void unpack8(const v4u& u, float (&f)[8]) {
    f[0] = bflo(u.x); f[1] = bfhi(u.x); f[2] = bflo(u.y); f[3] = bfhi(u.y); f[4] = bflo(u.z); f[5] = bfhi(u.z); f[6] = bflo(u.w); f[7] = bfhi(u.w);
}
__device__ __forceinline__ v4u pack8(const float (&f)[8]) { v4u o; o.x = pk2(f[0], f[1]); o.y = pk2(f[2], f[3]); o.z = pk2(f[4], f[5]); o.w = pk2(f[6], f[7]); return o; }

#define XB_TMO      128
#define XB_XCNT(j)  (256  + 64 * (j))
#define XB_XSUB(j)  (1280 + 64 * (j))
#define XB_XGEN(j)  (2304 + 64 * (j))
#define XB_TOP      3328
#define XB_TOPGEN   3392
#define XCD_BAR_WORDS 3456
#define XB_SPIN_CAP (1u << 24)

__device__ __forceinline__ unsigned xb_ld(unsigned* p)              { return __hip_atomic_load(p, __ATOMIC_RELAXED, __HIP_MEMORY_SCOPE_AGENT); }
__device__ __forceinline__ unsigned xb_add(unsigned* p, unsigned v) { return __hip_atomic_fetch_add(p, v, __ATOMIC_RELAXED, __HIP_MEMORY_SCOPE_AGENT); }
__device__ __forceinline__ unsigned xb_xcc_id() { return (unsigned)__builtin_amdgcn_s_getreg((3 << 11) | 20) & 0xFu; }
#define XB_SPIN(cond, bar) do { unsigned _sp = 0; while (cond) { __builtin_amdgcn_s_sleep(1); \
    if ((++_sp & 255u) == 0u) { if (xb_ld(&(bar)[XB_TMO])) break; if (_sp > XB_SPIN_CAP) { atomicAdd(&(bar)[XB_TMO], 1u); break; } } } } while (0)

struct XcdBarrier {
    unsigned* bar; unsigned x;
    volatile LAS unsigned* st;
};

__device__ __forceinline__ XcdBarrier xcd_barrier_post(unsigned* bar, volatile LAS unsigned* st) {
    XcdBarrier b; b.bar = bar; b.x = xb_xcc_id(); b.st = st;
    if (threadIdx.x == 0) (void)xb_add(&bar[XB_XCNT(b.x)], 1u);
    return b;
}
__device__ __forceinline__ void xcd_barrier_complete(unsigned* bar, unsigned x, unsigned& nloc, unsigned& nx) {
    const unsigned G = gridDim.x * gridDim.y * gridDim.z;
    unsigned sum, cnt, mine, sp = 0u;
    for (;;) {
        sum = 0u; cnt = 0u; mine = 0u;
#pragma unroll
        for (unsigned j = 0; j < 16; ++j) { const unsigned c = xb_ld(&bar[XB_XCNT(j)]); sum += c; cnt += (c > 0u) ? 1u : 0u; mine = (j == x) ? c : mine; }
        if (sum == G) break;
        __builtin_amdgcn_s_sleep(1);
        if ((++sp & 255u) == 0u) { if (xb_ld(&bar[XB_TMO])) break; if (sp > XB_SPIN_CAP) { atomicAdd(&bar[XB_TMO], 1u); break; } }
    }
    nloc = mine > 0u ? mine : 1u; nx = cnt > 0u ? cnt : 1u;
}

__device__ __forceinline__ void xcd_barrier(const XcdBarrier& b) {
    asm volatile("s_waitcnt vmcnt(0)" ::: "memory");
    __syncthreads();
    if (threadIdx.x == 0) {
        unsigned* bar = b.bar;
        __builtin_amdgcn_s_waitcnt(0);
        unsigned nloc = b.st[0], nx = b.st[1];
        if (nloc == 0u) { xcd_barrier_complete(bar, b.x, nloc, nx); b.st[0] = nloc; b.st[1] = nx; }
        const unsigned old = xb_add(&bar[XB_XSUB(b.x)], 1u);
        const unsigned gen = old / nloc;
        if (old + 1u == (gen + 1u) * nloc) {
            __builtin_amdgcn_fence(__ATOMIC_RELEASE, "agent");
            asm volatile("s_waitcnt vmcnt(0)" ::: "memory");
            const unsigned og = xb_add(&bar[XB_TOP], 1u);
            const unsigned tg = og / nx;
            if (og + 1u == (tg + 1u) * nx) xb_add(&bar[XB_TOPGEN], 1u);
            else XB_SPIN(xb_ld(&bar[XB_TOPGEN]) == tg, bar);
            __builtin_amdgcn_fence(__ATOMIC_ACQUIRE, "agent");
            xb_add(&bar[XB_XGEN(b.x)], 1u);
            asm volatile("s_waitcnt vmcnt(0)" ::: "memory");
        } else {
            XB_SPIN(xb_ld(&bar[XB_XGEN(b.x)]) == gen, bar);
            __builtin_amdgcn_fence(__ATOMIC_ACQUIRE, "agent");
            asm volatile("s_waitcnt vmcnt(0)" ::: "memory");
        }
    }
    __syncthreads();
}

struct EpiProj {
    bf16 *sbqk, *vt, *mlqk, *mlv, *mlo, *gates;
    __device__ __forceinline__ void operator()(int row, int col, const F8& a) const {
        bf16* dst;
        if (col < 1024) dst = sbqk + (size_t)row * 1024 + col;
        else if (col < 1536) {
            const int c = col - 1024, hh = c >> 6, d = c & 63, b = row >> 11, sq = row & 2047;
            bf16* vp = vt + ((size_t)(b * 8 + hh) * 64 + d) * 2048 + sq;
#pragma unroll
            for (int i = 0; i < 8; ++i) vp[(size_t)i * 2048] = (bf16)f2bf(a.v[i]);
            return;
        }
        else if (col < 2560) dst = mlqk + (size_t)row * 1024 + (col - 1536);
        else if (col < 3072) dst = mlv + (size_t)row * 512 + (col - 2560);
        else if (col < 3584) dst = mlo + (size_t)row * 512 + (col - 3072);
        else dst = gates + (size_t)row * 2048 + (col - 3584);
        *(v4u*)dst = pack8(a.v);
    }
};
struct EpiMergeA {
    bf16* merged; const bf16* gates;
    __device__ __forceinline__ void operator()(int row, int col, const F8& a) const {
        float g[8], o[8]; unpack8(*(const v4u*)(gates + (size_t)row * 2048 + col), g);
#pragma unroll
        for (int i = 0; i < 8; ++i) o[i] = sigmoidf_(g[i]) * a.v[i];
        *(v4u*)(merged + (size_t)row * 1024 + col) = pack8(o);
    }
};
struct EpiMergeB {
    bf16* merged; const bf16* gates;
    __device__ __forceinline__ void operator()(int row, int col, const F8& a) const {
        float g[8], o[8]; unpack8(*(const v4u*)(gates + (size_t)row * 2048 + 1024 + col), g);
        unpack8(*(const v4u*)(merged + (size_t)row * 1024 + col), o);
#pragma unroll
        for (int i = 0; i < 8; ++i) o[i] += sigmoidf_(g[i]) * a.v[i];
        *(v4u*)(merged + (size_t)row * 1024 + col) = pack8(o);
    }
};
struct EpiH {
    float* h; const float* x;
    __device__ __forceinline__ void operator()(int row, int col, const F8& a) const {
        const f32x4 x0 = *(const f32x4*)(x + (size_t)row * 1024 + col), x1 = *(const f32x4*)(x + (size_t)row * 1024 + col + 4);
        *(f32x4*)(h + (size_t)row * 1024 + col) = (f32x4){x0.x + a.v[0], x0.y + a.v[1], x0.z + a.v[2], x0.w + a.v[3]};
        *(f32x4*)(h + (size_t)row * 1024 + col + 4) = (f32x4){x1.x + a.v[4], x1.y + a.v[5], x1.z + a.v[6], x1.w + a.v[7]};
    }
};
struct EpiF32 {
    float* o; int ldc;
    __device__ __forceinline__ void operator()(int row, int col, const F8& a) const {
        *(f32x4*)(o + (size_t)row * ldc + col) = (f32x4){a.v[0], a.v[1], a.v[2], a.v[3]};
        *(f32x4*)(o + (size_t)row * ldc + col + 4) = (f32x4){a.v[4], a.v[5], a.v[6], a.v[7]};
    }
};

template <class E> struct EpiAdapt {
    static constexpr bool PERM = true, AFTER_DRAIN = false;
    E e;
    __device__ __forceinline__ void operator()(const pg8::f32x4 (&acc)[2][2][4][2], const pg8::Unit& u, int wr, int wc, int fr, int fq) const {
#pragma unroll
        for (int ai = 0; ai < 2; ++ai)
#pragma unroll
            for (int m = 0; m < 4; ++m) {
                const int row = u.pm * 256 + ai * 128 + wr * 64 + m * 16 + fr;
#pragma unroll
                for (int bj = 0; bj < 2; ++bj) {
                    const int col = u.pn * 256 + bj * 128 + wc * 32 + 8 * fq;
                    F8 a; const pg8::f32x4 v0 = acc[ai][bj][m][0], v1 = acc[ai][bj][m][1];
                    a.v[0] = v0[0]; a.v[1] = v0[1]; a.v[2] = v0[2]; a.v[3] = v0[3]; a.v[4] = v1[0]; a.v[5] = v1[1]; a.v[6] = v1[2]; a.v[7] = v1[3];
                    e(row, col, a);
                }
            }
    }
};

template <class E>
__device__ __forceinline__ void simple_gemm(LAS unsigned char* lds, const bf16* A, const bf16* Bt, int M, int N, int K, const E& e) {
    LAS float* As = (LAS float*)lds;
    LAS float* Bs = As + 32 * 132;
    const int tid = threadIdx.x, ty = tid >> 4, tx = tid & 15;
    const int ntn = N / 128, ntiles = (M / 128) * ntn;
    for (int tile = blockIdx.x; tile < ntiles; tile += gridDim.x) {
        const int tm = tile / ntn, tn = tile % ntn;
        float acc[4][8];
#pragma unroll
        for (int i = 0; i < 4; ++i)
#pragma unroll
            for (int j = 0; j < 8; ++j) acc[i][j] = 0.f;
        for (int k0 = 0; k0 < K; k0 += 32) {
            {
                const int r = tid >> 2, kq = (tid & 3) * 8;
                float fa[8], fb[8];
                unpack8(*(const v4u*)(A + (size_t)(tm * 128 + r) * K + k0 + kq), fa);
                unpack8(*(const v4u*)(Bt + (size_t)(tn * 128 + r) * K + k0 + kq), fb);
#pragma unroll
                for (int i = 0; i < 8; ++i) { As[(kq + i) * 132 + r] = fa[i]; Bs[(kq + i) * 132 + r] = fb[i]; }
            }
            __syncthreads();
#pragma unroll 8
            for (int k = 0; k < 32; ++k) {
                const f32x4 a4 = *(const LAS f32x4*)(As + k * 132 + ty * 4);
                const f32x4 b0 = *(const LAS f32x4*)(Bs + k * 132 + tx * 8), b1 = *(const LAS f32x4*)(Bs + k * 132 + tx * 8 + 4);
                const float av[4] = {a4.x, a4.y, a4.z, a4.w};
                const float bv[8] = {b0.x, b0.y, b0.z, b0.w, b1.x, b1.y, b1.z, b1.w};
#pragma unroll
                for (int i = 0; i < 4; ++i)
#pragma unroll
                    for (int j = 0; j < 8; ++j) acc[i][j] += av[i] * bv[j];
            }
            __syncthreads();
        }
#pragma unroll
        for (int i = 0; i < 4; ++i) {
            F8 a;
#pragma unroll
            for (int j = 0; j < 8; ++j) a.v[j] = acc[i][j];
            e(tm * 128 + ty * 4 + i, tn * 128 + tx * 8, a);
        }
    }
}

template <class E>
__device__ __forceinline__ void gemm(LAS unsigned char* lds, const bf16* A, const bf16* Bt, int M, int N, int K, const E& e) {
#if USE_PG8
    pg8::Gemm g{A, Bt, M, N, K}; pg8::StaticOrder S; S.init(M, N, (int)gridDim.x, (int)blockIdx.x);
    EpiAdapt<E> ea{e};
    pg8::gemm_phase<EpiAdapt<E>, pg8::StaticOrder, true, true>(lds, g, S, ea);
#else
    simple_gemm<E>(lds, A, Bt, M, N, K, e);
#endif
}

__device__ __forceinline__ void transpose_item(const float* W, int ldw, int K, bf16* WT, int src_col0, int dst_row0, LAS float* scr, int kb, int lane) {
    const int k0 = 64 * kb;
#pragma unroll 8
    for (int i = 0; i < 32; ++i) { const int kk = 2 * i + (lane >> 5); scr[kk * 33 + (lane & 31)] = W[(size_t)(k0 + kk) * ldw + src_col0 + (lane & 31)]; }
    LDS_WAIT(); asm volatile("" ::: "memory");
    const int c = lane & 7;
#pragma unroll
    for (int j = 0; j < 4; ++j) { const int n = (lane >> 3) + 8 * j; const LAS float* s = scr + (8 * c) * 33 + n;
        v4u o; o.x = pk2(s[0 * 33], s[1 * 33]); o.y = pk2(s[2 * 33], s[3 * 33]); o.z = pk2(s[4 * 33], s[5 * 33]); o.w = pk2(s[6 * 33], s[7 * 33]);
        *(v4u*)(WT + (size_t)(dst_row0 + n) * K + k0 + 8 * c) = o; }
    LDS_WAIT(); asm volatile("" ::: "memory");
}

struct P {
    const float *x, *norm_mix_w, *w_in, *conv_w, *conv_b, *b_i, *b_f, *ml_norm_w, *w_sb, *w_ml, *w_out, *norm_ffn_w, *w_query, *keys1, *keys2, *peer_u, *peer_v, *norm_final_w;
    float* out; unsigned char* ws;
};

__device__ __forceinline__ void p0_prologue(const P& p, LAS unsigned char* lds, int wave, int lane) {
    LAS float* scr = (LAS float*)(lds + wave * 16384);
    const int gw = blockIdx.x * NWAVES + wave, NGW = gridDim.x * NWAVES;
    bf16* W1T = (bf16*)(p.ws + WS_W1T); bf16* WSBT = (bf16*)(p.ws + WS_WSBT); bf16* WMLT = (bf16*)(p.ws + WS_WMLT); bf16* WOUTT = (bf16*)(p.ws + WS_WOUTT); bf16* WCT = (bf16*)(p.ws + WS_WCT);
    constexpr int I_1 = 16 * 176, I_SB = 8 * 32, I_ML = 8 * 32, I_O = 16 * 32, NT = I_1 + I_SB + I_ML + I_O;
    for (int it = gw; it < NT; it += NGW) {
        int r = it;
        if (r < I_1) { const int kb = r / 176, nb = r % 176, n0 = nb * 32; transpose_item(p.w_in, INC, 1024, W1T, n0 < 3584 ? n0 : n0 + 8, n0, scr, kb, lane); continue; } r -= I_1;
        if (r < I_SB) { const int kb = r / 32, nb = r % 32; transpose_item(p.w_sb, 1024, 512, WSBT, nb * 32, nb * 32, scr, kb, lane); continue; } r -= I_SB;
        if (r < I_ML) { const int kb = r / 32, nb = r % 32; transpose_item(p.w_ml, 1024, 512, WMLT, nb * 32, nb * 32, scr, kb, lane); continue; } r -= I_ML;
        { const int kb = r / 32, nb = r % 32; transpose_item(p.w_out, 1024, 1024, WOUTT, nb * 32, nb * 32, scr, kb, lane); }
    }
    for (int it = gw; it < 2048 * 16; it += NGW) {
        const int col = it >> 4, kb = it & 15, head = col >> 8, half = (col >> 7) & 1, key = col & 127, k = kb * 64 + lane;
        const float* kr = (half ? p.keys2 : p.keys1) + ((size_t)head * 128 + key) * 128;
        const float* wq = p.w_query + (size_t)k * 2048 + head * 256 + half * 128;
        float acc = 0.f;
#pragma unroll 4
        for (int d = 0; d < 128; d += 4) { const f32x4 a = *(const f32x4*)(wq + d), b = *(const f32x4*)(kr + d); acc += a.x * b.x + a.y * b.y + a.z * b.z + a.w * b.w; }
        WCT[(size_t)col * 1024 + k] = (bf16)f2bf(acc);
    }
    bf16* XN = (bf16*)(p.ws + WS_XN); float* IFG = (float*)(p.ws + WS_IFG);
    for (int m = gw; m < T_; m += NGW) {
        const f32x4* xr = (const f32x4*)(p.x + (size_t)m * 1024) + lane;
        const f32x4* wr = (const f32x4*)p.norm_mix_w + lane;
        f32x4 v[4]; float ss = 0.f;
#pragma unroll
        for (int j = 0; j < 4; ++j) { v[j] = xr[64 * j]; ss += (v[j].x * v[j].x + v[j].y * v[j].y) + (v[j].z * v[j].z + v[j].w * v[j].w); }
        const float rstd = 1.f / sqrtf(wave_sum(ss) * (1.f / 1024.f) + EPS);
        float g[8];
#pragma unroll
        for (int i = 0; i < 8; ++i) g[i] = 0.f;
        v2u* o8 = (v2u*)(XN + (size_t)m * 1024) + lane;
#pragma unroll
        for (int j = 0; j < 4; ++j) {
            const f32x4 w = wr[64 * j];
            const float y[4] = {v[j].x * rstd * w.x, v[j].y * rstd * w.y, v[j].z * rstd * w.z, v[j].w * rstd * w.w};
            o8[64 * j] = (v2u){pk2(y[0], y[1]), pk2(y[2], y[3])};
#pragma unroll
            for (int q = 0; q < 4; ++q) {
                const int k = 256 * j + 4 * lane + q;
                const f32x4 w0 = *(const f32x4*)(p.w_in + (size_t)k * INC + 3584), w1 = *(const f32x4*)(p.w_in + (size_t)k * INC + 3588);
                g[0] += y[q] * w0.x; g[1] += y[q] * w0.y; g[2] += y[q] * w0.z; g[3] += y[q] * w0.w;
                g[4] += y[q] * w1.x; g[5] += y[q] * w1.y; g[6] += y[q] * w1.z; g[7] += y[q] * w1.w;
            }
        }
#pragma unroll
        for (int i = 0; i < 8; ++i) g[i] = wave_sum(g[i]);
        if (lane == 0) {
#pragma unroll
            for (int i = 0; i < 4; ++i) { IFG[(size_t)m * 8 + i] = g[i] + p.b_i[i]; IFG[(size_t)m * 8 + 4 + i] = g[4 + i] + p.b_f[i]; }
        }
    }
    {
        const size_t n8 = (size_t)NEXP * 1024 / 8, gt = (size_t)blockIdx.x * NTHR + threadIdx.x, NG = (size_t)gridDim.x * NTHR;
        v4u* U16 = (v4u*)(p.ws + WS_U16); v4u* V16 = (v4u*)(p.ws + WS_V16);
        for (size_t i = gt; i < n8; i += NG) {
            const f32x4 a = ((const f32x4*)p.peer_u)[2 * i], b = ((const f32x4*)p.peer_u)[2 * i + 1];
            U16[i] = (v4u){pk2(a.x, a.y), pk2(a.z, a.w), pk2(b.x, b.y), pk2(b.z, b.w)};
            const f32x4 c = ((const f32x4*)p.peer_v)[2 * i], d = ((const f32x4*)p.peer_v)[2 * i + 1];
            V16[i] = (v4u){pk2(c.x, c.y), pk2(c.z, c.w), pk2(d.x, d.y), pk2(d.z, d.w)};
        }
    }
}

typedef short bf16x8 __attribute__((ext_vector_type(8)));
typedef float f32x16 __attribute__((ext_vector_type(16)));
typedef float f32x2_t __attribute__((ext_vector_type(2))); typedef __bf16 bf16x2_t __attribute__((ext_vector_type(2)));
__device__ __forceinline__ unsigned cvtpk(float lo, float hi) { f32x2_t v = {lo, hi}; bf16x2_t b = __builtin_convertvector(v, bf16x2_t); return __builtin_bit_cast(unsigned, b); }
#define MFMA32(a, b, c) __builtin_amdgcn_mfma_f32_32x32x16_bf16((a), (b), (c), 0, 0, 0)
__device__ __forceinline__ int crow(int reg, int hh) { return (reg & 3) + 8 * (reg >> 2) + 4 * hh; }
template <int S> __device__ __forceinline__ bf16x8 pack_step(const f32x16& x) {
    v4u p; p.x = cvtpk(x[8 * S], x[8 * S + 1]); p.y = cvtpk(x[8 * S + 2], x[8 * S + 3]); p.z = cvtpk(x[8 * S + 4], x[8 * S + 5]); p.w = cvtpk(x[8 * S + 6], x[8 * S + 7]);
    return __builtin_bit_cast(bf16x8, p);
}
__device__ __forceinline__ bf16x8 frag2(const v2u& lo, const v2u& hi) { v4u p; p.x = lo.x; p.y = lo.y; p.z = hi.x; p.w = hi.y; return __builtin_bit_cast(bf16x8, p); }
__device__ __forceinline__ f32x16 zero16() { f32x16 z; for (int i = 0; i < 16; ++i) z[i] = 0.f; return z; }


constexpr int ML_QS = 0, ML_KS = 17408, ML_KWT = 34816, ML_VTL = 53248, ML_PS = 71680, ML_CT = 80896, ML_SCAL = 115712, ML_SSP = 118272, ML_QN = ML_SSP + 512, ML_F1 = ML_QN + 256, ML_F2 = ML_F1 + 256, ML_NV = ML_F2 + 256;
static_assert(ML_NV + 512 <= RING_BYTES, "mLSTM LDS map");
__device__ __forceinline__ void mlstm_scal(const float* IFG, int b, int h, int c, LAS float* sc, float& m_carry, int lane) {
    const size_t tok = (size_t)b * S_ + c * 64 + lane;
    const float ip = IFG[tok * 8 + h], fp = IFG[tok * 8 + 4 + h];
    const float lf = fminf(fp, 0.f) - log1pf(expf(-fabsf(fp)));
    float bc = lf;
#pragma unroll
    for (int o = 1; o < 64; o <<= 1) { const float t2 = __shfl_up(bc, o); if (lane >= o) bc += t2; }
    const float a = ip - bc; float pm = a;
#pragma unroll
    for (int o = 1; o < 64; o <<= 1) { const float t2 = __shfl_up(pm, o); if (lane >= o) pm = fmaxf(pm, t2); }
    const float M = fmaxf(m_carry, pm);
    const float M63 = __shfl(M, 63), bc63 = __shfl(bc, 63);
    sc[lane] = a; sc[64 + lane] = M; sc[128 + lane] = expf(a - M63); sc[192 + lane] = expf(m_carry - M); sc[256 + lane] = expf(-(bc + M));
    m_carry = bc63 + M63;
}
__device__ __forceinline__ void mlstm_item(const P& p, LAS unsigned char* lds, int item, int tid, int wave, int lane) {
    const int b = item >> 2, h = item & 3;
    const int r = lane & 31, hh = lane >> 5, et = wave & 3, th = wave >> 2;
    const bf16* MLQK = (const bf16*)(p.ws + WS_MLQK); const bf16* MLV = (const bf16*)(p.ws + WS_MLV); const float* IFG = (const float*)(p.ws + WS_IFG);
    bf16* HML = (bf16*)(p.ws + WS_YML);
    LAS float* SCAL = (LAS float*)(lds + ML_SCAL); LAS float* SSP = (LAS float*)(lds + ML_SSP); LAS float* QN = (LAS float*)(lds + ML_QN);
    LAS float* F1 = (LAS float*)(lds + ML_F1); LAS float* F2 = (LAS float*)(lds + ML_F2); LAS float* NV = (LAS float*)(lds + ML_NV);
    const int grp = tid & 31, rs = tid >> 5;
    const bool isk = grp >= 16;
    const int dch = 8 * (grp & 15);
    const int ch0 = (isk ? 512 : 0) + h * 128 + dch;
    float cw[4][8], cb[8];
#pragma unroll
    for (int i = 0; i < 8; ++i) { cb[i] = p.conv_b[ch0 + i];
#pragma unroll
        for (int j = 0; j < 4; ++j) cw[j][i] = p.conv_w[j * 1024 + ch0 + i]; }
    for (int i = tid; i < (128 * 136 * 2) / 4; i += NTHR) ((LAS unsigned*)(lds + ML_CT))[i] = 0u;
    if (tid < 128) NV[tid] = 0.f;
    f32x16 accC[2]; accC[0] = zero16(); accC[1] = zero16();
    float m_carry = 0.f;
    if (wave == 3) mlstm_scal(IFG, b, h, 0, SCAL, m_carry, lane);
    __syncthreads();
    for (int c = 0; c < 32; ++c) {
        const size_t tok0 = (size_t)b * S_ + c * 64;
        LAS float* sc = SCAL + (c & 1) * 320;
        {
            v4u xr[7];
#pragma unroll
            for (int k = 0; k < 7; ++k) { const int pos = c * 64 + 4 * rs + k - 3;
                xr[k] = pos >= 0 ? *(const v4u*)(MLQK + ((size_t)b * S_ + pos) * 1024 + ch0) : (v4u){0u, 0u, 0u, 0u}; }
            const int eg = tid & 15, sl = tid >> 4;
            const v4u v0 = *(const v4u*)(MLV + (tok0 + sl) * 512 + h * 128 + 8 * eg), v1 = *(const v4u*)(MLV + (tok0 + sl + 32) * 512 + h * 128 + 8 * eg);
#pragma unroll
            for (int tt = 0; tt < 4; ++tt) {
                float y[8];
#pragma unroll
                for (int i = 0; i < 8; ++i) y[i] = cb[i];
#pragma unroll
                for (int j = 0; j < 4; ++j) { float f[8]; unpack8(xr[tt + j], f);
#pragma unroll
                    for (int i = 0; i < 8; ++i) y[i] += cw[j][i] * f[i]; }
                const int t = 4 * rs + tt;
#pragma unroll
                for (int i = 0; i < 8; ++i) y[i] = y[i] * sigmoidf_(y[i]);
                if (!isk) { *(LAS v4u*)(lds + ML_QS + t * 272 + dch * 2) = pack8(y); }
                else {
#pragma unroll
                    for (int i = 0; i < 8; ++i) y[i] *= 0.08838834764831845f;
                    *(LAS v4u*)(lds + ML_KS + t * 272 + dch * 2) = pack8(y);
                    const float wk = sc[128 + t];
#pragma unroll
                    for (int i = 0; i < 8; ++i) *(LAS bf16*)(lds + ML_KWT + (dch + i) * 144 + t * 2) = (bf16)f2bf(y[i] * wk);
                }
            }
            {
                const unsigned vv0[4] = {v0.x, v0.y, v0.z, v0.w}, vv1[4] = {v1.x, v1.y, v1.z, v1.w};
#pragma unroll
                for (int i = 0; i < 4; ++i) {
                    *(LAS bf16*)(lds + ML_VTL + (8 * eg + 2 * i) * 144 + sl * 2) = (bf16)(vv0[i] & 0xffffu);
                    *(LAS bf16*)(lds + ML_VTL + (8 * eg + 2 * i + 1) * 144 + sl * 2) = (bf16)(vv0[i] >> 16);
                    *(LAS bf16*)(lds + ML_VTL + (8 * eg + 2 * i) * 144 + (sl + 32) * 2) = (bf16)(vv1[i] & 0xffffu);
                    *(LAS bf16*)(lds + ML_VTL + (8 * eg + 2 * i + 1) * 144 + (sl + 32) * 2) = (bf16)(vv1[i] >> 16);
                }
            }
        }
        __syncthreads();
        f32x16 acc_inter = zero16();
        if (wave < 3) {
            const int tt = wave > 0 ? 1 : 0, st = wave == 2 ? 1 : 0;
            f32x16 zt = zero16();
#pragma unroll
            for (int ks = 0; ks < 8; ++ks) {
                const bf16x8 ka = *(const LAS bf16x8*)(lds + ML_KS + (32 * st + r) * 272 + 32 * ks + 16 * hh);
                const bf16x8 qb = *(const LAS bf16x8*)(lds + ML_QS + (32 * tt + r) * 272 + 32 * ks + 16 * hh);
                zt = MFMA32(ka, qb, zt);
            }
            const int t = 32 * tt + r; const float Mt = sc[64 + t];
            float ps = 0.f;
#pragma unroll
            for (int g = 0; g < 4; ++g) {
                const f32x4 av = *(const LAS f32x4*)(sc + 32 * st + 8 * g + 4 * hh);
                float pv[4];
#pragma unroll
                for (int q = 0; q < 4; ++q) { const int sidx = 32 * st + 8 * g + 4 * hh + q;
                    const float wgt = sidx <= t ? expf(av[q] - Mt) : 0.f; pv[q] = zt[4 * g + q] * wgt; ps += pv[q]; }
                *(LAS v2u*)(lds + ML_PS + t * 144 + (32 * st + 8 * g + 4 * hh) * 2) = (v2u){cvtpk(pv[0], pv[1]), cvtpk(pv[2], pv[3])};
            }
            ps += __shfl_xor(ps, 32);
            if (hh == 0) { SSP[st * 64 + t] = ps; if (wave == 0) SSP[64 + t] = 0.f; }
        }
        if (wave == 3 && c + 1 < 32) mlstm_scal(IFG, b, h, c + 1, SCAL + ((c + 1) & 1) * 320, m_carry, lane);
#pragma unroll
        for (int ks = 0; ks < 8; ++ks) {
            const bf16x8 qa = *(const LAS bf16x8*)(lds + ML_QS + (32 * th + r) * 272 + 32 * ks + 16 * hh);
            const bf16x8 cbf = *(const LAS bf16x8*)(lds + ML_CT + (32 * et + r) * 272 + 32 * ks + 16 * hh);
            acc_inter = MFMA32(qa, cbf, acc_inter);
        }
        {
            const int t = tid >> 3, part = tid & 7;
            float f[8], sum = 0.f;
            { const v4u tq = *(const LAS v4u*)(lds + ML_QS + t * 272 + part * 32); unpack8(tq, f); }
#pragma unroll
            for (int i = 0; i < 8; ++i) sum += f[i] * NV[16 * part + i];
            { const v4u tq = *(const LAS v4u*)(lds + ML_QS + t * 272 + part * 32 + 16); unpack8(tq, f); }
#pragma unroll
            for (int i = 0; i < 8; ++i) sum += f[i] * NV[16 * part + 8 + i];
            sum += __shfl_xor(sum, 1); sum += __shfl_xor(sum, 2); sum += __shfl_xor(sum, 4);
            if (part == 0) QN[t] = sum;
        }
        __syncthreads();
        f32x16 acc_intra = zero16();
#pragma unroll
        for (int ks = 0; ks < 4; ++ks) {
            if (ks < 2 || th == 1) {
                const bf16x8 pa = *(const LAS bf16x8*)(lds + ML_PS + (32 * th + r) * 144 + 32 * ks + 16 * hh);
                const bf16x8 vb = *(const LAS bf16x8*)(lds + ML_VTL + (32 * et + r) * 144 + 32 * ks + 16 * hh);
                acc_intra = MFMA32(pa, vb, acc_intra);
            }
        }
        if (tid < 64) {
            const float wi = sc[192 + tid];
            const float den = SSP[tid] + SSP[64 + tid] + wi * QN[tid];
            const float f1 = 1.f / fmaxf(fabsf(den), sc[256 + tid]);
            F1[tid] = f1; F2[tid] = wi * f1;
        }
        const float decay = sc[192 + 63];
#pragma unroll
        for (int dt = 0; dt < 2; ++dt) {
#pragma unroll
            for (int i = 0; i < 16; ++i) accC[dt][i] *= decay;
#pragma unroll
            for (int ks = 0; ks < 4; ++ks) {
                const bf16x8 ka = *(const LAS bf16x8*)(lds + ML_KWT + (64 * th + 32 * dt + r) * 144 + 32 * ks + 16 * hh);
                const bf16x8 vb = *(const LAS bf16x8*)(lds + ML_VTL + (32 * et + r) * 144 + 32 * ks + 16 * hh);
                accC[dt] = MFMA32(ka, vb, accC[dt]);
            }
        }
        {
            const int d = tid >> 2, part = tid & 3;
            float f[8], sum = 0.f;
            { const v4u tq = *(const LAS v4u*)(lds + ML_KWT + d * 144 + part * 32); unpack8(tq, f); }
#pragma unroll
            for (int i = 0; i < 8; ++i) sum += f[i];
            { const v4u tq = *(const LAS v4u*)(lds + ML_KWT + d * 144 + part * 32 + 16); unpack8(tq, f); }
#pragma unroll
            for (int i = 0; i < 8; ++i) sum += f[i];
            sum += __shfl_xor(sum, 1); sum += __shfl_xor(sum, 2);
            if (part == 0) NV[d] = decay * NV[d] + sum;
        }
        __syncthreads();
        {
            bf16* hp = HML + (tok0 + 32 * th) * 512 + h * 128 + 32 * et + r;
#pragma unroll
            for (int g = 0; g < 4; ++g) {
                const f32x4 f1v = *(const LAS f32x4*)(F1 + 32 * th + 8 * g + 4 * hh), f2v = *(const LAS f32x4*)(F2 + 32 * th + 8 * g + 4 * hh);
#pragma unroll
                for (int q = 0; q < 4; ++q) { const int tl = 8 * g + 4 * hh + q;
                    hp[(size_t)tl * 512] = (bf16)f2bf(acc_intra[4 * g + q] * f1v[q] + acc_inter[4 * g + q] * f2v[q]); }
            }
#pragma unroll
            for (int dt = 0; dt < 2; ++dt)
#pragma unroll
                for (int g = 0; g < 4; ++g)
                    *(LAS v2u*)(lds + ML_CT + (32 * et + r) * 272 + (64 * th + 32 * dt + 8 * g + 4 * hh) * 2) = (v2u){cvtpk(accC[dt][4 * g], accC[dt][4 * g + 1]), cvtpk(accC[dt][4 * g + 2], accC[dt][4 * g + 3])};
        }
    }
    __syncthreads();
}

__device__ __forceinline__ void sba_wave_item(const bf16* __restrict__ QK, const bf16* __restrict__ VT, bf16* __restrict__ YSB, int b, int h, int qt, int lane) {
    const int r = lane & 31, hh = lane >> 5, t0 = qt * 32;
    const size_t rowbase = (size_t)b * S_;
    bf16x8 qf[4];
    {
        const bf16* qp = QK + (rowbase + t0 + r) * 1024 + h * 64 + 8 * hh;
#pragma unroll
        for (int ks = 0; ks < 4; ++ks) qf[ks] = *(const bf16x8*)(qp + 16 * ks);
    }
    bf16x8 tri[2];
#pragma unroll
    for (int s2 = 0; s2 < 2; ++s2)
#pragma unroll
        for (int j = 0; j < 8; ++j) { const int rho = 16 * s2 + 8 * (j >> 2) + 4 * hh + (j & 3); tri[s2][j] = (rho > r) ? (short)0x3F80 : (short)0; }
    f32x16 o0 = zero16(), o1 = zero16();
    float carry = 0.f;
    const bf16* kbase = QK + rowbase * 1024 + 512 + h * 64 + 8 * hh + (size_t)r * 1024;
    const bf16* vbase = VT + ((size_t)(b * 8 + h) * 64 + r) * 2048 + 4 * hh;
    bf16x8 kf[4]; v2u vl[2][2], vh[2][2];
#pragma unroll
    for (int ks = 0; ks < 4; ++ks) kf[ks] = *(const bf16x8*)(kbase + (size_t)t0 * 1024 + 16 * ks);
#pragma unroll
    for (int dt = 0; dt < 2; ++dt)
#pragma unroll
        for (int s2 = 0; s2 < 2; ++s2) { const bf16* vp = vbase + (size_t)dt * 32 * 2048 + t0 + 16 * s2; vl[dt][s2] = *(const v2u*)vp; vh[dt][s2] = *(const v2u*)(vp + 8); }
    for (int s0 = t0; s0 >= 0; s0 -= 32) {
        bf16x8 kn[4]; v2u vln[2][2], vhn[2][2];
        const int sn = s0 >= 32 ? s0 - 32 : 0;
#pragma unroll
        for (int ks = 0; ks < 4; ++ks) kn[ks] = *(const bf16x8*)(kbase + (size_t)sn * 1024 + 16 * ks);
#pragma unroll
        for (int dt = 0; dt < 2; ++dt)
#pragma unroll
            for (int s2 = 0; s2 < 2; ++s2) { const bf16* vp = vbase + (size_t)dt * 32 * 2048 + sn + 16 * s2; vln[dt][s2] = *(const v2u*)vp; vhn[dt][s2] = *(const v2u*)(vp + 8); }
        f32x16 z = zero16();
#pragma unroll
        for (int ks = 0; ks < 4; ++ks) z = MFMA32(kf[ks], qf[ks], z);
        const bool diag = (s0 == t0);
        f32x16 sp; float rs = 0.f;
#pragma unroll
        for (int i = 0; i < 16; ++i) {
            const float zz = z[i] * 0.125f;
            const bool valid = !diag || (crow(i, hh) < r);
            float spv = fmaxf(zz, 0.f) + __logf(1.f + __expf(-fabsf(zz)));
            spv = valid ? spv : 0.f;
            sp[i] = spv; rs += spv; z[i] = zz - spv;
        }
        f32x16 suf = zero16();
        suf = MFMA32(tri[0], pack_step<0>(sp), suf);
        suf = MFMA32(tri[1], pack_step<1>(sp), suf);
        f32x16 w;
#pragma unroll
        for (int i = 0; i < 16; ++i) {
            const bool valid = !diag || (crow(i, hh) < r);
            const float lw = z[i] - suf[i] - carry;
            w[i] = valid ? __expf(lw) : 0.f;
        }
        rs += __shfl_xor(rs, 32);
        carry += rs;
        const bf16x8 pa0 = pack_step<0>(w), pa1 = pack_step<1>(w);
        o0 = MFMA32(pa0, frag2(vl[0][0], vh[0][0]), o0); o0 = MFMA32(pa1, frag2(vl[0][1], vh[0][1]), o0);
        o1 = MFMA32(pa0, frag2(vl[1][0], vh[1][0]), o1); o1 = MFMA32(pa1, frag2(vl[1][1], vh[1][1]), o1);
        if (__all(carry > 104.f)) break;
#pragma unroll
        for (int ks = 0; ks < 4; ++ks) kf[ks] = kn[ks];
#pragma unroll
        for (int dt = 0; dt < 2; ++dt)
#pragma unroll
            for (int s2 = 0; s2 < 2; ++s2) { vl[dt][s2] = vln[dt][s2]; vh[dt][s2] = vhn[dt][s2]; }
    }
    bf16* op = YSB + (rowbase + t0) * 512 + h * 64 + r;
#pragma unroll
    for (int i = 0; i < 16; ++i) { const int t = crow(i, hh); op[(size_t)t * 512] = (bf16)f2bf(o0[i]); op[(size_t)t * 512 + 32] = (bf16)f2bf(o1[i]); }
}
__device__ __forceinline__ void sba_item(const P& p, int item, int wave, int lane) {
    const int bh = item >> 3, qb = item & 7, b = bh >> 3, h = bh & 7;
    sba_wave_item((const bf16*)(p.ws + WS_SBQKV), (const bf16*)(p.ws + WS_VT), (bf16*)(p.ws + WS_YSB), b, h, qb * 8 + wave, lane);
}

__device__ __forceinline__ void p3_yml(const P& p, int wave, int lane) {
    const int gw = blockIdx.x * NWAVES + wave, NGW = gridDim.x * NWAVES;
    bf16* YML = (bf16*)(p.ws + WS_YML); const bf16* MLO = (const bf16*)(p.ws + WS_MLO);
    for (int m = gw; m < T_; m += NGW) {
        float hv[8], ov[8], o[8];
        unpack8(*(const v4u*)(YML + (size_t)m * 512 + lane * 8), hv); unpack8(*(const v4u*)(MLO + (size_t)m * 512 + lane * 8), ov);
        float ss = 0.f;
#pragma unroll
        for (int i = 0; i < 8; ++i) ss += hv[i] * hv[i];
        ss += __shfl_xor(ss, 1); ss += __shfl_xor(ss, 2); ss += __shfl_xor(ss, 4); ss += __shfl_xor(ss, 8);
        const float rstd = 1.f / sqrtf(ss * (1.f / 128.f) + EPS);
        const f32x4 w0 = *(const f32x4*)(p.ml_norm_w + lane * 8), w1 = *(const f32x4*)(p.ml_norm_w + lane * 8 + 4);
        const float wv[8] = {w0.x, w0.y, w0.z, w0.w, w1.x, w1.y, w1.z, w1.w};
#pragma unroll
        for (int i = 0; i < 8; ++i) o[i] = sigmoidf_(ov[i]) * hv[i] * rstd * wv[i];
        *(v4u*)(YML + (size_t)m * 512 + lane * 8) = pack8(o);
    }
}

__device__ __forceinline__ void p6_hn(const P& p, int wave, int lane) {
    const int gw = blockIdx.x * NWAVES + wave, NGW = gridDim.x * NWAVES;
    const float* H = (const float*)(p.ws + WS_H); bf16* HN = (bf16*)(p.ws + WS_HN);
    for (int m = gw; m < T_; m += NGW) {
        const f32x4* xr = (const f32x4*)(H + (size_t)m * 1024) + lane; const f32x4* wr = (const f32x4*)p.norm_ffn_w + lane;
        f32x4 v[4]; float ss = 0.f;
#pragma unroll
        for (int j = 0; j < 4; ++j) { v[j] = xr[64 * j]; ss += (v[j].x * v[j].x + v[j].y * v[j].y) + (v[j].z * v[j].z + v[j].w * v[j].w); }
        const float rstd = 1.f / sqrtf(wave_sum(ss) * (1.f / 1024.f) + EPS);
        v2u* o8 = (v2u*)(HN + (size_t)m * 1024) + lane;
#pragma unroll
        for (int j = 0; j < 4; ++j) { const f32x4 w = wr[64 * j]; o8[64 * j] = (v2u){pk2(v[j].x * rstd * w.x, v[j].y * rstd * w.y), pk2(v[j].z * rstd * w.z, v[j].w * rstd * w.w)}; }
    }
}

__device__ __forceinline__ unsigned ord_key(float f) { const unsigned u = __builtin_bit_cast(unsigned, f); return (u & 0x80000000u) ? ~u : (u | 0x80000000u); }
__device__ __forceinline__ float ord_val(unsigned k) { const unsigned u = (k & 0x80000000u) ? (k & 0x7fffffffu) : ~k; return __builtin_bit_cast(float, u); }
template <int CTRL> __device__ __forceinline__ unsigned dpp_u(unsigned v) { return (unsigned)__builtin_amdgcn_update_dpp(0, (int)v, CTRL, 0xF, 0xF, true); }
__device__ __forceinline__ unsigned umax_(unsigned a, unsigned b) { return a > b ? a : b; }
__device__ __forceinline__ unsigned umin_(unsigned a, unsigned b) { return a < b ? a : b; }
__device__ __forceinline__ unsigned row_max_u(unsigned v) {
    v = umax_(v, dpp_u<0xB1>(v)); v = umax_(v, dpp_u<0x4E>(v)); v = umax_(v, dpp_u<0x141>(v)); v = umax_(v, dpp_u<0x140>(v)); return v;
}
__device__ __forceinline__ float row_sum_f(float v) {
    v += __builtin_bit_cast(float, dpp_u<0xB1>(__builtin_bit_cast(unsigned, v))); v += __builtin_bit_cast(float, dpp_u<0x4E>(__builtin_bit_cast(unsigned, v)));
    v += __builtin_bit_cast(float, dpp_u<0x141>(__builtin_bit_cast(unsigned, v))); v += __builtin_bit_cast(float, dpp_u<0x140>(__builtin_bit_cast(unsigned, v))); return v;
}
#define CE_(i, j) do { const unsigned _a = k[i], _b = k[j]; k[i] = umax_(_a, _b); k[j] = umin_(_a, _b); } while (0)
__device__ __forceinline__ unsigned row_top16(unsigned (&k)[8], unsigned (&top)[16], int li) {
    CE_(0, 1); CE_(2, 3); CE_(4, 5); CE_(6, 7); CE_(0, 2); CE_(1, 3); CE_(4, 6); CE_(5, 7); CE_(1, 2); CE_(5, 6);
    CE_(0, 4); CE_(1, 5); CE_(2, 6); CE_(3, 7); CE_(2, 4); CE_(3, 5); CE_(1, 2); CE_(3, 4); CE_(5, 6);
    unsigned mine = 0u;
#pragma unroll
    for (int n = 0; n < 16; ++n) {
        const unsigned m = row_max_u(k[0]);
        const bool hit = k[0] == m;
#pragma unroll
        for (int i = 0; i < 7; ++i) k[i] = hit ? k[i + 1] : k[i];
        k[7] = hit ? 0u : k[7];
        top[n] = m; mine = (li == n) ? m : mine;
    }
    return mine;
}
__device__ __forceinline__ void p8_topk(const P& p, int hh, int wave, int lane) {
    const int gw = blockIdx.x * NWAVES + wave, NGW = gridDim.x * NWAVES;
    const float* SC = (const float*)(p.ws + WS_SC); int* IDX = (int*)(p.ws + WS_IDX); float* GATE = (float*)(p.ws + WS_GATE);
    const int q = lane >> 4, li = lane & 15, head = hh * 4 + q;
    for (int m = gw; m < T_; m += NGW) {
        const float* sr = SC + (size_t)m * 1024 + q * 256;
        unsigned k[8], top1[16], top2[16];
#pragma unroll
        for (int j = 0; j < 8; ++j) k[j] = (ord_key(sr[li + 16 * j]) & ~0x7fu) | (unsigned)(127 - (li + 16 * j));
        const unsigned mine1 = row_top16(k, top1, li);
#pragma unroll
        for (int j = 0; j < 8; ++j) k[j] = (ord_key(sr[128 + li + 16 * j]) & ~0x7fu) | (unsigned)(127 - (li + 16 * j));
        const unsigned mine2 = row_top16(k, top2, li);
        const float v2 = ord_val(mine2 & ~0x7fu);
        unsigned c[16];
#pragma unroll
        for (int j = 0; j < 16; ++j) {
            const float v1 = ord_val(top1[j] & ~0x7fu);
            const unsigned key = (ord_key(v1 + v2) & ~0xffu) | (unsigned)(255 - (16 * j + li));
            c[j] = ((j + 1) * (li + 1) <= 16) ? key : 0u;
        }
        unsigned tk = 0u, t0 = 0u;
#pragma unroll
        for (int n = 0; n < 16; ++n) {
            const unsigned mx = row_max_u(c[0]);
            const bool hit = c[0] == mx;
#pragma unroll
            for (int i = 0; i < 15; ++i) c[i] = hit ? c[i + 1] : c[i];
            c[15] = hit ? 0u : c[15];
            if (n == 0) t0 = mx;
            tk = (li == n) ? mx : tk;
        }
        const float sv = ord_val(tk & ~0xffu), s0 = ord_val(t0 & ~0xffu);
        const int cc = 255 - (int)(tk & 0xffu), a = (cc >> 4) & 15, bb = cc & 15;
        const int i1 = 127 - (int)((unsigned)__shfl((int)mine1, (lane & 48) + a) & 0x7fu), i2 = 127 - (int)((unsigned)__shfl((int)mine2, (lane & 48) + bb) & 0x7fu);
        const float pe = expf(sv - s0);
        const float den = row_sum_f(pe);
        IDX[(size_t)m * 128 + head * 16 + li] = i1 * 128 + i2; GATE[(size_t)m * 128 + head * 16 + li] = pe / den;
    }
}

__device__ __forceinline__ float gelu_erf(float x) { return 0.5f * x * (1.f + erff(x * 0.70710678118654752f)); }
__device__ __forceinline__ void p9_peer(const P& p, int wave, int lane) {
    const int gw = blockIdx.x * NWAVES + wave, NGW = gridDim.x * NWAVES;
    const float* H = (const float*)(p.ws + WS_H); const bf16* HN = (const bf16*)(p.ws + WS_HN);
    const int* IDX = (const int*)(p.ws + WS_IDX); const float* GATE = (const float*)(p.ws + WS_GATE);
    const bf16* U16 = (const bf16*)(p.ws + WS_U16); const bf16* V16 = (const bf16*)(p.ws + WS_V16);
    for (int m = gw; m < T_; m += NGW) {
        float xv[16], acc[16];
        { float f[8]; unpack8(*(const v4u*)(HN + (size_t)m * 1024 + lane * 8), f);
#pragma unroll
          for (int i = 0; i < 8; ++i) xv[i] = f[i];
          unpack8(*(const v4u*)(HN + (size_t)m * 1024 + 512 + lane * 8), f);
#pragma unroll
          for (int i = 0; i < 8; ++i) xv[8 + i] = f[i]; }
#pragma unroll
        for (int i = 0; i < 16; ++i) acc[i] = 0.f;
        const int myidx0 = IDX[(size_t)m * 128 + lane], myidx1 = IDX[(size_t)m * 128 + 64 + lane];
        const float myg0 = GATE[(size_t)m * 128 + lane], myg1 = GATE[(size_t)m * 128 + 64 + lane];
#pragma unroll 1
        for (int j0 = 0; j0 < 128; j0 += 4) {
            float dots[4]; int ei[4]; float gi[4];
#pragma unroll
            for (int u = 0; u < 4; ++u) {
                const int j = j0 + u;
                ei[u] = __shfl(j < 64 ? myidx0 : myidx1, j & 63); gi[u] = __shfl(j < 64 ? myg0 : myg1, j & 63);
                float f[8], d = 0.f;
                unpack8(*(const v4u*)(U16 + (size_t)ei[u] * 1024 + lane * 8), f);
#pragma unroll
                for (int i = 0; i < 8; ++i) d += f[i] * xv[i];
                unpack8(*(const v4u*)(U16 + (size_t)ei[u] * 1024 + 512 + lane * 8), f);
#pragma unroll
                for (int i = 0; i < 8; ++i) d += f[i] * xv[8 + i];
                dots[u] = d;
            }
#pragma unroll
            for (int u = 0; u < 4; ++u) dots[u] = wave_sum(dots[u]);
#pragma unroll
            for (int u = 0; u < 4; ++u) {
                const float coef = gi[u] * gelu_erf(dots[u]);
                float f[8];
                unpack8(*(const v4u*)(V16 + (size_t)ei[u] * 1024 + lane * 8), f);
#pragma unroll
                for (int i = 0; i < 8; ++i) acc[i] += coef * f[i];
                unpack8(*(const v4u*)(V16 + (size_t)ei[u] * 1024 + 512 + lane * 8), f);
#pragma unroll
                for (int i = 0; i < 8; ++i) acc[8 + i] += coef * f[i];
            }
        }
        float y[16], ss = 0.f;
#pragma unroll
        for (int hb = 0; hb < 2; ++hb) {
            const f32x4 h0 = *(const f32x4*)(H + (size_t)m * 1024 + hb * 512 + lane * 8), h1 = *(const f32x4*)(H + (size_t)m * 1024 + hb * 512 + lane * 8 + 4);
            y[hb * 8 + 0] = h0.x + acc[hb * 8 + 0]; y[hb * 8 + 1] = h0.y + acc[hb * 8 + 1]; y[hb * 8 + 2] = h0.z + acc[hb * 8 + 2]; y[hb * 8 + 3] = h0.w + acc[hb * 8 + 3];
            y[hb * 8 + 4] = h1.x + acc[hb * 8 + 4]; y[hb * 8 + 5] = h1.y + acc[hb * 8 + 5]; y[hb * 8 + 6] = h1.z + acc[hb * 8 + 6]; y[hb * 8 + 7] = h1.w + acc[hb * 8 + 7];
        }
#pragma unroll
        for (int i = 0; i < 16; ++i) ss += y[i] * y[i];
        const float rstd = 1.f / sqrtf(wave_sum(ss) * (1.f / 1024.f) + EPS);
#pragma unroll
        for (int hb = 0; hb < 2; ++hb) {
            const f32x4 w0 = *(const f32x4*)(p.norm_final_w + hb * 512 + lane * 8), w1 = *(const f32x4*)(p.norm_final_w + hb * 512 + lane * 8 + 4);
            *(f32x4*)(p.out + (size_t)m * 1024 + hb * 512 + lane * 8) = (f32x4){y[hb * 8 + 0] * rstd * w0.x, y[hb * 8 + 1] * rstd * w0.y, y[hb * 8 + 2] * rstd * w0.z, y[hb * 8 + 3] * rstd * w0.w};
            *(f32x4*)(p.out + (size_t)m * 1024 + hb * 512 + lane * 8 + 4) = (f32x4){y[hb * 8 + 4] * rstd * w1.x, y[hb * 8 + 5] * rstd * w1.y, y[hb * 8 + 6] * rstd * w1.z, y[hb * 8 + 7] * rstd * w1.w};
        }
    }
}

constexpr int N_PHASES = 12;
struct Args { P p; int ph_lo, ph_hi; };
__global__ void __launch_bounds__(NTHR, 2) fwd_kernel(Args args) {
    extern __shared__ __attribute__((aligned(16))) unsigned char lds_raw[];
    LAS unsigned char* lds = (LAS unsigned char*)lds_raw;
    const P& p = args.p;
    const int tid = threadIdx.x, lane = tid & 63, wave = __builtin_amdgcn_readfirstlane(tid >> 6);
    volatile LAS unsigned* MISC = (volatile LAS unsigned*)(lds + MISC_OFF);
    for (int u = tid; u < (LDS_BYTES - LDSCTL_OFF) / 4; u += NTHR) ((LAS unsigned*)(lds + LDSCTL_OFF))[u] = 0u;
    __syncthreads();
    XcdBarrier bar; bar.bar = (unsigned*)(p.ws + WS_CTL) + CW_BAR; bar.x = 0; bar.st = nullptr;
#if !MK_PER_PHASE
    bar = xcd_barrier_post((unsigned*)(p.ws + WS_CTL) + CW_BAR, MISC + 8);
#endif
    const int lo = args.ph_lo, hi = args.ph_hi;
#define IN(k) (lo <= (k) && (k) < hi)
#define SEAM(k) do { if (IN(k) && IN((k) + 1)) xcd_barrier(bar); } while (0)

#ifndef PROBE_REP
#define PROBE_REP -1
#endif
#define REP(k) ((PROBE_REP == (k)) ? 2 : 1)
    if (IN(0)) {
#pragma unroll 1
        for (int r = 0; r < REP(0); ++r) p0_prologue(p, lds, wave, lane); } SEAM(0);
    if (IN(1)) {
#pragma unroll 1
      for (int r = 0; r < REP(1); ++r) {
        EpiProj e{(bf16*)(p.ws + WS_SBQKV), (bf16*)(p.ws + WS_VT), (bf16*)(p.ws + WS_MLQK), (bf16*)(p.ws + WS_MLV), (bf16*)(p.ws + WS_MLO), (bf16*)(p.ws + WS_GATES)};
        gemm<EpiProj>(lds, (const bf16*)(p.ws + WS_XN), (const bf16*)(p.ws + WS_W1T), T_, NPROJ, 1024, e); }
    } SEAM(1);
    if (IN(2)) {
        for (int it = blockIdx.x; it < 64; it += gridDim.x) mlstm_item(p, lds, it, tid, wave, lane);
        unsigned* qctr = (unsigned*)(p.ws + WS_CTL) + CW_Q;
        for (;;) {
            if (tid == 0) MISC[12] = __hip_atomic_fetch_add(qctr, 1u, __ATOMIC_RELAXED, __HIP_MEMORY_SCOPE_AGENT);
            __syncthreads();
            const unsigned it = MISC[12];
            __syncthreads();
            if (it >= 1024u) break;
            sba_item(p, (int)it, wave, lane);
        }
    } SEAM(2);
    if (IN(3)) { p3_yml(p, wave, lane); } SEAM(3);
    if (IN(4)) {
        EpiMergeA ea{(bf16*)(p.ws + WS_MERGED), (const bf16*)(p.ws + WS_GATES)};
        gemm<EpiMergeA>(lds, (const bf16*)(p.ws + WS_YSB), (const bf16*)(p.ws + WS_WSBT), T_, 1024, 512, ea);
        VM_WAIT(); __syncthreads();
        EpiMergeB eb{(bf16*)(p.ws + WS_MERGED), (const bf16*)(p.ws + WS_GATES)};
        gemm<EpiMergeB>(lds, (const bf16*)(p.ws + WS_YML), (const bf16*)(p.ws + WS_WMLT), T_, 1024, 512, eb);
    } SEAM(4);
    if (IN(5)) {
#pragma unroll 1
      for (int r = 0; r < REP(5); ++r) {
        EpiH e{(float*)(p.ws + WS_H), p.x};
        gemm<EpiH>(lds, (const bf16*)(p.ws + WS_MERGED), (const bf16*)(p.ws + WS_WOUTT), T_, 1024, 1024, e); }
    } SEAM(5);
    if (IN(6)) { p6_hn(p, wave, lane); } SEAM(6);
    if (IN(7)) { EpiF32 e{(float*)(p.ws + WS_SC), 1024}; gemm<EpiF32>(lds, (const bf16*)(p.ws + WS_HN), (const bf16*)(p.ws + WS_WCT), T_, 1024, 1024, e); } SEAM(7);
    if (IN(8)) {
#pragma unroll 1
        for (int r = 0; r < REP(8); ++r) p8_topk(p, 0, wave, lane); } SEAM(8);
    if (IN(9)) { EpiF32 e{(float*)(p.ws + WS_SC), 1024}; gemm<EpiF32>(lds, (const bf16*)(p.ws + WS_HN), (const bf16*)(p.ws + WS_WCT) + (size_t)1024 * 1024, T_, 1024, 1024, e); } SEAM(9);
    if (IN(10)) { p8_topk(p, 1, wave, lane); } SEAM(10);
    if (IN(11)) {
#pragma unroll 1
        for (int r = 0; r < REP(11); ++r) p9_peer(p, wave, lane); }
#undef IN
#undef SEAM
}

extern "C" void kernel_launch(void* const* d_in, const int* in_sizes, int n_in, void* d_out, int out_size, void* d_ws, size_t ws_size, hipStream_t stream) {
    static int grid = 0;
    if (grid == 0) {
        if (n_in != 18 || in_sizes[0] != T_ * D_ || out_size != T_ * D_ || ws_size < WS_END) {
            fprintf(stderr, "kernel_launch: unexpected problem (n_in %d, in0 %d, out %d, ws %zu); nothing launched\n", n_in, n_in > 0 ? in_sizes[0] : -1, out_size, ws_size); grid = -1; return; }
        int dev = 0, cus = 0, per_cu = 0;
        if (hipGetDevice(&dev) != hipSuccess || hipDeviceGetAttribute(&cus, hipDeviceAttributeMultiprocessorCount, dev) != hipSuccess) { grid = -1; return; }
        if (hipFuncSetAttribute((const void*)fwd_kernel, hipFuncAttributeMaxDynamicSharedMemorySize, LDS_BYTES) != hipSuccess) { fprintf(stderr, "kernel_launch: hipFuncSetAttribute failed\n"); grid = -1; return; }
        if (hipOccupancyMaxActiveBlocksPerMultiprocessor(&per_cu, (const void*)fwd_kernel, NTHR, LDS_BYTES) != hipSuccess || per_cu < 1)
            fprintf(stderr, "kernel_launch: note: occupancy query reports %d workgroups per CU\n", per_cu);
        (void)hipGetLastError();
        grid = cus;
    }
    if (grid < 0) return;
    if (hipMemsetAsync((char*)d_ws + WS_CTL, 0, CTL_ZERO_BYTES, stream) != hipSuccess) { fprintf(stderr, "kernel_launch: memset failed\n"); return; }
    Args a{};
    const float** pp = (const float**)&a.p;
    for (int i = 0; i < 18; ++i) pp[i] = (const float*)d_in[i];
    a.p.out = (float*)d_out; a.p.ws = (unsigned char*)d_ws;
#if MK_PER_PHASE
    for (int ph = 0; ph < N_PHASES; ++ph) {
        a.ph_lo = ph; a.ph_hi = ph + 1;
        hipLaunchKernelGGL(fwd_kernel, dim3(grid), dim3(NTHR), LDS_BYTES, stream, a);
    }
#else
    a.ph_lo = 0; a.ph_hi = N_PHASES;
    hipLaunchKernelGGL(fwd_kernel, dim3(grid), dim3(NTHR), LDS_BYTES, stream, a);
#endif
    const hipError_t le = hipPeekAtLastError();
    if (le != hipSuccess) fprintf(stderr, "kernel_launch: launch failed: %s\n", hipGetErrorName(le));
}
```

```cpp
#include <hip/hip_runtime.h>
#include <cstdio>
#include <cstdint>
namespace pg8 {
#define PG8_LAS __attribute__((address_space(3)))
typedef unsigned short bf16_t;
typedef short bf16x8 __attribute__((ext_vector_type(8)));
typedef float f32x4 __attribute__((ext_vector_type(4)));
typedef unsigned u32x4 __attribute__((ext_vector_type(4)));
constexpr int BM = 256, BK = 64, HALF = 128, HTB = HALF * BK * 2  , STAGE_BYTES = 8 * HTB, NXCD = 8, WGM = 8;

__host__ __device__ __forceinline__ int lds_byte(int r, int c) { const int st = (r >> 4) * 2 + (c >> 5), rr = r & 15, cc = c & 31, ob = rr * 64 + cc * 2; return st * 1024 + (ob ^ (((ob >> 9) & 1) << 5)); }
__host__ __device__ __forceinline__ void stage_rc(int b, int& R, int& C) { const int st = b / 1024, sb = b % 1024, swz = sb ^ (((sb >> 9) & 1) << 5); R = (st >> 1) * 16 + swz / 64; C = (st & 1) * 32 + (swz % 64) / 2; }
__host__ __device__ __forceinline__ int perm32(int rho) { const int n = rho >> 4, i = rho & 15; return 8 * (i >> 2) + 4 * n + (i & 3); }

struct Unit { int pm, pn; };
struct Gemm { const bf16_t* A; const bf16_t* Bt; int M, N, K; };

struct StaticOrder {
    int nM, nN, nwg, G, c;
    __host__ __device__ void init(int M, int N, int G_, int c_) { nM = M / BM; nN = N / BM; nwg = nM * nN; G = G_; c = c_; }
    __host__ __device__ bool next(int i, Unit& u) const {
        const long L = (long)i * G + c; if (L >= nwg) return false;
        int wgid = (int)L; { const int q = nwg / NXCD, r = nwg % NXCD, xcd = wgid % NXCD, off = wgid / NXCD; wgid = (xcd < r ? xcd * (q + 1) : r * (q + 1) + (xcd - r) * q) + off; }
        const int nig = WGM * nN, gid = wgid / nig, fm = gid * WGM, gsz = (nM - fm) < WGM ? (nM - fm) : WGM;
        u.pm = fm + ((wgid % nig) % gsz); u.pn = (wgid % nig) / gsz; return true;
    }
    __device__ __forceinline__ void a_ready(const Unit&) const {}
    __device__ __forceinline__ void done(const Unit&) const {}
};

__device__ __forceinline__ unsigned cvt_pk_bf16(float lo, float hi) { unsigned r; asm volatile("v_cvt_pk_bf16_f32 %0, %1, %2" : "=v"(r) : "v"(lo), "v"(hi)); return r; }
template <class Epi, class Sched, bool ALIGN_EPI = false, bool SP2 = false>
__device__ __forceinline__ void gemm_phase(PG8_LAS unsigned char* lds, const Gemm g, const Sched& S, const Epi& E) {
    const int tid = threadIdx.x, wid = __builtin_amdgcn_readfirstlane(tid >> 6), lane = tid & 63, wr = wid >> 2, wc = wid & 3, fr = lane & 15, fq = lane >> 4;
    const int K = g.K, nt = K / BK;
    unsigned voffA[2], voffB[2];
#pragma unroll
    for (int i = 0; i < 2; ++i) { int R, C; stage_rc(tid * 16 + i * 8192, R, C); const int Rb = Epi::PERM ? ((R & ~31) + perm32(R & 31)) : R;
        voffA[i] = (unsigned)(R * K + C) * 2u; voffB[i] = (unsigned)(Rb * K + C) * 2u; }
    const size_t kstep = (size_t)(BK * 2);
    const size_t hstep = (size_t)HALF * K * 2;
    const size_t tstep = 2 * hstep;
    const unsigned ldsw = (unsigned)wid * 1024u;
    const int aoff = lds_byte(wr * 64 + fr, fq * 8), boff = lds_byte(wc * 32 + fr, fq * 8);
#define PG8_SA(b, h) (((b) * 2 + (h)) * HTB)
#define PG8_SB(b, h) ((4 + (b) * 2 + (h)) * HTB)
#define PG8_STAGE(bufoff, gbase, voff) do { _Pragma("unroll") for (int _i = 0; _i < 2; ++_i) \
        __builtin_amdgcn_global_load_lds((const unsigned*)((const char*)(gbase) + (voff)[_i]), (PG8_LAS unsigned*)(lds + (bufoff) + ldsw + _i * 8192), 16, 0, 0); } while (0)
#define PG8_LDA(dst, b, h) do { _Pragma("unroll") for (int m = 0; m < 4; ++m) _Pragma("unroll") for (int k = 0; k < 2; ++k) dst[m][k] = *(const PG8_LAS bf16x8*)(lds + PG8_SA(b, h) + aoff + m * 2048 + k * 1024); } while (0)
#define PG8_LDB(dst, b, h) do { _Pragma("unroll") for (int n = 0; n < 2; ++n) _Pragma("unroll") for (int k = 0; k < 2; ++k) dst[n][k] = *(const PG8_LAS bf16x8*)(lds + PG8_SB(b, h) + boff + n * 2048 + k * 1024); } while (0)
#define PG8_MMA(ai, bj, At, Bt) do { __builtin_amdgcn_s_setprio(1); _Pragma("unroll") for (int m = 0; m < 4; ++m) _Pragma("unroll") for (int n = 0; n < 2; ++n) _Pragma("unroll") for (int k = 0; k < 2; ++k) \
        acc[ai][bj][m][n] = __builtin_amdgcn_mfma_f32_16x16x32_bf16(Bt[n][k], At[m][k], acc[ai][bj][m][n], 0, 0, 0); __builtin_amdgcn_s_setprio(0); } while (0)
#define PG8_WAIT_V(n) asm volatile("s_waitcnt vmcnt(" #n ")" ::: "memory")
#define PG8_WAIT_L(n) asm volatile("s_waitcnt lgkmcnt(" #n ")" ::: "memory")
#define PG8_BAR __builtin_amdgcn_s_barrier()
#define PG8_SCHED __builtin_amdgcn_sched_barrier(0)
    Unit cur, nxt; int ui = 0;
    if (!S.next(0, cur)) return;
    f32x4 acc[2][2][4][2];
#pragma unroll
    for (int a = 0; a < 2; ++a)
#pragma unroll
        for (int b = 0; b < 2; ++b)
#pragma unroll
            for (int m = 0; m < 4; ++m)
#pragma unroll
                for (int n = 0; n < 2; ++n) acc[a][b][m][n] = (f32x4){0.f, 0.f, 0.f, 0.f};
    bf16x8 At[4][2], B0[2][2], B1[2][2];
    const char* cA = (const char*)g.A + (size_t)cur.pm * tstep; const char* cB = (const char*)g.Bt + (size_t)cur.pn * tstep;
    S.a_ready(cur);
    if constexpr (SP2) {
        PG8_STAGE(PG8_SB(0, 0), cB, voffB); PG8_STAGE(PG8_SB(0, 1), cB + hstep, voffB); PG8_STAGE(PG8_SA(0, 0), cA, voffA); PG8_STAGE(PG8_SA(0, 1), cA + hstep, voffA);
        if (wr == 1) PG8_BAR;
        PG8_WAIT_V(2); PG8_BAR;
        PG8_STAGE(PG8_SB(1, 0), cB + kstep, voffB); PG8_STAGE(PG8_SA(1, 0), cA + kstep, voffA); PG8_STAGE(PG8_SB(1, 1), cB + hstep + kstep, voffB);
        PG8_WAIT_V(6); PG8_BAR;
    } else {
        PG8_STAGE(PG8_SB(0, 0), cB, voffB); PG8_STAGE(PG8_SA(0, 0), cA, voffA); PG8_STAGE(PG8_SB(0, 1), cB + hstep, voffB); PG8_STAGE(PG8_SA(0, 1), cA + hstep, voffA);
        if (wr == 1) PG8_BAR;
        PG8_WAIT_V(4); PG8_BAR;
        PG8_STAGE(PG8_SB(1, 0), cB + kstep, voffB); PG8_STAGE(PG8_SA(1, 0), cA + kstep, voffA); PG8_STAGE(PG8_SB(1, 1), cB + hstep + kstep, voffB);
        PG8_WAIT_V(6); PG8_BAR;
    }
    for (;;) {
        const bool has_next = S.next(ui + 1, nxt);
        const char* nA = has_next ? (const char*)g.A + (size_t)nxt.pm * tstep : cA; const char* nB = has_next ? (const char*)g.Bt + (size_t)nxt.pn * tstep : cB;
        for (int t = 0; t < nt; t += 2) {
            const bool last = (t == nt - 2);
            const char* a1 = cA + (size_t)(t + 1) * kstep;
            const char* a2 = last ? nA : cA + (size_t)(t + 2) * kstep; const char* b2 = last ? nB : cB + (size_t)(t + 2) * kstep;
            const char* a3 = a2 + kstep; const char* b3 = b2 + kstep;
            if (last && has_next) S.a_ready(nxt);
            if constexpr (SP2) {
            PG8_LDB(B0, 0, 0); PG8_LDB(B1, 0, 1); PG8_SCHED; PG8_LDA(At, 0, 0); PG8_STAGE(PG8_SA(1, 1), a1 + hstep, voffA);
            PG8_WAIT_V(8); PG8_WAIT_L(0); PG8_BAR; PG8_MMA(0, 0, At, B0); PG8_MMA(0, 1, At, B1); PG8_BAR; PG8_SCHED;
            PG8_LDA(At, 0, 1); PG8_STAGE(PG8_SB(0, 0), b2, voffB); PG8_STAGE(PG8_SB(0, 1), b2 + hstep, voffB); PG8_STAGE(PG8_SA(0, 0), a2, voffA);
            PG8_WAIT_V(8); PG8_WAIT_L(0); PG8_BAR; PG8_MMA(1, 0, At, B0); PG8_MMA(1, 1, At, B1); PG8_BAR; PG8_SCHED;
            PG8_LDB(B0, 1, 0); PG8_LDB(B1, 1, 1); PG8_SCHED; PG8_LDA(At, 1, 0); PG8_STAGE(PG8_SA(0, 1), a2 + hstep, voffA);
            PG8_WAIT_V(8); PG8_WAIT_L(0); PG8_BAR; PG8_MMA(0, 0, At, B0); PG8_MMA(0, 1, At, B1); PG8_BAR; PG8_SCHED;
            PG8_LDA(At, 1, 1); PG8_STAGE(PG8_SB(1, 0), b3, voffB); PG8_STAGE(PG8_SB(1, 1), b3 + hstep, voffB); PG8_STAGE(PG8_SA(1, 0), a3, voffA);
            PG8_WAIT_V(8); PG8_WAIT_L(0); PG8_BAR; PG8_MMA(1, 0, At, B0); PG8_MMA(1, 1, At, B1); PG8_BAR; PG8_SCHED;
            } else {
            PG8_LDB(B0, 0, 0); PG8_SCHED; PG8_LDA(At, 0, 0); PG8_STAGE(PG8_SA(1, 1), a1 + hstep, voffA);
            PG8_WAIT_L(8); PG8_BAR; PG8_WAIT_L(0); PG8_MMA(0, 0, At, B0); PG8_BAR; PG8_SCHED;
            PG8_LDB(B1, 0, 1); PG8_STAGE(PG8_SB(0, 0), b2, voffB);
            PG8_BAR; PG8_WAIT_L(0); PG8_MMA(0, 1, At, B1); PG8_BAR;
            PG8_LDA(At, 0, 1); PG8_STAGE(PG8_SA(0, 0), a2, voffA);
            PG8_BAR; PG8_WAIT_L(0); PG8_MMA(1, 0, At, B0); PG8_BAR; PG8_SCHED;
            PG8_STAGE(PG8_SB(0, 1), b2 + hstep, voffB);
            PG8_WAIT_V(6); PG8_BAR; PG8_MMA(1, 1, At, B1); PG8_BAR;
            PG8_LDB(B0, 1, 0); PG8_SCHED; PG8_LDA(At, 1, 0); PG8_STAGE(PG8_SA(0, 1), a2 + hstep, voffA);
            PG8_WAIT_L(8); PG8_BAR; PG8_WAIT_L(0); PG8_MMA(0, 0, At, B0); PG8_BAR; PG8_SCHED;
            PG8_LDB(B1, 1, 1); PG8_STAGE(PG8_SB(1, 0), b3, voffB);
            PG8_BAR; PG8_WAIT_L(0); PG8_MMA(0, 1, At, B1); PG8_BAR;
            PG8_LDA(At, 1, 1); PG8_STAGE(PG8_SA(1, 0), a3, voffA);
            PG8_BAR; PG8_WAIT_L(0); PG8_MMA(1, 0, At, B0); PG8_BAR; PG8_SCHED;
            PG8_STAGE(PG8_SB(1, 1), b3 + hstep, voffB);
            PG8_WAIT_V(6); PG8_BAR; PG8_MMA(1, 1, At, B1); PG8_BAR;
            }
        }
        if constexpr (ALIGN_EPI) { if (wr == 0) PG8_BAR; }
        if constexpr (!Epi::AFTER_DRAIN) { E(acc, cur, wr, wc, fr, fq); S.done(cur); }
        if (!has_next) break;
#pragma unroll
        for (int a = 0; a < 2; ++a)
#pragma unroll
            for (int b = 0; b < 2; ++b)
#pragma unroll
                for (int m = 0; m < 4; ++m)
#pragma unroll
                    for (int n = 0; n < 2; ++n) acc[a][b][m][n] = (f32x4){0.f, 0.f, 0.f, 0.f};
        cur = nxt; cA = nA; cB = nB; ++ui;
        if constexpr (ALIGN_EPI) { if (wr == 1) PG8_BAR; }
    }
    PG8_WAIT_V(0);
    if constexpr (!ALIGN_EPI) { if (wr == 0) PG8_BAR; }
    PG8_BAR;
    if constexpr (Epi::AFTER_DRAIN) { E.fused(acc, cur, wr, wc, fr, fq, lds, wid, lane); S.done(cur); }
#undef PG8_SA
#undef PG8_SB
#undef PG8_STAGE
#undef PG8_LDA
#undef PG8_LDB
#undef PG8_MMA
#undef PG8_WAIT_V
#undef PG8_WAIT_L
#undef PG8_BAR
#undef PG8_SCHED
}
}

#ifndef MK_PER_PHASE
#define MK_PER_PHASE 0
#endif
#ifndef USE_PG8
#define USE_PG8 1
#endif
constexpr int NWAVES = 8, NTHR = 512;

constexpr int B_ = 16, S_ = 2048, D_ = 1024, T_ = B_ * S_;
constexpr int INC = 5640, NPROJ = 5632;
constexpr int NEXP = 16384;
constexpr float EPS = 1e-6f;

constexpr size_t MiB = 1u << 20;
constexpr size_t WS_CTL = 0, CTL_ZERO_BYTES = 1 * MiB;
constexpr size_t WS_W1T = 2 * MiB, WS_WSBT = 13 * MiB, WS_WMLT = 14 * MiB, WS_WOUTT = 15 * MiB, WS_WCT = 17 * MiB, WS_IFG = 21 * MiB;
constexpr size_t WS_U8 = 24 * MiB, WS_V8 = 40 * MiB, WS_USC = 22 * MiB, WS_VSC = 23 * MiB;
constexpr size_t WS_XN = 88 * MiB, WS_YSB = 88 * MiB, WS_YML = 120 * MiB;
constexpr size_t WS_SBQKV = 152 * MiB  , WS_VT = 216 * MiB  , WS_MLQK = 248 * MiB, WS_MLV = 312 * MiB, WS_MLO = 344 * MiB, WS_GATES = 376 * MiB;
constexpr size_t WS_MERGED = 216 * MiB, WS_H = 88 * MiB, WS_HN = 216 * MiB, WS_IDX = 280 * MiB, WS_GATE = 296 * MiB, WS_SC = 312 * MiB;
constexpr size_t WS_END = 504 * MiB;
constexpr int CW_BAR = 4096, CW_Q = 8192;

constexpr int RING_OFF = 0, RING_BYTES = 131072;
constexpr int LDSCTL_OFF = RING_BYTES, MISC_OFF = LDSCTL_OFF + 320;
constexpr int LDS_BYTES = 147456;

#define GAS __attribute__((address_space(1)))
#define LAS __attribute__((address_space(3)))
typedef unsigned short bf16;
typedef unsigned v4u __attribute__((ext_vector_type(4)));
typedef unsigned v2u __attribute__((ext_vector_type(2)));
typedef float f32x4 __attribute__((ext_vector_type(4)));
#define LDS_WAIT() asm volatile("s_waitcnt lgkmcnt(0)" ::: "memory")
#define VM_WAIT() asm volatile("s_waitcnt vmcnt(0)" ::: "memory")
__device__ __forceinline__ unsigned f2bf(float f) { unsigned u = __builtin_bit_cast(unsigned, f); return (u + 0x7fffu + ((u >> 16) & 1u)) >> 16; }
__device__ __forceinline__ unsigned pk2(float lo, float hi) { return f2bf(lo) | (f2bf(hi) << 16); }
__device__ __forceinline__ float bflo(unsigned u) { return __builtin_bit_cast(float, u << 16); }
__device__ __forceinline__ float bfhi(unsigned u) { return __builtin_bit_cast(float, u & 0xffff0000u); }
__device__ __forceinline__ float bf2f(bf16 b) { return __builtin_bit_cast(float, (unsigned)b << 16); }
__device__ __forceinline__ float sigmoidf_(float x) { return 1.f / (1.f + __expf(-x)); }
__device__ __forceinline__ float wave_sum(float v) {
#pragma unroll
    for (int o = 1; o < 64; o <<= 1) v += __shfl_xor(v, o);
    return v;
}
__device__ __forceinline__ unsigned wave_max_u(unsigned v) {
#pragma unroll
    for (int o = 1; o < 64; o <<= 1) { const unsigned w = (unsigned)__shfl_xor((int)v, o); v = v > w ? v : w; }
    return v;
}
struct F8 { float v[8]; };
__device__ __forceinline__ void unpack8(const v4u& u, float (&f)[8]) {
    f[0] = bflo(u.x); f[1] = bfhi(u.x); f[2] = bflo(u.y); f[3] = bfhi(u.y); f[4] = bflo(u.z); f[5] = bfhi(u.z); f[6] = bflo(u.w); f[7] = bfhi(u.w);
}
__device__ __forceinline__ v4u pack8(const float (&f)[8]) { v4u o; o.x = pk2(f[0], f[1]); o.y = pk2(f[2], f[3]); o.z = pk2(f[4], f[5]); o.w = pk2(f[6], f[7]); return o; }

#define XB_TMO      128
#define XB_XCNT(j)  (256  + 64 * (j))
#define XB_XSUB(j)  (1280 + 64 * (j))
#define XB_XGEN(j)  (2304 + 64 * (j))
#define XB_TOP      3328
#define XB_TOPGEN   3392
#define XCD_BAR_WORDS 3456
#define XB_SPIN_CAP (1u << 24)

__device__ __forceinline__ unsigned xb_ld(unsigned* p)              { return __hip_atomic_load(p, __ATOMIC_RELAXED, __HIP_MEMORY_SCOPE_AGENT); }
__device__ __forceinline__ unsigned xb_add(unsigned* p, unsigned v) { return __hip_atomic_fetch_add(p, v, __ATOMIC_RELAXED, __HIP_MEMORY_SCOPE_AGENT); }
__device__ __forceinline__ unsigned xb_xcc_id() { return (unsigned)__builtin_amdgcn_s_getreg((3 << 11) | 20) & 0xFu; }
#define XB_SPIN(cond, bar) do { unsigned _sp = 0; while (cond) { __builtin_amdgcn_s_sleep(1); \
    if ((++_sp & 255u) == 0u) { if (xb_ld(&(bar)[XB_TMO])) break; if (_sp > XB_SPIN_CAP) { atomicAdd(&(bar)[XB_TMO], 1u); break; } } } } while (0)

struct XcdBarrier {
    unsigned* bar; unsigned x;
    volatile LAS unsigned* st;
};

__device__ __forceinline__ XcdBarrier xcd_barrier_post(unsigned* bar, volatile LAS unsigned* st) {
    XcdBarrier b; b.bar = bar; b.x = xb_xcc_id(); b.st = st;
    if (threadIdx.x == 0) (void)xb_add(&bar[XB_XCNT(b.x)], 1u);
    return b;
}
__device__ __forceinline__ void xcd_barrier_complete(unsigned* bar, unsigned x, unsigned& nloc, unsigned& nx) {
    const unsigned G = gridDim.x * gridDim.y * gridDim.z;
    unsigned sum, cnt, mine, sp = 0u;
    for (;;) {
        sum = 0u; cnt = 0u; mine = 0u;
#pragma unroll
        for (unsigned j = 0; j < 16; ++j) { const unsigned c = xb_ld(&bar[XB_XCNT(j)]); sum += c; cnt += (c > 0u) ? 1u : 0u; mine = (j == x) ? c : mine; }
        if (sum == G) break;
        __builtin_amdgcn_s_sleep(1);
        if ((++sp & 255u) == 0u) { if (xb_ld(&bar[XB_TMO])) break; if (sp > XB_SPIN_CAP) { atomicAdd(&bar[XB_TMO], 1u); break; } }
    }
    nloc = mine > 0u ? mine : 1u; nx = cnt > 0u ? cnt : 1u;
}

__device__ __forceinline__ void xcd_barrier(const XcdBarrier& b) {
    asm volatile("s_waitcnt vmcnt(0)" ::: "memory");
    __syncthreads();
    if (threadIdx.x == 0) {
        unsigned* bar = b.bar;
        __builtin_amdgcn_s_waitcnt(0);
        unsigned nloc = b.st[0], nx = b.st[1];
        if (nloc == 0u) { xcd_barrier_complete(bar, b.x, nloc, nx); b.st[0] = nloc; b.st[1] = nx; }
        const unsigned old = xb_add(&bar[XB_XSUB(b.x)], 1u);
        const unsigned gen = old / nloc;
        if (old + 1u == (gen + 1u) * nloc) {
            __builtin_amdgcn_fence(__ATOMIC_RELEASE, "agent");
            asm volatile("s_waitcnt vmcnt(0)" ::: "memory");
            const unsigned og = xb_add(&bar[XB_TOP], 1u);
            const unsigned tg = og / nx;
            if (og + 1u == (tg + 1u) * nx) xb_add(&bar[XB_TOPGEN], 1u);
            else XB_SPIN(xb_ld(&bar[XB_TOPGEN]) == tg, bar);
            __builtin_amdgcn_fence(__ATOMIC_ACQUIRE, "agent");
            xb_add(&bar[XB_XGEN(b.x)], 1u);
            asm volatile("s_waitcnt vmcnt(0)" ::: "memory");
        } else {
            XB_SPIN(xb_ld(&bar[XB_XGEN(b.x)]) == gen, bar);
            __builtin_amdgcn_fence(__ATOMIC_ACQUIRE, "agent");
            asm volatile("s_waitcnt vmcnt(0)" ::: "memory");
        }
    }
    __syncthreads();
}

struct EpiProj {
    bf16 *sbqk, *vt, *mlqk, *mlv, *mlo, *gates;
    __device__ __forceinline__ void operator()(int row, int col, const F8& a) const {
        bf16* dst;
        if (col < 1024) dst = sbqk + (size_t)row * 1024 + col;
        else if (col < 1536) {
            const int c = col - 1024, hh = c >> 6, d = c & 63, b = row >> 11, sq = row & 2047;
            bf16* vp = vt + ((size_t)(b * 8 + hh) * 64 + d) * 2048 + sq;
#pragma unroll
            for (int i = 0; i < 8; ++i) vp[(size_t)i * 2048] = (bf16)f2bf(a.v[i]);
            return;
        }
        else if (col < 2560) dst = mlqk + (size_t)row * 1024 + (col - 1536);
        else if (col < 3072) dst = mlv + (size_t)row * 512 + (col - 2560);
        else if (col < 3584) dst = mlo + (size_t)row * 512 + (col - 3072);
        else dst = gates + (size_t)row * 2048 + (col - 3584);
        *(v4u*)dst = pack8(a.v);
    }
};
struct EpiMergeA {
    bf16* merged; const bf16* gates;
    __device__ __forceinline__ void operator()(int row, int col, const F8& a) const {
        float g[8], o[8]; unpack8(*(const v4u*)(gates + (size_t)row * 2048 + col), g);
#pragma unroll
        for (int i = 0; i < 8; ++i) o[i] = sigmoidf_(g[i]) * a.v[i];
        *(v4u*)(merged + (size_t)row * 1024 + col) = pack8(o);
    }
};
struct EpiMergeB {
    bf16* merged; const bf16* gates;
    __device__ __forceinline__ void operator()(int row, int col, const F8& a) const {
        float g[8], o[8]; unpack8(*(const v4u*)(gates + (size_t)row * 2048 + 1024 + col), g);
        unpack8(*(const v4u*)(merged + (size_t)row * 1024 + col), o);
#pragma unroll
        for (int i = 0; i < 8; ++i) o[i] += sigmoidf_(g[i]) * a.v[i];
        *(v4u*)(merged + (size_t)row * 1024 + col) = pack8(o);
    }
};
struct EpiH {
    float* h; const float* x;
    __device__ __forceinline__ void operator()(int row, int col, const F8& a) const {
        const f32x4 x0 = *(const f32x4*)(x + (size_t)row * 1024 + col), x1 = *(const f32x4*)(x + (size_t)row * 1024 + col + 4);
        *(f32x4*)(h + (size_t)row * 1024 + col) = (f32x4){x0.x + a.v[0], x0.y + a.v[1], x0.z + a.v[2], x0.w + a.v[3]};
        *(f32x4*)(h + (size_t)row * 1024 + col + 4) = (f32x4){x1.x + a.v[4], x1.y + a.v[5], x1.z + a.v[6], x1.w + a.v[7]};
    }
};
struct EpiF32 {
    float* o; int ldc;
    __device__ __forceinline__ void operator()(int row, int col, const F8& a) const {
        *(f32x4*)(o + (size_t)row * ldc + col) = (f32x4){a.v[0], a.v[1], a.v[2], a.v[3]};
        *(f32x4*)(o + (size_t)row * ldc + col + 4) = (f32x4){a.v[4], a.v[5], a.v[6], a.v[7]};
    }
};

template <class E> struct EpiAdapt {
    static constexpr bool PERM = true, AFTER_DRAIN = false;
    E e;
    __device__ __forceinline__ void operator()(const pg8::f32x4 (&acc)[2][2][4][2], const pg8::Unit& u, int wr, int wc, int fr, int fq) const {
#pragma unroll
        for (int ai = 0; ai < 2; ++ai)
#pragma unroll
            for (int m = 0; m < 4; ++m) {
                const int row = u.pm * 256 + ai * 128 + wr * 64 + m * 16 + fr;
#pragma unroll
                for (int bj = 0; bj < 2; ++bj) {
                    const int col = u.pn * 256 + bj * 128 + wc * 32 + 8 * fq;
                    F8 a; const pg8::f32x4 v0 = acc[ai][bj][m][0], v1 = acc[ai][bj][m][1];
                    a.v[0] = v0[0]; a.v[1] = v0[1]; a.v[2] = v0[2]; a.v[3] = v0[3]; a.v[4] = v1[0]; a.v[5] = v1[1]; a.v[6] = v1[2]; a.v[7] = v1[3];
                    e(row, col, a);
                }
            }
    }
};

template <class E>
__device__ __forceinline__ void simple_gemm(LAS unsigned char* lds, const bf16* A, const bf16* Bt, int M, int N, int K, const E& e) {
    LAS float* As = (LAS float*)lds;
    LAS float* Bs = As + 32 * 132;
    const int tid = threadIdx.x, ty = tid >> 4, tx = tid & 15;
    const int ntn = N / 128, ntiles = (M / 128) * ntn;
    for (int tile = blockIdx.x; tile < ntiles; tile += gridDim.x) {
        const int tm = tile / ntn, tn = tile % ntn;
        float acc[4][8];
#pragma unroll
        for (int i = 0; i < 4; ++i)
#pragma unroll
            for (int j = 0; j < 8; ++j) acc[i][j] = 0.f;
        for (int k0 = 0; k0 < K; k0 += 32) {
            {
                const int r = tid >> 2, kq = (tid & 3) * 8;
                float fa[8], fb[8];
                unpack8(*(const v4u*)(A + (size_t)(tm * 128 + r) * K + k0 + kq), fa);
                unpack8(*(const v4u*)(Bt + (size_t)(tn * 128 + r) * K + k0 + kq), fb);
#pragma unroll
                for (int i = 0; i < 8; ++i) { As[(kq + i) * 132 + r] = fa[i]; Bs[(kq + i) * 132 + r] = fb[i]; }
            }
            __syncthreads();
#pragma unroll 8
            for (int k = 0; k < 32; ++k) {
                const f32x4 a4 = *(const LAS f32x4*)(As + k * 132 + ty * 4);
                const f32x4 b0 = *(const LAS f32x4*)(Bs + k * 132 + tx * 8), b1 = *(const LAS f32x4*)(Bs + k * 132 + tx * 8 + 4);
                const float av[4] = {a4.x, a4.y, a4.z, a4.w};
                const float bv[8] = {b0.x, b0.y, b0.z, b0.w, b1.x, b1.y, b1.z, b1.w};
#pragma unroll
                for (int i = 0; i < 4; ++i)
#pragma unroll
                    for (int j = 0; j < 8; ++j) acc[i][j] += av[i] * bv[j];
            }
            __syncthreads();
        }
#pragma unroll
        for (int i = 0; i < 4; ++i) {
            F8 a;
#pragma unroll
            for (int j = 0; j < 8; ++j) a.v[j] = acc[i][j];
            e(tm * 128 + ty * 4 + i, tn * 128 + tx * 8, a);
        }
    }
}

template <class E>
__device__ __forceinline__ void gemm(LAS unsigned char* lds, const bf16* A, const bf16* Bt, int M, int N, int K, const E& e) {
#if USE_PG8
    pg8::Gemm g{A, Bt, M, N, K}; pg8::StaticOrder S; S.init(M, N, (int)gridDim.x, (int)blockIdx.x);
    EpiAdapt<E> ea{e};
    pg8::gemm_phase<EpiAdapt<E>, pg8::StaticOrder, true, true>(lds, g, S, ea);
#else
    simple_gemm<E>(lds, A, Bt, M, N, K, e);
#endif
}

__device__ __forceinline__ void transpose_item(const float* W, int ldw, int K, bf16* WT, int src_col0, int dst_row0, LAS float* scr, int kb, int lane) {
    const int k0 = 64 * kb;
#pragma unroll 8
    for (int i = 0; i < 32; ++i) { const int kk = 2 * i + (lane >> 5); scr[kk * 33 + (lane & 31)] = W[(size_t)(k0 + kk) * ldw + src_col0 + (lane & 31)]; }
    LDS_WAIT(); asm volatile("" ::: "memory");
    const int c = lane & 7;
#pragma unroll
    for (int j = 0; j < 4; ++j) { const int n = (lane >> 3) + 8 * j; const LAS float* s = scr + (8 * c) * 33 + n;
        v4u o; o.x = pk2(s[0 * 33], s[1 * 33]); o.y = pk2(s[2 * 33], s[3 * 33]); o.z = pk2(s[4 * 33], s[5 * 33]); o.w = pk2(s[6 * 33], s[7 * 33]);
        *(v4u*)(WT + (size_t)(dst_row0 + n) * K + k0 + 8 * c) = o; }
    LDS_WAIT(); asm volatile("" ::: "memory");
}

struct P {
    const float *x, *norm_mix_w, *w_in, *conv_w, *conv_b, *b_i, *b_f, *ml_norm_w, *w_sb, *w_ml, *w_out, *norm_ffn_w, *w_query, *keys1, *keys2, *peer_u, *peer_v, *norm_final_w;
    float* out; unsigned char* ws;
};

__device__ __forceinline__ void p0_prologue(const P& p, LAS unsigned char* lds, int wave, int lane) {
    LAS float* scr = (LAS float*)(lds + wave * 16384);
    const int gw = blockIdx.x * NWAVES + wave, NGW = gridDim.x * NWAVES;
    bf16* W1T = (bf16*)(p.ws + WS_W1T); bf16* WSBT = (bf16*)(p.ws + WS_WSBT); bf16* WMLT = (bf16*)(p.ws + WS_WMLT); bf16* WOUTT = (bf16*)(p.ws + WS_WOUTT); bf16* WCT = (bf16*)(p.ws + WS_WCT);
    constexpr int I_1 = 16 * 176, I_SB = 8 * 32, I_ML = 8 * 32, I_O = 16 * 32, NT = I_1 + I_SB + I_ML + I_O;
    for (int it = gw; it < NT; it += NGW) {
        int r = it;
        if (r < I_1) { const int kb = r / 176, nb = r % 176, n0 = nb * 32; transpose_item(p.w_in, INC, 1024, W1T, n0 < 3584 ? n0 : n0 + 8, n0, scr, kb, lane); continue; } r -= I_1;
        if (r < I_SB) { const int kb = r / 32, nb = r % 32; transpose_item(p.w_sb, 1024, 512, WSBT, nb * 32, nb * 32, scr, kb, lane); continue; } r -= I_SB;
        if (r < I_ML) { const int kb = r / 32, nb = r % 32; transpose_item(p.w_ml, 1024, 512, WMLT, nb * 32, nb * 32, scr, kb, lane); continue; } r -= I_ML;
        { const int kb = r / 32, nb = r % 32; transpose_item(p.w_out, 1024, 1024, WOUTT, nb * 32, nb * 32, scr, kb, lane); }
    }
    for (int it = gw; it < 2048 * 16; it += NGW) {
        const int col = it >> 4, kb = it & 15, head = col >> 8, half = (col >> 7) & 1, key = col & 127, k = kb * 64 + lane;
        const float* kr = (half ? p.keys2 : p.keys1) + ((size_t)head * 128 + key) * 128;
        const float* wq = p.w_query + (size_t)k * 2048 + head * 256 + half * 128;
        float acc = 0.f;
#pragma unroll 4
        for (int d = 0; d < 128; d += 4) { const f32x4 a = *(const f32x4*)(wq + d), b = *(const f32x4*)(kr + d); acc += a.x * b.x + a.y * b.y + a.z * b.z + a.w * b.w; }
        WCT[(size_t)col * 1024 + k] = (bf16)f2bf(acc);
    }
    bf16* XN = (bf16*)(p.ws + WS_XN); float* IFG = (float*)(p.ws + WS_IFG);
    for (int m = gw; m < T_; m += NGW) {
        const f32x4* xr = (const f32x4*)(p.x + (size_t)m * 1024) + lane;
        const f32x4* wr = (const f32x4*)p.norm_mix_w + lane;
        f32x4 v[4]; float ss = 0.f;
#pragma unroll
        for (int j = 0; j < 4; ++j) { v[j] = xr[64 * j]; ss += (v[j].x * v[j].x + v[j].y * v[j].y) + (v[j].z * v[j].z + v[j].w * v[j].w); }
        const float rstd = 1.f / sqrtf(wave_sum(ss) * (1.f / 1024.f) + EPS);
        float g[8];
#pragma unroll
        for (int i = 0; i < 8; ++i) g[i] = 0.f;
        v2u* o8 = (v2u*)(XN + (size_t)m * 1024) + lane;
#pragma unroll
        for (int j = 0; j < 4; ++j) {
            const f32x4 w = wr[64 * j];
            const float y[4] = {v[j].x * rstd * w.x, v[j].y * rstd * w.y, v[j].z * rstd * w.z, v[j].w * rstd * w.w};
            o8[64 * j] = (v2u){pk2(y[0], y[1]), pk2(y[2], y[3])};
#pragma unroll
            for (int q = 0; q < 4; ++q) {
                const int k = 256 * j + 4 * lane + q;
                const f32x4 w0 = *(const f32x4*)(p.w_in + (size_t)k * INC + 3584), w1 = *(const f32x4*)(p.w_in + (size_t)k * INC + 3588);
                g[0] += y[q] * w0.x; g[1] += y[q] * w0.y; g[2] += y[q] * w0.z; g[3] += y[q] * w0.w;
                g[4] += y[q] * w1.x; g[5] += y[q] * w1.y; g[6] += y[q] * w1.z; g[7] += y[q] * w1.w;
            }
        }
#pragma unroll
        for (int i = 0; i < 8; ++i) g[i] = wave_sum(g[i]);
        if (lane == 0) {
#pragma unroll
            for (int i = 0; i < 4; ++i) { IFG[(size_t)m * 8 + i] = g[i] + p.b_i[i]; IFG[(size_t)m * 8 + 4 + i] = g[4 + i] + p.b_f[i]; }
        }
    }
    {
        unsigned char* U8 = p.ws + WS_U8; unsigned char* V8 = p.ws + WS_V8; float* USC = (float*)(p.ws + WS_USC); float* VSC = (float*)(p.ws + WS_VSC);
        for (int it = gw; it < 2 * NEXP; it += NGW) {
            const int e = it >> 1, which = it & 1;
            const float* src = (which ? p.peer_v : p.peer_u) + (size_t)e * 1024 + 16 * lane;
            f32x4 v[4]; float am = 0.f;
#pragma unroll
            for (int j = 0; j < 4; ++j) { v[j] = *(const f32x4*)(src + 4 * j); am = fmaxf(am, fmaxf(fmaxf(fabsf(v[j].x), fabsf(v[j].y)), fmaxf(fabsf(v[j].z), fabsf(v[j].w)))); }
#pragma unroll
            for (int o = 1; o < 64; o <<= 1) am = fmaxf(am, __shfl_xor(am, o));
            const float sc = am > 0.f ? exp2f(floorf(log2f(448.f / am))) : 1.f;
            v4u o4;
            unsigned w[4];
#pragma unroll
            for (int j = 0; j < 4; ++j) { int t = __builtin_amdgcn_cvt_pk_fp8_f32(v[j].x * sc, v[j].y * sc, 0, false); t = __builtin_amdgcn_cvt_pk_fp8_f32(v[j].z * sc, v[j].w * sc, t, true); w[j] = (unsigned)t; }
            o4.x = w[0]; o4.y = w[1]; o4.z = w[2]; o4.w = w[3];
            *(v4u*)((which ? V8 : U8) + (size_t)e * 1024 + 16 * lane) = o4;
            if (lane == 0) (which ? VSC : USC)[e] = 1.f / sc;
        }
    }
}

typedef short bf16x8 __attribute__((ext_vector_type(8)));
typedef float f32x16 __attribute__((ext_vector_type(16)));
typedef float f32x2_t __attribute__((ext_vector_type(2))); typedef __bf16 bf16x2_t __attribute__((ext_vector_type(2)));
__device__ __forceinline__ unsigned cvtpk(float lo, float hi) { f32x2_t v = {lo, hi}; bf16x2_t b = __builtin_convertvector(v, bf16x2_t); return __builtin_bit_cast(unsigned, b); }
#define MFMA32(a, b, c) __builtin_amdgcn_mfma_f32_32x32x16_bf16((a), (b), (c), 0, 0, 0)
__device__ __forceinline__ int crow(int reg, int hh) { return (reg & 3) + 8 * (reg >> 2) + 4 * hh; }
template <int S> __device__ __forceinline__ bf16x8 pack_step(const f32x16& x) {
    v4u p; p.x = cvtpk(x[8 * S], x[8 * S + 1]); p.y = cvtpk(x[8 * S + 2], x[8 * S + 3]); p.z = cvtpk(x[8 * S + 4], x[8 * S + 5]); p.w = cvtpk(x[8 * S + 6], x[8 * S + 7]);
    return __builtin_bit_cast(bf16x8, p);
}
__device__ __forceinline__ bf16x8 frag2(const v2u& lo, const v2u& hi) { v4u p; p.x = lo.x; p.y = lo.y; p.z = hi.x; p.w = hi.y; return __builtin_bit_cast(bf16x8, p); }
__device__ __forceinline__ f32x16 zero16() { f32x16 z; for (int i = 0; i < 16; ++i) z[i] = 0.f; return z; }


constexpr int ML_QS = 0, ML_KS = 17408, ML_KWT = 34816, ML_VTL = 53248, ML_PS = 71680, ML_CT = 80896, ML_SCAL = 115712, ML_SSP = 118272, ML_QN = ML_SSP + 512, ML_F1 = ML_QN + 256, ML_F2 = ML_F1 + 256, ML_NV = ML_F2 + 256;
static_assert(ML_NV + 512 <= RING_BYTES, "mLSTM LDS map");
__device__ __forceinline__ void mlstm_scal(const float* IFG, int b, int h, int c, LAS float* sc, float& m_carry, int lane) {
    const size_t tok = (size_t)b * S_ + c * 64 + lane;
    const float ip = IFG[tok * 8 + h], fp = IFG[tok * 8 + 4 + h];
    const float lf = fminf(fp, 0.f) - log1pf(expf(-fabsf(fp)));
    float bc = lf;
#pragma unroll
    for (int o = 1; o < 64; o <<= 1) { const float t2 = __shfl_up(bc, o); if (lane >= o) bc += t2; }
    const float a = ip - bc; float pm = a;
#pragma unroll
    for (int o = 1; o < 64; o <<= 1) { const float t2 = __shfl_up(pm, o); if (lane >= o) pm = fmaxf(pm, t2); }
    const float M = fmaxf(m_carry, pm);
    const float M63 = __shfl(M, 63), bc63 = __shfl(bc, 63);
    sc[lane] = a; sc[64 + lane] = M; sc[128 + lane] = expf(a - M63); sc[192 + lane] = expf(m_carry - M); sc[256 + lane] = expf(-(bc + M));
    m_carry = bc63 + M63;
}
__device__ __forceinline__ void mlstm_item(const P& p, LAS unsigned char* lds, int item, int tid, int wave, int lane) {
    const int b = item >> 2, h = item & 3;
    const int r = lane & 31, hh = lane >> 5, et = wave & 3, th = wave >> 2;
    const bf16* MLQK = (const bf16*)(p.ws + WS_MLQK); const bf16* MLV = (const bf16*)(p.ws + WS_MLV); const float* IFG = (const float*)(p.ws + WS_IFG);
    bf16* HML = (bf16*)(p.ws + WS_YML);
    LAS float* SCAL = (LAS float*)(lds + ML_SCAL); LAS float* SSP = (LAS float*)(lds + ML_SSP); LAS float* QN = (LAS float*)(lds + ML_QN);
    LAS float* F1 = (LAS float*)(lds + ML_F1); LAS float* F2 = (LAS float*)(lds + ML_F2); LAS float* NV = (LAS float*)(lds + ML_NV);
    const int grp = tid & 31, rs = tid >> 5;
    const bool isk = grp >= 16;
    const int dch = 8 * (grp & 15);
    const int ch0 = (isk ? 512 : 0) + h * 128 + dch;
    float cw[4][8], cb[8];
#pragma unroll
    for (int i = 0; i < 8; ++i) { cb[i] = p.conv_b[ch0 + i];
#pragma unroll
        for (int j = 0; j < 4; ++j) cw[j][i] = p.conv_w[j * 1024 + ch0 + i]; }
    for (int i = tid; i < (128 * 136 * 2) / 4; i += NTHR) ((LAS unsigned*)(lds + ML_CT))[i] = 0u;
    if (tid < 128) NV[tid] = 0.f;
    f32x16 accC[2]; accC[0] = zero16(); accC[1] = zero16();
    float m_carry = 0.f;
    if (wave == 3) mlstm_scal(IFG, b, h, 0, SCAL, m_carry, lane);
    __syncthreads();
    for (int c = 0; c < 32; ++c) {
        const size_t tok0 = (size_t)b * S_ + c * 64;
        LAS float* sc = SCAL + (c & 1) * 320;
        {
            v4u xr[7];
#pragma unroll
            for (int k = 0; k < 7; ++k) { const int pos = c * 64 + 4 * rs + k - 3;
                xr[k] = pos >= 0 ? *(const v4u*)(MLQK + ((size_t)b * S_ + pos) * 1024 + ch0) : (v4u){0u, 0u, 0u, 0u}; }
            const int eg = tid & 15, sl = tid >> 4;
            const v4u v0 = *(const v4u*)(MLV + (tok0 + sl) * 512 + h * 128 + 8 * eg), v1 = *(const v4u*)(MLV + (tok0 + sl + 32) * 512 + h * 128 + 8 * eg);
#pragma unroll
            for (int tt = 0; tt < 4; ++tt) {
                float y[8];
#pragma unroll
                for (int i = 0; i < 8; ++i) y[i] = cb[i];
#pragma unroll
                for (int j = 0; j < 4; ++j) { float f[8]; unpack8(xr[tt + j], f);
#pragma unroll
                    for (int i = 0; i < 8; ++i) y[i] += cw[j][i] * f[i]; }
                const int t = 4 * rs + tt;
#pragma unroll
                for (int i = 0; i < 8; ++i) y[i] = y[i] * sigmoidf_(y[i]);
                if (!isk) { *(LAS v4u*)(lds + ML_QS + t * 272 + dch * 2) = pack8(y); }
                else {
#pragma unroll
                    for (int i = 0; i < 8; ++i) y[i] *= 0.08838834764831845f;
                    *(LAS v4u*)(lds + ML_KS + t * 272 + dch * 2) = pack8(y);
                    const float wk = sc[128 + t];
#pragma unroll
                    for (int i = 0; i < 8; ++i) *(LAS bf16*)(lds + ML_KWT + (dch + i) * 144 + t * 2) = (bf16)f2bf(y[i] * wk);
                }
            }
            {
                const unsigned vv0[4] = {v0.x, v0.y, v0.z, v0.w}, vv1[4] = {v1.x, v1.y, v1.z, v1.w};
#pragma unroll
                for (int i = 0; i < 4; ++i) {
                    *(LAS bf16*)(lds + ML_VTL + (8 * eg + 2 * i) * 144 + sl * 2) = (bf16)(vv0[i] & 0xffffu);
                    *(LAS bf16*)(lds + ML_VTL + (8 * eg + 2 * i + 1) * 144 + sl * 2) = (bf16)(vv0[i] >> 16);
                    *(LAS bf16*)(lds + ML_VTL + (8 * eg + 2 * i) * 144 + (sl + 32) * 2) = (bf16)(vv1[i] & 0xffffu);
                    *(LAS bf16*)(lds + ML_VTL + (8 * eg + 2 * i + 1) * 144 + (sl + 32) * 2) = (bf16)(vv1[i] >> 16);
                }
            }
        }
        __syncthreads();
        f32x16 acc_inter = zero16();
        if (wave < 3) {
            const int tt = wave > 0 ? 1 : 0, st = wave == 2 ? 1 : 0;
            f32x16 zt = zero16();
#pragma unroll
            for (int ks = 0; ks < 8; ++ks) {
                const bf16x8 ka = *(const LAS bf16x8*)(lds + ML_KS + (32 * st + r) * 272 + 32 * ks + 16 * hh);
                const bf16x8 qb = *(const LAS bf16x8*)(lds + ML_QS + (32 * tt + r) * 272 + 32 * ks + 16 * hh);
                zt = MFMA32(ka, qb, zt);
            }
            const int t = 32 * tt + r; const float Mt = sc[64 + t];
            float ps = 0.f;
#pragma unroll
            for (int g = 0; g < 4; ++g) {
                const f32x4 av = *(const LAS f32x4*)(sc + 32 * st + 8 * g + 4 * hh);
                float pv[4];
#pragma unroll
                for (int q = 0; q < 4; ++q) { const int sidx = 32 * st + 8 * g + 4 * hh + q;
                    const float wgt = sidx <= t ? expf(av[q] - Mt) : 0.f; pv[q] = zt[4 * g + q] * wgt; ps += pv[q]; }
                *(LAS v2u*)(lds + ML_PS + t * 144 + (32 * st + 8 * g + 4 * hh) * 2) = (v2u){cvtpk(pv[0], pv[1]), cvtpk(pv[2], pv[3])};
            }
            ps += __shfl_xor(ps, 32);
            if (hh == 0) { SSP[st * 64 + t] = ps; if (wave == 0) SSP[64 + t] = 0.f; }
        }
        if (wave == 3 && c + 1 < 32) mlstm_scal(IFG, b, h, c + 1, SCAL + ((c + 1) & 1) * 320, m_carry, lane);
#pragma unroll
        for (int ks = 0; ks < 8; ++ks) {
            const bf16x8 qa = *(const LAS bf16x8*)(lds + ML_QS + (32 * th + r) * 272 + 32 * ks + 16 * hh);
            const bf16x8 cbf = *(const LAS bf16x8*)(lds + ML_CT + (32 * et + r) * 272 + 32 * ks + 16 * hh);
            acc_inter = MFMA32(qa, cbf, acc_inter);
        }
        {
            const int t = tid >> 3, part = tid & 7;
            float f[8], sum = 0.f;
            { const v4u tq = *(const LAS v4u*)(lds + ML_QS + t * 272 + part * 32); unpack8(tq, f); }
#pragma unroll
            for (int i = 0; i < 8; ++i) sum += f[i] * NV[16 * part + i];
            { const v4u tq = *(const LAS v4u*)(lds + ML_QS + t * 272 + part * 32 + 16); unpack8(tq, f); }
#pragma unroll
            for (int i = 0; i < 8; ++i) sum += f[i] * NV[16 * part + 8 + i];
            sum += __shfl_xor(sum, 1); sum += __shfl_xor(sum, 2); sum += __shfl_xor(sum, 4);
            if (part == 0) QN[t] = sum;
        }
        __syncthreads();
        f32x16 acc_intra = zero16();
#pragma unroll
        for (int ks = 0; ks < 4; ++ks) {
            if (ks < 2 || th == 1) {
                const bf16x8 pa = *(const LAS bf16x8*)(lds + ML_PS + (32 * th + r) * 144 + 32 * ks + 16 * hh);
                const bf16x8 vb = *(const LAS bf16x8*)(lds + ML_VTL + (32 * et + r) * 144 + 32 * ks + 16 * hh);
                acc_intra = MFMA32(pa, vb, acc_intra);
            }
        }
        if (tid < 64) {
            const float wi = sc[192 + tid];
            const float den = SSP[tid] + SSP[64 + tid] + wi * QN[tid];
            const float f1 = 1.f / fmaxf(fabsf(den), sc[256 + tid]);
            F1[tid] = f1; F2[tid] = wi * f1;
        }
        const float decay = sc[192 + 63];
#pragma unroll
        for (int dt = 0; dt < 2; ++dt) {
#pragma unroll
            for (int i = 0; i < 16; ++i) accC[dt][i] *= decay;
#pragma unroll
            for (int ks = 0; ks < 4; ++ks) {
                const bf16x8 ka = *(const LAS bf16x8*)(lds + ML_KWT + (64 * th + 32 * dt + r) * 144 + 32 * ks + 16 * hh);
                const bf16x8 vb = *(const LAS bf16x8*)(lds + ML_VTL + (32 * et + r) * 144 + 32 * ks + 16 * hh);
                accC[dt] = MFMA32(ka, vb, accC[dt]);
            }
        }
        {
            const int d = tid >> 2, part = tid & 3;
            float f[8], sum = 0.f;
            { const v4u tq = *(const LAS v4u*)(lds + ML_KWT + d * 144 + part * 32); unpack8(tq, f); }
#pragma unroll
            for (int i = 0; i < 8; ++i) sum += f[i];
            { const v4u tq = *(const LAS v4u*)(lds + ML_KWT + d * 144 + part * 32 + 16); unpack8(tq, f); }
#pragma unroll
            for (int i = 0; i < 8; ++i) sum += f[i];
            sum += __shfl_xor(sum, 1); sum += __shfl_xor(sum, 2);
            if (part == 0) NV[d] = decay * NV[d] + sum;
        }
        __syncthreads();
        {
            bf16* hp = HML + (tok0 + 32 * th) * 512 + h * 128 + 32 * et + r;
#pragma unroll
            for (int g = 0; g < 4; ++g) {
                const f32x4 f1v = *(const LAS f32x4*)(F1 + 32 * th + 8 * g + 4 * hh), f2v = *(const LAS f32x4*)(F2 + 32 * th + 8 * g + 4 * hh);
#pragma unroll
                for (int q = 0; q < 4; ++q) { const int tl = 8 * g + 4 * hh + q;
                    hp[(size_t)tl * 512] = (bf16)f2bf(acc_intra[4 * g + q] * f1v[q] + acc_inter[4 * g + q] * f2v[q]); }
            }
#pragma unroll
            for (int dt = 0; dt < 2; ++dt)
#pragma unroll
                for (int g = 0; g < 4; ++g)
                    *(LAS v2u*)(lds + ML_CT + (32 * et + r) * 272 + (64 * th + 32 * dt + 8 * g + 4 * hh) * 2) = (v2u){cvtpk(accC[dt][4 * g], accC[dt][4 * g + 1]), cvtpk(accC[dt][4 * g + 2], accC[dt][4 * g + 3])};
        }
    }
    __syncthreads();
}

__device__ __forceinline__ void sba_wave_item(const bf16* __restrict__ QK, const bf16* __restrict__ VT, bf16* __restrict__ YSB, int b, int h, int qt, int lane) {
    const int r = lane & 31, hh = lane >> 5, t0 = qt * 32;
    const size_t rowbase = (size_t)b * S_;
    bf16x8 qf[4];
    {
        const bf16* qp = QK + (rowbase + t0 + r) * 1024 + h * 64 + 8 * hh;
#pragma unroll
        for (int ks = 0; ks < 4; ++ks) qf[ks] = *(const bf16x8*)(qp + 16 * ks);
    }
    bf16x8 tri[2];
#pragma unroll
    for (int s2 = 0; s2 < 2; ++s2)
#pragma unroll
        for (int j = 0; j < 8; ++j) { const int rho = 16 * s2 + 8 * (j >> 2) + 4 * hh + (j & 3); tri[s2][j] = (rho > r) ? (short)0x3F80 : (short)0; }
    f32x16 o0 = zero16(), o1 = zero16();
    float carry = 0.f;
    const bf16* kbase = QK + rowbase * 1024 + 512 + h * 64 + 8 * hh + (size_t)r * 1024;
    const bf16* vbase = VT + ((size_t)(b * 8 + h) * 64 + r) * 2048 + 4 * hh;
    bf16x8 kf[4]; v2u vl[2][2], vh[2][2];
#pragma unroll
    for (int ks = 0; ks < 4; ++ks) kf[ks] = *(const bf16x8*)(kbase + (size_t)t0 * 1024 + 16 * ks);
#pragma unroll
    for (int dt = 0; dt < 2; ++dt)
#pragma unroll
        for (int s2 = 0; s2 < 2; ++s2) { const bf16* vp = vbase + (size_t)dt * 32 * 2048 + t0 + 16 * s2; vl[dt][s2] = *(const v2u*)vp; vh[dt][s2] = *(const v2u*)(vp + 8); }
    for (int s0 = t0; s0 >= 0; s0 -= 32) {
        bf16x8 kn[4]; v2u vln[2][2], vhn[2][2];
        const int sn = s0 >= 32 ? s0 - 32 : 0;
#pragma unroll
        for (int ks = 0; ks < 4; ++ks) kn[ks] = *(const bf16x8*)(kbase + (size_t)sn * 1024 + 16 * ks);
#pragma unroll
        for (int dt = 0; dt < 2; ++dt)
#pragma unroll
            for (int s2 = 0; s2 < 2; ++s2) { const bf16* vp = vbase + (size_t)dt * 32 * 2048 + sn + 16 * s2; vln[dt][s2] = *(const v2u*)vp; vhn[dt][s2] = *(const v2u*)(vp + 8); }
        f32x16 z = zero16();
#pragma unroll
        for (int ks = 0; ks < 4; ++ks) z = MFMA32(kf[ks], qf[ks], z);
        const bool diag = (s0 == t0);
        f32x16 sp; float rs = 0.f;
#pragma unroll
        for (int i = 0; i < 16; ++i) {
            const float zz = z[i] * 0.125f;
            const bool valid = !diag || (crow(i, hh) < r);
            float spv = fmaxf(zz, 0.f) + __logf(1.f + __expf(-fabsf(zz)));
            spv = valid ? spv : 0.f;
            sp[i] = spv; rs += spv; z[i] = zz - spv;
        }
        f32x16 suf = zero16();
        suf = MFMA32(tri[0], pack_step<0>(sp), suf);
        suf = MFMA32(tri[1], pack_step<1>(sp), suf);
        f32x16 w;
#pragma unroll
        for (int i = 0; i < 16; ++i) {
            const bool valid = !diag || (crow(i, hh) < r);
            const float lw = z[i] - suf[i] - carry;
            w[i] = valid ? __expf(lw) : 0.f;
        }
        rs += __shfl_xor(rs, 32);
        carry += rs;
        const bf16x8 pa0 = pack_step<0>(w), pa1 = pack_step<1>(w);
        o0 = MFMA32(pa0, frag2(vl[0][0], vh[0][0]), o0); o0 = MFMA32(pa1, frag2(vl[0][1], vh[0][1]), o0);
        o1 = MFMA32(pa0, frag2(vl[1][0], vh[1][0]), o1); o1 = MFMA32(pa1, frag2(vl[1][1], vh[1][1]), o1);
        if (__all(carry > 104.f)) break;
#pragma unroll
        for (int ks = 0; ks < 4; ++ks) kf[ks] = kn[ks];
#pragma unroll
        for (int dt = 0; dt < 2; ++dt)
#pragma unroll
            for (int s2 = 0; s2 < 2; ++s2) { vl[dt][s2] = vln[dt][s2]; vh[dt][s2] = vhn[dt][s2]; }
    }
    bf16* op = YSB + (rowbase + t0) * 512 + h * 64 + r;
#pragma unroll
    for (int i = 0; i < 16; ++i) { const int t = crow(i, hh); op[(size_t)t * 512] = (bf16)f2bf(o0[i]); op[(size_t)t * 512 + 32] = (bf16)f2bf(o1[i]); }
}
__device__ __forceinline__ void sba_item(const P& p, int item, int wave, int lane) {
    const int bh = item >> 3, qb = item & 7, b = bh >> 3, h = bh & 7;
    sba_wave_item((const bf16*)(p.ws + WS_SBQKV), (const bf16*)(p.ws + WS_VT), (bf16*)(p.ws + WS_YSB), b, h, qb * 8 + wave, lane);
}

__device__ __forceinline__ void p3_yml(const P& p, int wave, int lane) {
    const int gw = blockIdx.x * NWAVES + wave, NGW = gridDim.x * NWAVES;
    bf16* YML = (bf16*)(p.ws + WS_YML); const bf16* MLO = (const bf16*)(p.ws + WS_MLO);
    for (int m = gw; m < T_; m += NGW) {
        float hv[8], ov[8], o[8];
        unpack8(*(const v4u*)(YML + (size_t)m * 512 + lane * 8), hv); unpack8(*(const v4u*)(MLO + (size_t)m * 512 + lane * 8), ov);
        float ss = 0.f;
#pragma unroll
        for (int i = 0; i < 8; ++i) ss += hv[i] * hv[i];
        ss += __shfl_xor(ss, 1); ss += __shfl_xor(ss, 2); ss += __shfl_xor(ss, 4); ss += __shfl_xor(ss, 8);
        const float rstd = 1.f / sqrtf(ss * (1.f / 128.f) + EPS);
        const f32x4 w0 = *(const f32x4*)(p.ml_norm_w + lane * 8), w1 = *(const f32x4*)(p.ml_norm_w + lane * 8 + 4);
        const float wv[8] = {w0.x, w0.y, w0.z, w0.w, w1.x, w1.y, w1.z, w1.w};
#pragma unroll
        for (int i = 0; i < 8; ++i) o[i] = sigmoidf_(ov[i]) * hv[i] * rstd * wv[i];
        *(v4u*)(YML + (size_t)m * 512 + lane * 8) = pack8(o);
    }
}

__device__ __forceinline__ void p6_hn(const P& p, int wave, int lane) {
    const int gw = blockIdx.x * NWAVES + wave, NGW = gridDim.x * NWAVES;
    const float* H = (const float*)(p.ws + WS_H); bf16* HN = (bf16*)(p.ws + WS_HN);
    for (int m = gw; m < T_; m += NGW) {
        const f32x4* xr = (const f32x4*)(H + (size_t)m * 1024) + lane; const f32x4* wr = (const f32x4*)p.norm_ffn_w + lane;
        f32x4 v[4]; float ss = 0.f;
#pragma unroll
        for (int j = 0; j < 4; ++j) { v[j] = xr[64 * j]; ss += (v[j].x * v[j].x + v[j].y * v[j].y) + (v[j].z * v[j].z + v[j].w * v[j].w); }
        const float rstd = 1.f / sqrtf(wave_sum(ss) * (1.f / 1024.f) + EPS);
        v2u* o8 = (v2u*)(HN + (size_t)m * 1024) + lane;
#pragma unroll
        for (int j = 0; j < 4; ++j) { const f32x4 w = wr[64 * j]; o8[64 * j] = (v2u){pk2(v[j].x * rstd * w.x, v[j].y * rstd * w.y), pk2(v[j].z * rstd * w.z, v[j].w * rstd * w.w)}; }
    }
}

__device__ __forceinline__ unsigned ord_key(float f) { const unsigned u = __builtin_bit_cast(unsigned, f); return (u & 0x80000000u) ? ~u : (u | 0x80000000u); }
__device__ __forceinline__ float ord_val(unsigned k) { const unsigned u = (k & 0x80000000u) ? (k & 0x7fffffffu) : ~k; return __builtin_bit_cast(float, u); }
template <int CTRL> __device__ __forceinline__ unsigned dpp_u(unsigned v) { return (unsigned)__builtin_amdgcn_update_dpp(0, (int)v, CTRL, 0xF, 0xF, true); }
__device__ __forceinline__ unsigned umax_(unsigned a, unsigned b) { return a > b ? a : b; }
__device__ __forceinline__ unsigned umin_(unsigned a, unsigned b) { return a < b ? a : b; }
__device__ __forceinline__ unsigned row_max_u(unsigned v) {
    v = umax_(v, dpp_u<0xB1>(v)); v = umax_(v, dpp_u<0x4E>(v)); v = umax_(v, dpp_u<0x141>(v)); v = umax_(v, dpp_u<0x140>(v)); return v;
}
__device__ __forceinline__ float row_sum_f(float v) {
    v += __builtin_bit_cast(float, dpp_u<0xB1>(__builtin_bit_cast(unsigned, v))); v += __builtin_bit_cast(float, dpp_u<0x4E>(__builtin_bit_cast(unsigned, v)));
    v += __builtin_bit_cast(float, dpp_u<0x141>(__builtin_bit_cast(unsigned, v))); v += __builtin_bit_cast(float, dpp_u<0x140>(__builtin_bit_cast(unsigned, v))); return v;
}
#define CE_(i, j) do { const unsigned _a = k[i], _b = k[j]; k[i] = umax_(_a, _b); k[j] = umin_(_a, _b); } while (0)
__device__ __forceinline__ unsigned row_top16(unsigned (&k)[8], unsigned (&top)[16], int li) {
    CE_(0, 1); CE_(2, 3); CE_(4, 5); CE_(6, 7); CE_(0, 2); CE_(1, 3); CE_(4, 6); CE_(5, 7); CE_(1, 2); CE_(5, 6);
    CE_(0, 4); CE_(1, 5); CE_(2, 6); CE_(3, 7); CE_(2, 4); CE_(3, 5); CE_(1, 2); CE_(3, 4); CE_(5, 6);
    unsigned mine = 0u;
#pragma unroll
    for (int n = 0; n < 16; ++n) {
        const unsigned m = row_max_u(k[0]);
        const bool hit = k[0] == m;
#pragma unroll
        for (int i = 0; i < 7; ++i) k[i] = hit ? k[i + 1] : k[i];
        k[7] = hit ? 0u : k[7];
        top[n] = m; mine = (li == n) ? m : mine;
    }
    return mine;
}
__device__ __forceinline__ void p8_topk(const P& p, int hh, int wave, int lane) {
    const int gw = blockIdx.x * NWAVES + wave, NGW = gridDim.x * NWAVES;
    const float* SC = (const float*)(p.ws + WS_SC); int* IDX = (int*)(p.ws + WS_IDX); float* GATE = (float*)(p.ws + WS_GATE);
    const int q = lane >> 4, li = lane & 15, head = hh * 4 + q;
    for (int m = gw; m < T_; m += NGW) {
        const float* sr = SC + (size_t)m * 1024 + q * 256;
        unsigned k[8], top1[16], top2[16];
#pragma unroll
        for (int j = 0; j < 8; ++j) k[j] = (ord_key(sr[li + 16 * j]) & ~0x7fu) | (unsigned)(127 - (li + 16 * j));
        const unsigned mine1 = row_top16(k, top1, li);
#pragma unroll
        for (int j = 0; j < 8; ++j) k[j] = (ord_key(sr[128 + li + 16 * j]) & ~0x7fu) | (unsigned)(127 - (li + 16 * j));
        const unsigned mine2 = row_top16(k, top2, li);
        const float v2 = ord_val(mine2 & ~0x7fu);
        unsigned c[16];
#pragma unroll
        for (int j = 0; j < 16; ++j) {
            const float v1 = ord_val(top1[j] & ~0x7fu);
            const unsigned key = (ord_key(v1 + v2) & ~0xffu) | (unsigned)(255 - (16 * j + li));
            c[j] = ((j + 1) * (li + 1) <= 16) ? key : 0u;
        }
        unsigned tk = 0u, t0 = 0u;
#pragma unroll
        for (int n = 0; n < 16; ++n) {
            const unsigned mx = row_max_u(c[0]);
            const bool hit = c[0] == mx;
#pragma unroll
            for (int i = 0; i < 15; ++i) c[i] = hit ? c[i + 1] : c[i];
            c[15] = hit ? 0u : c[15];
            if (n == 0) t0 = mx;
            tk = (li == n) ? mx : tk;
        }
        const float sv = ord_val(tk & ~0xffu), s0 = ord_val(t0 & ~0xffu);
        const int cc = 255 - (int)(tk & 0xffu), a = (cc >> 4) & 15, bb = cc & 15;
        const int i1 = 127 - (int)((unsigned)__shfl((int)mine1, (lane & 48) + a) & 0x7fu), i2 = 127 - (int)((unsigned)__shfl((int)mine2, (lane & 48) + bb) & 0x7fu);
        const float pe = expf(sv - s0);
        const float den = row_sum_f(pe);
        IDX[(size_t)m * 128 + head * 16 + li] = i1 * 128 + i2; GATE[(size_t)m * 128 + head * 16 + li] = pe / den;
    }
}

__device__ __forceinline__ float gelu_erf(float x) { return 0.5f * x * (1.f + erff(x * 0.70710678118654752f)); }
typedef float f32x2 __attribute__((ext_vector_type(2)));
__device__ __forceinline__ void cvt16_fp8(const v4u& w, f32x2 (&f)[8]) {
    f[0] = __builtin_amdgcn_cvt_pk_f32_fp8((int)w.x, false); f[1] = __builtin_amdgcn_cvt_pk_f32_fp8((int)w.x, true);
    f[2] = __builtin_amdgcn_cvt_pk_f32_fp8((int)w.y, false); f[3] = __builtin_amdgcn_cvt_pk_f32_fp8((int)w.y, true);
    f[4] = __builtin_amdgcn_cvt_pk_f32_fp8((int)w.z, false); f[5] = __builtin_amdgcn_cvt_pk_f32_fp8((int)w.z, true);
    f[6] = __builtin_amdgcn_cvt_pk_f32_fp8((int)w.w, false); f[7] = __builtin_amdgcn_cvt_pk_f32_fp8((int)w.w, true);
}
__device__ __forceinline__ constexpr int peer_lane_of(int u) { return 8 * ((u >> 2) & 1) + 16 * ((u >> 1) & 1) + 32 * (u & 1); }
__device__ __forceinline__ void p9_peer(const P& p, int wave, int lane) {
    const int gw = blockIdx.x * NWAVES + wave, NGW = gridDim.x * NWAVES;
    const float* H = (const float*)(p.ws + WS_H); const bf16* HN = (const bf16*)(p.ws + WS_HN);
    const int* IDX = (const int*)(p.ws + WS_IDX); const float* GATE = (const float*)(p.ws + WS_GATE);
    const unsigned char* U8 = p.ws + WS_U8; const unsigned char* V8 = p.ws + WS_V8; const float* USC = (const float*)(p.ws + WS_USC); const float* VSC = (const float*)(p.ws + WS_VSC);
    const int eid = 4 * ((lane >> 3) & 1) + 2 * ((lane >> 4) & 1) + ((lane >> 5) & 1);
    const bool b5 = (lane & 32) != 0, b4 = (lane & 16) != 0, b3 = (lane & 8) != 0;
    for (int m = gw; m < T_; m += NGW) {
        f32x2 xv[8], acc[8];
        { float f[8]; const v4u h0 = *(const v4u*)(HN + (size_t)m * 1024 + 16 * lane), h1 = *(const v4u*)(HN + (size_t)m * 1024 + 16 * lane + 8);
          unpack8(h0, f);
#pragma unroll
          for (int i = 0; i < 4; ++i) xv[i] = (f32x2){f[2 * i], f[2 * i + 1]};
          unpack8(h1, f);
#pragma unroll
          for (int i = 0; i < 4; ++i) xv[4 + i] = (f32x2){f[2 * i], f[2 * i + 1]}; }
#pragma unroll
        for (int i = 0; i < 8; ++i) acc[i] = (f32x2){0.f, 0.f};
        int e_l = IDX[(size_t)m * 128 + eid]; float g_l = GATE[(size_t)m * 128 + eid];
#pragma unroll 1
        for (int j0 = 0; j0 < 128; j0 += 8) {
            int ei[8];
#pragma unroll
            for (int u = 0; u < 8; ++u) ei[u] = __builtin_amdgcn_readlane(e_l, peer_lane_of(u));
            v4u ur[8], vr[8];
#pragma unroll
            for (int u = 0; u < 8; ++u) ur[u] = *(const v4u*)(U8 + (size_t)ei[u] * 1024 + 16 * lane);
            const float usc = USC[e_l], vsc = VSC[e_l], g_cur = g_l;
#pragma unroll
            for (int u = 0; u < 8; ++u) vr[u] = *(const v4u*)(V8 + (size_t)ei[u] * 1024 + 16 * lane);
            const int jn = j0 + 8 < 128 ? j0 + 8 : j0;
            e_l = IDX[(size_t)m * 128 + jn + eid]; g_l = GATE[(size_t)m * 128 + jn + eid];
            float d[8];
#pragma unroll
            for (int u = 0; u < 8; ++u) {
                f32x2 f[8]; cvt16_fp8(ur[u], f);
                f32x2 s2 = f[0] * xv[0];
#pragma unroll
                for (int i = 1; i < 8; ++i) s2 += f[i] * xv[i];
                d[u] = s2.x + s2.y;
            }
            float e4[4], f2[2], gsum;
#pragma unroll
            for (int i = 0; i < 4; ++i) { const float keep = b5 ? d[2 * i + 1] : d[2 * i], send = b5 ? d[2 * i] : d[2 * i + 1]; e4[i] = keep + __shfl_xor(send, 32); }
#pragma unroll
            for (int i = 0; i < 2; ++i) { const float keep = b4 ? e4[2 * i + 1] : e4[2 * i], send = b4 ? e4[2 * i] : e4[2 * i + 1]; f2[i] = keep + __shfl_xor(send, 16); }
            { const float keep = b3 ? f2[1] : f2[0], send = b3 ? f2[0] : f2[1]; gsum = keep + __shfl_xor(send, 8); }
            gsum += __builtin_bit_cast(float, dpp_u<0xB1>(__builtin_bit_cast(unsigned, gsum)));
            gsum += __builtin_bit_cast(float, dpp_u<0x4E>(__builtin_bit_cast(unsigned, gsum)));
            gsum += __builtin_bit_cast(float, dpp_u<0x141>(__builtin_bit_cast(unsigned, gsum)));
            const float coef_l = g_cur * gelu_erf(gsum * usc) * vsc;
#pragma unroll
            for (int u = 0; u < 8; ++u) {
                const float cu = __builtin_bit_cast(float, __builtin_amdgcn_readlane(__builtin_bit_cast(int, coef_l), peer_lane_of(u)));
                const f32x2 c2 = (f32x2){cu, cu};
                f32x2 f[8]; cvt16_fp8(vr[u], f);
#pragma unroll
                for (int i = 0; i < 8; ++i) acc[i] += c2 * f[i];
            }
        }
        float y[16], ss = 0.f;
#pragma unroll
        for (int j = 0; j < 4; ++j) { const f32x4 hv = *(const f32x4*)(H + (size_t)m * 1024 + 16 * lane + 4 * j);
            y[4 * j] = hv.x + acc[2 * j].x; y[4 * j + 1] = hv.y + acc[2 * j].y; y[4 * j + 2] = hv.z + acc[2 * j + 1].x; y[4 * j + 3] = hv.w + acc[2 * j + 1].y; }
#pragma unroll
        for (int i = 0; i < 16; ++i) ss += y[i] * y[i];
        const float rstd = 1.f / sqrtf(wave_sum(ss) * (1.f / 1024.f) + EPS);
#pragma unroll
        for (int j = 0; j < 4; ++j) { const f32x4 w = *(const f32x4*)(p.norm_final_w + 16 * lane + 4 * j);
            *(f32x4*)(p.out + (size_t)m * 1024 + 16 * lane + 4 * j) = (f32x4){y[4 * j] * rstd * w.x, y[4 * j + 1] * rstd * w.y, y[4 * j + 2] * rstd * w.z, y[4 * j + 3] * rstd * w.w}; }
    }
}

constexpr int N_PHASES = 12;
struct Args { P p; int ph_lo, ph_hi; };
__global__ void __launch_bounds__(NTHR, 2) fwd_kernel(Args args) {
    extern __shared__ __attribute__((aligned(16))) unsigned char lds_raw[];
    LAS unsigned char* lds = (LAS unsigned char*)lds_raw;
    const P& p = args.p;
    const int tid = threadIdx.x, lane = tid & 63, wave = __builtin_amdgcn_readfirstlane(tid >> 6);
    volatile LAS unsigned* MISC = (volatile LAS unsigned*)(lds + MISC_OFF);
    for (int u = tid; u < (LDS_BYTES - LDSCTL_OFF) / 4; u += NTHR) ((LAS unsigned*)(lds + LDSCTL_OFF))[u] = 0u;
    __syncthreads();
    XcdBarrier bar; bar.bar = (unsigned*)(p.ws + WS_CTL) + CW_BAR; bar.x = 0; bar.st = nullptr;
#if !MK_PER_PHASE
    bar = xcd_barrier_post((unsigned*)(p.ws + WS_CTL) + CW_BAR, MISC + 8);
#endif
    const int lo = args.ph_lo, hi = args.ph_hi;
#define IN(k) (lo <= (k) && (k) < hi)
#define SEAM(k) do { if (IN(k) && IN((k) + 1)) xcd_barrier(bar); } while (0)

#ifndef PROBE_REP
#define PROBE_REP -1
#endif
#define REP(k) ((PROBE_REP == (k)) ? 2 : 1)
    if (IN(0)) {
#pragma unroll 1
        for (int r = 0; r < REP(0); ++r) p0_prologue(p, lds, wave, lane); } SEAM(0);
    if (IN(1)) {
#pragma unroll 1
      for (int r = 0; r < REP(1); ++r) {
        EpiProj e{(bf16*)(p.ws + WS_SBQKV), (bf16*)(p.ws + WS_VT), (bf16*)(p.ws + WS_MLQK), (bf16*)(p.ws + WS_MLV), (bf16*)(p.ws + WS_MLO), (bf16*)(p.ws + WS_GATES)};
        gemm<EpiProj>(lds, (const bf16*)(p.ws + WS_XN), (const bf16*)(p.ws + WS_W1T), T_, NPROJ, 1024, e); }
    } SEAM(1);
    if (IN(2)) {
        for (int it = blockIdx.x; it < 64; it += gridDim.x) mlstm_item(p, lds, it, tid, wave, lane);
        unsigned* qctr = (unsigned*)(p.ws + WS_CTL) + CW_Q;
        for (;;) {
            if (tid == 0) MISC[12] = __hip_atomic_fetch_add(qctr, 1u, __ATOMIC_RELAXED, __HIP_MEMORY_SCOPE_AGENT);
            __syncthreads();
            const unsigned it = MISC[12];
            __syncthreads();
            if (it >= 1024u) break;
            sba_item(p, (int)it, wave, lane);
        }
    } SEAM(2);
    if (IN(3)) { p3_yml(p, wave, lane); } SEAM(3);
    if (IN(4)) {
        EpiMergeA ea{(bf16*)(p.ws + WS_MERGED), (const bf16*)(p.ws + WS_GATES)};
        gemm<EpiMergeA>(lds, (const bf16*)(p.ws + WS_YSB), (const bf16*)(p.ws + WS_WSBT), T_, 1024, 512, ea);
        VM_WAIT(); __syncthreads();
        EpiMergeB eb{(bf16*)(p.ws + WS_MERGED), (const bf16*)(p.ws + WS_GATES)};
        gemm<EpiMergeB>(lds, (const bf16*)(p.ws + WS_YML), (const bf16*)(p.ws + WS_WMLT), T_, 1024, 512, eb);
    } SEAM(4);
    if (IN(5)) {
#pragma unroll 1
      for (int r = 0; r < REP(5); ++r) {
        EpiH e{(float*)(p.ws + WS_H), p.x};
        gemm<EpiH>(lds, (const bf16*)(p.ws + WS_MERGED), (const bf16*)(p.ws + WS_WOUTT), T_, 1024, 1024, e); }
    } SEAM(5);
    if (IN(6)) { p6_hn(p, wave, lane); } SEAM(6);
    if (IN(7)) { EpiF32 e{(float*)(p.ws + WS_SC), 1024}; gemm<EpiF32>(lds, (const bf16*)(p.ws + WS_HN), (const bf16*)(p.ws + WS_WCT), T_, 1024, 1024, e); } SEAM(7);
    if (IN(8)) {
#pragma unroll 1
        for (int r = 0; r < REP(8); ++r) p8_topk(p, 0, wave, lane); } SEAM(8);
    if (IN(9)) { EpiF32 e{(float*)(p.ws + WS_SC), 1024}; gemm<EpiF32>(lds, (const bf16*)(p.ws + WS_HN), (const bf16*)(p.ws + WS_WCT) + (size_t)1024 * 1024, T_, 1024, 1024, e); } SEAM(9);
    if (IN(10)) { p8_topk(p, 1, wave, lane); } SEAM(10);
    if (IN(11)) {
#pragma unroll 1
        for (int r = 0; r < REP(11); ++r) p9_peer(p, wave, lane); }
#undef IN
#undef SEAM
}

extern "C" void kernel_launch(void* const* d_in, const int* in_sizes, int n_in, void* d_out, int out_size, void* d_ws, size_t ws_size, hipStream_t stream) {
    static int grid = 0;
    if (grid == 0) {
        if (n_in != 18 || in_sizes[0] != T_ * D_ || out_size != T_ * D_ || ws_size < WS_END) {
            fprintf(stderr, "kernel_launch: unexpected problem (n_in %d, in0 %d, out %d, ws %zu); nothing launched\n", n_in, n_in > 0 ? in_sizes[0] : -1, out_size, ws_size); grid = -1; return; }
        int dev = 0, cus = 0, per_cu = 0;
        if (hipGetDevice(&dev) != hipSuccess || hipDeviceGetAttribute(&cus, hipDeviceAttributeMultiprocessorCount, dev) != hipSuccess) { grid = -1; return; }
        if (hipFuncSetAttribute((const void*)fwd_kernel, hipFuncAttributeMaxDynamicSharedMemorySize, LDS_BYTES) != hipSuccess) { fprintf(stderr, "kernel_launch: hipFuncSetAttribute failed\n"); grid = -1; return; }
        if (hipOccupancyMaxActiveBlocksPerMultiprocessor(&per_cu, (const void*)fwd_kernel, NTHR, LDS_BYTES) != hipSuccess || per_cu < 1)
            fprintf(stderr, "kernel_launch: note: occupancy query reports %d workgroups per CU\n", per_cu);
        (void)hipGetLastError();
        grid = cus;
    }
    if (grid < 0) return;
    if (hipMemsetAsync((char*)d_ws + WS_CTL, 0, CTL_ZERO_BYTES, stream) != hipSuccess) { fprintf(stderr, "kernel_launch: memset failed\n"); return; }
    Args a{};
    const float** pp = (const float**)&a.p;
    for (int i = 0; i < 18; ++i) pp[i] = (const float*)d_in[i];
    a.p.out = (float*)d_out; a.p.ws = (unsigned char*)d_ws;
#if MK_PER_PHASE
    for (int ph = 0; ph < N_PHASES; ++ph) {
        a.ph_lo = ph; a.ph_hi = ph + 1;
        hipLaunchKernelGGL(fwd_kernel, dim3(grid), dim3(NTHR), LDS_BYTES, stream, a);
    }
#else
    a.ph_lo = 0; a.ph_hi = N_PHASES;
    hipLaunchKernelGGL(fwd_kernel, dim3(grid), dim3(NTHR), LDS_BYTES, stream, a);
#endif
    const hipError_t le = hipPeekAtLastError();
    if (le != hipSuccess) fprintf(stderr, "kernel_launch: launch failed: %s\n", hipGetErrorName(le));
}
```

```cpp
#include <hip/hip_runtime.h>
#include <cstdio>
#include <cstdint>
namespace pg8 {
#define PG8_LAS __attribute__((address_space(3)))
typedef unsigned short bf16_t;
typedef short bf16x8 __attribute__((ext_vector_type(8)));
typedef float f32x4 __attribute__((ext_vector_type(4)));
typedef unsigned u32x4 __attribute__((ext_vector_type(4)));
constexpr int BM = 256, BK = 64, HALF = 128, HTB = HALF * BK * 2  , STAGE_BYTES = 8 * HTB, NXCD = 8, WGM = 8;

__host__ __device__ __forceinline__ int lds_byte(int r, int c) { const int st = (r >> 4) * 2 + (c >> 5), rr = r & 15, cc = c & 31, ob = rr * 64 + cc * 2; return st * 1024 + (ob ^ (((ob >> 9) & 1) << 5)); }
__host__ __device__ __forceinline__ void stage_rc(int b, int& R, int& C) { const int st = b / 1024, sb = b % 1024, swz = sb ^ (((sb >> 9) & 1) << 5); R = (st >> 1) * 16 + swz / 64; C = (st & 1) * 32 + (swz % 64) / 2; }
__host__ __device__ __forceinline__ int perm32(int rho) { const int n = rho >> 4, i = rho & 15; return 8 * (i >> 2) + 4 * n + (i & 3); }

struct Unit { int pm, pn; };
struct Gemm { const bf16_t* A; const bf16_t* Bt; int M, N, K; };

struct StaticOrder {
    int nM, nN, nwg, G, c;
    __host__ __device__ void init(int M, int N, int G_, int c_) { nM = M / BM; nN = N / BM; nwg = nM * nN; G = G_; c = c_; }
    __host__ __device__ bool next(int i, Unit& u) const {
        const long L = (long)i * G + c; if (L >= nwg) return false;
        int wgid = (int)L; { const int q = nwg / NXCD, r = nwg % NXCD, xcd = wgid % NXCD, off = wgid / NXCD; wgid = (xcd < r ? xcd * (q + 1) : r * (q + 1) + (xcd - r) * q) + off; }
        const int nig = WGM * nN, gid = wgid / nig, fm = gid * WGM, gsz = (nM - fm) < WGM ? (nM - fm) : WGM;
        u.pm = fm + ((wgid % nig) % gsz); u.pn = (wgid % nig) / gsz; return true;
    }
    __device__ __forceinline__ void a_ready(const Unit&) const {}
    __device__ __forceinline__ void done(const Unit&) const {}
};

__device__ __forceinline__ unsigned cvt_pk_bf16(float lo, float hi) { unsigned r; asm volatile("v_cvt_pk_bf16_f32 %0, %1, %2" : "=v"(r) : "v"(lo), "v"(hi)); return r; }
template <class Epi, class Sched, bool ALIGN_EPI = false, bool SP2 = false>
__device__ __forceinline__ void gemm_phase(PG8_LAS unsigned char* lds, const Gemm g, const Sched& S, const Epi& E) {
    const int tid = threadIdx.x, wid = __builtin_amdgcn_readfirstlane(tid >> 6), lane = tid & 63, wr = wid >> 2, wc = wid & 3, fr = lane & 15, fq = lane >> 4;
    const int K = g.K, nt = K / BK;
    unsigned voffA[2], voffB[2];
#pragma unroll
    for (int i = 0; i < 2; ++i) { int R, C; stage_rc(tid * 16 + i * 8192, R, C); const int Rb = Epi::PERM ? ((R & ~31) + perm32(R & 31)) : R;
        voffA[i] = (unsigned)(R * K + C) * 2u; voffB[i] = (unsigned)(Rb * K + C) * 2u; }
    const size_t kstep = (size_t)(BK * 2);
    const size_t hstep = (size_t)HALF * K * 2;
    const size_t tstep = 2 * hstep;
    const unsigned ldsw = (unsigned)wid * 1024u;
    const int aoff = lds_byte(wr * 64 + fr, fq * 8), boff = lds_byte(wc * 32 + fr, fq * 8);
#define PG8_SA(b, h) (((b) * 2 + (h)) * HTB)
#define PG8_SB(b, h) ((4 + (b) * 2 + (h)) * HTB)
#define PG8_STAGE(bufoff, gbase, voff) do { _Pragma("unroll") for (int _i = 0; _i < 2; ++_i) \
        __builtin_amdgcn_global_load_lds((const unsigned*)((const char*)(gbase) + (voff)[_i]), (PG8_LAS unsigned*)(lds + (bufoff) + ldsw + _i * 8192), 16, 0, 0); } while (0)
#define PG8_LDA(dst, b, h) do { _Pragma("unroll") for (int m = 0; m < 4; ++m) _Pragma("unroll") for (int k = 0; k < 2; ++k) dst[m][k] = *(const PG8_LAS bf16x8*)(lds + PG8_SA(b, h) + aoff + m * 2048 + k * 1024); } while (0)
#define PG8_LDB(dst, b, h) do { _Pragma("unroll") for (int n = 0; n < 2; ++n) _Pragma("unroll") for (int k = 0; k < 2; ++k) dst[n][k] = *(const PG8_LAS bf16x8*)(lds + PG8_SB(b, h) + boff + n * 2048 + k * 1024); } while (0)
#define PG8_MMA(ai, bj, At, Bt) do { __builtin_amdgcn_s_setprio(1); _Pragma("unroll") for (int m = 0; m < 4; ++m) _Pragma("unroll") for (int n = 0; n < 2; ++n) _Pragma("unroll") for (int k = 0; k < 2; ++k) \
        acc[ai][bj][m][n] = __builtin_amdgcn_mfma_f32_16x16x32_bf16(Bt[n][k], At[m][k], acc[ai][bj][m][n], 0, 0, 0); __builtin_amdgcn_s_setprio(0); } while (0)
#define PG8_WAIT_V(n) asm volatile("s_waitcnt vmcnt(" #n ")" ::: "memory")
#define PG8_WAIT_L(n) asm volatile("s_waitcnt lgkmcnt(" #n ")" ::: "memory")
#define PG8_BAR __builtin_amdgcn_s_barrier()
#define PG8_SCHED __builtin_amdgcn_sched_barrier(0)
    Unit cur, nxt; int ui = 0;
    if (!S.next(0, cur)) return;
    f32x4 acc[2][2][4][2];
#pragma unroll
    for (int a = 0; a < 2; ++a)
#pragma unroll
        for (int b = 0; b < 2; ++b)
#pragma unroll
            for (int m = 0; m < 4; ++m)
#pragma unroll
                for (int n = 0; n < 2; ++n) acc[a][b][m][n] = (f32x4){0.f, 0.f, 0.f, 0.f};
    bf16x8 At[4][2], B0[2][2], B1[2][2];
    const char* cA = (const char*)g.A + (size_t)cur.pm * tstep; const char* cB = (const char*)g.Bt + (size_t)cur.pn * tstep;
    S.a_ready(cur);
    if constexpr (SP2) {
        PG8_STAGE(PG8_SB(0, 0), cB, voffB); PG8_STAGE(PG8_SB(0, 1), cB + hstep, voffB); PG8_STAGE(PG8_SA(0, 0), cA, voffA); PG8_STAGE(PG8_SA(0, 1), cA + hstep, voffA);
        if (wr == 1) PG8_BAR;
        PG8_WAIT_V(2); PG8_BAR;
        PG8_STAGE(PG8_SB(1, 0), cB + kstep, voffB); PG8_STAGE(PG8_SA(1, 0), cA + kstep, voffA); PG8_STAGE(PG8_SB(1, 1), cB + hstep + kstep, voffB);
        PG8_WAIT_V(6); PG8_BAR;
    } else {
        PG8_STAGE(PG8_SB(0, 0), cB, voffB); PG8_STAGE(PG8_SA(0, 0), cA, voffA); PG8_STAGE(PG8_SB(0, 1), cB + hstep, voffB); PG8_STAGE(PG8_SA(0, 1), cA + hstep, voffA);
        if (wr == 1) PG8_BAR;
        PG8_WAIT_V(4); PG8_BAR;
        PG8_STAGE(PG8_SB(1, 0), cB + kstep, voffB); PG8_STAGE(PG8_SA(1, 0), cA + kstep, voffA); PG8_STAGE(PG8_SB(1, 1), cB + hstep + kstep, voffB);
        PG8_WAIT_V(6); PG8_BAR;
    }
    for (;;) {
        const bool has_next = S.next(ui + 1, nxt);
        const char* nA = has_next ? (const char*)g.A + (size_t)nxt.pm * tstep : cA; const char* nB = has_next ? (const char*)g.Bt + (size_t)nxt.pn * tstep : cB;
        for (int t = 0; t < nt; t += 2) {
            const bool last = (t == nt - 2);
            const char* a1 = cA + (size_t)(t + 1) * kstep;
            const char* a2 = last ? nA : cA + (size_t)(t + 2) * kstep; const char* b2 = last ? nB : cB + (size_t)(t + 2) * kstep;
            const char* a3 = a2 + kstep; const char* b3 = b2 + kstep;
            if (last && has_next) S.a_ready(nxt);
            if constexpr (SP2) {
            PG8_LDB(B0, 0, 0); PG8_LDB(B1, 0, 1); PG8_SCHED; PG8_LDA(At, 0, 0); PG8_STAGE(PG8_SA(1, 1), a1 + hstep, voffA);
            PG8_WAIT_V(8); PG8_WAIT_L(0); PG8_BAR; PG8_MMA(0, 0, At, B0); PG8_MMA(0, 1, At, B1); PG8_BAR; PG8_SCHED;
            PG8_LDA(At, 0, 1); PG8_STAGE(PG8_SB(0, 0), b2, voffB); PG8_STAGE(PG8_SB(0, 1), b2 + hstep, voffB); PG8_STAGE(PG8_SA(0, 0), a2, voffA);
            PG8_WAIT_V(8); PG8_WAIT_L(0); PG8_BAR; PG8_MMA(1, 0, At, B0); PG8_MMA(1, 1, At, B1); PG8_BAR; PG8_SCHED;
            PG8_LDB(B0, 1, 0); PG8_LDB(B1, 1, 1); PG8_SCHED; PG8_LDA(At, 1, 0); PG8_STAGE(PG8_SA(0, 1), a2 + hstep, voffA);
            PG8_WAIT_V(8); PG8_WAIT_L(0); PG8_BAR; PG8_MMA(0, 0, At, B0); PG8_MMA(0, 1, At, B1); PG8_BAR; PG8_SCHED;
            PG8_LDA(At, 1, 1); PG8_STAGE(PG8_SB(1, 0), b3, voffB); PG8_STAGE(PG8_SB(1, 1), b3 + hstep, voffB); PG8_STAGE(PG8_SA(1, 0), a3, voffA);
            PG8_WAIT_V(8); PG8_WAIT_L(0); PG8_BAR; PG8_MMA(1, 0, At, B0); PG8_MMA(1, 1, At, B1); PG8_BAR; PG8_SCHED;
            } else {
            PG8_LDB(B0, 0, 0); PG8_SCHED; PG8_LDA(At, 0, 0); PG8_STAGE(PG8_SA(1, 1), a1 + hstep, voffA);
            PG8_WAIT_L(8); PG8_BAR; PG8_WAIT_L(0); PG8_MMA(0, 0, At, B0); PG8_BAR; PG8_SCHED;
            PG8_LDB(B1, 0, 1); PG8_STAGE(PG8_SB(0, 0), b2, voffB);
            PG8_BAR; PG8_WAIT_L(0); PG8_MMA(0, 1, At, B1); PG8_BAR;
            PG8_LDA(At, 0, 1); PG8_STAGE(PG8_SA(0, 0), a2, voffA);
            PG8_BAR; PG8_WAIT_L(0); PG8_MMA(1, 0, At, B0); PG8_BAR; PG8_SCHED;
            PG8_STAGE(PG8_SB(0, 1), b2 + hstep, voffB);
            PG8_WAIT_V(6); PG8_BAR; PG8_MMA(1, 1, At, B1); PG8_BAR;
            PG8_LDB(B0, 1, 0); PG8_SCHED; PG8_LDA(At, 1, 0); PG8_STAGE(PG8_SA(0, 1), a2 + hstep, voffA);
            PG8_WAIT_L(8); PG8_BAR; PG8_WAIT_L(0); PG8_MMA(0, 0, At, B0); PG8_BAR; PG8_SCHED;
            PG8_LDB(B1, 1, 1); PG8_STAGE(PG8_SB(1, 0), b3, voffB);
            PG8_BAR; PG8_WAIT_L(0); PG8_MMA(0, 1, At, B1); PG8_BAR;
            PG8_LDA(At, 1, 1); PG8_STAGE(PG8_SA(1, 0), a3, voffA);
            PG8_BAR; PG8_WAIT_L(0); PG8_MMA(1, 0, At, B0); PG8_BAR; PG8_SCHED;
            PG8_STAGE(PG8_SB(1, 1), b3 + hstep, voffB);
            PG8_WAIT_V(6); PG8_BAR; PG8_MMA(1, 1, At, B1); PG8_BAR;
            }
        }
        if constexpr (ALIGN_EPI) { if (wr == 0) PG8_BAR; }
        if constexpr (!Epi::AFTER_DRAIN) { E(acc, cur, wr, wc, fr, fq); S.done(cur); }
        if (!has_next) break;
#pragma unroll
        for (int a = 0; a < 2; ++a)
#pragma unroll
            for (int b = 0; b < 2; ++b)
#pragma unroll
                for (int m = 0; m < 4; ++m)
#pragma unroll
                    for (int n = 0; n < 2; ++n) acc[a][b][m][n] = (f32x4){0.f, 0.f, 0.f, 0.f};
        cur = nxt; cA = nA; cB = nB; ++ui;
        if constexpr (ALIGN_EPI) { if (wr == 1) PG8_BAR; }
    }
    PG8_WAIT_V(0);
    if constexpr (!ALIGN_EPI) { if (wr == 0) PG8_BAR; }
    PG8_BAR;
    if constexpr (Epi::AFTER_DRAIN) { E.fused(acc, cur, wr, wc, fr, fq, lds, wid, lane); S.done(cur); }
#undef PG8_SA
#undef PG8_SB
#undef PG8_STAGE
#undef PG8_LDA
#undef PG8_LDB
#undef PG8_MMA
#undef PG8_WAIT_V
#undef PG8_WAIT_L
#undef PG8_BAR
#undef PG8_SCHED
}
}

#ifndef MK_PER_PHASE
#define MK_PER_PHASE 0
#endif
#ifndef USE_PG8
#define USE_PG8 1
#endif
constexpr int NWAVES = 8, NTHR = 512;

constexpr int B_ = 16, S_ = 2048, D_ = 1024, T_ = B_ * S_;
constexpr int INC = 5640, NPROJ = 5632;
constexpr int NEXP = 16384;
constexpr float EPS = 1e-6f;

constexpr size_t MiB = 1u << 20;
constexpr size_t WS_CTL = 0, CTL_ZERO_BYTES = 1 * MiB;
constexpr size_t WS_W1T = 2 * MiB, WS_WSBT = 13 * MiB, WS_WMLT = 14 * MiB, WS_WOUTT = 15 * MiB, WS_WCT = 17 * MiB, WS_IFG = 21 * MiB;
constexpr size_t WS_U8 = 24 * MiB, WS_V8 = 40 * MiB, WS_USC = 22 * MiB, WS_VSC = 23 * MiB;
constexpr size_t WS_XN = 88 * MiB, WS_QC = 88 * MiB, WS_KC = 120 * MiB;
constexpr size_t WS_SBQKV = 152 * MiB  , WS_VT = 216 * MiB  , WS_MLQK = 248 * MiB, WS_MLV = 312 * MiB, WS_MLO = 344 * MiB, WS_GATES = 376 * MiB;
constexpr size_t WS_MERGED = 216 * MiB, WS_H = 88 * MiB, WS_HN = 216 * MiB, WS_IDX = 280 * MiB, WS_GATE = 296 * MiB, WS_SC = 312 * MiB;
constexpr size_t WS_END = 504 * MiB;
constexpr int CW_BAR = 4096, CW_Q = 8192;

constexpr int RING_OFF = 0, RING_BYTES = 131072;
constexpr int LDSCTL_OFF = RING_BYTES, MISC_OFF = LDSCTL_OFF + 320;
constexpr int LDS_BYTES = 147456;

#define GAS __attribute__((address_space(1)))
#define LAS __attribute__((address_space(3)))
typedef unsigned short bf16;
typedef unsigned v4u __attribute__((ext_vector_type(4)));
typedef unsigned v2u __attribute__((ext_vector_type(2)));
typedef float f32x4 __attribute__((ext_vector_type(4)));
#define LDS_WAIT() asm volatile("s_waitcnt lgkmcnt(0)" ::: "memory")
#define VM_WAIT() asm volatile("s_waitcnt vmcnt(0)" ::: "memory")
__device__ __forceinline__ unsigned f2bf(float f) { unsigned u = __builtin_bit_cast(unsigned, f); return (u + 0x7fffu + ((u >> 16) & 1u)) >> 16; }
__device__ __forceinline__ unsigned pk2(float lo, float hi) { return f2bf(lo) | (f2bf(hi) << 16); }
__device__ __forceinline__ float bflo(unsigned u) { return __builtin_bit_cast(float, u << 16); }
__device__ __forceinline__ float bfhi(unsigned u) { return __builtin_bit_cast(float, u & 0xffff0000u); }
__device__ __forceinline__ float bf2f(bf16 b) { return __builtin_bit_cast(float, (unsigned)b << 16); }
__device__ __forceinline__ float sigmoidf_(float x) { return 1.f / (1.f + __expf(-x)); }
__device__ __forceinline__ float wave_sum(float v) {
#pragma unroll
    for (int o = 1; o < 64; o <<= 1) v += __shfl_xor(v, o);
    return v;
}
__device__ __forceinline__ unsigned wave_max_u(unsigned v) {
#pragma unroll
    for (int o = 1; o < 64; o <<= 1) { const unsigned w = (unsigned)__shfl_xor((int)v, o); v = v > w ? v : w; }
    return v;
}
struct F8 { float v[8]; };
__device__ __forceinline__ void unpack8(const v4u& u, float (&f)[8]) {
    f[0] = bflo(u.x); f[1] = bfhi(u.x); f[2] = bflo(u.y); f[3] = bfhi(u.y); f[4] = bflo(u.z); f[5] = bfhi(u.z); f[6] = bflo(u.w); f[7] = bfhi(u.w);
}
__device__ __forceinline__ v4u pack8(const float (&f)[8]) { v4u o; o.x = pk2(f[0], f[1]); o.y = pk2(f[2], f[3]); o.z = pk2(f[4], f[5]); o.w = pk2(f[6], f[7]); return o; }

#define XB_TMO      128
#define XB_XCNT(j)  (256  + 64 * (j))
#define XB_XSUB(j)  (1280 + 64 * (j))
#define XB_XGEN(j)  (2304 + 64 * (j))
#define XB_TOP      3328
#define XB_TOPGEN   3392
#define XCD_BAR_WORDS 3456
#define XB_SPIN_CAP (1u << 24)

__device__ __forceinline__ unsigned xb_ld(unsigned* p)              { return __hip_atomic_load(p, __ATOMIC_RELAXED, __HIP_MEMORY_SCOPE_AGENT); }
__device__ __forceinline__ unsigned xb_add(unsigned* p, unsigned v) { return __hip_atomic_fetch_add(p, v, __ATOMIC_RELAXED, __HIP_MEMORY_SCOPE_AGENT); }
__device__ __forceinline__ unsigned xb_xcc_id() { return (unsigned)__builtin_amdgcn_s_getreg((3 << 11) | 20) & 0xFu; }
#define XB_SPIN(cond, bar) do { unsigned _sp = 0; while (cond) { __builtin_amdgcn_s_sleep(1); \
    if ((++_sp & 255u) == 0u) { if (xb_ld(&(bar)[XB_TMO])) break; if (_sp > XB_SPIN_CAP) { atomicAdd(&(bar)[XB_TMO], 1u); break; } } } } while (0)

struct XcdBarrier {
    unsigned* bar; unsigned x;
    volatile LAS unsigned* st;
};

__device__ __forceinline__ XcdBarrier xcd_barrier_post(unsigned* bar, volatile LAS unsigned* st) {
    XcdBarrier b; b.bar = bar; b.x = xb_xcc_id(); b.st = st;
    if (threadIdx.x == 0) (void)xb_add(&bar[XB_XCNT(b.x)], 1u);
    return b;
}
__device__ __forceinline__ void xcd_barrier_complete(unsigned* bar, unsigned x, unsigned& nloc, unsigned& nx) {
    const unsigned G = gridDim.x * gridDim.y * gridDim.z;
    unsigned sum, cnt, mine, sp = 0u;
    for (;;) {
        sum = 0u; cnt = 0u; mine = 0u;
#pragma unroll
        for (unsigned j = 0; j < 16; ++j) { const unsigned c = xb_ld(&bar[XB_XCNT(j)]); sum += c; cnt += (c > 0u) ? 1u : 0u; mine = (j == x) ? c : mine; }
        if (sum == G) break;
        __builtin_amdgcn_s_sleep(1);
        if ((++sp & 255u) == 0u) { if (xb_ld(&bar[XB_TMO])) break; if (sp > XB_SPIN_CAP) { atomicAdd(&bar[XB_TMO], 1u); break; } }
    }
    nloc = mine > 0u ? mine : 1u; nx = cnt > 0u ? cnt : 1u;
}

__device__ __forceinline__ void xcd_barrier(const XcdBarrier& b) {
    asm volatile("s_waitcnt vmcnt(0)" ::: "memory");
    __syncthreads();
    if (threadIdx.x == 0) {
        unsigned* bar = b.bar;
        __builtin_amdgcn_s_waitcnt(0);
        unsigned nloc = b.st[0], nx = b.st[1];
        if (nloc == 0u) { xcd_barrier_complete(bar, b.x, nloc, nx); b.st[0] = nloc; b.st[1] = nx; }
        const unsigned old = xb_add(&bar[XB_XSUB(b.x)], 1u);
        const unsigned gen = old / nloc;
        if (old + 1u == (gen + 1u) * nloc) {
            __builtin_amdgcn_fence(__ATOMIC_RELEASE, "agent");
            asm volatile("s_waitcnt vmcnt(0)" ::: "memory");
            const unsigned og = xb_add(&bar[XB_TOP], 1u);
            const unsigned tg = og / nx;
            if (og + 1u == (tg + 1u) * nx) xb_add(&bar[XB_TOPGEN], 1u);
            else XB_SPIN(xb_ld(&bar[XB_TOPGEN]) == tg, bar);
            __builtin_amdgcn_fence(__ATOMIC_ACQUIRE, "agent");
            xb_add(&bar[XB_XGEN(b.x)], 1u);
            asm volatile("s_waitcnt vmcnt(0)" ::: "memory");
        } else {
            XB_SPIN(xb_ld(&bar[XB_XGEN(b.x)]) == gen, bar);
            __builtin_amdgcn_fence(__ATOMIC_ACQUIRE, "agent");
            asm volatile("s_waitcnt vmcnt(0)" ::: "memory");
        }
    }
    __syncthreads();
}

struct EpiProj {
    bf16 *sbqk, *vt, *mlqk, *mlv, *mlo, *gates;
    __device__ __forceinline__ void operator()(int row, int col, const F8& a) const {
        bf16* dst;
        if (col < 1024) dst = sbqk + (size_t)row * 1024 + col;
        else if (col < 1536) {
            const int c = col - 1024, hh = c >> 6, d = c & 63, b = row >> 11, sq = row & 2047;
            bf16* vp = vt + ((size_t)(b * 8 + hh) * 64 + d) * 2048 + sq;
#pragma unroll
            for (int i = 0; i < 8; ++i) vp[(size_t)i * 2048] = (bf16)f2bf(a.v[i]);
            return;
        }
        else if (col < 2560) dst = mlqk + (size_t)row * 1024 + (col - 1536);
        else if (col < 3072) dst = mlv + (size_t)row * 512 + (col - 2560);
        else if (col < 3584) dst = mlo + (size_t)row * 512 + (col - 3072);
        else dst = gates + (size_t)row * 2048 + (col - 3584);
        *(v4u*)dst = pack8(a.v);
    }
};
struct EpiMergeA {
    bf16* merged; const bf16* gates;
    __device__ __forceinline__ void operator()(int row, int col, const F8& a) const {
        float g[8], o[8]; unpack8(*(const v4u*)(gates + (size_t)row * 2048 + col), g);
#pragma unroll
        for (int i = 0; i < 8; ++i) o[i] = sigmoidf_(g[i]) * a.v[i];
        *(v4u*)(merged + (size_t)row * 1024 + col) = pack8(o);
    }
};
struct EpiMergeB {
    bf16* merged; const bf16* gates;
    __device__ __forceinline__ void operator()(int row, int col, const F8& a) const {
        float g[8], o[8]; unpack8(*(const v4u*)(gates + (size_t)row * 2048 + 1024 + col), g);
        unpack8(*(const v4u*)(merged + (size_t)row * 1024 + col), o);
#pragma unroll
        for (int i = 0; i < 8; ++i) o[i] += sigmoidf_(g[i]) * a.v[i];
        *(v4u*)(merged + (size_t)row * 1024 + col) = pack8(o);
    }
};
struct EpiH {
    float* h; const float* x;
    __device__ __forceinline__ void operator()(int row, int col, const F8& a) const {
        const f32x4 x0 = *(const f32x4*)(x + (size_t)row * 1024 + col), x1 = *(const f32x4*)(x + (size_t)row * 1024 + col + 4);
        *(f32x4*)(h + (size_t)row * 1024 + col) = (f32x4){x0.x + a.v[0], x0.y + a.v[1], x0.z + a.v[2], x0.w + a.v[3]};
        *(f32x4*)(h + (size_t)row * 1024 + col + 4) = (f32x4){x1.x + a.v[4], x1.y + a.v[5], x1.z + a.v[6], x1.w + a.v[7]};
    }
};
struct EpiF32 {
    float* o; int ldc;
    __device__ __forceinline__ void operator()(int row, int col, const F8& a) const {
        *(f32x4*)(o + (size_t)row * ldc + col) = (f32x4){a.v[0], a.v[1], a.v[2], a.v[3]};
        *(f32x4*)(o + (size_t)row * ldc + col + 4) = (f32x4){a.v[4], a.v[5], a.v[6], a.v[7]};
    }
};

template <class E> struct EpiAdapt {
    static constexpr bool PERM = true, AFTER_DRAIN = false;
    E e;
    __device__ __forceinline__ void operator()(const pg8::f32x4 (&acc)[2][2][4][2], const pg8::Unit& u, int wr, int wc, int fr, int fq) const {
#pragma unroll
        for (int ai = 0; ai < 2; ++ai)
#pragma unroll
            for (int m = 0; m < 4; ++m) {
                const int row = u.pm * 256 + ai * 128 + wr * 64 + m * 16 + fr;
#pragma unroll
                for (int bj = 0; bj < 2; ++bj) {
                    const int col = u.pn * 256 + bj * 128 + wc * 32 + 8 * fq;
                    F8 a; const pg8::f32x4 v0 = acc[ai][bj][m][0], v1 = acc[ai][bj][m][1];
                    a.v[0] = v0[0]; a.v[1] = v0[1]; a.v[2] = v0[2]; a.v[3] = v0[3]; a.v[4] = v1[0]; a.v[5] = v1[1]; a.v[6] = v1[2]; a.v[7] = v1[3];
                    e(row, col, a);
                }
            }
    }
};

template <class E>
__device__ __forceinline__ void simple_gemm(LAS unsigned char* lds, const bf16* A, const bf16* Bt, int M, int N, int K, const E& e) {
    LAS float* As = (LAS float*)lds;
    LAS float* Bs = As + 32 * 132;
    const int tid = threadIdx.x, ty = tid >> 4, tx = tid & 15;
    const int ntn = N / 128, ntiles = (M / 128) * ntn;
    for (int tile = blockIdx.x; tile < ntiles; tile += gridDim.x) {
        const int tm = tile / ntn, tn = tile % ntn;
        float acc[4][8];
#pragma unroll
        for (int i = 0; i < 4; ++i)
#pragma unroll
            for (int j = 0; j < 8; ++j) acc[i][j] = 0.f;
        for (int k0 = 0; k0 < K; k0 += 32) {
            {
                const int r = tid >> 2, kq = (tid & 3) * 8;
                float fa[8], fb[8];
                unpack8(*(const v4u*)(A + (size_t)(tm * 128 + r) * K + k0 + kq), fa);
                unpack8(*(const v4u*)(Bt + (size_t)(tn * 128 + r) * K + k0 + kq), fb);
#pragma unroll
                for (int i = 0; i < 8; ++i) { As[(kq + i) * 132 + r] = fa[i]; Bs[(kq + i) * 132 + r] = fb[i]; }
            }
            __syncthreads();
#pragma unroll 8
            for (int k = 0; k < 32; ++k) {
                const f32x4 a4 = *(const LAS f32x4*)(As + k * 132 + ty * 4);
                const f32x4 b0 = *(const LAS f32x4*)(Bs + k * 132 + tx * 8), b1 = *(const LAS f32x4*)(Bs + k * 132 + tx * 8 + 4);
                const float av[4] = {a4.x, a4.y, a4.z, a4.w};
                const float bv[8] = {b0.x, b0.y, b0.z, b0.w, b1.x, b1.y, b1.z, b1.w};
#pragma unroll
                for (int i = 0; i < 4; ++i)
#pragma unroll
                    for (int j = 0; j < 8; ++j) acc[i][j] += av[i] * bv[j];
            }
            __syncthreads();
        }
#pragma unroll
        for (int i = 0; i < 4; ++i) {
            F8 a;
#pragma unroll
            for (int j = 0; j < 8; ++j) a.v[j] = acc[i][j];
            e(tm * 128 + ty * 4 + i, tn * 128 + tx * 8, a);
        }
    }
}

template <class E>
__device__ __forceinline__ void gemm(LAS unsigned char* lds, const bf16* A, const bf16* Bt, int M, int N, int K, const E& e) {
#if USE_PG8
    pg8::Gemm g{A, Bt, M, N, K}; pg8::StaticOrder S; S.init(M, N, (int)gridDim.x, (int)blockIdx.x);
    EpiAdapt<E> ea{e};
    pg8::gemm_phase<EpiAdapt<E>, pg8::StaticOrder, true, true>(lds, g, S, ea);
#else
    simple_gemm<E>(lds, A, Bt, M, N, K, e);
#endif
}

__device__ __forceinline__ void transpose_item(const float* W, int ldw, int K, bf16* WT, int src_col0, int dst_row0, LAS float* scr, int kb, int lane) {
    const int k0 = 64 * kb;
#pragma unroll 8
    for (int i = 0; i < 32; ++i) { const int kk = 2 * i + (lane >> 5); scr[kk * 33 + (lane & 31)] = W[(size_t)(k0 + kk) * ldw + src_col0 + (lane & 31)]; }
    LDS_WAIT(); asm volatile("" ::: "memory");
    const int c = lane & 7;
#pragma unroll
    for (int j = 0; j < 4; ++j) { const int n = (lane >> 3) + 8 * j; const LAS float* s = scr + (8 * c) * 33 + n;
        v4u o; o.x = pk2(s[0 * 33], s[1 * 33]); o.y = pk2(s[2 * 33], s[3 * 33]); o.z = pk2(s[4 * 33], s[5 * 33]); o.w = pk2(s[6 * 33], s[7 * 33]);
        *(v4u*)(WT + (size_t)(dst_row0 + n) * K + k0 + 8 * c) = o; }
    LDS_WAIT(); asm volatile("" ::: "memory");
}

struct P {
    const float *x, *norm_mix_w, *w_in, *conv_w, *conv_b, *b_i, *b_f, *ml_norm_w, *w_sb, *w_ml, *w_out, *norm_ffn_w, *w_query, *keys1, *keys2, *peer_u, *peer_v, *norm_final_w;
    float* out; unsigned char* ws;
};

__device__ __forceinline__ void p0_prologue(const P& p, LAS unsigned char* lds, int wave, int lane) {
    LAS float* scr = (LAS float*)(lds + wave * 8448);
    const int gw = blockIdx.x * NWAVES + wave, NGW = gridDim.x * NWAVES;
    bf16* W1T = (bf16*)(p.ws + WS_W1T); bf16* WSBT = (bf16*)(p.ws + WS_WSBT); bf16* WMLT = (bf16*)(p.ws + WS_WMLT); bf16* WOUTT = (bf16*)(p.ws + WS_WOUTT); bf16* WCT = (bf16*)(p.ws + WS_WCT);
    constexpr int I_1 = 16 * 176, I_SB = 8 * 32, I_ML = 8 * 32, I_O = 16 * 32, NT = I_1 + I_SB + I_ML + I_O;
    for (int it = gw; it < NT; it += NGW) {
        int r = it;
        if (r < I_1) { const int kb = r / 176, nb = r % 176, n0 = nb * 32; transpose_item(p.w_in, INC, 1024, W1T, n0 < 3584 ? n0 : n0 + 8, n0, scr, kb, lane); continue; } r -= I_1;
        if (r < I_SB) { const int kb = r / 32, nb = r % 32; transpose_item(p.w_sb, 1024, 512, WSBT, nb * 32, nb * 32, scr, kb, lane); continue; } r -= I_SB;
        if (r < I_ML) { const int kb = r / 32, nb = r % 32; transpose_item(p.w_ml, 1024, 512, WMLT, nb * 32, nb * 32, scr, kb, lane); continue; } r -= I_ML;
        { const int kb = r / 32, nb = r % 32; transpose_item(p.w_out, 1024, 1024, WOUTT, nb * 32, nb * 32, scr, kb, lane); }
    }
    for (int it = gw; it < 16 * 16 * 4; it += NGW) {
        const int hhf = it >> 6, kb = (it >> 2) & 15, kq = it & 3, head = hhf >> 1, half = hhf & 1, k = kb * 64 + lane;
        const f32x4* wq = (const f32x4*)(p.w_query + (size_t)k * 2048 + head * 256 + half * 128);
        f32x4 wr[32];
#pragma unroll
        for (int i = 0; i < 32; ++i) wr[i] = wq[i];
        const float* kbase = (half ? p.keys2 : p.keys1) + ((size_t)head * 128 + kq * 32) * 128;
#pragma unroll 1
        for (int key = 0; key < 32; ++key) {
            const f32x4* kr = (const f32x4*)(kbase + (size_t)key * 128);
            float a0 = 0.f, a1 = 0.f;
#pragma unroll
            for (int i = 0; i < 32; i += 2) { const f32x4 b0 = kr[i], b1 = kr[i + 1];
                a0 += wr[i].x * b0.x + wr[i].y * b0.y + wr[i].z * b0.z + wr[i].w * b0.w;
                a1 += wr[i + 1].x * b1.x + wr[i + 1].y * b1.y + wr[i + 1].z * b1.z + wr[i + 1].w * b1.w; }
            WCT[(size_t)(hhf * 128 + kq * 32 + key) * 1024 + k] = (bf16)f2bf(a0 + a1);
        }
    }
    bf16* XN = (bf16*)(p.ws + WS_XN); float* IFG = (float*)(p.ws + WS_IFG);
    LAS float* WG = (LAS float*)(lds + 8 * 8448);
    __syncthreads();
    for (int i = threadIdx.x; i < 2048; i += NTHR) { const int k = i >> 1, hf = i & 1; *(LAS f32x4*)(WG + k * 8 + hf * 4) = *(const f32x4*)(p.w_in + (size_t)k * INC + 3584 + hf * 4); }
    __syncthreads();
    for (int m = gw; m < T_; m += NGW) {
        const f32x4* xr = (const f32x4*)(p.x + (size_t)m * 1024) + lane;
        const f32x4* wr = (const f32x4*)p.norm_mix_w + lane;
        f32x4 v[4]; float ss = 0.f;
#pragma unroll
        for (int j = 0; j < 4; ++j) { v[j] = xr[64 * j]; ss += (v[j].x * v[j].x + v[j].y * v[j].y) + (v[j].z * v[j].z + v[j].w * v[j].w); }
        const float rstd = 1.f / sqrtf(wave_sum(ss) * (1.f / 1024.f) + EPS);
        float g[8];
#pragma unroll
        for (int i = 0; i < 8; ++i) g[i] = 0.f;
        v2u* o8 = (v2u*)(XN + (size_t)m * 1024) + lane;
#pragma unroll
        for (int j = 0; j < 4; ++j) {
            const f32x4 w = wr[64 * j];
            const float y[4] = {v[j].x * rstd * w.x, v[j].y * rstd * w.y, v[j].z * rstd * w.z, v[j].w * rstd * w.w};
            o8[64 * j] = (v2u){pk2(y[0], y[1]), pk2(y[2], y[3])};
#pragma unroll
            for (int q = 0; q < 4; ++q) {
                const int k = 256 * j + 4 * lane + q;
                const f32x4 w0 = *(const LAS f32x4*)(WG + k * 8), w1 = *(const LAS f32x4*)(WG + k * 8 + 4);
                g[0] += y[q] * w0.x; g[1] += y[q] * w0.y; g[2] += y[q] * w0.z; g[3] += y[q] * w0.w;
                g[4] += y[q] * w1.x; g[5] += y[q] * w1.y; g[6] += y[q] * w1.z; g[7] += y[q] * w1.w;
            }
        }
#pragma unroll
        for (int i = 0; i < 8; ++i) g[i] = wave_sum(g[i]);
        if (lane == 0) {
#pragma unroll
            for (int i = 0; i < 4; ++i) { IFG[(size_t)m * 8 + i] = g[i] + p.b_i[i]; IFG[(size_t)m * 8 + 4 + i] = g[4 + i] + p.b_f[i]; }
        }
    }
    {
        unsigned char* U8 = p.ws + WS_U8; unsigned char* V8 = p.ws + WS_V8; float* USC = (float*)(p.ws + WS_USC); float* VSC = (float*)(p.ws + WS_VSC);
        for (int e = gw; e < NEXP; e += NGW) {
            f32x4 v[2][4]; float am[2] = {0.f, 0.f};
#pragma unroll
            for (int which = 0; which < 2; ++which) {
                const float* src = (which ? p.peer_v : p.peer_u) + (size_t)e * 1024 + 16 * lane;
#pragma unroll
                for (int j = 0; j < 4; ++j) v[which][j] = *(const f32x4*)(src + 4 * j);
            }
#pragma unroll
            for (int which = 0; which < 2; ++which)
#pragma unroll
                for (int j = 0; j < 4; ++j) am[which] = fmaxf(am[which], fmaxf(fmaxf(fabsf(v[which][j].x), fabsf(v[which][j].y)), fmaxf(fabsf(v[which][j].z), fabsf(v[which][j].w))));
#pragma unroll
            for (int o = 1; o < 64; o <<= 1) { am[0] = fmaxf(am[0], __shfl_xor(am[0], o)); am[1] = fmaxf(am[1], __shfl_xor(am[1], o)); }
#pragma unroll
            for (int which = 0; which < 2; ++which) {
                const float sc = am[which] > 0.f ? exp2f(floorf(log2f(448.f / am[which]))) : 1.f;
                unsigned w[4];
#pragma unroll
                for (int j = 0; j < 4; ++j) { int t = __builtin_amdgcn_cvt_pk_fp8_f32(v[which][j].x * sc, v[which][j].y * sc, 0, false); t = __builtin_amdgcn_cvt_pk_fp8_f32(v[which][j].z * sc, v[which][j].w * sc, t, true); w[j] = (unsigned)t; }
                *(v4u*)((which ? V8 : U8) + (size_t)e * 1024 + 16 * lane) = (v4u){w[0], w[1], w[2], w[3]};
                if (lane == 0) (which ? VSC : USC)[e] = 1.f / sc;
            }
        }
    }
}

typedef short bf16x8 __attribute__((ext_vector_type(8)));
typedef float f32x16 __attribute__((ext_vector_type(16)));
typedef float f32x2_t __attribute__((ext_vector_type(2))); typedef __bf16 bf16x2_t __attribute__((ext_vector_type(2)));
__device__ __forceinline__ unsigned cvtpk(float lo, float hi) { f32x2_t v = {lo, hi}; bf16x2_t b = __builtin_convertvector(v, bf16x2_t); return __builtin_bit_cast(unsigned, b); }
#define MFMA32(a, b, c) __builtin_amdgcn_mfma_f32_32x32x16_bf16((a), (b), (c), 0, 0, 0)
__device__ __forceinline__ int crow(int reg, int hh) { return (reg & 3) + 8 * (reg >> 2) + 4 * hh; }
template <int S> __device__ __forceinline__ bf16x8 pack_step(const f32x16& x) {
    v4u p; p.x = cvtpk(x[8 * S], x[8 * S + 1]); p.y = cvtpk(x[8 * S + 2], x[8 * S + 3]); p.z = cvtpk(x[8 * S + 4], x[8 * S + 5]); p.w = cvtpk(x[8 * S + 6], x[8 * S + 7]);
    return __builtin_bit_cast(bf16x8, p);
}
__device__ __forceinline__ bf16x8 frag2(const v2u& lo, const v2u& hi) { v4u p; p.x = lo.x; p.y = lo.y; p.z = hi.x; p.w = hi.y; return __builtin_bit_cast(bf16x8, p); }
__device__ __forceinline__ f32x16 zero16() { f32x16 z; for (int i = 0; i < 16; ++i) z[i] = 0.f; return z; }


__device__ __forceinline__ void p2_conv(const P& p, int tid) {
    const bf16* MLQK = (const bf16*)(p.ws + WS_MLQK); bf16* QC = (bf16*)(p.ws + WS_QC); bf16* KC = (bf16*)(p.ws + WS_KC);
    const int cg = tid & 127, ch0 = 8 * cg;
    float cw[4][8], cb[8];
#pragma unroll
    for (int i = 0; i < 8; ++i) { cb[i] = p.conv_b[ch0 + i];
#pragma unroll
        for (int j = 0; j < 4; ++j) cw[j][i] = p.conv_w[j * 1024 + ch0 + i]; }
    const float osc = cg >= 64 ? 0.08838834764831845f : 1.f;
    bf16* dst = (cg >= 64 ? KC : QC) + (cg & 63) * 8;
    for (int rg = blockIdx.x * 4 + (tid >> 7); rg < T_ / 4; rg += gridDim.x * 4) {
        const int tok = rg * 4, pos0 = tok & (S_ - 1);
        v4u xr[7];
#pragma unroll
        for (int k = 0; k < 7; ++k) xr[k] = (pos0 + k - 3 >= 0) ? *(const v4u*)(MLQK + (size_t)(tok + k - 3) * 1024 + ch0) : (v4u){0u, 0u, 0u, 0u};
#pragma unroll
        for (int tt = 0; tt < 4; ++tt) {
            float y[8];
#pragma unroll
            for (int i = 0; i < 8; ++i) y[i] = cb[i];
#pragma unroll
            for (int j = 0; j < 4; ++j) { float f[8]; unpack8(xr[tt + j], f);
#pragma unroll
                for (int i = 0; i < 8; ++i) y[i] += cw[j][i] * f[i]; }
#pragma unroll
            for (int i = 0; i < 8; ++i) y[i] = y[i] * sigmoidf_(y[i]) * osc;
            *(v4u*)(dst + (size_t)(tok + tt) * 512) = pack8(y);
        }
    }
}

constexpr int ML_QS = 0, ML_KS = 17408, ML_KWT = 34816, ML_VTL = 53248, ML_PS = 71680, ML_CT = 80896, ML_SCAL = 115712, ML_SSP = 118272, ML_QN = ML_SSP + 512, ML_F1 = ML_QN + 256, ML_F2 = ML_F1 + 256, ML_NV = ML_F2 + 256;
static_assert(ML_NV + 512 <= RING_BYTES, "mLSTM LDS map");
__device__ __forceinline__ void mlstm_scal(float ip, float fp, LAS float* sc, float& m_carry, int lane) {
    const float lf = fminf(fp, 0.f) - log1pf(expf(-fabsf(fp)));
    float bc = lf;
#pragma unroll
    for (int o = 1; o < 64; o <<= 1) { const float t2 = __shfl_up(bc, o); if (lane >= o) bc += t2; }
    const float a = ip - bc; float pm = a;
#pragma unroll
    for (int o = 1; o < 64; o <<= 1) { const float t2 = __shfl_up(pm, o); if (lane >= o) pm = fmaxf(pm, t2); }
    const float M = fmaxf(m_carry, pm);
    const float M63 = __shfl(M, 63), bc63 = __shfl(bc, 63);
    sc[lane] = a; sc[64 + lane] = M; sc[128 + lane] = expf(a - M63); sc[192 + lane] = expf(m_carry - M); sc[256 + lane] = expf(-(bc + M));
    m_carry = bc63 + M63;
}
__device__ __forceinline__ void mlstm_item(const P& p, LAS unsigned char* lds, int item, int tid, int wave, int lane) {
    const int b = item >> 2, h = item & 3;
    const int r = lane & 31, hh = lane >> 5, et = wave & 3, th = wave >> 2;
    const bf16* QC = (const bf16*)(p.ws + WS_QC); const bf16* KC = (const bf16*)(p.ws + WS_KC); const bf16* MLV = (const bf16*)(p.ws + WS_MLV); const float* IFG = (const float*)(p.ws + WS_IFG);
    bf16* HML = (bf16*)p.out + (size_t)T_ * 512;
    LAS float* SCAL = (LAS float*)(lds + ML_SCAL); LAS float* SSP = (LAS float*)(lds + ML_SSP); LAS float* QN = (LAS float*)(lds + ML_QN);
    LAS float* F1 = (LAS float*)(lds + ML_F1); LAS float* F2 = (LAS float*)(lds + ML_F2); LAS float* NV = (LAS float*)(lds + ML_NV);
    const int cg = tid & 15, trow = tid >> 4, eg = cg, sl = trow;
    const size_t hq = (size_t)h * 128 + 8 * cg;
    for (int i = tid; i < (128 * 136 * 2) / 4; i += NTHR) ((LAS unsigned*)(lds + ML_CT))[i] = 0u;
    if (tid < 128) NV[tid] = 0.f;
    f32x16 accC[2]; accC[0] = zero16(); accC[1] = zero16();
    float m_carry = 0.f;
    if (wave == 3) { const size_t tk = (size_t)b * S_ + lane; mlstm_scal(IFG[tk * 8 + h], IFG[tk * 8 + 4 + h], SCAL, m_carry, lane); }
    v4u pq[2], pk[2], pv[2];
    {
        const size_t t0 = (size_t)b * S_;
#pragma unroll
        for (int u = 0; u < 2; ++u) { pq[u] = *(const v4u*)(QC + (t0 + trow + 32 * u) * 512 + hq); pk[u] = *(const v4u*)(KC + (t0 + trow + 32 * u) * 512 + hq); pv[u] = *(const v4u*)(MLV + (t0 + sl + 32 * u) * 512 + hq); }
    }
    float ipn = 0.f, fpn = 0.f;
    __syncthreads();
    for (int c = 0; c < 32; ++c) {
        const size_t tok0 = (size_t)b * S_ + c * 64;
        LAS float* sc = SCAL + (c & 1) * 320;
        {
#pragma unroll
            for (int u = 0; u < 2; ++u) {
                const int t = trow + 32 * u;
                *(LAS v4u*)(lds + ML_QS + t * 272 + cg * 16) = pq[u];
                *(LAS v4u*)(lds + ML_KS + t * 272 + cg * 16) = pk[u];
                float f[8]; unpack8(pk[u], f);
                const float wk = sc[128 + t];
#pragma unroll
                for (int i = 0; i < 8; ++i) *(LAS bf16*)(lds + ML_KWT + (8 * cg + i) * 144 + ((t ^ (8 * (cg & 7))) * 2)) = (bf16)f2bf(f[i] * wk);
                const unsigned vv[4] = {pv[u].x, pv[u].y, pv[u].z, pv[u].w};
#pragma unroll
                for (int i = 0; i < 4; ++i) {
                    *(LAS bf16*)(lds + ML_VTL + (8 * eg + 2 * i) * 144 + ((t ^ (8 * (eg & 7))) * 2)) = (bf16)(vv[i] & 0xffffu);
                    *(LAS bf16*)(lds + ML_VTL + (8 * eg + 2 * i + 1) * 144 + ((t ^ (8 * (eg & 7))) * 2)) = (bf16)(vv[i] >> 16);
                }
            }
            if (c + 1 < 32) {
                const size_t t1 = tok0 + 64;
#pragma unroll
                for (int u = 0; u < 2; ++u) { pq[u] = *(const v4u*)(QC + (t1 + trow + 32 * u) * 512 + hq); pk[u] = *(const v4u*)(KC + (t1 + trow + 32 * u) * 512 + hq); pv[u] = *(const v4u*)(MLV + (t1 + sl + 32 * u) * 512 + hq); }
                if (wave == 3) { ipn = IFG[(t1 + lane) * 8 + h]; fpn = IFG[(t1 + lane) * 8 + 4 + h]; }
            }
        }
        __syncthreads();
        f32x16 acc_inter = zero16();
        if (wave < 3) {
            const int tt = wave > 0 ? 1 : 0, st = wave == 2 ? 1 : 0;
            f32x16 zt = zero16();
#pragma unroll
            for (int ks = 0; ks < 8; ++ks) {
                const bf16x8 ka = *(const LAS bf16x8*)(lds + ML_KS + (32 * st + r) * 272 + 32 * ks + 16 * hh);
                const bf16x8 qb = *(const LAS bf16x8*)(lds + ML_QS + (32 * tt + r) * 272 + 32 * ks + 16 * hh);
                zt = MFMA32(ka, qb, zt);
            }
            const int t = 32 * tt + r; const float Mt = sc[64 + t];
            float ps = 0.f;
#pragma unroll
            for (int g = 0; g < 4; ++g) {
                const f32x4 av = *(const LAS f32x4*)(sc + 32 * st + 8 * g + 4 * hh);
                float pv[4];
#pragma unroll
                for (int q = 0; q < 4; ++q) { const int sidx = 32 * st + 8 * g + 4 * hh + q;
                    const float wgt = sidx <= t ? expf(av[q] - Mt) : 0.f; pv[q] = zt[4 * g + q] * wgt; ps += pv[q]; }
                *(LAS v2u*)(lds + ML_PS + t * 144 + (32 * st + 8 * g + 4 * hh) * 2) = (v2u){cvtpk(pv[0], pv[1]), cvtpk(pv[2], pv[3])};
            }
            ps += __shfl_xor(ps, 32);
            if (hh == 0) { SSP[st * 64 + t] = ps; if (wave == 0) SSP[64 + t] = 0.f; }
        }
        if (wave == 3 && c + 1 < 32) mlstm_scal(ipn, fpn, SCAL + ((c + 1) & 1) * 320, m_carry, lane);
#pragma unroll
        for (int ks = 0; ks < 8; ++ks) {
            const bf16x8 qa = *(const LAS bf16x8*)(lds + ML_QS + (32 * th + r) * 272 + 32 * ks + 16 * hh);
            const bf16x8 cbf = *(const LAS bf16x8*)(lds + ML_CT + (32 * et + r) * 272 + 32 * ks + 16 * hh);
            acc_inter = MFMA32(qa, cbf, acc_inter);
        }
        {
            const int t = tid >> 3, part = tid & 7;
            float f[8], sum = 0.f;
            { const v4u tq = *(const LAS v4u*)(lds + ML_QS + t * 272 + part * 32); unpack8(tq, f); }
#pragma unroll
            for (int i = 0; i < 8; ++i) sum += f[i] * NV[16 * part + i];
            { const v4u tq = *(const LAS v4u*)(lds + ML_QS + t * 272 + part * 32 + 16); unpack8(tq, f); }
#pragma unroll
            for (int i = 0; i < 8; ++i) sum += f[i] * NV[16 * part + 8 + i];
            sum += __shfl_xor(sum, 1); sum += __shfl_xor(sum, 2); sum += __shfl_xor(sum, 4);
            if (part == 0) QN[t] = sum;
        }
        __syncthreads();
        f32x16 acc_intra = zero16();
#pragma unroll
        for (int ks = 0; ks < 4; ++ks) {
            if (ks < 2 || th == 1) {
                const bf16x8 pa = *(const LAS bf16x8*)(lds + ML_PS + (32 * th + r) * 144 + 32 * ks + 16 * hh);
                const bf16x8 vb = *(const LAS bf16x8*)(lds + ML_VTL + (32 * et + r) * 144 + 16 * ((2 * ks + hh) ^ (((32 * et + r) >> 3) & 7)));
                acc_intra = MFMA32(pa, vb, acc_intra);
            }
        }
        if (tid < 64) {
            const float wi = sc[192 + tid];
            const float den = SSP[tid] + SSP[64 + tid] + wi * QN[tid];
            const float f1 = 1.f / fmaxf(fabsf(den), sc[256 + tid]);
            F1[tid] = f1; F2[tid] = wi * f1;
        }
        const float decay = sc[192 + 63];
#pragma unroll
        for (int dt = 0; dt < 2; ++dt) {
#pragma unroll
            for (int i = 0; i < 16; ++i) accC[dt][i] *= decay;
#pragma unroll
            for (int ks = 0; ks < 4; ++ks) {
                const bf16x8 ka = *(const LAS bf16x8*)(lds + ML_KWT + (64 * th + 32 * dt + r) * 144 + 16 * ((2 * ks + hh) ^ (((64 * th + 32 * dt + r) >> 3) & 7)));
                const bf16x8 vb = *(const LAS bf16x8*)(lds + ML_VTL + (32 * et + r) * 144 + 16 * ((2 * ks + hh) ^ (((32 * et + r) >> 3) & 7)));
                accC[dt] = MFMA32(ka, vb, accC[dt]);
            }
        }
        {
            const int d = tid >> 2, part = tid & 3;
            float f[8], sum = 0.f;
            { const v4u tq = *(const LAS v4u*)(lds + ML_KWT + d * 144 + part * 32); unpack8(tq, f); }
#pragma unroll
            for (int i = 0; i < 8; ++i) sum += f[i];
            { const v4u tq = *(const LAS v4u*)(lds + ML_KWT + d * 144 + part * 32 + 16); unpack8(tq, f); }
#pragma unroll
            for (int i = 0; i < 8; ++i) sum += f[i];
            sum += __shfl_xor(sum, 1); sum += __shfl_xor(sum, 2);
            if (part == 0) NV[d] = decay * NV[d] + sum;
        }
        __syncthreads();
        {
            bf16* hp = HML + (tok0 + 32 * th) * 512 + h * 128 + 32 * et + r;
#pragma unroll
            for (int g = 0; g < 4; ++g) {
                const f32x4 f1v = *(const LAS f32x4*)(F1 + 32 * th + 8 * g + 4 * hh), f2v = *(const LAS f32x4*)(F2 + 32 * th + 8 * g + 4 * hh);
#pragma unroll
                for (int q = 0; q < 4; ++q) { const int tl = 8 * g + 4 * hh + q;
                    hp[(size_t)tl * 512] = (bf16)f2bf(acc_intra[4 * g + q] * f1v[q] + acc_inter[4 * g + q] * f2v[q]); }
            }
#pragma unroll
            for (int dt = 0; dt < 2; ++dt)
#pragma unroll
                for (int g = 0; g < 4; ++g)
                    *(LAS v2u*)(lds + ML_CT + (32 * et + r) * 272 + (64 * th + 32 * dt + 8 * g + 4 * hh) * 2) = (v2u){cvtpk(accC[dt][4 * g], accC[dt][4 * g + 1]), cvtpk(accC[dt][4 * g + 2], accC[dt][4 * g + 3])};
        }
    }
    __syncthreads();
}

__device__ __forceinline__ void sba_wave_item(const bf16* __restrict__ QK, const bf16* __restrict__ VT, bf16* __restrict__ YSB, int b, int h, int qt, int lane) {
    const int r = lane & 31, hh = lane >> 5, t0 = qt * 32;
    const size_t rowbase = (size_t)b * S_;
    bf16x8 qf[4];
    {
        const bf16* qp = QK + (rowbase + t0 + r) * 1024 + h * 64 + 8 * hh;
#pragma unroll
        for (int ks = 0; ks < 4; ++ks) qf[ks] = *(const bf16x8*)(qp + 16 * ks);
    }
    bf16x8 tri[2];
#pragma unroll
    for (int s2 = 0; s2 < 2; ++s2)
#pragma unroll
        for (int j = 0; j < 8; ++j) { const int rho = 16 * s2 + 8 * (j >> 2) + 4 * hh + (j & 3); tri[s2][j] = (rho > r) ? (short)0x3F80 : (short)0; }
    f32x16 o0 = zero16(), o1 = zero16();
    float carry = 0.f;
    const bf16* kbase = QK + rowbase * 1024 + 512 + h * 64 + 8 * hh + (size_t)r * 1024;
    const bf16* vbase = VT + ((size_t)(b * 8 + h) * 64 + r) * 2048 + 4 * hh;
    bf16x8 kf[4]; v2u vl[2][2], vh[2][2];
#pragma unroll
    for (int ks = 0; ks < 4; ++ks) kf[ks] = *(const bf16x8*)(kbase + (size_t)t0 * 1024 + 16 * ks);
#pragma unroll
    for (int dt = 0; dt < 2; ++dt)
#pragma unroll
        for (int s2 = 0; s2 < 2; ++s2) { const bf16* vp = vbase + (size_t)dt * 32 * 2048 + t0 + 16 * s2; vl[dt][s2] = *(const v2u*)vp; vh[dt][s2] = *(const v2u*)(vp + 8); }
    for (int s0 = t0; s0 >= 0; s0 -= 32) {
        bf16x8 kn[4]; v2u vln[2][2], vhn[2][2];
        const int sn = s0 >= 32 ? s0 - 32 : 0;
#pragma unroll
        for (int ks = 0; ks < 4; ++ks) kn[ks] = *(const bf16x8*)(kbase + (size_t)sn * 1024 + 16 * ks);
#pragma unroll
        for (int dt = 0; dt < 2; ++dt)
#pragma unroll
            for (int s2 = 0; s2 < 2; ++s2) { const bf16* vp = vbase + (size_t)dt * 32 * 2048 + sn + 16 * s2; vln[dt][s2] = *(const v2u*)vp; vhn[dt][s2] = *(const v2u*)(vp + 8); }
        f32x16 z = zero16();
#pragma unroll
        for (int ks = 0; ks < 4; ++ks) z = MFMA32(kf[ks], qf[ks], z);
        const bool diag = (s0 == t0);
        f32x16 sp; float rs = 0.f;
#pragma unroll
        for (int i = 0; i < 16; ++i) {
            const float zz = z[i] * 0.125f;
            const bool valid = !diag || (crow(i, hh) < r);
            float spv = fmaxf(zz, 0.f) + __logf(1.f + __expf(-fabsf(zz)));
            spv = valid ? spv : 0.f;
            sp[i] = spv; rs += spv; z[i] = zz - spv;
        }
        f32x16 suf = zero16();
        suf = MFMA32(tri[0], pack_step<0>(sp), suf);
        suf = MFMA32(tri[1], pack_step<1>(sp), suf);
        f32x16 w;
#pragma unroll
        for (int i = 0; i < 16; ++i) {
            const bool valid = !diag || (crow(i, hh) < r);
            const float lw = z[i] - suf[i] - carry;
            w[i] = valid ? __expf(lw) : 0.f;
        }
        rs += __shfl_xor(rs, 32);
        carry += rs;
        const bf16x8 pa0 = pack_step<0>(w), pa1 = pack_step<1>(w);
        o0 = MFMA32(pa0, frag2(vl[0][0], vh[0][0]), o0); o0 = MFMA32(pa1, frag2(vl[0][1], vh[0][1]), o0);
        o1 = MFMA32(pa0, frag2(vl[1][0], vh[1][0]), o1); o1 = MFMA32(pa1, frag2(vl[1][1], vh[1][1]), o1);
        if (__all(carry > 104.f)) break;
#pragma unroll
        for (int ks = 0; ks < 4; ++ks) kf[ks] = kn[ks];
#pragma unroll
        for (int dt = 0; dt < 2; ++dt)
#pragma unroll
            for (int s2 = 0; s2 < 2; ++s2) { vl[dt][s2] = vln[dt][s2]; vh[dt][s2] = vhn[dt][s2]; }
    }
    bf16* op = YSB + (rowbase + t0) * 512 + h * 64 + r;
#pragma unroll
    for (int i = 0; i < 16; ++i) { const int t = crow(i, hh); op[(size_t)t * 512] = (bf16)f2bf(o0[i]); op[(size_t)t * 512 + 32] = (bf16)f2bf(o1[i]); }
}
__device__ __forceinline__ void sba_item(const P& p, int item, int wave, int lane) {
    const int bh = item >> 3, qb = item & 7, b = bh >> 3, h = bh & 7;
    sba_wave_item((const bf16*)(p.ws + WS_SBQKV), (const bf16*)(p.ws + WS_VT), (bf16*)p.out, b, h, qb * 8 + wave, lane);
}

__device__ __forceinline__ void p3_yml(const P& p, int wave, int lane) {
    const int gw = blockIdx.x * NWAVES + wave, NGW = gridDim.x * NWAVES;
    bf16* YML = (bf16*)p.out + (size_t)T_ * 512; const bf16* MLO = (const bf16*)(p.ws + WS_MLO);
    for (int m = gw; m < T_; m += NGW) {
        float hv[8], ov[8], o[8];
        unpack8(*(const v4u*)(YML + (size_t)m * 512 + lane * 8), hv); unpack8(*(const v4u*)(MLO + (size_t)m * 512 + lane * 8), ov);
        float ss = 0.f;
#pragma unroll
        for (int i = 0; i < 8; ++i) ss += hv[i] * hv[i];
        ss += __shfl_xor(ss, 1); ss += __shfl_xor(ss, 2); ss += __shfl_xor(ss, 4); ss += __shfl_xor(ss, 8);
        const float rstd = 1.f / sqrtf(ss * (1.f / 128.f) + EPS);
        const f32x4 w0 = *(const f32x4*)(p.ml_norm_w + lane * 8), w1 = *(const f32x4*)(p.ml_norm_w + lane * 8 + 4);
        const float wv[8] = {w0.x, w0.y, w0.z, w0.w, w1.x, w1.y, w1.z, w1.w};
#pragma unroll
        for (int i = 0; i < 8; ++i) o[i] = sigmoidf_(ov[i]) * hv[i] * rstd * wv[i];
        *(v4u*)(YML + (size_t)m * 512 + lane * 8) = pack8(o);
    }
}

__device__ __forceinline__ void p6_hn(const P& p, int wave, int lane) {
    const int gw = blockIdx.x * NWAVES + wave, NGW = gridDim.x * NWAVES;
    const float* H = (const float*)(p.ws + WS_H); bf16* HN = (bf16*)(p.ws + WS_HN);
    for (int m = gw; m < T_; m += NGW) {
        const f32x4* xr = (const f32x4*)(H + (size_t)m * 1024) + lane; const f32x4* wr = (const f32x4*)p.norm_ffn_w + lane;
        f32x4 v[4]; float ss = 0.f;
#pragma unroll
        for (int j = 0; j < 4; ++j) { v[j] = xr[64 * j]; ss += (v[j].x * v[j].x + v[j].y * v[j].y) + (v[j].z * v[j].z + v[j].w * v[j].w); }
        const float rstd = 1.f / sqrtf(wave_sum(ss) * (1.f / 1024.f) + EPS);
        v2u* o8 = (v2u*)(HN + (size_t)m * 1024) + lane;
#pragma unroll
        for (int j = 0; j < 4; ++j) { const f32x4 w = wr[64 * j]; o8[64 * j] = (v2u){pk2(v[j].x * rstd * w.x, v[j].y * rstd * w.y), pk2(v[j].z * rstd * w.z, v[j].w * rstd * w.w)}; }
    }
}

__device__ __forceinline__ unsigned ord_key(float f) { const unsigned u = __builtin_bit_cast(unsigned, f); return (u & 0x80000000u) ? ~u : (u | 0x80000000u); }
__device__ __forceinline__ float ord_val(unsigned k) { const unsigned u = (k & 0x80000000u) ? (k & 0x7fffffffu) : ~k; return __builtin_bit_cast(float, u); }
template <int CTRL> __device__ __forceinline__ unsigned dpp_u(unsigned v) { return (unsigned)__builtin_amdgcn_update_dpp(0, (int)v, CTRL, 0xF, 0xF, true); }
__device__ __forceinline__ unsigned umax_(unsigned a, unsigned b) { return a > b ? a : b; }
__device__ __forceinline__ unsigned umin_(unsigned a, unsigned b) { return a < b ? a : b; }
__device__ __forceinline__ unsigned row_max_u(unsigned v) {
    v = umax_(v, dpp_u<0xB1>(v)); v = umax_(v, dpp_u<0x4E>(v)); v = umax_(v, dpp_u<0x141>(v)); v = umax_(v, dpp_u<0x140>(v)); return v;
}
__device__ __forceinline__ float row_sum_f(float v) {
    v += __builtin_bit_cast(float, dpp_u<0xB1>(__builtin_bit_cast(unsigned, v))); v += __builtin_bit_cast(float, dpp_u<0x4E>(__builtin_bit_cast(unsigned, v)));
    v += __builtin_bit_cast(float, dpp_u<0x141>(__builtin_bit_cast(unsigned, v))); v += __builtin_bit_cast(float, dpp_u<0x140>(__builtin_bit_cast(unsigned, v))); return v;
}
#define CE_(i, j) do { const unsigned _a = k[i], _b = k[j]; k[i] = umax_(_a, _b); k[j] = umin_(_a, _b); } while (0)
__device__ __forceinline__ unsigned row_top16(unsigned (&k)[8], unsigned (&top)[16], int li) {
    CE_(0, 1); CE_(2, 3); CE_(4, 5); CE_(6, 7); CE_(0, 2); CE_(1, 3); CE_(4, 6); CE_(5, 7); CE_(1, 2); CE_(5, 6);
    CE_(0, 4); CE_(1, 5); CE_(2, 6); CE_(3, 7); CE_(2, 4); CE_(3, 5); CE_(1, 2); CE_(3, 4); CE_(5, 6);
    unsigned mine = 0u;
#pragma unroll
    for (int n = 0; n < 16; ++n) {
        const unsigned m = row_max_u(k[0]);
        const bool hit = k[0] == m;
#pragma unroll
        for (int i = 0; i < 7; ++i) k[i] = hit ? k[i + 1] : k[i];
        k[7] = hit ? 0u : k[7];
        top[n] = m; mine = (li == n) ? m : mine;
    }
    return mine;
}
__device__ __forceinline__ void p8_topk(const P& p, int hh, int wave, int lane) {
    const int gw = blockIdx.x * NWAVES + wave, NGW = gridDim.x * NWAVES;
    const float* SC = (const float*)(p.ws + WS_SC); int* IDX = (int*)(p.ws + WS_IDX); float* GATE = (float*)(p.ws + WS_GATE);
    const int q = lane >> 4, li = lane & 15, head = hh * 4 + q;
    for (int m = gw; m < T_; m += NGW) {
        const float* sr = SC + (size_t)m * 1024 + q * 256;
        unsigned k[8], top1[16], top2[16];
#pragma unroll
        for (int j = 0; j < 8; ++j) k[j] = (ord_key(sr[li + 16 * j]) & ~0x7fu) | (unsigned)(127 - (li + 16 * j));
        const unsigned mine1 = row_top16(k, top1, li);
#pragma unroll
        for (int j = 0; j < 8; ++j) k[j] = (ord_key(sr[128 + li + 16 * j]) & ~0x7fu) | (unsigned)(127 - (li + 16 * j));
        const unsigned mine2 = row_top16(k, top2, li);
        const float v2 = ord_val(mine2 & ~0x7fu);
        unsigned c[16];
#pragma unroll
        for (int j = 0; j < 16; ++j) {
            const float v1 = ord_val(top1[j] & ~0x7fu);
            const unsigned key = (ord_key(v1 + v2) & ~0xffu) | (unsigned)(255 - (16 * j + li));
            c[j] = ((j + 1) * (li + 1) <= 16) ? key : 0u;
        }
        unsigned tk = 0u, t0 = 0u;
#pragma unroll
        for (int n = 0; n < 16; ++n) {
            const unsigned mx = row_max_u(c[0]);
            const bool hit = c[0] == mx;
#pragma unroll
            for (int i = 0; i < 15; ++i) c[i] = hit ? c[i + 1] : c[i];
            c[15] = hit ? 0u : c[15];
            if (n == 0) t0 = mx;
            tk = (li == n) ? mx : tk;
        }
        const float sv = ord_val(tk & ~0xffu), s0 = ord_val(t0 & ~0xffu);
        const int cc = 255 - (int)(tk & 0xffu), a = (cc >> 4) & 15, bb = cc & 15;
        const int i1 = 127 - (int)((unsigned)__shfl((int)mine1, (lane & 48) + a) & 0x7fu), i2 = 127 - (int)((unsigned)__shfl((int)mine2, (lane & 48) + bb) & 0x7fu);
        const float pe = expf(sv - s0);
        const float den = row_sum_f(pe);
        IDX[(size_t)m * 128 + head * 16 + li] = i1 * 128 + i2; GATE[(size_t)m * 128 + head * 16 + li] = pe / den;
    }
}

__device__ __forceinline__ float gelu_erf(float x) { return 0.5f * x * (1.f + erff(x * 0.70710678118654752f)); }
typedef float f32x2 __attribute__((ext_vector_type(2)));
__device__ __forceinline__ void cvt16_fp8(const v4u& w, f32x2 (&f)[8]) {
    f[0] = __builtin_amdgcn_cvt_pk_f32_fp8((int)w.x, false); f[1] = __builtin_amdgcn_cvt_pk_f32_fp8((int)w.x, true);
    f[2] = __builtin_amdgcn_cvt_pk_f32_fp8((int)w.y, false); f[3] = __builtin_amdgcn_cvt_pk_f32_fp8((int)w.y, true);
    f[4] = __builtin_amdgcn_cvt_pk_f32_fp8((int)w.z, false); f[5] = __builtin_amdgcn_cvt_pk_f32_fp8((int)w.z, true);
    f[6] = __builtin_amdgcn_cvt_pk_f32_fp8((int)w.w, false); f[7] = __builtin_amdgcn_cvt_pk_f32_fp8((int)w.w, true);
}
__device__ __forceinline__ constexpr int peer_lane_of(int u) { return 8 * ((u >> 2) & 1) + 16 * ((u >> 1) & 1) + 32 * (u & 1); }
__device__ __forceinline__ void p9_peer(const P& p, volatile LAS unsigned* MISC, int wave, int lane) {
    const float* H = (const float*)(p.ws + WS_H); const bf16* HN = (const bf16*)(p.ws + WS_HN);
    const int* IDX = (const int*)(p.ws + WS_IDX); const float* GATE = (const float*)(p.ws + WS_GATE);
    const unsigned char* U8 = p.ws + WS_U8; const unsigned char* V8 = p.ws + WS_V8; const float* USC = (const float*)(p.ws + WS_USC); const float* VSC = (const float*)(p.ws + WS_VSC);
    const int eid = 4 * ((lane >> 3) & 1) + 2 * ((lane >> 4) & 1) + ((lane >> 5) & 1);
    const bool b5 = (lane & 32) != 0, b4 = (lane & 16) != 0, b3 = (lane & 8) != 0;
    unsigned* qctr = (unsigned*)(p.ws + WS_CTL) + CW_Q + 64;
    for (;;) {
        if (threadIdx.x == 0) MISC[12] = __hip_atomic_fetch_add(qctr, 8u, __ATOMIC_RELAXED, __HIP_MEMORY_SCOPE_AGENT);
        __syncthreads();
        const unsigned mbase = MISC[12];
        __syncthreads();
        if (mbase >= (unsigned)T_) break;
        const int m = (int)mbase + wave;
        f32x2 xv[8], acc[8];
        { float f[8]; const v4u h0 = *(const v4u*)(HN + (size_t)m * 1024 + 16 * lane), h1 = *(const v4u*)(HN + (size_t)m * 1024 + 16 * lane + 8);
          unpack8(h0, f);
#pragma unroll
          for (int i = 0; i < 4; ++i) xv[i] = (f32x2){f[2 * i], f[2 * i + 1]};
          unpack8(h1, f);
#pragma unroll
          for (int i = 0; i < 4; ++i) xv[4 + i] = (f32x2){f[2 * i], f[2 * i + 1]}; }
#pragma unroll
        for (int i = 0; i < 8; ++i) acc[i] = (f32x2){0.f, 0.f};
        int e_l = IDX[(size_t)m * 128 + eid]; float g_l = GATE[(size_t)m * 128 + eid];
#pragma unroll 1
        for (int j0 = 0; j0 < 128; j0 += 8) {
            int ei[8];
#pragma unroll
            for (int u = 0; u < 8; ++u) ei[u] = __builtin_amdgcn_readlane(e_l, peer_lane_of(u));
            v4u ur[8], vr[8];
#pragma unroll
            for (int u = 0; u < 8; ++u) ur[u] = *(const v4u*)(U8 + (size_t)ei[u] * 1024 + 16 * lane);
            const float usc = USC[e_l], vsc = VSC[e_l], g_cur = g_l;
#pragma unroll
            for (int u = 0; u < 8; ++u) vr[u] = *(const v4u*)(V8 + (size_t)ei[u] * 1024 + 16 * lane);
            const int jn = j0 + 8 < 128 ? j0 + 8 : j0;
            e_l = IDX[(size_t)m * 128 + jn + eid]; g_l = GATE[(size_t)m * 128 + jn + eid];
            float d[8];
#pragma unroll
            for (int u = 0; u < 8; ++u) {
                f32x2 f[8]; cvt16_fp8(ur[u], f);
                f32x2 s2 = f[0] * xv[0];
#pragma unroll
                for (int i = 1; i < 8; ++i) s2 += f[i] * xv[i];
                d[u] = s2.x + s2.y;
            }
            float e4[4], f2[2], gsum;
#pragma unroll
            for (int i = 0; i < 4; ++i) { const float keep = b5 ? d[2 * i + 1] : d[2 * i], send = b5 ? d[2 * i] : d[2 * i + 1]; e4[i] = keep + __shfl_xor(send, 32); }
#pragma unroll
            for (int i = 0; i < 2; ++i) { const float keep = b4 ? e4[2 * i + 1] : e4[2 * i], send = b4 ? e4[2 * i] : e4[2 * i + 1]; f2[i] = keep + __shfl_xor(send, 16); }
            { const float keep = b3 ? f2[1] : f2[0], send = b3 ? f2[0] : f2[1]; gsum = keep + __shfl_xor(send, 8); }
            gsum += __builtin_bit_cast(float, dpp_u<0xB1>(__builtin_bit_cast(unsigned, gsum)));
            gsum += __builtin_bit_cast(float, dpp_u<0x4E>(__builtin_bit_cast(unsigned, gsum)));
            gsum += __builtin_bit_cast(float, dpp_u<0x141>(__builtin_bit_cast(unsigned, gsum)));
            const float coef_l = g_cur * gelu_erf(gsum * usc) * vsc;
#pragma unroll
            for (int u = 0; u < 8; ++u) {
                const float cu = __builtin_bit_cast(float, __builtin_amdgcn_readlane(__builtin_bit_cast(int, coef_l), peer_lane_of(u)));
                const f32x2 c2 = (f32x2){cu, cu};
                f32x2 f[8]; cvt16_fp8(vr[u], f);
#pragma unroll
                for (int i = 0; i < 8; ++i) acc[i] += c2 * f[i];
            }
        }
        float y[16], ss = 0.f;
#pragma unroll
        for (int j = 0; j < 4; ++j) { const f32x4 hv = *(const f32x4*)(H + (size_t)m * 1024 + 16 * lane + 4 * j);
            y[4 * j] = hv.x + acc[2 * j].x; y[4 * j + 1] = hv.y + acc[2 * j].y; y[4 * j + 2] = hv.z + acc[2 * j + 1].x; y[4 * j + 3] = hv.w + acc[2 * j + 1].y; }
#pragma unroll
        for (int i = 0; i < 16; ++i) ss += y[i] * y[i];
        const float rstd = 1.f / sqrtf(wave_sum(ss) * (1.f / 1024.f) + EPS);
#pragma unroll
        for (int j = 0; j < 4; ++j) { const f32x4 w = *(const f32x4*)(p.norm_final_w + 16 * lane + 4 * j);
            *(f32x4*)(p.out + (size_t)m * 1024 + 16 * lane + 4 * j) = (f32x4){y[4 * j] * rstd * w.x, y[4 * j + 1] * rstd * w.y, y[4 * j + 2] * rstd * w.z, y[4 * j + 3] * rstd * w.w}; }
    }
}

constexpr int N_PHASES = 13;
struct Args { P p; int ph_lo, ph_hi; };
__global__ void __launch_bounds__(NTHR, 2) fwd_kernel(Args args) {
    extern __shared__ __attribute__((aligned(16))) unsigned char lds_raw[];
    LAS unsigned char* lds = (LAS unsigned char*)lds_raw;
    const P& p = args.p;
    const int tid = threadIdx.x, lane = tid & 63, wave = __builtin_amdgcn_readfirstlane(tid >> 6);
    volatile LAS unsigned* MISC = (volatile LAS unsigned*)(lds + MISC_OFF);
    for (int u = tid; u < (LDS_BYTES - LDSCTL_OFF) / 4; u += NTHR) ((LAS unsigned*)(lds + LDSCTL_OFF))[u] = 0u;
    __syncthreads();
    XcdBarrier bar; bar.bar = (unsigned*)(p.ws + WS_CTL) + CW_BAR; bar.x = 0; bar.st = nullptr;
#if !MK_PER_PHASE
    bar = xcd_barrier_post((unsigned*)(p.ws + WS_CTL) + CW_BAR, MISC + 8);
#endif
    const int lo = args.ph_lo, hi = args.ph_hi;
#define IN(k) (lo <= (k) && (k) < hi)
#ifndef PROBE_WAIT_LO
#define PROBE_WAIT_LO -1
#define PROBE_WAIT_HI -1
#endif
    volatile LAS unsigned long long* STAMP = (volatile LAS unsigned long long*)(lds + MISC_OFF + 256);
#define SEAM(k) do { if (IN(k) && IN((k) + 1)) xcd_barrier(bar); if (PROBE_WAIT_LO >= 0 && blockIdx.x == 0 && tid == 0) STAMP[(k) + 1] = __builtin_amdgcn_s_memrealtime(); } while (0)
    if (PROBE_WAIT_LO >= 0 && blockIdx.x == 0 && tid == 0) STAMP[0] = __builtin_amdgcn_s_memrealtime();

#ifndef PROBE_REP
#define PROBE_REP -1
#endif
#define REP(k) ((PROBE_REP == (k)) ? 2 : 1)
    if (IN(0)) {
#pragma unroll 1
        for (int r = 0; r < REP(0); ++r) p0_prologue(p, lds, wave, lane); } SEAM(0);
    if (IN(1)) {
#pragma unroll 1
      for (int r = 0; r < REP(1); ++r) {
        EpiProj e{(bf16*)(p.ws + WS_SBQKV), (bf16*)(p.ws + WS_VT), (bf16*)(p.ws + WS_MLQK), (bf16*)(p.ws + WS_MLV), (bf16*)(p.ws + WS_MLO), (bf16*)(p.ws + WS_GATES)};
        gemm<EpiProj>(lds, (const bf16*)(p.ws + WS_XN), (const bf16*)(p.ws + WS_W1T), T_, NPROJ, 1024, e); }
    } SEAM(1);
    if (IN(2)) { p2_conv(p, tid); } SEAM(2);
    if (IN(3)) {
        for (int it = blockIdx.x; it < 64; it += gridDim.x) mlstm_item(p, lds, it, tid, wave, lane);
        unsigned* qctr = (unsigned*)(p.ws + WS_CTL) + CW_Q;
        for (;;) {
            if (tid == 0) MISC[12] = __hip_atomic_fetch_add(qctr, 1u, __ATOMIC_RELAXED, __HIP_MEMORY_SCOPE_AGENT);
            __syncthreads();
            const unsigned it = MISC[12];
            __syncthreads();
            if (it >= 1024u) break;
            sba_item(p, (int)it, wave, lane);
        }
    } SEAM(3);
    if (IN(4)) { p3_yml(p, wave, lane); } SEAM(4);
    if (IN(5)) {
        EpiMergeA ea{(bf16*)(p.ws + WS_MERGED), (const bf16*)(p.ws + WS_GATES)};
        gemm<EpiMergeA>(lds, (const bf16*)p.out, (const bf16*)(p.ws + WS_WSBT), T_, 1024, 512, ea);
        VM_WAIT(); __syncthreads();
        EpiMergeB eb{(bf16*)(p.ws + WS_MERGED), (const bf16*)(p.ws + WS_GATES)};
        gemm<EpiMergeB>(lds, (const bf16*)p.out + (size_t)T_ * 512, (const bf16*)(p.ws + WS_WMLT), T_, 1024, 512, eb);
    } SEAM(5);
    if (IN(6)) {
#pragma unroll 1
      for (int r = 0; r < REP(5); ++r) {
        EpiH e{(float*)(p.ws + WS_H), p.x};
        gemm<EpiH>(lds, (const bf16*)(p.ws + WS_MERGED), (const bf16*)(p.ws + WS_WOUTT), T_, 1024, 1024, e); }
    } SEAM(6);
    if (IN(7)) { p6_hn(p, wave, lane); } SEAM(7);
    if (IN(8)) { EpiF32 e{(float*)(p.ws + WS_SC), 1024}; gemm<EpiF32>(lds, (const bf16*)(p.ws + WS_HN), (const bf16*)(p.ws + WS_WCT), T_, 1024, 1024, e); } SEAM(8);
    if (IN(9)) {
#pragma unroll 1
        for (int r = 0; r < REP(8); ++r) p8_topk(p, 0, wave, lane); } SEAM(9);
    if (IN(10)) { EpiF32 e{(float*)(p.ws + WS_SC), 1024}; gemm<EpiF32>(lds, (const bf16*)(p.ws + WS_HN), (const bf16*)(p.ws + WS_WCT) + (size_t)1024 * 1024, T_, 1024, 1024, e); } SEAM(10);
    if (IN(11)) { p8_topk(p, 1, wave, lane); } SEAM(11);
    if (IN(12)) {
#pragma unroll 1
        for (int r = 0; r < REP(11); ++r) p9_peer(p, MISC, wave, lane); }
    if (PROBE_WAIT_LO >= 0 && blockIdx.x == 0 && tid == 0) {
        const unsigned long long tend = __builtin_amdgcn_s_memrealtime();
        const unsigned long long thi = PROBE_WAIT_HI >= 13 ? tend : STAMP[PROBE_WAIT_HI < 0 ? 0 : PROBE_WAIT_HI];
        const unsigned long long dt = thi - STAMP[PROBE_WAIT_LO];
        while (__builtin_amdgcn_s_memrealtime() - tend < dt) __builtin_amdgcn_s_sleep(8);
    }
#undef IN
#undef SEAM
}

extern "C" void kernel_launch(void* const* d_in, const int* in_sizes, int n_in, void* d_out, int out_size, void* d_ws, size_t ws_size, hipStream_t stream) {
    static int grid = 0;
    if (grid == 0) {
        if (n_in != 18 || in_sizes[0] != T_ * D_ || out_size != T_ * D_ || ws_size < WS_END) {
            fprintf(stderr, "kernel_launch: unexpected problem (n_in %d, in0 %d, out %d, ws %zu); nothing launched\n", n_in, n_in > 0 ? in_sizes[0] : -1, out_size, ws_size); grid = -1; return; }
        int dev = 0, cus = 0, per_cu = 0;
        if (hipGetDevice(&dev) != hipSuccess || hipDeviceGetAttribute(&cus, hipDeviceAttributeMultiprocessorCount, dev) != hipSuccess) { grid = -1; return; }
        if (hipFuncSetAttribute((const void*)fwd_kernel, hipFuncAttributeMaxDynamicSharedMemorySize, LDS_BYTES) != hipSuccess) { fprintf(stderr, "kernel_launch: hipFuncSetAttribute failed\n"); grid = -1; return; }
        if (hipOccupancyMaxActiveBlocksPerMultiprocessor(&per_cu, (const void*)fwd_kernel, NTHR, LDS_BYTES) != hipSuccess || per_cu < 1)
            fprintf(stderr, "kernel_launch: note: occupancy query reports %d workgroups per CU\n", per_cu);
        (void)hipGetLastError();
        grid = cus;
    }
    if (grid < 0) return;
    if (hipMemsetAsync((char*)d_ws + WS_CTL, 0, CTL_ZERO_BYTES, stream) != hipSuccess) { fprintf(stderr, "kernel_launch: memset failed\n"); return; }
    Args a{};
    const float** pp = (const float**)&a.p;
    for (int i = 0; i < 18; ++i) pp[i] = (const float*)d_in[i];
    a.p.out = (float*)d_out; a.p.ws = (unsigned char*)d_ws;
#if MK_PER_PHASE
    for (int ph = 0; ph < N_PHASES; ++ph) {
        a.ph_lo = ph; a.ph_hi = ph + 1;
        hipLaunchKernelGGL(fwd_kernel, dim3(grid), dim3(NTHR), LDS_BYTES, stream, a);
    }
#else
    a.ph_lo = 0; a.ph_hi = N_PHASES;
    hipLaunchKernelGGL(fwd_kernel, dim3(grid), dim3(NTHR), LDS_BYTES, stream, a);
#endif
    const hipError_t le = hipPeekAtLastError();
    if (le != hipSuccess) fprintf(stderr, "kernel_launch: launch failed: %s\n", hipGetErrorName(le));
}
```

```cpp
#include <hip/hip_runtime.h>
#include <cstdio>
#include <cstdint>
namespace pg8 {
#define PG8_LAS __attribute__((address_space(3)))
typedef unsigned short bf16_t;
typedef short bf16x8 __attribute__((ext_vector_type(8)));
typedef float f32x4 __attribute__((ext_vector_type(4)));
typedef unsigned u32x4 __attribute__((ext_vector_type(4)));
constexpr int BM = 256, BK = 64, HALF = 128, HTB = HALF * BK * 2  , STAGE_BYTES = 8 * HTB, NXCD = 8, WGM = 8;

__host__ __device__ __forceinline__ int lds_byte(int r, int c) { const int st = (r >> 4) * 2 + (c >> 5), rr = r & 15, cc = c & 31, ob = rr * 64 + cc * 2; return st * 1024 + (ob ^ (((ob >> 9) & 1) << 5)); }
__host__ __device__ __forceinline__ void stage_rc(int b, int& R, int& C) { const int st = b / 1024, sb = b % 1024, swz = sb ^ (((sb >> 9) & 1) << 5); R = (st >> 1) * 16 + swz / 64; C = (st & 1) * 32 + (swz % 64) / 2; }
__host__ __device__ __forceinline__ int perm32(int rho) { const int n = rho >> 4, i = rho & 15; return 8 * (i >> 2) + 4 * n + (i & 3); }

struct Unit { int pm, pn; };
struct Gemm { const bf16_t* A; const bf16_t* Bt; int M, N, K; };

struct StaticOrder {
    int nM, nN, nwg, G, c;
    __host__ __device__ void init(int M, int N, int G_, int c_) { nM = M / BM; nN = N / BM; nwg = nM * nN; G = G_; c = c_; }
    __host__ __device__ bool next(int i, Unit& u) const {
        const long L = (long)i * G + c; if (L >= nwg) return false;
        int wgid = (int)L; { const int q = nwg / NXCD, r = nwg % NXCD, xcd = wgid % NXCD, off = wgid / NXCD; wgid = (xcd < r ? xcd * (q + 1) : r * (q + 1) + (xcd - r) * q) + off; }
        const int nig = WGM * nN, gid = wgid / nig, fm = gid * WGM, gsz = (nM - fm) < WGM ? (nM - fm) : WGM;
        u.pm = fm + ((wgid % nig) % gsz); u.pn = (wgid % nig) / gsz; return true;
    }
    __device__ __forceinline__ void a_ready(const Unit&) const {}
    __device__ __forceinline__ void done(const Unit&) const {}
};

__device__ __forceinline__ unsigned cvt_pk_bf16(float lo, float hi) { unsigned r; asm volatile("v_cvt_pk_bf16_f32 %0, %1, %2" : "=v"(r) : "v"(lo), "v"(hi)); return r; }
template <class Epi, class Sched, bool ALIGN_EPI = false, bool SP2 = false>
__device__ __forceinline__ void gemm_phase(PG8_LAS unsigned char* lds, const Gemm g, const Sched& S, const Epi& E) {
    const int tid = threadIdx.x, wid = __builtin_amdgcn_readfirstlane(tid >> 6), lane = tid & 63, wr = wid >> 2, wc = wid & 3, fr = lane & 15, fq = lane >> 4;
    const int K = g.K, nt = K / BK;
    unsigned voffA[2], voffB[2];
#pragma unroll
    for (int i = 0; i < 2; ++i) { int R, C; stage_rc(tid * 16 + i * 8192, R, C); const int Rb = Epi::PERM ? ((R & ~31) + perm32(R & 31)) : R;
        voffA[i] = (unsigned)(R * K + C) * 2u; voffB[i] = (unsigned)(Rb * K + C) * 2u; }
    const size_t kstep = (size_t)(BK * 2);
    const size_t hstep = (size_t)HALF * K * 2;
    const size_t tstep = 2 * hstep;
    const unsigned ldsw = (unsigned)wid * 1024u;
    const int aoff = lds_byte(wr * 64 + fr, fq * 8), boff = lds_byte(wc * 32 + fr, fq * 8);
#define PG8_SA(b, h) (((b) * 2 + (h)) * HTB)
#define PG8_SB(b, h) ((4 + (b) * 2 + (h)) * HTB)
#define PG8_STAGE(bufoff, gbase, voff) do { _Pragma("unroll") for (int _i = 0; _i < 2; ++_i) \
        __builtin_amdgcn_global_load_lds((const unsigned*)((const char*)(gbase) + (voff)[_i]), (PG8_LAS unsigned*)(lds + (bufoff) + ldsw + _i * 8192), 16, 0, 0); } while (0)
#define PG8_LDA(dst, b, h) do { _Pragma("unroll") for (int m = 0; m < 4; ++m) _Pragma("unroll") for (int k = 0; k < 2; ++k) dst[m][k] = *(const PG8_LAS bf16x8*)(lds + PG8_SA(b, h) + aoff + m * 2048 + k * 1024); } while (0)
#define PG8_LDB(dst, b, h) do { _Pragma("unroll") for (int n = 0; n < 2; ++n) _Pragma("unroll") for (int k = 0; k < 2; ++k) dst[n][k] = *(const PG8_LAS bf16x8*)(lds + PG8_SB(b, h) + boff + n * 2048 + k * 1024); } while (0)
#define PG8_MMA(ai, bj, At, Bt) do { __builtin_amdgcn_s_setprio(1); _Pragma("unroll") for (int m = 0; m < 4; ++m) _Pragma("unroll") for (int n = 0; n < 2; ++n) _Pragma("unroll") for (int k = 0; k < 2; ++k) \
        acc[ai][bj][m][n] = __builtin_amdgcn_mfma_f32_16x16x32_bf16(Bt[n][k], At[m][k], acc[ai][bj][m][n], 0, 0, 0); __builtin_amdgcn_s_setprio(0); } while (0)
#define PG8_WAIT_V(n) asm volatile("s_waitcnt vmcnt(" #n ")" ::: "memory")
#define PG8_WAIT_L(n) asm volatile("s_waitcnt lgkmcnt(" #n ")" ::: "memory")
#define PG8_BAR __builtin_amdgcn_s_barrier()
#define PG8_SCHED __builtin_amdgcn_sched_barrier(0)
    Unit cur, nxt; int ui = 0;
    if (!S.next(0, cur)) return;
    f32x4 acc[2][2][4][2];
#pragma unroll
    for (int a = 0; a < 2; ++a)
#pragma unroll
        for (int b = 0; b < 2; ++b)
#pragma unroll
            for (int m = 0; m < 4; ++m)
#pragma unroll
                for (int n = 0; n < 2; ++n) acc[a][b][m][n] = (f32x4){0.f, 0.f, 0.f, 0.f};
    bf16x8 At[4][2], B0[2][2], B1[2][2];
    const char* cA = (const char*)g.A + (size_t)cur.pm * tstep; const char* cB = (const char*)g.Bt + (size_t)cur.pn * tstep;
    S.a_ready(cur);
    if constexpr (SP2) {
        PG8_STAGE(PG8_SB(0, 0), cB, voffB); PG8_STAGE(PG8_SB(0, 1), cB + hstep, voffB); PG8_STAGE(PG8_SA(0, 0), cA, voffA); PG8_STAGE(PG8_SA(0, 1), cA + hstep, voffA);
        if (wr == 1) PG8_BAR;
        PG8_WAIT_V(2); PG8_BAR;
        PG8_STAGE(PG8_SB(1, 0), cB + kstep, voffB); PG8_STAGE(PG8_SA(1, 0), cA + kstep, voffA); PG8_STAGE(PG8_SB(1, 1), cB + hstep + kstep, voffB);
        PG8_WAIT_V(6); PG8_BAR;
    } else {
        PG8_STAGE(PG8_SB(0, 0), cB, voffB); PG8_STAGE(PG8_SA(0, 0), cA, voffA); PG8_STAGE(PG8_SB(0, 1), cB + hstep, voffB); PG8_STAGE(PG8_SA(0, 1), cA + hstep, voffA);
        if (wr == 1) PG8_BAR;
        PG8_WAIT_V(4); PG8_BAR;
        PG8_STAGE(PG8_SB(1, 0), cB + kstep, voffB); PG8_STAGE(PG8_SA(1, 0), cA + kstep, voffA); PG8_STAGE(PG8_SB(1, 1), cB + hstep + kstep, voffB);
        PG8_WAIT_V(6); PG8_BAR;
    }
    for (;;) {
        const bool has_next = S.next(ui + 1, nxt);
        const char* nA = has_next ? (const char*)g.A + (size_t)nxt.pm * tstep : cA; const char* nB = has_next ? (const char*)g.Bt + (size_t)nxt.pn * tstep : cB;
        for (int t = 0; t < nt; t += 2) {
            const bool last = (t == nt - 2);
            const char* a1 = cA + (size_t)(t + 1) * kstep;
            const char* a2 = last ? nA : cA + (size_t)(t + 2) * kstep; const char* b2 = last ? nB : cB + (size_t)(t + 2) * kstep;
            const char* a3 = a2 + kstep; const char* b3 = b2 + kstep;
            if (last && has_next) S.a_ready(nxt);
            if constexpr (SP2) {
            PG8_LDB(B0, 0, 0); PG8_LDB(B1, 0, 1); PG8_SCHED; PG8_LDA(At, 0, 0); PG8_STAGE(PG8_SA(1, 1), a1 + hstep, voffA);
            PG8_WAIT_V(8); PG8_WAIT_L(0); PG8_BAR; PG8_MMA(0, 0, At, B0); PG8_MMA(0, 1, At, B1); PG8_BAR; PG8_SCHED;
            PG8_LDA(At, 0, 1); PG8_STAGE(PG8_SB(0, 0), b2, voffB); PG8_STAGE(PG8_SB(0, 1), b2 + hstep, voffB); PG8_STAGE(PG8_SA(0, 0), a2, voffA);
            PG8_WAIT_V(8); PG8_WAIT_L(0); PG8_BAR; PG8_MMA(1, 0, At, B0); PG8_MMA(1, 1, At, B1); PG8_BAR; PG8_SCHED;
            PG8_LDB(B0, 1, 0); PG8_LDB(B1, 1, 1); PG8_SCHED; PG8_LDA(At, 1, 0); PG8_STAGE(PG8_SA(0, 1), a2 + hstep, voffA);
            PG8_WAIT_V(8); PG8_WAIT_L(0); PG8_BAR; PG8_MMA(0, 0, At, B0); PG8_MMA(0, 1, At, B1); PG8_BAR; PG8_SCHED;
            PG8_LDA(At, 1, 1); PG8_STAGE(PG8_SB(1, 0), b3, voffB); PG8_STAGE(PG8_SB(1, 1), b3 + hstep, voffB); PG8_STAGE(PG8_SA(1, 0), a3, voffA);
            PG8_WAIT_V(8); PG8_WAIT_L(0); PG8_BAR; PG8_MMA(1, 0, At, B0); PG8_MMA(1, 1, At, B1); PG8_BAR; PG8_SCHED;
            } else {
            PG8_LDB(B0, 0, 0); PG8_SCHED; PG8_LDA(At, 0, 0); PG8_STAGE(PG8_SA(1, 1), a1 + hstep, voffA);
            PG8_WAIT_L(8); PG8_BAR; PG8_WAIT_L(0); PG8_MMA(0, 0, At, B0); PG8_BAR; PG8_SCHED;
            PG8_LDB(B1, 0, 1); PG8_STAGE(PG8_SB(0, 0), b2, voffB);
            PG8_BAR; PG8_WAIT_L(0); PG8_MMA(0, 1, At, B1); PG8_BAR;
            PG8_LDA(At, 0, 1); PG8_STAGE(PG8_SA(0, 0), a2, voffA);
            PG8_BAR; PG8_WAIT_L(0); PG8_MMA(1, 0, At, B0); PG8_BAR; PG8_SCHED;
            PG8_STAGE(PG8_SB(0, 1), b2 + hstep, voffB);
            PG8_WAIT_V(6); PG8_BAR; PG8_MMA(1, 1, At, B1); PG8_BAR;
            PG8_LDB(B0, 1, 0); PG8_SCHED; PG8_LDA(At, 1, 0); PG8_STAGE(PG8_SA(0, 1), a2 + hstep, voffA);
            PG8_WAIT_L(8); PG8_BAR; PG8_WAIT_L(0); PG8_MMA(0, 0, At, B0); PG8_BAR; PG8_SCHED;
            PG8_LDB(B1, 1, 1); PG8_STAGE(PG8_SB(1, 0), b3, voffB);
            PG8_BAR; PG8_WAIT_L(0); PG8_MMA(0, 1, At, B1); PG8_BAR;
            PG8_LDA(At, 1, 1); PG8_STAGE(PG8_SA(1, 0), a3, voffA);
            PG8_BAR; PG8_WAIT_L(0); PG8_MMA(1, 0, At, B0); PG8_BAR; PG8_SCHED;
            PG8_STAGE(PG8_SB(1, 1), b3 + hstep, voffB);
            PG8_WAIT_V(6); PG8_BAR; PG8_MMA(1, 1, At, B1); PG8_BAR;
            }
        }
        if constexpr (ALIGN_EPI) { if (wr == 0) PG8_BAR; }
        if constexpr (!Epi::AFTER_DRAIN) { E(acc, cur, wr, wc, fr, fq); S.done(cur); }
        if (!has_next) break;
#pragma unroll
        for (int a = 0; a < 2; ++a)
#pragma unroll
            for (int b = 0; b < 2; ++b)
#pragma unroll
                for (int m = 0; m < 4; ++m)
#pragma unroll
                    for (int n = 0; n < 2; ++n) acc[a][b][m][n] = (f32x4){0.f, 0.f, 0.f, 0.f};
        cur = nxt; cA = nA; cB = nB; ++ui;
        if constexpr (ALIGN_EPI) { if (wr == 1) PG8_BAR; }
    }
    PG8_WAIT_V(0);
    if constexpr (!ALIGN_EPI) { if (wr == 0) PG8_BAR; }
    PG8_BAR;
    if constexpr (Epi::AFTER_DRAIN) { E.fused(acc, cur, wr, wc, fr, fq, lds, wid, lane); S.done(cur); }
#undef PG8_SA
#undef PG8_SB
#undef PG8_STAGE
#undef PG8_LDA
#undef PG8_LDB
#undef PG8_MMA
#undef PG8_WAIT_V
#undef PG8_WAIT_L
#undef PG8_BAR
#undef PG8_SCHED
}
}

#ifndef MK_PER_PHASE
#define MK_PER_PHASE 0
#endif
#ifndef USE_PG8
#define USE_PG8 1
#endif
constexpr int NWAVES = 8, NTHR = 512;

constexpr int B_ = 16, S_ = 2048, D_ = 1024, T_ = B_ * S_;
constexpr int INC = 5640, NPROJ = 5632;
constexpr int NEXP = 16384;
constexpr float EPS = 1e-6f;

constexpr size_t MiB = 1u << 20;
constexpr size_t WS_CTL = 0, CTL_ZERO_BYTES = 1 * MiB;
constexpr size_t WS_W1T = 2 * MiB, WS_WSBT = 13 * MiB, WS_WMLT = 14 * MiB, WS_WOUTT = 15 * MiB, WS_WCT = 17 * MiB, WS_IFG = 21 * MiB;
constexpr size_t WS_U8 = 24 * MiB, WS_V8 = 40 * MiB, WS_USC = 22 * MiB, WS_VSC = 23 * MiB;
constexpr size_t WS_XN = 88 * MiB, WS_QC = 88 * MiB, WS_KC = 120 * MiB;
constexpr size_t WS_SBQKV = 152 * MiB  , WS_VT = 216 * MiB  , WS_MLQK = 248 * MiB, WS_MLV = 312 * MiB, WS_MLO = 344 * MiB, WS_GATES = 376 * MiB;
constexpr size_t WS_MERGED = 216 * MiB, WS_H = 88 * MiB, WS_HN = 216 * MiB, WS_IDX = 280 * MiB, WS_GATE = 296 * MiB, WS_SC = 312 * MiB;
constexpr size_t WS_PART = 312 * MiB  , WS_SSQ = 504 * MiB  , WS_COEF = 56 * MiB  ;
constexpr size_t WS_END = 505 * MiB;
constexpr int CW_BAR = 4096, CW_Q = 8192;

constexpr int RING_OFF = 0, RING_BYTES = 131072;
constexpr int LDSCTL_OFF = RING_BYTES, MISC_OFF = LDSCTL_OFF + 320;
constexpr int LDS_BYTES = 147456;

#define GAS __attribute__((address_space(1)))
#define LAS __attribute__((address_space(3)))
typedef unsigned short bf16;
typedef unsigned v4u __attribute__((ext_vector_type(4)));
typedef unsigned v2u __attribute__((ext_vector_type(2)));
typedef float f32x4 __attribute__((ext_vector_type(4)));
#define LDS_WAIT() asm volatile("s_waitcnt lgkmcnt(0)" ::: "memory")
#define VM_WAIT() asm volatile("s_waitcnt vmcnt(0)" ::: "memory")
__device__ __forceinline__ unsigned f2bf(float f) { unsigned u = __builtin_bit_cast(unsigned, f); return (u + 0x7fffu + ((u >> 16) & 1u)) >> 16; }
__device__ __forceinline__ unsigned pk2(float lo, float hi) { return f2bf(lo) | (f2bf(hi) << 16); }
__device__ __forceinline__ float bflo(unsigned u) { return __builtin_bit_cast(float, u << 16); }
__device__ __forceinline__ float bfhi(unsigned u) { return __builtin_bit_cast(float, u & 0xffff0000u); }
__device__ __forceinline__ float bf2f(bf16 b) { return __builtin_bit_cast(float, (unsigned)b << 16); }
__device__ __forceinline__ float sigmoidf_(float x) { return 1.f / (1.f + __expf(-x)); }
__device__ __forceinline__ float wave_sum(float v) {
#pragma unroll
    for (int o = 1; o < 64; o <<= 1) v += __shfl_xor(v, o);
    return v;
}
__device__ __forceinline__ unsigned wave_max_u(unsigned v) {
#pragma unroll
    for (int o = 1; o < 64; o <<= 1) { const unsigned w = (unsigned)__shfl_xor((int)v, o); v = v > w ? v : w; }
    return v;
}
struct F8 { float v[8]; };
__device__ __forceinline__ void unpack8(const v4u& u, float (&f)[8]) {
    f[0] = bflo(u.x); f[1] = bfhi(u.x); f[2] = bflo(u.y); f[3] = bfhi(u.y); f[4] = bflo(u.z); f[5] = bfhi(u.z); f[6] = bflo(u.w); f[7] = bfhi(u.w);
}
__device__ __forceinline__ v4u pack8(const float (&f)[8]) { v4u o; o.x = pk2(f[0], f[1]); o.y = pk2(f[2], f[3]); o.z = pk2(f[4], f[5]); o.w = pk2(f[6], f[7]); return o; }

#define XB_TMO      128
#define XB_XCNT(j)  (256  + 64 * (j))
#define XB_XSUB(j)  (1280 + 64 * (j))
#define XB_XGEN(j)  (2304 + 64 * (j))
#define XB_TOP      3328
#define XB_TOPGEN   3392
#define XCD_BAR_WORDS 3456
#define XB_SPIN_CAP (1u << 24)

__device__ __forceinline__ unsigned xb_ld(unsigned* p)              { return __hip_atomic_load(p, __ATOMIC_RELAXED, __HIP_MEMORY_SCOPE_AGENT); }
__device__ __forceinline__ unsigned xb_add(unsigned* p, unsigned v) { return __hip_atomic_fetch_add(p, v, __ATOMIC_RELAXED, __HIP_MEMORY_SCOPE_AGENT); }
__device__ __forceinline__ unsigned xb_xcc_id() { return (unsigned)__builtin_amdgcn_s_getreg((3 << 11) | 20) & 0xFu; }
#define XB_SPIN(cond, bar) do { unsigned _sp = 0; while (cond) { __builtin_amdgcn_s_sleep(1); \
    if ((++_sp & 255u) == 0u) { if (xb_ld(&(bar)[XB_TMO])) break; if (_sp > XB_SPIN_CAP) { atomicAdd(&(bar)[XB_TMO], 1u); break; } } } } while (0)

struct XcdBarrier {
    unsigned* bar; unsigned x;
    volatile LAS unsigned* st;
};

__device__ __forceinline__ XcdBarrier xcd_barrier_post(unsigned* bar, volatile LAS unsigned* st) {
    XcdBarrier b; b.bar = bar; b.x = xb_xcc_id(); b.st = st;
    if (threadIdx.x == 0) (void)xb_add(&bar[XB_XCNT(b.x)], 1u);
    return b;
}
__device__ __forceinline__ void xcd_barrier_complete(unsigned* bar, unsigned x, unsigned& nloc, unsigned& nx) {
    const unsigned G = gridDim.x * gridDim.y * gridDim.z;
    unsigned sum, cnt, mine, sp = 0u;
    for (;;) {
        sum = 0u; cnt = 0u; mine = 0u;
#pragma unroll
        for (unsigned j = 0; j < 16; ++j) { const unsigned c = xb_ld(&bar[XB_XCNT(j)]); sum += c; cnt += (c > 0u) ? 1u : 0u; mine = (j == x) ? c : mine; }
        if (sum == G) break;
        __builtin_amdgcn_s_sleep(1);
        if ((++sp & 255u) == 0u) { if (xb_ld(&bar[XB_TMO])) break; if (sp > XB_SPIN_CAP) { atomicAdd(&bar[XB_TMO], 1u); break; } }
    }
    nloc = mine > 0u ? mine : 1u; nx = cnt > 0u ? cnt : 1u;
}

__device__ __forceinline__ void xcd_barrier(const XcdBarrier& b) {
    asm volatile("s_waitcnt vmcnt(0)" ::: "memory");
    __syncthreads();
    if (threadIdx.x == 0) {
        unsigned* bar = b.bar;
        __builtin_amdgcn_s_waitcnt(0);
        unsigned nloc = b.st[0], nx = b.st[1];
        if (nloc == 0u) { xcd_barrier_complete(bar, b.x, nloc, nx); b.st[0] = nloc; b.st[1] = nx; }
        const unsigned old = xb_add(&bar[XB_XSUB(b.x)], 1u);
        const unsigned gen = old / nloc;
        if (old + 1u == (gen + 1u) * nloc) {
            __builtin_amdgcn_fence(__ATOMIC_RELEASE, "agent");
            asm volatile("s_waitcnt vmcnt(0)" ::: "memory");
            const unsigned og = xb_add(&bar[XB_TOP], 1u);
            const unsigned tg = og / nx;
            if (og + 1u == (tg + 1u) * nx) xb_add(&bar[XB_TOPGEN], 1u);
            else XB_SPIN(xb_ld(&bar[XB_TOPGEN]) == tg, bar);
            __builtin_amdgcn_fence(__ATOMIC_ACQUIRE, "agent");
            xb_add(&bar[XB_XGEN(b.x)], 1u);
            asm volatile("s_waitcnt vmcnt(0)" ::: "memory");
        } else {
            XB_SPIN(xb_ld(&bar[XB_XGEN(b.x)]) == gen, bar);
            __builtin_amdgcn_fence(__ATOMIC_ACQUIRE, "agent");
            asm volatile("s_waitcnt vmcnt(0)" ::: "memory");
        }
    }
    __syncthreads();
}

struct EpiProj {
    bf16 *sbqk, *vt, *mlqk, *mlv, *mlo, *gates;
    __device__ __forceinline__ void operator()(int row, int col, const F8& a) const {
        bf16* dst;
        if (col < 1024) dst = sbqk + (size_t)row * 1024 + col;
        else if (col < 1536) {
            const int c = col - 1024, hh = c >> 6, d = c & 63, b = row >> 11, sq = row & 2047;
            bf16* vp = vt + ((size_t)(b * 8 + hh) * 64 + d) * 2048 + sq;
#pragma unroll
            for (int i = 0; i < 8; ++i) vp[(size_t)i * 2048] = (bf16)f2bf(a.v[i]);
            return;
        }
        else if (col < 2560) dst = mlqk + (size_t)row * 1024 + (col - 1536);
        else if (col < 3072) dst = mlv + (size_t)row * 512 + (col - 2560);
        else if (col < 3584) dst = mlo + (size_t)row * 512 + (col - 3072);
        else dst = gates + (size_t)row * 2048 + (col - 3584);
        *(v4u*)dst = pack8(a.v);
    }
};
struct EpiMergeA {
    bf16* merged; const bf16* gates;
    __device__ __forceinline__ void operator()(int row, int col, const F8& a) const {
        float g[8], o[8]; unpack8(*(const v4u*)(gates + (size_t)row * 2048 + col), g);
#pragma unroll
        for (int i = 0; i < 8; ++i) o[i] = sigmoidf_(g[i]) * a.v[i];
        *(v4u*)(merged + (size_t)row * 1024 + col) = pack8(o);
    }
};
struct EpiMergeB {
    bf16* merged; const bf16* gates;
    __device__ __forceinline__ void operator()(int row, int col, const F8& a) const {
        float g[8], o[8]; unpack8(*(const v4u*)(gates + (size_t)row * 2048 + 1024 + col), g);
        unpack8(*(const v4u*)(merged + (size_t)row * 1024 + col), o);
#pragma unroll
        for (int i = 0; i < 8; ++i) o[i] += sigmoidf_(g[i]) * a.v[i];
        *(v4u*)(merged + (size_t)row * 1024 + col) = pack8(o);
    }
};
struct EpiH {
    float* h; const float* x;
    __device__ __forceinline__ void operator()(int row, int col, const F8& a) const {
        const f32x4 x0 = *(const f32x4*)(x + (size_t)row * 1024 + col), x1 = *(const f32x4*)(x + (size_t)row * 1024 + col + 4);
        *(f32x4*)(h + (size_t)row * 1024 + col) = (f32x4){x0.x + a.v[0], x0.y + a.v[1], x0.z + a.v[2], x0.w + a.v[3]};
        *(f32x4*)(h + (size_t)row * 1024 + col + 4) = (f32x4){x1.x + a.v[4], x1.y + a.v[5], x1.z + a.v[6], x1.w + a.v[7]};
    }
};
struct EpiF32 {
    float* o; int ldc;
    __device__ __forceinline__ void operator()(int row, int col, const F8& a) const {
        *(f32x4*)(o + (size_t)row * ldc + col) = (f32x4){a.v[0], a.v[1], a.v[2], a.v[3]};
        *(f32x4*)(o + (size_t)row * ldc + col + 4) = (f32x4){a.v[4], a.v[5], a.v[6], a.v[7]};
    }
};

template <class E> struct EpiAdapt {
    static constexpr bool PERM = true, AFTER_DRAIN = false;
    E e;
    __device__ __forceinline__ void operator()(const pg8::f32x4 (&acc)[2][2][4][2], const pg8::Unit& u, int wr, int wc, int fr, int fq) const {
#pragma unroll
        for (int ai = 0; ai < 2; ++ai)
#pragma unroll
            for (int m = 0; m < 4; ++m) {
                const int row = u.pm * 256 + ai * 128 + wr * 64 + m * 16 + fr;
#pragma unroll
                for (int bj = 0; bj < 2; ++bj) {
                    const int col = u.pn * 256 + bj * 128 + wc * 32 + 8 * fq;
                    F8 a; const pg8::f32x4 v0 = acc[ai][bj][m][0], v1 = acc[ai][bj][m][1];
                    a.v[0] = v0[0]; a.v[1] = v0[1]; a.v[2] = v0[2]; a.v[3] = v0[3]; a.v[4] = v1[0]; a.v[5] = v1[1]; a.v[6] = v1[2]; a.v[7] = v1[3];
                    e(row, col, a);
                }
            }
    }
};

template <class E>
__device__ __forceinline__ void simple_gemm(LAS unsigned char* lds, const bf16* A, const bf16* Bt, int M, int N, int K, const E& e) {
    LAS float* As = (LAS float*)lds;
    LAS float* Bs = As + 32 * 132;
    const int tid = threadIdx.x, ty = tid >> 4, tx = tid & 15;
    const int ntn = N / 128, ntiles = (M / 128) * ntn;
    for (int tile = blockIdx.x; tile < ntiles; tile += gridDim.x) {
        const int tm = tile / ntn, tn = tile % ntn;
        float acc[4][8];
#pragma unroll
        for (int i = 0; i < 4; ++i)
#pragma unroll
            for (int j = 0; j < 8; ++j) acc[i][j] = 0.f;
        for (int k0 = 0; k0 < K; k0 += 32) {
            {
                const int r = tid >> 2, kq = (tid & 3) * 8;
                float fa[8], fb[8];
                unpack8(*(const v4u*)(A + (size_t)(tm * 128 + r) * K + k0 + kq), fa);
                unpack8(*(const v4u*)(Bt + (size_t)(tn * 128 + r) * K + k0 + kq), fb);
#pragma unroll
                for (int i = 0; i < 8; ++i) { As[(kq + i) * 132 + r] = fa[i]; Bs[(kq + i) * 132 + r] = fb[i]; }
            }
            __syncthreads();
#pragma unroll 8
            for (int k = 0; k < 32; ++k) {
                const f32x4 a4 = *(const LAS f32x4*)(As + k * 132 + ty * 4);
                const f32x4 b0 = *(const LAS f32x4*)(Bs + k * 132 + tx * 8), b1 = *(const LAS f32x4*)(Bs + k * 132 + tx * 8 + 4);
                const float av[4] = {a4.x, a4.y, a4.z, a4.w};
                const float bv[8] = {b0.x, b0.y, b0.z, b0.w, b1.x, b1.y, b1.z, b1.w};
#pragma unroll
                for (int i = 0; i < 4; ++i)
#pragma unroll
                    for (int j = 0; j < 8; ++j) acc[i][j] += av[i] * bv[j];
            }
            __syncthreads();
        }
#pragma unroll
        for (int i = 0; i < 4; ++i) {
            F8 a;
#pragma unroll
            for (int j = 0; j < 8; ++j) a.v[j] = acc[i][j];
            e(tm * 128 + ty * 4 + i, tn * 128 + tx * 8, a);
        }
    }
}

template <class E>
__device__ __forceinline__ void gemm(LAS unsigned char* lds, const bf16* A, const bf16* Bt, int M, int N, int K, const E& e) {
#if USE_PG8
    pg8::Gemm g{A, Bt, M, N, K}; pg8::StaticOrder S; S.init(M, N, (int)gridDim.x, (int)blockIdx.x);
    EpiAdapt<E> ea{e};
    pg8::gemm_phase<EpiAdapt<E>, pg8::StaticOrder, true, true>(lds, g, S, ea);
#else
    simple_gemm<E>(lds, A, Bt, M, N, K, e);
#endif
}

__device__ __forceinline__ void transpose_item(const float* W, int ldw, int K, bf16* WT, int src_col0, int dst_row0, LAS float* scr, int kb, int lane) {
    const int k0 = 64 * kb;
#pragma unroll 8
    for (int i = 0; i < 32; ++i) { const int kk = 2 * i + (lane >> 5); scr[kk * 33 + (lane & 31)] = W[(size_t)(k0 + kk) * ldw + src_col0 + (lane & 31)]; }
    LDS_WAIT(); asm volatile("" ::: "memory");
    const int c = lane & 7;
#pragma unroll
    for (int j = 0; j < 4; ++j) { const int n = (lane >> 3) + 8 * j; const LAS float* s = scr + (8 * c) * 33 + n;
        v4u o; o.x = pk2(s[0 * 33], s[1 * 33]); o.y = pk2(s[2 * 33], s[3 * 33]); o.z = pk2(s[4 * 33], s[5 * 33]); o.w = pk2(s[6 * 33], s[7 * 33]);
        *(v4u*)(WT + (size_t)(dst_row0 + n) * K + k0 + 8 * c) = o; }
    LDS_WAIT(); asm volatile("" ::: "memory");
}

struct P {
    const float *x, *norm_mix_w, *w_in, *conv_w, *conv_b, *b_i, *b_f, *ml_norm_w, *w_sb, *w_ml, *w_out, *norm_ffn_w, *w_query, *keys1, *keys2, *peer_u, *peer_v, *norm_final_w;
    float* out; unsigned char* ws;
};

__device__ __forceinline__ void p0_prologue(const P& p, LAS unsigned char* lds, int wave, int lane) {
    LAS float* scr = (LAS float*)(lds + wave * 8448);
    const int gw = blockIdx.x * NWAVES + wave, NGW = gridDim.x * NWAVES;
    bf16* W1T = (bf16*)(p.ws + WS_W1T); bf16* WSBT = (bf16*)(p.ws + WS_WSBT); bf16* WMLT = (bf16*)(p.ws + WS_WMLT); bf16* WOUTT = (bf16*)(p.ws + WS_WOUTT); bf16* WCT = (bf16*)(p.ws + WS_WCT);
    constexpr int I_1 = 16 * 176, I_SB = 8 * 32, I_ML = 8 * 32, I_O = 16 * 32, NT = I_1 + I_SB + I_ML + I_O;
    for (int it = gw; it < NT; it += NGW) {
        int r = it;
        if (r < I_1) { const int kb = r / 176, nb = r % 176, n0 = nb * 32; transpose_item(p.w_in, INC, 1024, W1T, n0 < 3584 ? n0 : n0 + 8, n0, scr, kb, lane); continue; } r -= I_1;
        if (r < I_SB) { const int kb = r / 32, nb = r % 32; transpose_item(p.w_sb, 1024, 512, WSBT, nb * 32, nb * 32, scr, kb, lane); continue; } r -= I_SB;
        if (r < I_ML) { const int kb = r / 32, nb = r % 32; transpose_item(p.w_ml, 1024, 512, WMLT, nb * 32, nb * 32, scr, kb, lane); continue; } r -= I_ML;
        { const int kb = r / 32, nb = r % 32; transpose_item(p.w_out, 1024, 1024, WOUTT, nb * 32, nb * 32, scr, kb, lane); }
    }
    for (int it = gw; it < 16 * 16 * 4; it += NGW) {
        const int hhf = it >> 6, kb = (it >> 2) & 15, kq = it & 3, head = hhf >> 1, half = hhf & 1, k = kb * 64 + lane;
        const f32x4* wq = (const f32x4*)(p.w_query + (size_t)k * 2048 + head * 256 + half * 128);
        f32x4 wr[32];
#pragma unroll
        for (int i = 0; i < 32; ++i) wr[i] = wq[i];
        const float* kbase = (half ? p.keys2 : p.keys1) + ((size_t)head * 128 + kq * 32) * 128;
#pragma unroll 1
        for (int key = 0; key < 32; ++key) {
            const f32x4* kr = (const f32x4*)(kbase + (size_t)key * 128);
            float a0 = 0.f, a1 = 0.f;
#pragma unroll
            for (int i = 0; i < 32; i += 2) { const f32x4 b0 = kr[i], b1 = kr[i + 1];
                a0 += wr[i].x * b0.x + wr[i].y * b0.y + wr[i].z * b0.z + wr[i].w * b0.w;
                a1 += wr[i + 1].x * b1.x + wr[i + 1].y * b1.y + wr[i + 1].z * b1.z + wr[i + 1].w * b1.w; }
            WCT[(size_t)(hhf * 128 + kq * 32 + key) * 1024 + k] = (bf16)f2bf(a0 + a1);
        }
    }
    bf16* XN = (bf16*)(p.ws + WS_XN); float* IFG = (float*)(p.ws + WS_IFG);
    LAS float* WG = (LAS float*)(lds + 8 * 8448);
    __syncthreads();
    for (int i = threadIdx.x; i < 2048; i += NTHR) { const int k = i >> 1, hf = i & 1; *(LAS f32x4*)(WG + k * 8 + hf * 4) = *(const f32x4*)(p.w_in + (size_t)k * INC + 3584 + hf * 4); }
    __syncthreads();
    for (int m = gw; m < T_; m += NGW) {
        const f32x4* xr = (const f32x4*)(p.x + (size_t)m * 1024) + lane;
        const f32x4* wr = (const f32x4*)p.norm_mix_w + lane;
        f32x4 v[4]; float ss = 0.f;
#pragma unroll
        for (int j = 0; j < 4; ++j) { v[j] = xr[64 * j]; ss += (v[j].x * v[j].x + v[j].y * v[j].y) + (v[j].z * v[j].z + v[j].w * v[j].w); }
        const float rstd = 1.f / sqrtf(wave_sum(ss) * (1.f / 1024.f) + EPS);
        float g[8];
#pragma unroll
        for (int i = 0; i < 8; ++i) g[i] = 0.f;
        v2u* o8 = (v2u*)(XN + (size_t)m * 1024) + lane;
#pragma unroll
        for (int j = 0; j < 4; ++j) {
            const f32x4 w = wr[64 * j];
            const float y[4] = {v[j].x * rstd * w.x, v[j].y * rstd * w.y, v[j].z * rstd * w.z, v[j].w * rstd * w.w};
            o8[64 * j] = (v2u){pk2(y[0], y[1]), pk2(y[2], y[3])};
#pragma unroll
            for (int q = 0; q < 4; ++q) {
                const int k = 256 * j + 4 * lane + q;
                const f32x4 w0 = *(const LAS f32x4*)(WG + k * 8), w1 = *(const LAS f32x4*)(WG + k * 8 + 4);
                g[0] += y[q] * w0.x; g[1] += y[q] * w0.y; g[2] += y[q] * w0.z; g[3] += y[q] * w0.w;
                g[4] += y[q] * w1.x; g[5] += y[q] * w1.y; g[6] += y[q] * w1.z; g[7] += y[q] * w1.w;
            }
        }
#pragma unroll
        for (int i = 0; i < 8; ++i) g[i] = wave_sum(g[i]);
        if (lane == 0) {
#pragma unroll
            for (int i = 0; i < 4; ++i) { IFG[(size_t)m * 8 + i] = g[i] + p.b_i[i]; IFG[(size_t)m * 8 + 4 + i] = g[4 + i] + p.b_f[i]; }
        }
    }
    {
        unsigned char* U8 = p.ws + WS_U8; unsigned char* V8 = p.ws + WS_V8; float* USC = (float*)(p.ws + WS_USC); float* VSC = (float*)(p.ws + WS_VSC);
        for (int e = gw; e < NEXP; e += NGW) {
            f32x4 v[2][4]; float am[2] = {0.f, 0.f};
#pragma unroll
            for (int which = 0; which < 2; ++which) {
                const float* src = (which ? p.peer_v : p.peer_u) + (size_t)e * 1024 + 16 * lane;
#pragma unroll
                for (int j = 0; j < 4; ++j) v[which][j] = *(const f32x4*)(src + 4 * j);
            }
#pragma unroll
            for (int which = 0; which < 2; ++which)
#pragma unroll
                for (int j = 0; j < 4; ++j) am[which] = fmaxf(am[which], fmaxf(fmaxf(fabsf(v[which][j].x), fabsf(v[which][j].y)), fmaxf(fabsf(v[which][j].z), fabsf(v[which][j].w))));
#pragma unroll
            for (int o = 1; o < 64; o <<= 1) { am[0] = fmaxf(am[0], __shfl_xor(am[0], o)); am[1] = fmaxf(am[1], __shfl_xor(am[1], o)); }
#pragma unroll
            for (int which = 0; which < 2; ++which) {
                const float sc = am[which] > 0.f ? exp2f(floorf(log2f(448.f / am[which]))) : 1.f;
                unsigned w[4];
#pragma unroll
                for (int j = 0; j < 4; ++j) { int t = __builtin_amdgcn_cvt_pk_fp8_f32(v[which][j].x * sc, v[which][j].y * sc, 0, false); t = __builtin_amdgcn_cvt_pk_fp8_f32(v[which][j].z * sc, v[which][j].w * sc, t, true); w[j] = (unsigned)t; }
                *(v4u*)((which ? V8 : U8) + ((size_t)(lane >> 3) * NEXP + e) * 128 + 16 * (lane & 7)) = (v4u){w[0], w[1], w[2], w[3]};
                if (lane == 0) (which ? VSC : USC)[e] = 1.f / sc;
            }
        }
    }
}

typedef short bf16x8 __attribute__((ext_vector_type(8)));
typedef float f32x16 __attribute__((ext_vector_type(16)));
typedef float f32x2_t __attribute__((ext_vector_type(2))); typedef __bf16 bf16x2_t __attribute__((ext_vector_type(2)));
__device__ __forceinline__ unsigned cvtpk(float lo, float hi) { f32x2_t v = {lo, hi}; bf16x2_t b = __builtin_convertvector(v, bf16x2_t); return __builtin_bit_cast(unsigned, b); }
#define MFMA32(a, b, c) __builtin_amdgcn_mfma_f32_32x32x16_bf16((a), (b), (c), 0, 0, 0)
__device__ __forceinline__ int crow(int reg, int hh) { return (reg & 3) + 8 * (reg >> 2) + 4 * hh; }
template <int S> __device__ __forceinline__ bf16x8 pack_step(const f32x16& x) {
    v4u p; p.x = cvtpk(x[8 * S], x[8 * S + 1]); p.y = cvtpk(x[8 * S + 2], x[8 * S + 3]); p.z = cvtpk(x[8 * S + 4], x[8 * S + 5]); p.w = cvtpk(x[8 * S + 6], x[8 * S + 7]);
    return __builtin_bit_cast(bf16x8, p);
}
__device__ __forceinline__ bf16x8 frag2(const v2u& lo, const v2u& hi) { v4u p; p.x = lo.x; p.y = lo.y; p.z = hi.x; p.w = hi.y; return __builtin_bit_cast(bf16x8, p); }
__device__ __forceinline__ f32x16 zero16() { f32x16 z; for (int i = 0; i < 16; ++i) z[i] = 0.f; return z; }


__device__ __forceinline__ void p2_conv(const P& p, int tid) {
    const bf16* MLQK = (const bf16*)(p.ws + WS_MLQK); bf16* QC = (bf16*)(p.ws + WS_QC); bf16* KC = (bf16*)(p.ws + WS_KC);
    const int cg = tid & 127, ch0 = 8 * cg;
    float cw[4][8], cb[8];
#pragma unroll
    for (int i = 0; i < 8; ++i) { cb[i] = p.conv_b[ch0 + i];
#pragma unroll
        for (int j = 0; j < 4; ++j) cw[j][i] = p.conv_w[j * 1024 + ch0 + i]; }
    const float osc = cg >= 64 ? 0.08838834764831845f : 1.f;
    bf16* dst = (cg >= 64 ? KC : QC) + (cg & 63) * 8;
    for (int rg = blockIdx.x * 4 + (tid >> 7); rg < T_ / 4; rg += gridDim.x * 4) {
        const int tok = rg * 4, pos0 = tok & (S_ - 1);
        v4u xr[7];
#pragma unroll
        for (int k = 0; k < 7; ++k) xr[k] = (pos0 + k - 3 >= 0) ? *(const v4u*)(MLQK + (size_t)(tok + k - 3) * 1024 + ch0) : (v4u){0u, 0u, 0u, 0u};
#pragma unroll
        for (int tt = 0; tt < 4; ++tt) {
            float y[8];
#pragma unroll
            for (int i = 0; i < 8; ++i) y[i] = cb[i];
#pragma unroll
            for (int j = 0; j < 4; ++j) { float f[8]; unpack8(xr[tt + j], f);
#pragma unroll
                for (int i = 0; i < 8; ++i) y[i] += cw[j][i] * f[i]; }
#pragma unroll
            for (int i = 0; i < 8; ++i) y[i] = y[i] * sigmoidf_(y[i]) * osc;
            *(v4u*)(dst + (size_t)(tok + tt) * 512) = pack8(y);
        }
    }
}

constexpr int ML_QS = 0, ML_KS = 17408, ML_KWT = 34816, ML_VTL = 53248, ML_PS = 71680, ML_CT = 80896, ML_SCAL = 115712, ML_SSP = 118272, ML_QN = ML_SSP + 512, ML_F1 = ML_QN + 256, ML_F2 = ML_F1 + 256, ML_NV = ML_F2 + 256;
static_assert(ML_NV + 512 <= RING_BYTES, "mLSTM LDS map");
__device__ __forceinline__ void mlstm_scal(float ip, float fp, LAS float* sc, float& m_carry, int lane) {
    const float lf = fminf(fp, 0.f) - log1pf(expf(-fabsf(fp)));
    float bc = lf;
#pragma unroll
    for (int o = 1; o < 64; o <<= 1) { const float t2 = __shfl_up(bc, o); if (lane >= o) bc += t2; }
    const float a = ip - bc; float pm = a;
#pragma unroll
    for (int o = 1; o < 64; o <<= 1) { const float t2 = __shfl_up(pm, o); if (lane >= o) pm = fmaxf(pm, t2); }
    const float M = fmaxf(m_carry, pm);
    const float M63 = __shfl(M, 63), bc63 = __shfl(bc, 63);
    sc[lane] = a; sc[64 + lane] = M; sc[128 + lane] = expf(a - M63); sc[192 + lane] = expf(m_carry - M); sc[256 + lane] = expf(-(bc + M));
    m_carry = bc63 + M63;
}
__device__ __forceinline__ void mlstm_item(const P& p, LAS unsigned char* lds, int item, int tid, int wave, int lane) {
    const int b = item >> 2, h = item & 3;
    const int r = lane & 31, hh = lane >> 5, et = wave & 3, th = wave >> 2;
    const bf16* QC = (const bf16*)(p.ws + WS_QC); const bf16* KC = (const bf16*)(p.ws + WS_KC); const bf16* MLV = (const bf16*)(p.ws + WS_MLV); const float* IFG = (const float*)(p.ws + WS_IFG);
    bf16* HML = (bf16*)p.out + (size_t)T_ * 512;
    LAS float* SCAL = (LAS float*)(lds + ML_SCAL); LAS float* SSP = (LAS float*)(lds + ML_SSP); LAS float* QN = (LAS float*)(lds + ML_QN);
    LAS float* F1 = (LAS float*)(lds + ML_F1); LAS float* F2 = (LAS float*)(lds + ML_F2); LAS float* NV = (LAS float*)(lds + ML_NV);
    const int cg = tid & 15, trow = tid >> 4, eg = cg, sl = trow;
    const size_t hq = (size_t)h * 128 + 8 * cg;
    for (int i = tid; i < (128 * 136 * 2) / 4; i += NTHR) ((LAS unsigned*)(lds + ML_CT))[i] = 0u;
    if (tid < 128) NV[tid] = 0.f;
    f32x16 accC[2]; accC[0] = zero16(); accC[1] = zero16();
    float m_carry = 0.f;
    if (wave == 3) { const size_t tk = (size_t)b * S_ + lane; mlstm_scal(IFG[tk * 8 + h], IFG[tk * 8 + 4 + h], SCAL, m_carry, lane); }
    v4u pq[2], pk[2], pv[2];
    {
        const size_t t0 = (size_t)b * S_;
#pragma unroll
        for (int u = 0; u < 2; ++u) { pq[u] = *(const v4u*)(QC + (t0 + trow + 32 * u) * 512 + hq); pk[u] = *(const v4u*)(KC + (t0 + trow + 32 * u) * 512 + hq); pv[u] = *(const v4u*)(MLV + (t0 + sl + 32 * u) * 512 + hq); }
    }
    float ipn = 0.f, fpn = 0.f;
    __syncthreads();
    for (int c = 0; c < 32; ++c) {
        const size_t tok0 = (size_t)b * S_ + c * 64;
        LAS float* sc = SCAL + (c & 1) * 320;
        {
#pragma unroll
            for (int u = 0; u < 2; ++u) {
                const int t = trow + 32 * u;
                *(LAS v4u*)(lds + ML_QS + t * 272 + cg * 16) = pq[u];
                *(LAS v4u*)(lds + ML_KS + t * 272 + cg * 16) = pk[u];
                float f[8]; unpack8(pk[u], f);
                const float wk = sc[128 + t];
#pragma unroll
                for (int i = 0; i < 8; ++i) *(LAS bf16*)(lds + ML_KWT + (8 * cg + i) * 144 + ((t ^ (8 * (cg & 7))) * 2)) = (bf16)f2bf(f[i] * wk);
                const unsigned vv[4] = {pv[u].x, pv[u].y, pv[u].z, pv[u].w};
#pragma unroll
                for (int i = 0; i < 4; ++i) {
                    *(LAS bf16*)(lds + ML_VTL + (8 * eg + 2 * i) * 144 + ((t ^ (8 * (eg & 7))) * 2)) = (bf16)(vv[i] & 0xffffu);
                    *(LAS bf16*)(lds + ML_VTL + (8 * eg + 2 * i + 1) * 144 + ((t ^ (8 * (eg & 7))) * 2)) = (bf16)(vv[i] >> 16);
                }
            }
            if (c + 1 < 32) {
                const size_t t1 = tok0 + 64;
#pragma unroll
                for (int u = 0; u < 2; ++u) { pq[u] = *(const v4u*)(QC + (t1 + trow + 32 * u) * 512 + hq); pk[u] = *(const v4u*)(KC + (t1 + trow + 32 * u) * 512 + hq); pv[u] = *(const v4u*)(MLV + (t1 + sl + 32 * u) * 512 + hq); }
                if (wave == 3) { ipn = IFG[(t1 + lane) * 8 + h]; fpn = IFG[(t1 + lane) * 8 + 4 + h]; }
            }
        }
        __syncthreads();
        f32x16 acc_inter = zero16();
        if (wave < 3) {
            const int tt = wave > 0 ? 1 : 0, st = wave == 2 ? 1 : 0;
            f32x16 zt = zero16();
#pragma unroll
            for (int ks = 0; ks < 8; ++ks) {
                const bf16x8 ka = *(const LAS bf16x8*)(lds + ML_KS + (32 * st + r) * 272 + 32 * ks + 16 * hh);
                const bf16x8 qb = *(const LAS bf16x8*)(lds + ML_QS + (32 * tt + r) * 272 + 32 * ks + 16 * hh);
                zt = MFMA32(ka, qb, zt);
            }
            const int t = 32 * tt + r; const float Mt = sc[64 + t];
            float ps = 0.f;
#pragma unroll
            for (int g = 0; g < 4; ++g) {
                const f32x4 av = *(const LAS f32x4*)(sc + 32 * st + 8 * g + 4 * hh);
                float pv[4];
#pragma unroll
                for (int q = 0; q < 4; ++q) { const int sidx = 32 * st + 8 * g + 4 * hh + q;
                    const float wgt = sidx <= t ? expf(av[q] - Mt) : 0.f; pv[q] = zt[4 * g + q] * wgt; ps += pv[q]; }
                *(LAS v2u*)(lds + ML_PS + t * 144 + (32 * st + 8 * g + 4 * hh) * 2) = (v2u){cvtpk(pv[0], pv[1]), cvtpk(pv[2], pv[3])};
            }
            ps += __shfl_xor(ps, 32);
            if (hh == 0) { SSP[st * 64 + t] = ps; if (wave == 0) SSP[64 + t] = 0.f; }
        }
        if (wave == 3 && c + 1 < 32) mlstm_scal(ipn, fpn, SCAL + ((c + 1) & 1) * 320, m_carry, lane);
#pragma unroll
        for (int ks = 0; ks < 8; ++ks) {
            const bf16x8 qa = *(const LAS bf16x8*)(lds + ML_QS + (32 * th + r) * 272 + 32 * ks + 16 * hh);
            const bf16x8 cbf = *(const LAS bf16x8*)(lds + ML_CT + (32 * et + r) * 272 + 32 * ks + 16 * hh);
            acc_inter = MFMA32(qa, cbf, acc_inter);
        }
        {
            const int t = tid >> 3, part = tid & 7;
            float f[8], sum = 0.f;
            { const v4u tq = *(const LAS v4u*)(lds + ML_QS + t * 272 + part * 32); unpack8(tq, f); }
#pragma unroll
            for (int i = 0; i < 8; ++i) sum += f[i] * NV[16 * part + i];
            { const v4u tq = *(const LAS v4u*)(lds + ML_QS + t * 272 + part * 32 + 16); unpack8(tq, f); }
#pragma unroll
            for (int i = 0; i < 8; ++i) sum += f[i] * NV[16 * part + 8 + i];
            sum += __shfl_xor(sum, 1); sum += __shfl_xor(sum, 2); sum += __shfl_xor(sum, 4);
            if (part == 0) QN[t] = sum;
        }
        __syncthreads();
        f32x16 acc_intra = zero16();
#pragma unroll
        for (int ks = 0; ks < 4; ++ks) {
            if (ks < 2 || th == 1) {
                const bf16x8 pa = *(const LAS bf16x8*)(lds + ML_PS + (32 * th + r) * 144 + 32 * ks + 16 * hh);
                const bf16x8 vb = *(const LAS bf16x8*)(lds + ML_VTL + (32 * et + r) * 144 + 16 * ((2 * ks + hh) ^ (((32 * et + r) >> 3) & 7)));
                acc_intra = MFMA32(pa, vb, acc_intra);
            }
        }
        if (tid < 64) {
            const float wi = sc[192 + tid];
            const float den = SSP[tid] + SSP[64 + tid] + wi * QN[tid];
            const float f1 = 1.f / fmaxf(fabsf(den), sc[256 + tid]);
            F1[tid] = f1; F2[tid] = wi * f1;
        }
        const float decay = sc[192 + 63];
#pragma unroll
        for (int dt = 0; dt < 2; ++dt) {
#pragma unroll
            for (int i = 0; i < 16; ++i) accC[dt][i] *= decay;
#pragma unroll
            for (int ks = 0; ks < 4; ++ks) {
                const bf16x8 ka = *(const LAS bf16x8*)(lds + ML_KWT + (64 * th + 32 * dt + r) * 144 + 16 * ((2 * ks + hh) ^ (((64 * th + 32 * dt + r) >> 3) & 7)));
                const bf16x8 vb = *(const LAS bf16x8*)(lds + ML_VTL + (32 * et + r) * 144 + 16 * ((2 * ks + hh) ^ (((32 * et + r) >> 3) & 7)));
                accC[dt] = MFMA32(ka, vb, accC[dt]);
            }
        }
        {
            const int d = tid >> 2, part = tid & 3;
            float f[8], sum = 0.f;
            { const v4u tq = *(const LAS v4u*)(lds + ML_KWT + d * 144 + part * 32); unpack8(tq, f); }
#pragma unroll
            for (int i = 0; i < 8; ++i) sum += f[i];
            { const v4u tq = *(const LAS v4u*)(lds + ML_KWT + d * 144 + part * 32 + 16); unpack8(tq, f); }
#pragma unroll
            for (int i = 0; i < 8; ++i) sum += f[i];
            sum += __shfl_xor(sum, 1); sum += __shfl_xor(sum, 2);
            if (part == 0) NV[d] = decay * NV[d] + sum;
        }
        __syncthreads();
        {
            bf16* hp = HML + (tok0 + 32 * th) * 512 + h * 128 + 32 * et + r;
#pragma unroll
            for (int g = 0; g < 4; ++g) {
                const f32x4 f1v = *(const LAS f32x4*)(F1 + 32 * th + 8 * g + 4 * hh), f2v = *(const LAS f32x4*)(F2 + 32 * th + 8 * g + 4 * hh);
#pragma unroll
                for (int q = 0; q < 4; ++q) { const int tl = 8 * g + 4 * hh + q;
                    hp[(size_t)tl * 512] = (bf16)f2bf(acc_intra[4 * g + q] * f1v[q] + acc_inter[4 * g + q] * f2v[q]); }
            }
#pragma unroll
            for (int dt = 0; dt < 2; ++dt)
#pragma unroll
                for (int g = 0; g < 4; ++g)
                    *(LAS v2u*)(lds + ML_CT + (32 * et + r) * 272 + (64 * th + 32 * dt + 8 * g + 4 * hh) * 2) = (v2u){cvtpk(accC[dt][4 * g], accC[dt][4 * g + 1]), cvtpk(accC[dt][4 * g + 2], accC[dt][4 * g + 3])};
        }
    }
    __syncthreads();
}

__device__ __forceinline__ void sba_wave_item(const bf16* __restrict__ QK, const bf16* __restrict__ VT, bf16* __restrict__ YSB, int b, int h, int qt, int lane) {
    const int r = lane & 31, hh = lane >> 5, t0 = qt * 32;
    const size_t rowbase = (size_t)b * S_;
    bf16x8 qf[4];
    {
        const bf16* qp = QK + (rowbase + t0 + r) * 1024 + h * 64 + 8 * hh;
#pragma unroll
        for (int ks = 0; ks < 4; ++ks) qf[ks] = *(const bf16x8*)(qp + 16 * ks);
    }
    bf16x8 tri[2];
#pragma unroll
    for (int s2 = 0; s2 < 2; ++s2)
#pragma unroll
        for (int j = 0; j < 8; ++j) { const int rho = 16 * s2 + 8 * (j >> 2) + 4 * hh + (j & 3); tri[s2][j] = (rho > r) ? (short)0x3F80 : (short)0; }
    f32x16 o0 = zero16(), o1 = zero16();
    float carry = 0.f;
    const bf16* kbase = QK + rowbase * 1024 + 512 + h * 64 + 8 * hh + (size_t)r * 1024;
    const bf16* vbase = VT + ((size_t)(b * 8 + h) * 64 + r) * 2048 + 4 * hh;
    bf16x8 kf[4]; v2u vl[2][2], vh[2][2];
#pragma unroll
    for (int ks = 0; ks < 4; ++ks) kf[ks] = *(const bf16x8*)(kbase + (size_t)t0 * 1024 + 16 * ks);
#pragma unroll
    for (int dt = 0; dt < 2; ++dt)
#pragma unroll
        for (int s2 = 0; s2 < 2; ++s2) { const bf16* vp = vbase + (size_t)dt * 32 * 2048 + t0 + 16 * s2; vl[dt][s2] = *(const v2u*)vp; vh[dt][s2] = *(const v2u*)(vp + 8); }
    for (int s0 = t0; s0 >= 0; s0 -= 32) {
        bf16x8 kn[4]; v2u vln[2][2], vhn[2][2];
        const int sn = s0 >= 32 ? s0 - 32 : 0;
#pragma unroll
        for (int ks = 0; ks < 4; ++ks) kn[ks] = *(const bf16x8*)(kbase + (size_t)sn * 1024 + 16 * ks);
#pragma unroll
        for (int dt = 0; dt < 2; ++dt)
#pragma unroll
            for (int s2 = 0; s2 < 2; ++s2) { const bf16* vp = vbase + (size_t)dt * 32 * 2048 + sn + 16 * s2; vln[dt][s2] = *(const v2u*)vp; vhn[dt][s2] = *(const v2u*)(vp + 8); }
        f32x16 z = zero16();
#pragma unroll
        for (int ks = 0; ks < 4; ++ks) z = MFMA32(kf[ks], qf[ks], z);
        const bool diag = (s0 == t0);
        f32x16 sp; float rs = 0.f;
#pragma unroll
        for (int i = 0; i < 16; ++i) {
            const float zz = z[i] * 0.125f;
            const bool valid = !diag || (crow(i, hh) < r);
            float spv = fmaxf(zz, 0.f) + __logf(1.f + __expf(-fabsf(zz)));
            spv = valid ? spv : 0.f;
            sp[i] = spv; rs += spv; z[i] = zz - spv;
        }
        f32x16 suf = zero16();
        suf = MFMA32(tri[0], pack_step<0>(sp), suf);
        suf = MFMA32(tri[1], pack_step<1>(sp), suf);
        f32x16 w;
#pragma unroll
        for (int i = 0; i < 16; ++i) {
            const bool valid = !diag || (crow(i, hh) < r);
            const float lw = z[i] - suf[i] - carry;
            w[i] = valid ? __expf(lw) : 0.f;
        }
        rs += __shfl_xor(rs, 32);
        carry += rs;
        const bf16x8 pa0 = pack_step<0>(w), pa1 = pack_step<1>(w);
        o0 = MFMA32(pa0, frag2(vl[0][0], vh[0][0]), o0); o0 = MFMA32(pa1, frag2(vl[0][1], vh[0][1]), o0);
        o1 = MFMA32(pa0, frag2(vl[1][0], vh[1][0]), o1); o1 = MFMA32(pa1, frag2(vl[1][1], vh[1][1]), o1);
        if (__all(carry > 104.f)) break;
#pragma unroll
        for (int ks = 0; ks < 4; ++ks) kf[ks] = kn[ks];
#pragma unroll
        for (int dt = 0; dt < 2; ++dt)
#pragma unroll
            for (int s2 = 0; s2 < 2; ++s2) { vl[dt][s2] = vln[dt][s2]; vh[dt][s2] = vhn[dt][s2]; }
    }
    bf16* op = YSB + (rowbase + t0) * 512 + h * 64 + r;
#pragma unroll
    for (int i = 0; i < 16; ++i) { const int t = crow(i, hh); op[(size_t)t * 512] = (bf16)f2bf(o0[i]); op[(size_t)t * 512 + 32] = (bf16)f2bf(o1[i]); }
}
__device__ __forceinline__ void sba_item(const P& p, int item, int wave, int lane) {
    const int bh = item >> 3, qb = item & 7, b = bh >> 3, h = bh & 7;
    sba_wave_item((const bf16*)(p.ws + WS_SBQKV), (const bf16*)(p.ws + WS_VT), (bf16*)p.out, b, h, qb * 8 + wave, lane);
}

__device__ __forceinline__ void p3_yml(const P& p, int wave, int lane) {
    const int gw = blockIdx.x * NWAVES + wave, NGW = gridDim.x * NWAVES;
    bf16* YML = (bf16*)p.out + (size_t)T_ * 512; const bf16* MLO = (const bf16*)(p.ws + WS_MLO);
    for (int m = gw; m < T_; m += NGW) {
        float hv[8], ov[8], o[8];
        unpack8(*(const v4u*)(YML + (size_t)m * 512 + lane * 8), hv); unpack8(*(const v4u*)(MLO + (size_t)m * 512 + lane * 8), ov);
        float ss = 0.f;
#pragma unroll
        for (int i = 0; i < 8; ++i) ss += hv[i] * hv[i];
        ss += __shfl_xor(ss, 1); ss += __shfl_xor(ss, 2); ss += __shfl_xor(ss, 4); ss += __shfl_xor(ss, 8);
        const float rstd = 1.f / sqrtf(ss * (1.f / 128.f) + EPS);
        const f32x4 w0 = *(const f32x4*)(p.ml_norm_w + lane * 8), w1 = *(const f32x4*)(p.ml_norm_w + lane * 8 + 4);
        const float wv[8] = {w0.x, w0.y, w0.z, w0.w, w1.x, w1.y, w1.z, w1.w};
#pragma unroll
        for (int i = 0; i < 8; ++i) o[i] = sigmoidf_(ov[i]) * hv[i] * rstd * wv[i];
        *(v4u*)(YML + (size_t)m * 512 + lane * 8) = pack8(o);
    }
}

__device__ __forceinline__ void p6_hn(const P& p, int wave, int lane) {
    const int gw = blockIdx.x * NWAVES + wave, NGW = gridDim.x * NWAVES;
    const float* H = (const float*)(p.ws + WS_H); bf16* HN = (bf16*)(p.ws + WS_HN);
    for (int m = gw; m < T_; m += NGW) {
        const f32x4* xr = (const f32x4*)(H + (size_t)m * 1024) + lane; const f32x4* wr = (const f32x4*)p.norm_ffn_w + lane;
        f32x4 v[4]; float ss = 0.f;
#pragma unroll
        for (int j = 0; j < 4; ++j) { v[j] = xr[64 * j]; ss += (v[j].x * v[j].x + v[j].y * v[j].y) + (v[j].z * v[j].z + v[j].w * v[j].w); }
        const float rstd = 1.f / sqrtf(wave_sum(ss) * (1.f / 1024.f) + EPS);
        v2u* o8 = (v2u*)(HN + (size_t)m * 1024) + lane;
#pragma unroll
        for (int j = 0; j < 4; ++j) { const f32x4 w = wr[64 * j]; o8[64 * j] = (v2u){pk2(v[j].x * rstd * w.x, v[j].y * rstd * w.y), pk2(v[j].z * rstd * w.z, v[j].w * rstd * w.w)}; }
    }
}

__device__ __forceinline__ unsigned ord_key(float f) { const unsigned u = __builtin_bit_cast(unsigned, f); return (u & 0x80000000u) ? ~u : (u | 0x80000000u); }
__device__ __forceinline__ float ord_val(unsigned k) { const unsigned u = (k & 0x80000000u) ? (k & 0x7fffffffu) : ~k; return __builtin_bit_cast(float, u); }
template <int CTRL> __device__ __forceinline__ unsigned dpp_u(unsigned v) { return (unsigned)__builtin_amdgcn_update_dpp(0, (int)v, CTRL, 0xF, 0xF, true); }
__device__ __forceinline__ unsigned umax_(unsigned a, unsigned b) { return a > b ? a : b; }
__device__ __forceinline__ unsigned umin_(unsigned a, unsigned b) { return a < b ? a : b; }
__device__ __forceinline__ unsigned row_max_u(unsigned v) {
    v = umax_(v, dpp_u<0xB1>(v)); v = umax_(v, dpp_u<0x4E>(v)); v = umax_(v, dpp_u<0x141>(v)); v = umax_(v, dpp_u<0x140>(v)); return v;
}
__device__ __forceinline__ float row_sum_f(float v) {
    v += __builtin_bit_cast(float, dpp_u<0xB1>(__builtin_bit_cast(unsigned, v))); v += __builtin_bit_cast(float, dpp_u<0x4E>(__builtin_bit_cast(unsigned, v)));
    v += __builtin_bit_cast(float, dpp_u<0x141>(__builtin_bit_cast(unsigned, v))); v += __builtin_bit_cast(float, dpp_u<0x140>(__builtin_bit_cast(unsigned, v))); return v;
}
#define CE_(i, j) do { const unsigned _a = k[i], _b = k[j]; k[i] = umax_(_a, _b); k[j] = umin_(_a, _b); } while (0)
__device__ __forceinline__ unsigned row_top16(unsigned (&k)[8], unsigned (&top)[16], int li) {
    CE_(0, 1); CE_(2, 3); CE_(4, 5); CE_(6, 7); CE_(0, 2); CE_(1, 3); CE_(4, 6); CE_(5, 7); CE_(1, 2); CE_(5, 6);
    CE_(0, 4); CE_(1, 5); CE_(2, 6); CE_(3, 7); CE_(2, 4); CE_(3, 5); CE_(1, 2); CE_(3, 4); CE_(5, 6);
    unsigned mine = 0u;
#pragma unroll
    for (int n = 0; n < 16; ++n) {
        const unsigned m = row_max_u(k[0]);
        const bool hit = k[0] == m;
#pragma unroll
        for (int i = 0; i < 7; ++i) k[i] = hit ? k[i + 1] : k[i];
        k[7] = hit ? 0u : k[7];
        top[n] = m; mine = (li == n) ? m : mine;
    }
    return mine;
}
__device__ __forceinline__ void p8_topk(const P& p, int hh, int wave, int lane) {
    const int gw = blockIdx.x * NWAVES + wave, NGW = gridDim.x * NWAVES;
    const float* SC = (const float*)(p.ws + WS_SC); int* IDX = (int*)(p.ws + WS_IDX); float* GATE = (float*)(p.ws + WS_GATE);
    const int q = lane >> 4, li = lane & 15, head = hh * 4 + q;
    for (int m = gw; m < T_; m += NGW) {
        const float* sr = SC + (size_t)m * 1024 + q * 256;
        unsigned k[8], top1[16], top2[16];
#pragma unroll
        for (int j = 0; j < 8; ++j) k[j] = (ord_key(sr[li + 16 * j]) & ~0x7fu) | (unsigned)(127 - (li + 16 * j));
        const unsigned mine1 = row_top16(k, top1, li);
#pragma unroll
        for (int j = 0; j < 8; ++j) k[j] = (ord_key(sr[128 + li + 16 * j]) & ~0x7fu) | (unsigned)(127 - (li + 16 * j));
        const unsigned mine2 = row_top16(k, top2, li);
        const float v2 = ord_val(mine2 & ~0x7fu);
        unsigned c[16];
#pragma unroll
        for (int j = 0; j < 16; ++j) {
            const float v1 = ord_val(top1[j] & ~0x7fu);
            const unsigned key = (ord_key(v1 + v2) & ~0xffu) | (unsigned)(255 - (16 * j + li));
            c[j] = ((j + 1) * (li + 1) <= 16) ? key : 0u;
        }
        unsigned tk = 0u, t0 = 0u;
#pragma unroll
        for (int n = 0; n < 16; ++n) {
            const unsigned mx = row_max_u(c[0]);
            const bool hit = c[0] == mx;
#pragma unroll
            for (int i = 0; i < 15; ++i) c[i] = hit ? c[i + 1] : c[i];
            c[15] = hit ? 0u : c[15];
            if (n == 0) t0 = mx;
            tk = (li == n) ? mx : tk;
        }
        const float sv = ord_val(tk & ~0xffu), s0 = ord_val(t0 & ~0xffu);
        const int cc = 255 - (int)(tk & 0xffu), a = (cc >> 4) & 15, bb = cc & 15;
        const int i1 = 127 - (int)((unsigned)__shfl((int)mine1, (lane & 48) + a) & 0x7fu), i2 = 127 - (int)((unsigned)__shfl((int)mine2, (lane & 48) + bb) & 0x7fu);
        const float pe = expf(sv - s0);
        const float den = row_sum_f(pe);
        IDX[(size_t)m * 128 + head * 16 + li] = i1 * 128 + i2; GATE[(size_t)m * 128 + head * 16 + li] = pe / den;
    }
}

__device__ __forceinline__ float gelu_erf(float x) { return 0.5f * x * (1.f + erff(x * 0.70710678118654752f)); }
typedef float f32x2 __attribute__((ext_vector_type(2)));
__device__ __forceinline__ void cvt16_fp8(const v4u& w, f32x2 (&f)[8]) {
    f[0] = __builtin_amdgcn_cvt_pk_f32_fp8((int)w.x, false); f[1] = __builtin_amdgcn_cvt_pk_f32_fp8((int)w.x, true);
    f[2] = __builtin_amdgcn_cvt_pk_f32_fp8((int)w.y, false); f[3] = __builtin_amdgcn_cvt_pk_f32_fp8((int)w.y, true);
    f[4] = __builtin_amdgcn_cvt_pk_f32_fp8((int)w.z, false); f[5] = __builtin_amdgcn_cvt_pk_f32_fp8((int)w.z, true);
    f[6] = __builtin_amdgcn_cvt_pk_f32_fp8((int)w.w, false); f[7] = __builtin_amdgcn_cvt_pk_f32_fp8((int)w.w, true);
}
__device__ __forceinline__ float grp8_sum(float v) {
    v += __builtin_bit_cast(float, dpp_u<0xB1>(__builtin_bit_cast(unsigned, v)));
    v += __builtin_bit_cast(float, dpp_u<0x4E>(__builtin_bit_cast(unsigned, v)));
    v += __builtin_bit_cast(float, dpp_u<0x141>(__builtin_bit_cast(unsigned, v)));
    return v;
}
typedef int i32x4 __attribute__((ext_vector_type(4)));
template <int PAT> __device__ __forceinline__ float swz_f(float v) { return __builtin_bit_cast(float, __builtin_amdgcn_ds_swizzle(__builtin_bit_cast(int, v), PAT)); }
__device__ __forceinline__ void peer_u_token(const v4u (&ur)[16], const f32x2 (&xv)[8], float* dst, int c8) {
    float d[16];
#pragma unroll
    for (int i = 0; i < 16; ++i) {
        f32x2 f[8]; cvt16_fp8(ur[i], f);
        f32x2 s2 = f[0] * xv[0];
#pragma unroll
        for (int q = 1; q < 8; ++q) s2 += f[q] * xv[q];
        d[i] = s2.x + s2.y;
    }
    const bool b0 = (c8 & 1) != 0, b1 = (c8 & 2) != 0, b2 = (c8 & 4) != 0;
    float e8[8], e4[4], e2[2];
#pragma unroll
    for (int i = 0; i < 8; ++i) { const float keep = b0 ? d[2 * i + 1] : d[2 * i], send = b0 ? d[2 * i] : d[2 * i + 1];
        e8[i] = keep + __builtin_bit_cast(float, dpp_u<0xB1>(__builtin_bit_cast(unsigned, send))); }
#pragma unroll
    for (int i = 0; i < 4; ++i) { const float keep = b1 ? e8[2 * i + 1] : e8[2 * i], send = b1 ? e8[2 * i] : e8[2 * i + 1];
        e4[i] = keep + __builtin_bit_cast(float, dpp_u<0x4E>(__builtin_bit_cast(unsigned, send))); }
#pragma unroll
    for (int i = 0; i < 2; ++i) { const float keep = b2 ? e4[2 * i + 1] : e4[2 * i], send = b2 ? e4[2 * i] : e4[2 * i + 1];
        e2[i] = keep + swz_f<0x1F | (4 << 10)>(send); }
    dst[c8] = e2[0]; dst[c8 + 8] = e2[1];
}
__device__ __forceinline__ void peer_u(const P& p, int wave, int lane) {
    const int j = blockIdx.x & 7, nchunk = gridDim.x >> 3, chunk = blockIdx.x >> 3, stride = nchunk * 8;
    const int g = lane >> 3, c8 = lane & 7;
    const bf16* HN = (const bf16*)(p.ws + WS_HN) + 128 * j + 16 * c8; const int* IDX = (const int*)(p.ws + WS_IDX) + 16 * g;
    const unsigned char* US = p.ws + WS_U8 + (size_t)j * NEXP * 128 + 16 * c8;
    float* PART = (float*)(p.ws + WS_PART) + (size_t)j * T_ * 128 + 16 * g;
    int m = chunk * 8 + wave;
    i32x4 ei[4]; v4u h0, h1;
#pragma unroll
    for (int q = 0; q < 4; ++q) ei[q] = *(const i32x4*)(IDX + (size_t)m * 128 + 4 * q);
    h0 = *(const v4u*)(HN + (size_t)m * 1024); h1 = *(const v4u*)(HN + (size_t)m * 1024 + 8);
    for (; m < T_; m += stride) {
        v4u ur[16];
#pragma unroll
        for (int i = 0; i < 16; ++i) ur[i] = *(const v4u*)(US + (size_t)ei[i >> 2][i & 3] * 128);
        f32x2 xv[8]; float f[8];
        unpack8(h0, f);
#pragma unroll
        for (int i = 0; i < 4; ++i) xv[i] = (f32x2){f[2 * i], f[2 * i + 1]};
        unpack8(h1, f);
#pragma unroll
        for (int i = 0; i < 4; ++i) xv[4 + i] = (f32x2){f[2 * i], f[2 * i + 1]};
        {
            const int n = m + stride < T_ ? m + stride : m;
#pragma unroll
            for (int q = 0; q < 4; ++q) ei[q] = *(const i32x4*)(IDX + (size_t)n * 128 + 4 * q);
            h0 = *(const v4u*)(HN + (size_t)n * 1024); h1 = *(const v4u*)(HN + (size_t)n * 1024 + 8);
        }
        peer_u_token(ur, xv, PART + (size_t)m * 128, c8);
    }
}
__device__ __forceinline__ void peer_c(const P& p, int wave, int lane) {
    const int gw = blockIdx.x * NWAVES + wave, NGW = gridDim.x * NWAVES;
    const int* IDX = (const int*)(p.ws + WS_IDX); const float* GATE = (const float*)(p.ws + WS_GATE); const float* PART = (const float*)(p.ws + WS_PART);
    const float* USC = (const float*)(p.ws + WS_USC); const float* VSC = (const float*)(p.ws + WS_VSC); float* COEF = (float*)(p.ws + WS_COEF);
    for (int m = gw; m < T_; m += NGW) {
        float s0 = 0.f, s1 = 0.f;
#pragma unroll
        for (int jj = 0; jj < 8; ++jj) { s0 += PART[((size_t)jj * T_ + m) * 128 + lane]; s1 += PART[((size_t)jj * T_ + m) * 128 + 64 + lane]; }
        const int e0 = IDX[(size_t)m * 128 + lane], e1 = IDX[(size_t)m * 128 + 64 + lane];
        const float g0 = GATE[(size_t)m * 128 + lane], g1 = GATE[(size_t)m * 128 + 64 + lane];
        COEF[(size_t)m * 128 + lane] = g0 * gelu_erf(s0 * USC[e0]) * VSC[e0];
        COEF[(size_t)m * 128 + 64 + lane] = g1 * gelu_erf(s1 * USC[e1]) * VSC[e1];
    }
}
struct PvPre { i32x4 ei[4]; float c0, c1; };
__device__ __forceinline__ void pv_level1(PvPre& q, const int* IDXg, const float* COEFg, int m, int c8) {
#pragma unroll
    for (int k = 0; k < 4; ++k) q.ei[k] = *(const i32x4*)(IDXg + (size_t)m * 128 + 4 * k);
    q.c0 = COEFg[(size_t)m * 128 + c8]; q.c1 = COEFg[(size_t)m * 128 + c8 + 8];
}
__device__ __forceinline__ void peer_v_token(const v4u (&vr)[16], float coef0, float coef1, const float* H, float* out, float* ssq, bool b3, bool b4, bool b5, int lane) {
    f32x2 acc[8];
#pragma unroll
    for (int i = 0; i < 8; ++i) acc[i] = (f32x2){0.f, 0.f};
#define PV_STEP(I) do { const float cs_ = ((I) >> 3) ? coef1 : coef0; \
        const float cu_ = swz_f<0x18 | (((I) & 7) << 5)>(cs_);     \
        const f32x2 c2_ = (f32x2){cu_, cu_}; f32x2 f_[8]; cvt16_fp8(vr[I], f_); \
        _Pragma("unroll") for (int q = 0; q < 8; ++q) acc[q] += c2_ * f_[q]; } while (0)
    PV_STEP(0); PV_STEP(1); PV_STEP(2); PV_STEP(3); PV_STEP(4); PV_STEP(5); PV_STEP(6); PV_STEP(7);
    PV_STEP(8); PV_STEP(9); PV_STEP(10); PV_STEP(11); PV_STEP(12); PV_STEP(13); PV_STEP(14); PV_STEP(15);
#undef PV_STEP
    f32x2 a1[4], a2[2], a3;
#pragma unroll
    for (int i = 0; i < 4; ++i) { const f32x2 keep = b5 ? acc[2 * i + 1] : acc[2 * i], send = b5 ? acc[2 * i] : acc[2 * i + 1];
        a1[i] = keep + (f32x2){__shfl_xor(send.x, 32), __shfl_xor(send.y, 32)}; }
#pragma unroll
    for (int i = 0; i < 2; ++i) { const f32x2 keep = b4 ? a1[2 * i + 1] : a1[2 * i], send = b4 ? a1[2 * i] : a1[2 * i + 1];
        a2[i] = keep + (f32x2){swz_f<0x1F | (16 << 10)>(send.x), swz_f<0x1F | (16 << 10)>(send.y)}; }
    { const f32x2 keep = b3 ? a2[1] : a2[0], send = b3 ? a2[0] : a2[1]; a3 = keep + (f32x2){swz_f<0x1F | (8 << 10)>(send.x), swz_f<0x1F | (8 << 10)>(send.y)}; }
    const f32x2 hv = *(const f32x2*)H;
    const f32x2 y = hv + a3;
    *(f32x2*)out = y;
    const float ss = wave_sum(y.x * y.x + y.y * y.y);
    if (lane == 0) *ssq = ss;
}
__device__ __forceinline__ void peer_v(const P& p, int wave, int lane) {
    const int j = blockIdx.x & 7, nchunk = gridDim.x >> 3, chunk = blockIdx.x >> 3, stride = nchunk * 8;
    const int g = lane >> 3, c8 = lane & 7;
    const bool b5 = (lane & 32) != 0, b4 = (lane & 16) != 0, b3 = (lane & 8) != 0;
    const int pi = 4 * (b3 ? 1 : 0) + 2 * (b4 ? 1 : 0) + (b5 ? 1 : 0);
    const size_t colo = 128 * j + 16 * c8 + 2 * pi;
    const float* H = (const float*)(p.ws + WS_H) + colo; float* OUT = p.out + colo;
    const int* IDXg = (const int*)(p.ws + WS_IDX) + 16 * g; const float* COEFg = (const float*)(p.ws + WS_COEF) + 16 * g;
    const unsigned char* VS = p.ws + WS_V8 + (size_t)j * NEXP * 128 + 16 * c8;
    float* SSQ = (float*)(p.ws + WS_SSQ) + (size_t)j * T_;
    int m = chunk * 8 + wave;
    PvPre q;
    pv_level1(q, IDXg, COEFg, m, c8);
    for (; m < T_; m += stride) {
        v4u vr[16];
#pragma unroll
        for (int i = 0; i < 16; ++i) vr[i] = *(const v4u*)(VS + (size_t)q.ei[i >> 2][i & 3] * 128);
        const float c0 = q.c0, c1 = q.c1;
        pv_level1(q, IDXg, COEFg, m + stride < T_ ? m + stride : m, c8);
        peer_v_token(vr, c0, c1, H + (size_t)m * 1024, OUT + (size_t)m * 1024, SSQ + m, b3, b4, b5, lane);
    }
}
__device__ __forceinline__ void peer_f(const P& p, int wave, int lane) {
    const int gw = blockIdx.x * NWAVES + wave, NGW = gridDim.x * NWAVES;
    const float* SSQ = (const float*)(p.ws + WS_SSQ);
    for (int m = gw; m < T_; m += NGW) {
        float ss = 0.f;
#pragma unroll
        for (int jj = 0; jj < 8; ++jj) ss += SSQ[(size_t)jj * T_ + m];
        const float rstd = 1.f / sqrtf(ss * (1.f / 1024.f) + EPS);
        f32x4* o = (f32x4*)(p.out + (size_t)m * 1024) + lane; const f32x4* wr = (const f32x4*)p.norm_final_w + lane;
#pragma unroll
        for (int q = 0; q < 4; ++q) { const f32x4 v = o[64 * q], w = wr[64 * q]; o[64 * q] = (f32x4){v.x * rstd * w.x, v.y * rstd * w.y, v.z * rstd * w.z, v.w * rstd * w.w}; }
    }
}

constexpr int N_PHASES = 16;
struct Args { P p; int ph_lo, ph_hi; };
__global__ void __launch_bounds__(NTHR, 2) fwd_kernel(Args args) {
    extern __shared__ __attribute__((aligned(16))) unsigned char lds_raw[];
    LAS unsigned char* lds = (LAS unsigned char*)lds_raw;
    const P& p = args.p;
    const int tid = threadIdx.x, lane = tid & 63, wave = __builtin_amdgcn_readfirstlane(tid >> 6);
    volatile LAS unsigned* MISC = (volatile LAS unsigned*)(lds + MISC_OFF);
    for (int u = tid; u < (LDS_BYTES - LDSCTL_OFF) / 4; u += NTHR) ((LAS unsigned*)(lds + LDSCTL_OFF))[u] = 0u;
    __syncthreads();
    XcdBarrier bar; bar.bar = (unsigned*)(p.ws + WS_CTL) + CW_BAR; bar.x = 0; bar.st = nullptr;
#if !MK_PER_PHASE
    bar = xcd_barrier_post((unsigned*)(p.ws + WS_CTL) + CW_BAR, MISC + 8);
#endif
    const int lo = args.ph_lo, hi = args.ph_hi;
#define IN(k) (lo <= (k) && (k) < hi)
#ifndef PROBE_WAIT_LO
#define PROBE_WAIT_LO -1
#define PROBE_WAIT_HI -1
#endif
    volatile LAS unsigned long long* STAMP = (volatile LAS unsigned long long*)(lds + MISC_OFF + 256);
#define SEAM(k) do { if (IN(k) && IN((k) + 1)) xcd_barrier(bar); if (PROBE_WAIT_LO >= 0 && blockIdx.x == 0 && tid == 0) STAMP[(k) + 1] = __builtin_amdgcn_s_memrealtime(); } while (0)
    if (PROBE_WAIT_LO >= 0 && blockIdx.x == 0 && tid == 0) STAMP[0] = __builtin_amdgcn_s_memrealtime();

#ifndef PROBE_REP
#define PROBE_REP -1
#endif
#define REP(k) ((PROBE_REP == (k)) ? 2 : 1)
    if (IN(0)) {
#pragma unroll 1
        for (int r = 0; r < REP(0); ++r) p0_prologue(p, lds, wave, lane); } SEAM(0);
    if (IN(1)) {
#pragma unroll 1
      for (int r = 0; r < REP(1); ++r) {
        EpiProj e{(bf16*)(p.ws + WS_SBQKV), (bf16*)(p.ws + WS_VT), (bf16*)(p.ws + WS_MLQK), (bf16*)(p.ws + WS_MLV), (bf16*)(p.ws + WS_MLO), (bf16*)(p.ws + WS_GATES)};
        gemm<EpiProj>(lds, (const bf16*)(p.ws + WS_XN), (const bf16*)(p.ws + WS_W1T), T_, NPROJ, 1024, e); }
    } SEAM(1);
    if (IN(2)) { p2_conv(p, tid); } SEAM(2);
    if (IN(3)) {
        for (int it = blockIdx.x; it < 64; it += gridDim.x) mlstm_item(p, lds, it, tid, wave, lane);
        unsigned* qctr = (unsigned*)(p.ws + WS_CTL) + CW_Q;
        for (;;) {
            if (tid == 0) MISC[12] = __hip_atomic_fetch_add(qctr, 1u, __ATOMIC_RELAXED, __HIP_MEMORY_SCOPE_AGENT);
            __syncthreads();
            const unsigned it = MISC[12];
            __syncthreads();
            if (it >= 1024u) break;
            sba_item(p, (int)it, wave, lane);
        }
    } SEAM(3);
    if (IN(4)) { p3_yml(p, wave, lane); } SEAM(4);
    if (IN(5)) {
        EpiMergeA ea{(bf16*)(p.ws + WS_MERGED), (const bf16*)(p.ws + WS_GATES)};
        gemm<EpiMergeA>(lds, (const bf16*)p.out, (const bf16*)(p.ws + WS_WSBT), T_, 1024, 512, ea);
        VM_WAIT(); __syncthreads();
        EpiMergeB eb{(bf16*)(p.ws + WS_MERGED), (const bf16*)(p.ws + WS_GATES)};
        gemm<EpiMergeB>(lds, (const bf16*)p.out + (size_t)T_ * 512, (const bf16*)(p.ws + WS_WMLT), T_, 1024, 512, eb);
    } SEAM(5);
    if (IN(6)) {
#pragma unroll 1
      for (int r = 0; r < REP(5); ++r) {
        EpiH e{(float*)(p.ws + WS_H), p.x};
        gemm<EpiH>(lds, (const bf16*)(p.ws + WS_MERGED), (const bf16*)(p.ws + WS_WOUTT), T_, 1024, 1024, e); }
    } SEAM(6);
    if (IN(7)) { p6_hn(p, wave, lane); } SEAM(7);
    if (IN(8)) { EpiF32 e{(float*)(p.ws + WS_SC), 1024}; gemm<EpiF32>(lds, (const bf16*)(p.ws + WS_HN), (const bf16*)(p.ws + WS_WCT), T_, 1024, 1024, e); } SEAM(8);
    if (IN(9)) {
#pragma unroll 1
        for (int r = 0; r < REP(8); ++r) p8_topk(p, 0, wave, lane); } SEAM(9);
    if (IN(10)) { EpiF32 e{(float*)(p.ws + WS_SC), 1024}; gemm<EpiF32>(lds, (const bf16*)(p.ws + WS_HN), (const bf16*)(p.ws + WS_WCT) + (size_t)1024 * 1024, T_, 1024, 1024, e); } SEAM(10);
    if (IN(11)) { p8_topk(p, 1, wave, lane); } SEAM(11);
    if (IN(12)) { peer_u(p, wave, lane); } SEAM(12);
    if (IN(13)) { peer_c(p, wave, lane); } SEAM(13);
    if (IN(14)) { peer_v(p, wave, lane); } SEAM(14);
    if (IN(15)) { peer_f(p, wave, lane); }
    if (PROBE_WAIT_LO >= 0 && blockIdx.x == 0 && tid == 0) {
        const unsigned long long tend = __builtin_amdgcn_s_memrealtime();
        const unsigned long long thi = PROBE_WAIT_HI >= 16 ? tend : STAMP[PROBE_WAIT_HI < 0 ? 0 : PROBE_WAIT_HI];
        const unsigned long long dt = thi - STAMP[PROBE_WAIT_LO];
        while (__builtin_amdgcn_s_memrealtime() - tend < dt) __builtin_amdgcn_s_sleep(8);
    }
#undef IN
#undef SEAM
}

extern "C" void kernel_launch(void* const* d_in, const int* in_sizes, int n_in, void* d_out, int out_size, void* d_ws, size_t ws_size, hipStream_t stream) {
    static int grid = 0;
    if (grid == 0) {
        if (n_in != 18 || in_sizes[0] != T_ * D_ || out_size != T_ * D_ || ws_size < WS_END) {
            fprintf(stderr, "kernel_launch: unexpected problem (n_in %d, in0 %d, out %d, ws %zu); nothing launched\n", n_in, n_in > 0 ? in_sizes[0] : -1, out_size, ws_size); grid = -1; return; }
        int dev = 0, cus = 0, per_cu = 0;
        if (hipGetDevice(&dev) != hipSuccess || hipDeviceGetAttribute(&cus, hipDeviceAttributeMultiprocessorCount, dev) != hipSuccess) { grid = -1; return; }
        if (hipFuncSetAttribute((const void*)fwd_kernel, hipFuncAttributeMaxDynamicSharedMemorySize, LDS_BYTES) != hipSuccess) { fprintf(stderr, "kernel_launch: hipFuncSetAttribute failed\n"); grid = -1; return; }
        if (hipOccupancyMaxActiveBlocksPerMultiprocessor(&per_cu, (const void*)fwd_kernel, NTHR, LDS_BYTES) != hipSuccess || per_cu < 1)
            fprintf(stderr, "kernel_launch: note: occupancy query reports %d workgroups per CU\n", per_cu);
        (void)hipGetLastError();
        grid = cus;
    }
    if (grid < 0) return;
    if (hipMemsetAsync((char*)d_ws + WS_CTL, 0, CTL_ZERO_BYTES, stream) != hipSuccess) { fprintf(stderr, "kernel_launch: memset failed\n"); return; }
    Args a{};
    const float** pp = (const float**)&a.p;
    for (int i = 0; i < 18; ++i) pp[i] = (const float*)d_in[i];
    a.p.out = (float*)d_out; a.p.ws = (unsigned char*)d_ws;
#if MK_PER_PHASE
    for (int ph = 0; ph < N_PHASES; ++ph) {
        a.ph_lo = ph; a.ph_hi = ph + 1;
        hipLaunchKernelGGL(fwd_kernel, dim3(grid), dim3(NTHR), LDS_BYTES, stream, a);
    }
#else
    a.ph_lo = 0; a.ph_hi = N_PHASES;
    hipLaunchKernelGGL(fwd_kernel, dim3(grid), dim3(NTHR), LDS_BYTES, stream, a);
#endif
    const hipError_t le = hipPeekAtLastError();
    if (le != hipSuccess) fprintf(stderr, "kernel_launch: launch failed: %s\n", hipGetErrorName(le));
}
```

```cpp
#include <hip/hip_runtime.h>
#include <cstdio>
#include <cstdint>
namespace pg8 {
#define PG8_LAS __attribute__((address_space(3)))
typedef unsigned short bf16_t;
typedef short bf16x8 __attribute__((ext_vector_type(8)));
typedef float f32x4 __attribute__((ext_vector_type(4)));
typedef unsigned u32x4 __attribute__((ext_vector_type(4)));
constexpr int BM = 256, BK = 64, HALF = 128, HTB = HALF * BK * 2  , STAGE_BYTES = 8 * HTB, NXCD = 8, WGM = 8;

__host__ __device__ __forceinline__ int lds_byte(int r, int c) { const int st = (r >> 4) * 2 + (c >> 5), rr = r & 15, cc = c & 31, ob = rr * 64 + cc * 2; return st * 1024 + (ob ^ (((ob >> 9) & 1) << 5)); }
__host__ __device__ __forceinline__ void stage_rc(int b, int& R, int& C) { const int st = b / 1024, sb = b % 1024, swz = sb ^ (((sb >> 9) & 1) << 5); R = (st >> 1) * 16 + swz / 64; C = (st & 1) * 32 + (swz % 64) / 2; }
__host__ __device__ __forceinline__ int perm32(int rho) { const int n = rho >> 4, i = rho & 15; return 8 * (i >> 2) + 4 * n + (i & 3); }

struct Unit { int pm, pn; };
struct Gemm { const bf16_t* A; const bf16_t* Bt; int M, N, K; };

struct StaticOrder {
    int nM, nN, nwg, G, c;
    __host__ __device__ void init(int M, int N, int G_, int c_) { nM = M / BM; nN = N / BM; nwg = nM * nN; G = G_; c = c_; }
    __host__ __device__ bool next(int i, Unit& u) const {
        const long L = (long)i * G + c; if (L >= nwg) return false;
        int wgid = (int)L; { const int q = nwg / NXCD, r = nwg % NXCD, xcd = wgid % NXCD, off = wgid / NXCD; wgid = (xcd < r ? xcd * (q + 1) : r * (q + 1) + (xcd - r) * q) + off; }
        const int nig = WGM * nN, gid = wgid / nig, fm = gid * WGM, gsz = (nM - fm) < WGM ? (nM - fm) : WGM;
        u.pm = fm + ((wgid % nig) % gsz); u.pn = (wgid % nig) / gsz; return true;
    }
    __device__ __forceinline__ void a_ready(const Unit&) const {}
    __device__ __forceinline__ void done(const Unit&) const {}
};

__device__ __forceinline__ unsigned cvt_pk_bf16(float lo, float hi) { unsigned r; asm volatile("v_cvt_pk_bf16_f32 %0, %1, %2" : "=v"(r) : "v"(lo), "v"(hi)); return r; }
template <class Epi, class Sched, bool ALIGN_EPI = false, bool SP2 = false>
__device__ __forceinline__ void gemm_phase(PG8_LAS unsigned char* lds, const Gemm g, const Sched& S, const Epi& E) {
    const int tid = threadIdx.x, wid = __builtin_amdgcn_readfirstlane(tid >> 6), lane = tid & 63, wr = wid >> 2, wc = wid & 3, fr = lane & 15, fq = lane >> 4;
    const int K = g.K, nt = K / BK;
    unsigned voffA[2], voffB[2];
#pragma unroll
    for (int i = 0; i < 2; ++i) { int R, C; stage_rc(tid * 16 + i * 8192, R, C); const int Rb = Epi::PERM ? ((R & ~31) + perm32(R & 31)) : R;
        voffA[i] = (unsigned)(R * K + C) * 2u; voffB[i] = (unsigned)(Rb * K + C) * 2u; }
    const size_t kstep = (size_t)(BK * 2);
    const size_t hstep = (size_t)HALF * K * 2;
    const size_t tstep = 2 * hstep;
    const unsigned ldsw = (unsigned)wid * 1024u;
    const int aoff = lds_byte(wr * 64 + fr, fq * 8), boff = lds_byte(wc * 32 + fr, fq * 8);
#define PG8_SA(b, h) (((b) * 2 + (h)) * HTB)
#define PG8_SB(b, h) ((4 + (b) * 2 + (h)) * HTB)
#define PG8_STAGE(bufoff, gbase, voff) do { _Pragma("unroll") for (int _i = 0; _i < 2; ++_i) \
        __builtin_amdgcn_global_load_lds((const unsigned*)((const char*)(gbase) + (voff)[_i]), (PG8_LAS unsigned*)(lds + (bufoff) + ldsw + _i * 8192), 16, 0, 0); } while (0)
#define PG8_LDA(dst, b, h) do { _Pragma("unroll") for (int m = 0; m < 4; ++m) _Pragma("unroll") for (int k = 0; k < 2; ++k) dst[m][k] = *(const PG8_LAS bf16x8*)(lds + PG8_SA(b, h) + aoff + m * 2048 + k * 1024); } while (0)
#define PG8_LDB(dst, b, h) do { _Pragma("unroll") for (int n = 0; n < 2; ++n) _Pragma("unroll") for (int k = 0; k < 2; ++k) dst[n][k] = *(const PG8_LAS bf16x8*)(lds + PG8_SB(b, h) + boff + n * 2048 + k * 1024); } while (0)
#define PG8_MMA(ai, bj, At, Bt) do { __builtin_amdgcn_s_setprio(1); _Pragma("unroll") for (int m = 0; m < 4; ++m) _Pragma("unroll") for (int n = 0; n < 2; ++n) _Pragma("unroll") for (int k = 0; k < 2; ++k) \
        acc[ai][bj][m][n] = __builtin_amdgcn_mfma_f32_16x16x32_bf16(Bt[n][k], At[m][k], acc[ai][bj][m][n], 0, 0, 0); __builtin_amdgcn_s_setprio(0); } while (0)
#define PG8_WAIT_V(n) asm volatile("s_waitcnt vmcnt(" #n ")" ::: "memory")
#define PG8_WAIT_L(n) asm volatile("s_waitcnt lgkmcnt(" #n ")" ::: "memory")
#define PG8_BAR __builtin_amdgcn_s_barrier()
#define PG8_SCHED __builtin_amdgcn_sched_barrier(0)
    Unit cur, nxt; int ui = 0;
    if (!S.next(0, cur)) return;
    f32x4 acc[2][2][4][2];
#pragma unroll
    for (int a = 0; a < 2; ++a)
#pragma unroll
        for (int b = 0; b < 2; ++b)
#pragma unroll
            for (int m = 0; m < 4; ++m)
#pragma unroll
                for (int n = 0; n < 2; ++n) acc[a][b][m][n] = (f32x4){0.f, 0.f, 0.f, 0.f};
    bf16x8 At[4][2], B0[2][2], B1[2][2];
    const char* cA = (const char*)g.A + (size_t)cur.pm * tstep; const char* cB = (const char*)g.Bt + (size_t)cur.pn * tstep;
    S.a_ready(cur);
    if constexpr (SP2) {
        PG8_STAGE(PG8_SB(0, 0), cB, voffB); PG8_STAGE(PG8_SB(0, 1), cB + hstep, voffB); PG8_STAGE(PG8_SA(0, 0), cA, voffA); PG8_STAGE(PG8_SA(0, 1), cA + hstep, voffA);
        if (wr == 1) PG8_BAR;
        PG8_WAIT_V(2); PG8_BAR;
        PG8_STAGE(PG8_SB(1, 0), cB + kstep, voffB); PG8_STAGE(PG8_SA(1, 0), cA + kstep, voffA); PG8_STAGE(PG8_SB(1, 1), cB + hstep + kstep, voffB);
        PG8_WAIT_V(6); PG8_BAR;
    } else {
        PG8_STAGE(PG8_SB(0, 0), cB, voffB); PG8_STAGE(PG8_SA(0, 0), cA, voffA); PG8_STAGE(PG8_SB(0, 1), cB + hstep, voffB); PG8_STAGE(PG8_SA(0, 1), cA + hstep, voffA);
        if (wr == 1) PG8_BAR;
        PG8_WAIT_V(4); PG8_BAR;
        PG8_STAGE(PG8_SB(1, 0), cB + kstep, voffB); PG8_STAGE(PG8_SA(1, 0), cA + kstep, voffA); PG8_STAGE(PG8_SB(1, 1), cB + hstep + kstep, voffB);
        PG8_WAIT_V(6); PG8_BAR;
    }
    for (;;) {
        const bool has_next = S.next(ui + 1, nxt);
        const char* nA = has_next ? (const char*)g.A + (size_t)nxt.pm * tstep : cA; const char* nB = has_next ? (const char*)g.Bt + (size_t)nxt.pn * tstep : cB;
        for (int t = 0; t < nt; t += 2) {
            const bool last = (t == nt - 2);
            const char* a1 = cA + (size_t)(t + 1) * kstep;
            const char* a2 = last ? nA : cA + (size_t)(t + 2) * kstep; const char* b2 = last ? nB : cB + (size_t)(t + 2) * kstep;
            const char* a3 = a2 + kstep; const char* b3 = b2 + kstep;
            if (last && has_next) S.a_ready(nxt);
            if constexpr (SP2) {
            PG8_LDB(B0, 0, 0); PG8_LDB(B1, 0, 1); PG8_SCHED; PG8_LDA(At, 0, 0); PG8_STAGE(PG8_SA(1, 1), a1 + hstep, voffA);
            PG8_WAIT_V(8); PG8_WAIT_L(0); PG8_BAR; PG8_MMA(0, 0, At, B0); PG8_MMA(0, 1, At, B1); PG8_BAR; PG8_SCHED;
            PG8_LDA(At, 0, 1); PG8_STAGE(PG8_SB(0, 0), b2, voffB); PG8_STAGE(PG8_SB(0, 1), b2 + hstep, voffB); PG8_STAGE(PG8_SA(0, 0), a2, voffA);
            PG8_WAIT_V(8); PG8_WAIT_L(0); PG8_BAR; PG8_MMA(1, 0, At, B0); PG8_MMA(1, 1, At, B1); PG8_BAR; PG8_SCHED;
            PG8_LDB(B0, 1, 0); PG8_LDB(B1, 1, 1); PG8_SCHED; PG8_LDA(At, 1, 0); PG8_STAGE(PG8_SA(0, 1), a2 + hstep, voffA);
            PG8_WAIT_V(8); PG8_WAIT_L(0); PG8_BAR; PG8_MMA(0, 0, At, B0); PG8_MMA(0, 1, At, B1); PG8_BAR; PG8_SCHED;
            PG8_LDA(At, 1, 1); PG8_STAGE(PG8_SB(1, 0), b3, voffB); PG8_STAGE(PG8_SB(1, 1), b3 + hstep, voffB); PG8_STAGE(PG8_SA(1, 0), a3, voffA);
            PG8_WAIT_V(8); PG8_WAIT_L(0); PG8_BAR; PG8_MMA(1, 0, At, B0); PG8_MMA(1, 1, At, B1); PG8_BAR; PG8_SCHED;
            } else {
            PG8_LDB(B0, 0, 0); PG8_SCHED; PG8_LDA(At, 0, 0); PG8_STAGE(PG8_SA(1, 1), a1 + hstep, voffA);
            PG8_WAIT_L(8); PG8_BAR; PG8_WAIT_L(0); PG8_MMA(0, 0, At, B0); PG8_BAR; PG8_SCHED;
            PG8_LDB(B1, 0, 1); PG8_STAGE(PG8_SB(0, 0), b2, voffB);
            PG8_BAR; PG8_WAIT_L(0); PG8_MMA(0, 1, At, B1); PG8_BAR;
            PG8_LDA(At, 0, 1); PG8_STAGE(PG8_SA(0, 0), a2, voffA);
            PG8_BAR; PG8_WAIT_L(0); PG8_MMA(1, 0, At, B0); PG8_BAR; PG8_SCHED;
            PG8_STAGE(PG8_SB(0, 1), b2 + hstep, voffB);
            PG8_WAIT_V(6); PG8_BAR; PG8_MMA(1, 1, At, B1); PG8_BAR;
            PG8_LDB(B0, 1, 0); PG8_SCHED; PG8_LDA(At, 1, 0); PG8_STAGE(PG8_SA(0, 1), a2 + hstep, voffA);
            PG8_WAIT_L(8); PG8_BAR; PG8_WAIT_L(0); PG8_MMA(0, 0, At, B0); PG8_BAR; PG8_SCHED;
            PG8_LDB(B1, 1, 1); PG8_STAGE(PG8_SB(1, 0), b3, voffB);
            PG8_BAR; PG8_WAIT_L(0); PG8_MMA(0, 1, At, B1); PG8_BAR;
            PG8_LDA(At, 1, 1); PG8_STAGE(PG8_SA(1, 0), a3, voffA);
            PG8_BAR; PG8_WAIT_L(0); PG8_MMA(1, 0, At, B0); PG8_BAR; PG8_SCHED;
            PG8_STAGE(PG8_SB(1, 1), b3 + hstep, voffB);
            PG8_WAIT_V(6); PG8_BAR; PG8_MMA(1, 1, At, B1); PG8_BAR;
            }
        }
        if constexpr (ALIGN_EPI) { if (wr == 0) PG8_BAR; }
        if constexpr (!Epi::AFTER_DRAIN) { E(acc, cur, wr, wc, fr, fq); S.done(cur); }
        if (!has_next) break;
#pragma unroll
        for (int a = 0; a < 2; ++a)
#pragma unroll
            for (int b = 0; b < 2; ++b)
#pragma unroll
                for (int m = 0; m < 4; ++m)
#pragma unroll
                    for (int n = 0; n < 2; ++n) acc[a][b][m][n] = (f32x4){0.f, 0.f, 0.f, 0.f};
        cur = nxt; cA = nA; cB = nB; ++ui;
        if constexpr (ALIGN_EPI) { if (wr == 1) PG8_BAR; }
    }
    PG8_WAIT_V(0);
    if constexpr (!ALIGN_EPI) { if (wr == 0) PG8_BAR; }
    PG8_BAR;
    if constexpr (Epi::AFTER_DRAIN) { E.fused(acc, cur, wr, wc, fr, fq, lds, wid, lane); S.done(cur); }
#undef PG8_SA
#undef PG8_SB
#undef PG8_STAGE
#undef PG8_LDA
#undef PG8_LDB
#undef PG8_MMA
#undef PG8_WAIT_V
#undef PG8_WAIT_L
#undef PG8_BAR
#undef PG8_SCHED
}
}

#ifndef MK_PER_PHASE
#define MK_PER_PHASE 0
#endif
#ifndef USE_PG8
#define USE_PG8 1
#endif
constexpr int NWAVES = 8, NTHR = 512;

constexpr int B_ = 16, S_ = 2048, D_ = 1024, T_ = B_ * S_;
constexpr int INC = 5640, NPROJ = 5632;
constexpr int NEXP = 16384;
constexpr float EPS = 1e-6f;

constexpr size_t MiB = 1u << 20;
constexpr size_t WS_CTL = 0, CTL_ZERO_BYTES = 1 * MiB;
constexpr size_t WS_W1T = 2 * MiB, WS_WSBT = 13 * MiB, WS_WMLT = 14 * MiB, WS_WOUTT = 15 * MiB, WS_WCT = 17 * MiB, WS_IFG = 21 * MiB;
constexpr size_t WS_U8 = 24 * MiB, WS_V8 = 40 * MiB, WS_USC = 22 * MiB, WS_VSC = 23 * MiB;
constexpr size_t WS_XN = 88 * MiB, WS_QC = 88 * MiB, WS_KC = 120 * MiB;
constexpr size_t WS_SBQKV = 152 * MiB  , WS_VT = 216 * MiB  , WS_MLQK = 248 * MiB, WS_MLV = 312 * MiB, WS_MLO = 344 * MiB, WS_GATES = 376 * MiB;
constexpr size_t WS_MERGED = 216 * MiB, WS_H = 88 * MiB, WS_HN = 216 * MiB, WS_IDX = 280 * MiB, WS_GATE = 296 * MiB, WS_SC = 312 * MiB;
constexpr size_t WS_PART = 312 * MiB  , WS_SSQ = 504 * MiB  , WS_COEF = 56 * MiB  , WS_HN8 = 440 * MiB  , WS_XS = 505 * MiB  , WS_SS = 506 * MiB  ;
constexpr size_t WS_END = 508 * MiB;
constexpr int CW_BAR = 4096, CW_Q = 8192;

constexpr int RING_OFF = 0, RING_BYTES = 135168;
constexpr int LDSCTL_OFF = RING_BYTES, MISC_OFF = LDSCTL_OFF + 320;
constexpr int LDS_BYTES = 147456;

#define GAS __attribute__((address_space(1)))
#define LAS __attribute__((address_space(3)))
typedef unsigned short bf16;
typedef unsigned v4u __attribute__((ext_vector_type(4)));
typedef unsigned v2u __attribute__((ext_vector_type(2)));
typedef float f32x4 __attribute__((ext_vector_type(4)));
#define LDS_WAIT() asm volatile("s_waitcnt lgkmcnt(0)" ::: "memory")
#define VM_WAIT() asm volatile("s_waitcnt vmcnt(0)" ::: "memory")
__device__ __forceinline__ unsigned f2bf(float f) { unsigned u = __builtin_bit_cast(unsigned, f); return (u + 0x7fffu + ((u >> 16) & 1u)) >> 16; }
__device__ __forceinline__ unsigned pk2(float lo, float hi) { return f2bf(lo) | (f2bf(hi) << 16); }
__device__ __forceinline__ float bflo(unsigned u) { return __builtin_bit_cast(float, u << 16); }
__device__ __forceinline__ float bfhi(unsigned u) { return __builtin_bit_cast(float, u & 0xffff0000u); }
__device__ __forceinline__ float bf2f(bf16 b) { return __builtin_bit_cast(float, (unsigned)b << 16); }
__device__ __forceinline__ float sigmoidf_(float x) { return 1.f / (1.f + __expf(-x)); }
__device__ __forceinline__ float wave_sum(float v) {
#pragma unroll
    for (int o = 1; o < 64; o <<= 1) v += __shfl_xor(v, o);
    return v;
}
__device__ __forceinline__ unsigned wave_max_u(unsigned v) {
#pragma unroll
    for (int o = 1; o < 64; o <<= 1) { const unsigned w = (unsigned)__shfl_xor((int)v, o); v = v > w ? v : w; }
    return v;
}
struct F8 { float v[8]; };
__device__ __forceinline__ void unpack8(const v4u& u, float (&f)[8]) {
    f[0] = bflo(u.x); f[1] = bfhi(u.x); f[2] = bflo(u.y); f[3] = bfhi(u.y); f[4] = bflo(u.z); f[5] = bfhi(u.z); f[6] = bflo(u.w); f[7] = bfhi(u.w);
}
__device__ __forceinline__ v4u pack8(const float (&f)[8]) { v4u o; o.x = pk2(f[0], f[1]); o.y = pk2(f[2], f[3]); o.z = pk2(f[4], f[5]); o.w = pk2(f[6], f[7]); return o; }

#define XB_TMO      128
#define XB_XCNT(j)  (256  + 64 * (j))
#define XB_XSUB(j)  (1280 + 64 * (j))
#define XB_XGEN(j)  (2304 + 64 * (j))
#define XB_TOP      3328
#define XB_TOPGEN   3392
#define XCD_BAR_WORDS 3456
#define XB_SPIN_CAP (1u << 24)

__device__ __forceinline__ unsigned xb_ld(unsigned* p)              { return __hip_atomic_load(p, __ATOMIC_RELAXED, __HIP_MEMORY_SCOPE_AGENT); }
__device__ __forceinline__ unsigned xb_add(unsigned* p, unsigned v) { return __hip_atomic_fetch_add(p, v, __ATOMIC_RELAXED, __HIP_MEMORY_SCOPE_AGENT); }
__device__ __forceinline__ unsigned xb_xcc_id() { return (unsigned)__builtin_amdgcn_s_getreg((3 << 11) | 20) & 0xFu; }
#define XB_SPIN(cond, bar) do { unsigned _sp = 0; while (cond) { __builtin_amdgcn_s_sleep(1); \
    if ((++_sp & 255u) == 0u) { if (xb_ld(&(bar)[XB_TMO])) break; if (_sp > XB_SPIN_CAP) { atomicAdd(&(bar)[XB_TMO], 1u); break; } } } } while (0)

struct XcdBarrier {
    unsigned* bar; unsigned x;
    volatile LAS unsigned* st;
};

__device__ __forceinline__ XcdBarrier xcd_barrier_post(unsigned* bar, volatile LAS unsigned* st) {
    XcdBarrier b; b.bar = bar; b.x = xb_xcc_id(); b.st = st;
    if (threadIdx.x == 0) (void)xb_add(&bar[XB_XCNT(b.x)], 1u);
    return b;
}
__device__ __forceinline__ void xcd_barrier_complete(unsigned* bar, unsigned x, unsigned& nloc, unsigned& nx) {
    const unsigned G = gridDim.x * gridDim.y * gridDim.z;
    unsigned sum, cnt, mine, sp = 0u;
    for (;;) {
        sum = 0u; cnt = 0u; mine = 0u;
#pragma unroll
        for (unsigned j = 0; j < 16; ++j) { const unsigned c = xb_ld(&bar[XB_XCNT(j)]); sum += c; cnt += (c > 0u) ? 1u : 0u; mine = (j == x) ? c : mine; }
        if (sum == G) break;
        __builtin_amdgcn_s_sleep(1);
        if ((++sp & 255u) == 0u) { if (xb_ld(&bar[XB_TMO])) break; if (sp > XB_SPIN_CAP) { atomicAdd(&bar[XB_TMO], 1u); break; } }
    }
    nloc = mine > 0u ? mine : 1u; nx = cnt > 0u ? cnt : 1u;
}

__device__ __forceinline__ void xcd_barrier(const XcdBarrier& b) {
    asm volatile("s_waitcnt vmcnt(0)" ::: "memory");
    __syncthreads();
    if (threadIdx.x == 0) {
        unsigned* bar = b.bar;
        __builtin_amdgcn_s_waitcnt(0);
        unsigned nloc = b.st[0], nx = b.st[1];
        if (nloc == 0u) { xcd_barrier_complete(bar, b.x, nloc, nx); b.st[0] = nloc; b.st[1] = nx; }
        const unsigned old = xb_add(&bar[XB_XSUB(b.x)], 1u);
        const unsigned gen = old / nloc;
        if (old + 1u == (gen + 1u) * nloc) {
            __builtin_amdgcn_fence(__ATOMIC_RELEASE, "agent");
            asm volatile("s_waitcnt vmcnt(0)" ::: "memory");
            const unsigned og = xb_add(&bar[XB_TOP], 1u);
            const unsigned tg = og / nx;
            if (og + 1u == (tg + 1u) * nx) xb_add(&bar[XB_TOPGEN], 1u);
            else XB_SPIN(xb_ld(&bar[XB_TOPGEN]) == tg, bar);
            __builtin_amdgcn_fence(__ATOMIC_ACQUIRE, "agent");
            xb_add(&bar[XB_XGEN(b.x)], 1u);
            asm volatile("s_waitcnt vmcnt(0)" ::: "memory");
        } else {
            XB_SPIN(xb_ld(&bar[XB_XGEN(b.x)]) == gen, bar);
            __builtin_amdgcn_fence(__ATOMIC_ACQUIRE, "agent");
            asm volatile("s_waitcnt vmcnt(0)" ::: "memory");
        }
    }
    __syncthreads();
}

struct EpiProj {
    bf16 *sbqk, *vt, *mlqk, *mlv, *mlo, *gates;
    __device__ __forceinline__ void operator()(int row, int col, const F8& a) const {
        bf16* dst;
        if (col < 1024) dst = sbqk + (size_t)row * 1024 + col;
        else if (col < 1536) {
            const int c = col - 1024, hh = c >> 6, d = c & 63, b = row >> 11, sq = row & 2047;
            bf16* vp = vt + ((size_t)(b * 8 + hh) * 64 + d) * 2048 + sq;
#pragma unroll
            for (int i = 0; i < 8; ++i) vp[(size_t)i * 2048] = (bf16)f2bf(a.v[i]);
            return;
        }
        else if (col < 2560) dst = mlqk + (size_t)row * 1024 + (col - 1536);
        else if (col < 3072) dst = mlv + (size_t)row * 512 + (col - 2560);
        else if (col < 3584) dst = mlo + (size_t)row * 512 + (col - 3072);
        else dst = gates + (size_t)row * 2048 + (col - 3584);
        *(v4u*)dst = pack8(a.v);
    }
};
struct EpiMergeA {
    bf16* merged; const bf16* gates;
    __device__ __forceinline__ void operator()(int row, int col, const F8& a) const {
        float g[8], o[8]; unpack8(*(const v4u*)(gates + (size_t)row * 2048 + col), g);
#pragma unroll
        for (int i = 0; i < 8; ++i) o[i] = sigmoidf_(g[i]) * a.v[i];
        *(v4u*)(merged + (size_t)row * 1024 + col) = pack8(o);
    }
};
struct EpiMergeB {
    bf16* merged; const bf16* gates;
    __device__ __forceinline__ void operator()(int row, int col, const F8& a) const {
        float g[8], o[8]; unpack8(*(const v4u*)(gates + (size_t)row * 2048 + 1024 + col), g);
        unpack8(*(const v4u*)(merged + (size_t)row * 1024 + col), o);
#pragma unroll
        for (int i = 0; i < 8; ++i) o[i] += sigmoidf_(g[i]) * a.v[i];
        *(v4u*)(merged + (size_t)row * 1024 + col) = pack8(o);
    }
};
struct EpiH {
    float* h; const float* x;
    __device__ __forceinline__ void operator()(int row, int col, const F8& a) const {
        const f32x4 x0 = *(const f32x4*)(x + (size_t)row * 1024 + col), x1 = *(const f32x4*)(x + (size_t)row * 1024 + col + 4);
        *(f32x4*)(h + (size_t)row * 1024 + col) = (f32x4){x0.x + a.v[0], x0.y + a.v[1], x0.z + a.v[2], x0.w + a.v[3]};
        *(f32x4*)(h + (size_t)row * 1024 + col + 4) = (f32x4){x1.x + a.v[4], x1.y + a.v[5], x1.z + a.v[6], x1.w + a.v[7]};
    }
};
struct EpiF32 {
    float* o; int ldc;
    __device__ __forceinline__ void operator()(int row, int col, const F8& a) const {
        *(f32x4*)(o + (size_t)row * ldc + col) = (f32x4){a.v[0], a.v[1], a.v[2], a.v[3]};
        *(f32x4*)(o + (size_t)row * ldc + col + 4) = (f32x4){a.v[4], a.v[5], a.v[6], a.v[7]};
    }
};

template <class E> struct EpiAdapt {
    static constexpr bool PERM = true, AFTER_DRAIN = false;
    E e;
    __device__ __forceinline__ void operator()(const pg8::f32x4 (&acc)[2][2][4][2], const pg8::Unit& u, int wr, int wc, int fr, int fq) const {
#pragma unroll
        for (int ai = 0; ai < 2; ++ai)
#pragma unroll
            for (int m = 0; m < 4; ++m) {
                const int row = u.pm * 256 + ai * 128 + wr * 64 + m * 16 + fr;
#pragma unroll
                for (int bj = 0; bj < 2; ++bj) {
                    const int col = u.pn * 256 + bj * 128 + wc * 32 + 8 * fq;
                    F8 a; const pg8::f32x4 v0 = acc[ai][bj][m][0], v1 = acc[ai][bj][m][1];
                    a.v[0] = v0[0]; a.v[1] = v0[1]; a.v[2] = v0[2]; a.v[3] = v0[3]; a.v[4] = v1[0]; a.v[5] = v1[1]; a.v[6] = v1[2]; a.v[7] = v1[3];
                    e(row, col, a);
                }
            }
    }
};

struct EpiHW {
    static constexpr bool PERM = true, AFTER_DRAIN = false;
    float* h; const float* x; bf16* hw; const float* wffn; float* ss;
    __device__ __forceinline__ void operator()(const pg8::f32x4 (&acc)[2][2][4][2], const pg8::Unit& u, int wr, int wc, int fr, int fq) const {
#pragma unroll
        for (int ai = 0; ai < 2; ++ai)
#pragma unroll
            for (int m = 0; m < 4; ++m) {
                const int row = u.pm * 256 + ai * 128 + wr * 64 + m * 16 + fr;
                float sq = 0.f;
#pragma unroll
                for (int bj = 0; bj < 2; ++bj) {
                    const int col = u.pn * 256 + bj * 128 + wc * 32 + 8 * fq;
                    const size_t o = (size_t)row * 1024 + col;
                    const f32x4 x0 = *(const f32x4*)(x + o), x1 = *(const f32x4*)(x + o + 4);
                    const f32x4 w0 = *(const f32x4*)(wffn + col), w1 = *(const f32x4*)(wffn + col + 4);
                    const pg8::f32x4 v0 = acc[ai][bj][m][0], v1 = acc[ai][bj][m][1];
                    const f32x4 h0 = (f32x4){x0.x + v0[0], x0.y + v0[1], x0.z + v0[2], x0.w + v0[3]}, h1 = (f32x4){x1.x + v1[0], x1.y + v1[1], x1.z + v1[2], x1.w + v1[3]};
                    *(f32x4*)(h + o) = h0; *(f32x4*)(h + o + 4) = h1;
                    *(v4u*)(hw + o) = (v4u){pk2(h0.x * w0.x, h0.y * w0.y), pk2(h0.z * w0.z, h0.w * w0.w), pk2(h1.x * w1.x, h1.y * w1.y), pk2(h1.z * w1.z, h1.w * w1.w)};
                    sq += (h0.x * h0.x + h0.y * h0.y) + (h0.z * h0.z + h0.w * h0.w) + (h1.x * h1.x + h1.y * h1.y) + (h1.z * h1.z + h1.w * h1.w);
                }
                sq += __shfl_xor(sq, 16); sq += __shfl_xor(sq, 32);
                if (fq == 0) ss[(size_t)row * 16 + u.pn * 4 + wc] = sq;
            }
    }
};

template <class E>
__device__ __forceinline__ void simple_gemm(LAS unsigned char* lds, const bf16* A, const bf16* Bt, int M, int N, int K, const E& e) {
    LAS float* As = (LAS float*)lds;
    LAS float* Bs = As + 32 * 132;
    const int tid = threadIdx.x, ty = tid >> 4, tx = tid & 15;
    const int ntn = N / 128, ntiles = (M / 128) * ntn;
    for (int tile = blockIdx.x; tile < ntiles; tile += gridDim.x) {
        const int tm = tile / ntn, tn = tile % ntn;
        float acc[4][8];
#pragma unroll
        for (int i = 0; i < 4; ++i)
#pragma unroll
            for (int j = 0; j < 8; ++j) acc[i][j] = 0.f;
        for (int k0 = 0; k0 < K; k0 += 32) {
            {
                const int r = tid >> 2, kq = (tid & 3) * 8;
                float fa[8], fb[8];
                unpack8(*(const v4u*)(A + (size_t)(tm * 128 + r) * K + k0 + kq), fa);
                unpack8(*(const v4u*)(Bt + (size_t)(tn * 128 + r) * K + k0 + kq), fb);
#pragma unroll
                for (int i = 0; i < 8; ++i) { As[(kq + i) * 132 + r] = fa[i]; Bs[(kq + i) * 132 + r] = fb[i]; }
            }
            __syncthreads();
#pragma unroll 8
            for (int k = 0; k < 32; ++k) {
                const f32x4 a4 = *(const LAS f32x4*)(As + k * 132 + ty * 4);
                const f32x4 b0 = *(const LAS f32x4*)(Bs + k * 132 + tx * 8), b1 = *(const LAS f32x4*)(Bs + k * 132 + tx * 8 + 4);
                const float av[4] = {a4.x, a4.y, a4.z, a4.w};
                const float bv[8] = {b0.x, b0.y, b0.z, b0.w, b1.x, b1.y, b1.z, b1.w};
#pragma unroll
                for (int i = 0; i < 4; ++i)
#pragma unroll
                    for (int j = 0; j < 8; ++j) acc[i][j] += av[i] * bv[j];
            }
            __syncthreads();
        }
#pragma unroll
        for (int i = 0; i < 4; ++i) {
            F8 a;
#pragma unroll
            for (int j = 0; j < 8; ++j) a.v[j] = acc[i][j];
            e(tm * 128 + ty * 4 + i, tn * 128 + tx * 8, a);
        }
    }
}

template <class E>
__device__ __forceinline__ void gemm(LAS unsigned char* lds, const bf16* A, const bf16* Bt, int M, int N, int K, const E& e) {
#if USE_PG8
    pg8::Gemm g{A, Bt, M, N, K}; pg8::StaticOrder S; S.init(M, N, (int)gridDim.x, (int)blockIdx.x);
    EpiAdapt<E> ea{e};
    pg8::gemm_phase<EpiAdapt<E>, pg8::StaticOrder, true, true>(lds, g, S, ea);
#else
    simple_gemm<E>(lds, A, Bt, M, N, K, e);
#endif
}

__device__ __forceinline__ void transpose_item(const float* W, int ldw, int K, bf16* WT, int src_col0, int dst_row0, LAS float* scr, int kb, int lane) {
    const int k0 = 64 * kb;
#pragma unroll 8
    for (int i = 0; i < 32; ++i) { const int kk = 2 * i + (lane >> 5); scr[kk * 33 + (lane & 31)] = W[(size_t)(k0 + kk) * ldw + src_col0 + (lane & 31)]; }
    LDS_WAIT(); asm volatile("" ::: "memory");
    const int c = lane & 7;
#pragma unroll
    for (int j = 0; j < 4; ++j) { const int n = (lane >> 3) + 8 * j; const LAS float* s = scr + (8 * c) * 33 + n;
        v4u o; o.x = pk2(s[0 * 33], s[1 * 33]); o.y = pk2(s[2 * 33], s[3 * 33]); o.z = pk2(s[4 * 33], s[5 * 33]); o.w = pk2(s[6 * 33], s[7 * 33]);
        *(v4u*)(WT + (size_t)(dst_row0 + n) * K + k0 + 8 * c) = o; }
    LDS_WAIT(); asm volatile("" ::: "memory");
}

struct P {
    const float *x, *norm_mix_w, *w_in, *conv_w, *conv_b, *b_i, *b_f, *ml_norm_w, *w_sb, *w_ml, *w_out, *norm_ffn_w, *w_query, *keys1, *keys2, *peer_u, *peer_v, *norm_final_w;
    float* out; unsigned char* ws;
};

__device__ __forceinline__ void p0_prologue(const P& p, LAS unsigned char* lds, int wave, int lane) {
    LAS float* scr = (LAS float*)(lds + wave * 8448);
    const int gw = blockIdx.x * NWAVES + wave, NGW = gridDim.x * NWAVES;
    bf16* W1T = (bf16*)(p.ws + WS_W1T); bf16* WSBT = (bf16*)(p.ws + WS_WSBT); bf16* WMLT = (bf16*)(p.ws + WS_WMLT); bf16* WOUTT = (bf16*)(p.ws + WS_WOUTT); bf16* WCT = (bf16*)(p.ws + WS_WCT);
    constexpr int I_1 = 16 * 176, I_SB = 8 * 32, I_ML = 8 * 32, I_O = 16 * 32, NT = I_1 + I_SB + I_ML + I_O;
    for (int it = gw; it < NT; it += NGW) {
        int r = it;
        if (r < I_1) { const int kb = r / 176, nb = r % 176, n0 = nb * 32; transpose_item(p.w_in, INC, 1024, W1T, n0 < 3584 ? n0 : n0 + 8, n0, scr, kb, lane); continue; } r -= I_1;
        if (r < I_SB) { const int kb = r / 32, nb = r % 32; transpose_item(p.w_sb, 1024, 512, WSBT, nb * 32, nb * 32, scr, kb, lane); continue; } r -= I_SB;
        if (r < I_ML) { const int kb = r / 32, nb = r % 32; transpose_item(p.w_ml, 1024, 512, WMLT, nb * 32, nb * 32, scr, kb, lane); continue; } r -= I_ML;
        { const int kb = r / 32, nb = r % 32; transpose_item(p.w_out, 1024, 1024, WOUTT, nb * 32, nb * 32, scr, kb, lane); }
    }
    for (int it = gw; it < 16 * 16 * 4; it += NGW) {
        const int hhf = it >> 6, kb = (it >> 2) & 15, kq = it & 3, head = hhf >> 1, half = hhf & 1, k = kb * 64 + lane;
        const f32x4* wq = (const f32x4*)(p.w_query + (size_t)k * 2048 + head * 256 + half * 128);
        f32x4 wr[32];
#pragma unroll
        for (int i = 0; i < 32; ++i) wr[i] = wq[i];
        const float* kbase = (half ? p.keys2 : p.keys1) + ((size_t)head * 128 + kq * 32) * 128;
#pragma unroll 1
        for (int key = 0; key < 32; ++key) {
            const f32x4* kr = (const f32x4*)(kbase + (size_t)key * 128);
            float a0 = 0.f, a1 = 0.f;
#pragma unroll
            for (int i = 0; i < 32; i += 2) { const f32x4 b0 = kr[i], b1 = kr[i + 1];
                a0 += wr[i].x * b0.x + wr[i].y * b0.y + wr[i].z * b0.z + wr[i].w * b0.w;
                a1 += wr[i + 1].x * b1.x + wr[i + 1].y * b1.y + wr[i + 1].z * b1.z + wr[i + 1].w * b1.w; }
            WCT[(size_t)(hhf * 128 + kq * 32 + key) * 1024 + k] = (bf16)f2bf(a0 + a1);
        }
    }
    bf16* XN = (bf16*)(p.ws + WS_XN); float* IFG = (float*)(p.ws + WS_IFG);
    LAS float* WG = (LAS float*)(lds + 8 * 8448);
    __syncthreads();
    for (int i = threadIdx.x; i < 2048; i += NTHR) { const int k = i >> 1, hf = i & 1; *(LAS f32x4*)(WG + k * 8 + hf * 4) = *(const f32x4*)(p.w_in + (size_t)k * INC + 3584 + hf * 4); }
    __syncthreads();
    for (int m = gw; m < T_; m += NGW) {
        const f32x4* xr = (const f32x4*)(p.x + (size_t)m * 1024) + lane;
        const f32x4* wr = (const f32x4*)p.norm_mix_w + lane;
        f32x4 v[4]; float ss = 0.f;
#pragma unroll
        for (int j = 0; j < 4; ++j) { v[j] = xr[64 * j]; ss += (v[j].x * v[j].x + v[j].y * v[j].y) + (v[j].z * v[j].z + v[j].w * v[j].w); }
        const float rstd = 1.f / sqrtf(wave_sum(ss) * (1.f / 1024.f) + EPS);
        float g[8];
#pragma unroll
        for (int i = 0; i < 8; ++i) g[i] = 0.f;
        v2u* o8 = (v2u*)(XN + (size_t)m * 1024) + lane;
#pragma unroll
        for (int j = 0; j < 4; ++j) {
            const f32x4 w = wr[64 * j];
            const float y[4] = {v[j].x * rstd * w.x, v[j].y * rstd * w.y, v[j].z * rstd * w.z, v[j].w * rstd * w.w};
            o8[64 * j] = (v2u){pk2(y[0], y[1]), pk2(y[2], y[3])};
#pragma unroll
            for (int q = 0; q < 4; ++q) {
                const int k = 256 * j + 4 * lane + q;
                const f32x4 w0 = *(const LAS f32x4*)(WG + k * 8), w1 = *(const LAS f32x4*)(WG + k * 8 + 4);
                g[0] += y[q] * w0.x; g[1] += y[q] * w0.y; g[2] += y[q] * w0.z; g[3] += y[q] * w0.w;
                g[4] += y[q] * w1.x; g[5] += y[q] * w1.y; g[6] += y[q] * w1.z; g[7] += y[q] * w1.w;
            }
        }
#pragma unroll
        for (int i = 0; i < 8; ++i) g[i] = wave_sum(g[i]);
        if (lane == 0) {
#pragma unroll
            for (int i = 0; i < 4; ++i) { IFG[(size_t)m * 8 + i] = g[i] + p.b_i[i]; IFG[(size_t)m * 8 + 4 + i] = g[4 + i] + p.b_f[i]; }
        }
    }
    {
        unsigned char* U8 = p.ws + WS_U8; unsigned char* V8 = p.ws + WS_V8; float* USC = (float*)(p.ws + WS_USC); float* VSC = (float*)(p.ws + WS_VSC);
        for (int e = gw; e < NEXP; e += NGW) {
            f32x4 v[2][4]; float am[2] = {0.f, 0.f};
#pragma unroll
            for (int which = 0; which < 2; ++which) {
                const float* src = (which ? p.peer_v : p.peer_u) + (size_t)e * 1024 + 16 * lane;
#pragma unroll
                for (int j = 0; j < 4; ++j) v[which][j] = *(const f32x4*)(src + 4 * j);
            }
#pragma unroll
            for (int which = 0; which < 2; ++which)
#pragma unroll
                for (int j = 0; j < 4; ++j) am[which] = fmaxf(am[which], fmaxf(fmaxf(fabsf(v[which][j].x), fabsf(v[which][j].y)), fmaxf(fabsf(v[which][j].z), fabsf(v[which][j].w))));
#pragma unroll
            for (int o = 1; o < 64; o <<= 1) { am[0] = fmaxf(am[0], __shfl_xor(am[0], o)); am[1] = fmaxf(am[1], __shfl_xor(am[1], o)); }
#pragma unroll
            for (int which = 0; which < 2; ++which) {
                const float sc = am[which] > 0.f ? exp2f(floorf(log2f(448.f / am[which]))) : 1.f;
                unsigned w[4];
#pragma unroll
                for (int j = 0; j < 4; ++j) { int t = __builtin_amdgcn_cvt_pk_fp8_f32(v[which][j].x * sc, v[which][j].y * sc, 0, false); t = __builtin_amdgcn_cvt_pk_fp8_f32(v[which][j].z * sc, v[which][j].w * sc, t, true); w[j] = (unsigned)t; }
                *(v4u*)((which ? V8 : U8) + ((size_t)(lane >> 3) * NEXP + e) * 128 + 16 * (lane & 7)) = (v4u){w[0], w[1], w[2], w[3]};
                if (lane == 0) (which ? VSC : USC)[e] = 1.f / sc;
            }
        }
    }
}

typedef short bf16x8 __attribute__((ext_vector_type(8)));
typedef float f32x16 __attribute__((ext_vector_type(16)));
typedef float f32x2_t __attribute__((ext_vector_type(2))); typedef __bf16 bf16x2_t __attribute__((ext_vector_type(2)));
__device__ __forceinline__ unsigned cvtpk(float lo, float hi) { f32x2_t v = {lo, hi}; bf16x2_t b = __builtin_convertvector(v, bf16x2_t); return __builtin_bit_cast(unsigned, b); }
#define MFMA32(a, b, c) __builtin_amdgcn_mfma_f32_32x32x16_bf16((a), (b), (c), 0, 0, 0)
__device__ __forceinline__ int crow(int reg, int hh) { return (reg & 3) + 8 * (reg >> 2) + 4 * hh; }
template <int S> __device__ __forceinline__ bf16x8 pack_step(const f32x16& x) {
    v4u p; p.x = cvtpk(x[8 * S], x[8 * S + 1]); p.y = cvtpk(x[8 * S + 2], x[8 * S + 3]); p.z = cvtpk(x[8 * S + 4], x[8 * S + 5]); p.w = cvtpk(x[8 * S + 6], x[8 * S + 7]);
    return __builtin_bit_cast(bf16x8, p);
}
__device__ __forceinline__ bf16x8 frag2(const v2u& lo, const v2u& hi) { v4u p; p.x = lo.x; p.y = lo.y; p.z = hi.x; p.w = hi.y; return __builtin_bit_cast(bf16x8, p); }
__device__ __forceinline__ f32x16 zero16() { f32x16 z; for (int i = 0; i < 16; ++i) z[i] = 0.f; return z; }


__device__ __forceinline__ void p2_conv(const P& p, int tid) {
    const bf16* MLQK = (const bf16*)(p.ws + WS_MLQK); bf16* QC = (bf16*)(p.ws + WS_QC); bf16* KC = (bf16*)(p.ws + WS_KC);
    const int cg = tid & 127, ch0 = 8 * cg;
    float cw[4][8], cb[8];
#pragma unroll
    for (int i = 0; i < 8; ++i) { cb[i] = p.conv_b[ch0 + i];
#pragma unroll
        for (int j = 0; j < 4; ++j) cw[j][i] = p.conv_w[j * 1024 + ch0 + i]; }
    const float osc = cg >= 64 ? 0.08838834764831845f : 1.f;
    bf16* dst = (cg >= 64 ? KC : QC) + (cg & 63) * 8;
    for (int rg = blockIdx.x * 4 + (tid >> 7); rg < T_ / 4; rg += gridDim.x * 4) {
        const int tok = rg * 4, pos0 = tok & (S_ - 1);
        v4u xr[7];
#pragma unroll
        for (int k = 0; k < 7; ++k) xr[k] = (pos0 + k - 3 >= 0) ? *(const v4u*)(MLQK + (size_t)(tok + k - 3) * 1024 + ch0) : (v4u){0u, 0u, 0u, 0u};
#pragma unroll
        for (int tt = 0; tt < 4; ++tt) {
            float y[8];
#pragma unroll
            for (int i = 0; i < 8; ++i) y[i] = cb[i];
#pragma unroll
            for (int j = 0; j < 4; ++j) { float f[8]; unpack8(xr[tt + j], f);
#pragma unroll
                for (int i = 0; i < 8; ++i) y[i] += cw[j][i] * f[i]; }
#pragma unroll
            for (int i = 0; i < 8; ++i) y[i] = y[i] * sigmoidf_(y[i]) * osc;
            *(v4u*)(dst + (size_t)(tok + tt) * 512) = pack8(y);
        }
    }
}

constexpr int ML_QS = 0, ML_KS = 17408, ML_KWT = 34816, ML_VTL = 53248, ML_PS = 71680, ML_CT = 80896, ML_SCAL = 115712, ML_SSP = 118272, ML_QN = ML_SSP + 512, ML_F1 = ML_QN + 256, ML_F2 = ML_F1 + 256, ML_NV = ML_F2 + 256;
static_assert(ML_NV + 512 <= RING_BYTES, "mLSTM LDS map");
__device__ __forceinline__ void mlstm_scal(float ip, float fp, LAS float* sc, float& m_carry, int lane) {
    const float lf = fminf(fp, 0.f) - log1pf(expf(-fabsf(fp)));
    float bc = lf;
#pragma unroll
    for (int o = 1; o < 64; o <<= 1) { const float t2 = __shfl_up(bc, o); if (lane >= o) bc += t2; }
    const float a = ip - bc; float pm = a;
#pragma unroll
    for (int o = 1; o < 64; o <<= 1) { const float t2 = __shfl_up(pm, o); if (lane >= o) pm = fmaxf(pm, t2); }
    const float M = fmaxf(m_carry, pm);
    const float M63 = __shfl(M, 63), bc63 = __shfl(bc, 63);
    sc[lane] = a; sc[64 + lane] = M; sc[128 + lane] = expf(a - M63); sc[192 + lane] = expf(m_carry - M); sc[256 + lane] = expf(-(bc + M));
    m_carry = bc63 + M63;
}
__device__ __forceinline__ void mlstm_item(const P& p, LAS unsigned char* lds, int item, int tid, int wave, int lane) {
    const int b = item >> 2, h = item & 3;
    const int r = lane & 31, hh = lane >> 5, et = wave & 3, th = wave >> 2;
    const bf16* QC = (const bf16*)(p.ws + WS_QC); const bf16* KC = (const bf16*)(p.ws + WS_KC); const bf16* MLV = (const bf16*)(p.ws + WS_MLV); const float* IFG = (const float*)(p.ws + WS_IFG);
    bf16* HML = (bf16*)p.out + (size_t)T_ * 512;
    LAS float* SCAL = (LAS float*)(lds + ML_SCAL); LAS float* SSP = (LAS float*)(lds + ML_SSP); LAS float* QN = (LAS float*)(lds + ML_QN);
    LAS float* F1 = (LAS float*)(lds + ML_F1); LAS float* F2 = (LAS float*)(lds + ML_F2); LAS float* NV = (LAS float*)(lds + ML_NV);
    const int cg = tid & 15, trow = tid >> 4, eg = cg, sl = trow;
    const size_t hq = (size_t)h * 128 + 8 * cg;
    for (int i = tid; i < (128 * 136 * 2) / 4; i += NTHR) ((LAS unsigned*)(lds + ML_CT))[i] = 0u;
    if (tid < 128) NV[tid] = 0.f;
    f32x16 accC[2]; accC[0] = zero16(); accC[1] = zero16();
    float m_carry = 0.f;
    if (wave == 3) { const size_t tk = (size_t)b * S_ + lane; mlstm_scal(IFG[tk * 8 + h], IFG[tk * 8 + 4 + h], SCAL, m_carry, lane); }
    v4u pq[2], pk[2], pv[2];
    {
        const size_t t0 = (size_t)b * S_;
#pragma unroll
        for (int u = 0; u < 2; ++u) { pq[u] = *(const v4u*)(QC + (t0 + trow + 32 * u) * 512 + hq); pk[u] = *(const v4u*)(KC + (t0 + trow + 32 * u) * 512 + hq); pv[u] = *(const v4u*)(MLV + (t0 + sl + 32 * u) * 512 + hq); }
    }
    float ipn = 0.f, fpn = 0.f;
    __syncthreads();
    for (int c = 0; c < 32; ++c) {
        const size_t tok0 = (size_t)b * S_ + c * 64;
        LAS float* sc = SCAL + (c & 1) * 320;
        {
#pragma unroll
            for (int u = 0; u < 2; ++u) {
                const int t = trow + 32 * u;
                *(LAS v4u*)(lds + ML_QS + t * 272 + cg * 16) = pq[u];
                *(LAS v4u*)(lds + ML_KS + t * 272 + cg * 16) = pk[u];
                float f[8]; unpack8(pk[u], f);
                const float wk = sc[128 + t];
#pragma unroll
                for (int i = 0; i < 8; ++i) *(LAS bf16*)(lds + ML_KWT + (8 * cg + i) * 144 + ((t ^ (8 * (cg & 7))) * 2)) = (bf16)f2bf(f[i] * wk);
                const unsigned vv[4] = {pv[u].x, pv[u].y, pv[u].z, pv[u].w};
#pragma unroll
                for (int i = 0; i < 4; ++i) {
                    *(LAS bf16*)(lds + ML_VTL + (8 * eg + 2 * i) * 144 + ((t ^ (8 * (eg & 7))) * 2)) = (bf16)(vv[i] & 0xffffu);
                    *(LAS bf16*)(lds + ML_VTL + (8 * eg + 2 * i + 1) * 144 + ((t ^ (8 * (eg & 7))) * 2)) = (bf16)(vv[i] >> 16);
                }
            }
            if (c + 1 < 32) {
                const size_t t1 = tok0 + 64;
#pragma unroll
                for (int u = 0; u < 2; ++u) { pq[u] = *(const v4u*)(QC + (t1 + trow + 32 * u) * 512 + hq); pk[u] = *(const v4u*)(KC + (t1 + trow + 32 * u) * 512 + hq); pv[u] = *(const v4u*)(MLV + (t1 + sl + 32 * u) * 512 + hq); }
                if (wave == 3) { ipn = IFG[(t1 + lane) * 8 + h]; fpn = IFG[(t1 + lane) * 8 + 4 + h]; }
            }
        }
        __syncthreads();
        f32x16 acc_inter = zero16();
        if (wave < 3) {
            const int tt = wave > 0 ? 1 : 0, st = wave == 2 ? 1 : 0;
            f32x16 zt = zero16();
#pragma unroll
            for (int ks = 0; ks < 8; ++ks) {
                const bf16x8 ka = *(const LAS bf16x8*)(lds + ML_KS + (32 * st + r) * 272 + 32 * ks + 16 * hh);
                const bf16x8 qb = *(const LAS bf16x8*)(lds + ML_QS + (32 * tt + r) * 272 + 32 * ks + 16 * hh);
                zt = MFMA32(ka, qb, zt);
            }
            const int t = 32 * tt + r; const float Mt = sc[64 + t];
            float ps = 0.f;
#pragma unroll
            for (int g = 0; g < 4; ++g) {
                const f32x4 av = *(const LAS f32x4*)(sc + 32 * st + 8 * g + 4 * hh);
                float pv[4];
#pragma unroll
                for (int q = 0; q < 4; ++q) { const int sidx = 32 * st + 8 * g + 4 * hh + q;
                    const float wgt = sidx <= t ? expf(av[q] - Mt) : 0.f; pv[q] = zt[4 * g + q] * wgt; ps += pv[q]; }
                *(LAS v2u*)(lds + ML_PS + t * 144 + (32 * st + 8 * g + 4 * hh) * 2) = (v2u){cvtpk(pv[0], pv[1]), cvtpk(pv[2], pv[3])};
            }
            ps += __shfl_xor(ps, 32);
            if (hh == 0) { SSP[st * 64 + t] = ps; if (wave == 0) SSP[64 + t] = 0.f; }
        }
        if (wave == 3 && c + 1 < 32) mlstm_scal(ipn, fpn, SCAL + ((c + 1) & 1) * 320, m_carry, lane);
#pragma unroll
        for (int ks = 0; ks < 8; ++ks) {
            const bf16x8 qa = *(const LAS bf16x8*)(lds + ML_QS + (32 * th + r) * 272 + 32 * ks + 16 * hh);
            const bf16x8 cbf = *(const LAS bf16x8*)(lds + ML_CT + (32 * et + r) * 272 + 32 * ks + 16 * hh);
            acc_inter = MFMA32(qa, cbf, acc_inter);
        }
        {
            const int t = tid >> 3, part = tid & 7;
            float f[8], sum = 0.f;
            { const v4u tq = *(const LAS v4u*)(lds + ML_QS + t * 272 + part * 32); unpack8(tq, f); }
#pragma unroll
            for (int i = 0; i < 8; ++i) sum += f[i] * NV[16 * part + i];
            { const v4u tq = *(const LAS v4u*)(lds + ML_QS + t * 272 + part * 32 + 16); unpack8(tq, f); }
#pragma unroll
            for (int i = 0; i < 8; ++i) sum += f[i] * NV[16 * part + 8 + i];
            sum += __shfl_xor(sum, 1); sum += __shfl_xor(sum, 2); sum += __shfl_xor(sum, 4);
            if (part == 0) QN[t] = sum;
        }
        __syncthreads();
        f32x16 acc_intra = zero16();
#pragma unroll
        for (int ks = 0; ks < 4; ++ks) {
            if (ks < 2 || th == 1) {
                const bf16x8 pa = *(const LAS bf16x8*)(lds + ML_PS + (32 * th + r) * 144 + 32 * ks + 16 * hh);
                const bf16x8 vb = *(const LAS bf16x8*)(lds + ML_VTL + (32 * et + r) * 144 + 16 * ((2 * ks + hh) ^ (((32 * et + r) >> 3) & 7)));
                acc_intra = MFMA32(pa, vb, acc_intra);
            }
        }
        if (tid < 64) {
            const float wi = sc[192 + tid];
            const float den = SSP[tid] + SSP[64 + tid] + wi * QN[tid];
            const float f1 = 1.f / fmaxf(fabsf(den), sc[256 + tid]);
            F1[tid] = f1; F2[tid] = wi * f1;
        }
        const float decay = sc[192 + 63];
#pragma unroll
        for (int dt = 0; dt < 2; ++dt) {
#pragma unroll
            for (int i = 0; i < 16; ++i) accC[dt][i] *= decay;
#pragma unroll
            for (int ks = 0; ks < 4; ++ks) {
                const bf16x8 ka = *(const LAS bf16x8*)(lds + ML_KWT + (64 * th + 32 * dt + r) * 144 + 16 * ((2 * ks + hh) ^ (((64 * th + 32 * dt + r) >> 3) & 7)));
                const bf16x8 vb = *(const LAS bf16x8*)(lds + ML_VTL + (32 * et + r) * 144 + 16 * ((2 * ks + hh) ^ (((32 * et + r) >> 3) & 7)));
                accC[dt] = MFMA32(ka, vb, accC[dt]);
            }
        }
        {
            const int d = tid >> 2, part = tid & 3;
            float f[8], sum = 0.f;
            { const v4u tq = *(const LAS v4u*)(lds + ML_KWT + d * 144 + part * 32); unpack8(tq, f); }
#pragma unroll
            for (int i = 0; i < 8; ++i) sum += f[i];
            { const v4u tq = *(const LAS v4u*)(lds + ML_KWT + d * 144 + part * 32 + 16); unpack8(tq, f); }
#pragma unroll
            for (int i = 0; i < 8; ++i) sum += f[i];
            sum += __shfl_xor(sum, 1); sum += __shfl_xor(sum, 2);
            if (part == 0) NV[d] = decay * NV[d] + sum;
        }
        __syncthreads();
        {
            bf16* hp = HML + (tok0 + 32 * th) * 512 + h * 128 + 32 * et + r;
#pragma unroll
            for (int g = 0; g < 4; ++g) {
                const f32x4 f1v = *(const LAS f32x4*)(F1 + 32 * th + 8 * g + 4 * hh), f2v = *(const LAS f32x4*)(F2 + 32 * th + 8 * g + 4 * hh);
#pragma unroll
                for (int q = 0; q < 4; ++q) { const int tl = 8 * g + 4 * hh + q;
                    hp[(size_t)tl * 512] = (bf16)f2bf(acc_intra[4 * g + q] * f1v[q] + acc_inter[4 * g + q] * f2v[q]); }
            }
#pragma unroll
            for (int dt = 0; dt < 2; ++dt)
#pragma unroll
                for (int g = 0; g < 4; ++g)
                    *(LAS v2u*)(lds + ML_CT + (32 * et + r) * 272 + (64 * th + 32 * dt + 8 * g + 4 * hh) * 2) = (v2u){cvtpk(accC[dt][4 * g], accC[dt][4 * g + 1]), cvtpk(accC[dt][4 * g + 2], accC[dt][4 * g + 3])};
        }
    }
    __syncthreads();
}

__device__ __forceinline__ void sba_wave_item(const bf16* __restrict__ QK, const bf16* __restrict__ VT, bf16* __restrict__ YSB, int b, int h, int qt, int lane) {
    const int r = lane & 31, hh = lane >> 5, t0 = qt * 32;
    const size_t rowbase = (size_t)b * S_;
    bf16x8 qf[4];
    {
        const bf16* qp = QK + (rowbase + t0 + r) * 1024 + h * 64 + 8 * hh;
#pragma unroll
        for (int ks = 0; ks < 4; ++ks) qf[ks] = *(const bf16x8*)(qp + 16 * ks);
    }
    bf16x8 tri[2];
#pragma unroll
    for (int s2 = 0; s2 < 2; ++s2)
#pragma unroll
        for (int j = 0; j < 8; ++j) { const int rho = 16 * s2 + 8 * (j >> 2) + 4 * hh + (j & 3); tri[s2][j] = (rho > r) ? (short)0x3F80 : (short)0; }
    f32x16 o0 = zero16(), o1 = zero16();
    float carry = 0.f;
    const bf16* kbase = QK + rowbase * 1024 + 512 + h * 64 + 8 * hh + (size_t)r * 1024;
    const bf16* vbase = VT + ((size_t)(b * 8 + h) * 64 + r) * 2048 + 4 * hh;
    bf16x8 kf[4]; v2u vl[2][2], vh[2][2];
#pragma unroll
    for (int ks = 0; ks < 4; ++ks) kf[ks] = *(const bf16x8*)(kbase + (size_t)t0 * 1024 + 16 * ks);
#pragma unroll
    for (int dt = 0; dt < 2; ++dt)
#pragma unroll
        for (int s2 = 0; s2 < 2; ++s2) { const bf16* vp = vbase + (size_t)dt * 32 * 2048 + t0 + 16 * s2; vl[dt][s2] = *(const v2u*)vp; vh[dt][s2] = *(const v2u*)(vp + 8); }
    for (int s0 = t0; s0 >= 0; s0 -= 32) {
        bf16x8 kn[4]; v2u vln[2][2], vhn[2][2];
        const int sn = s0 >= 32 ? s0 - 32 : 0;
#pragma unroll
        for (int ks = 0; ks < 4; ++ks) kn[ks] = *(const bf16x8*)(kbase + (size_t)sn * 1024 + 16 * ks);
#pragma unroll
        for (int dt = 0; dt < 2; ++dt)
#pragma unroll
            for (int s2 = 0; s2 < 2; ++s2) { const bf16* vp = vbase + (size_t)dt * 32 * 2048 + sn + 16 * s2; vln[dt][s2] = *(const v2u*)vp; vhn[dt][s2] = *(const v2u*)(vp + 8); }
        f32x16 z = zero16();
#pragma unroll
        for (int ks = 0; ks < 4; ++ks) z = MFMA32(kf[ks], qf[ks], z);
        const bool diag = (s0 == t0);
        f32x16 sp; float rs = 0.f;
#pragma unroll
        for (int i = 0; i < 16; ++i) {
            const float zz = z[i] * 0.125f;
            const bool valid = !diag || (crow(i, hh) < r);
            float spv = fmaxf(zz, 0.f) + __logf(1.f + __expf(-fabsf(zz)));
            spv = valid ? spv : 0.f;
            sp[i] = spv; rs += spv; z[i] = zz - spv;
        }
        f32x16 suf = zero16();
        suf = MFMA32(tri[0], pack_step<0>(sp), suf);
        suf = MFMA32(tri[1], pack_step<1>(sp), suf);
        f32x16 w;
#pragma unroll
        for (int i = 0; i < 16; ++i) {
            const bool valid = !diag || (crow(i, hh) < r);
            const float lw = z[i] - suf[i] - carry;
            w[i] = valid ? __expf(lw) : 0.f;
        }
        rs += __shfl_xor(rs, 32);
        carry += rs;
        const bf16x8 pa0 = pack_step<0>(w), pa1 = pack_step<1>(w);
        o0 = MFMA32(pa0, frag2(vl[0][0], vh[0][0]), o0); o0 = MFMA32(pa1, frag2(vl[0][1], vh[0][1]), o0);
        o1 = MFMA32(pa0, frag2(vl[1][0], vh[1][0]), o1); o1 = MFMA32(pa1, frag2(vl[1][1], vh[1][1]), o1);
        if (__all(carry > 104.f)) break;
#pragma unroll
        for (int ks = 0; ks < 4; ++ks) kf[ks] = kn[ks];
#pragma unroll
        for (int dt = 0; dt < 2; ++dt)
#pragma unroll
            for (int s2 = 0; s2 < 2; ++s2) { vl[dt][s2] = vln[dt][s2]; vh[dt][s2] = vhn[dt][s2]; }
    }
    bf16* op = YSB + (rowbase + t0) * 512 + h * 64 + r;
#pragma unroll
    for (int i = 0; i < 16; ++i) { const int t = crow(i, hh); op[(size_t)t * 512] = (bf16)f2bf(o0[i]); op[(size_t)t * 512 + 32] = (bf16)f2bf(o1[i]); }
}
__device__ __forceinline__ void sba_item(const P& p, int item, int wave, int lane) {
    const int bh = item >> 3, qb = item & 7, b = bh >> 3, h = bh & 7;
    sba_wave_item((const bf16*)(p.ws + WS_SBQKV), (const bf16*)(p.ws + WS_VT), (bf16*)p.out, b, h, qb * 8 + wave, lane);
}

__device__ __forceinline__ void p3_yml(const P& p, int wave, int lane) {
    const int gw = blockIdx.x * NWAVES + wave, NGW = gridDim.x * NWAVES;
    bf16* YML = (bf16*)p.out + (size_t)T_ * 512; const bf16* MLO = (const bf16*)(p.ws + WS_MLO);
    for (int m = gw; m < T_; m += NGW) {
        float hv[8], ov[8], o[8];
        unpack8(*(const v4u*)(YML + (size_t)m * 512 + lane * 8), hv); unpack8(*(const v4u*)(MLO + (size_t)m * 512 + lane * 8), ov);
        float ss = 0.f;
#pragma unroll
        for (int i = 0; i < 8; ++i) ss += hv[i] * hv[i];
        ss += __shfl_xor(ss, 1); ss += __shfl_xor(ss, 2); ss += __shfl_xor(ss, 4); ss += __shfl_xor(ss, 8);
        const float rstd = 1.f / sqrtf(ss * (1.f / 128.f) + EPS);
        const f32x4 w0 = *(const f32x4*)(p.ml_norm_w + lane * 8), w1 = *(const f32x4*)(p.ml_norm_w + lane * 8 + 4);
        const float wv[8] = {w0.x, w0.y, w0.z, w0.w, w1.x, w1.y, w1.z, w1.w};
#pragma unroll
        for (int i = 0; i < 8; ++i) o[i] = sigmoidf_(ov[i]) * hv[i] * rstd * wv[i];
        *(v4u*)(YML + (size_t)m * 512 + lane * 8) = pack8(o);
    }
}

__device__ __forceinline__ void p6_hn(const P& p, int wave, int lane) {
    const int gw = blockIdx.x * NWAVES + wave, NGW = gridDim.x * NWAVES;
    const float* H = (const float*)(p.ws + WS_H); bf16* HN = (bf16*)(p.ws + WS_HN);
    for (int m = gw; m < T_; m += NGW) {
        const f32x4* xr = (const f32x4*)(H + (size_t)m * 1024) + lane; const f32x4* wr = (const f32x4*)p.norm_ffn_w + lane;
        f32x4 v[4]; float ss = 0.f;
#pragma unroll
        for (int j = 0; j < 4; ++j) { v[j] = xr[64 * j]; ss += (v[j].x * v[j].x + v[j].y * v[j].y) + (v[j].z * v[j].z + v[j].w * v[j].w); }
        const float rstd = 1.f / sqrtf(wave_sum(ss) * (1.f / 1024.f) + EPS);
        v2u* o8 = (v2u*)(HN + (size_t)m * 1024) + lane;
#pragma unroll
        for (int j = 0; j < 4; ++j) { const f32x4 w = wr[64 * j]; o8[64 * j] = (v2u){pk2(v[j].x * rstd * w.x, v[j].y * rstd * w.y), pk2(v[j].z * rstd * w.z, v[j].w * rstd * w.w)}; }
    }
}

__device__ __forceinline__ float ffn_rstd(const float* SS, int m) {
    const f32x4* q = (const f32x4*)(SS + (size_t)m * 16); const f32x4 a = q[0], b = q[1], c = q[2], d = q[3];
    const float t = ((a.x + a.y) + (a.z + a.w)) + ((b.x + b.y) + (b.z + b.w)) + ((c.x + c.y) + (c.z + c.w)) + ((d.x + d.y) + (d.z + d.w));
    return 1.f / sqrtf(t * (1.f / 1024.f) + EPS);
}
__device__ __forceinline__ unsigned ord_key(float f) { const unsigned u = __builtin_bit_cast(unsigned, f); return (u & 0x80000000u) ? ~u : (u | 0x80000000u); }
__device__ __forceinline__ float ord_val(unsigned k) { const unsigned u = (k & 0x80000000u) ? (k & 0x7fffffffu) : ~k; return __builtin_bit_cast(float, u); }
template <int CTRL> __device__ __forceinline__ unsigned dpp_u(unsigned v) { return (unsigned)__builtin_amdgcn_update_dpp(0, (int)v, CTRL, 0xF, 0xF, true); }
__device__ __forceinline__ unsigned umax_(unsigned a, unsigned b) { return a > b ? a : b; }
__device__ __forceinline__ unsigned umin_(unsigned a, unsigned b) { return a < b ? a : b; }
__device__ __forceinline__ unsigned row_max_u(unsigned v) {
    v = umax_(v, dpp_u<0xB1>(v)); v = umax_(v, dpp_u<0x4E>(v)); v = umax_(v, dpp_u<0x141>(v)); v = umax_(v, dpp_u<0x140>(v)); return v;
}
__device__ __forceinline__ float row_sum_f(float v) {
    v += __builtin_bit_cast(float, dpp_u<0xB1>(__builtin_bit_cast(unsigned, v))); v += __builtin_bit_cast(float, dpp_u<0x4E>(__builtin_bit_cast(unsigned, v)));
    v += __builtin_bit_cast(float, dpp_u<0x141>(__builtin_bit_cast(unsigned, v))); v += __builtin_bit_cast(float, dpp_u<0x140>(__builtin_bit_cast(unsigned, v))); return v;
}
#define CE_(i, j) do { const unsigned _a = k[i], _b = k[j]; k[i] = umax_(_a, _b); k[j] = umin_(_a, _b); } while (0)
__device__ __forceinline__ unsigned row_top16(unsigned (&k)[8], unsigned (&top)[16], int li) {
    CE_(0, 1); CE_(2, 3); CE_(4, 5); CE_(6, 7); CE_(0, 2); CE_(1, 3); CE_(4, 6); CE_(5, 7); CE_(1, 2); CE_(5, 6);
    CE_(0, 4); CE_(1, 5); CE_(2, 6); CE_(3, 7); CE_(2, 4); CE_(3, 5); CE_(1, 2); CE_(3, 4); CE_(5, 6);
    unsigned mine = 0u;
#pragma unroll
    for (int n = 0; n < 16; ++n) {
        const unsigned m = row_max_u(k[0]);
        const bool hit = k[0] == m;
#pragma unroll
        for (int i = 0; i < 7; ++i) k[i] = hit ? k[i + 1] : k[i];
        k[7] = hit ? 0u : k[7];
        top[n] = m; mine = (li == n) ? m : mine;
    }
    return mine;
}
__device__ __forceinline__ void topk_core(const float (&s1)[8], const float (&s2)[8], float rstd, int li, int lane, int& e_out, float& g_out) {
    unsigned k[8], top1[16], top2[16];
#pragma unroll
    for (int j = 0; j < 8; ++j) k[j] = (ord_key(s1[j]) & ~0x7fu) | (unsigned)(127 - (li + 16 * j));
    const unsigned mine1 = row_top16(k, top1, li);
#pragma unroll
    for (int j = 0; j < 8; ++j) k[j] = (ord_key(s2[j]) & ~0x7fu) | (unsigned)(127 - (li + 16 * j));
    const unsigned mine2 = row_top16(k, top2, li);
    const float v2 = ord_val(mine2 & ~0x7fu);
    unsigned c[16];
#pragma unroll
    for (int j = 0; j < 16; ++j) {
        const float v1 = ord_val(top1[j] & ~0x7fu);
        const unsigned key = (ord_key(v1 + v2) & ~0xffu) | (unsigned)(255 - (16 * j + li));
        c[j] = ((j + 1) * (li + 1) <= 16) ? key : 0u;
    }
    unsigned tk = 0u, t0 = 0u;
#pragma unroll
    for (int n = 0; n < 16; ++n) {
        const unsigned mx = row_max_u(c[0]);
        const bool hit = c[0] == mx;
#pragma unroll
        for (int i = 0; i < 15; ++i) c[i] = hit ? c[i + 1] : c[i];
        c[15] = hit ? 0u : c[15];
        if (n == 0) t0 = mx;
        tk = (li == n) ? mx : tk;
    }
    const float sv = ord_val(tk & ~0xffu), s0 = ord_val(t0 & ~0xffu);
    const int cc = 255 - (int)(tk & 0xffu), a = (cc >> 4) & 15, bb = cc & 15;
    const int i1 = 127 - (int)((unsigned)__shfl((int)mine1, (lane & 48) + a) & 0x7fu), i2 = 127 - (int)((unsigned)__shfl((int)mine2, (lane & 48) + bb) & 0x7fu);
    const float pe = expf((sv - s0) * rstd);
    const float den = row_sum_f(pe);
    e_out = i1 * 128 + i2; g_out = pe / den;
}
constexpr int TK_RS = 1040;
struct EpiTopk {
    static constexpr bool PERM = true, AFTER_DRAIN = true;
    int* IDX; float* GATE; const float* SS;
    __device__ __forceinline__ void fused(pg8::f32x4 (&acc)[2][2][4][2], const pg8::Unit& u, int wr, int wc, int fr, int fq, PG8_LAS unsigned char* lds, int wid, int lane) const {
        const int head = u.pn, q = lane >> 4, li = lane & 15;
#pragma unroll
        for (int ai = 0; ai < 2; ++ai) {
#pragma unroll
            for (int m = 0; m < 4; ++m)
#pragma unroll
                for (int bj = 0; bj < 2; ++bj) {
                    PG8_LAS unsigned char* dst = lds + (wr * 64 + m * 16 + fr) * TK_RS + (bj * 128 + wc * 32 + 8 * fq) * 4;
                    *(PG8_LAS pg8::f32x4*)dst = acc[ai][bj][m][0]; *(PG8_LAS pg8::f32x4*)(dst + 16) = acc[ai][bj][m][1];
                }
            __syncthreads();
#pragma unroll 1
            for (int it = 0; it < 4; ++it) {
                const int rowl = 16 * wid + 4 * it + q, m = u.pm * 256 + ai * 128 + rowl;
                const PG8_LAS float* sr = (const PG8_LAS float*)(lds + rowl * TK_RS);
                float s1[8], s2[8];
#pragma unroll
                for (int j = 0; j < 8; ++j) { s1[j] = sr[li + 16 * j]; s2[j] = sr[128 + li + 16 * j]; }
                int e; float g;
                topk_core(s1, s2, ffn_rstd(SS, m), li, lane, e, g);
                IDX[(size_t)m * 128 + head * 16 + li] = e; GATE[(size_t)m * 128 + head * 16 + li] = g;
            }
            __syncthreads();
        }
    }
};
struct OneUnit {
    pg8::Unit u;
    __device__ __forceinline__ bool next(int i, pg8::Unit& o) const { if (i) return false; o = u; return true; }
    __device__ __forceinline__ void a_ready(const pg8::Unit&) const {}
    __device__ __forceinline__ void done(const pg8::Unit&) const {}
};

__device__ __forceinline__ float gelu_erf(float x) { return 0.5f * x * (1.f + erff(x * 0.70710678118654752f)); }
typedef float f32x2 __attribute__((ext_vector_type(2)));
__device__ __forceinline__ void cvt16_fp8(const v4u& w, f32x2 (&f)[8]) {
    f[0] = __builtin_amdgcn_cvt_pk_f32_fp8((int)w.x, false); f[1] = __builtin_amdgcn_cvt_pk_f32_fp8((int)w.x, true);
    f[2] = __builtin_amdgcn_cvt_pk_f32_fp8((int)w.y, false); f[3] = __builtin_amdgcn_cvt_pk_f32_fp8((int)w.y, true);
    f[4] = __builtin_amdgcn_cvt_pk_f32_fp8((int)w.z, false); f[5] = __builtin_amdgcn_cvt_pk_f32_fp8((int)w.z, true);
    f[6] = __builtin_amdgcn_cvt_pk_f32_fp8((int)w.w, false); f[7] = __builtin_amdgcn_cvt_pk_f32_fp8((int)w.w, true);
}
__device__ __forceinline__ float grp8_sum(float v) {
    v += __builtin_bit_cast(float, dpp_u<0xB1>(__builtin_bit_cast(unsigned, v)));
    v += __builtin_bit_cast(float, dpp_u<0x4E>(__builtin_bit_cast(unsigned, v)));
    v += __builtin_bit_cast(float, dpp_u<0x141>(__builtin_bit_cast(unsigned, v)));
    return v;
}
typedef int i32x4 __attribute__((ext_vector_type(4)));
template <int PAT> __device__ __forceinline__ float swz_f(float v) { return __builtin_bit_cast(float, __builtin_amdgcn_ds_swizzle(__builtin_bit_cast(int, v), PAT)); }
__device__ __forceinline__ void peer_u_token(const v4u (&ur)[16], const f32x2 (&xv)[8], float* dst, int c8) {
    float d[16];
#pragma unroll
    for (int i = 0; i < 16; ++i) {
        f32x2 f[8]; cvt16_fp8(ur[i], f);
        f32x2 s2 = f[0] * xv[0];
#pragma unroll
        for (int q = 1; q < 8; ++q) s2 += f[q] * xv[q];
        d[i] = s2.x + s2.y;
    }
    const bool b0 = (c8 & 1) != 0, b1 = (c8 & 2) != 0, b2 = (c8 & 4) != 0;
    float e8[8], e4[4], e2[2];
#pragma unroll
    for (int i = 0; i < 8; ++i) { const float keep = b0 ? d[2 * i + 1] : d[2 * i], send = b0 ? d[2 * i] : d[2 * i + 1];
        e8[i] = keep + __builtin_bit_cast(float, dpp_u<0xB1>(__builtin_bit_cast(unsigned, send))); }
#pragma unroll
    for (int i = 0; i < 4; ++i) { const float keep = b1 ? e8[2 * i + 1] : e8[2 * i], send = b1 ? e8[2 * i] : e8[2 * i + 1];
        e4[i] = keep + __builtin_bit_cast(float, dpp_u<0x4E>(__builtin_bit_cast(unsigned, send))); }
#pragma unroll
    for (int i = 0; i < 2; ++i) { const float keep = b2 ? e4[2 * i + 1] : e4[2 * i], send = b2 ? e4[2 * i] : e4[2 * i + 1];
        e2[i] = keep + swz_f<0x1F | (4 << 10)>(send); }
    dst[c8] = e2[0]; dst[c8 + 8] = e2[1];
}
__device__ __forceinline__ void peer_u(const P& p, int wave, int lane) {
    const int j = blockIdx.x & 7, nchunk = gridDim.x >> 3, chunk = blockIdx.x >> 3, stride = nchunk * 8;
    const int g = lane >> 3, c8 = lane & 7;
    const bf16* HN = (const bf16*)p.out + 128 * j + 16 * c8; const int* IDX = (const int*)(p.ws + WS_IDX) + 16 * g;
    const unsigned char* US = p.ws + WS_U8 + (size_t)j * NEXP * 128 + 16 * c8;
    float* PART = (float*)(p.ws + WS_PART) + (size_t)j * T_ * 128 + 16 * g;
    const int m0 = chunk * 8 + wave, ntok = (T_ - m0 + stride - 1) / stride;
#define PU_CLAMP(k) (m0 + ((k) < ntok ? (k) : ntok - 1) * stride)
#define PU_ROWS(ur, ei) _Pragma("unroll") for (int i = 0; i < 16; ++i) ur[i] = *(const v4u*)(US + (size_t)ei[i >> 2][i & 3] * 128)
#define PU_L1(ei, h0, h1, mm) do { _Pragma("unroll") for (int q = 0; q < 4; ++q) ei[q] = *(const i32x4*)(IDX + (size_t)(mm) * 128 + 4 * q); \
        h0 = *(const v4u*)(HN + (size_t)(mm) * 1024); h1 = *(const v4u*)(HN + (size_t)(mm) * 1024 + 8); } while (0)
#define PU_X(xv, h0, h1) do { float f_[8]; unpack8(h0, f_); _Pragma("unroll") for (int i = 0; i < 4; ++i) xv[i] = (f32x2){f_[2 * i], f_[2 * i + 1]}; \
        unpack8(h1, f_); _Pragma("unroll") for (int i = 0; i < 4; ++i) xv[4 + i] = (f32x2){f_[2 * i], f_[2 * i + 1]}; } while (0)
    i32x4 ei[4]; v4u hA0, hA1, hB0, hB1; v4u urA[16], urB[16]; f32x2 xv[8];
    PU_L1(ei, hA0, hA1, m0);
    PU_ROWS(urA, ei);
    PU_L1(ei, hB0, hB1, PU_CLAMP(1));
    for (int k = 0; k < ntok; k += 2) {
        PU_ROWS(urB, ei);
        PU_X(xv, hA0, hA1);
        PU_L1(ei, hA0, hA1, PU_CLAMP(k + 2));
        peer_u_token(urA, xv, PART + (size_t)(m0 + k * stride) * 128, c8);
        if (k + 1 < ntok) {
            PU_ROWS(urA, ei);
            PU_X(xv, hB0, hB1);
            PU_L1(ei, hB0, hB1, PU_CLAMP(k + 3));
            peer_u_token(urB, xv, PART + (size_t)(m0 + (k + 1) * stride) * 128, c8);
        }
    }
#undef PU_CLAMP
#undef PU_ROWS
#undef PU_L1
#undef PU_X
}
__device__ __forceinline__ void peer_c(const P& p, int wave, int lane) {
    const int gw = blockIdx.x * NWAVES + wave, NGW = gridDim.x * NWAVES;
    const int* IDX = (const int*)(p.ws + WS_IDX); const float* GATE = (const float*)(p.ws + WS_GATE); const float* PART = (const float*)(p.ws + WS_PART);
    const float* USC = (const float*)(p.ws + WS_USC); const float* VSC = (const float*)(p.ws + WS_VSC); float* COEF = (float*)(p.ws + WS_COEF); const float* SS = (const float*)(p.ws + WS_SS);
    for (int m = gw; m < T_; m += NGW) {
        const float rs = ffn_rstd(SS, m);
        float s0 = 0.f, s1 = 0.f;
#pragma unroll
        for (int jj = 0; jj < 8; ++jj) { s0 += PART[((size_t)jj * T_ + m) * 128 + lane]; s1 += PART[((size_t)jj * T_ + m) * 128 + 64 + lane]; }
        const int e0 = IDX[(size_t)m * 128 + lane], e1 = IDX[(size_t)m * 128 + 64 + lane];
        const float g0 = GATE[(size_t)m * 128 + lane], g1 = GATE[(size_t)m * 128 + 64 + lane];
        COEF[(size_t)m * 128 + lane] = g0 * gelu_erf(s0 * rs * USC[e0]) * VSC[e0];
        COEF[(size_t)m * 128 + 64 + lane] = g1 * gelu_erf(s1 * rs * USC[e1]) * VSC[e1];
    }
}
struct PvPre { i32x4 ei[4]; float c0, c1; };
__device__ __forceinline__ void pv_level1(PvPre& q, const int* IDXg, const float* COEFg, int m, int c8) {
#pragma unroll
    for (int k = 0; k < 4; ++k) q.ei[k] = *(const i32x4*)(IDXg + (size_t)m * 128 + 4 * k);
    q.c0 = COEFg[(size_t)m * 128 + c8]; q.c1 = COEFg[(size_t)m * 128 + c8 + 8];
}
__device__ __forceinline__ void peer_v_token(const v4u (&vr)[16], float coef0, float coef1, const float* H, float* out, float* ssq, bool b3, bool b4, bool b5, int lane) {
    f32x2 acc[8];
#pragma unroll
    for (int i = 0; i < 8; ++i) acc[i] = (f32x2){0.f, 0.f};
#define PV_STEP(I) do { const float cs_ = ((I) >> 3) ? coef1 : coef0; \
        const float cu_ = swz_f<0x18 | (((I) & 7) << 5)>(cs_);     \
        const f32x2 c2_ = (f32x2){cu_, cu_}; f32x2 f_[8]; cvt16_fp8(vr[I], f_); \
        _Pragma("unroll") for (int q = 0; q < 8; ++q) acc[q] += c2_ * f_[q]; } while (0)
    PV_STEP(0); PV_STEP(1); PV_STEP(2); PV_STEP(3); PV_STEP(4); PV_STEP(5); PV_STEP(6); PV_STEP(7);
    PV_STEP(8); PV_STEP(9); PV_STEP(10); PV_STEP(11); PV_STEP(12); PV_STEP(13); PV_STEP(14); PV_STEP(15);
#undef PV_STEP
    f32x2 a1[4], a2[2], a3;
#pragma unroll
    for (int i = 0; i < 4; ++i) { const f32x2 keep = b5 ? acc[2 * i + 1] : acc[2 * i], send = b5 ? acc[2 * i] : acc[2 * i + 1];
        a1[i] = keep + (f32x2){__shfl_xor(send.x, 32), __shfl_xor(send.y, 32)}; }
#pragma unroll
    for (int i = 0; i < 2; ++i) { const f32x2 keep = b4 ? a1[2 * i + 1] : a1[2 * i], send = b4 ? a1[2 * i] : a1[2 * i + 1];
        a2[i] = keep + (f32x2){swz_f<0x1F | (16 << 10)>(send.x), swz_f<0x1F | (16 << 10)>(send.y)}; }
    { const f32x2 keep = b3 ? a2[1] : a2[0], send = b3 ? a2[0] : a2[1]; a3 = keep + (f32x2){swz_f<0x1F | (8 << 10)>(send.x), swz_f<0x1F | (8 << 10)>(send.y)}; }
    const f32x2 hv = *(const f32x2*)H;
    const f32x2 y = hv + a3;
    *(f32x2*)out = y;
    const float ss = wave_sum(y.x * y.x + y.y * y.y);
    if (lane == 0) *ssq = ss;
}
__device__ __forceinline__ void peer_v(const P& p, int wave, int lane) {
    const int j = blockIdx.x & 7, nchunk = gridDim.x >> 3, chunk = blockIdx.x >> 3, stride = nchunk * 8;
    const int g = lane >> 3, c8 = lane & 7;
    const bool b5 = (lane & 32) != 0, b4 = (lane & 16) != 0, b3 = (lane & 8) != 0;
    const int pi = 4 * (b3 ? 1 : 0) + 2 * (b4 ? 1 : 0) + (b5 ? 1 : 0);
    const size_t colo = 128 * j + 16 * c8 + 2 * pi;
    const float* H = (const float*)(p.ws + WS_H) + colo; float* OUT = p.out + colo;
    const int* IDXg = (const int*)(p.ws + WS_IDX) + 16 * g; const float* COEFg = (const float*)(p.ws + WS_COEF) + 16 * g;
    const unsigned char* VS = p.ws + WS_V8 + (size_t)j * NEXP * 128 + 16 * c8;
    float* SSQ = (float*)(p.ws + WS_SSQ) + (size_t)j * T_;
    const int m0 = chunk * 8 + wave, ntok = (T_ - m0 + stride - 1) / stride;
#define PV_CLAMP(k) (m0 + ((k) < ntok ? (k) : ntok - 1) * stride)
#define PV_ROWS(vr, q) _Pragma("unroll") for (int i = 0; i < 16; ++i) vr[i] = *(const v4u*)(VS + (size_t)q.ei[i >> 2][i & 3] * 128)
    PvPre q; v4u vrA[16], vrB[16];
    pv_level1(q, IDXg, COEFg, m0, c8);
    PV_ROWS(vrA, q);
    float cA0 = q.c0, cA1 = q.c1, cB0, cB1;
    pv_level1(q, IDXg, COEFg, PV_CLAMP(1), c8);
    for (int k = 0; k < ntok; k += 2) {
        PV_ROWS(vrB, q); cB0 = q.c0; cB1 = q.c1;
        pv_level1(q, IDXg, COEFg, PV_CLAMP(k + 2), c8);
        { const size_t mm = (size_t)(m0 + k * stride); peer_v_token(vrA, cA0, cA1, H + mm * 1024, OUT + mm * 1024, SSQ + mm, b3, b4, b5, lane); }
        if (k + 1 < ntok) {
            PV_ROWS(vrA, q); cA0 = q.c0; cA1 = q.c1;
            pv_level1(q, IDXg, COEFg, PV_CLAMP(k + 3), c8);
            { const size_t mm = (size_t)(m0 + (k + 1) * stride); peer_v_token(vrB, cB0, cB1, H + mm * 1024, OUT + mm * 1024, SSQ + mm, b3, b4, b5, lane); }
        }
    }
#undef PV_CLAMP
#undef PV_ROWS
}
__device__ __forceinline__ void peer_f(const P& p, int wave, int lane) {
    const int gw = blockIdx.x * NWAVES + wave, NGW = gridDim.x * NWAVES;
    const float* SSQ = (const float*)(p.ws + WS_SSQ);
    for (int m = gw; m < T_; m += NGW) {
        float ss = 0.f;
#pragma unroll
        for (int jj = 0; jj < 8; ++jj) ss += SSQ[(size_t)jj * T_ + m];
        const float rstd = 1.f / sqrtf(ss * (1.f / 1024.f) + EPS);
        f32x4* o = (f32x4*)(p.out + (size_t)m * 1024) + lane; const f32x4* wr = (const f32x4*)p.norm_final_w + lane;
#pragma unroll
        for (int q = 0; q < 4; ++q) { const f32x4 v = o[64 * q], w = wr[64 * q]; o[64 * q] = (f32x4){v.x * rstd * w.x, v.y * rstd * w.y, v.z * rstd * w.z, v.w * rstd * w.w}; }
    }
}

constexpr int N_PHASES = 12;
struct Args { P p; int ph_lo, ph_hi; };
__global__ void __launch_bounds__(NTHR, 2) fwd_kernel(Args args) {
    extern __shared__ __attribute__((aligned(16))) unsigned char lds_raw[];
    LAS unsigned char* lds = (LAS unsigned char*)lds_raw;
    const P& p = args.p;
    const int tid = threadIdx.x, lane = tid & 63, wave = __builtin_amdgcn_readfirstlane(tid >> 6);
    volatile LAS unsigned* MISC = (volatile LAS unsigned*)(lds + MISC_OFF);
    for (int u = tid; u < (LDS_BYTES - LDSCTL_OFF) / 4; u += NTHR) ((LAS unsigned*)(lds + LDSCTL_OFF))[u] = 0u;
    __syncthreads();
    XcdBarrier bar; bar.bar = (unsigned*)(p.ws + WS_CTL) + CW_BAR; bar.x = 0; bar.st = nullptr;
#if !MK_PER_PHASE
    bar = xcd_barrier_post((unsigned*)(p.ws + WS_CTL) + CW_BAR, MISC + 8);
#endif
    const int lo = args.ph_lo, hi = args.ph_hi;
#define IN(k) (lo <= (k) && (k) < hi)
#ifndef PROBE_WAIT_LO
#define PROBE_WAIT_LO -1
#define PROBE_WAIT_HI -1
#endif
    volatile LAS unsigned long long* STAMP = (volatile LAS unsigned long long*)(lds + MISC_OFF + 256);
#define SEAM(k) do { if (IN(k) && IN((k) + 1)) xcd_barrier(bar); if (PROBE_WAIT_LO >= 0 && blockIdx.x == 0 && tid == 0) STAMP[(k) + 1] = __builtin_amdgcn_s_memrealtime(); } while (0)
    if (PROBE_WAIT_LO >= 0 && blockIdx.x == 0 && tid == 0) STAMP[0] = __builtin_amdgcn_s_memrealtime();

#ifndef PROBE_REP
#define PROBE_REP -1
#endif
#define REP(k) ((PROBE_REP == (k)) ? 2 : 1)
    if (IN(0)) {
#pragma unroll 1
        for (int r = 0; r < REP(0); ++r) p0_prologue(p, lds, wave, lane); } SEAM(0);
    if (IN(1)) {
#pragma unroll 1
      for (int r = 0; r < REP(1); ++r) {
        EpiProj e{(bf16*)(p.ws + WS_SBQKV), (bf16*)(p.ws + WS_VT), (bf16*)(p.ws + WS_MLQK), (bf16*)(p.ws + WS_MLV), (bf16*)(p.ws + WS_MLO), (bf16*)(p.ws + WS_GATES)};
        gemm<EpiProj>(lds, (const bf16*)(p.ws + WS_XN), (const bf16*)(p.ws + WS_W1T), T_, NPROJ, 1024, e); }
    } SEAM(1);
    if (IN(2)) { p2_conv(p, tid); } SEAM(2);
    if (IN(3)) {
        for (int it = blockIdx.x; it < 64; it += gridDim.x) mlstm_item(p, lds, it, tid, wave, lane);
        unsigned* qctr = (unsigned*)(p.ws + WS_CTL) + CW_Q;
        for (;;) {
            if (tid == 0) MISC[12] = __hip_atomic_fetch_add(qctr, 1u, __ATOMIC_RELAXED, __HIP_MEMORY_SCOPE_AGENT);
            __syncthreads();
            const unsigned it = MISC[12];
            __syncthreads();
            if (it >= 1024u) break;
            sba_item(p, (int)it, wave, lane);
        }
    } SEAM(3);
    if (IN(4)) { p3_yml(p, wave, lane); } SEAM(4);
    if (IN(5)) {
        EpiMergeA ea{(bf16*)(p.ws + WS_MERGED), (const bf16*)(p.ws + WS_GATES)};
        gemm<EpiMergeA>(lds, (const bf16*)p.out, (const bf16*)(p.ws + WS_WSBT), T_, 1024, 512, ea);
        VM_WAIT(); __syncthreads();
        EpiMergeB eb{(bf16*)(p.ws + WS_MERGED), (const bf16*)(p.ws + WS_GATES)};
        gemm<EpiMergeB>(lds, (const bf16*)p.out + (size_t)T_ * 512, (const bf16*)(p.ws + WS_WMLT), T_, 1024, 512, eb);
    } SEAM(5);
    if (IN(6)) {
        pg8::Gemm g{(const bf16*)(p.ws + WS_MERGED), (const bf16*)(p.ws + WS_WOUTT), T_, 1024, 1024}; pg8::StaticOrder S; S.init(T_, 1024, (int)gridDim.x, (int)blockIdx.x);
        EpiHW e{(float*)(p.ws + WS_H), p.x, (bf16*)p.out  , p.norm_ffn_w, (float*)(p.ws + WS_SS)};
        pg8::gemm_phase<EpiHW, pg8::StaticOrder, true, true>(lds, g, S, e);
    } SEAM(6);
    if (IN(7)) {
        pg8::Gemm g{(const bf16*)p.out, (const bf16*)(p.ws + WS_WCT), T_, 2048, 1024}; pg8::StaticOrder S; S.init(T_, 2048, (int)gridDim.x, (int)blockIdx.x);
        EpiTopk e{(int*)(p.ws + WS_IDX), (float*)(p.ws + WS_GATE), (const float*)(p.ws + WS_SS)};
#pragma unroll 1
        for (int i = 0;; ++i) { OneUnit s1; if (!S.next(i, s1.u)) break; pg8::gemm_phase<EpiTopk, OneUnit, false, true>(lds, g, s1, e); }
    } SEAM(7);
    if (IN(8)) { peer_u(p, wave, lane); } SEAM(8);
    if (IN(9)) { peer_c(p, wave, lane); } SEAM(9);
    if (IN(10)) { peer_v(p, wave, lane); } SEAM(10);
    if (IN(11)) { peer_f(p, wave, lane); }
    if (PROBE_WAIT_LO >= 0 && blockIdx.x == 0 && tid == 0) {
        const unsigned long long tend = __builtin_amdgcn_s_memrealtime();
        const unsigned long long thi = PROBE_WAIT_HI >= 12 ? tend : STAMP[PROBE_WAIT_HI < 0 ? 0 : PROBE_WAIT_HI];
        const unsigned long long dt = thi - STAMP[PROBE_WAIT_LO];
        while (__builtin_amdgcn_s_memrealtime() - tend < dt) __builtin_amdgcn_s_sleep(8);
    }
#undef IN
#undef SEAM
}

extern "C" void kernel_launch(void* const* d_in, const int* in_sizes, int n_in, void* d_out, int out_size, void* d_ws, size_t ws_size, hipStream_t stream) {
    static int grid = 0;
    if (grid == 0) {
        if (n_in != 18 || in_sizes[0] != T_ * D_ || out_size != T_ * D_ || ws_size < WS_END) {
            fprintf(stderr, "kernel_launch: unexpected problem (n_in %d, in0 %d, out %d, ws %zu); nothing launched\n", n_in, n_in > 0 ? in_sizes[0] : -1, out_size, ws_size); grid = -1; return; }
        int dev = 0, cus = 0, per_cu = 0;
        if (hipGetDevice(&dev) != hipSuccess || hipDeviceGetAttribute(&cus, hipDeviceAttributeMultiprocessorCount, dev) != hipSuccess) { grid = -1; return; }
        if (hipFuncSetAttribute((const void*)fwd_kernel, hipFuncAttributeMaxDynamicSharedMemorySize, LDS_BYTES) != hipSuccess) { fprintf(stderr, "kernel_launch: hipFuncSetAttribute failed\n"); grid = -1; return; }
        if (hipOccupancyMaxActiveBlocksPerMultiprocessor(&per_cu, (const void*)fwd_kernel, NTHR, LDS_BYTES) != hipSuccess || per_cu < 1)
            fprintf(stderr, "kernel_launch: note: occupancy query reports %d workgroups per CU\n", per_cu);
        (void)hipGetLastError();
        grid = cus;
    }
    if (grid < 0) return;
    if (hipMemsetAsync((char*)d_ws + WS_CTL, 0, CTL_ZERO_BYTES, stream) != hipSuccess) { fprintf(stderr, "kernel_launch: memset failed\n"); return; }
    Args a{};
    const float** pp = (const float**)&a.p;
    for (int i = 0; i < 18; ++i) pp[i] = (const float*)d_in[i];
    a.p.out = (float*)d_out; a.p.ws = (unsigned char*)d_ws;
#if MK_PER_PHASE
    for (int ph = 0; ph < N_PHASES; ++ph) {
        a.ph_lo = ph; a.ph_hi = ph + 1;
        hipLaunchKernelGGL(fwd_kernel, dim3(grid), dim3(NTHR), LDS_BYTES, stream, a);
    }
#else
    a.ph_lo = 0; a.ph_hi = N_PHASES;
    hipLaunchKernelGGL(fwd_kernel, dim3(grid), dim3(NTHR), LDS_BYTES, stream, a);
#endif
    const hipError_t le = hipPeekAtLastError();
    if (le != hipSuccess) fprintf(stderr, "kernel_launch: launch failed: %s\n", hipGetErrorName(le));
}
```

```cpp
#include <hip/hip_runtime.h>
#include <cstdio>
#include <cstdint>
namespace pg8 {
#define PG8_LAS __attribute__((address_space(3)))
typedef unsigned short bf16_t;
typedef short bf16x8 __attribute__((ext_vector_type(8)));
typedef float f32x4 __attribute__((ext_vector_type(4)));
typedef unsigned u32x4 __attribute__((ext_vector_type(4)));
constexpr int BM = 256, BK = 64, HALF = 128, HTB = HALF * BK * 2  , STAGE_BYTES = 8 * HTB, NXCD = 8, WGM = 8;

__host__ __device__ __forceinline__ int lds_byte(int r, int c) { const int st = (r >> 4) * 2 + (c >> 5), rr = r & 15, cc = c & 31, ob = rr * 64 + cc * 2; return st * 1024 + (ob ^ (((ob >> 9) & 1) << 5)); }
__host__ __device__ __forceinline__ void stage_rc(int b, int& R, int& C) { const int st = b / 1024, sb = b % 1024, swz = sb ^ (((sb >> 9) & 1) << 5); R = (st >> 1) * 16 + swz / 64; C = (st & 1) * 32 + (swz % 64) / 2; }
__host__ __device__ __forceinline__ int perm32(int rho) { const int n = rho >> 4, i = rho & 15; return 8 * (i >> 2) + 4 * n + (i & 3); }

struct Unit { int pm, pn; };
struct Gemm { const bf16_t* A; const bf16_t* Bt; int M, N, K; };

struct StaticOrder {
    int nM, nN, nwg, G, c;
    __host__ __device__ void init(int M, int N, int G_, int c_) { nM = M / BM; nN = N / BM; nwg = nM * nN; G = G_; c = c_; }
    __host__ __device__ bool next(int i, Unit& u) const {
        const long L = (long)i * G + c; if (L >= nwg) return false;
        int wgid = (int)L; { const int q = nwg / NXCD, r = nwg % NXCD, xcd = wgid % NXCD, off = wgid / NXCD; wgid = (xcd < r ? xcd * (q + 1) : r * (q + 1) + (xcd - r) * q) + off; }
        const int nig = WGM * nN, gid = wgid / nig, fm = gid * WGM, gsz = (nM - fm) < WGM ? (nM - fm) : WGM;
        u.pm = fm + ((wgid % nig) % gsz); u.pn = (wgid % nig) / gsz; return true;
    }
    __device__ __forceinline__ void a_ready(const Unit&) const {}
    __device__ __forceinline__ void done(const Unit&) const {}
};

__device__ __forceinline__ unsigned cvt_pk_bf16(float lo, float hi) { unsigned r; asm volatile("v_cvt_pk_bf16_f32 %0, %1, %2" : "=v"(r) : "v"(lo), "v"(hi)); return r; }
template <class Epi, class Sched, bool ALIGN_EPI = false, bool SP2 = false>
__device__ __forceinline__ void gemm_phase(PG8_LAS unsigned char* lds, const Gemm g, const Sched& S, const Epi& E) {
    const int tid = threadIdx.x, wid = __builtin_amdgcn_readfirstlane(tid >> 6), lane = tid & 63, wr = wid >> 2, wc = wid & 3, fr = lane & 15, fq = lane >> 4;
    const int K = g.K, nt = K / BK;
    unsigned voffA[2], voffB[2];
#pragma unroll
    for (int i = 0; i < 2; ++i) { int R, C; stage_rc(tid * 16 + i * 8192, R, C); const int Rb = Epi::PERM ? ((R & ~31) + perm32(R & 31)) : R;
        voffA[i] = (unsigned)(R * K + C) * 2u; voffB[i] = (unsigned)(Rb * K + C) * 2u; }
    const size_t kstep = (size_t)(BK * 2);
    const size_t hstep = (size_t)HALF * K * 2;
    const size_t tstep = 2 * hstep;
    const unsigned ldsw = (unsigned)wid * 1024u;
    const int aoff = lds_byte(wr * 64 + fr, fq * 8), boff = lds_byte(wc * 32 + fr, fq * 8);
#define PG8_SA(b, h) (((b) * 2 + (h)) * HTB)
#define PG8_SB(b, h) ((4 + (b) * 2 + (h)) * HTB)
#define PG8_STAGE(bufoff, gbase, voff) do { _Pragma("unroll") for (int _i = 0; _i < 2; ++_i) \
        __builtin_amdgcn_global_load_lds((const unsigned*)((const char*)(gbase) + (voff)[_i]), (PG8_LAS unsigned*)(lds + (bufoff) + ldsw + _i * 8192), 16, 0, 0); } while (0)
#define PG8_LDA(dst, b, h) do { _Pragma("unroll") for (int m = 0; m < 4; ++m) _Pragma("unroll") for (int k = 0; k < 2; ++k) dst[m][k] = *(const PG8_LAS bf16x8*)(lds + PG8_SA(b, h) + aoff + m * 2048 + k * 1024); } while (0)
#define PG8_LDB(dst, b, h) do { _Pragma("unroll") for (int n = 0; n < 2; ++n) _Pragma("unroll") for (int k = 0; k < 2; ++k) dst[n][k] = *(const PG8_LAS bf16x8*)(lds + PG8_SB(b, h) + boff + n * 2048 + k * 1024); } while (0)
#define PG8_MMA(ai, bj, At, Bt) do { __builtin_amdgcn_s_setprio(1); _Pragma("unroll") for (int m = 0; m < 4; ++m) _Pragma("unroll") for (int n = 0; n < 2; ++n) _Pragma("unroll") for (int k = 0; k < 2; ++k) \
        acc[ai][bj][m][n] = __builtin_amdgcn_mfma_f32_16x16x32_bf16(Bt[n][k], At[m][k], acc[ai][bj][m][n], 0, 0, 0); __builtin_amdgcn_s_setprio(0); } while (0)
#define PG8_WAIT_V(n) asm volatile("s_waitcnt vmcnt(" #n ")" ::: "memory")
#define PG8_WAIT_L(n) asm volatile("s_waitcnt lgkmcnt(" #n ")" ::: "memory")
#define PG8_BAR __builtin_amdgcn_s_barrier()
#define PG8_SCHED __builtin_amdgcn_sched_barrier(0)
    Unit cur, nxt; int ui = 0;
    if (!S.next(0, cur)) return;
    f32x4 acc[2][2][4][2];
#pragma unroll
    for (int a = 0; a < 2; ++a)
#pragma unroll
        for (int b = 0; b < 2; ++b)
#pragma unroll
            for (int m = 0; m < 4; ++m)
#pragma unroll
                for (int n = 0; n < 2; ++n) acc[a][b][m][n] = (f32x4){0.f, 0.f, 0.f, 0.f};
    bf16x8 At[4][2], B0[2][2], B1[2][2];
    const char* cA = (const char*)g.A + (size_t)cur.pm * tstep; const char* cB = (const char*)g.Bt + (size_t)cur.pn * tstep;
    S.a_ready(cur);
    if constexpr (SP2) {
        PG8_STAGE(PG8_SB(0, 0), cB, voffB); PG8_STAGE(PG8_SB(0, 1), cB + hstep, voffB); PG8_STAGE(PG8_SA(0, 0), cA, voffA); PG8_STAGE(PG8_SA(0, 1), cA + hstep, voffA);
        if (wr == 1) PG8_BAR;
        PG8_WAIT_V(2); PG8_BAR;
        PG8_STAGE(PG8_SB(1, 0), cB + kstep, voffB); PG8_STAGE(PG8_SA(1, 0), cA + kstep, voffA); PG8_STAGE(PG8_SB(1, 1), cB + hstep + kstep, voffB);
        PG8_WAIT_V(6); PG8_BAR;
    } else {
        PG8_STAGE(PG8_SB(0, 0), cB, voffB); PG8_STAGE(PG8_SA(0, 0), cA, voffA); PG8_STAGE(PG8_SB(0, 1), cB + hstep, voffB); PG8_STAGE(PG8_SA(0, 1), cA + hstep, voffA);
        if (wr == 1) PG8_BAR;
        PG8_WAIT_V(4); PG8_BAR;
        PG8_STAGE(PG8_SB(1, 0), cB + kstep, voffB); PG8_STAGE(PG8_SA(1, 0), cA + kstep, voffA); PG8_STAGE(PG8_SB(1, 1), cB + hstep + kstep, voffB);
        PG8_WAIT_V(6); PG8_BAR;
    }
    for (;;) {
        const bool has_next = S.next(ui + 1, nxt);
        const char* nA = has_next ? (const char*)g.A + (size_t)nxt.pm * tstep : cA; const char* nB = has_next ? (const char*)g.Bt + (size_t)nxt.pn * tstep : cB;
        for (int t = 0; t < nt; t += 2) {
            const bool last = (t == nt - 2);
            const char* a1 = cA + (size_t)(t + 1) * kstep;
            const char* a2 = last ? nA : cA + (size_t)(t + 2) * kstep; const char* b2 = last ? nB : cB + (size_t)(t + 2) * kstep;
            const char* a3 = a2 + kstep; const char* b3 = b2 + kstep;
            if (last && has_next) S.a_ready(nxt);
            if constexpr (SP2) {
            PG8_LDB(B0, 0, 0); PG8_LDB(B1, 0, 1); PG8_SCHED; PG8_LDA(At, 0, 0); PG8_STAGE(PG8_SA(1, 1), a1 + hstep, voffA);
            PG8_WAIT_V(8); PG8_WAIT_L(0); PG8_BAR; PG8_MMA(0, 0, At, B0); PG8_MMA(0, 1, At, B1); PG8_BAR; PG8_SCHED;
            PG8_LDA(At, 0, 1); PG8_STAGE(PG8_SB(0, 0), b2, voffB); PG8_STAGE(PG8_SB(0, 1), b2 + hstep, voffB); PG8_STAGE(PG8_SA(0, 0), a2, voffA);
            PG8_WAIT_V(8); PG8_WAIT_L(0); PG8_BAR; PG8_MMA(1, 0, At, B0); PG8_MMA(1, 1, At, B1); PG8_BAR; PG8_SCHED;
            PG8_LDB(B0, 1, 0); PG8_LDB(B1, 1, 1); PG8_SCHED; PG8_LDA(At, 1, 0); PG8_STAGE(PG8_SA(0, 1), a2 + hstep, voffA);
            PG8_WAIT_V(8); PG8_WAIT_L(0); PG8_BAR; PG8_MMA(0, 0, At, B0); PG8_MMA(0, 1, At, B1); PG8_BAR; PG8_SCHED;
            PG8_LDA(At, 1, 1); PG8_STAGE(PG8_SB(1, 0), b3, voffB); PG8_STAGE(PG8_SB(1, 1), b3 + hstep, voffB); PG8_STAGE(PG8_SA(1, 0), a3, voffA);
            PG8_WAIT_V(8); PG8_WAIT_L(0); PG8_BAR; PG8_MMA(1, 0, At, B0); PG8_MMA(1, 1, At, B1); PG8_BAR; PG8_SCHED;
            } else {
            PG8_LDB(B0, 0, 0); PG8_SCHED; PG8_LDA(At, 0, 0); PG8_STAGE(PG8_SA(1, 1), a1 + hstep, voffA);
            PG8_WAIT_L(8); PG8_BAR; PG8_WAIT_L(0); PG8_MMA(0, 0, At, B0); PG8_BAR; PG8_SCHED;
            PG8_LDB(B1, 0, 1); PG8_STAGE(PG8_SB(0, 0), b2, voffB);
            PG8_BAR; PG8_WAIT_L(0); PG8_MMA(0, 1, At, B1); PG8_BAR;
            PG8_LDA(At, 0, 1); PG8_STAGE(PG8_SA(0, 0), a2, voffA);
            PG8_BAR; PG8_WAIT_L(0); PG8_MMA(1, 0, At, B0); PG8_BAR; PG8_SCHED;
            PG8_STAGE(PG8_SB(0, 1), b2 + hstep, voffB);
            PG8_WAIT_V(6); PG8_BAR; PG8_MMA(1, 1, At, B1); PG8_BAR;
            PG8_LDB(B0, 1, 0); PG8_SCHED; PG8_LDA(At, 1, 0); PG8_STAGE(PG8_SA(0, 1), a2 + hstep, voffA);
            PG8_WAIT_L(8); PG8_BAR; PG8_WAIT_L(0); PG8_MMA(0, 0, At, B0); PG8_BAR; PG8_SCHED;
            PG8_LDB(B1, 1, 1); PG8_STAGE(PG8_SB(1, 0), b3, voffB);
            PG8_BAR; PG8_WAIT_L(0); PG8_MMA(0, 1, At, B1); PG8_BAR;
            PG8_LDA(At, 1, 1); PG8_STAGE(PG8_SA(1, 0), a3, voffA);
            PG8_BAR; PG8_WAIT_L(0); PG8_MMA(1, 0, At, B0); PG8_BAR; PG8_SCHED;
            PG8_STAGE(PG8_SB(1, 1), b3 + hstep, voffB);
            PG8_WAIT_V(6); PG8_BAR; PG8_MMA(1, 1, At, B1); PG8_BAR;
            }
        }
        if constexpr (ALIGN_EPI) { if (wr == 0) PG8_BAR; }
        if constexpr (!Epi::AFTER_DRAIN) { E(acc, cur, wr, wc, fr, fq); S.done(cur); }
        if (!has_next) break;
#pragma unroll
        for (int a = 0; a < 2; ++a)
#pragma unroll
            for (int b = 0; b < 2; ++b)
#pragma unroll
                for (int m = 0; m < 4; ++m)
#pragma unroll
                    for (int n = 0; n < 2; ++n) acc[a][b][m][n] = (f32x4){0.f, 0.f, 0.f, 0.f};
        cur = nxt; cA = nA; cB = nB; ++ui;
        if constexpr (ALIGN_EPI) { if (wr == 1) PG8_BAR; }
    }
    PG8_WAIT_V(0);
    if constexpr (!ALIGN_EPI) { if (wr == 0) PG8_BAR; }
    PG8_BAR;
    if constexpr (Epi::AFTER_DRAIN) { E.fused(acc, cur, wr, wc, fr, fq, lds, wid, lane); S.done(cur); }
#undef PG8_SA
#undef PG8_SB
#undef PG8_STAGE
#undef PG8_LDA
#undef PG8_LDB
#undef PG8_MMA
#undef PG8_WAIT_V
#undef PG8_WAIT_L
#undef PG8_BAR
#undef PG8_SCHED
}
}

#ifndef MK_PER_PHASE
#define MK_PER_PHASE 0
#endif
#ifndef USE_PG8
#define USE_PG8 1
#endif
constexpr int NWAVES = 8, NTHR = 512;

constexpr int B_ = 16, S_ = 2048, D_ = 1024, T_ = B_ * S_;
constexpr int INC = 5640, NPROJ = 5632;
constexpr int NEXP = 16384;
constexpr float EPS = 1e-6f;

constexpr size_t MiB = 1u << 20;
constexpr size_t WS_CTL = 0, CTL_ZERO_BYTES = 1 * MiB;
constexpr size_t WS_W1T = 2 * MiB, WS_WSBT = 13 * MiB, WS_WMLT = 14 * MiB, WS_WOUTT = 15 * MiB, WS_WCT = 17 * MiB, WS_IFG = 21 * MiB;
constexpr size_t WS_U8 = 24 * MiB, WS_V8 = 40 * MiB, WS_USC = 22 * MiB, WS_VSC = 23 * MiB;
constexpr size_t WS_XN = 88 * MiB, WS_QC = 88 * MiB, WS_KC = 120 * MiB;
constexpr size_t WS_SBQKV = 152 * MiB  , WS_VT = 216 * MiB  , WS_MLQK = 248 * MiB, WS_MLV = 312 * MiB, WS_MLO = 344 * MiB, WS_GATES = 376 * MiB;
constexpr size_t WS_MERGED = 216 * MiB, WS_H = 88 * MiB, WS_HN = 216 * MiB, WS_IDX = 280 * MiB, WS_GATE = 296 * MiB, WS_SC = 312 * MiB;
constexpr size_t WS_PART = 312 * MiB  , WS_SSQ = 504 * MiB  , WS_COEF = 56 * MiB  , WS_HN8 = 440 * MiB  , WS_XS = 505 * MiB  , WS_SS = 506 * MiB  ;
constexpr size_t WS_END = 508 * MiB;
constexpr int CW_BAR = 4096, CW_Q = 8192;

constexpr int RING_OFF = 0, RING_BYTES = 135168;
constexpr int LDSCTL_OFF = RING_BYTES, MISC_OFF = LDSCTL_OFF + 320;
constexpr int LDS_BYTES = 147456;

#define GAS __attribute__((address_space(1)))
#define LAS __attribute__((address_space(3)))
typedef unsigned short bf16;
typedef unsigned v4u __attribute__((ext_vector_type(4)));
typedef unsigned v2u __attribute__((ext_vector_type(2)));
typedef float f32x4 __attribute__((ext_vector_type(4)));
#define LDS_WAIT() asm volatile("s_waitcnt lgkmcnt(0)" ::: "memory")
#define VM_WAIT() asm volatile("s_waitcnt vmcnt(0)" ::: "memory")
__device__ __forceinline__ unsigned f2bf(float f) { unsigned u = __builtin_bit_cast(unsigned, f); return (u + 0x7fffu + ((u >> 16) & 1u)) >> 16; }
__device__ __forceinline__ unsigned pk2(float lo, float hi) { return f2bf(lo) | (f2bf(hi) << 16); }
__device__ __forceinline__ float bflo(unsigned u) { return __builtin_bit_cast(float, u << 16); }
__device__ __forceinline__ float bfhi(unsigned u) { return __builtin_bit_cast(float, u & 0xffff0000u); }
__device__ __forceinline__ float bf2f(bf16 b) { return __builtin_bit_cast(float, (unsigned)b << 16); }
__device__ __forceinline__ float sigmoidf_(float x) { return 1.f / (1.f + __expf(-x)); }
__device__ __forceinline__ float wave_sum(float v) {
#pragma unroll
    for (int o = 1; o < 64; o <<= 1) v += __shfl_xor(v, o);
    return v;
}
__device__ __forceinline__ unsigned wave_max_u(unsigned v) {
#pragma unroll
    for (int o = 1; o < 64; o <<= 1) { const unsigned w = (unsigned)__shfl_xor((int)v, o); v = v > w ? v : w; }
    return v;
}
struct F8 { float v[8]; };
__device__ __forceinline__ void unpack8(const v4u& u, float (&f)[8]) {
    f[0] = bflo(u.x); f[1] = bfhi(u.x); f[2] = bflo(u.y); f[3] = bfhi(u.y); f[4] = bflo(u.z); f[5] = bfhi(u.z); f[6] = bflo(u.w); f[7] = bfhi(u.w);
}
__device__ __forceinline__ v4u pack8(const float (&f)[8]) { v4u o; o.x = pk2(f[0], f[1]); o.y = pk2(f[2], f[3]); o.z = pk2(f[4], f[5]); o.w = pk2(f[6], f[7]); return o; }

#define XB_TMO      128
#define XB_XCNT(j)  (256  + 64 * (j))
#define XB_XSUB(j)  (1280 + 64 * (j))
#define XB_XGEN(j)  (2304 + 64 * (j))
#define XB_TOP      3328
#define XB_TOPGEN   3392
#define XCD_BAR_WORDS 3456
#define XB_SPIN_CAP (1u << 24)

__device__ __forceinline__ unsigned xb_ld(unsigned* p)              { return __hip_atomic_load(p, __ATOMIC_RELAXED, __HIP_MEMORY_SCOPE_AGENT); }
__device__ __forceinline__ unsigned xb_add(unsigned* p, unsigned v) { return __hip_atomic_fetch_add(p, v, __ATOMIC_RELAXED, __HIP_MEMORY_SCOPE_AGENT); }
__device__ __forceinline__ unsigned xb_xcc_id() { return (unsigned)__builtin_amdgcn_s_getreg((3 << 11) | 20) & 0xFu; }
#define XB_SPIN(cond, bar) do { unsigned _sp = 0; while (cond) { __builtin_amdgcn_s_sleep(1); \
    if ((++_sp & 255u) == 0u) { if (xb_ld(&(bar)[XB_TMO])) break; if (_sp > XB_SPIN_CAP) { atomicAdd(&(bar)[XB_TMO], 1u); break; } } } } while (0)

struct XcdBarrier {
    unsigned* bar; unsigned x;
    volatile LAS unsigned* st;
};

__device__ __forceinline__ XcdBarrier xcd_barrier_post(unsigned* bar, volatile LAS unsigned* st) {
    XcdBarrier b; b.bar = bar; b.x = xb_xcc_id(); b.st = st;
    if (threadIdx.x == 0) (void)xb_add(&bar[XB_XCNT(b.x)], 1u);
    return b;
}
__device__ __forceinline__ void xcd_barrier_complete(unsigned* bar, unsigned x, unsigned& nloc, unsigned& nx) {
    const unsigned G = gridDim.x * gridDim.y * gridDim.z;
    unsigned sum, cnt, mine, sp = 0u;
    for (;;) {
        sum = 0u; cnt = 0u; mine = 0u;
#pragma unroll
        for (unsigned j = 0; j < 16; ++j) { const unsigned c = xb_ld(&bar[XB_XCNT(j)]); sum += c; cnt += (c > 0u) ? 1u : 0u; mine = (j == x) ? c : mine; }
        if (sum == G) break;
        __builtin_amdgcn_s_sleep(1);
        if ((++sp & 255u) == 0u) { if (xb_ld(&bar[XB_TMO])) break; if (sp > XB_SPIN_CAP) { atomicAdd(&bar[XB_TMO], 1u); break; } }
    }
    nloc = mine > 0u ? mine : 1u; nx = cnt > 0u ? cnt : 1u;
}

__device__ __forceinline__ void xcd_barrier(const XcdBarrier& b) {
    asm volatile("s_waitcnt vmcnt(0)" ::: "memory");
    __syncthreads();
    if (threadIdx.x == 0) {
        unsigned* bar = b.bar;
        __builtin_amdgcn_s_waitcnt(0);
        unsigned nloc = b.st[0], nx = b.st[1];
        if (nloc == 0u) { xcd_barrier_complete(bar, b.x, nloc, nx); b.st[0] = nloc; b.st[1] = nx; }
        const unsigned old = xb_add(&bar[XB_XSUB(b.x)], 1u);
        const unsigned gen = old / nloc;
        if (old + 1u == (gen + 1u) * nloc) {
            __builtin_amdgcn_fence(__ATOMIC_RELEASE, "agent");
            asm volatile("s_waitcnt vmcnt(0)" ::: "memory");
            const unsigned og = xb_add(&bar[XB_TOP], 1u);
            const unsigned tg = og / nx;
            if (og + 1u == (tg + 1u) * nx) xb_add(&bar[XB_TOPGEN], 1u);
            else XB_SPIN(xb_ld(&bar[XB_TOPGEN]) == tg, bar);
            __builtin_amdgcn_fence(__ATOMIC_ACQUIRE, "agent");
            xb_add(&bar[XB_XGEN(b.x)], 1u);
            asm volatile("s_waitcnt vmcnt(0)" ::: "memory");
        } else {
            XB_SPIN(xb_ld(&bar[XB_XGEN(b.x)]) == gen, bar);
            __builtin_amdgcn_fence(__ATOMIC_ACQUIRE, "agent");
            asm volatile("s_waitcnt vmcnt(0)" ::: "memory");
        }
    }
    __syncthreads();
}

struct EpiProj {
    bf16 *sbqk, *vt, *mlqk, *mlv, *mlo, *gates;
    __device__ __forceinline__ void operator()(int row, int col, const F8& a) const {
        bf16* dst;
        if (col < 1024) dst = sbqk + (size_t)row * 1024 + col;
        else if (col < 1536) {
            const int c = col - 1024, hh = c >> 6, d = c & 63, b = row >> 11, sq = row & 2047;
            bf16* vp = vt + ((size_t)(b * 8 + hh) * 64 + d) * 2048 + sq;
#pragma unroll
            for (int i = 0; i < 8; ++i) vp[(size_t)i * 2048] = (bf16)f2bf(a.v[i]);
            return;
        }
        else if (col < 2560) dst = mlqk + (size_t)row * 1024 + (col - 1536);
        else if (col < 3072) dst = mlv + (size_t)row * 512 + (col - 2560);
        else if (col < 3584) dst = mlo + (size_t)row * 512 + (col - 3072);
        else dst = gates + (size_t)row * 2048 + (col - 3584);
        *(v4u*)dst = pack8(a.v);
    }
};
struct EpiMergeA {
    bf16* merged; const bf16* gates;
    __device__ __forceinline__ void operator()(int row, int col, const F8& a) const {
        float g[8], o[8]; unpack8(*(const v4u*)(gates + (size_t)row * 2048 + col), g);
#pragma unroll
        for (int i = 0; i < 8; ++i) o[i] = sigmoidf_(g[i]) * a.v[i];
        *(v4u*)(merged + (size_t)row * 1024 + col) = pack8(o);
    }
};
struct EpiMergeB {
    bf16* merged; const bf16* gates;
    __device__ __forceinline__ void operator()(int row, int col, const F8& a) const {
        float g[8], o[8]; unpack8(*(const v4u*)(gates + (size_t)row * 2048 + 1024 + col), g);
        unpack8(*(const v4u*)(merged + (size_t)row * 1024 + col), o);
#pragma unroll
        for (int i = 0; i < 8; ++i) o[i] += sigmoidf_(g[i]) * a.v[i];
        *(v4u*)(merged + (size_t)row * 1024 + col) = pack8(o);
    }
};
struct EpiH {
    float* h; const float* x;
    __device__ __forceinline__ void operator()(int row, int col, const F8& a) const {
        const f32x4 x0 = *(const f32x4*)(x + (size_t)row * 1024 + col), x1 = *(const f32x4*)(x + (size_t)row * 1024 + col + 4);
        *(f32x4*)(h + (size_t)row * 1024 + col) = (f32x4){x0.x + a.v[0], x0.y + a.v[1], x0.z + a.v[2], x0.w + a.v[3]};
        *(f32x4*)(h + (size_t)row * 1024 + col + 4) = (f32x4){x1.x + a.v[4], x1.y + a.v[5], x1.z + a.v[6], x1.w + a.v[7]};
    }
};
struct EpiF32 {
    float* o; int ldc;
    __device__ __forceinline__ void operator()(int row, int col, const F8& a) const {
        *(f32x4*)(o + (size_t)row * ldc + col) = (f32x4){a.v[0], a.v[1], a.v[2], a.v[3]};
        *(f32x4*)(o + (size_t)row * ldc + col + 4) = (f32x4){a.v[4], a.v[5], a.v[6], a.v[7]};
    }
};

template <class E> struct EpiAdapt {
    static constexpr bool PERM = true, AFTER_DRAIN = false;
    E e;
    __device__ __forceinline__ void operator()(const pg8::f32x4 (&acc)[2][2][4][2], const pg8::Unit& u, int wr, int wc, int fr, int fq) const {
#pragma unroll
        for (int ai = 0; ai < 2; ++ai)
#pragma unroll
            for (int m = 0; m < 4; ++m) {
                const int row = u.pm * 256 + ai * 128 + wr * 64 + m * 16 + fr;
#pragma unroll
                for (int bj = 0; bj < 2; ++bj) {
                    const int col = u.pn * 256 + bj * 128 + wc * 32 + 8 * fq;
                    F8 a; const pg8::f32x4 v0 = acc[ai][bj][m][0], v1 = acc[ai][bj][m][1];
                    a.v[0] = v0[0]; a.v[1] = v0[1]; a.v[2] = v0[2]; a.v[3] = v0[3]; a.v[4] = v1[0]; a.v[5] = v1[1]; a.v[6] = v1[2]; a.v[7] = v1[3];
                    e(row, col, a);
                }
            }
    }
};

struct EpiHW {
    static constexpr bool PERM = true, AFTER_DRAIN = false;
    float* h; const float* x; bf16* hw; const float* wffn; float* ss;
    __device__ __forceinline__ void operator()(const pg8::f32x4 (&acc)[2][2][4][2], const pg8::Unit& u, int wr, int wc, int fr, int fq) const {
#pragma unroll
        for (int ai = 0; ai < 2; ++ai)
#pragma unroll
            for (int m = 0; m < 4; ++m) {
                const int row = u.pm * 256 + ai * 128 + wr * 64 + m * 16 + fr;
                float sq = 0.f;
#pragma unroll
                for (int bj = 0; bj < 2; ++bj) {
                    const int col = u.pn * 256 + bj * 128 + wc * 32 + 8 * fq;
                    const size_t o = (size_t)row * 1024 + col;
                    const f32x4 x0 = *(const f32x4*)(x + o), x1 = *(const f32x4*)(x + o + 4);
                    const f32x4 w0 = *(const f32x4*)(wffn + col), w1 = *(const f32x4*)(wffn + col + 4);
                    const pg8::f32x4 v0 = acc[ai][bj][m][0], v1 = acc[ai][bj][m][1];
                    const f32x4 h0 = (f32x4){x0.x + v0[0], x0.y + v0[1], x0.z + v0[2], x0.w + v0[3]}, h1 = (f32x4){x1.x + v1[0], x1.y + v1[1], x1.z + v1[2], x1.w + v1[3]};
                    *(f32x4*)(h + o) = h0; *(f32x4*)(h + o + 4) = h1;
                    *(v4u*)(hw + o) = (v4u){pk2(h0.x * w0.x, h0.y * w0.y), pk2(h0.z * w0.z, h0.w * w0.w), pk2(h1.x * w1.x, h1.y * w1.y), pk2(h1.z * w1.z, h1.w * w1.w)};
                    sq += (h0.x * h0.x + h0.y * h0.y) + (h0.z * h0.z + h0.w * h0.w) + (h1.x * h1.x + h1.y * h1.y) + (h1.z * h1.z + h1.w * h1.w);
                }
                sq += __shfl_xor(sq, 16); sq += __shfl_xor(sq, 32);
                if (fq == 0) ss[(size_t)row * 16 + u.pn * 4 + wc] = sq;
            }
    }
};

template <class E>
__device__ __forceinline__ void simple_gemm(LAS unsigned char* lds, const bf16* A, const bf16* Bt, int M, int N, int K, const E& e) {
    LAS float* As = (LAS float*)lds;
    LAS float* Bs = As + 32 * 132;
    const int tid = threadIdx.x, ty = tid >> 4, tx = tid & 15;
    const int ntn = N / 128, ntiles = (M / 128) * ntn;
    for (int tile = blockIdx.x; tile < ntiles; tile += gridDim.x) {
        const int tm = tile / ntn, tn = tile % ntn;
        float acc[4][8];
#pragma unroll
        for (int i = 0; i < 4; ++i)
#pragma unroll
            for (int j = 0; j < 8; ++j) acc[i][j] = 0.f;
        for (int k0 = 0; k0 < K; k0 += 32) {
            {
                const int r = tid >> 2, kq = (tid & 3) * 8;
                float fa[8], fb[8];
                unpack8(*(const v4u*)(A + (size_t)(tm * 128 + r) * K + k0 + kq), fa);
                unpack8(*(const v4u*)(Bt + (size_t)(tn * 128 + r) * K + k0 + kq), fb);
#pragma unroll
                for (int i = 0; i < 8; ++i) { As[(kq + i) * 132 + r] = fa[i]; Bs[(kq + i) * 132 + r] = fb[i]; }
            }
            __syncthreads();
#pragma unroll 8
            for (int k = 0; k < 32; ++k) {
                const f32x4 a4 = *(const LAS f32x4*)(As + k * 132 + ty * 4);
                const f32x4 b0 = *(const LAS f32x4*)(Bs + k * 132 + tx * 8), b1 = *(const LAS f32x4*)(Bs + k * 132 + tx * 8 + 4);
                const float av[4] = {a4.x, a4.y, a4.z, a4.w};
                const float bv[8] = {b0.x, b0.y, b0.z, b0.w, b1.x, b1.y, b1.z, b1.w};
#pragma unroll
                for (int i = 0; i < 4; ++i)
#pragma unroll
                    for (int j = 0; j < 8; ++j) acc[i][j] += av[i] * bv[j];
            }
            __syncthreads();
        }
#pragma unroll
        for (int i = 0; i < 4; ++i) {
            F8 a;
#pragma unroll
            for (int j = 0; j < 8; ++j) a.v[j] = acc[i][j];
            e(tm * 128 + ty * 4 + i, tn * 128 + tx * 8, a);
        }
    }
}

template <class E>
__device__ __forceinline__ void gemm(LAS unsigned char* lds, const bf16* A, const bf16* Bt, int M, int N, int K, const E& e) {
#if USE_PG8
    pg8::Gemm g{A, Bt, M, N, K}; pg8::StaticOrder S; S.init(M, N, (int)gridDim.x, (int)blockIdx.x);
    EpiAdapt<E> ea{e};
    pg8::gemm_phase<EpiAdapt<E>, pg8::StaticOrder, true, true>(lds, g, S, ea);
#else
    simple_gemm<E>(lds, A, Bt, M, N, K, e);
#endif
}

__device__ __forceinline__ void transpose_item(const float* W, int ldw, int K, bf16* WT, int src_col0, int dst_row0, LAS float* scr, int kb, int lane) {
    const int k0 = 64 * kb;
#pragma unroll 8
    for (int i = 0; i < 32; ++i) { const int kk = 2 * i + (lane >> 5); scr[kk * 33 + (lane & 31)] = W[(size_t)(k0 + kk) * ldw + src_col0 + (lane & 31)]; }
    LDS_WAIT(); asm volatile("" ::: "memory");
    const int c = lane & 7;
#pragma unroll
    for (int j = 0; j < 4; ++j) { const int n = (lane >> 3) + 8 * j; const LAS float* s = scr + (8 * c) * 33 + n;
        v4u o; o.x = pk2(s[0 * 33], s[1 * 33]); o.y = pk2(s[2 * 33], s[3 * 33]); o.z = pk2(s[4 * 33], s[5 * 33]); o.w = pk2(s[6 * 33], s[7 * 33]);
        *(v4u*)(WT + (size_t)(dst_row0 + n) * K + k0 + 8 * c) = o; }
    LDS_WAIT(); asm volatile("" ::: "memory");
}

struct P {
    const float *x, *norm_mix_w, *w_in, *conv_w, *conv_b, *b_i, *b_f, *ml_norm_w, *w_sb, *w_ml, *w_out, *norm_ffn_w, *w_query, *keys1, *keys2, *peer_u, *peer_v, *norm_final_w;
    float* out; unsigned char* ws;
};

__device__ __forceinline__ void p0_prologue(const P& p, LAS unsigned char* lds, int wave, int lane) {
    LAS float* scr = (LAS float*)(lds + wave * 8448);
    const int gw = blockIdx.x * NWAVES + wave, NGW = gridDim.x * NWAVES;
    bf16* W1T = (bf16*)(p.ws + WS_W1T); bf16* WSBT = (bf16*)(p.ws + WS_WSBT); bf16* WMLT = (bf16*)(p.ws + WS_WMLT); bf16* WOUTT = (bf16*)(p.ws + WS_WOUTT); bf16* WCT = (bf16*)(p.ws + WS_WCT);
    constexpr int I_1 = 16 * 176, I_SB = 8 * 32, I_ML = 8 * 32, I_O = 16 * 32, NT = I_1 + I_SB + I_ML + I_O;
    for (int it = gw; it < NT; it += NGW) {
        int r = it;
        if (r < I_1) { const int kb = r / 176, nb = r % 176, n0 = nb * 32; transpose_item(p.w_in, INC, 1024, W1T, n0 < 3584 ? n0 : n0 + 8, n0, scr, kb, lane); continue; } r -= I_1;
        if (r < I_SB) { const int kb = r / 32, nb = r % 32; transpose_item(p.w_sb, 1024, 512, WSBT, nb * 32, nb * 32, scr, kb, lane); continue; } r -= I_SB;
        if (r < I_ML) { const int kb = r / 32, nb = r % 32; transpose_item(p.w_ml, 1024, 512, WMLT, nb * 32, nb * 32, scr, kb, lane); continue; } r -= I_ML;
        { const int kb = r / 32, nb = r % 32; transpose_item(p.w_out, 1024, 1024, WOUTT, nb * 32, nb * 32, scr, kb, lane); }
    }
    bf16* XN = (bf16*)(p.ws + WS_XN); float* IFG = (float*)(p.ws + WS_IFG);
    LAS float* WG = (LAS float*)(lds + 8 * 8448);
    __syncthreads();
    for (int i = threadIdx.x; i < 2048; i += NTHR) { const int k = i >> 1, hf = i & 1; *(LAS f32x4*)(WG + k * 8 + hf * 4) = *(const f32x4*)(p.w_in + (size_t)k * INC + 3584 + hf * 4); }
    __syncthreads();
    for (int m = gw; m < T_; m += NGW) {
        const f32x4* xr = (const f32x4*)(p.x + (size_t)m * 1024) + lane;
        const f32x4* wr = (const f32x4*)p.norm_mix_w + lane;
        f32x4 v[4]; float ss = 0.f;
#pragma unroll
        for (int j = 0; j < 4; ++j) { v[j] = xr[64 * j]; ss += (v[j].x * v[j].x + v[j].y * v[j].y) + (v[j].z * v[j].z + v[j].w * v[j].w); }
        const float rstd = 1.f / sqrtf(wave_sum(ss) * (1.f / 1024.f) + EPS);
        float g[8];
#pragma unroll
        for (int i = 0; i < 8; ++i) g[i] = 0.f;
        v2u* o8 = (v2u*)(XN + (size_t)m * 1024) + lane;
#pragma unroll
        for (int j = 0; j < 4; ++j) {
            const f32x4 w = wr[64 * j];
            const float y[4] = {v[j].x * rstd * w.x, v[j].y * rstd * w.y, v[j].z * rstd * w.z, v[j].w * rstd * w.w};
            o8[64 * j] = (v2u){pk2(y[0], y[1]), pk2(y[2], y[3])};
#pragma unroll
            for (int q = 0; q < 4; ++q) {
                const int k = 256 * j + 4 * lane + q;
                const f32x4 w0 = *(const LAS f32x4*)(WG + k * 8), w1 = *(const LAS f32x4*)(WG + k * 8 + 4);
                g[0] += y[q] * w0.x; g[1] += y[q] * w0.y; g[2] += y[q] * w0.z; g[3] += y[q] * w0.w;
                g[4] += y[q] * w1.x; g[5] += y[q] * w1.y; g[6] += y[q] * w1.z; g[7] += y[q] * w1.w;
            }
        }
        {
            const bool b5 = (lane & 32) != 0, b4 = (lane & 16) != 0, b3 = (lane & 8) != 0;
            float e4[4], f2[2], gs;
#pragma unroll
            for (int i = 0; i < 4; ++i) { const float keep = b5 ? g[2 * i + 1] : g[2 * i], send = b5 ? g[2 * i] : g[2 * i + 1]; e4[i] = keep + __shfl_xor(send, 32); }
#pragma unroll
            for (int i = 0; i < 2; ++i) { const float keep = b4 ? e4[2 * i + 1] : e4[2 * i], send = b4 ? e4[2 * i] : e4[2 * i + 1]; f2[i] = keep + __shfl_xor(send, 16); }
            { const float keep = b3 ? f2[1] : f2[0], send = b3 ? f2[0] : f2[1]; gs = keep + __shfl_xor(send, 8); }
            gs += __shfl_xor(gs, 4); gs += __shfl_xor(gs, 2); gs += __shfl_xor(gs, 1);
            const int gi = 4 * (b3 ? 1 : 0) + 2 * (b4 ? 1 : 0) + (b5 ? 1 : 0);
            if ((lane & 7) == 0) IFG[(size_t)m * 8 + gi] = gs + (gi < 4 ? p.b_i[gi] : p.b_f[gi - 4]);
        }
    }
}

__device__ __forceinline__ void fill_wc(const P& p, int it, int lane) {
    bf16* WCT = (bf16*)(p.ws + WS_WCT);
    const int hhf = it >> 6, kb = (it >> 2) & 15, kq = it & 3, head = hhf >> 1, half = hhf & 1, k = kb * 64 + lane;
    const f32x4* wq = (const f32x4*)(p.w_query + (size_t)k * 2048 + head * 256 + half * 128);
    f32x4 wr[32];
#pragma unroll
    for (int i = 0; i < 32; ++i) wr[i] = wq[i];
    const float* kbase = (half ? p.keys2 : p.keys1) + ((size_t)head * 128 + kq * 32) * 128;
#pragma unroll 1
    for (int key = 0; key < 32; ++key) {
        const f32x4* kr = (const f32x4*)(kbase + (size_t)key * 128);
        float a0 = 0.f, a1 = 0.f;
#pragma unroll
        for (int i = 0; i < 32; i += 2) { const f32x4 b0 = kr[i], b1 = kr[i + 1];
            a0 += wr[i].x * b0.x + wr[i].y * b0.y + wr[i].z * b0.z + wr[i].w * b0.w;
            a1 += wr[i + 1].x * b1.x + wr[i + 1].y * b1.y + wr[i + 1].z * b1.z + wr[i + 1].w * b1.w; }
        WCT[(size_t)(hhf * 128 + kq * 32 + key) * 1024 + k] = (bf16)f2bf(a0 + a1);
    }
}
__device__ __forceinline__ void fill_tables(const P& p, int e, int lane) {
    unsigned char* U8 = p.ws + WS_U8; unsigned char* V8 = p.ws + WS_V8; float* USC = (float*)(p.ws + WS_USC); float* VSC = (float*)(p.ws + WS_VSC);
    f32x4 v[2][4]; float am[2] = {0.f, 0.f};
#pragma unroll
    for (int which = 0; which < 2; ++which) {
        const float* src = (which ? p.peer_v : p.peer_u) + (size_t)e * 1024 + 16 * lane;
#pragma unroll
        for (int j = 0; j < 4; ++j) v[which][j] = *(const f32x4*)(src + 4 * j);
    }
#pragma unroll
    for (int which = 0; which < 2; ++which)
#pragma unroll
        for (int j = 0; j < 4; ++j) am[which] = fmaxf(am[which], fmaxf(fmaxf(fabsf(v[which][j].x), fabsf(v[which][j].y)), fmaxf(fabsf(v[which][j].z), fabsf(v[which][j].w))));
#pragma unroll
    for (int o = 1; o < 64; o <<= 1) { am[0] = fmaxf(am[0], __shfl_xor(am[0], o)); am[1] = fmaxf(am[1], __shfl_xor(am[1], o)); }
#pragma unroll
    for (int which = 0; which < 2; ++which) {
        const float sc = am[which] > 0.f ? exp2f(floorf(log2f(448.f / am[which]))) : 1.f;
        unsigned w[4];
#pragma unroll
        for (int j = 0; j < 4; ++j) { int t = __builtin_amdgcn_cvt_pk_fp8_f32(v[which][j].x * sc, v[which][j].y * sc, 0, false); t = __builtin_amdgcn_cvt_pk_fp8_f32(v[which][j].z * sc, v[which][j].w * sc, t, true); w[j] = (unsigned)t; }
        *(v4u*)((which ? V8 : U8) + ((size_t)(lane >> 3) * NEXP + e) * 128 + 16 * (lane & 7)) = (v4u){w[0], w[1], w[2], w[3]};
        if (lane == 0) (which ? VSC : USC)[e] = 1.f / sc;
    }
}
constexpr int N_FILL = 128 + 1024;
__device__ __forceinline__ void fill_item(const P& p, int item, int wave, int lane) {
    if (item < 128) fill_wc(p, item * 8 + wave, lane);
    else { const int e0 = (item - 128) * 16 + wave * 2; fill_tables(p, e0, lane); fill_tables(p, e0 + 1, lane); }
}

typedef short bf16x8 __attribute__((ext_vector_type(8)));
typedef float f32x16 __attribute__((ext_vector_type(16)));
typedef float f32x2_t __attribute__((ext_vector_type(2))); typedef __bf16 bf16x2_t __attribute__((ext_vector_type(2)));
__device__ __forceinline__ unsigned cvtpk(float lo, float hi) { f32x2_t v = {lo, hi}; bf16x2_t b = __builtin_convertvector(v, bf16x2_t); return __builtin_bit_cast(unsigned, b); }
#define MFMA32(a, b, c) __builtin_amdgcn_mfma_f32_32x32x16_bf16((a), (b), (c), 0, 0, 0)
__device__ __forceinline__ int crow(int reg, int hh) { return (reg & 3) + 8 * (reg >> 2) + 4 * hh; }
template <int S> __device__ __forceinline__ bf16x8 pack_step(const f32x16& x) {
    v4u p; p.x = cvtpk(x[8 * S], x[8 * S + 1]); p.y = cvtpk(x[8 * S + 2], x[8 * S + 3]); p.z = cvtpk(x[8 * S + 4], x[8 * S + 5]); p.w = cvtpk(x[8 * S + 6], x[8 * S + 7]);
    return __builtin_bit_cast(bf16x8, p);
}
__device__ __forceinline__ bf16x8 frag2(const v2u& lo, const v2u& hi) { v4u p; p.x = lo.x; p.y = lo.y; p.z = hi.x; p.w = hi.y; return __builtin_bit_cast(bf16x8, p); }
__device__ __forceinline__ f32x16 zero16() { f32x16 z; for (int i = 0; i < 16; ++i) z[i] = 0.f; return z; }


__device__ __forceinline__ void p2_conv(const P& p, int tid) {
    const bf16* MLQK = (const bf16*)(p.ws + WS_MLQK); bf16* QC = (bf16*)(p.ws + WS_QC); bf16* KC = (bf16*)(p.ws + WS_KC);
    const int cg = tid & 127, ch0 = 8 * cg;
    float cw[4][8], cb[8];
#pragma unroll
    for (int i = 0; i < 8; ++i) { cb[i] = p.conv_b[ch0 + i];
#pragma unroll
        for (int j = 0; j < 4; ++j) cw[j][i] = p.conv_w[j * 1024 + ch0 + i]; }
    const float osc = cg >= 64 ? 0.08838834764831845f : 1.f;
    bf16* dst = (cg >= 64 ? KC : QC) + (cg & 63) * 8;
    for (int rg = blockIdx.x * 4 + (tid >> 7); rg < T_ / 4; rg += gridDim.x * 4) {
        const int tok = rg * 4, pos0 = tok & (S_ - 1);
        v4u xr[7];
#pragma unroll
        for (int k = 0; k < 7; ++k) xr[k] = (pos0 + k - 3 >= 0) ? *(const v4u*)(MLQK + (size_t)(tok + k - 3) * 1024 + ch0) : (v4u){0u, 0u, 0u, 0u};
#pragma unroll
        for (int tt = 0; tt < 4; ++tt) {
            float y[8];
#pragma unroll
            for (int i = 0; i < 8; ++i) y[i] = cb[i];
#pragma unroll
            for (int j = 0; j < 4; ++j) { float f[8]; unpack8(xr[tt + j], f);
#pragma unroll
                for (int i = 0; i < 8; ++i) y[i] += cw[j][i] * f[i]; }
#pragma unroll
            for (int i = 0; i < 8; ++i) y[i] = y[i] * sigmoidf_(y[i]) * osc;
            *(v4u*)(dst + (size_t)(tok + tt) * 512) = pack8(y);
        }
    }
}

constexpr int ML_QS = 0, ML_KS = 17408, ML_KWT = 34816, ML_VTL = 53248, ML_PS = 71680, ML_CT = 80896, ML_SCAL = 115712, ML_SSP = 118272, ML_QN = ML_SSP + 512, ML_F1 = ML_QN + 256, ML_F2 = ML_F1 + 256, ML_NV = ML_F2 + 256;
static_assert(ML_NV + 512 <= RING_BYTES, "mLSTM LDS map");
__device__ __forceinline__ void mlstm_scal(float ip, float fp, LAS float* sc, float& m_carry, int lane) {
    const float lf = fminf(fp, 0.f) - log1pf(expf(-fabsf(fp)));
    float bc = lf;
#pragma unroll
    for (int o = 1; o < 64; o <<= 1) { const float t2 = __shfl_up(bc, o); if (lane >= o) bc += t2; }
    const float a = ip - bc; float pm = a;
#pragma unroll
    for (int o = 1; o < 64; o <<= 1) { const float t2 = __shfl_up(pm, o); if (lane >= o) pm = fmaxf(pm, t2); }
    const float M = fmaxf(m_carry, pm);
    const float M63 = __shfl(M, 63), bc63 = __shfl(bc, 63);
    sc[lane] = a; sc[64 + lane] = M; sc[128 + lane] = expf(a - M63); sc[192 + lane] = expf(m_carry - M); sc[256 + lane] = expf(-(bc + M));
    m_carry = bc63 + M63;
}
__device__ __forceinline__ void mlstm_item(const P& p, LAS unsigned char* lds, int item, int tid, int wave, int lane) {
    const int b = item >> 2, h = item & 3;
    const int r = lane & 31, hh = lane >> 5, et = wave & 3, th = wave >> 2;
    const bf16* QC = (const bf16*)(p.ws + WS_QC); const bf16* KC = (const bf16*)(p.ws + WS_KC); const bf16* MLV = (const bf16*)(p.ws + WS_MLV); const float* IFG = (const float*)(p.ws + WS_IFG);
    bf16* HML = (bf16*)p.out + (size_t)T_ * 512;
    LAS float* SCAL = (LAS float*)(lds + ML_SCAL); LAS float* SSP = (LAS float*)(lds + ML_SSP); LAS float* QN = (LAS float*)(lds + ML_QN);
    LAS float* F1 = (LAS float*)(lds + ML_F1); LAS float* F2 = (LAS float*)(lds + ML_F2); LAS float* NV = (LAS float*)(lds + ML_NV);
    const int cg = tid & 15, trow = tid >> 4, eg = cg, sl = trow;
    const size_t hq = (size_t)h * 128 + 8 * cg;
    for (int i = tid; i < (128 * 136 * 2) / 4; i += NTHR) ((LAS unsigned*)(lds + ML_CT))[i] = 0u;
    if (tid < 128) NV[tid] = 0.f;
    f32x16 accC[2]; accC[0] = zero16(); accC[1] = zero16();
    float m_carry = 0.f;
    if (wave == 3) { const size_t tk = (size_t)b * S_ + lane; mlstm_scal(IFG[tk * 8 + h], IFG[tk * 8 + 4 + h], SCAL, m_carry, lane); }
    v4u pq[2], pk[2], pv[2];
    {
        const size_t t0 = (size_t)b * S_;
#pragma unroll
        for (int u = 0; u < 2; ++u) { pq[u] = *(const v4u*)(QC + (t0 + trow + 32 * u) * 512 + hq); pk[u] = *(const v4u*)(KC + (t0 + trow + 32 * u) * 512 + hq); pv[u] = *(const v4u*)(MLV + (t0 + sl + 32 * u) * 512 + hq); }
    }
    float ipn = 0.f, fpn = 0.f;
    __syncthreads();
    for (int c = 0; c < 32; ++c) {
        const size_t tok0 = (size_t)b * S_ + c * 64;
        LAS float* sc = SCAL + (c & 1) * 320;
        {
#pragma unroll
            for (int u = 0; u < 2; ++u) {
                const int t = trow + 32 * u;
                *(LAS v4u*)(lds + ML_QS + t * 272 + cg * 16) = pq[u];
                *(LAS v4u*)(lds + ML_KS + t * 272 + cg * 16) = pk[u];
                float f[8]; unpack8(pk[u], f);
                const float wk = sc[128 + t];
#pragma unroll
                for (int i = 0; i < 8; ++i) *(LAS bf16*)(lds + ML_KWT + (8 * cg + i) * 144 + ((t ^ (8 * (cg & 7))) * 2)) = (bf16)f2bf(f[i] * wk);
                const unsigned vv[4] = {pv[u].x, pv[u].y, pv[u].z, pv[u].w};
#pragma unroll
                for (int i = 0; i < 4; ++i) {
                    *(LAS bf16*)(lds + ML_VTL + (8 * eg + 2 * i) * 144 + ((t ^ (8 * (eg & 7))) * 2)) = (bf16)(vv[i] & 0xffffu);
                    *(LAS bf16*)(lds + ML_VTL + (8 * eg + 2 * i + 1) * 144 + ((t ^ (8 * (eg & 7))) * 2)) = (bf16)(vv[i] >> 16);
                }
            }
            if (c + 1 < 32) {
                const size_t t1 = tok0 + 64;
#pragma unroll
                for (int u = 0; u < 2; ++u) { pq[u] = *(const v4u*)(QC + (t1 + trow + 32 * u) * 512 + hq); pk[u] = *(const v4u*)(KC + (t1 + trow + 32 * u) * 512 + hq); pv[u] = *(const v4u*)(MLV + (t1 + sl + 32 * u) * 512 + hq); }
                if (wave == 3) { ipn = IFG[(t1 + lane) * 8 + h]; fpn = IFG[(t1 + lane) * 8 + 4 + h]; }
            }
        }
        __syncthreads();
        f32x16 acc_inter = zero16();
        if (wave < 3) {
            const int tt = wave > 0 ? 1 : 0, st = wave == 2 ? 1 : 0;
            f32x16 zt = zero16();
#pragma unroll
            for (int ks = 0; ks < 8; ++ks) {
                const bf16x8 ka = *(const LAS bf16x8*)(lds + ML_KS + (32 * st + r) * 272 + 32 * ks + 16 * hh);
                const bf16x8 qb = *(const LAS bf16x8*)(lds + ML_QS + (32 * tt + r) * 272 + 32 * ks + 16 * hh);
                zt = MFMA32(ka, qb, zt);
            }
            const int t = 32 * tt + r; const float Mt = sc[64 + t];
            float ps = 0.f;
#pragma unroll
            for (int g = 0; g < 4; ++g) {
                const f32x4 av = *(const LAS f32x4*)(sc + 32 * st + 8 * g + 4 * hh);
                float pv[4];
#pragma unroll
                for (int q = 0; q < 4; ++q) { const int sidx = 32 * st + 8 * g + 4 * hh + q;
                    const float wgt = sidx <= t ? expf(av[q] - Mt) : 0.f; pv[q] = zt[4 * g + q] * wgt; ps += pv[q]; }
                *(LAS v2u*)(lds + ML_PS + t * 144 + (32 * st + 8 * g + 4 * hh) * 2) = (v2u){cvtpk(pv[0], pv[1]), cvtpk(pv[2], pv[3])};
            }
            ps += __shfl_xor(ps, 32);
            if (hh == 0) { SSP[st * 64 + t] = ps; if (wave == 0) SSP[64 + t] = 0.f; }
        }
        if (wave == 3 && c + 1 < 32) mlstm_scal(ipn, fpn, SCAL + ((c + 1) & 1) * 320, m_carry, lane);
#pragma unroll
        for (int ks = 0; ks < 8; ++ks) {
            const bf16x8 qa = *(const LAS bf16x8*)(lds + ML_QS + (32 * th + r) * 272 + 32 * ks + 16 * hh);
            const bf16x8 cbf = *(const LAS bf16x8*)(lds + ML_CT + (32 * et + r) * 272 + 32 * ks + 16 * hh);
            acc_inter = MFMA32(qa, cbf, acc_inter);
        }
        {
            const int t = tid >> 3, part = tid & 7;
            float f[8], sum = 0.f;
            { const v4u tq = *(const LAS v4u*)(lds + ML_QS + t * 272 + part * 32); unpack8(tq, f); }
#pragma unroll
            for (int i = 0; i < 8; ++i) sum += f[i] * NV[16 * part + i];
            { const v4u tq = *(const LAS v4u*)(lds + ML_QS + t * 272 + part * 32 + 16); unpack8(tq, f); }
#pragma unroll
            for (int i = 0; i < 8; ++i) sum += f[i] * NV[16 * part + 8 + i];
            sum += __shfl_xor(sum, 1); sum += __shfl_xor(sum, 2); sum += __shfl_xor(sum, 4);
            if (part == 0) QN[t] = sum;
        }
        __syncthreads();
        f32x16 acc_intra = zero16();
#pragma unroll
        for (int ks = 0; ks < 4; ++ks) {
            if (ks < 2 || th == 1) {
                const bf16x8 pa = *(const LAS bf16x8*)(lds + ML_PS + (32 * th + r) * 144 + 32 * ks + 16 * hh);
                const bf16x8 vb = *(const LAS bf16x8*)(lds + ML_VTL + (32 * et + r) * 144 + 16 * ((2 * ks + hh) ^ (((32 * et + r) >> 3) & 7)));
                acc_intra = MFMA32(pa, vb, acc_intra);
            }
        }
        if (tid < 64) {
            const float wi = sc[192 + tid];
            const float den = SSP[tid] + SSP[64 + tid] + wi * QN[tid];
            const float f1 = 1.f / fmaxf(fabsf(den), sc[256 + tid]);
            F1[tid] = f1; F2[tid] = wi * f1;
        }
        const float decay = sc[192 + 63];
#pragma unroll
        for (int dt = 0; dt < 2; ++dt) {
#pragma unroll
            for (int i = 0; i < 16; ++i) accC[dt][i] *= decay;
#pragma unroll
            for (int ks = 0; ks < 4; ++ks) {
                const bf16x8 ka = *(const LAS bf16x8*)(lds + ML_KWT + (64 * th + 32 * dt + r) * 144 + 16 * ((2 * ks + hh) ^ (((64 * th + 32 * dt + r) >> 3) & 7)));
                const bf16x8 vb = *(const LAS bf16x8*)(lds + ML_VTL + (32 * et + r) * 144 + 16 * ((2 * ks + hh) ^ (((32 * et + r) >> 3) & 7)));
                accC[dt] = MFMA32(ka, vb, accC[dt]);
            }
        }
        {
            const int d = tid >> 2, part = tid & 3;
            float f[8], sum = 0.f;
            { const v4u tq = *(const LAS v4u*)(lds + ML_KWT + d * 144 + part * 32); unpack8(tq, f); }
#pragma unroll
            for (int i = 0; i < 8; ++i) sum += f[i];
            { const v4u tq = *(const LAS v4u*)(lds + ML_KWT + d * 144 + part * 32 + 16); unpack8(tq, f); }
#pragma unroll
            for (int i = 0; i < 8; ++i) sum += f[i];
            sum += __shfl_xor(sum, 1); sum += __shfl_xor(sum, 2);
            if (part == 0) NV[d] = decay * NV[d] + sum;
        }
        __syncthreads();
        {
            bf16* hp = HML + (tok0 + 32 * th) * 512 + h * 128 + 32 * et + r;
#pragma unroll
            for (int g = 0; g < 4; ++g) {
                const f32x4 f1v = *(const LAS f32x4*)(F1 + 32 * th + 8 * g + 4 * hh), f2v = *(const LAS f32x4*)(F2 + 32 * th + 8 * g + 4 * hh);
#pragma unroll
                for (int q = 0; q < 4; ++q) { const int tl = 8 * g + 4 * hh + q;
                    hp[(size_t)tl * 512] = (bf16)f2bf(acc_intra[4 * g + q] * f1v[q] + acc_inter[4 * g + q] * f2v[q]); }
            }
#pragma unroll
            for (int dt = 0; dt < 2; ++dt)
#pragma unroll
                for (int g = 0; g < 4; ++g)
                    *(LAS v2u*)(lds + ML_CT + (32 * et + r) * 272 + (64 * th + 32 * dt + 8 * g + 4 * hh) * 2) = (v2u){cvtpk(accC[dt][4 * g], accC[dt][4 * g + 1]), cvtpk(accC[dt][4 * g + 2], accC[dt][4 * g + 3])};
        }
    }
    __syncthreads();
}

__device__ __forceinline__ void sba_wave_item(const bf16* __restrict__ QK, const bf16* __restrict__ VT, bf16* __restrict__ YSB, int b, int h, int qt, int lane) {
    const int r = lane & 31, hh = lane >> 5, t0 = qt * 32;
    const size_t rowbase = (size_t)b * S_;
    bf16x8 qf[4];
    {
        const bf16* qp = QK + (rowbase + t0 + r) * 1024 + h * 64 + 8 * hh;
#pragma unroll
        for (int ks = 0; ks < 4; ++ks) qf[ks] = *(const bf16x8*)(qp + 16 * ks);
    }
    bf16x8 tri[2];
#pragma unroll
    for (int s2 = 0; s2 < 2; ++s2)
#pragma unroll
        for (int j = 0; j < 8; ++j) { const int rho = 16 * s2 + 8 * (j >> 2) + 4 * hh + (j & 3); tri[s2][j] = (rho > r) ? (short)0x3F80 : (short)0; }
    f32x16 o0 = zero16(), o1 = zero16();
    float carry = 0.f;
    const bf16* kbase = QK + rowbase * 1024 + 512 + h * 64 + 8 * hh + (size_t)r * 1024;
    const bf16* vbase = VT + ((size_t)(b * 8 + h) * 64 + r) * 2048 + 4 * hh;
    bf16x8 kf[4]; v2u vl[2][2], vh[2][2];
#pragma unroll
    for (int ks = 0; ks < 4; ++ks) kf[ks] = *(const bf16x8*)(kbase + (size_t)t0 * 1024 + 16 * ks);
#pragma unroll
    for (int dt = 0; dt < 2; ++dt)
#pragma unroll
        for (int s2 = 0; s2 < 2; ++s2) { const bf16* vp = vbase + (size_t)dt * 32 * 2048 + t0 + 16 * s2; vl[dt][s2] = *(const v2u*)vp; vh[dt][s2] = *(const v2u*)(vp + 8); }
    for (int s0 = t0; s0 >= 0; s0 -= 32) {
        bf16x8 kn[4]; v2u vln[2][2], vhn[2][2];
        const int sn = s0 >= 32 ? s0 - 32 : 0;
#pragma unroll
        for (int ks = 0; ks < 4; ++ks) kn[ks] = *(const bf16x8*)(kbase + (size_t)sn * 1024 + 16 * ks);
#pragma unroll
        for (int dt = 0; dt < 2; ++dt)
#pragma unroll
            for (int s2 = 0; s2 < 2; ++s2) { const bf16* vp = vbase + (size_t)dt * 32 * 2048 + sn + 16 * s2; vln[dt][s2] = *(const v2u*)vp; vhn[dt][s2] = *(const v2u*)(vp + 8); }
        f32x16 z = zero16();
#pragma unroll
        for (int ks = 0; ks < 4; ++ks) z = MFMA32(kf[ks], qf[ks], z);
        const bool diag = (s0 == t0);
        f32x16 sp; float rs = 0.f;
#pragma unroll
        for (int i = 0; i < 16; ++i) {
            const float zz = z[i] * 0.125f;
            const bool valid = !diag || (crow(i, hh) < r);
            float spv = fmaxf(zz, 0.f) + __logf(1.f + __expf(-fabsf(zz)));
            spv = valid ? spv : 0.f;
            sp[i] = spv; rs += spv; z[i] = zz - spv;
        }
        f32x16 suf = zero16();
        suf = MFMA32(tri[0], pack_step<0>(sp), suf);
        suf = MFMA32(tri[1], pack_step<1>(sp), suf);
        f32x16 w;
#pragma unroll
        for (int i = 0; i < 16; ++i) {
            const bool valid = !diag || (crow(i, hh) < r);
            const float lw = z[i] - suf[i] - carry;
            w[i] = valid ? __expf(lw) : 0.f;
        }
        rs += __shfl_xor(rs, 32);
        carry += rs;
        const bf16x8 pa0 = pack_step<0>(w), pa1 = pack_step<1>(w);
        o0 = MFMA32(pa0, frag2(vl[0][0], vh[0][0]), o0); o0 = MFMA32(pa1, frag2(vl[0][1], vh[0][1]), o0);
        o1 = MFMA32(pa0, frag2(vl[1][0], vh[1][0]), o1); o1 = MFMA32(pa1, frag2(vl[1][1], vh[1][1]), o1);
        if (__all(carry > 104.f)) break;
#pragma unroll
        for (int ks = 0; ks < 4; ++ks) kf[ks] = kn[ks];
#pragma unroll
        for (int dt = 0; dt < 2; ++dt)
#pragma unroll
            for (int s2 = 0; s2 < 2; ++s2) { vl[dt][s2] = vln[dt][s2]; vh[dt][s2] = vhn[dt][s2]; }
    }
    bf16* op = YSB + (rowbase + t0) * 512 + h * 64 + r;
#pragma unroll
    for (int i = 0; i < 16; ++i) { const int t = crow(i, hh); op[(size_t)t * 512] = (bf16)f2bf(o0[i]); op[(size_t)t * 512 + 32] = (bf16)f2bf(o1[i]); }
}
__device__ __forceinline__ void sba_item(const P& p, int item, int wave, int lane) {
    const int bh = item >> 3, qb = item & 7, b = bh >> 3, h = bh & 7;
    sba_wave_item((const bf16*)(p.ws + WS_SBQKV), (const bf16*)(p.ws + WS_VT), (bf16*)p.out, b, h, qb * 8 + wave, lane);
}

__device__ __forceinline__ void p3_yml(const P& p, int wave, int lane) {
    const int gw = blockIdx.x * NWAVES + wave, NGW = gridDim.x * NWAVES;
    bf16* YML = (bf16*)p.out + (size_t)T_ * 512; const bf16* MLO = (const bf16*)(p.ws + WS_MLO);
    for (int m = gw; m < T_; m += NGW) {
        float hv[8], ov[8], o[8];
        unpack8(*(const v4u*)(YML + (size_t)m * 512 + lane * 8), hv); unpack8(*(const v4u*)(MLO + (size_t)m * 512 + lane * 8), ov);
        float ss = 0.f;
#pragma unroll
        for (int i = 0; i < 8; ++i) ss += hv[i] * hv[i];
        ss += __shfl_xor(ss, 1); ss += __shfl_xor(ss, 2); ss += __shfl_xor(ss, 4); ss += __shfl_xor(ss, 8);
        const float rstd = 1.f / sqrtf(ss * (1.f / 128.f) + EPS);
        const f32x4 w0 = *(const f32x4*)(p.ml_norm_w + lane * 8), w1 = *(const f32x4*)(p.ml_norm_w + lane * 8 + 4);
        const float wv[8] = {w0.x, w0.y, w0.z, w0.w, w1.x, w1.y, w1.z, w1.w};
#pragma unroll
        for (int i = 0; i < 8; ++i) o[i] = sigmoidf_(ov[i]) * hv[i] * rstd * wv[i];
        *(v4u*)(YML + (size_t)m * 512 + lane * 8) = pack8(o);
    }
}

__device__ __forceinline__ void p6_hn(const P& p, int wave, int lane) {
    const int gw = blockIdx.x * NWAVES + wave, NGW = gridDim.x * NWAVES;
    const float* H = (const float*)(p.ws + WS_H); bf16* HN = (bf16*)(p.ws + WS_HN);
    for (int m = gw; m < T_; m += NGW) {
        const f32x4* xr = (const f32x4*)(H + (size_t)m * 1024) + lane; const f32x4* wr = (const f32x4*)p.norm_ffn_w + lane;
        f32x4 v[4]; float ss = 0.f;
#pragma unroll
        for (int j = 0; j < 4; ++j) { v[j] = xr[64 * j]; ss += (v[j].x * v[j].x + v[j].y * v[j].y) + (v[j].z * v[j].z + v[j].w * v[j].w); }
        const float rstd = 1.f / sqrtf(wave_sum(ss) * (1.f / 1024.f) + EPS);
        v2u* o8 = (v2u*)(HN + (size_t)m * 1024) + lane;
#pragma unroll
        for (int j = 0; j < 4; ++j) { const f32x4 w = wr[64 * j]; o8[64 * j] = (v2u){pk2(v[j].x * rstd * w.x, v[j].y * rstd * w.y), pk2(v[j].z * rstd * w.z, v[j].w * rstd * w.w)}; }
    }
}

__device__ __forceinline__ float ffn_rstd(const float* SS, int m) {
    const f32x4* q = (const f32x4*)(SS + (size_t)m * 16); const f32x4 a = q[0], b = q[1], c = q[2], d = q[3];
    const float t = ((a.x + a.y) + (a.z + a.w)) + ((b.x + b.y) + (b.z + b.w)) + ((c.x + c.y) + (c.z + c.w)) + ((d.x + d.y) + (d.z + d.w));
    return 1.f / sqrtf(t * (1.f / 1024.f) + EPS);
}
__device__ __forceinline__ unsigned ord_key(float f) { const unsigned u = __builtin_bit_cast(unsigned, f); return (u & 0x80000000u) ? ~u : (u | 0x80000000u); }
__device__ __forceinline__ float ord_val(unsigned k) { const unsigned u = (k & 0x80000000u) ? (k & 0x7fffffffu) : ~k; return __builtin_bit_cast(float, u); }
template <int CTRL> __device__ __forceinline__ unsigned dpp_u(unsigned v) { return (unsigned)__builtin_amdgcn_update_dpp(0, (int)v, CTRL, 0xF, 0xF, true); }
__device__ __forceinline__ unsigned umax_(unsigned a, unsigned b) { return a > b ? a : b; }
__device__ __forceinline__ unsigned umin_(unsigned a, unsigned b) { return a < b ? a : b; }
__device__ __forceinline__ unsigned row_max_u(unsigned v) {
    v = umax_(v, dpp_u<0xB1>(v)); v = umax_(v, dpp_u<0x4E>(v)); v = umax_(v, dpp_u<0x141>(v)); v = umax_(v, dpp_u<0x140>(v)); return v;
}
__device__ __forceinline__ float row_sum_f(float v) {
    v += __builtin_bit_cast(float, dpp_u<0xB1>(__builtin_bit_cast(unsigned, v))); v += __builtin_bit_cast(float, dpp_u<0x4E>(__builtin_bit_cast(unsigned, v)));
    v += __builtin_bit_cast(float, dpp_u<0x141>(__builtin_bit_cast(unsigned, v))); v += __builtin_bit_cast(float, dpp_u<0x140>(__builtin_bit_cast(unsigned, v))); return v;
}
#define CE_(i, j) do { const unsigned _a = k[i], _b = k[j]; k[i] = umax_(_a, _b); k[j] = umin_(_a, _b); } while (0)
__device__ __forceinline__ unsigned row_top16(unsigned (&k)[8], unsigned (&top)[16], int li) {
    CE_(0, 1); CE_(2, 3); CE_(4, 5); CE_(6, 7); CE_(0, 2); CE_(1, 3); CE_(4, 6); CE_(5, 7); CE_(1, 2); CE_(5, 6);
    CE_(0, 4); CE_(1, 5); CE_(2, 6); CE_(3, 7); CE_(2, 4); CE_(3, 5); CE_(1, 2); CE_(3, 4); CE_(5, 6);
    unsigned mine = 0u;
#pragma unroll
    for (int n = 0; n < 16; ++n) {
        const unsigned m = row_max_u(k[0]);
        const bool hit = k[0] == m;
#pragma unroll
        for (int i = 0; i < 7; ++i) k[i] = hit ? k[i + 1] : k[i];
        k[7] = hit ? 0u : k[7];
        top[n] = m; mine = (li == n) ? m : mine;
    }
    return mine;
}
__device__ __forceinline__ void topk_core(const float (&s1)[8], const float (&s2)[8], float rstd, int li, int lane, int& e_out, float& g_out) {
    unsigned k[8], top1[16], top2[16];
#pragma unroll
    for (int j = 0; j < 8; ++j) k[j] = (ord_key(s1[j]) & ~0x7fu) | (unsigned)(127 - (li + 16 * j));
    const unsigned mine1 = row_top16(k, top1, li);
#pragma unroll
    for (int j = 0; j < 8; ++j) k[j] = (ord_key(s2[j]) & ~0x7fu) | (unsigned)(127 - (li + 16 * j));
    const unsigned mine2 = row_top16(k, top2, li);
    const float v2 = ord_val(mine2 & ~0x7fu);
    unsigned c[16];
#pragma unroll
    for (int j = 0; j < 16; ++j) {
        const float v1 = ord_val(top1[j] & ~0x7fu);
        const unsigned key = (ord_key(v1 + v2) & ~0xffu) | (unsigned)(255 - (16 * j + li));
        c[j] = ((j + 1) * (li + 1) <= 16) ? key : 0u;
    }
    unsigned tk = 0u, t0 = 0u;
#pragma unroll
    for (int n = 0; n < 16; ++n) {
        const unsigned mx = row_max_u(c[0]);
        const bool hit = c[0] == mx;
#pragma unroll
        for (int i = 0; i < 15; ++i) c[i] = hit ? c[i + 1] : c[i];
        c[15] = hit ? 0u : c[15];
        if (n == 0) t0 = mx;
        tk = (li == n) ? mx : tk;
    }
    const float sv = ord_val(tk & ~0xffu), s0 = ord_val(t0 & ~0xffu);
    const int cc = 255 - (int)(tk & 0xffu), a = (cc >> 4) & 15, bb = cc & 15;
    const int i1 = 127 - (int)((unsigned)__shfl((int)mine1, (lane & 48) + a) & 0x7fu), i2 = 127 - (int)((unsigned)__shfl((int)mine2, (lane & 48) + bb) & 0x7fu);
    const float pe = expf((sv - s0) * rstd);
    const float den = row_sum_f(pe);
    e_out = i1 * 128 + i2; g_out = pe / den;
}
constexpr int TK_RS = 1040;
struct EpiTopk {
    static constexpr bool PERM = true, AFTER_DRAIN = true;
    int* IDX; float* GATE; const float* SS;
    __device__ __forceinline__ void fused(pg8::f32x4 (&acc)[2][2][4][2], const pg8::Unit& u, int wr, int wc, int fr, int fq, PG8_LAS unsigned char* lds, int wid, int lane) const {
        const int head = u.pn, q = lane >> 4, li = lane & 15;
#pragma unroll
        for (int ai = 0; ai < 2; ++ai) {
#pragma unroll
            for (int m = 0; m < 4; ++m)
#pragma unroll
                for (int bj = 0; bj < 2; ++bj) {
                    PG8_LAS unsigned char* dst = lds + (wr * 64 + m * 16 + fr) * TK_RS + (bj * 128 + wc * 32 + 8 * fq) * 4;
                    *(PG8_LAS pg8::f32x4*)dst = acc[ai][bj][m][0]; *(PG8_LAS pg8::f32x4*)(dst + 16) = acc[ai][bj][m][1];
                }
            __syncthreads();
#pragma unroll 1
            for (int it = 0; it < 4; ++it) {
                const int rowl = 16 * wid + 4 * it + q, m = u.pm * 256 + ai * 128 + rowl;
                const PG8_LAS float* sr = (const PG8_LAS float*)(lds + rowl * TK_RS);
                float s1[8], s2[8];
#pragma unroll
                for (int j = 0; j < 8; ++j) { s1[j] = sr[li + 16 * j]; s2[j] = sr[128 + li + 16 * j]; }
                int e; float g;
                topk_core(s1, s2, ffn_rstd(SS, m), li, lane, e, g);
                IDX[(size_t)m * 128 + head * 16 + li] = e; GATE[(size_t)m * 128 + head * 16 + li] = g;
            }
            __syncthreads();
        }
    }
};
struct OneUnit {
    pg8::Unit u;
    __device__ __forceinline__ bool next(int i, pg8::Unit& o) const { if (i) return false; o = u; return true; }
    __device__ __forceinline__ void a_ready(const pg8::Unit&) const {}
    __device__ __forceinline__ void done(const pg8::Unit&) const {}
};

__device__ __forceinline__ float gelu_erf(float x) { return 0.5f * x * (1.f + erff(x * 0.70710678118654752f)); }
typedef float f32x2 __attribute__((ext_vector_type(2)));
__device__ __forceinline__ void cvt16_fp8(const v4u& w, f32x2 (&f)[8]) {
    f[0] = __builtin_amdgcn_cvt_pk_f32_fp8((int)w.x, false); f[1] = __builtin_amdgcn_cvt_pk_f32_fp8((int)w.x, true);
    f[2] = __builtin_amdgcn_cvt_pk_f32_fp8((int)w.y, false); f[3] = __builtin_amdgcn_cvt_pk_f32_fp8((int)w.y, true);
    f[4] = __builtin_amdgcn_cvt_pk_f32_fp8((int)w.z, false); f[5] = __builtin_amdgcn_cvt_pk_f32_fp8((int)w.z, true);
    f[6] = __builtin_amdgcn_cvt_pk_f32_fp8((int)w.w, false); f[7] = __builtin_amdgcn_cvt_pk_f32_fp8((int)w.w, true);
}
__device__ __forceinline__ float grp8_sum(float v) {
    v += __builtin_bit_cast(float, dpp_u<0xB1>(__builtin_bit_cast(unsigned, v)));
    v += __builtin_bit_cast(float, dpp_u<0x4E>(__builtin_bit_cast(unsigned, v)));
    v += __builtin_bit_cast(float, dpp_u<0x141>(__builtin_bit_cast(unsigned, v)));
    return v;
}
typedef int i32x4 __attribute__((ext_vector_type(4)));
template <int PAT> __device__ __forceinline__ float swz_f(float v) { return __builtin_bit_cast(float, __builtin_amdgcn_ds_swizzle(__builtin_bit_cast(int, v), PAT)); }
__device__ __forceinline__ void peer_u_token(const v4u (&ur)[16], const f32x2 (&xv)[8], float* dst, int c8) {
    float d[16];
#pragma unroll
    for (int i = 0; i < 16; ++i) {
        f32x2 f[8]; cvt16_fp8(ur[i], f);
        f32x2 s2 = f[0] * xv[0];
#pragma unroll
        for (int q = 1; q < 8; ++q) s2 += f[q] * xv[q];
        d[i] = s2.x + s2.y;
    }
    const bool b0 = (c8 & 1) != 0, b1 = (c8 & 2) != 0, b2 = (c8 & 4) != 0;
    float e8[8], e4[4], e2[2];
#pragma unroll
    for (int i = 0; i < 8; ++i) { const float keep = b0 ? d[2 * i + 1] : d[2 * i], send = b0 ? d[2 * i] : d[2 * i + 1];
        e8[i] = keep + __builtin_bit_cast(float, dpp_u<0xB1>(__builtin_bit_cast(unsigned, send))); }
#pragma unroll
    for (int i = 0; i < 4; ++i) { const float keep = b1 ? e8[2 * i + 1] : e8[2 * i], send = b1 ? e8[2 * i] : e8[2 * i + 1];
        e4[i] = keep + __builtin_bit_cast(float, dpp_u<0x4E>(__builtin_bit_cast(unsigned, send))); }
#pragma unroll
    for (int i = 0; i < 2; ++i) { const float keep = b2 ? e4[2 * i + 1] : e4[2 * i], send = b2 ? e4[2 * i] : e4[2 * i + 1];
        e2[i] = keep + swz_f<0x1F | (4 << 10)>(send); }
    dst[c8] = e2[0]; dst[c8 + 8] = e2[1];
}
__device__ __forceinline__ void peer_u(const P& p, int wave, int lane) {
    const int j = blockIdx.x & 7, nchunk = gridDim.x >> 3, chunk = blockIdx.x >> 3, stride = nchunk * 8;
    const int g = lane >> 3, c8 = lane & 7;
    const bf16* HN = (const bf16*)p.out + 128 * j + 16 * c8; const int* IDX = (const int*)(p.ws + WS_IDX) + 16 * g;
    const unsigned char* US = p.ws + WS_U8 + (size_t)j * NEXP * 128 + 16 * c8;
    float* PART = (float*)(p.ws + WS_PART) + (size_t)j * T_ * 128 + 16 * g;
    const int m0 = chunk * 8 + wave, ntok = (T_ - m0 + stride - 1) / stride;
#define PU_CLAMP(k) (m0 + ((k) < ntok ? (k) : ntok - 1) * stride)
#define PU_ROWS(ur, ei) _Pragma("unroll") for (int i = 0; i < 16; ++i) ur[i] = *(const v4u*)(US + (size_t)ei[i >> 2][i & 3] * 128)
#define PU_L1(ei, h0, h1, mm) do { _Pragma("unroll") for (int q = 0; q < 4; ++q) ei[q] = *(const i32x4*)(IDX + (size_t)(mm) * 128 + 4 * q); \
        h0 = *(const v4u*)(HN + (size_t)(mm) * 1024); h1 = *(const v4u*)(HN + (size_t)(mm) * 1024 + 8); } while (0)
#define PU_X(xv, h0, h1) do { float f_[8]; unpack8(h0, f_); _Pragma("unroll") for (int i = 0; i < 4; ++i) xv[i] = (f32x2){f_[2 * i], f_[2 * i + 1]}; \
        unpack8(h1, f_); _Pragma("unroll") for (int i = 0; i < 4; ++i) xv[4 + i] = (f32x2){f_[2 * i], f_[2 * i + 1]}; } while (0)
    i32x4 ei[4]; v4u hA0, hA1, hB0, hB1; v4u urA[16], urB[16]; f32x2 xv[8];
    PU_L1(ei, hA0, hA1, m0);
    PU_ROWS(urA, ei);
    PU_L1(ei, hB0, hB1, PU_CLAMP(1));
    for (int k = 0; k < ntok; k += 2) {
        PU_ROWS(urB, ei);
        PU_X(xv, hA0, hA1);
        PU_L1(ei, hA0, hA1, PU_CLAMP(k + 2));
        peer_u_token(urA, xv, PART + (size_t)(m0 + k * stride) * 128, c8);
        if (k + 1 < ntok) {
            PU_ROWS(urA, ei);
            PU_X(xv, hB0, hB1);
            PU_L1(ei, hB0, hB1, PU_CLAMP(k + 3));
            peer_u_token(urB, xv, PART + (size_t)(m0 + (k + 1) * stride) * 128, c8);
        }
    }
#undef PU_CLAMP
#undef PU_ROWS
#undef PU_L1
#undef PU_X
}
__device__ __forceinline__ void peer_c(const P& p, int wave, int lane) {
    const int gw = blockIdx.x * NWAVES + wave, NGW = gridDim.x * NWAVES;
    const int* IDX = (const int*)(p.ws + WS_IDX); const float* GATE = (const float*)(p.ws + WS_GATE); const float* PART = (const float*)(p.ws + WS_PART);
    const float* USC = (const float*)(p.ws + WS_USC); const float* VSC = (const float*)(p.ws + WS_VSC); float* COEF = (float*)(p.ws + WS_COEF); const float* SS = (const float*)(p.ws + WS_SS);
    for (int m = gw; m < T_; m += NGW) {
        const float rs = ffn_rstd(SS, m);
        float s0 = 0.f, s1 = 0.f;
#pragma unroll
        for (int jj = 0; jj < 8; ++jj) { s0 += PART[((size_t)jj * T_ + m) * 128 + lane]; s1 += PART[((size_t)jj * T_ + m) * 128 + 64 + lane]; }
        const int e0 = IDX[(size_t)m * 128 + lane], e1 = IDX[(size_t)m * 128 + 64 + lane];
        const float g0 = GATE[(size_t)m * 128 + lane], g1 = GATE[(size_t)m * 128 + 64 + lane];
        COEF[(size_t)m * 128 + lane] = g0 * gelu_erf(s0 * rs * USC[e0]) * VSC[e0];
        COEF[(size_t)m * 128 + 64 + lane] = g1 * gelu_erf(s1 * rs * USC[e1]) * VSC[e1];
    }
}
struct PvPre { i32x4 ei[4]; float c0, c1; };
__device__ __forceinline__ void pv_level1(PvPre& q, const int* IDXg, const float* COEFg, int m, int c8) {
#pragma unroll
    for (int k = 0; k < 4; ++k) q.ei[k] = *(const i32x4*)(IDXg + (size_t)m * 128 + 4 * k);
    q.c0 = COEFg[(size_t)m * 128 + c8]; q.c1 = COEFg[(size_t)m * 128 + c8 + 8];
}
__device__ __forceinline__ void peer_v_token(const v4u (&vr)[16], float coef0, float coef1, const float* H, float* out, float* ssq, bool b3, bool b4, bool b5, int lane) {
    f32x2 acc[8];
#pragma unroll
    for (int i = 0; i < 8; ++i) acc[i] = (f32x2){0.f, 0.f};
#define PV_STEP(I) do { const float cs_ = ((I) >> 3) ? coef1 : coef0; \
        const float cu_ = swz_f<0x18 | (((I) & 7) << 5)>(cs_);     \
        const f32x2 c2_ = (f32x2){cu_, cu_}; f32x2 f_[8]; cvt16_fp8(vr[I], f_); \
        _Pragma("unroll") for (int q = 0; q < 8; ++q) acc[q] += c2_ * f_[q]; } while (0)
    PV_STEP(0); PV_STEP(1); PV_STEP(2); PV_STEP(3); PV_STEP(4); PV_STEP(5); PV_STEP(6); PV_STEP(7);
    PV_STEP(8); PV_STEP(9); PV_STEP(10); PV_STEP(11); PV_STEP(12); PV_STEP(13); PV_STEP(14); PV_STEP(15);
#undef PV_STEP
    f32x2 a1[4], a2[2], a3;
#pragma unroll
    for (int i = 0; i < 4; ++i) { const f32x2 keep = b5 ? acc[2 * i + 1] : acc[2 * i], send = b5 ? acc[2 * i] : acc[2 * i + 1];
        a1[i] = keep + (f32x2){__shfl_xor(send.x, 32), __shfl_xor(send.y, 32)}; }
#pragma unroll
    for (int i = 0; i < 2; ++i) { const f32x2 keep = b4 ? a1[2 * i + 1] : a1[2 * i], send = b4 ? a1[2 * i] : a1[2 * i + 1];
        a2[i] = keep + (f32x2){swz_f<0x1F | (16 << 10)>(send.x), swz_f<0x1F | (16 << 10)>(send.y)}; }
    { const f32x2 keep = b3 ? a2[1] : a2[0], send = b3 ? a2[0] : a2[1]; a3 = keep + (f32x2){swz_f<0x1F | (8 << 10)>(send.x), swz_f<0x1F | (8 << 10)>(send.y)}; }
    const f32x2 hv = *(const f32x2*)H;
    const f32x2 y = hv + a3;
    *(f32x2*)out = y;
    const float ss = wave_sum(y.x * y.x + y.y * y.y);
    if (lane == 0) *ssq = ss;
}
__device__ __forceinline__ void peer_v(const P& p, int wave, int lane) {
    const int j = blockIdx.x & 7, nchunk = gridDim.x >> 3, chunk = blockIdx.x >> 3, stride = nchunk * 8;
    const int g = lane >> 3, c8 = lane & 7;
    const bool b5 = (lane & 32) != 0, b4 = (lane & 16) != 0, b3 = (lane & 8) != 0;
    const int pi = 4 * (b3 ? 1 : 0) + 2 * (b4 ? 1 : 0) + (b5 ? 1 : 0);
    const size_t colo = 128 * j + 16 * c8 + 2 * pi;
    const float* H = (const float*)(p.ws + WS_H) + colo; float* OUT = p.out + colo;
    const int* IDXg = (const int*)(p.ws + WS_IDX) + 16 * g; const float* COEFg = (const float*)(p.ws + WS_COEF) + 16 * g;
    const unsigned char* VS = p.ws + WS_V8 + (size_t)j * NEXP * 128 + 16 * c8;
    float* SSQ = (float*)(p.ws + WS_SSQ) + (size_t)j * T_;
    const int m0 = chunk * 8 + wave, ntok = (T_ - m0 + stride - 1) / stride;
#define PV_CLAMP(k) (m0 + ((k) < ntok ? (k) : ntok - 1) * stride)
#define PV_ROWS(vr, q) _Pragma("unroll") for (int i = 0; i < 16; ++i) vr[i] = *(const v4u*)(VS + (size_t)q.ei[i >> 2][i & 3] * 128)
    PvPre q; v4u vrA[16], vrB[16];
    pv_level1(q, IDXg, COEFg, m0, c8);
    PV_ROWS(vrA, q);
    float cA0 = q.c0, cA1 = q.c1, cB0, cB1;
    pv_level1(q, IDXg, COEFg, PV_CLAMP(1), c8);
    for (int k = 0; k < ntok; k += 2) {
        PV_ROWS(vrB, q); cB0 = q.c0; cB1 = q.c1;
        pv_level1(q, IDXg, COEFg, PV_CLAMP(k + 2), c8);
        { const size_t mm = (size_t)(m0 + k * stride); peer_v_token(vrA, cA0, cA1, H + mm * 1024, OUT + mm * 1024, SSQ + mm, b3, b4, b5, lane); }
        if (k + 1 < ntok) {
            PV_ROWS(vrA, q); cA0 = q.c0; cA1 = q.c1;
            pv_level1(q, IDXg, COEFg, PV_CLAMP(k + 3), c8);
            { const size_t mm = (size_t)(m0 + (k + 1) * stride); peer_v_token(vrB, cB0, cB1, H + mm * 1024, OUT + mm * 1024, SSQ + mm, b3, b4, b5, lane); }
        }
    }
#undef PV_CLAMP
#undef PV_ROWS
}
__device__ __forceinline__ void peer_f(const P& p, int wave, int lane) {
    const int gw = blockIdx.x * NWAVES + wave, NGW = gridDim.x * NWAVES;
    const float* SSQ = (const float*)(p.ws + WS_SSQ);
    for (int m = gw; m < T_; m += NGW) {
        float ss = 0.f;
#pragma unroll
        for (int jj = 0; jj < 8; ++jj) ss += SSQ[(size_t)jj * T_ + m];
        const float rstd = 1.f / sqrtf(ss * (1.f / 1024.f) + EPS);
        f32x4* o = (f32x4*)(p.out + (size_t)m * 1024) + lane; const f32x4* wr = (const f32x4*)p.norm_final_w + lane;
#pragma unroll
        for (int q = 0; q < 4; ++q) { const f32x4 v = o[64 * q], w = wr[64 * q]; o[64 * q] = (f32x4){v.x * rstd * w.x, v.y * rstd * w.y, v.z * rstd * w.z, v.w * rstd * w.w}; }
    }
}

constexpr int N_PHASES = 12;
struct Args { P p; int ph_lo, ph_hi; };
__global__ void __launch_bounds__(NTHR, 2) fwd_kernel(Args args) {
    extern __shared__ __attribute__((aligned(16))) unsigned char lds_raw[];
    LAS unsigned char* lds = (LAS unsigned char*)lds_raw;
    const P& p = args.p;
    const int tid = threadIdx.x, lane = tid & 63, wave = __builtin_amdgcn_readfirstlane(tid >> 6);
    volatile LAS unsigned* MISC = (volatile LAS unsigned*)(lds + MISC_OFF);
    for (int u = tid; u < (LDS_BYTES - LDSCTL_OFF) / 4; u += NTHR) ((LAS unsigned*)(lds + LDSCTL_OFF))[u] = 0u;
    __syncthreads();
    XcdBarrier bar; bar.bar = (unsigned*)(p.ws + WS_CTL) + CW_BAR; bar.x = 0; bar.st = nullptr;
#if !MK_PER_PHASE
    bar = xcd_barrier_post((unsigned*)(p.ws + WS_CTL) + CW_BAR, MISC + 8);
#endif
    const int lo = args.ph_lo, hi = args.ph_hi;
#define IN(k) (lo <= (k) && (k) < hi)
#ifndef PROBE_WAIT_LO
#define PROBE_WAIT_LO -1
#define PROBE_WAIT_HI -1
#endif
    volatile LAS unsigned long long* STAMP = (volatile LAS unsigned long long*)(lds + MISC_OFF + 256);
#define SEAM(k) do { if (IN(k) && IN((k) + 1)) xcd_barrier(bar); if (PROBE_WAIT_LO >= 0 && blockIdx.x == 0 && tid == 0) STAMP[(k) + 1] = __builtin_amdgcn_s_memrealtime(); } while (0)
    if (PROBE_WAIT_LO >= 0 && blockIdx.x == 0 && tid == 0) STAMP[0] = __builtin_amdgcn_s_memrealtime();

#ifndef PROBE_REP
#define PROBE_REP -1
#endif
#define REP(k) ((PROBE_REP == (k)) ? 2 : 1)
    if (IN(0)) {
#pragma unroll 1
        for (int r = 0; r < REP(0); ++r) p0_prologue(p, lds, wave, lane); } SEAM(0);
    if (IN(1)) {
#pragma unroll 1
      for (int r = 0; r < REP(1); ++r) {
        EpiProj e{(bf16*)(p.ws + WS_SBQKV), (bf16*)(p.ws + WS_VT), (bf16*)(p.ws + WS_MLQK), (bf16*)(p.ws + WS_MLV), (bf16*)(p.ws + WS_MLO), (bf16*)(p.ws + WS_GATES)};
        gemm<EpiProj>(lds, (const bf16*)(p.ws + WS_XN), (const bf16*)(p.ws + WS_W1T), T_, NPROJ, 1024, e); }
    } SEAM(1);
    if (IN(2)) { p2_conv(p, tid); } SEAM(2);
    if (IN(3)) {
        for (int it = blockIdx.x; it < 64; it += gridDim.x) mlstm_item(p, lds, it, tid, wave, lane);
        unsigned* qctr = (unsigned*)(p.ws + WS_CTL) + CW_Q;
        for (;;) {
            if (tid == 0) MISC[12] = __hip_atomic_fetch_add(qctr, 1u, __ATOMIC_RELAXED, __HIP_MEMORY_SCOPE_AGENT);
            __syncthreads();
            const unsigned it = MISC[12];
            __syncthreads();
            if (it >= 1024u) break;
            sba_item(p, (int)it, wave, lane);
        }
        for (;;) {
            if (tid == 0) MISC[12] = __hip_atomic_fetch_add(qctr + 128, 1u, __ATOMIC_RELAXED, __HIP_MEMORY_SCOPE_AGENT);
            __syncthreads();
            const unsigned it = MISC[12];
            __syncthreads();
            if (it >= (unsigned)N_FILL) break;
            fill_item(p, (int)it, wave, lane);
        }
    } SEAM(3);
    if (IN(4)) { p3_yml(p, wave, lane); } SEAM(4);
    if (IN(5)) {
        EpiMergeA ea{(bf16*)(p.ws + WS_MERGED), (const bf16*)(p.ws + WS_GATES)};
        gemm<EpiMergeA>(lds, (const bf16*)p.out, (const bf16*)(p.ws + WS_WSBT), T_, 1024, 512, ea);
        VM_WAIT(); __syncthreads();
        EpiMergeB eb{(bf16*)(p.ws + WS_MERGED), (const bf16*)(p.ws + WS_GATES)};
        gemm<EpiMergeB>(lds, (const bf16*)p.out + (size_t)T_ * 512, (const bf16*)(p.ws + WS_WMLT), T_, 1024, 512, eb);
    } SEAM(5);
    if (IN(6)) {
        pg8::Gemm g{(const bf16*)(p.ws + WS_MERGED), (const bf16*)(p.ws + WS_WOUTT), T_, 1024, 1024}; pg8::StaticOrder S; S.init(T_, 1024, (int)gridDim.x, (int)blockIdx.x);
        EpiHW e{(float*)(p.ws + WS_H), p.x, (bf16*)p.out  , p.norm_ffn_w, (float*)(p.ws + WS_SS)};
        pg8::gemm_phase<EpiHW, pg8::StaticOrder, true, true>(lds, g, S, e);
    } SEAM(6);
    if (IN(7)) {
        pg8::Gemm g{(const bf16*)p.out, (const bf16*)(p.ws + WS_WCT), T_, 2048, 1024}; pg8::StaticOrder S; S.init(T_, 2048, (int)gridDim.x, (int)blockIdx.x);
        EpiTopk e{(int*)(p.ws + WS_IDX), (float*)(p.ws + WS_GATE), (const float*)(p.ws + WS_SS)};
#pragma unroll 1
        for (int i = 0;; ++i) { OneUnit s1; if (!S.next(i, s1.u)) break; pg8::gemm_phase<EpiTopk, OneUnit, false, true>(lds, g, s1, e); }
    } SEAM(7);
    if (IN(8)) { peer_u(p, wave, lane); } SEAM(8);
    if (IN(9)) { peer_c(p, wave, lane); } SEAM(9);
    if (IN(10)) { peer_v(p, wave, lane); } SEAM(10);
    if (IN(11)) { peer_f(p, wave, lane); }
    if (PROBE_WAIT_LO >= 0 && blockIdx.x == 0 && tid == 0) {
        const unsigned long long tend = __builtin_amdgcn_s_memrealtime();
        const unsigned long long thi = PROBE_WAIT_HI >= 12 ? tend : STAMP[PROBE_WAIT_HI < 0 ? 0 : PROBE_WAIT_HI];
        const unsigned long long dt = thi - STAMP[PROBE_WAIT_LO];
        while (__builtin_amdgcn_s_memrealtime() - tend < dt) __builtin_amdgcn_s_sleep(8);
    }
#undef IN
#undef SEAM
}

extern "C" void kernel_launch(void* const* d_in, const int* in_sizes, int n_in, void* d_out, int out_size, void* d_ws, size_t ws_size, hipStream_t stream) {
    static int grid = 0;
    if (grid == 0) {
        if (n_in != 18 || in_sizes[0] != T_ * D_ || out_size != T_ * D_ || ws_size < WS_END) {
            fprintf(stderr, "kernel_launch: unexpected problem (n_in %d, in0 %d, out %d, ws %zu); nothing launched\n", n_in, n_in > 0 ? in_sizes[0] : -1, out_size, ws_size); grid = -1; return; }
        int dev = 0, cus = 0, per_cu = 0;
        if (hipGetDevice(&dev) != hipSuccess || hipDeviceGetAttribute(&cus, hipDeviceAttributeMultiprocessorCount, dev) != hipSuccess) { grid = -1; return; }
        if (hipFuncSetAttribute((const void*)fwd_kernel, hipFuncAttributeMaxDynamicSharedMemorySize, LDS_BYTES) != hipSuccess) { fprintf(stderr, "kernel_launch: hipFuncSetAttribute failed\n"); grid = -1; return; }
        if (hipOccupancyMaxActiveBlocksPerMultiprocessor(&per_cu, (const void*)fwd_kernel, NTHR, LDS_BYTES) != hipSuccess || per_cu < 1)
            fprintf(stderr, "kernel_launch: note: occupancy query reports %d workgroups per CU\n", per_cu);
        (void)hipGetLastError();
        grid = cus;
    }
    if (grid < 0) return;
    if (hipMemsetAsync((char*)d_ws + WS_CTL, 0, CTL_ZERO_BYTES, stream) != hipSuccess) { fprintf(stderr, "kernel_launch: memset failed\n"); return; }
    Args a{};
    const float** pp = (const float**)&a.p;
    for (int i = 0; i < 18; ++i) pp[i] = (const float*)d_in[i];
    a.p.out = (float*)d_out; a.p.ws = (unsigned char*)d_ws;
#if MK_PER_PHASE
    for (int ph = 0; ph < N_PHASES; ++ph) {
        a.ph_lo = ph; a.ph_hi = ph + 1;
        hipLaunchKernelGGL(fwd_kernel, dim3(grid), dim3(NTHR), LDS_BYTES, stream, a);
    }
#else
    a.ph_lo = 0; a.ph_hi = N_PHASES;
    hipLaunchKernelGGL(fwd_kernel, dim3(grid), dim3(NTHR), LDS_BYTES, stream, a);
#endif
    const hipError_t le = hipPeekAtLastError();
    if (le != hipSuccess) fprintf(stderr, "kernel_launch: launch failed: %s\n", hipGetErrorName(le));
}
```

```cpp
#include <hip/hip_runtime.h>
#include <cstdio>
#include <cstdint>
namespace pg8 {
#define PG8_LAS __attribute__((address_space(3)))
typedef unsigned short bf16_t;
typedef short bf16x8 __attribute__((ext_vector_type(8)));
typedef float f32x4 __attribute__((ext_vector_type(4)));
typedef unsigned u32x4 __attribute__((ext_vector_type(4)));
constexpr int BM = 256, BK = 64, HALF = 128, HTB = HALF * BK * 2  , STAGE_BYTES = 8 * HTB, NXCD = 8, WGM = 8;

__host__ __device__ __forceinline__ int lds_byte(int r, int c) { const int st = (r >> 4) * 2 + (c >> 5), rr = r & 15, cc = c & 31, ob = rr * 64 + cc * 2; return st * 1024 + (ob ^ (((ob >> 9) & 1) << 5)); }
__host__ __device__ __forceinline__ void stage_rc(int b, int& R, int& C) { const int st = b / 1024, sb = b % 1024, swz = sb ^ (((sb >> 9) & 1) << 5); R = (st >> 1) * 16 + swz / 64; C = (st & 1) * 32 + (swz % 64) / 2; }
__host__ __device__ __forceinline__ int perm32(int rho) { const int n = rho >> 4, i = rho & 15; return 8 * (i >> 2) + 4 * n + (i & 3); }

struct Unit { int pm, pn; };
struct Gemm { const bf16_t* A; const bf16_t* Bt; int M, N, K; };

struct StaticOrder {
    int nM, nN, nwg, G, c;
    __host__ __device__ void init(int M, int N, int G_, int c_) { nM = M / BM; nN = N / BM; nwg = nM * nN; G = G_; c = c_; }
    __host__ __device__ bool next(int i, Unit& u) const {
        const long L = (long)i * G + c; if (L >= nwg) return false;
        int wgid = (int)L; { const int q = nwg / NXCD, r = nwg % NXCD, xcd = wgid % NXCD, off = wgid / NXCD; wgid = (xcd < r ? xcd * (q + 1) : r * (q + 1) + (xcd - r) * q) + off; }
        const int nig = WGM * nN, gid = wgid / nig, fm = gid * WGM, gsz = (nM - fm) < WGM ? (nM - fm) : WGM;
        u.pm = fm + ((wgid % nig) % gsz); u.pn = (wgid % nig) / gsz; return true;
    }
    __device__ __forceinline__ void a_ready(const Unit&) const {}
    __device__ __forceinline__ void done(const Unit&) const {}
};

__device__ __forceinline__ unsigned cvt_pk_bf16(float lo, float hi) { unsigned r; asm volatile("v_cvt_pk_bf16_f32 %0, %1, %2" : "=v"(r) : "v"(lo), "v"(hi)); return r; }
template <class Epi, class Sched, bool ALIGN_EPI = false, bool SP2 = false, bool MID = false  >
__device__ __forceinline__ void gemm_phase(PG8_LAS unsigned char* lds, const Gemm g, const Sched& S, const Epi& E) {
    const int tid = threadIdx.x, wid = __builtin_amdgcn_readfirstlane(tid >> 6), lane = tid & 63, wr = wid >> 2, wc = wid & 3, fr = lane & 15, fq = lane >> 4;
    const int K = g.K, nt = K / BK;
    unsigned voffA[2], voffB[2];
#pragma unroll
    for (int i = 0; i < 2; ++i) { int R, C; stage_rc(tid * 16 + i * 8192, R, C); const int Rb = Epi::PERM ? ((R & ~31) + perm32(R & 31)) : R;
        voffA[i] = (unsigned)(R * K + C) * 2u; voffB[i] = (unsigned)(Rb * K + C) * 2u; }
    const size_t kstep = (size_t)(BK * 2);
    const size_t hstep = (size_t)HALF * K * 2;
    const size_t tstep = 2 * hstep;
    const unsigned ldsw = (unsigned)wid * 1024u;
    const int aoff = lds_byte(wr * 64 + fr, fq * 8), boff = lds_byte(wc * 32 + fr, fq * 8);
#define PG8_SA(b, h) (((b) * 2 + (h)) * HTB)
#define PG8_SB(b, h) ((4 + (b) * 2 + (h)) * HTB)
#define PG8_STAGE(bufoff, gbase, voff) do { _Pragma("unroll") for (int _i = 0; _i < 2; ++_i) \
        __builtin_amdgcn_global_load_lds((const unsigned*)((const char*)(gbase) + (voff)[_i]), (PG8_LAS unsigned*)(lds + (bufoff) + ldsw + _i * 8192), 16, 0, 0); } while (0)
#define PG8_LDA(dst, b, h) do { _Pragma("unroll") for (int m = 0; m < 4; ++m) _Pragma("unroll") for (int k = 0; k < 2; ++k) dst[m][k] = *(const PG8_LAS bf16x8*)(lds + PG8_SA(b, h) + aoff + m * 2048 + k * 1024); } while (0)
#define PG8_LDB(dst, b, h) do { _Pragma("unroll") for (int n = 0; n < 2; ++n) _Pragma("unroll") for (int k = 0; k < 2; ++k) dst[n][k] = *(const PG8_LAS bf16x8*)(lds + PG8_SB(b, h) + boff + n * 2048 + k * 1024); } while (0)
#define PG8_MMA(ai, bj, At, Bt) do { __builtin_amdgcn_s_setprio(1); _Pragma("unroll") for (int m = 0; m < 4; ++m) _Pragma("unroll") for (int n = 0; n < 2; ++n) _Pragma("unroll") for (int k = 0; k < 2; ++k) \
        acc[ai][bj][m][n] = __builtin_amdgcn_mfma_f32_16x16x32_bf16(Bt[n][k], At[m][k], acc[ai][bj][m][n], 0, 0, 0); __builtin_amdgcn_s_setprio(0); } while (0)
#define PG8_WAIT_V(n) asm volatile("s_waitcnt vmcnt(" #n ")" ::: "memory")
#define PG8_WAIT_L(n) asm volatile("s_waitcnt lgkmcnt(" #n ")" ::: "memory")
#define PG8_BAR __builtin_amdgcn_s_barrier()
#define PG8_SCHED __builtin_amdgcn_sched_barrier(0)
    Unit cur, nxt; int ui = 0;
    if (!S.next(0, cur)) return;
    f32x4 acc[2][2][4][2];
#pragma unroll
    for (int a = 0; a < 2; ++a)
#pragma unroll
        for (int b = 0; b < 2; ++b)
#pragma unroll
            for (int m = 0; m < 4; ++m)
#pragma unroll
                for (int n = 0; n < 2; ++n) acc[a][b][m][n] = (f32x4){0.f, 0.f, 0.f, 0.f};
    bf16x8 At[4][2], B0[2][2], B1[2][2];
    const char* cA = (const char*)g.A + (size_t)cur.pm * tstep; const char* cB = (const char*)g.Bt + (size_t)cur.pn * tstep;
    S.a_ready(cur);
    if constexpr (SP2) {
        PG8_STAGE(PG8_SB(0, 0), cB, voffB); PG8_STAGE(PG8_SB(0, 1), cB + hstep, voffB); PG8_STAGE(PG8_SA(0, 0), cA, voffA); PG8_STAGE(PG8_SA(0, 1), cA + hstep, voffA);
        if (wr == 1) PG8_BAR;
        PG8_WAIT_V(2); PG8_BAR;
        PG8_STAGE(PG8_SB(1, 0), cB + kstep, voffB); PG8_STAGE(PG8_SA(1, 0), cA + kstep, voffA); PG8_STAGE(PG8_SB(1, 1), cB + hstep + kstep, voffB);
        PG8_WAIT_V(6); PG8_BAR;
    } else {
        PG8_STAGE(PG8_SB(0, 0), cB, voffB); PG8_STAGE(PG8_SA(0, 0), cA, voffA); PG8_STAGE(PG8_SB(0, 1), cB + hstep, voffB); PG8_STAGE(PG8_SA(0, 1), cA + hstep, voffA);
        if (wr == 1) PG8_BAR;
        PG8_WAIT_V(4); PG8_BAR;
        PG8_STAGE(PG8_SB(1, 0), cB + kstep, voffB); PG8_STAGE(PG8_SA(1, 0), cA + kstep, voffA); PG8_STAGE(PG8_SB(1, 1), cB + hstep + kstep, voffB);
        PG8_WAIT_V(6); PG8_BAR;
    }
    for (;;) {
        const bool has_next = S.next(ui + 1, nxt);
        const char* nA = has_next ? (const char*)g.A + (size_t)nxt.pm * tstep : cA; const char* nB = has_next ? (const char*)g.Bt + (size_t)nxt.pn * tstep : cB;
        for (int t = 0; t < nt; t += 2) {
            if constexpr (MID) { if (t == (nt >> 1)) E.mid(acc, cur, wr, wc, fr, fq); }
            const bool last = (t == nt - 2);
            const char* a1 = cA + (size_t)(t + 1) * kstep;
            const char* a2 = last ? nA : cA + (size_t)(t + 2) * kstep; const char* b2 = last ? nB : cB + (size_t)(t + 2) * kstep;
            const char* a3 = a2 + kstep; const char* b3 = b2 + kstep;
            if (last && has_next) S.a_ready(nxt);
            if constexpr (SP2) {
            PG8_LDB(B0, 0, 0); PG8_LDB(B1, 0, 1); PG8_SCHED; PG8_LDA(At, 0, 0); PG8_STAGE(PG8_SA(1, 1), a1 + hstep, voffA);
            PG8_WAIT_V(8); PG8_WAIT_L(0); PG8_BAR; PG8_MMA(0, 0, At, B0); PG8_MMA(0, 1, At, B1); PG8_BAR; PG8_SCHED;
            PG8_LDA(At, 0, 1); PG8_STAGE(PG8_SB(0, 0), b2, voffB); PG8_STAGE(PG8_SB(0, 1), b2 + hstep, voffB); PG8_STAGE(PG8_SA(0, 0), a2, voffA);
            PG8_WAIT_V(8); PG8_WAIT_L(0); PG8_BAR; PG8_MMA(1, 0, At, B0); PG8_MMA(1, 1, At, B1); PG8_BAR; PG8_SCHED;
            PG8_LDB(B0, 1, 0); PG8_LDB(B1, 1, 1); PG8_SCHED; PG8_LDA(At, 1, 0); PG8_STAGE(PG8_SA(0, 1), a2 + hstep, voffA);
            PG8_WAIT_V(8); PG8_WAIT_L(0); PG8_BAR; PG8_MMA(0, 0, At, B0); PG8_MMA(0, 1, At, B1); PG8_BAR; PG8_SCHED;
            PG8_LDA(At, 1, 1); PG8_STAGE(PG8_SB(1, 0), b3, voffB); PG8_STAGE(PG8_SB(1, 1), b3 + hstep, voffB); PG8_STAGE(PG8_SA(1, 0), a3, voffA);
            PG8_WAIT_V(8); PG8_WAIT_L(0); PG8_BAR; PG8_MMA(1, 0, At, B0); PG8_MMA(1, 1, At, B1); PG8_BAR; PG8_SCHED;
            } else {
            PG8_LDB(B0, 0, 0); PG8_SCHED; PG8_LDA(At, 0, 0); PG8_STAGE(PG8_SA(1, 1), a1 + hstep, voffA);
            PG8_WAIT_L(8); PG8_BAR; PG8_WAIT_L(0); PG8_MMA(0, 0, At, B0); PG8_BAR; PG8_SCHED;
            PG8_LDB(B1, 0, 1); PG8_STAGE(PG8_SB(0, 0), b2, voffB);
            PG8_BAR; PG8_WAIT_L(0); PG8_MMA(0, 1, At, B1); PG8_BAR;
            PG8_LDA(At, 0, 1); PG8_STAGE(PG8_SA(0, 0), a2, voffA);
            PG8_BAR; PG8_WAIT_L(0); PG8_MMA(1, 0, At, B0); PG8_BAR; PG8_SCHED;
            PG8_STAGE(PG8_SB(0, 1), b2 + hstep, voffB);
            PG8_WAIT_V(6); PG8_BAR; PG8_MMA(1, 1, At, B1); PG8_BAR;
            PG8_LDB(B0, 1, 0); PG8_SCHED; PG8_LDA(At, 1, 0); PG8_STAGE(PG8_SA(0, 1), a2 + hstep, voffA);
            PG8_WAIT_L(8); PG8_BAR; PG8_WAIT_L(0); PG8_MMA(0, 0, At, B0); PG8_BAR; PG8_SCHED;
            PG8_LDB(B1, 1, 1); PG8_STAGE(PG8_SB(1, 0), b3, voffB);
            PG8_BAR; PG8_WAIT_L(0); PG8_MMA(0, 1, At, B1); PG8_BAR;
            PG8_LDA(At, 1, 1); PG8_STAGE(PG8_SA(1, 0), a3, voffA);
            PG8_BAR; PG8_WAIT_L(0); PG8_MMA(1, 0, At, B0); PG8_BAR; PG8_SCHED;
            PG8_STAGE(PG8_SB(1, 1), b3 + hstep, voffB);
            PG8_WAIT_V(6); PG8_BAR; PG8_MMA(1, 1, At, B1); PG8_BAR;
            }
        }
        if constexpr (ALIGN_EPI) { if (wr == 0) PG8_BAR; }
        if constexpr (!Epi::AFTER_DRAIN) { E(acc, cur, wr, wc, fr, fq); S.done(cur); }
        if (!has_next) break;
#pragma unroll
        for (int a = 0; a < 2; ++a)
#pragma unroll
            for (int b = 0; b < 2; ++b)
#pragma unroll
                for (int m = 0; m < 4; ++m)
#pragma unroll
                    for (int n = 0; n < 2; ++n) acc[a][b][m][n] = (f32x4){0.f, 0.f, 0.f, 0.f};
        cur = nxt; cA = nA; cB = nB; ++ui;
        if constexpr (ALIGN_EPI) { if (wr == 1) PG8_BAR; }
    }
    PG8_WAIT_V(0);
    if constexpr (!ALIGN_EPI) { if (wr == 0) PG8_BAR; }
    PG8_BAR;
    if constexpr (Epi::AFTER_DRAIN) { E.fused(acc, cur, wr, wc, fr, fq, lds, wid, lane); S.done(cur); }
#undef PG8_SA
#undef PG8_SB
#undef PG8_STAGE
#undef PG8_LDA
#undef PG8_LDB
#undef PG8_MMA
#undef PG8_WAIT_V
#undef PG8_WAIT_L
#undef PG8_BAR
#undef PG8_SCHED
}
}

#ifndef MK_PER_PHASE
#define MK_PER_PHASE 0
#endif
#ifndef USE_PG8
#define USE_PG8 1
#endif
constexpr int NWAVES = 8, NTHR = 512;

constexpr int B_ = 16, S_ = 2048, D_ = 1024, T_ = B_ * S_;
constexpr int INC = 5640, NPROJ = 5632;
constexpr int NEXP = 16384;
constexpr float EPS = 1e-6f;

constexpr size_t MiB = 1u << 20;
constexpr size_t WS_CTL = 0, CTL_ZERO_BYTES = 1 * MiB;
constexpr size_t WS_W1T = 2 * MiB, WS_WSBT = 13 * MiB, WS_WMLT = 14 * MiB, WS_WOUTT = 15 * MiB, WS_WCT = 17 * MiB, WS_IFG = 21 * MiB;
constexpr size_t WS_U8 = 24 * MiB, WS_V8 = 40 * MiB, WS_USC = 22 * MiB, WS_VSC = 23 * MiB;
constexpr size_t WS_XN = 88 * MiB, WS_QC = 88 * MiB, WS_KC = 120 * MiB;
constexpr size_t WS_SBQKV = 152 * MiB  , WS_VT = 216 * MiB  , WS_MLQK = 248 * MiB, WS_MLV = 312 * MiB, WS_MLO = 344 * MiB, WS_GATES = 376 * MiB;
constexpr size_t WS_MERGED = 216 * MiB, WS_H = 88 * MiB, WS_HN = 216 * MiB, WS_IDX = 280 * MiB, WS_GATE = 296 * MiB, WS_SC = 312 * MiB;
constexpr size_t WS_PART = 312 * MiB  , WS_SSQ = 504 * MiB  , WS_COEF = 56 * MiB  , WS_YB = 152 * MiB  , WS_HN8 = 440 * MiB  , WS_XS = 505 * MiB  , WS_SS = 506 * MiB  ;
constexpr size_t WS_END = 508 * MiB;
constexpr int CW_BAR = 4096, CW_Q = 8192;

constexpr int RING_OFF = 0, RING_BYTES = 135168;
constexpr int LDSCTL_OFF = RING_BYTES, MISC_OFF = LDSCTL_OFF + 320;
constexpr int LDS_BYTES = 147456;

#define GAS __attribute__((address_space(1)))
#define LAS __attribute__((address_space(3)))
typedef unsigned short bf16;
typedef unsigned v4u __attribute__((ext_vector_type(4)));
typedef unsigned v2u __attribute__((ext_vector_type(2)));
typedef float f32x4 __attribute__((ext_vector_type(4)));
#define LDS_WAIT() asm volatile("s_waitcnt lgkmcnt(0)" ::: "memory")
#define VM_WAIT() asm volatile("s_waitcnt vmcnt(0)" ::: "memory")
__device__ __forceinline__ unsigned f2bf(float f) { unsigned u = __builtin_bit_cast(unsigned, f); return (u + 0x7fffu + ((u >> 16) & 1u)) >> 16; }
__device__ __forceinline__ unsigned pk2(float lo, float hi) { return f2bf(lo) | (f2bf(hi) << 16); }
__device__ __forceinline__ float bflo(unsigned u) { return __builtin_bit_cast(float, u << 16); }
__device__ __forceinline__ float bfhi(unsigned u) { return __builtin_bit_cast(float, u & 0xffff0000u); }
__device__ __forceinline__ float bf2f(bf16 b) { return __builtin_bit_cast(float, (unsigned)b << 16); }
__device__ __forceinline__ float sigmoidf_(float x) { return 1.f / (1.f + __expf(-x)); }
__device__ __forceinline__ float wave_sum(float v) {
#pragma unroll
    for (int o = 1; o < 64; o <<= 1) v += __shfl_xor(v, o);
    return v;
}
__device__ __forceinline__ unsigned wave_max_u(unsigned v) {
#pragma unroll
    for (int o = 1; o < 64; o <<= 1) { const unsigned w = (unsigned)__shfl_xor((int)v, o); v = v > w ? v : w; }
    return v;
}
struct F8 { float v[8]; };
__device__ __forceinline__ void unpack8(const v4u& u, float (&f)[8]) {
    f[0] = bflo(u.x); f[1] = bfhi(u.x); f[2] = bflo(u.y); f[3] = bfhi(u.y); f[4] = bflo(u.z); f[5] = bfhi(u.z); f[6] = bflo(u.w); f[7] = bfhi(u.w);
}
__device__ __forceinline__ v4u pack8(const float (&f)[8]) { v4u o; o.x = pk2(f[0], f[1]); o.y = pk2(f[2], f[3]); o.z = pk2(f[4], f[5]); o.w = pk2(f[6], f[7]); return o; }

#define XB_TMO      128
#define XB_XCNT(j)  (256  + 64 * (j))
#define XB_XSUB(j)  (1280 + 64 * (j))
#define XB_XGEN(j)  (2304 + 64 * (j))
#define XB_TOP      3328
#define XB_TOPGEN   3392
#define XCD_BAR_WORDS 3456
#define XB_SPIN_CAP (1u << 24)

__device__ __forceinline__ unsigned xb_ld(unsigned* p)              { return __hip_atomic_load(p, __ATOMIC_RELAXED, __HIP_MEMORY_SCOPE_AGENT); }
__device__ __forceinline__ unsigned xb_add(unsigned* p, unsigned v) { return __hip_atomic_fetch_add(p, v, __ATOMIC_RELAXED, __HIP_MEMORY_SCOPE_AGENT); }
__device__ __forceinline__ unsigned xb_xcc_id() { return (unsigned)__builtin_amdgcn_s_getreg((3 << 11) | 20) & 0xFu; }
#define XB_SPIN(cond, bar) do { unsigned _sp = 0; while (cond) { __builtin_amdgcn_s_sleep(1); \
    if ((++_sp & 255u) == 0u) { if (xb_ld(&(bar)[XB_TMO])) break; if (_sp > XB_SPIN_CAP) { atomicAdd(&(bar)[XB_TMO], 1u); break; } } } } while (0)

struct XcdBarrier {
    unsigned* bar; unsigned x;
    volatile LAS unsigned* st;
};

__device__ __forceinline__ XcdBarrier xcd_barrier_post(unsigned* bar, volatile LAS unsigned* st) {
    XcdBarrier b; b.bar = bar; b.x = xb_xcc_id(); b.st = st;
    if (threadIdx.x == 0) (void)xb_add(&bar[XB_XCNT(b.x)], 1u);
    return b;
}
__device__ __forceinline__ void xcd_barrier_complete(unsigned* bar, unsigned x, unsigned& nloc, unsigned& nx) {
    const unsigned G = gridDim.x * gridDim.y * gridDim.z;
    unsigned sum, cnt, mine, sp = 0u;
    for (;;) {
        sum = 0u; cnt = 0u; mine = 0u;
#pragma unroll
        for (unsigned j = 0; j < 16; ++j) { const unsigned c = xb_ld(&bar[XB_XCNT(j)]); sum += c; cnt += (c > 0u) ? 1u : 0u; mine = (j == x) ? c : mine; }
        if (sum == G) break;
        __builtin_amdgcn_s_sleep(1);
        if ((++sp & 255u) == 0u) { if (xb_ld(&bar[XB_TMO])) break; if (sp > XB_SPIN_CAP) { atomicAdd(&bar[XB_TMO], 1u); break; } }
    }
    nloc = mine > 0u ? mine : 1u; nx = cnt > 0u ? cnt : 1u;
}

__device__ __forceinline__ void xcd_barrier(const XcdBarrier& b) {
    asm volatile("s_waitcnt vmcnt(0)" ::: "memory");
    __syncthreads();
    if (threadIdx.x == 0) {
        unsigned* bar = b.bar;
        __builtin_amdgcn_s_waitcnt(0);
        unsigned nloc = b.st[0], nx = b.st[1];
        if (nloc == 0u) { xcd_barrier_complete(bar, b.x, nloc, nx); b.st[0] = nloc; b.st[1] = nx; }
        const unsigned old = xb_add(&bar[XB_XSUB(b.x)], 1u);
        const unsigned gen = old / nloc;
        if (old + 1u == (gen + 1u) * nloc) {
            __builtin_amdgcn_fence(__ATOMIC_RELEASE, "agent");
            asm volatile("s_waitcnt vmcnt(0)" ::: "memory");
            const unsigned og = xb_add(&bar[XB_TOP], 1u);
            const unsigned tg = og / nx;
            if (og + 1u == (tg + 1u) * nx) xb_add(&bar[XB_TOPGEN], 1u);
            else XB_SPIN(xb_ld(&bar[XB_TOPGEN]) == tg, bar);
            __builtin_amdgcn_fence(__ATOMIC_ACQUIRE, "agent");
            xb_add(&bar[XB_XGEN(b.x)], 1u);
            asm volatile("s_waitcnt vmcnt(0)" ::: "memory");
        } else {
            XB_SPIN(xb_ld(&bar[XB_XGEN(b.x)]) == gen, bar);
            __builtin_amdgcn_fence(__ATOMIC_ACQUIRE, "agent");
            asm volatile("s_waitcnt vmcnt(0)" ::: "memory");
        }
    }
    __syncthreads();
}

struct EpiProj {
    bf16 *sbqk, *vt, *mlqk, *mlv, *mlo, *gates;
    __device__ __forceinline__ void operator()(int row, int col, const F8& a) const {
        bf16* dst;
        if (col < 1024) dst = sbqk + (size_t)row * 1024 + col;
        else if (col < 1536) {
            const int c = col - 1024, hh = c >> 6, d = c & 63, b = row >> 11, sq = row & 2047;
            bf16* vp = vt + ((size_t)(b * 8 + hh) * 64 + d) * 2048 + sq;
#pragma unroll
            for (int i = 0; i < 8; ++i) vp[(size_t)i * 2048] = (bf16)f2bf(a.v[i]);
            return;
        }
        else if (col < 2560) dst = mlqk + (size_t)row * 1024 + (col - 1536);
        else if (col < 3072) dst = mlv + (size_t)row * 512 + (col - 2560);
        else if (col < 3584) dst = mlo + (size_t)row * 512 + (col - 3072);
        else dst = gates + (size_t)row * 2048 + (col - 3584);
        *(v4u*)dst = pack8(a.v);
    }
};
struct EpiMergeA {
    bf16* merged; const bf16* gates;
    __device__ __forceinline__ void operator()(int row, int col, const F8& a) const {
        float g[8], o[8]; unpack8(*(const v4u*)(gates + (size_t)row * 2048 + col), g);
#pragma unroll
        for (int i = 0; i < 8; ++i) o[i] = sigmoidf_(g[i]) * a.v[i];
        *(v4u*)(merged + (size_t)row * 1024 + col) = pack8(o);
    }
};
struct EpiMergeB {
    bf16* merged; const bf16* gates;
    __device__ __forceinline__ void operator()(int row, int col, const F8& a) const {
        float g[8], o[8]; unpack8(*(const v4u*)(gates + (size_t)row * 2048 + 1024 + col), g);
        unpack8(*(const v4u*)(merged + (size_t)row * 1024 + col), o);
#pragma unroll
        for (int i = 0; i < 8; ++i) o[i] += sigmoidf_(g[i]) * a.v[i];
        *(v4u*)(merged + (size_t)row * 1024 + col) = pack8(o);
    }
};
struct EpiH {
    float* h; const float* x;
    __device__ __forceinline__ void operator()(int row, int col, const F8& a) const {
        const f32x4 x0 = *(const f32x4*)(x + (size_t)row * 1024 + col), x1 = *(const f32x4*)(x + (size_t)row * 1024 + col + 4);
        *(f32x4*)(h + (size_t)row * 1024 + col) = (f32x4){x0.x + a.v[0], x0.y + a.v[1], x0.z + a.v[2], x0.w + a.v[3]};
        *(f32x4*)(h + (size_t)row * 1024 + col + 4) = (f32x4){x1.x + a.v[4], x1.y + a.v[5], x1.z + a.v[6], x1.w + a.v[7]};
    }
};
struct EpiF32 {
    float* o; int ldc;
    __device__ __forceinline__ void operator()(int row, int col, const F8& a) const {
        *(f32x4*)(o + (size_t)row * ldc + col) = (f32x4){a.v[0], a.v[1], a.v[2], a.v[3]};
        *(f32x4*)(o + (size_t)row * ldc + col + 4) = (f32x4){a.v[4], a.v[5], a.v[6], a.v[7]};
    }
};

template <class E> struct EpiAdapt {
    static constexpr bool PERM = true, AFTER_DRAIN = false;
    E e;
    __device__ __forceinline__ void operator()(const pg8::f32x4 (&acc)[2][2][4][2], const pg8::Unit& u, int wr, int wc, int fr, int fq) const {
#pragma unroll
        for (int ai = 0; ai < 2; ++ai)
#pragma unroll
            for (int m = 0; m < 4; ++m) {
                const int row = u.pm * 256 + ai * 128 + wr * 64 + m * 16 + fr;
#pragma unroll
                for (int bj = 0; bj < 2; ++bj) {
                    const int col = u.pn * 256 + bj * 128 + wc * 32 + 8 * fq;
                    F8 a; const pg8::f32x4 v0 = acc[ai][bj][m][0], v1 = acc[ai][bj][m][1];
                    a.v[0] = v0[0]; a.v[1] = v0[1]; a.v[2] = v0[2]; a.v[3] = v0[3]; a.v[4] = v1[0]; a.v[5] = v1[1]; a.v[6] = v1[2]; a.v[7] = v1[3];
                    e(row, col, a);
                }
            }
    }
};

struct EpiMerge1 {
    static constexpr bool PERM = true, AFTER_DRAIN = false;
    bf16* merged; const bf16* gates;
    __device__ __forceinline__ void mid(pg8::f32x4 (&acc)[2][2][4][2], const pg8::Unit& u, int wr, int wc, int fr, int fq) const {
#pragma unroll
        for (int ai = 0; ai < 2; ++ai)
#pragma unroll
            for (int m = 0; m < 4; ++m) {
                const int row = u.pm * 256 + ai * 128 + wr * 64 + m * 16 + fr;
#pragma unroll
                for (int bj = 0; bj < 2; ++bj) {
                    const int col = u.pn * 256 + bj * 128 + wc * 32 + 8 * fq;
                    float gs[8], gm[8]; unpack8(*(const v4u*)(gates + (size_t)row * 2048 + col), gs); unpack8(*(const v4u*)(gates + (size_t)row * 2048 + 1024 + col), gm);
#pragma unroll
                    for (int i = 0; i < 8; ++i) { const float r = (1.f + __expf(-gm[i])) / (1.f + __expf(-gs[i])); acc[ai][bj][m][i >> 2][i & 3] *= r; }
                }
            }
    }
    __device__ __forceinline__ void operator()(const pg8::f32x4 (&acc)[2][2][4][2], const pg8::Unit& u, int wr, int wc, int fr, int fq) const {
#pragma unroll
        for (int ai = 0; ai < 2; ++ai)
#pragma unroll
            for (int m = 0; m < 4; ++m) {
                const int row = u.pm * 256 + ai * 128 + wr * 64 + m * 16 + fr;
#pragma unroll
                for (int bj = 0; bj < 2; ++bj) {
                    const int col = u.pn * 256 + bj * 128 + wc * 32 + 8 * fq;
                    float gm[8], o[8]; unpack8(*(const v4u*)(gates + (size_t)row * 2048 + 1024 + col), gm);
#pragma unroll
                    for (int i = 0; i < 8; ++i) o[i] = sigmoidf_(gm[i]) * acc[ai][bj][m][i >> 2][i & 3];
                    *(v4u*)(merged + (size_t)row * 1024 + col) = pack8(o);
                }
            }
    }
};
struct EpiHW {
    static constexpr bool PERM = true, AFTER_DRAIN = false;
    bf16* h; const float* x; bf16* hw; const float* wffn; float* ss;
    __device__ __forceinline__ void operator()(const pg8::f32x4 (&acc)[2][2][4][2], const pg8::Unit& u, int wr, int wc, int fr, int fq) const {
#pragma unroll
        for (int ai = 0; ai < 2; ++ai)
#pragma unroll
            for (int m = 0; m < 4; ++m) {
                const int row = u.pm * 256 + ai * 128 + wr * 64 + m * 16 + fr;
                float sq = 0.f;
#pragma unroll
                for (int bj = 0; bj < 2; ++bj) {
                    const int col = u.pn * 256 + bj * 128 + wc * 32 + 8 * fq;
                    const size_t o = (size_t)row * 1024 + col;
                    const f32x4 x0 = *(const f32x4*)(x + o), x1 = *(const f32x4*)(x + o + 4);
                    const f32x4 w0 = *(const f32x4*)(wffn + col), w1 = *(const f32x4*)(wffn + col + 4);
                    const pg8::f32x4 v0 = acc[ai][bj][m][0], v1 = acc[ai][bj][m][1];
                    const f32x4 h0 = (f32x4){x0.x + v0[0], x0.y + v0[1], x0.z + v0[2], x0.w + v0[3]}, h1 = (f32x4){x1.x + v1[0], x1.y + v1[1], x1.z + v1[2], x1.w + v1[3]};
                    *(v4u*)(h + o) = (v4u){pk2(h0.x, h0.y), pk2(h0.z, h0.w), pk2(h1.x, h1.y), pk2(h1.z, h1.w)};
                    *(v4u*)(hw + o) = (v4u){pk2(h0.x * w0.x, h0.y * w0.y), pk2(h0.z * w0.z, h0.w * w0.w), pk2(h1.x * w1.x, h1.y * w1.y), pk2(h1.z * w1.z, h1.w * w1.w)};
                    sq += (h0.x * h0.x + h0.y * h0.y) + (h0.z * h0.z + h0.w * h0.w) + (h1.x * h1.x + h1.y * h1.y) + (h1.z * h1.z + h1.w * h1.w);
                }
                sq += __shfl_xor(sq, 16); sq += __shfl_xor(sq, 32);
                if (fq == 0) ss[(size_t)row * 16 + u.pn * 4 + wc] = sq;
            }
    }
};

template <class E>
__device__ __forceinline__ void simple_gemm(LAS unsigned char* lds, const bf16* A, const bf16* Bt, int M, int N, int K, const E& e) {
    LAS float* As = (LAS float*)lds;
    LAS float* Bs = As + 32 * 132;
    const int tid = threadIdx.x, ty = tid >> 4, tx = tid & 15;
    const int ntn = N / 128, ntiles = (M / 128) * ntn;
    for (int tile = blockIdx.x; tile < ntiles; tile += gridDim.x) {
        const int tm = tile / ntn, tn = tile % ntn;
        float acc[4][8];
#pragma unroll
        for (int i = 0; i < 4; ++i)
#pragma unroll
            for (int j = 0; j < 8; ++j) acc[i][j] = 0.f;
        for (int k0 = 0; k0 < K; k0 += 32) {
            {
                const int r = tid >> 2, kq = (tid & 3) * 8;
                float fa[8], fb[8];
                unpack8(*(const v4u*)(A + (size_t)(tm * 128 + r) * K + k0 + kq), fa);
                unpack8(*(const v4u*)(Bt + (size_t)(tn * 128 + r) * K + k0 + kq), fb);
#pragma unroll
                for (int i = 0; i < 8; ++i) { As[(kq + i) * 132 + r] = fa[i]; Bs[(kq + i) * 132 + r] = fb[i]; }
            }
            __syncthreads();
#pragma unroll 8
            for (int k = 0; k < 32; ++k) {
                const f32x4 a4 = *(const LAS f32x4*)(As + k * 132 + ty * 4);
                const f32x4 b0 = *(const LAS f32x4*)(Bs + k * 132 + tx * 8), b1 = *(const LAS f32x4*)(Bs + k * 132 + tx * 8 + 4);
                const float av[4] = {a4.x, a4.y, a4.z, a4.w};
                const float bv[8] = {b0.x, b0.y, b0.z, b0.w, b1.x, b1.y, b1.z, b1.w};
#pragma unroll
                for (int i = 0; i < 4; ++i)
#pragma unroll
                    for (int j = 0; j < 8; ++j) acc[i][j] += av[i] * bv[j];
            }
            __syncthreads();
        }
#pragma unroll
        for (int i = 0; i < 4; ++i) {
            F8 a;
#pragma unroll
            for (int j = 0; j < 8; ++j) a.v[j] = acc[i][j];
            e(tm * 128 + ty * 4 + i, tn * 128 + tx * 8, a);
        }
    }
}

template <class E>
__device__ __forceinline__ void gemm(LAS unsigned char* lds, const bf16* A, const bf16* Bt, int M, int N, int K, const E& e) {
#if USE_PG8
    pg8::Gemm g{A, Bt, M, N, K}; pg8::StaticOrder S; S.init(M, N, (int)gridDim.x, (int)blockIdx.x);
    EpiAdapt<E> ea{e};
    pg8::gemm_phase<EpiAdapt<E>, pg8::StaticOrder, true, true>(lds, g, S, ea);
#else
    simple_gemm<E>(lds, A, Bt, M, N, K, e);
#endif
}

__device__ __forceinline__ void transpose_item(const float* W, int ldw, int K, bf16* WT, int src_col0, int dst_row0, LAS float* scr, int kb, int lane) {
    const int k0 = 64 * kb;
#pragma unroll 8
    for (int i = 0; i < 32; ++i) { const int kk = 2 * i + (lane >> 5); scr[kk * 33 + (lane & 31)] = W[(size_t)(k0 + kk) * ldw + src_col0 + (lane & 31)]; }
    LDS_WAIT(); asm volatile("" ::: "memory");
    const int c = lane & 7;
#pragma unroll
    for (int j = 0; j < 4; ++j) { const int n = (lane >> 3) + 8 * j; const LAS float* s = scr + (8 * c) * 33 + n;
        v4u o; o.x = pk2(s[0 * 33], s[1 * 33]); o.y = pk2(s[2 * 33], s[3 * 33]); o.z = pk2(s[4 * 33], s[5 * 33]); o.w = pk2(s[6 * 33], s[7 * 33]);
        *(v4u*)(WT + (size_t)(dst_row0 + n) * K + k0 + 8 * c) = o; }
    LDS_WAIT(); asm volatile("" ::: "memory");
}

struct P {
    const float *x, *norm_mix_w, *w_in, *conv_w, *conv_b, *b_i, *b_f, *ml_norm_w, *w_sb, *w_ml, *w_out, *norm_ffn_w, *w_query, *keys1, *keys2, *peer_u, *peer_v, *norm_final_w;
    float* out; unsigned char* ws;
};

__device__ __forceinline__ void p0_prologue(const P& p, LAS unsigned char* lds, int wave, int lane) {
    LAS float* scr = (LAS float*)(lds + wave * 8448);
    const int gw = blockIdx.x * NWAVES + wave, NGW = gridDim.x * NWAVES;
    bf16* W1T = (bf16*)(p.ws + WS_W1T); bf16* WSBT = (bf16*)(p.ws + WS_WSBT); bf16* WMLT = (bf16*)(p.ws + WS_WMLT); bf16* WOUTT = (bf16*)(p.ws + WS_WOUTT); bf16* WCT = (bf16*)(p.ws + WS_WCT);
    constexpr int I_1 = 16 * 176, I_SB = 8 * 32, I_ML = 8 * 32, I_O = 16 * 32, NT = I_1 + I_SB + I_ML + I_O;
    for (int it = gw; it < NT; it += NGW) {
        int r = it;
        if (r < I_1) { const int kb = r / 176, nb = r % 176, n0 = nb * 32; transpose_item(p.w_in, INC, 1024, W1T, n0 < 3584 ? n0 : n0 + 8, n0, scr, kb, lane); continue; } r -= I_1;
        if (r < I_SB) { const int kb = r / 32, nb = r % 32; transpose_item(p.w_sb, 1024, 1024, WSBT, nb * 32, nb * 32, scr, kb, lane);             continue; } r -= I_SB;
        if (r < I_ML) { const int kb = r / 32, nb = r % 32; transpose_item(p.w_ml, 1024, 1024, WSBT + 512, nb * 32, nb * 32, scr, kb, lane); continue; } r -= I_ML;
        { const int kb = r / 32, nb = r % 32; transpose_item(p.w_out, 1024, 1024, WOUTT, nb * 32, nb * 32, scr, kb, lane); }
    }
    bf16* XN = (bf16*)(p.ws + WS_XN); float* IFG = (float*)(p.ws + WS_IFG);
    LAS float* WG = (LAS float*)(lds + 8 * 8448);
    __syncthreads();
    for (int i = threadIdx.x; i < 2048; i += NTHR) { const int k = i >> 1, hf = i & 1; *(LAS f32x4*)(WG + k * 8 + hf * 4) = *(const f32x4*)(p.w_in + (size_t)k * INC + 3584 + hf * 4); }
    __syncthreads();
    for (int m = gw; m < T_; m += NGW) {
        const f32x4* xr = (const f32x4*)(p.x + (size_t)m * 1024) + lane;
        const f32x4* wr = (const f32x4*)p.norm_mix_w + lane;
        f32x4 v[4]; float ss = 0.f;
#pragma unroll
        for (int j = 0; j < 4; ++j) { v[j] = xr[64 * j]; ss += (v[j].x * v[j].x + v[j].y * v[j].y) + (v[j].z * v[j].z + v[j].w * v[j].w); }
        const float rstd = 1.f / sqrtf(wave_sum(ss) * (1.f / 1024.f) + EPS);
        float g[8];
#pragma unroll
        for (int i = 0; i < 8; ++i) g[i] = 0.f;
        v2u* o8 = (v2u*)(XN + (size_t)m * 1024) + lane;
#pragma unroll
        for (int j = 0; j < 4; ++j) {
            const f32x4 w = wr[64 * j];
            const float y[4] = {v[j].x * rstd * w.x, v[j].y * rstd * w.y, v[j].z * rstd * w.z, v[j].w * rstd * w.w};
            o8[64 * j] = (v2u){pk2(y[0], y[1]), pk2(y[2], y[3])};
#pragma unroll
            for (int q = 0; q < 4; ++q) {
                const int k = 256 * j + 4 * lane + q;
                const f32x4 w0 = *(const LAS f32x4*)(WG + k * 8), w1 = *(const LAS f32x4*)(WG + k * 8 + 4);
                g[0] += y[q] * w0.x; g[1] += y[q] * w0.y; g[2] += y[q] * w0.z; g[3] += y[q] * w0.w;
                g[4] += y[q] * w1.x; g[5] += y[q] * w1.y; g[6] += y[q] * w1.z; g[7] += y[q] * w1.w;
            }
        }
        {
            const bool b5 = (lane & 32) != 0, b4 = (lane & 16) != 0, b3 = (lane & 8) != 0;
            float e4[4], f2[2], gs;
#pragma unroll
            for (int i = 0; i < 4; ++i) { const float keep = b5 ? g[2 * i + 1] : g[2 * i], send = b5 ? g[2 * i] : g[2 * i + 1]; e4[i] = keep + __shfl_xor(send, 32); }
#pragma unroll
            for (int i = 0; i < 2; ++i) { const float keep = b4 ? e4[2 * i + 1] : e4[2 * i], send = b4 ? e4[2 * i] : e4[2 * i + 1]; f2[i] = keep + __shfl_xor(send, 16); }
            { const float keep = b3 ? f2[1] : f2[0], send = b3 ? f2[0] : f2[1]; gs = keep + __shfl_xor(send, 8); }
            gs += __shfl_xor(gs, 4); gs += __shfl_xor(gs, 2); gs += __shfl_xor(gs, 1);
            const int gi = 4 * (b3 ? 1 : 0) + 2 * (b4 ? 1 : 0) + (b5 ? 1 : 0);
            if ((lane & 7) == 0) IFG[(size_t)m * 8 + gi] = gs + (gi < 4 ? p.b_i[gi] : p.b_f[gi - 4]);
        }
    }
}

__device__ __forceinline__ void fill_wc(const P& p, int it, int lane) {
    bf16* WCT = (bf16*)(p.ws + WS_WCT);
    const int hhf = it >> 6, kb = (it >> 2) & 15, kq = it & 3, head = hhf >> 1, half = hhf & 1, k = kb * 64 + lane;
    const f32x4* wq = (const f32x4*)(p.w_query + (size_t)k * 2048 + head * 256 + half * 128);
    f32x4 wr[32];
#pragma unroll
    for (int i = 0; i < 32; ++i) wr[i] = wq[i];
    const float* kbase = (half ? p.keys2 : p.keys1) + ((size_t)head * 128 + kq * 32) * 128;
#pragma unroll 1
    for (int key = 0; key < 32; ++key) {
        const f32x4* kr = (const f32x4*)(kbase + (size_t)key * 128);
        float a0 = 0.f, a1 = 0.f;
#pragma unroll
        for (int i = 0; i < 32; i += 2) { const f32x4 b0 = kr[i], b1 = kr[i + 1];
            a0 += wr[i].x * b0.x + wr[i].y * b0.y + wr[i].z * b0.z + wr[i].w * b0.w;
            a1 += wr[i + 1].x * b1.x + wr[i + 1].y * b1.y + wr[i + 1].z * b1.z + wr[i + 1].w * b1.w; }
        WCT[(size_t)(hhf * 128 + kq * 32 + key) * 1024 + k] = (bf16)f2bf(a0 + a1);
    }
}
__device__ __forceinline__ void fill_tables(const P& p, int e, int lane) {
    unsigned char* U8 = p.ws + WS_U8; unsigned char* V8 = p.ws + WS_V8; float* USC = (float*)(p.ws + WS_USC); float* VSC = (float*)(p.ws + WS_VSC);
    f32x4 v[2][4]; float am[2] = {0.f, 0.f};
#pragma unroll
    for (int which = 0; which < 2; ++which) {
        const float* src = (which ? p.peer_v : p.peer_u) + (size_t)e * 1024 + 16 * lane;
#pragma unroll
        for (int j = 0; j < 4; ++j) v[which][j] = *(const f32x4*)(src + 4 * j);
    }
#pragma unroll
    for (int which = 0; which < 2; ++which)
#pragma unroll
        for (int j = 0; j < 4; ++j) am[which] = fmaxf(am[which], fmaxf(fmaxf(fabsf(v[which][j].x), fabsf(v[which][j].y)), fmaxf(fabsf(v[which][j].z), fabsf(v[which][j].w))));
#pragma unroll
    for (int o = 1; o < 64; o <<= 1) { am[0] = fmaxf(am[0], __shfl_xor(am[0], o)); am[1] = fmaxf(am[1], __shfl_xor(am[1], o)); }
#pragma unroll
    for (int which = 0; which < 2; ++which) {
        const float sc = am[which] > 0.f ? exp2f(floorf(log2f(448.f / am[which]))) : 1.f;
        unsigned w[4];
#pragma unroll
        for (int j = 0; j < 4; ++j) { int t = __builtin_amdgcn_cvt_pk_fp8_f32(v[which][j].x * sc, v[which][j].y * sc, 0, false); t = __builtin_amdgcn_cvt_pk_fp8_f32(v[which][j].z * sc, v[which][j].w * sc, t, true); w[j] = (unsigned)t; }
        *(v4u*)((which ? V8 : U8) + ((size_t)(lane >> 3) * NEXP + e) * 128 + 16 * (lane & 7)) = (v4u){w[0], w[1], w[2], w[3]};
        if (lane == 0) (which ? VSC : USC)[e] = 1.f / sc;
    }
}
constexpr int N_FILL = 128 + 1024;
__device__ __forceinline__ void fill_item(const P& p, int item, int wave, int lane) {
    if (item < 128) fill_wc(p, item * 8 + wave, lane);
    else { const int e0 = (item - 128) * 16 + wave * 2; fill_tables(p, e0, lane); fill_tables(p, e0 + 1, lane); }
}

typedef short bf16x8 __attribute__((ext_vector_type(8)));
typedef float f32x16 __attribute__((ext_vector_type(16)));
typedef float f32x2_t __attribute__((ext_vector_type(2))); typedef __bf16 bf16x2_t __attribute__((ext_vector_type(2)));
__device__ __forceinline__ unsigned cvtpk(float lo, float hi) { f32x2_t v = {lo, hi}; bf16x2_t b = __builtin_convertvector(v, bf16x2_t); return __builtin_bit_cast(unsigned, b); }
#define MFMA32(a, b, c) __builtin_amdgcn_mfma_f32_32x32x16_bf16((a), (b), (c), 0, 0, 0)
__device__ __forceinline__ int crow(int reg, int hh) { return (reg & 3) + 8 * (reg >> 2) + 4 * hh; }
template <int S> __device__ __forceinline__ bf16x8 pack_step(const f32x16& x) {
    v4u p; p.x = cvtpk(x[8 * S], x[8 * S + 1]); p.y = cvtpk(x[8 * S + 2], x[8 * S + 3]); p.z = cvtpk(x[8 * S + 4], x[8 * S + 5]); p.w = cvtpk(x[8 * S + 6], x[8 * S + 7]);
    return __builtin_bit_cast(bf16x8, p);
}
__device__ __forceinline__ bf16x8 frag2(const v2u& lo, const v2u& hi) { v4u p; p.x = lo.x; p.y = lo.y; p.z = hi.x; p.w = hi.y; return __builtin_bit_cast(bf16x8, p); }
__device__ __forceinline__ f32x16 zero16() { f32x16 z; for (int i = 0; i < 16; ++i) z[i] = 0.f; return z; }


__device__ __forceinline__ void p2_conv(const P& p, int tid) {
    const bf16* MLQK = (const bf16*)(p.ws + WS_MLQK); bf16* QC = (bf16*)(p.ws + WS_QC); bf16* KC = (bf16*)(p.ws + WS_KC);
    const int cg = tid & 127, ch0 = 8 * cg;
    float cw[4][8], cb[8];
#pragma unroll
    for (int i = 0; i < 8; ++i) { cb[i] = p.conv_b[ch0 + i];
#pragma unroll
        for (int j = 0; j < 4; ++j) cw[j][i] = p.conv_w[j * 1024 + ch0 + i]; }
    const float osc = cg >= 64 ? 0.08838834764831845f : 1.f;
    bf16* dst = (cg >= 64 ? KC : QC) + (cg & 63) * 8;
    for (int rg = blockIdx.x * 4 + (tid >> 7); rg < T_ / 4; rg += gridDim.x * 4) {
        const int tok = rg * 4, pos0 = tok & (S_ - 1);
        v4u xr[7];
#pragma unroll
        for (int k = 0; k < 7; ++k) xr[k] = (pos0 + k - 3 >= 0) ? *(const v4u*)(MLQK + (size_t)(tok + k - 3) * 1024 + ch0) : (v4u){0u, 0u, 0u, 0u};
#pragma unroll
        for (int tt = 0; tt < 4; ++tt) {
            float y[8];
#pragma unroll
            for (int i = 0; i < 8; ++i) y[i] = cb[i];
#pragma unroll
            for (int j = 0; j < 4; ++j) { float f[8]; unpack8(xr[tt + j], f);
#pragma unroll
                for (int i = 0; i < 8; ++i) y[i] += cw[j][i] * f[i]; }
#pragma unroll
            for (int i = 0; i < 8; ++i) y[i] = y[i] * sigmoidf_(y[i]) * osc;
            *(v4u*)(dst + (size_t)(tok + tt) * 512) = pack8(y);
        }
    }
}

constexpr int ML_QS = 0, ML_KS = 17408, ML_KWT = 34816, ML_VTL = 53248, ML_PS = 71680, ML_CT = 80896, ML_SCAL = 115712, ML_SSP = 118272, ML_QN = ML_SSP + 512, ML_F1 = ML_QN + 256, ML_F2 = ML_F1 + 256, ML_NV = ML_F2 + 256;
static_assert(ML_NV + 512 <= RING_BYTES, "mLSTM LDS map");
__device__ __forceinline__ void mlstm_scal(float ip, float fp, LAS float* sc, float& m_carry, int lane) {
    const float lf = fminf(fp, 0.f) - log1pf(expf(-fabsf(fp)));
    float bc = lf;
#pragma unroll
    for (int o = 1; o < 64; o <<= 1) { const float t2 = __shfl_up(bc, o); if (lane >= o) bc += t2; }
    const float a = ip - bc; float pm = a;
#pragma unroll
    for (int o = 1; o < 64; o <<= 1) { const float t2 = __shfl_up(pm, o); if (lane >= o) pm = fmaxf(pm, t2); }
    const float M = fmaxf(m_carry, pm);
    const float M63 = __shfl(M, 63), bc63 = __shfl(bc, 63);
    sc[lane] = a; sc[64 + lane] = M; sc[128 + lane] = expf(a - M63); sc[192 + lane] = expf(m_carry - M); sc[256 + lane] = expf(-(bc + M));
    m_carry = bc63 + M63;
}
__device__ __forceinline__ void mlstm_item(const P& p, LAS unsigned char* lds, int item, int tid, int wave, int lane) {
    const int b = item >> 2, h = item & 3;
    const int r = lane & 31, hh = lane >> 5, et = wave & 3, th = wave >> 2;
    const bf16* QC = (const bf16*)(p.ws + WS_QC); const bf16* KC = (const bf16*)(p.ws + WS_KC); const bf16* MLV = (const bf16*)(p.ws + WS_MLV); const float* IFG = (const float*)(p.ws + WS_IFG);
    bf16* HML = (bf16*)p.out + 512;
    LAS float* SCAL = (LAS float*)(lds + ML_SCAL); LAS float* SSP = (LAS float*)(lds + ML_SSP); LAS float* QN = (LAS float*)(lds + ML_QN);
    LAS float* F1 = (LAS float*)(lds + ML_F1); LAS float* F2 = (LAS float*)(lds + ML_F2); LAS float* NV = (LAS float*)(lds + ML_NV);
    const int cg = tid & 15, trow = tid >> 4, eg = cg, sl = trow;
    const size_t hq = (size_t)h * 128 + 8 * cg;
    for (int i = tid; i < (128 * 136 * 2) / 4; i += NTHR) ((LAS unsigned*)(lds + ML_CT))[i] = 0u;
    if (tid < 128) NV[tid] = 0.f;
    f32x16 accC[2]; accC[0] = zero16(); accC[1] = zero16();
    float m_carry = 0.f;
    if (wave == 3) { const size_t tk = (size_t)b * S_ + lane; mlstm_scal(IFG[tk * 8 + h], IFG[tk * 8 + 4 + h], SCAL, m_carry, lane); }
    v4u pq[2], pk[2], pv[2];
    {
        const size_t t0 = (size_t)b * S_;
#pragma unroll
        for (int u = 0; u < 2; ++u) { pq[u] = *(const v4u*)(QC + (t0 + trow + 32 * u) * 512 + hq); pk[u] = *(const v4u*)(KC + (t0 + trow + 32 * u) * 512 + hq); pv[u] = *(const v4u*)(MLV + (t0 + sl + 32 * u) * 512 + hq); }
    }
    float ipn = 0.f, fpn = 0.f;
    __syncthreads();
    for (int c = 0; c < 32; ++c) {
        const size_t tok0 = (size_t)b * S_ + c * 64;
        LAS float* sc = SCAL + (c & 1) * 320;
        {
#pragma unroll
            for (int u = 0; u < 2; ++u) {
                const int t = trow + 32 * u;
                *(LAS v4u*)(lds + ML_QS + t * 272 + cg * 16) = pq[u];
                *(LAS v4u*)(lds + ML_KS + t * 272 + cg * 16) = pk[u];
                float f[8]; unpack8(pk[u], f);
                const float wk = sc[128 + t];
#pragma unroll
                for (int i = 0; i < 8; ++i) *(LAS bf16*)(lds + ML_KWT + (8 * cg + i) * 144 + ((t ^ (8 * (cg & 7))) * 2)) = (bf16)f2bf(f[i] * wk);
                const unsigned vv[4] = {pv[u].x, pv[u].y, pv[u].z, pv[u].w};
#pragma unroll
                for (int i = 0; i < 4; ++i) {
                    *(LAS bf16*)(lds + ML_VTL + (8 * eg + 2 * i) * 144 + ((t ^ (8 * (eg & 7))) * 2)) = (bf16)(vv[i] & 0xffffu);
                    *(LAS bf16*)(lds + ML_VTL + (8 * eg + 2 * i + 1) * 144 + ((t ^ (8 * (eg & 7))) * 2)) = (bf16)(vv[i] >> 16);
                }
            }
            if (c + 1 < 32) {
                const size_t t1 = tok0 + 64;
#pragma unroll
                for (int u = 0; u < 2; ++u) { pq[u] = *(const v4u*)(QC + (t1 + trow + 32 * u) * 512 + hq); pk[u] = *(const v4u*)(KC + (t1 + trow + 32 * u) * 512 + hq); pv[u] = *(const v4u*)(MLV + (t1 + sl + 32 * u) * 512 + hq); }
                if (wave == 3) { ipn = IFG[(t1 + lane) * 8 + h]; fpn = IFG[(t1 + lane) * 8 + 4 + h]; }
            }
        }
        __syncthreads();
        f32x16 acc_inter = zero16();
        if (wave < 3) {
            const int tt = wave > 0 ? 1 : 0, st = wave == 2 ? 1 : 0;
            f32x16 zt = zero16();
#pragma unroll
            for (int ks = 0; ks < 8; ++ks) {
                const bf16x8 ka = *(const LAS bf16x8*)(lds + ML_KS + (32 * st + r) * 272 + 32 * ks + 16 * hh);
                const bf16x8 qb = *(const LAS bf16x8*)(lds + ML_QS + (32 * tt + r) * 272 + 32 * ks + 16 * hh);
                zt = MFMA32(ka, qb, zt);
            }
            const int t = 32 * tt + r; const float Mt = sc[64 + t];
            float ps = 0.f;
#pragma unroll
            for (int g = 0; g < 4; ++g) {
                const f32x4 av = *(const LAS f32x4*)(sc + 32 * st + 8 * g + 4 * hh);
                float pv[4];
#pragma unroll
                for (int q = 0; q < 4; ++q) { const int sidx = 32 * st + 8 * g + 4 * hh + q;
                    const float wgt = sidx <= t ? expf(av[q] - Mt) : 0.f; pv[q] = zt[4 * g + q] * wgt; ps += pv[q]; }
                *(LAS v2u*)(lds + ML_PS + t * 144 + (32 * st + 8 * g + 4 * hh) * 2) = (v2u){cvtpk(pv[0], pv[1]), cvtpk(pv[2], pv[3])};
            }
            ps += __shfl_xor(ps, 32);
            if (hh == 0) { SSP[st * 64 + t] = ps; if (wave == 0) SSP[64 + t] = 0.f; }
        }
        if (wave == 3 && c + 1 < 32) mlstm_scal(ipn, fpn, SCAL + ((c + 1) & 1) * 320, m_carry, lane);
#pragma unroll
        for (int ks = 0; ks < 8; ++ks) {
            const bf16x8 qa = *(const LAS bf16x8*)(lds + ML_QS + (32 * th + r) * 272 + 32 * ks + 16 * hh);
            const bf16x8 cbf = *(const LAS bf16x8*)(lds + ML_CT + (32 * et + r) * 272 + 32 * ks + 16 * hh);
            acc_inter = MFMA32(qa, cbf, acc_inter);
        }
        {
            const int t = tid >> 3, part = tid & 7;
            float f[8], sum = 0.f;
            { const v4u tq = *(const LAS v4u*)(lds + ML_QS + t * 272 + part * 32); unpack8(tq, f); }
#pragma unroll
            for (int i = 0; i < 8; ++i) sum += f[i] * NV[16 * part + i];
            { const v4u tq = *(const LAS v4u*)(lds + ML_QS + t * 272 + part * 32 + 16); unpack8(tq, f); }
#pragma unroll
            for (int i = 0; i < 8; ++i) sum += f[i] * NV[16 * part + 8 + i];
            sum += __shfl_xor(sum, 1); sum += __shfl_xor(sum, 2); sum += __shfl_xor(sum, 4);
            if (part == 0) QN[t] = sum;
        }
        __syncthreads();
        f32x16 acc_intra = zero16();
#pragma unroll
        for (int ks = 0; ks < 4; ++ks) {
            if (ks < 2 || th == 1) {
                const bf16x8 pa = *(const LAS bf16x8*)(lds + ML_PS + (32 * th + r) * 144 + 32 * ks + 16 * hh);
                const bf16x8 vb = *(const LAS bf16x8*)(lds + ML_VTL + (32 * et + r) * 144 + 16 * ((2 * ks + hh) ^ (((32 * et + r) >> 3) & 7)));
                acc_intra = MFMA32(pa, vb, acc_intra);
            }
        }
        if (tid < 64) {
            const float wi = sc[192 + tid];
            const float den = SSP[tid] + SSP[64 + tid] + wi * QN[tid];
            const float f1 = 1.f / fmaxf(fabsf(den), sc[256 + tid]);
            F1[tid] = f1; F2[tid] = wi * f1;
        }
        const float decay = sc[192 + 63];
#pragma unroll
        for (int dt = 0; dt < 2; ++dt) {
#pragma unroll
            for (int i = 0; i < 16; ++i) accC[dt][i] *= decay;
#pragma unroll
            for (int ks = 0; ks < 4; ++ks) {
                const bf16x8 ka = *(const LAS bf16x8*)(lds + ML_KWT + (64 * th + 32 * dt + r) * 144 + 16 * ((2 * ks + hh) ^ (((64 * th + 32 * dt + r) >> 3) & 7)));
                const bf16x8 vb = *(const LAS bf16x8*)(lds + ML_VTL + (32 * et + r) * 144 + 16 * ((2 * ks + hh) ^ (((32 * et + r) >> 3) & 7)));
                accC[dt] = MFMA32(ka, vb, accC[dt]);
            }
        }
        {
            const int d = tid >> 2, part = tid & 3;
            float f[8], sum = 0.f;
            { const v4u tq = *(const LAS v4u*)(lds + ML_KWT + d * 144 + part * 32); unpack8(tq, f); }
#pragma unroll
            for (int i = 0; i < 8; ++i) sum += f[i];
            { const v4u tq = *(const LAS v4u*)(lds + ML_KWT + d * 144 + part * 32 + 16); unpack8(tq, f); }
#pragma unroll
            for (int i = 0; i < 8; ++i) sum += f[i];
            sum += __shfl_xor(sum, 1); sum += __shfl_xor(sum, 2);
            if (part == 0) NV[d] = decay * NV[d] + sum;
        }
        __syncthreads();
        {
            bf16* hp = HML + (tok0 + 32 * th) * 1024 + h * 128 + 32 * et + r;
#pragma unroll
            for (int g = 0; g < 4; ++g) {
                const f32x4 f1v = *(const LAS f32x4*)(F1 + 32 * th + 8 * g + 4 * hh), f2v = *(const LAS f32x4*)(F2 + 32 * th + 8 * g + 4 * hh);
#pragma unroll
                for (int q = 0; q < 4; ++q) { const int tl = 8 * g + 4 * hh + q;
                    hp[(size_t)tl * 1024] = (bf16)f2bf(acc_intra[4 * g + q] * f1v[q] + acc_inter[4 * g + q] * f2v[q]); }
            }
#pragma unroll
            for (int dt = 0; dt < 2; ++dt)
#pragma unroll
                for (int g = 0; g < 4; ++g)
                    *(LAS v2u*)(lds + ML_CT + (32 * et + r) * 272 + (64 * th + 32 * dt + 8 * g + 4 * hh) * 2) = (v2u){cvtpk(accC[dt][4 * g], accC[dt][4 * g + 1]), cvtpk(accC[dt][4 * g + 2], accC[dt][4 * g + 3])};
        }
    }
    __syncthreads();
}

__device__ __forceinline__ void sba_wave_item(const bf16* __restrict__ QK, const bf16* __restrict__ VT, bf16* __restrict__ YSB, int b, int h, int qt, int lane) {
    const int r = lane & 31, hh = lane >> 5, t0 = qt * 32;
    const size_t rowbase = (size_t)b * S_;
    bf16x8 qf[4];
    {
        const bf16* qp = QK + (rowbase + t0 + r) * 1024 + h * 64 + 8 * hh;
#pragma unroll
        for (int ks = 0; ks < 4; ++ks) qf[ks] = *(const bf16x8*)(qp + 16 * ks);
    }
    bf16x8 tri[2];
#pragma unroll
    for (int s2 = 0; s2 < 2; ++s2)
#pragma unroll
        for (int j = 0; j < 8; ++j) { const int rho = 16 * s2 + 8 * (j >> 2) + 4 * hh + (j & 3); tri[s2][j] = (rho > r) ? (short)0x3F80 : (short)0; }
    f32x16 o0 = zero16(), o1 = zero16();
    float carry = 0.f;
    const bf16* kbase = QK + rowbase * 1024 + 512 + h * 64 + 8 * hh + (size_t)r * 1024;
    const bf16* vbase = VT + ((size_t)(b * 8 + h) * 64 + r) * 2048 + 4 * hh;
    bf16x8 kf[4]; v2u vl[2][2], vh[2][2];
#pragma unroll
    for (int ks = 0; ks < 4; ++ks) kf[ks] = *(const bf16x8*)(kbase + (size_t)t0 * 1024 + 16 * ks);
#pragma unroll
    for (int dt = 0; dt < 2; ++dt)
#pragma unroll
        for (int s2 = 0; s2 < 2; ++s2) { const bf16* vp = vbase + (size_t)dt * 32 * 2048 + t0 + 16 * s2; vl[dt][s2] = *(const v2u*)vp; vh[dt][s2] = *(const v2u*)(vp + 8); }
    for (int s0 = t0; s0 >= 0; s0 -= 32) {
        bf16x8 kn[4]; v2u vln[2][2], vhn[2][2];
        const int sn = s0 >= 32 ? s0 - 32 : 0;
#pragma unroll
        for (int ks = 0; ks < 4; ++ks) kn[ks] = *(const bf16x8*)(kbase + (size_t)sn * 1024 + 16 * ks);
#pragma unroll
        for (int dt = 0; dt < 2; ++dt)
#pragma unroll
            for (int s2 = 0; s2 < 2; ++s2) { const bf16* vp = vbase + (size_t)dt * 32 * 2048 + sn + 16 * s2; vln[dt][s2] = *(const v2u*)vp; vhn[dt][s2] = *(const v2u*)(vp + 8); }
        f32x16 z = zero16();
#pragma unroll
        for (int ks = 0; ks < 4; ++ks) z = MFMA32(kf[ks], qf[ks], z);
        const bool diag = (s0 == t0);
        f32x16 sp; float rs = 0.f;
#pragma unroll
        for (int i = 0; i < 16; ++i) {
            const float zz = z[i] * 0.125f;
            const bool valid = !diag || (crow(i, hh) < r);
            float spv = fmaxf(zz, 0.f) + __logf(1.f + __expf(-fabsf(zz)));
            spv = valid ? spv : 0.f;
            sp[i] = spv; rs += spv; z[i] = zz - spv;
        }
        f32x16 suf = zero16();
        suf = MFMA32(tri[0], pack_step<0>(sp), suf);
        suf = MFMA32(tri[1], pack_step<1>(sp), suf);
        f32x16 w;
#pragma unroll
        for (int i = 0; i < 16; ++i) {
            const bool valid = !diag || (crow(i, hh) < r);
            const float lw = z[i] - suf[i] - carry;
            w[i] = valid ? __expf(lw) : 0.f;
        }
        rs += __shfl_xor(rs, 32);
        carry += rs;
        const bf16x8 pa0 = pack_step<0>(w), pa1 = pack_step<1>(w);
        o0 = MFMA32(pa0, frag2(vl[0][0], vh[0][0]), o0); o0 = MFMA32(pa1, frag2(vl[0][1], vh[0][1]), o0);
        o1 = MFMA32(pa0, frag2(vl[1][0], vh[1][0]), o1); o1 = MFMA32(pa1, frag2(vl[1][1], vh[1][1]), o1);
        if (__all(carry > 104.f)) break;
#pragma unroll
        for (int ks = 0; ks < 4; ++ks) kf[ks] = kn[ks];
#pragma unroll
        for (int dt = 0; dt < 2; ++dt)
#pragma unroll
            for (int s2 = 0; s2 < 2; ++s2) { vl[dt][s2] = vln[dt][s2]; vh[dt][s2] = vhn[dt][s2]; }
    }
    bf16* op = YSB + (rowbase + t0) * 1024 + h * 64 + r;
#pragma unroll
    for (int i = 0; i < 16; ++i) { const int t = crow(i, hh); op[(size_t)t * 1024] = (bf16)f2bf(o0[i]); op[(size_t)t * 1024 + 32] = (bf16)f2bf(o1[i]); }
}
__device__ __forceinline__ void sba_item(const P& p, int item, int wave, int lane) {
    const int bh = item >> 3, qb = item & 7, b = bh >> 3, h = bh & 7;
    sba_wave_item((const bf16*)(p.ws + WS_SBQKV), (const bf16*)(p.ws + WS_VT), (bf16*)p.out, b, h, qb * 8 + wave, lane);
}

__device__ __forceinline__ void p3_yml(const P& p, int wave, int lane) {
    const int gw = blockIdx.x * NWAVES + wave, NGW = gridDim.x * NWAVES;
    bf16* YML = (bf16*)p.out + 512; const bf16* MLO = (const bf16*)(p.ws + WS_MLO);
    for (int m = gw; m < T_; m += NGW) {
        float hv[8], ov[8], o[8];
        unpack8(*(const v4u*)(YML + (size_t)m * 1024 + lane * 8), hv); unpack8(*(const v4u*)(MLO + (size_t)m * 512 + lane * 8), ov);
        float ss = 0.f;
#pragma unroll
        for (int i = 0; i < 8; ++i) ss += hv[i] * hv[i];
        ss += __shfl_xor(ss, 1); ss += __shfl_xor(ss, 2); ss += __shfl_xor(ss, 4); ss += __shfl_xor(ss, 8);
        const float rstd = 1.f / sqrtf(ss * (1.f / 128.f) + EPS);
        const f32x4 w0 = *(const f32x4*)(p.ml_norm_w + lane * 8), w1 = *(const f32x4*)(p.ml_norm_w + lane * 8 + 4);
        const float wv[8] = {w0.x, w0.y, w0.z, w0.w, w1.x, w1.y, w1.z, w1.w};
#pragma unroll
        for (int i = 0; i < 8; ++i) o[i] = sigmoidf_(ov[i]) * hv[i] * rstd * wv[i];
        *(v4u*)(YML + (size_t)m * 1024 + lane * 8) = pack8(o);
    }
}

__device__ __forceinline__ void p6_hn(const P& p, int wave, int lane) {
    const int gw = blockIdx.x * NWAVES + wave, NGW = gridDim.x * NWAVES;
    const float* H = (const float*)(p.ws + WS_H); bf16* HN = (bf16*)(p.ws + WS_HN);
    for (int m = gw; m < T_; m += NGW) {
        const f32x4* xr = (const f32x4*)(H + (size_t)m * 1024) + lane; const f32x4* wr = (const f32x4*)p.norm_ffn_w + lane;
        f32x4 v[4]; float ss = 0.f;
#pragma unroll
        for (int j = 0; j < 4; ++j) { v[j] = xr[64 * j]; ss += (v[j].x * v[j].x + v[j].y * v[j].y) + (v[j].z * v[j].z + v[j].w * v[j].w); }
        const float rstd = 1.f / sqrtf(wave_sum(ss) * (1.f / 1024.f) + EPS);
        v2u* o8 = (v2u*)(HN + (size_t)m * 1024) + lane;
#pragma unroll
        for (int j = 0; j < 4; ++j) { const f32x4 w = wr[64 * j]; o8[64 * j] = (v2u){pk2(v[j].x * rstd * w.x, v[j].y * rstd * w.y), pk2(v[j].z * rstd * w.z, v[j].w * rstd * w.w)}; }
    }
}

__device__ __forceinline__ float ffn_rstd(const float* SS, int m) {
    const f32x4* q = (const f32x4*)(SS + (size_t)m * 16); const f32x4 a = q[0], b = q[1], c = q[2], d = q[3];
    const float t = ((a.x + a.y) + (a.z + a.w)) + ((b.x + b.y) + (b.z + b.w)) + ((c.x + c.y) + (c.z + c.w)) + ((d.x + d.y) + (d.z + d.w));
    return 1.f / sqrtf(t * (1.f / 1024.f) + EPS);
}
__device__ __forceinline__ unsigned ord_key(float f) { const unsigned u = __builtin_bit_cast(unsigned, f); return (u & 0x80000000u) ? ~u : (u | 0x80000000u); }
__device__ __forceinline__ float ord_val(unsigned k) { const unsigned u = (k & 0x80000000u) ? (k & 0x7fffffffu) : ~k; return __builtin_bit_cast(float, u); }
template <int CTRL> __device__ __forceinline__ unsigned dpp_u(unsigned v) { return (unsigned)__builtin_amdgcn_update_dpp(0, (int)v, CTRL, 0xF, 0xF, true); }
__device__ __forceinline__ unsigned umax_(unsigned a, unsigned b) { return a > b ? a : b; }
__device__ __forceinline__ unsigned umin_(unsigned a, unsigned b) { return a < b ? a : b; }
__device__ __forceinline__ unsigned row_max_u(unsigned v) {
    v = umax_(v, dpp_u<0xB1>(v)); v = umax_(v, dpp_u<0x4E>(v)); v = umax_(v, dpp_u<0x141>(v)); v = umax_(v, dpp_u<0x140>(v)); return v;
}
__device__ __forceinline__ float row_sum_f(float v) {
    v += __builtin_bit_cast(float, dpp_u<0xB1>(__builtin_bit_cast(unsigned, v))); v += __builtin_bit_cast(float, dpp_u<0x4E>(__builtin_bit_cast(unsigned, v)));
    v += __builtin_bit_cast(float, dpp_u<0x141>(__builtin_bit_cast(unsigned, v))); v += __builtin_bit_cast(float, dpp_u<0x140>(__builtin_bit_cast(unsigned, v))); return v;
}
#define CE_(i, j) do { const unsigned _a = k[i], _b = k[j]; k[i] = umax_(_a, _b); k[j] = umin_(_a, _b); } while (0)
__device__ __forceinline__ unsigned row_top16(unsigned (&k)[8], unsigned (&top)[16], int li) {
    CE_(0, 1); CE_(2, 3); CE_(4, 5); CE_(6, 7); CE_(0, 2); CE_(1, 3); CE_(4, 6); CE_(5, 7); CE_(1, 2); CE_(5, 6);
    CE_(0, 4); CE_(1, 5); CE_(2, 6); CE_(3, 7); CE_(2, 4); CE_(3, 5); CE_(1, 2); CE_(3, 4); CE_(5, 6);
    unsigned mine = 0u;
#pragma unroll
    for (int n = 0; n < 16; ++n) {
        const unsigned m = row_max_u(k[0]);
        const bool hit = k[0] == m;
#pragma unroll
        for (int i = 0; i < 7; ++i) k[i] = hit ? k[i + 1] : k[i];
        k[7] = hit ? 0u : k[7];
        top[n] = m; mine = (li == n) ? m : mine;
    }
    return mine;
}
__device__ __forceinline__ void topk_core(const float (&s1)[8], const float (&s2)[8], float rstd, int li, int lane, int& e_out, float& g_out) {
    unsigned k[8], top1[16], top2[16];
#pragma unroll
    for (int j = 0; j < 8; ++j) k[j] = (ord_key(s1[j]) & ~0x7fu) | (unsigned)(127 - (li + 16 * j));
    const unsigned mine1 = row_top16(k, top1, li);
#pragma unroll
    for (int j = 0; j < 8; ++j) k[j] = (ord_key(s2[j]) & ~0x7fu) | (unsigned)(127 - (li + 16 * j));
    const unsigned mine2 = row_top16(k, top2, li);
    const float v2 = ord_val(mine2 & ~0x7fu);
    unsigned c[16];
#pragma unroll
    for (int j = 0; j < 16; ++j) {
        const float v1 = ord_val(top1[j] & ~0x7fu);
        const unsigned key = (ord_key(v1 + v2) & ~0xffu) | (unsigned)(255 - (16 * j + li));
        c[j] = ((j + 1) * (li + 1) <= 16) ? key : 0u;
    }
    unsigned tk = 0u, t0 = 0u;
#pragma unroll
    for (int n = 0; n < 16; ++n) {
        const unsigned mx = row_max_u(c[0]);
        const bool hit = c[0] == mx;
#pragma unroll
        for (int i = 0; i < 15; ++i) c[i] = hit ? c[i + 1] : c[i];
        c[15] = hit ? 0u : c[15];
        if (n == 0) t0 = mx;
        tk = (li == n) ? mx : tk;
    }
    const float sv = ord_val(tk & ~0xffu), s0 = ord_val(t0 & ~0xffu);
    const int cc = 255 - (int)(tk & 0xffu), a = (cc >> 4) & 15, bb = cc & 15;
    const int i1 = 127 - (int)((unsigned)__shfl((int)mine1, (lane & 48) + a) & 0x7fu), i2 = 127 - (int)((unsigned)__shfl((int)mine2, (lane & 48) + bb) & 0x7fu);
    const float pe = expf((sv - s0) * rstd);
    const float den = row_sum_f(pe);
    e_out = i1 * 128 + i2; g_out = pe / den;
}
constexpr int TK_RS = 1040;
struct EpiTopk {
    static constexpr bool PERM = true, AFTER_DRAIN = true;
    int* IDX; float* GATE; const float* SS;
    __device__ __forceinline__ void fused(pg8::f32x4 (&acc)[2][2][4][2], const pg8::Unit& u, int wr, int wc, int fr, int fq, PG8_LAS unsigned char* lds, int wid, int lane) const {
        const int head = u.pn, q = lane >> 4, li = lane & 15;
#pragma unroll
        for (int ai = 0; ai < 2; ++ai) {
#pragma unroll
            for (int m = 0; m < 4; ++m)
#pragma unroll
                for (int bj = 0; bj < 2; ++bj) {
                    PG8_LAS unsigned char* dst = lds + (wr * 64 + m * 16 + fr) * TK_RS + (bj * 128 + wc * 32 + 8 * fq) * 4;
                    *(PG8_LAS pg8::f32x4*)dst = acc[ai][bj][m][0]; *(PG8_LAS pg8::f32x4*)(dst + 16) = acc[ai][bj][m][1];
                }
            __syncthreads();
#pragma unroll 1
            for (int it = 0; it < 4; it += 2) {
                const int rowa = 16 * wid + 4 * it + q, rowb = rowa + 4, ma = u.pm * 256 + ai * 128 + rowa, mb = ma + 4;
                const PG8_LAS float* sa = (const PG8_LAS float*)(lds + rowa * TK_RS); const PG8_LAS float* sb = (const PG8_LAS float*)(lds + rowb * TK_RS);
                float a1[8], a2[8], b1[8], b2[8];
#pragma unroll
                for (int j = 0; j < 8; ++j) { a1[j] = sa[li + 16 * j]; a2[j] = sa[128 + li + 16 * j]; b1[j] = sb[li + 16 * j]; b2[j] = sb[128 + li + 16 * j]; }
                const float ra = ffn_rstd(SS, ma), rb = ffn_rstd(SS, mb);
                int ea, eb; float ga, gb;
                topk_core(a1, a2, ra, li, lane, ea, ga);
                topk_core(b1, b2, rb, li, lane, eb, gb);
                IDX[(size_t)ma * 128 + head * 16 + li] = ea; GATE[(size_t)ma * 128 + head * 16 + li] = ga;
                IDX[(size_t)mb * 128 + head * 16 + li] = eb; GATE[(size_t)mb * 128 + head * 16 + li] = gb;
            }
            __syncthreads();
        }
    }
};
struct OneUnit {
    pg8::Unit u;
    __device__ __forceinline__ bool next(int i, pg8::Unit& o) const { if (i) return false; o = u; return true; }
    __device__ __forceinline__ void a_ready(const pg8::Unit&) const {}
    __device__ __forceinline__ void done(const pg8::Unit&) const {}
};

__device__ __forceinline__ float gelu_erf(float x) { return 0.5f * x * (1.f + erff(x * 0.70710678118654752f)); }
typedef float f32x2 __attribute__((ext_vector_type(2)));
__device__ __forceinline__ void cvt16_fp8(const v4u& w, f32x2 (&f)[8]) {
    f[0] = __builtin_amdgcn_cvt_pk_f32_fp8((int)w.x, false); f[1] = __builtin_amdgcn_cvt_pk_f32_fp8((int)w.x, true);
    f[2] = __builtin_amdgcn_cvt_pk_f32_fp8((int)w.y, false); f[3] = __builtin_amdgcn_cvt_pk_f32_fp8((int)w.y, true);
    f[4] = __builtin_amdgcn_cvt_pk_f32_fp8((int)w.z, false); f[5] = __builtin_amdgcn_cvt_pk_f32_fp8((int)w.z, true);
    f[6] = __builtin_amdgcn_cvt_pk_f32_fp8((int)w.w, false); f[7] = __builtin_amdgcn_cvt_pk_f32_fp8((int)w.w, true);
}
__device__ __forceinline__ float grp8_sum(float v) {
    v += __builtin_bit_cast(float, dpp_u<0xB1>(__builtin_bit_cast(unsigned, v)));
    v += __builtin_bit_cast(float, dpp_u<0x4E>(__builtin_bit_cast(unsigned, v)));
    v += __builtin_bit_cast(float, dpp_u<0x141>(__builtin_bit_cast(unsigned, v)));
    return v;
}
typedef int i32x4 __attribute__((ext_vector_type(4)));
template <int PAT> __device__ __forceinline__ float swz_f(float v) { return __builtin_bit_cast(float, __builtin_amdgcn_ds_swizzle(__builtin_bit_cast(int, v), PAT)); }
__device__ __forceinline__ void peer_u_token(const v4u (&ur)[16], const f32x2 (&xv)[8], bf16* dst, int c8) {
    float d[16];
#pragma unroll
    for (int i = 0; i < 16; ++i) {
        f32x2 f[8]; cvt16_fp8(ur[i], f);
        f32x2 s2 = f[0] * xv[0];
#pragma unroll
        for (int q = 1; q < 8; ++q) s2 += f[q] * xv[q];
        d[i] = s2.x + s2.y;
    }
    const bool b0 = (c8 & 1) != 0, b1 = (c8 & 2) != 0, b2 = (c8 & 4) != 0;
    float e8[8], e4[4], e2[2];
#pragma unroll
    for (int i = 0; i < 8; ++i) { const float keep = b0 ? d[2 * i + 1] : d[2 * i], send = b0 ? d[2 * i] : d[2 * i + 1];
        e8[i] = keep + __builtin_bit_cast(float, dpp_u<0xB1>(__builtin_bit_cast(unsigned, send))); }
#pragma unroll
    for (int i = 0; i < 4; ++i) { const float keep = b1 ? e8[2 * i + 1] : e8[2 * i], send = b1 ? e8[2 * i] : e8[2 * i + 1];
        e4[i] = keep + __builtin_bit_cast(float, dpp_u<0x4E>(__builtin_bit_cast(unsigned, send))); }
#pragma unroll
    for (int i = 0; i < 2; ++i) { const float keep = b2 ? e4[2 * i + 1] : e4[2 * i], send = b2 ? e4[2 * i] : e4[2 * i + 1];
        e2[i] = keep + swz_f<0x1F | (4 << 10)>(send); }
    dst[c8] = (bf16)f2bf(e2[0]); dst[c8 + 8] = (bf16)f2bf(e2[1]);
}
__device__ __forceinline__ void peer_u(const P& p, int wave, int lane) {
    const int j = blockIdx.x & 7, nchunk = gridDim.x >> 3, chunk = blockIdx.x >> 3, stride = nchunk * 8;
    const int g = lane >> 3, c8 = lane & 7;
    const bf16* HN = (const bf16*)p.out + 128 * j + 16 * c8; const int* IDX = (const int*)(p.ws + WS_IDX) + 16 * g;
    const unsigned char* US = p.ws + WS_U8 + (size_t)j * NEXP * 128 + 16 * c8;
    bf16* PART = (bf16*)(p.ws + WS_PART) + (size_t)j * T_ * 128 + 16 * g;
    const int m0 = chunk * 8 + wave, ntok = (T_ - m0 + stride - 1) / stride;
#define PU_CLAMP(k) (m0 + ((k) < ntok ? (k) : ntok - 1) * stride)
#define PU_ROWS(ur, ei) _Pragma("unroll") for (int i = 0; i < 16; ++i) ur[i] = *(const v4u*)(US + (size_t)ei[i >> 2][i & 3] * 128)
#define PU_L1(ei, h0, h1, mm) do { _Pragma("unroll") for (int q = 0; q < 4; ++q) ei[q] = *(const i32x4*)(IDX + (size_t)(mm) * 128 + 4 * q); \
        h0 = *(const v4u*)(HN + (size_t)(mm) * 1024); h1 = *(const v4u*)(HN + (size_t)(mm) * 1024 + 8); } while (0)
#define PU_X(xv, h0, h1) do { float f_[8]; unpack8(h0, f_); _Pragma("unroll") for (int i = 0; i < 4; ++i) xv[i] = (f32x2){f_[2 * i], f_[2 * i + 1]}; \
        unpack8(h1, f_); _Pragma("unroll") for (int i = 0; i < 4; ++i) xv[4 + i] = (f32x2){f_[2 * i], f_[2 * i + 1]}; } while (0)
    i32x4 ei[4]; v4u hA0, hA1, hB0, hB1; v4u urA[16], urB[16]; f32x2 xv[8];
    PU_L1(ei, hA0, hA1, m0);
    PU_ROWS(urA, ei);
    PU_L1(ei, hB0, hB1, PU_CLAMP(1));
    for (int k = 0; k < ntok; k += 2) {
        PU_ROWS(urB, ei);
        PU_X(xv, hA0, hA1);
        PU_L1(ei, hA0, hA1, PU_CLAMP(k + 2));
        peer_u_token(urA, xv, PART + (size_t)(m0 + k * stride) * 128, c8);
        if (k + 1 < ntok) {
            PU_ROWS(urA, ei);
            PU_X(xv, hB0, hB1);
            PU_L1(ei, hB0, hB1, PU_CLAMP(k + 3));
            peer_u_token(urB, xv, PART + (size_t)(m0 + (k + 1) * stride) * 128, c8);
        }
    }
#undef PU_CLAMP
#undef PU_ROWS
#undef PU_L1
#undef PU_X
}
__device__ __forceinline__ void peer_c(const P& p, int wave, int lane) {
    const int gw = blockIdx.x * NWAVES + wave, NGW = gridDim.x * NWAVES;
    const int* IDX = (const int*)(p.ws + WS_IDX); const float* GATE = (const float*)(p.ws + WS_GATE); const bf16* PART = (const bf16*)(p.ws + WS_PART);
    const float* USC = (const float*)(p.ws + WS_USC); const float* VSC = (const float*)(p.ws + WS_VSC); float* COEF = (float*)(p.ws + WS_COEF); const float* SS = (const float*)(p.ws + WS_SS);
    for (int m0 = gw * 2; m0 < T_; m0 += NGW * 2) {
        float s[2][2], rs[2], g[2][2]; int e[2][2];
#pragma unroll
        for (int u = 0; u < 2; ++u) {
            const int m = m0 + u;
            rs[u] = ffn_rstd(SS, m);
            s[u][0] = 0.f; s[u][1] = 0.f;
#pragma unroll
            for (int jj = 0; jj < 8; ++jj) { s[u][0] += bf2f(PART[((size_t)jj * T_ + m) * 128 + lane]); s[u][1] += bf2f(PART[((size_t)jj * T_ + m) * 128 + 64 + lane]); }
            e[u][0] = IDX[(size_t)m * 128 + lane]; e[u][1] = IDX[(size_t)m * 128 + 64 + lane];
            g[u][0] = GATE[(size_t)m * 128 + lane]; g[u][1] = GATE[(size_t)m * 128 + 64 + lane];
        }
        float us[2][2], vs[2][2];
#pragma unroll
        for (int u = 0; u < 2; ++u)
#pragma unroll
            for (int k = 0; k < 2; ++k) { us[u][k] = USC[e[u][k]]; vs[u][k] = VSC[e[u][k]]; }
#pragma unroll
        for (int u = 0; u < 2; ++u)
#pragma unroll
            for (int k = 0; k < 2; ++k) COEF[(size_t)(m0 + u) * 128 + 64 * k + lane] = g[u][k] * gelu_erf(s[u][k] * rs[u] * us[u][k]) * vs[u][k];
    }
}
struct PvPre { i32x4 ei[4]; float c0, c1; };
__device__ __forceinline__ void pv_level1(PvPre& q, const int* IDXg, const float* COEFg, int m, int c8) {
#pragma unroll
    for (int k = 0; k < 4; ++k) q.ei[k] = *(const i32x4*)(IDXg + (size_t)m * 128 + 4 * k);
    q.c0 = COEFg[(size_t)m * 128 + c8]; q.c1 = COEFg[(size_t)m * 128 + c8 + 8];
}
__device__ __forceinline__ void peer_v_token(const v4u (&vr)[16], float coef0, float coef1, const bf16* H, bf16* out, float* ssq, bool b3, bool b4, bool b5, int lane) {
    f32x2 acc[8];
#pragma unroll
    for (int i = 0; i < 8; ++i) acc[i] = (f32x2){0.f, 0.f};
#define PV_STEP(I) do { const float cs_ = ((I) >> 3) ? coef1 : coef0; \
        const float cu_ = swz_f<0x18 | (((I) & 7) << 5)>(cs_);     \
        const f32x2 c2_ = (f32x2){cu_, cu_}; f32x2 f_[8]; cvt16_fp8(vr[I], f_); \
        _Pragma("unroll") for (int q = 0; q < 8; ++q) acc[q] += c2_ * f_[q]; } while (0)
    PV_STEP(0); PV_STEP(1); PV_STEP(2); PV_STEP(3); PV_STEP(4); PV_STEP(5); PV_STEP(6); PV_STEP(7);
    PV_STEP(8); PV_STEP(9); PV_STEP(10); PV_STEP(11); PV_STEP(12); PV_STEP(13); PV_STEP(14); PV_STEP(15);
#undef PV_STEP
    f32x2 a1[4], a2[2], a3;
#pragma unroll
    for (int i = 0; i < 4; ++i) { const f32x2 keep = b5 ? acc[2 * i + 1] : acc[2 * i], send = b5 ? acc[2 * i] : acc[2 * i + 1];
        a1[i] = keep + (f32x2){__shfl_xor(send.x, 32), __shfl_xor(send.y, 32)}; }
#pragma unroll
    for (int i = 0; i < 2; ++i) { const f32x2 keep = b4 ? a1[2 * i + 1] : a1[2 * i], send = b4 ? a1[2 * i] : a1[2 * i + 1];
        a2[i] = keep + (f32x2){swz_f<0x1F | (16 << 10)>(send.x), swz_f<0x1F | (16 << 10)>(send.y)}; }
    { const f32x2 keep = b3 ? a2[1] : a2[0], send = b3 ? a2[0] : a2[1]; a3 = keep + (f32x2){swz_f<0x1F | (8 << 10)>(send.x), swz_f<0x1F | (8 << 10)>(send.y)}; }
    const unsigned hb = *(const unsigned*)H; const f32x2 hv = (f32x2){bflo(hb), bfhi(hb)};
    const f32x2 y = hv + a3;
    *(unsigned*)out = pk2(y.x, y.y);
    const float ss = wave_sum(y.x * y.x + y.y * y.y);
    if (lane == 0) *ssq = ss;
}
__device__ __forceinline__ void peer_v(const P& p, int wave, int lane) {
    const int j = blockIdx.x & 7, nchunk = gridDim.x >> 3, chunk = blockIdx.x >> 3, stride = nchunk * 8;
    const int g = lane >> 3, c8 = lane & 7;
    const bool b5 = (lane & 32) != 0, b4 = (lane & 16) != 0, b3 = (lane & 8) != 0;
    const int pi = 4 * (b3 ? 1 : 0) + 2 * (b4 ? 1 : 0) + (b5 ? 1 : 0);
    const size_t colo = 128 * j + 16 * c8 + 2 * pi;
    const bf16* H = (const bf16*)(p.ws + WS_H) + colo; bf16* OUT = (bf16*)(p.ws + WS_YB) + colo;
    const int* IDXg = (const int*)(p.ws + WS_IDX) + 16 * g; const float* COEFg = (const float*)(p.ws + WS_COEF) + 16 * g;
    const unsigned char* VS = p.ws + WS_V8 + (size_t)j * NEXP * 128 + 16 * c8;
    float* SSQ = (float*)(p.ws + WS_SSQ) + (size_t)j * T_;
    const int m0 = chunk * 8 + wave, ntok = (T_ - m0 + stride - 1) / stride;
#define PV_CLAMP(k) (m0 + ((k) < ntok ? (k) : ntok - 1) * stride)
#define PV_ROWS(vr, q) _Pragma("unroll") for (int i = 0; i < 16; ++i) vr[i] = *(const v4u*)(VS + (size_t)q.ei[i >> 2][i & 3] * 128)
    PvPre q; v4u vrA[16], vrB[16];
    pv_level1(q, IDXg, COEFg, m0, c8);
    PV_ROWS(vrA, q);
    float cA0 = q.c0, cA1 = q.c1, cB0, cB1;
    pv_level1(q, IDXg, COEFg, PV_CLAMP(1), c8);
    for (int k = 0; k < ntok; k += 2) {
        PV_ROWS(vrB, q); cB0 = q.c0; cB1 = q.c1;
        pv_level1(q, IDXg, COEFg, PV_CLAMP(k + 2), c8);
        { const size_t mm = (size_t)(m0 + k * stride); peer_v_token(vrA, cA0, cA1, H + mm * 1024, OUT + mm * 1024, SSQ + mm, b3, b4, b5, lane); }
        if (k + 1 < ntok) {
            PV_ROWS(vrA, q); cA0 = q.c0; cA1 = q.c1;
            pv_level1(q, IDXg, COEFg, PV_CLAMP(k + 3), c8);
            { const size_t mm = (size_t)(m0 + (k + 1) * stride); peer_v_token(vrB, cB0, cB1, H + mm * 1024, OUT + mm * 1024, SSQ + mm, b3, b4, b5, lane); }
        }
    }
#undef PV_CLAMP
#undef PV_ROWS
}
__device__ __forceinline__ void peer_f(const P& p, int wave, int lane) {
    const int gw = blockIdx.x * NWAVES + wave, NGW = gridDim.x * NWAVES;
    const float* SSQ = (const float*)(p.ws + WS_SSQ);
    for (int m = gw; m < T_; m += NGW) {
        float ss = 0.f;
#pragma unroll
        for (int jj = 0; jj < 8; ++jj) ss += SSQ[(size_t)jj * T_ + m];
        const float rstd = 1.f / sqrtf(ss * (1.f / 1024.f) + EPS);
        f32x4* o = (f32x4*)(p.out + (size_t)m * 1024) + lane; const f32x4* wr = (const f32x4*)p.norm_final_w + lane;
        const v2u* yb = (const v2u*)((const bf16*)(p.ws + WS_YB) + (size_t)m * 1024) + lane;
#pragma unroll
        for (int q = 0; q < 4; ++q) { const v2u yv = yb[64 * q]; const f32x4 w = wr[64 * q];
            o[64 * q] = (f32x4){bflo(yv.x) * rstd * w.x, bfhi(yv.x) * rstd * w.y, bflo(yv.y) * rstd * w.z, bfhi(yv.y) * rstd * w.w}; }
    }
}

constexpr int N_PHASES = 12;
struct Args { P p; int ph_lo, ph_hi; };
__global__ void __launch_bounds__(NTHR, 2) fwd_kernel(Args args) {
    extern __shared__ __attribute__((aligned(16))) unsigned char lds_raw[];
    LAS unsigned char* lds = (LAS unsigned char*)lds_raw;
    const P& p = args.p;
    const int tid = threadIdx.x, lane = tid & 63, wave = __builtin_amdgcn_readfirstlane(tid >> 6);
    volatile LAS unsigned* MISC = (volatile LAS unsigned*)(lds + MISC_OFF);
    for (int u = tid; u < (LDS_BYTES - LDSCTL_OFF) / 4; u += NTHR) ((LAS unsigned*)(lds + LDSCTL_OFF))[u] = 0u;
    __syncthreads();
    XcdBarrier bar; bar.bar = (unsigned*)(p.ws + WS_CTL) + CW_BAR; bar.x = 0; bar.st = nullptr;
#if !MK_PER_PHASE
    bar = xcd_barrier_post((unsigned*)(p.ws + WS_CTL) + CW_BAR, MISC + 8);
#endif
    const int lo = args.ph_lo, hi = args.ph_hi;
#define IN(k) (lo <= (k) && (k) < hi)
#ifndef PROBE_WAIT_LO
#define PROBE_WAIT_LO -1
#define PROBE_WAIT_HI -1
#endif
    volatile LAS unsigned long long* STAMP = (volatile LAS unsigned long long*)(lds + MISC_OFF + 256);
#define SEAM(k) do { if (IN(k) && IN((k) + 1)) xcd_barrier(bar); if (PROBE_WAIT_LO >= 0 && blockIdx.x == 0 && tid == 0) { STAMP[(k) + 1] = __builtin_amdgcn_s_memrealtime(); \
        if ((k) + 1 == N_PHASES - 1) { const unsigned long long d_ = STAMP[PROBE_WAIT_HI < 0 ? 0 : PROBE_WAIT_HI] - STAMP[PROBE_WAIT_LO < 0 ? 0 : PROBE_WAIT_LO]; \
            __hip_atomic_store((unsigned*)(p.ws + WS_CTL) + CW_Q + 256, (unsigned)d_ | 1u, __ATOMIC_RELAXED, __HIP_MEMORY_SCOPE_AGENT); } } } while (0)
    if (PROBE_WAIT_LO >= 0 && blockIdx.x == 0 && tid == 0) STAMP[0] = __builtin_amdgcn_s_memrealtime();

#ifndef PROBE_REP
#define PROBE_REP -1
#endif
#define REP(k) ((PROBE_REP == (k)) ? 2 : 1)
    if (IN(0)) {
#pragma unroll 1
        for (int r = 0; r < REP(0); ++r) p0_prologue(p, lds, wave, lane); } SEAM(0);
    if (IN(1)) {
#pragma unroll 1
      for (int r = 0; r < REP(1); ++r) {
        EpiProj e{(bf16*)(p.ws + WS_SBQKV), (bf16*)(p.ws + WS_VT), (bf16*)(p.ws + WS_MLQK), (bf16*)(p.ws + WS_MLV), (bf16*)(p.ws + WS_MLO), (bf16*)(p.ws + WS_GATES)};
        gemm<EpiProj>(lds, (const bf16*)(p.ws + WS_XN), (const bf16*)(p.ws + WS_W1T), T_, NPROJ, 1024, e); }
    } SEAM(1);
    if (IN(2)) { p2_conv(p, tid); } SEAM(2);
    if (IN(3)) {
        for (int it = blockIdx.x; it < 64; it += gridDim.x) mlstm_item(p, lds, it, tid, wave, lane);
        unsigned* qctr = (unsigned*)(p.ws + WS_CTL) + CW_Q;
        for (;;) {
            if (tid == 0) MISC[12] = __hip_atomic_fetch_add(qctr, 1u, __ATOMIC_RELAXED, __HIP_MEMORY_SCOPE_AGENT);
            __syncthreads();
            const unsigned it = MISC[12];
            __syncthreads();
            if (it >= 1024u) break;
            sba_item(p, (int)it, wave, lane);
        }
        for (;;) {
            if (tid == 0) MISC[12] = __hip_atomic_fetch_add(qctr + 128, 1u, __ATOMIC_RELAXED, __HIP_MEMORY_SCOPE_AGENT);
            __syncthreads();
            const unsigned it = MISC[12];
            __syncthreads();
            if (it >= (unsigned)N_FILL) break;
            fill_item(p, (int)it, wave, lane);
        }
    } SEAM(3);
    if (IN(4)) { p3_yml(p, wave, lane); } SEAM(4);
    if (IN(5)) {
        pg8::Gemm g{(const bf16*)p.out, (const bf16*)(p.ws + WS_WSBT), T_, 1024, 1024}; pg8::StaticOrder S; S.init(T_, 1024, (int)gridDim.x, (int)blockIdx.x);
        EpiMerge1 e{(bf16*)(p.ws + WS_MERGED), (const bf16*)(p.ws + WS_GATES)};
        pg8::gemm_phase<EpiMerge1, pg8::StaticOrder, true, true, true>(lds, g, S, e);
    } SEAM(5);
    if (IN(6)) {
        pg8::Gemm g{(const bf16*)(p.ws + WS_MERGED), (const bf16*)(p.ws + WS_WOUTT), T_, 1024, 1024}; pg8::StaticOrder S; S.init(T_, 1024, (int)gridDim.x, (int)blockIdx.x);
        EpiHW e{(bf16*)(p.ws + WS_H), p.x, (bf16*)p.out  , p.norm_ffn_w, (float*)(p.ws + WS_SS)};
        pg8::gemm_phase<EpiHW, pg8::StaticOrder, true, true>(lds, g, S, e);
    } SEAM(6);
    if (IN(7)) {
        pg8::Gemm g{(const bf16*)p.out, (const bf16*)(p.ws + WS_WCT), T_, 2048, 1024}; pg8::StaticOrder S; S.init(T_, 2048, (int)gridDim.x, (int)blockIdx.x);
        EpiTopk e{(int*)(p.ws + WS_IDX), (float*)(p.ws + WS_GATE), (const float*)(p.ws + WS_SS)};
#pragma unroll 1
        for (int i = 0;; ++i) { OneUnit s1; if (!S.next(i, s1.u)) break; pg8::gemm_phase<EpiTopk, OneUnit, false, true>(lds, g, s1, e); }
    } SEAM(7);
    if (IN(8)) { peer_u(p, wave, lane); } SEAM(8);
    if (IN(9)) { peer_c(p, wave, lane); } SEAM(9);
    if (IN(10)) { peer_v(p, wave, lane); } SEAM(10);
    if (IN(11)) { peer_f(p, wave, lane); }
    if (PROBE_WAIT_LO >= 0 && tid == 0) {
        unsigned* pw = (unsigned*)(p.ws + WS_CTL) + CW_Q + 256;
        unsigned dt = 0u;
        for (unsigned sp = 0; sp < (1u << 22); ++sp) { dt = __hip_atomic_load(pw, __ATOMIC_RELAXED, __HIP_MEMORY_SCOPE_AGENT); if (dt) break; __builtin_amdgcn_s_sleep(8); }
        const unsigned long long tend = __builtin_amdgcn_s_memrealtime();
        while (__builtin_amdgcn_s_memrealtime() - tend < (unsigned long long)dt) __builtin_amdgcn_s_sleep(8);
    }
#undef IN
#undef SEAM
}

extern "C" void kernel_launch(void* const* d_in, const int* in_sizes, int n_in, void* d_out, int out_size, void* d_ws, size_t ws_size, hipStream_t stream) {
    static int grid = 0;
    if (grid == 0) {
        if (n_in != 18 || in_sizes[0] != T_ * D_ || out_size != T_ * D_ || ws_size < WS_END) {
            fprintf(stderr, "kernel_launch: unexpected problem (n_in %d, in0 %d, out %d, ws %zu); nothing launched\n", n_in, n_in > 0 ? in_sizes[0] : -1, out_size, ws_size); grid = -1; return; }
        int dev = 0, cus = 0, per_cu = 0;
        if (hipGetDevice(&dev) != hipSuccess || hipDeviceGetAttribute(&cus, hipDeviceAttributeMultiprocessorCount, dev) != hipSuccess) { grid = -1; return; }
        if (hipFuncSetAttribute((const void*)fwd_kernel, hipFuncAttributeMaxDynamicSharedMemorySize, LDS_BYTES) != hipSuccess) { fprintf(stderr, "kernel_launch: hipFuncSetAttribute failed\n"); grid = -1; return; }
        if (hipOccupancyMaxActiveBlocksPerMultiprocessor(&per_cu, (const void*)fwd_kernel, NTHR, LDS_BYTES) != hipSuccess || per_cu < 1)
            fprintf(stderr, "kernel_launch: note: occupancy query reports %d workgroups per CU\n", per_cu);
        (void)hipGetLastError();
        grid = cus;
    }
    if (grid < 0) return;
    if (hipMemsetAsync((char*)d_ws + WS_CTL, 0, CTL_ZERO_BYTES, stream) != hipSuccess) { fprintf(stderr, "kernel_launch: memset failed\n"); return; }
    Args a{};
    const float** pp = (const float**)&a.p;
    for (int i = 0; i < 18; ++i) pp[i] = (const float*)d_in[i];
    a.p.out = (float*)d_out; a.p.ws = (unsigned char*)d_ws;
#if MK_PER_PHASE
    for (int ph = 0; ph < N_PHASES; ++ph) {
        a.ph_lo = ph; a.ph_hi = ph + 1;
        hipLaunchKernelGGL(fwd_kernel, dim3(grid), dim3(NTHR), LDS_BYTES, stream, a);
    }
#else
    a.ph_lo = 0; a.ph_hi = N_PHASES;
    hipLaunchKernelGGL(fwd_kernel, dim3(grid), dim3(NTHR), LDS_BYTES, stream, a);
#endif
    const hipError_t le = hipPeekAtLastError();
    if (le != hipSuccess) fprintf(stderr, "kernel_launch: launch failed: %s\n", hipGetErrorName(le));
}
```

```cpp
#include <hip/hip_runtime.h>
#include <cstdio>
#include <cstdint>
namespace pg8 {
#define PG8_LAS __attribute__((address_space(3)))
typedef unsigned short bf16_t;
typedef short bf16x8 __attribute__((ext_vector_type(8)));
typedef float f32x4 __attribute__((ext_vector_type(4)));
typedef unsigned u32x4 __attribute__((ext_vector_type(4)));
constexpr int BM = 256, BK = 64, HALF = 128, HTB = HALF * BK * 2  , STAGE_BYTES = 8 * HTB, NXCD = 8, WGM = 8;

__host__ __device__ __forceinline__ int lds_byte(int r, int c) { const int st = (r >> 4) * 2 + (c >> 5), rr = r & 15, cc = c & 31, ob = rr * 64 + cc * 2; return st * 1024 + (ob ^ (((ob >> 9) & 1) << 5)); }
__host__ __device__ __forceinline__ void stage_rc(int b, int& R, int& C) { const int st = b / 1024, sb = b % 1024, swz = sb ^ (((sb >> 9) & 1) << 5); R = (st >> 1) * 16 + swz / 64; C = (st & 1) * 32 + (swz % 64) / 2; }
__host__ __device__ __forceinline__ int perm32(int rho) { const int n = rho >> 4, i = rho & 15; return 8 * (i >> 2) + 4 * n + (i & 3); }

struct Unit { int pm, pn; };
struct Gemm { const bf16_t* A; const bf16_t* Bt; int M, N, K; };

struct StaticOrder {
    int nM, nN, nwg, G, c;
    __host__ __device__ void init(int M, int N, int G_, int c_) { nM = M / BM; nN = N / BM; nwg = nM * nN; G = G_; c = c_; }
    __host__ __device__ bool next(int i, Unit& u) const {
        const long L = (long)i * G + c; if (L >= nwg) return false;
        int wgid = (int)L; { const int q = nwg / NXCD, r = nwg % NXCD, xcd = wgid % NXCD, off = wgid / NXCD; wgid = (xcd < r ? xcd * (q + 1) : r * (q + 1) + (xcd - r) * q) + off; }
        const int nig = WGM * nN, gid = wgid / nig, fm = gid * WGM, gsz = (nM - fm) < WGM ? (nM - fm) : WGM;
        u.pm = fm + ((wgid % nig) % gsz); u.pn = (wgid % nig) / gsz; return true;
    }
    __device__ __forceinline__ void a_ready(const Unit&) const {}
    __device__ __forceinline__ void done(const Unit&) const {}
};

__device__ __forceinline__ unsigned cvt_pk_bf16(float lo, float hi) { unsigned r; asm volatile("v_cvt_pk_bf16_f32 %0, %1, %2" : "=v"(r) : "v"(lo), "v"(hi)); return r; }
template <class Epi, class Sched, bool ALIGN_EPI = false, bool SP2 = false, bool MID = false  >
__device__ __forceinline__ void gemm_phase(PG8_LAS unsigned char* lds, const Gemm g, const Sched& S, const Epi& E) {
    const int tid = threadIdx.x, wid = __builtin_amdgcn_readfirstlane(tid >> 6), lane = tid & 63, wr = wid >> 2, wc = wid & 3, fr = lane & 15, fq = lane >> 4;
    const int K = g.K, nt = K / BK;
    unsigned voffA[2], voffB[2];
#pragma unroll
    for (int i = 0; i < 2; ++i) { int R, C; stage_rc(tid * 16 + i * 8192, R, C); const int Rb = Epi::PERM ? ((R & ~31) + perm32(R & 31)) : R;
        voffA[i] = (unsigned)(R * K + C) * 2u; voffB[i] = (unsigned)(Rb * K + C) * 2u; }
    const size_t kstep = (size_t)(BK * 2);
    const size_t hstep = (size_t)HALF * K * 2;
    const size_t tstep = 2 * hstep;
    const unsigned ldsw = (unsigned)wid * 1024u;
    const int aoff = lds_byte(wr * 64 + fr, fq * 8), boff = lds_byte(wc * 32 + fr, fq * 8);
#define PG8_SA(b, h) (((b) * 2 + (h)) * HTB)
#define PG8_SB(b, h) ((4 + (b) * 2 + (h)) * HTB)
#define PG8_STAGE(bufoff, gbase, voff) do { _Pragma("unroll") for (int _i = 0; _i < 2; ++_i) \
        __builtin_amdgcn_global_load_lds((const unsigned*)((const char*)(gbase) + (voff)[_i]), (PG8_LAS unsigned*)(lds + (bufoff) + ldsw + _i * 8192), 16, 0, 0); } while (0)
#define PG8_LDA(dst, b, h) do { _Pragma("unroll") for (int m = 0; m < 4; ++m) _Pragma("unroll") for (int k = 0; k < 2; ++k) dst[m][k] = *(const PG8_LAS bf16x8*)(lds + PG8_SA(b, h) + aoff + m * 2048 + k * 1024); } while (0)
#define PG8_LDB(dst, b, h) do { _Pragma("unroll") for (int n = 0; n < 2; ++n) _Pragma("unroll") for (int k = 0; k < 2; ++k) dst[n][k] = *(const PG8_LAS bf16x8*)(lds + PG8_SB(b, h) + boff + n * 2048 + k * 1024); } while (0)
#define PG8_MMA(ai, bj, At, Bt) do { __builtin_amdgcn_s_setprio(1); _Pragma("unroll") for (int m = 0; m < 4; ++m) _Pragma("unroll") for (int n = 0; n < 2; ++n) _Pragma("unroll") for (int k = 0; k < 2; ++k) \
        acc[ai][bj][m][n] = __builtin_amdgcn_mfma_f32_16x16x32_bf16(Bt[n][k], At[m][k], acc[ai][bj][m][n], 0, 0, 0); __builtin_amdgcn_s_setprio(0); } while (0)
#define PG8_WAIT_V(n) asm volatile("s_waitcnt vmcnt(" #n ")" ::: "memory")
#define PG8_WAIT_L(n) asm volatile("s_waitcnt lgkmcnt(" #n ")" ::: "memory")
#define PG8_BAR __builtin_amdgcn_s_barrier()
#define PG8_SCHED __builtin_amdgcn_sched_barrier(0)
    Unit cur, nxt; int ui = 0;
    if (!S.next(0, cur)) return;
    f32x4 acc[2][2][4][2];
#pragma unroll
    for (int a = 0; a < 2; ++a)
#pragma unroll
        for (int b = 0; b < 2; ++b)
#pragma unroll
            for (int m = 0; m < 4; ++m)
#pragma unroll
                for (int n = 0; n < 2; ++n) acc[a][b][m][n] = (f32x4){0.f, 0.f, 0.f, 0.f};
    bf16x8 At[4][2], B0[2][2], B1[2][2];
    const char* cA = (const char*)g.A + (size_t)cur.pm * tstep; const char* cB = (const char*)g.Bt + (size_t)cur.pn * tstep;
    S.a_ready(cur);
    if constexpr (SP2) {
        PG8_STAGE(PG8_SB(0, 0), cB, voffB); PG8_STAGE(PG8_SB(0, 1), cB + hstep, voffB); PG8_STAGE(PG8_SA(0, 0), cA, voffA); PG8_STAGE(PG8_SA(0, 1), cA + hstep, voffA);
        if (wr == 1) PG8_BAR;
        PG8_WAIT_V(2); PG8_BAR;
        PG8_STAGE(PG8_SB(1, 0), cB + kstep, voffB); PG8_STAGE(PG8_SA(1, 0), cA + kstep, voffA); PG8_STAGE(PG8_SB(1, 1), cB + hstep + kstep, voffB);
        PG8_WAIT_V(6); PG8_BAR;
    } else {
        PG8_STAGE(PG8_SB(0, 0), cB, voffB); PG8_STAGE(PG8_SA(0, 0), cA, voffA); PG8_STAGE(PG8_SB(0, 1), cB + hstep, voffB); PG8_STAGE(PG8_SA(0, 1), cA + hstep, voffA);
        if (wr == 1) PG8_BAR;
        PG8_WAIT_V(4); PG8_BAR;
        PG8_STAGE(PG8_SB(1, 0), cB + kstep, voffB); PG8_STAGE(PG8_SA(1, 0), cA + kstep, voffA); PG8_STAGE(PG8_SB(1, 1), cB + hstep + kstep, voffB);
        PG8_WAIT_V(6); PG8_BAR;
    }
    for (;;) {
        const bool has_next = S.next(ui + 1, nxt);
        const char* nA = has_next ? (const char*)g.A + (size_t)nxt.pm * tstep : cA; const char* nB = has_next ? (const char*)g.Bt + (size_t)nxt.pn * tstep : cB;
        for (int t = 0; t < nt; t += 2) {
            if constexpr (MID) { if (t == (nt >> 1)) E.mid(acc, cur, wr, wc, fr, fq); }
            const bool last = (t == nt - 2);
            const char* a1 = cA + (size_t)(t + 1) * kstep;
            const char* a2 = last ? nA : cA + (size_t)(t + 2) * kstep; const char* b2 = last ? nB : cB + (size_t)(t + 2) * kstep;
            const char* a3 = a2 + kstep; const char* b3 = b2 + kstep;
            if (last && has_next) S.a_ready(nxt);
            if constexpr (SP2) {
            PG8_LDB(B0, 0, 0); PG8_LDB(B1, 0, 1); PG8_SCHED; PG8_LDA(At, 0, 0); PG8_STAGE(PG8_SA(1, 1), a1 + hstep, voffA);
            PG8_WAIT_V(8); PG8_WAIT_L(0); PG8_BAR; PG8_MMA(0, 0, At, B0); PG8_MMA(0, 1, At, B1); PG8_BAR; PG8_SCHED;
            PG8_LDA(At, 0, 1); PG8_STAGE(PG8_SB(0, 0), b2, voffB); PG8_STAGE(PG8_SB(0, 1), b2 + hstep, voffB); PG8_STAGE(PG8_SA(0, 0), a2, voffA);
            PG8_WAIT_V(8); PG8_WAIT_L(0); PG8_BAR; PG8_MMA(1, 0, At, B0); PG8_MMA(1, 1, At, B1); PG8_BAR; PG8_SCHED;
            PG8_LDB(B0, 1, 0); PG8_LDB(B1, 1, 1); PG8_SCHED; PG8_LDA(At, 1, 0); PG8_STAGE(PG8_SA(0, 1), a2 + hstep, voffA);
            PG8_WAIT_V(8); PG8_WAIT_L(0); PG8_BAR; PG8_MMA(0, 0, At, B0); PG8_MMA(0, 1, At, B1); PG8_BAR; PG8_SCHED;
            PG8_LDA(At, 1, 1); PG8_STAGE(PG8_SB(1, 0), b3, voffB); PG8_STAGE(PG8_SB(1, 1), b3 + hstep, voffB); PG8_STAGE(PG8_SA(1, 0), a3, voffA);
            PG8_WAIT_V(8); PG8_WAIT_L(0); PG8_BAR; PG8_MMA(1, 0, At, B0); PG8_MMA(1, 1, At, B1); PG8_BAR; PG8_SCHED;
            } else {
            PG8_LDB(B0, 0, 0); PG8_SCHED; PG8_LDA(At, 0, 0); PG8_STAGE(PG8_SA(1, 1), a1 + hstep, voffA);
            PG8_WAIT_L(8); PG8_BAR; PG8_WAIT_L(0); PG8_MMA(0, 0, At, B0); PG8_BAR; PG8_SCHED;
            PG8_LDB(B1, 0, 1); PG8_STAGE(PG8_SB(0, 0), b2, voffB);
            PG8_BAR; PG8_WAIT_L(0); PG8_MMA(0, 1, At, B1); PG8_BAR;
            PG8_LDA(At, 0, 1); PG8_STAGE(PG8_SA(0, 0), a2, voffA);
            PG8_BAR; PG8_WAIT_L(0); PG8_MMA(1, 0, At, B0); PG8_BAR; PG8_SCHED;
            PG8_STAGE(PG8_SB(0, 1), b2 + hstep, voffB);
            PG8_WAIT_V(6); PG8_BAR; PG8_MMA(1, 1, At, B1); PG8_BAR;
            PG8_LDB(B0, 1, 0); PG8_SCHED; PG8_LDA(At, 1, 0); PG8_STAGE(PG8_SA(0, 1), a2 + hstep, voffA);
            PG8_WAIT_L(8); PG8_BAR; PG8_WAIT_L(0); PG8_MMA(0, 0, At, B0); PG8_BAR; PG8_SCHED;
            PG8_LDB(B1, 1, 1); PG8_STAGE(PG8_SB(1, 0), b3, voffB);
            PG8_BAR; PG8_WAIT_L(0); PG8_MMA(0, 1, At, B1); PG8_BAR;
            PG8_LDA(At, 1, 1); PG8_STAGE(PG8_SA(1, 0), a3, voffA);
            PG8_BAR; PG8_WAIT_L(0); PG8_MMA(1, 0, At, B0); PG8_BAR; PG8_SCHED;
            PG8_STAGE(PG8_SB(1, 1), b3 + hstep, voffB);
            PG8_WAIT_V(6); PG8_BAR; PG8_MMA(1, 1, At, B1); PG8_BAR;
            }
        }
        if constexpr (ALIGN_EPI) { if (wr == 0) PG8_BAR; }
        if constexpr (!Epi::AFTER_DRAIN) { E(acc, cur, wr, wc, fr, fq); S.done(cur); }
        if (!has_next) break;
#pragma unroll
        for (int a = 0; a < 2; ++a)
#pragma unroll
            for (int b = 0; b < 2; ++b)
#pragma unroll
                for (int m = 0; m < 4; ++m)
#pragma unroll
                    for (int n = 0; n < 2; ++n) acc[a][b][m][n] = (f32x4){0.f, 0.f, 0.f, 0.f};
        cur = nxt; cA = nA; cB = nB; ++ui;
        if constexpr (ALIGN_EPI) { if (wr == 1) PG8_BAR; }
    }
    PG8_WAIT_V(0);
    if constexpr (!ALIGN_EPI) { if (wr == 0) PG8_BAR; }
    PG8_BAR;
    if constexpr (Epi::AFTER_DRAIN) { E.fused(acc, cur, wr, wc, fr, fq, lds, wid, lane); S.done(cur); }
#undef PG8_SA
#undef PG8_SB
#undef PG8_STAGE
#undef PG8_LDA
#undef PG8_LDB
#undef PG8_MMA
#undef PG8_WAIT_V
#undef PG8_WAIT_L
#undef PG8_BAR
#undef PG8_SCHED
}
}

#ifndef MK_PER_PHASE
#define MK_PER_PHASE 0
#endif
#ifndef USE_PG8
#define USE_PG8 1
#endif
constexpr int NWAVES = 8, NTHR = 512;

constexpr int B_ = 16, S_ = 2048, D_ = 1024, T_ = B_ * S_;
constexpr int INC = 5640, NPROJ = 5632;
constexpr int NEXP = 16384;
constexpr float EPS = 1e-6f;

constexpr size_t MiB = 1u << 20;
constexpr size_t WS_CTL = 0, CTL_ZERO_BYTES = 1 * MiB;
constexpr size_t WS_W1T = 2 * MiB, WS_WSBT = 13 * MiB, WS_WMLT = 14 * MiB, WS_WOUTT = 15 * MiB, WS_WCT = 17 * MiB, WS_IFG = 21 * MiB;
constexpr size_t WS_U8 = 24 * MiB, WS_V8 = 40 * MiB, WS_USC = 22 * MiB, WS_VSC = 23 * MiB;
constexpr size_t WS_XN = 88 * MiB, WS_QC = 88 * MiB, WS_KC = 120 * MiB;
constexpr size_t WS_SBQKV = 152 * MiB  , WS_VT = 216 * MiB  , WS_MLQK = 248 * MiB, WS_MLV = 312 * MiB, WS_MLO = 344 * MiB, WS_GATES = 376 * MiB;
constexpr size_t WS_MERGED = 216 * MiB, WS_H = 88 * MiB, WS_HN = 216 * MiB, WS_IDX = 280 * MiB, WS_GATE = 296 * MiB, WS_SC = 312 * MiB;
constexpr size_t WS_PART = 312 * MiB  , WS_SSQ = 504 * MiB  , WS_COEF = 56 * MiB  , WS_YB = 152 * MiB  , WS_HN8 = 440 * MiB  , WS_XS = 505 * MiB  , WS_SS = 506 * MiB  ;
constexpr size_t WS_END = 508 * MiB;
constexpr int CW_BAR = 4096, CW_Q = 8192;

constexpr int RING_OFF = 0, RING_BYTES = 135168;
constexpr int LDSCTL_OFF = RING_BYTES, MISC_OFF = LDSCTL_OFF + 320;
constexpr int LDS_BYTES = 147456;

#define GAS __attribute__((address_space(1)))
#define LAS __attribute__((address_space(3)))
typedef unsigned short bf16;
typedef unsigned v4u __attribute__((ext_vector_type(4)));
typedef unsigned v2u __attribute__((ext_vector_type(2)));
typedef float f32x4 __attribute__((ext_vector_type(4)));
#define LDS_WAIT() asm volatile("s_waitcnt lgkmcnt(0)" ::: "memory")
#define VM_WAIT() asm volatile("s_waitcnt vmcnt(0)" ::: "memory")
typedef float f32x2_t __attribute__((ext_vector_type(2))); typedef __bf16 bf16x2_t __attribute__((ext_vector_type(2)));
__device__ __forceinline__ unsigned cvtpk(float lo, float hi) { f32x2_t v = {lo, hi}; bf16x2_t b = __builtin_convertvector(v, bf16x2_t); return __builtin_bit_cast(unsigned, b); }
__device__ __forceinline__ unsigned f2bf(float f) { return cvtpk(f, f) & 0xffffu; }
__device__ __forceinline__ unsigned pk2(float lo, float hi) { return cvtpk(lo, hi); }
__device__ __forceinline__ float bflo(unsigned u) { return __builtin_bit_cast(float, u << 16); }
__device__ __forceinline__ float bfhi(unsigned u) { return __builtin_bit_cast(float, u & 0xffff0000u); }
__device__ __forceinline__ float bf2f(bf16 b) { return __builtin_bit_cast(float, (unsigned)b << 16); }
__device__ __forceinline__ float fexp(float x) { return __builtin_amdgcn_exp2f(x * 1.4426950408889634f); }
__device__ __forceinline__ float flog(float x) { return __builtin_amdgcn_logf(x) * 0.6931471805599453f; }
__device__ __forceinline__ float frcp(float x) { return __builtin_amdgcn_rcpf(x); }
__device__ __forceinline__ float frsq(float x) { return __builtin_amdgcn_rsqf(x); }
__device__ __forceinline__ float sigmoidf_(float x) { return frcp(1.f + fexp(-x)); }
__device__ __forceinline__ float wave_sum(float v) {
#pragma unroll
    for (int o = 1; o < 64; o <<= 1) v += __shfl_xor(v, o);
    return v;
}
__device__ __forceinline__ unsigned wave_max_u(unsigned v) {
#pragma unroll
    for (int o = 1; o < 64; o <<= 1) { const unsigned w = (unsigned)__shfl_xor((int)v, o); v = v > w ? v : w; }
    return v;
}
struct F8 { float v[8]; };
__device__ __forceinline__ void unpack8(const v4u& u, float (&f)[8]) {
    f[0] = bflo(u.x); f[1] = bfhi(u.x); f[2] = bflo(u.y); f[3] = bfhi(u.y); f[4] = bflo(u.z); f[5] = bfhi(u.z); f[6] = bflo(u.w); f[7] = bfhi(u.w);
}
__device__ __forceinline__ v4u pack8(const float (&f)[8]) { v4u o; o.x = pk2(f[0], f[1]); o.y = pk2(f[2], f[3]); o.z = pk2(f[4], f[5]); o.w = pk2(f[6], f[7]); return o; }

#define XB_TMO      128
#define XB_XCNT(j)  (256  + 64 * (j))
#define XB_XSUB(j)  (1280 + 64 * (j))
#define XB_XGEN(j)  (2304 + 64 * (j))
#define XB_TOP      3328
#define XB_TOPGEN   3392
#define XCD_BAR_WORDS 3456
#define XB_SPIN_CAP (1u << 24)

__device__ __forceinline__ unsigned xb_ld(unsigned* p)              { return __hip_atomic_load(p, __ATOMIC_RELAXED, __HIP_MEMORY_SCOPE_AGENT); }
__device__ __forceinline__ unsigned xb_add(unsigned* p, unsigned v) { return __hip_atomic_fetch_add(p, v, __ATOMIC_RELAXED, __HIP_MEMORY_SCOPE_AGENT); }
__device__ __forceinline__ unsigned xb_xcc_id() { return (unsigned)__builtin_amdgcn_s_getreg((3 << 11) | 20) & 0xFu; }
#define XB_SPIN(cond, bar) do { unsigned _sp = 0; while (cond) { __builtin_amdgcn_s_sleep(1); \
    if ((++_sp & 255u) == 0u) { if (xb_ld(&(bar)[XB_TMO])) break; if (_sp > XB_SPIN_CAP) { atomicAdd(&(bar)[XB_TMO], 1u); break; } } } } while (0)

struct XcdBarrier {
    unsigned* bar; unsigned x;
    volatile LAS unsigned* st;
};

__device__ __forceinline__ XcdBarrier xcd_barrier_post(unsigned* bar, volatile LAS unsigned* st) {
    XcdBarrier b; b.bar = bar; b.x = xb_xcc_id(); b.st = st;
    if (threadIdx.x == 0) (void)xb_add(&bar[XB_XCNT(b.x)], 1u);
    return b;
}
__device__ __forceinline__ void xcd_barrier_complete(unsigned* bar, unsigned x, unsigned& nloc, unsigned& nx) {
    const unsigned G = gridDim.x * gridDim.y * gridDim.z;
    unsigned sum, cnt, mine, sp = 0u;
    for (;;) {
        sum = 0u; cnt = 0u; mine = 0u;
#pragma unroll
        for (unsigned j = 0; j < 16; ++j) { const unsigned c = xb_ld(&bar[XB_XCNT(j)]); sum += c; cnt += (c > 0u) ? 1u : 0u; mine = (j == x) ? c : mine; }
        if (sum == G) break;
        __builtin_amdgcn_s_sleep(1);
        if ((++sp & 255u) == 0u) { if (xb_ld(&bar[XB_TMO])) break; if (sp > XB_SPIN_CAP) { atomicAdd(&bar[XB_TMO], 1u); break; } }
    }
    nloc = mine > 0u ? mine : 1u; nx = cnt > 0u ? cnt : 1u;
}

__device__ __forceinline__ void xcd_barrier(const XcdBarrier& b) {
    asm volatile("s_waitcnt vmcnt(0)" ::: "memory");
    __syncthreads();
    if (threadIdx.x == 0) {
        unsigned* bar = b.bar;
        __builtin_amdgcn_s_waitcnt(0);
        unsigned nloc = b.st[0], nx = b.st[1];
        if (nloc == 0u) { xcd_barrier_complete(bar, b.x, nloc, nx); b.st[0] = nloc; b.st[1] = nx; }
        const unsigned old = xb_add(&bar[XB_XSUB(b.x)], 1u);
        const unsigned gen = old / nloc;
        if (old + 1u == (gen + 1u) * nloc) {
            __builtin_amdgcn_fence(__ATOMIC_RELEASE, "agent");
            asm volatile("s_waitcnt vmcnt(0)" ::: "memory");
            const unsigned og = xb_add(&bar[XB_TOP], 1u);
            const unsigned tg = og / nx;
            if (og + 1u == (tg + 1u) * nx) xb_add(&bar[XB_TOPGEN], 1u);
            else XB_SPIN(xb_ld(&bar[XB_TOPGEN]) == tg, bar);
            __builtin_amdgcn_fence(__ATOMIC_ACQUIRE, "agent");
            xb_add(&bar[XB_XGEN(b.x)], 1u);
            asm volatile("s_waitcnt vmcnt(0)" ::: "memory");
        } else {
            XB_SPIN(xb_ld(&bar[XB_XGEN(b.x)]) == gen, bar);
            __builtin_amdgcn_fence(__ATOMIC_ACQUIRE, "agent");
            asm volatile("s_waitcnt vmcnt(0)" ::: "memory");
        }
    }
    __syncthreads();
}

struct EpiProj {
    bf16 *sbqk, *vt, *mlqk, *mlv, *mlo, *gates;
    __device__ __forceinline__ void operator()(int row, int col, const F8& a) const {
        bf16* dst;
        if (col < 1024) dst = sbqk + (size_t)row * 1024 + col;
        else if (col < 1536) {
            const int c = col - 1024, hh = c >> 6, d = c & 63, b = row >> 11, sq = row & 2047;
            bf16* vp = vt + ((size_t)(b * 8 + hh) * 64 + d) * 2048 + sq;
#pragma unroll
            for (int i = 0; i < 8; ++i) vp[(size_t)i * 2048] = (bf16)f2bf(a.v[i]);
            return;
        }
        else if (col < 2560) dst = mlqk + (size_t)row * 1024 + (col - 1536);
        else if (col < 3072) dst = mlv + (size_t)row * 512 + (col - 2560);
        else if (col < 3584) dst = mlo + (size_t)row * 512 + (col - 3072);
        else dst = gates + (size_t)row * 2048 + (col - 3584);
        *(v4u*)dst = pack8(a.v);
    }
};
struct EpiMergeA {
    bf16* merged; const bf16* gates;
    __device__ __forceinline__ void operator()(int row, int col, const F8& a) const {
        float g[8], o[8]; unpack8(*(const v4u*)(gates + (size_t)row * 2048 + col), g);
#pragma unroll
        for (int i = 0; i < 8; ++i) o[i] = sigmoidf_(g[i]) * a.v[i];
        *(v4u*)(merged + (size_t)row * 1024 + col) = pack8(o);
    }
};
struct EpiMergeB {
    bf16* merged; const bf16* gates;
    __device__ __forceinline__ void operator()(int row, int col, const F8& a) const {
        float g[8], o[8]; unpack8(*(const v4u*)(gates + (size_t)row * 2048 + 1024 + col), g);
        unpack8(*(const v4u*)(merged + (size_t)row * 1024 + col), o);
#pragma unroll
        for (int i = 0; i < 8; ++i) o[i] += sigmoidf_(g[i]) * a.v[i];
        *(v4u*)(merged + (size_t)row * 1024 + col) = pack8(o);
    }
};
struct EpiH {
    float* h; const float* x;
    __device__ __forceinline__ void operator()(int row, int col, const F8& a) const {
        const f32x4 x0 = *(const f32x4*)(x + (size_t)row * 1024 + col), x1 = *(const f32x4*)(x + (size_t)row * 1024 + col + 4);
        *(f32x4*)(h + (size_t)row * 1024 + col) = (f32x4){x0.x + a.v[0], x0.y + a.v[1], x0.z + a.v[2], x0.w + a.v[3]};
        *(f32x4*)(h + (size_t)row * 1024 + col + 4) = (f32x4){x1.x + a.v[4], x1.y + a.v[5], x1.z + a.v[6], x1.w + a.v[7]};
    }
};
struct EpiF32 {
    float* o; int ldc;
    __device__ __forceinline__ void operator()(int row, int col, const F8& a) const {
        *(f32x4*)(o + (size_t)row * ldc + col) = (f32x4){a.v[0], a.v[1], a.v[2], a.v[3]};
        *(f32x4*)(o + (size_t)row * ldc + col + 4) = (f32x4){a.v[4], a.v[5], a.v[6], a.v[7]};
    }
};

template <class E> struct EpiAdapt {
    static constexpr bool PERM = true, AFTER_DRAIN = false;
    E e;
    __device__ __forceinline__ void operator()(const pg8::f32x4 (&acc)[2][2][4][2], const pg8::Unit& u, int wr, int wc, int fr, int fq) const {
#pragma unroll
        for (int ai = 0; ai < 2; ++ai)
#pragma unroll
            for (int m = 0; m < 4; ++m) {
                const int row = u.pm * 256 + ai * 128 + wr * 64 + m * 16 + fr;
#pragma unroll
                for (int bj = 0; bj < 2; ++bj) {
                    const int col = u.pn * 256 + bj * 128 + wc * 32 + 8 * fq;
                    F8 a; const pg8::f32x4 v0 = acc[ai][bj][m][0], v1 = acc[ai][bj][m][1];
                    a.v[0] = v0[0]; a.v[1] = v0[1]; a.v[2] = v0[2]; a.v[3] = v0[3]; a.v[4] = v1[0]; a.v[5] = v1[1]; a.v[6] = v1[2]; a.v[7] = v1[3];
                    e(row, col, a);
                }
            }
    }
};

struct EpiMerge1 {
    static constexpr bool PERM = true, AFTER_DRAIN = false;
    bf16* merged; const bf16* gates;
    __device__ __forceinline__ void mid(pg8::f32x4 (&acc)[2][2][4][2], const pg8::Unit& u, int wr, int wc, int fr, int fq) const {
#pragma unroll
        for (int ai = 0; ai < 2; ++ai)
#pragma unroll
            for (int m = 0; m < 4; ++m) {
                const int row = u.pm * 256 + ai * 128 + wr * 64 + m * 16 + fr;
#pragma unroll
                for (int bj = 0; bj < 2; ++bj) {
                    const int col = u.pn * 256 + bj * 128 + wc * 32 + 8 * fq;
                    float gs[8], gm[8]; unpack8(*(const v4u*)(gates + (size_t)row * 2048 + col), gs); unpack8(*(const v4u*)(gates + (size_t)row * 2048 + 1024 + col), gm);
#pragma unroll
                    for (int i = 0; i < 8; ++i) { const float r = (1.f + fexp(-gm[i])) * frcp(1.f + fexp(-gs[i])); acc[ai][bj][m][i >> 2][i & 3] *= r; }
                }
            }
    }
    __device__ __forceinline__ void operator()(const pg8::f32x4 (&acc)[2][2][4][2], const pg8::Unit& u, int wr, int wc, int fr, int fq) const {
#pragma unroll
        for (int ai = 0; ai < 2; ++ai)
#pragma unroll
            for (int m = 0; m < 4; ++m) {
                const int row = u.pm * 256 + ai * 128 + wr * 64 + m * 16 + fr;
#pragma unroll
                for (int bj = 0; bj < 2; ++bj) {
                    const int col = u.pn * 256 + bj * 128 + wc * 32 + 8 * fq;
                    float gm[8], o[8]; unpack8(*(const v4u*)(gates + (size_t)row * 2048 + 1024 + col), gm);
#pragma unroll
                    for (int i = 0; i < 8; ++i) o[i] = sigmoidf_(gm[i]) * acc[ai][bj][m][i >> 2][i & 3];
                    *(v4u*)(merged + (size_t)row * 1024 + col) = pack8(o);
                }
            }
    }
};
struct EpiHW {
    static constexpr bool PERM = true, AFTER_DRAIN = false;
    bf16* h; const float* x; bf16* hw; const float* wffn; float* ss;
    __device__ __forceinline__ void operator()(const pg8::f32x4 (&acc)[2][2][4][2], const pg8::Unit& u, int wr, int wc, int fr, int fq) const {
#pragma unroll
        for (int ai = 0; ai < 2; ++ai)
#pragma unroll
            for (int m = 0; m < 4; ++m) {
                const int row = u.pm * 256 + ai * 128 + wr * 64 + m * 16 + fr;
                float sq = 0.f;
#pragma unroll
                for (int bj = 0; bj < 2; ++bj) {
                    const int col = u.pn * 256 + bj * 128 + wc * 32 + 8 * fq;
                    const size_t o = (size_t)row * 1024 + col;
                    const f32x4 x0 = *(const f32x4*)(x + o), x1 = *(const f32x4*)(x + o + 4);
                    const f32x4 w0 = *(const f32x4*)(wffn + col), w1 = *(const f32x4*)(wffn + col + 4);
                    const pg8::f32x4 v0 = acc[ai][bj][m][0], v1 = acc[ai][bj][m][1];
                    const f32x4 h0 = (f32x4){x0.x + v0[0], x0.y + v0[1], x0.z + v0[2], x0.w + v0[3]}, h1 = (f32x4){x1.x + v1[0], x1.y + v1[1], x1.z + v1[2], x1.w + v1[3]};
                    *(v4u*)(h + o) = (v4u){pk2(h0.x, h0.y), pk2(h0.z, h0.w), pk2(h1.x, h1.y), pk2(h1.z, h1.w)};
                    *(v4u*)(hw + o) = (v4u){pk2(h0.x * w0.x, h0.y * w0.y), pk2(h0.z * w0.z, h0.w * w0.w), pk2(h1.x * w1.x, h1.y * w1.y), pk2(h1.z * w1.z, h1.w * w1.w)};
                    sq += (h0.x * h0.x + h0.y * h0.y) + (h0.z * h0.z + h0.w * h0.w) + (h1.x * h1.x + h1.y * h1.y) + (h1.z * h1.z + h1.w * h1.w);
                }
                sq += __shfl_xor(sq, 16); sq += __shfl_xor(sq, 32);
                if (fq == 0) ss[(size_t)row * 16 + u.pn * 4 + wc] = sq;
            }
    }
};

template <class E>
__device__ __forceinline__ void simple_gemm(LAS unsigned char* lds, const bf16* A, const bf16* Bt, int M, int N, int K, const E& e) {
    LAS float* As = (LAS float*)lds;
    LAS float* Bs = As + 32 * 132;
    const int tid = threadIdx.x, ty = tid >> 4, tx = tid & 15;
    const int ntn = N / 128, ntiles = (M / 128) * ntn;
    for (int tile = blockIdx.x; tile < ntiles; tile += gridDim.x) {
        const int tm = tile / ntn, tn = tile % ntn;
        float acc[4][8];
#pragma unroll
        for (int i = 0; i < 4; ++i)
#pragma unroll
            for (int j = 0; j < 8; ++j) acc[i][j] = 0.f;
        for (int k0 = 0; k0 < K; k0 += 32) {
            {
                const int r = tid >> 2, kq = (tid & 3) * 8;
                float fa[8], fb[8];
                unpack8(*(const v4u*)(A + (size_t)(tm * 128 + r) * K + k0 + kq), fa);
                unpack8(*(const v4u*)(Bt + (size_t)(tn * 128 + r) * K + k0 + kq), fb);
#pragma unroll
                for (int i = 0; i < 8; ++i) { As[(kq + i) * 132 + r] = fa[i]; Bs[(kq + i) * 132 + r] = fb[i]; }
            }
            __syncthreads();
#pragma unroll 8
            for (int k = 0; k < 32; ++k) {
                const f32x4 a4 = *(const LAS f32x4*)(As + k * 132 + ty * 4);
                const f32x4 b0 = *(const LAS f32x4*)(Bs + k * 132 + tx * 8), b1 = *(const LAS f32x4*)(Bs + k * 132 + tx * 8 + 4);
                const float av[4] = {a4.x, a4.y, a4.z, a4.w};
                const float bv[8] = {b0.x, b0.y, b0.z, b0.w, b1.x, b1.y, b1.z, b1.w};
#pragma unroll
                for (int i = 0; i < 4; ++i)
#pragma unroll
                    for (int j = 0; j < 8; ++j) acc[i][j] += av[i] * bv[j];
            }
            __syncthreads();
        }
#pragma unroll
        for (int i = 0; i < 4; ++i) {
            F8 a;
#pragma unroll
            for (int j = 0; j < 8; ++j) a.v[j] = acc[i][j];
            e(tm * 128 + ty * 4 + i, tn * 128 + tx * 8, a);
        }
    }
}

template <class E>
__device__ __forceinline__ void gemm(LAS unsigned char* lds, const bf16* A, const bf16* Bt, int M, int N, int K, const E& e) {
#if USE_PG8
    pg8::Gemm g{A, Bt, M, N, K}; pg8::StaticOrder S; S.init(M, N, (int)gridDim.x, (int)blockIdx.x);
    EpiAdapt<E> ea{e};
    pg8::gemm_phase<EpiAdapt<E>, pg8::StaticOrder, true, true>(lds, g, S, ea);
#else
    simple_gemm<E>(lds, A, Bt, M, N, K, e);
#endif
}

__device__ __forceinline__ void transpose_item(const float* W, int ldw, int K, bf16* WT, int src_col0, int dst_row0, LAS float* scr, int kb, int lane) {
    const int k0 = 64 * kb;
#pragma unroll 8
    for (int i = 0; i < 32; ++i) { const int kk = 2 * i + (lane >> 5); scr[kk * 33 + (lane & 31)] = W[(size_t)(k0 + kk) * ldw + src_col0 + (lane & 31)]; }
    LDS_WAIT(); asm volatile("" ::: "memory");
    const int c = lane & 7;
#pragma unroll
    for (int j = 0; j < 4; ++j) { const int n = (lane >> 3) + 8 * j; const LAS float* s = scr + (8 * c) * 33 + n;
        v4u o; o.x = pk2(s[0 * 33], s[1 * 33]); o.y = pk2(s[2 * 33], s[3 * 33]); o.z = pk2(s[4 * 33], s[5 * 33]); o.w = pk2(s[6 * 33], s[7 * 33]);
        *(v4u*)(WT + (size_t)(dst_row0 + n) * K + k0 + 8 * c) = o; }
    LDS_WAIT(); asm volatile("" ::: "memory");
}

struct P {
    const float *x, *norm_mix_w, *w_in, *conv_w, *conv_b, *b_i, *b_f, *ml_norm_w, *w_sb, *w_ml, *w_out, *norm_ffn_w, *w_query, *keys1, *keys2, *peer_u, *peer_v, *norm_final_w;
    float* out; unsigned char* ws;
};

__device__ __forceinline__ void p0_prologue(const P& p, LAS unsigned char* lds, int wave, int lane) {
    LAS float* scr = (LAS float*)(lds + wave * 8448);
    const int gw = blockIdx.x * NWAVES + wave, NGW = gridDim.x * NWAVES;
    bf16* W1T = (bf16*)(p.ws + WS_W1T); bf16* WSBT = (bf16*)(p.ws + WS_WSBT); bf16* WMLT = (bf16*)(p.ws + WS_WMLT); bf16* WOUTT = (bf16*)(p.ws + WS_WOUTT); bf16* WCT = (bf16*)(p.ws + WS_WCT);
    constexpr int I_1 = 16 * 176, I_SB = 8 * 32, I_ML = 8 * 32, I_O = 16 * 32, NT = I_1 + I_SB + I_ML + I_O;
    for (int it = gw; it < NT; it += NGW) {
        int r = it;
        if (r < I_1) { const int kb = r / 176, nb = r % 176, n0 = nb * 32; transpose_item(p.w_in, INC, 1024, W1T, n0 < 3584 ? n0 : n0 + 8, n0, scr, kb, lane); continue; } r -= I_1;
        if (r < I_SB) { const int kb = r / 32, nb = r % 32; transpose_item(p.w_sb, 1024, 1024, WSBT, nb * 32, nb * 32, scr, kb, lane);             continue; } r -= I_SB;
        if (r < I_ML) { const int kb = r / 32, nb = r % 32; transpose_item(p.w_ml, 1024, 1024, WSBT + 512, nb * 32, nb * 32, scr, kb, lane); continue; } r -= I_ML;
        { const int kb = r / 32, nb = r % 32; transpose_item(p.w_out, 1024, 1024, WOUTT, nb * 32, nb * 32, scr, kb, lane); }
    }
    bf16* XN = (bf16*)(p.ws + WS_XN); float* IFG = (float*)(p.ws + WS_IFG);
    LAS float* WG = (LAS float*)(lds + 8 * 8448);
    __syncthreads();
    for (int i = threadIdx.x; i < 2048; i += NTHR) { const int k = i >> 1, hf = i & 1; *(LAS f32x4*)(WG + k * 8 + hf * 4) = *(const f32x4*)(p.w_in + (size_t)k * INC + 3584 + hf * 4); }
    __syncthreads();
    for (int m = gw; m < T_; m += NGW) {
        const f32x4* xr = (const f32x4*)(p.x + (size_t)m * 1024) + lane;
        const f32x4* wr = (const f32x4*)p.norm_mix_w + lane;
        f32x4 v[4]; float ss = 0.f;
#pragma unroll
        for (int j = 0; j < 4; ++j) { v[j] = xr[64 * j]; ss += (v[j].x * v[j].x + v[j].y * v[j].y) + (v[j].z * v[j].z + v[j].w * v[j].w); }
        const float rstd = frsq(wave_sum(ss) * (1.f / 1024.f) + EPS);
        float g[8];
#pragma unroll
        for (int i = 0; i < 8; ++i) g[i] = 0.f;
        v2u* o8 = (v2u*)(XN + (size_t)m * 1024) + lane;
#pragma unroll
        for (int j = 0; j < 4; ++j) {
            const f32x4 w = wr[64 * j];
            const float y[4] = {v[j].x * rstd * w.x, v[j].y * rstd * w.y, v[j].z * rstd * w.z, v[j].w * rstd * w.w};
            o8[64 * j] = (v2u){pk2(y[0], y[1]), pk2(y[2], y[3])};
#pragma unroll
            for (int q = 0; q < 4; ++q) {
                const int k = 256 * j + 4 * lane + q;
                const f32x4 w0 = *(const LAS f32x4*)(WG + k * 8), w1 = *(const LAS f32x4*)(WG + k * 8 + 4);
                g[0] += y[q] * w0.x; g[1] += y[q] * w0.y; g[2] += y[q] * w0.z; g[3] += y[q] * w0.w;
                g[4] += y[q] * w1.x; g[5] += y[q] * w1.y; g[6] += y[q] * w1.z; g[7] += y[q] * w1.w;
            }
        }
        {
            const bool b5 = (lane & 32) != 0, b4 = (lane & 16) != 0, b3 = (lane & 8) != 0;
            float e4[4], f2[2], gs;
#pragma unroll
            for (int i = 0; i < 4; ++i) { const float keep = b5 ? g[2 * i + 1] : g[2 * i], send = b5 ? g[2 * i] : g[2 * i + 1]; e4[i] = keep + __shfl_xor(send, 32); }
#pragma unroll
            for (int i = 0; i < 2; ++i) { const float keep = b4 ? e4[2 * i + 1] : e4[2 * i], send = b4 ? e4[2 * i] : e4[2 * i + 1]; f2[i] = keep + __shfl_xor(send, 16); }
            { const float keep = b3 ? f2[1] : f2[0], send = b3 ? f2[0] : f2[1]; gs = keep + __shfl_xor(send, 8); }
            gs += __shfl_xor(gs, 4); gs += __shfl_xor(gs, 2); gs += __shfl_xor(gs, 1);
            const int gi = 4 * (b3 ? 1 : 0) + 2 * (b4 ? 1 : 0) + (b5 ? 1 : 0);
            if ((lane & 7) == 0) IFG[(size_t)m * 8 + gi] = gs + (gi < 4 ? p.b_i[gi] : p.b_f[gi - 4]);
        }
    }
}

__device__ __forceinline__ void fill_wc(const P& p, int it, int lane) {
    bf16* WCT = (bf16*)(p.ws + WS_WCT);
    const int hhf = it >> 6, kb = (it >> 2) & 15, kq = it & 3, head = hhf >> 1, half = hhf & 1, k = kb * 64 + lane;
    const f32x4* wq = (const f32x4*)(p.w_query + (size_t)k * 2048 + head * 256 + half * 128);
    f32x4 wr[32];
#pragma unroll
    for (int i = 0; i < 32; ++i) wr[i] = wq[i];
    const float* kbase = (half ? p.keys2 : p.keys1) + ((size_t)head * 128 + kq * 32) * 128;
#pragma unroll 1
    for (int key = 0; key < 32; ++key) {
        const f32x4* kr = (const f32x4*)(kbase + (size_t)key * 128);
        float a0 = 0.f, a1 = 0.f;
#pragma unroll
        for (int i = 0; i < 32; i += 2) { const f32x4 b0 = kr[i], b1 = kr[i + 1];
            a0 += wr[i].x * b0.x + wr[i].y * b0.y + wr[i].z * b0.z + wr[i].w * b0.w;
            a1 += wr[i + 1].x * b1.x + wr[i + 1].y * b1.y + wr[i + 1].z * b1.z + wr[i + 1].w * b1.w; }
        WCT[(size_t)(hhf * 128 + kq * 32 + key) * 1024 + k] = (bf16)f2bf(a0 + a1);
    }
}
__device__ __forceinline__ void fill_tables(const P& p, int e, int lane) {
    unsigned char* U8 = p.ws + WS_U8; unsigned char* V8 = p.ws + WS_V8; float* USC = (float*)(p.ws + WS_USC); float* VSC = (float*)(p.ws + WS_VSC);
    f32x4 v[2][4]; float am[2] = {0.f, 0.f};
#pragma unroll
    for (int which = 0; which < 2; ++which) {
        const float* src = (which ? p.peer_v : p.peer_u) + (size_t)e * 1024 + 16 * lane;
#pragma unroll
        for (int j = 0; j < 4; ++j) v[which][j] = *(const f32x4*)(src + 4 * j);
    }
#pragma unroll
    for (int which = 0; which < 2; ++which)
#pragma unroll
        for (int j = 0; j < 4; ++j) am[which] = fmaxf(am[which], fmaxf(fmaxf(fabsf(v[which][j].x), fabsf(v[which][j].y)), fmaxf(fabsf(v[which][j].z), fabsf(v[which][j].w))));
#pragma unroll
    for (int o = 1; o < 64; o <<= 1) { am[0] = fmaxf(am[0], __shfl_xor(am[0], o)); am[1] = fmaxf(am[1], __shfl_xor(am[1], o)); }
#pragma unroll
    for (int which = 0; which < 2; ++which) {
        const float sc = am[which] > 0.f ? exp2f(floorf(log2f(448.f / am[which]))) : 1.f;
        unsigned w[4];
#pragma unroll
        for (int j = 0; j < 4; ++j) { int t = __builtin_amdgcn_cvt_pk_fp8_f32(v[which][j].x * sc, v[which][j].y * sc, 0, false); t = __builtin_amdgcn_cvt_pk_fp8_f32(v[which][j].z * sc, v[which][j].w * sc, t, true); w[j] = (unsigned)t; }
        *(v4u*)((which ? V8 : U8) + ((size_t)(lane >> 3) * NEXP + e) * 128 + 16 * (lane & 7)) = (v4u){w[0], w[1], w[2], w[3]};
        if (lane == 0) (which ? VSC : USC)[e] = 1.f / sc;
    }
}
constexpr int N_FILL = 128 + 1024;
__device__ __forceinline__ void fill_item(const P& p, int item, int wave, int lane) {
    if (item < 128) fill_wc(p, item * 8 + wave, lane);
    else { const int e0 = (item - 128) * 16 + wave * 2; fill_tables(p, e0, lane); fill_tables(p, e0 + 1, lane); }
}

typedef short bf16x8 __attribute__((ext_vector_type(8)));
typedef float f32x16 __attribute__((ext_vector_type(16)));
#define MFMA32(a, b, c) __builtin_amdgcn_mfma_f32_32x32x16_bf16((a), (b), (c), 0, 0, 0)
__device__ __forceinline__ int crow(int reg, int hh) { return (reg & 3) + 8 * (reg >> 2) + 4 * hh; }
template <int S> __device__ __forceinline__ bf16x8 pack_step(const f32x16& x) {
    v4u p; p.x = cvtpk(x[8 * S], x[8 * S + 1]); p.y = cvtpk(x[8 * S + 2], x[8 * S + 3]); p.z = cvtpk(x[8 * S + 4], x[8 * S + 5]); p.w = cvtpk(x[8 * S + 6], x[8 * S + 7]);
    return __builtin_bit_cast(bf16x8, p);
}
__device__ __forceinline__ bf16x8 frag2(const v2u& lo, const v2u& hi) { v4u p; p.x = lo.x; p.y = lo.y; p.z = hi.x; p.w = hi.y; return __builtin_bit_cast(bf16x8, p); }
__device__ __forceinline__ f32x16 zero16() { f32x16 z; for (int i = 0; i < 16; ++i) z[i] = 0.f; return z; }


__device__ __forceinline__ void p2_conv(const P& p, int tid) {
    const bf16* MLQK = (const bf16*)(p.ws + WS_MLQK); bf16* QC = (bf16*)(p.ws + WS_QC); bf16* KC = (bf16*)(p.ws + WS_KC);
    const int cg = tid & 127, ch0 = 8 * cg;
    float cw[4][8], cb[8];
#pragma unroll
    for (int i = 0; i < 8; ++i) { cb[i] = p.conv_b[ch0 + i];
#pragma unroll
        for (int j = 0; j < 4; ++j) cw[j][i] = p.conv_w[j * 1024 + ch0 + i]; }
    const float osc = cg >= 64 ? 0.08838834764831845f : 1.f;
    bf16* dst = (cg >= 64 ? KC : QC) + (cg & 63) * 8;
    for (int rg = blockIdx.x * 4 + (tid >> 7); rg < T_ / 4; rg += gridDim.x * 4) {
        const int tok = rg * 4, pos0 = tok & (S_ - 1);
        v4u xr[7];
#pragma unroll
        for (int k = 0; k < 7; ++k) xr[k] = (pos0 + k - 3 >= 0) ? *(const v4u*)(MLQK + (size_t)(tok + k - 3) * 1024 + ch0) : (v4u){0u, 0u, 0u, 0u};
#pragma unroll
        for (int tt = 0; tt < 4; ++tt) {
            float y[8];
#pragma unroll
            for (int i = 0; i < 8; ++i) y[i] = cb[i];
#pragma unroll
            for (int j = 0; j < 4; ++j) { float f[8]; unpack8(xr[tt + j], f);
#pragma unroll
                for (int i = 0; i < 8; ++i) y[i] += cw[j][i] * f[i]; }
#pragma unroll
            for (int i = 0; i < 8; ++i) y[i] = y[i] * sigmoidf_(y[i]) * osc;
            *(v4u*)(dst + (size_t)(tok + tt) * 512) = pack8(y);
        }
    }
}

constexpr int ML_QS = 0, ML_KS = 17408, ML_KWT = 34816, ML_VTL = 53248, ML_PS = 71680, ML_CT = 80896, ML_SCAL = 115712, ML_SSP = 118272, ML_QN = ML_SSP + 512, ML_F1 = ML_QN + 256, ML_F2 = ML_F1 + 256, ML_NV = ML_F2 + 256;
static_assert(ML_NV + 512 <= RING_BYTES, "mLSTM LDS map");
__device__ __forceinline__ void mlstm_scal(float ip, float fp, LAS float* sc, float& m_carry, int lane) {
    const float lf = fminf(fp, 0.f) - flog(1.f + fexp(-fabsf(fp)));
    float bc = lf;
#pragma unroll
    for (int o = 1; o < 64; o <<= 1) { const float t2 = __shfl_up(bc, o); if (lane >= o) bc += t2; }
    const float a = ip - bc; float pm = a;
#pragma unroll
    for (int o = 1; o < 64; o <<= 1) { const float t2 = __shfl_up(pm, o); if (lane >= o) pm = fmaxf(pm, t2); }
    const float M = fmaxf(m_carry, pm);
    const float M63 = __shfl(M, 63), bc63 = __shfl(bc, 63);
    sc[lane] = a; sc[64 + lane] = M; sc[128 + lane] = fexp(a - M63); sc[192 + lane] = fexp(m_carry - M); sc[256 + lane] = fexp(-(bc + M));
    m_carry = bc63 + M63;
}
__device__ __forceinline__ void mlstm_item(const P& p, LAS unsigned char* lds, int item, int tid, int wave, int lane) {
    const int b = item >> 2, h = item & 3;
    const int r = lane & 31, hh = lane >> 5, et = wave & 3, th = wave >> 2;
    const bf16* QC = (const bf16*)(p.ws + WS_QC); const bf16* KC = (const bf16*)(p.ws + WS_KC); const bf16* MLV = (const bf16*)(p.ws + WS_MLV); const float* IFG = (const float*)(p.ws + WS_IFG);
    bf16* HML = (bf16*)p.out + 512;
    LAS float* SCAL = (LAS float*)(lds + ML_SCAL); LAS float* SSP = (LAS float*)(lds + ML_SSP); LAS float* QN = (LAS float*)(lds + ML_QN);
    LAS float* F1 = (LAS float*)(lds + ML_F1); LAS float* F2 = (LAS float*)(lds + ML_F2); LAS float* NV = (LAS float*)(lds + ML_NV);
    const int cg = tid & 15, trow = tid >> 4, eg = cg, sl = trow;
    const size_t hq = (size_t)h * 128 + 8 * cg;
    for (int i = tid; i < (128 * 136 * 2) / 4; i += NTHR) ((LAS unsigned*)(lds + ML_CT))[i] = 0u;
    if (tid < 128) NV[tid] = 0.f;
    f32x16 accC[2]; accC[0] = zero16(); accC[1] = zero16();
    float m_carry = 0.f;
    if (wave == 3) { const size_t tk = (size_t)b * S_ + lane; mlstm_scal(IFG[tk * 8 + h], IFG[tk * 8 + 4 + h], SCAL, m_carry, lane); }
    v4u pq[2], pk[2], pv[2];
    {
        const size_t t0 = (size_t)b * S_;
#pragma unroll
        for (int u = 0; u < 2; ++u) { pq[u] = *(const v4u*)(QC + (t0 + trow + 32 * u) * 512 + hq); pk[u] = *(const v4u*)(KC + (t0 + trow + 32 * u) * 512 + hq); pv[u] = *(const v4u*)(MLV + (t0 + sl + 32 * u) * 512 + hq); }
    }
    float ipn = 0.f, fpn = 0.f;
    __syncthreads();
    for (int c = 0; c < 32; ++c) {
        const size_t tok0 = (size_t)b * S_ + c * 64;
        LAS float* sc = SCAL + (c & 1) * 320;
        {
#pragma unroll
            for (int u = 0; u < 2; ++u) {
                const int t = trow + 32 * u;
                *(LAS v4u*)(lds + ML_QS + t * 272 + cg * 16) = pq[u];
                *(LAS v4u*)(lds + ML_KS + t * 272 + cg * 16) = pk[u];
                float f[8]; unpack8(pk[u], f);
                const float wk = sc[128 + t];
#pragma unroll
                for (int i = 0; i < 8; ++i) *(LAS bf16*)(lds + ML_KWT + (8 * cg + i) * 144 + ((t ^ (8 * (cg & 7))) * 2)) = (bf16)f2bf(f[i] * wk);
                const unsigned vv[4] = {pv[u].x, pv[u].y, pv[u].z, pv[u].w};
#pragma unroll
                for (int i = 0; i < 4; ++i) {
                    *(LAS bf16*)(lds + ML_VTL + (8 * eg + 2 * i) * 144 + ((t ^ (8 * (eg & 7))) * 2)) = (bf16)(vv[i] & 0xffffu);
                    *(LAS bf16*)(lds + ML_VTL + (8 * eg + 2 * i + 1) * 144 + ((t ^ (8 * (eg & 7))) * 2)) = (bf16)(vv[i] >> 16);
                }
            }
            if (c + 1 < 32) {
                const size_t t1 = tok0 + 64;
#pragma unroll
                for (int u = 0; u < 2; ++u) { pq[u] = *(const v4u*)(QC + (t1 + trow + 32 * u) * 512 + hq); pk[u] = *(const v4u*)(KC + (t1 + trow + 32 * u) * 512 + hq); pv[u] = *(const v4u*)(MLV + (t1 + sl + 32 * u) * 512 + hq); }
                if (wave == 3) { ipn = IFG[(t1 + lane) * 8 + h]; fpn = IFG[(t1 + lane) * 8 + 4 + h]; }
            }
        }
        __syncthreads();
        f32x16 acc_inter = zero16();
        if (wave < 3) {
            const int tt = wave > 0 ? 1 : 0, st = wave == 2 ? 1 : 0;
            f32x16 zt = zero16();
#pragma unroll
            for (int ks = 0; ks < 8; ++ks) {
                const bf16x8 ka = *(const LAS bf16x8*)(lds + ML_KS + (32 * st + r) * 272 + 32 * ks + 16 * hh);
                const bf16x8 qb = *(const LAS bf16x8*)(lds + ML_QS + (32 * tt + r) * 272 + 32 * ks + 16 * hh);
                zt = MFMA32(ka, qb, zt);
            }
            const int t = 32 * tt + r; const float Mt = sc[64 + t];
            float ps = 0.f;
#pragma unroll
            for (int g = 0; g < 4; ++g) {
                const f32x4 av = *(const LAS f32x4*)(sc + 32 * st + 8 * g + 4 * hh);
                float pv[4];
#pragma unroll
                for (int q = 0; q < 4; ++q) { const int sidx = 32 * st + 8 * g + 4 * hh + q;
                    const float wgt = sidx <= t ? fexp(av[q] - Mt) : 0.f; pv[q] = zt[4 * g + q] * wgt; ps += pv[q]; }
                *(LAS v2u*)(lds + ML_PS + t * 144 + (32 * st + 8 * g + 4 * hh) * 2) = (v2u){cvtpk(pv[0], pv[1]), cvtpk(pv[2], pv[3])};
            }
            ps += __shfl_xor(ps, 32);
            if (hh == 0) { SSP[st * 64 + t] = ps; if (wave == 0) SSP[64 + t] = 0.f; }
        }
        if (wave == 3 && c + 1 < 32) mlstm_scal(ipn, fpn, SCAL + ((c + 1) & 1) * 320, m_carry, lane);
#pragma unroll
        for (int ks = 0; ks < 8; ++ks) {
            const bf16x8 qa = *(const LAS bf16x8*)(lds + ML_QS + (32 * th + r) * 272 + 32 * ks + 16 * hh);
            const bf16x8 cbf = *(const LAS bf16x8*)(lds + ML_CT + (32 * et + r) * 272 + 32 * ks + 16 * hh);
            acc_inter = MFMA32(qa, cbf, acc_inter);
        }
        {
            const int t = tid >> 3, part = tid & 7;
            float f[8], sum = 0.f;
            { const v4u tq = *(const LAS v4u*)(lds + ML_QS + t * 272 + part * 32); unpack8(tq, f); }
#pragma unroll
            for (int i = 0; i < 8; ++i) sum += f[i] * NV[16 * part + i];
            { const v4u tq = *(const LAS v4u*)(lds + ML_QS + t * 272 + part * 32 + 16); unpack8(tq, f); }
#pragma unroll
            for (int i = 0; i < 8; ++i) sum += f[i] * NV[16 * part + 8 + i];
            sum += __shfl_xor(sum, 1); sum += __shfl_xor(sum, 2); sum += __shfl_xor(sum, 4);
            if (part == 0) QN[t] = sum;
        }
        __syncthreads();
        f32x16 acc_intra = zero16();
#pragma unroll
        for (int ks = 0; ks < 4; ++ks) {
            if (ks < 2 || th == 1) {
                const bf16x8 pa = *(const LAS bf16x8*)(lds + ML_PS + (32 * th + r) * 144 + 32 * ks + 16 * hh);
                const bf16x8 vb = *(const LAS bf16x8*)(lds + ML_VTL + (32 * et + r) * 144 + 16 * ((2 * ks + hh) ^ (((32 * et + r) >> 3) & 7)));
                acc_intra = MFMA32(pa, vb, acc_intra);
            }
        }
        if (tid < 64) {
            const float wi = sc[192 + tid];
            const float den = SSP[tid] + SSP[64 + tid] + wi * QN[tid];
            const float f1 = frcp(fmaxf(fabsf(den), sc[256 + tid]));
            F1[tid] = f1; F2[tid] = wi * f1;
        }
        const float decay = sc[192 + 63];
#pragma unroll
        for (int dt = 0; dt < 2; ++dt) {
#pragma unroll
            for (int i = 0; i < 16; ++i) accC[dt][i] *= decay;
#pragma unroll
            for (int ks = 0; ks < 4; ++ks) {
                const bf16x8 ka = *(const LAS bf16x8*)(lds + ML_KWT + (64 * th + 32 * dt + r) * 144 + 16 * ((2 * ks + hh) ^ (((64 * th + 32 * dt + r) >> 3) & 7)));
                const bf16x8 vb = *(const LAS bf16x8*)(lds + ML_VTL + (32 * et + r) * 144 + 16 * ((2 * ks + hh) ^ (((32 * et + r) >> 3) & 7)));
                accC[dt] = MFMA32(ka, vb, accC[dt]);
            }
        }
        {
            const int d = tid >> 2, part = tid & 3;
            float f[8], sum = 0.f;
            { const v4u tq = *(const LAS v4u*)(lds + ML_KWT + d * 144 + part * 32); unpack8(tq, f); }
#pragma unroll
            for (int i = 0; i < 8; ++i) sum += f[i];
            { const v4u tq = *(const LAS v4u*)(lds + ML_KWT + d * 144 + part * 32 + 16); unpack8(tq, f); }
#pragma unroll
            for (int i = 0; i < 8; ++i) sum += f[i];
            sum += __shfl_xor(sum, 1); sum += __shfl_xor(sum, 2);
            if (part == 0) NV[d] = decay * NV[d] + sum;
        }
        __syncthreads();
        {
            bf16* hp = HML + (tok0 + 32 * th) * 1024 + h * 128 + 32 * et + r;
#pragma unroll
            for (int g = 0; g < 4; ++g) {
                const f32x4 f1v = *(const LAS f32x4*)(F1 + 32 * th + 8 * g + 4 * hh), f2v = *(const LAS f32x4*)(F2 + 32 * th + 8 * g + 4 * hh);
#pragma unroll
                for (int q = 0; q < 4; ++q) { const int tl = 8 * g + 4 * hh + q;
                    hp[(size_t)tl * 1024] = (bf16)f2bf(acc_intra[4 * g + q] * f1v[q] + acc_inter[4 * g + q] * f2v[q]); }
            }
#pragma unroll
            for (int dt = 0; dt < 2; ++dt)
#pragma unroll
                for (int g = 0; g < 4; ++g)
                    *(LAS v2u*)(lds + ML_CT + (32 * et + r) * 272 + (64 * th + 32 * dt + 8 * g + 4 * hh) * 2) = (v2u){cvtpk(accC[dt][4 * g], accC[dt][4 * g + 1]), cvtpk(accC[dt][4 * g + 2], accC[dt][4 * g + 3])};
        }
    }
    __syncthreads();
}

__device__ __forceinline__ void sba_wave_item(const bf16* __restrict__ QK, const bf16* __restrict__ VT, bf16* __restrict__ YSB, int b, int h, int qt, int lane) {
    const int r = lane & 31, hh = lane >> 5, t0 = qt * 32;
    const size_t rowbase = (size_t)b * S_;
    bf16x8 qf[4];
    {
        const bf16* qp = QK + (rowbase + t0 + r) * 1024 + h * 64 + 8 * hh;
#pragma unroll
        for (int ks = 0; ks < 4; ++ks) qf[ks] = *(const bf16x8*)(qp + 16 * ks);
    }
    bf16x8 tri[2];
#pragma unroll
    for (int s2 = 0; s2 < 2; ++s2)
#pragma unroll
        for (int j = 0; j < 8; ++j) { const int rho = 16 * s2 + 8 * (j >> 2) + 4 * hh + (j & 3); tri[s2][j] = (rho > r) ? (short)0x3F80 : (short)0; }
    f32x16 o0 = zero16(), o1 = zero16();
    float carry = 0.f;
    const bf16* kbase = QK + rowbase * 1024 + 512 + h * 64 + 8 * hh + (size_t)r * 1024;
    const bf16* vbase = VT + ((size_t)(b * 8 + h) * 64 + r) * 2048 + 4 * hh;
    bf16x8 kf[4]; v2u vl[2][2], vh[2][2];
#pragma unroll
    for (int ks = 0; ks < 4; ++ks) kf[ks] = *(const bf16x8*)(kbase + (size_t)t0 * 1024 + 16 * ks);
#pragma unroll
    for (int dt = 0; dt < 2; ++dt)
#pragma unroll
        for (int s2 = 0; s2 < 2; ++s2) { const bf16* vp = vbase + (size_t)dt * 32 * 2048 + t0 + 16 * s2; vl[dt][s2] = *(const v2u*)vp; vh[dt][s2] = *(const v2u*)(vp + 8); }
    for (int s0 = t0; s0 >= 0; s0 -= 32) {
        bf16x8 kn[4]; v2u vln[2][2], vhn[2][2];
        const int sn = s0 >= 32 ? s0 - 32 : 0;
#pragma unroll
        for (int ks = 0; ks < 4; ++ks) kn[ks] = *(const bf16x8*)(kbase + (size_t)sn * 1024 + 16 * ks);
#pragma unroll
        for (int dt = 0; dt < 2; ++dt)
#pragma unroll
            for (int s2 = 0; s2 < 2; ++s2) { const bf16* vp = vbase + (size_t)dt * 32 * 2048 + sn + 16 * s2; vln[dt][s2] = *(const v2u*)vp; vhn[dt][s2] = *(const v2u*)(vp + 8); }
        f32x16 z = zero16();
#pragma unroll
        for (int ks = 0; ks < 4; ++ks) z = MFMA32(kf[ks], qf[ks], z);
        const bool diag = (s0 == t0);
        f32x16 sp; float rs = 0.f;
#pragma unroll
        for (int i = 0; i < 16; ++i) {
            const float zz = z[i] * 0.125f;
            const bool valid = !diag || (crow(i, hh) < r);
            float spv = fmaxf(zz, 0.f) + flog(1.f + fexp(-fabsf(zz)));
            spv = valid ? spv : 0.f;
            sp[i] = spv; rs += spv; z[i] = zz - spv;
        }
        f32x16 suf = zero16();
        suf = MFMA32(tri[0], pack_step<0>(sp), suf);
        suf = MFMA32(tri[1], pack_step<1>(sp), suf);
        f32x16 w;
#pragma unroll
        for (int i = 0; i < 16; ++i) {
            const bool valid = !diag || (crow(i, hh) < r);
            const float lw = z[i] - suf[i] - carry;
            w[i] = valid ? fexp(lw) : 0.f;
        }
        rs += __shfl_xor(rs, 32);
        carry += rs;
        const bf16x8 pa0 = pack_step<0>(w), pa1 = pack_step<1>(w);
        o0 = MFMA32(pa0, frag2(vl[0][0], vh[0][0]), o0); o0 = MFMA32(pa1, frag2(vl[0][1], vh[0][1]), o0);
        o1 = MFMA32(pa0, frag2(vl[1][0], vh[1][0]), o1); o1 = MFMA32(pa1, frag2(vl[1][1], vh[1][1]), o1);
        if (__all(carry > 104.f)) break;
#pragma unroll
        for (int ks = 0; ks < 4; ++ks) kf[ks] = kn[ks];
#pragma unroll
        for (int dt = 0; dt < 2; ++dt)
#pragma unroll
            for (int s2 = 0; s2 < 2; ++s2) { vl[dt][s2] = vln[dt][s2]; vh[dt][s2] = vhn[dt][s2]; }
    }
    bf16* op = YSB + (rowbase + t0) * 1024 + h * 64 + r;
#pragma unroll
    for (int i = 0; i < 16; ++i) { const int t = crow(i, hh); op[(size_t)t * 1024] = (bf16)f2bf(o0[i]); op[(size_t)t * 1024 + 32] = (bf16)f2bf(o1[i]); }
}
__device__ __forceinline__ void sba_item(const P& p, int item, int wave, int lane) {
    const int bh = item >> 3, qb = item & 7, b = bh >> 3, h = bh & 7;
    sba_wave_item((const bf16*)(p.ws + WS_SBQKV), (const bf16*)(p.ws + WS_VT), (bf16*)p.out, b, h, qb * 8 + wave, lane);
}

__device__ __forceinline__ void p3_yml(const P& p, int wave, int lane) {
    const int gw = blockIdx.x * NWAVES + wave, NGW = gridDim.x * NWAVES;
    bf16* YML = (bf16*)p.out + 512; const bf16* MLO = (const bf16*)(p.ws + WS_MLO);
    for (int m = gw; m < T_; m += NGW) {
        float hv[8], ov[8], o[8];
        unpack8(*(const v4u*)(YML + (size_t)m * 1024 + lane * 8), hv); unpack8(*(const v4u*)(MLO + (size_t)m * 512 + lane * 8), ov);
        float ss = 0.f;
#pragma unroll
        for (int i = 0; i < 8; ++i) ss += hv[i] * hv[i];
        ss += __shfl_xor(ss, 1); ss += __shfl_xor(ss, 2); ss += __shfl_xor(ss, 4); ss += __shfl_xor(ss, 8);
        const float rstd = frsq(ss * (1.f / 128.f) + EPS);
        const f32x4 w0 = *(const f32x4*)(p.ml_norm_w + lane * 8), w1 = *(const f32x4*)(p.ml_norm_w + lane * 8 + 4);
        const float wv[8] = {w0.x, w0.y, w0.z, w0.w, w1.x, w1.y, w1.z, w1.w};
#pragma unroll
        for (int i = 0; i < 8; ++i) o[i] = sigmoidf_(ov[i]) * hv[i] * rstd * wv[i];
        *(v4u*)(YML + (size_t)m * 1024 + lane * 8) = pack8(o);
    }
}

__device__ __forceinline__ void p6_hn(const P& p, int wave, int lane) {
    const int gw = blockIdx.x * NWAVES + wave, NGW = gridDim.x * NWAVES;
    const float* H = (const float*)(p.ws + WS_H); bf16* HN = (bf16*)(p.ws + WS_HN);
    for (int m = gw; m < T_; m += NGW) {
        const f32x4* xr = (const f32x4*)(H + (size_t)m * 1024) + lane; const f32x4* wr = (const f32x4*)p.norm_ffn_w + lane;
        f32x4 v[4]; float ss = 0.f;
#pragma unroll
        for (int j = 0; j < 4; ++j) { v[j] = xr[64 * j]; ss += (v[j].x * v[j].x + v[j].y * v[j].y) + (v[j].z * v[j].z + v[j].w * v[j].w); }
        const float rstd = frsq(wave_sum(ss) * (1.f / 1024.f) + EPS);
        v2u* o8 = (v2u*)(HN + (size_t)m * 1024) + lane;
#pragma unroll
        for (int j = 0; j < 4; ++j) { const f32x4 w = wr[64 * j]; o8[64 * j] = (v2u){pk2(v[j].x * rstd * w.x, v[j].y * rstd * w.y), pk2(v[j].z * rstd * w.z, v[j].w * rstd * w.w)}; }
    }
}

__device__ __forceinline__ float ffn_rstd(const float* SS, int m) {
    const f32x4* q = (const f32x4*)(SS + (size_t)m * 16); const f32x4 a = q[0], b = q[1], c = q[2], d = q[3];
    const float t = ((a.x + a.y) + (a.z + a.w)) + ((b.x + b.y) + (b.z + b.w)) + ((c.x + c.y) + (c.z + c.w)) + ((d.x + d.y) + (d.z + d.w));
    return frsq(t * (1.f / 1024.f) + EPS);
}
__device__ __forceinline__ unsigned ord_key(float f) { const unsigned u = __builtin_bit_cast(unsigned, f); return (u & 0x80000000u) ? ~u : (u | 0x80000000u); }
__device__ __forceinline__ float ord_val(unsigned k) { const unsigned u = (k & 0x80000000u) ? (k & 0x7fffffffu) : ~k; return __builtin_bit_cast(float, u); }
template <int CTRL> __device__ __forceinline__ unsigned dpp_u(unsigned v) { return (unsigned)__builtin_amdgcn_update_dpp(0, (int)v, CTRL, 0xF, 0xF, true); }
__device__ __forceinline__ unsigned umax_(unsigned a, unsigned b) { return a > b ? a : b; }
__device__ __forceinline__ unsigned umin_(unsigned a, unsigned b) { return a < b ? a : b; }
__device__ __forceinline__ unsigned row_max_u(unsigned v) {
    v = umax_(v, dpp_u<0xB1>(v)); v = umax_(v, dpp_u<0x4E>(v)); v = umax_(v, dpp_u<0x141>(v)); v = umax_(v, dpp_u<0x140>(v)); return v;
}
__device__ __forceinline__ float row_sum_f(float v) {
    v += __builtin_bit_cast(float, dpp_u<0xB1>(__builtin_bit_cast(unsigned, v))); v += __builtin_bit_cast(float, dpp_u<0x4E>(__builtin_bit_cast(unsigned, v)));
    v += __builtin_bit_cast(float, dpp_u<0x141>(__builtin_bit_cast(unsigned, v))); v += __builtin_bit_cast(float, dpp_u<0x140>(__builtin_bit_cast(unsigned, v))); return v;
}
#define CE_(i, j) do { const unsigned _a = k[i], _b = k[j]; k[i] = umax_(_a, _b); k[j] = umin_(_a, _b); } while (0)
__device__ __forceinline__ unsigned row_top16(unsigned (&k)[8], unsigned (&top)[16], int li) {
    CE_(0, 1); CE_(2, 3); CE_(4, 5); CE_(6, 7); CE_(0, 2); CE_(1, 3); CE_(4, 6); CE_(5, 7); CE_(1, 2); CE_(5, 6);
    CE_(0, 4); CE_(1, 5); CE_(2, 6); CE_(3, 7); CE_(2, 4); CE_(3, 5); CE_(1, 2); CE_(3, 4); CE_(5, 6);
    unsigned mine = 0u;
#pragma unroll
    for (int n = 0; n < 16; ++n) {
        const unsigned m = row_max_u(k[0]);
        const bool hit = k[0] == m;
#pragma unroll
        for (int i = 0; i < 7; ++i) k[i] = hit ? k[i + 1] : k[i];
        k[7] = hit ? 0u : k[7];
        top[n] = m; mine = (li == n) ? m : mine;
    }
    return mine;
}
__device__ __forceinline__ void topk_core(const float (&s1)[8], const float (&s2)[8], float rstd, int li, int lane, int& e_out, float& g_out) {
    unsigned k[8], top1[16], top2[16];
#pragma unroll
    for (int j = 0; j < 8; ++j) k[j] = (ord_key(s1[j]) & ~0x7fu) | (unsigned)(127 - (li + 16 * j));
    const unsigned mine1 = row_top16(k, top1, li);
#pragma unroll
    for (int j = 0; j < 8; ++j) k[j] = (ord_key(s2[j]) & ~0x7fu) | (unsigned)(127 - (li + 16 * j));
    const unsigned mine2 = row_top16(k, top2, li);
    const float v2 = ord_val(mine2 & ~0x7fu);
    unsigned c[16];
#pragma unroll
    for (int j = 0; j < 16; ++j) {
        const float v1 = ord_val(top1[j] & ~0x7fu);
        const unsigned key = (ord_key(v1 + v2) & ~0xffu) | (unsigned)(255 - (16 * j + li));
        c[j] = ((j + 1) * (li + 1) <= 16) ? key : 0u;
    }
    unsigned tk = 0u, t0 = 0u;
#pragma unroll
    for (int n = 0; n < 16; ++n) {
        const unsigned mx = row_max_u(c[0]);
        const bool hit = c[0] == mx;
#pragma unroll
        for (int i = 0; i < 15; ++i) c[i] = hit ? c[i + 1] : c[i];
        c[15] = hit ? 0u : c[15];
        if (n == 0) t0 = mx;
        tk = (li == n) ? mx : tk;
    }
    const float sv = ord_val(tk & ~0xffu), s0 = ord_val(t0 & ~0xffu);
    const int cc = 255 - (int)(tk & 0xffu), a = (cc >> 4) & 15, bb = cc & 15;
    const int i1 = 127 - (int)((unsigned)__shfl((int)mine1, (lane & 48) + a) & 0x7fu), i2 = 127 - (int)((unsigned)__shfl((int)mine2, (lane & 48) + bb) & 0x7fu);
    const float pe = fexp((sv - s0) * rstd);
    const float den = row_sum_f(pe);
    e_out = i1 * 128 + i2; g_out = pe * frcp(den);
}
constexpr int TK_RS = 1040;
struct EpiTopk {
    static constexpr bool PERM = true, AFTER_DRAIN = true;
    int* IDX; float* GATE; const float* SS;
    __device__ __forceinline__ void fused(pg8::f32x4 (&acc)[2][2][4][2], const pg8::Unit& u, int wr, int wc, int fr, int fq, PG8_LAS unsigned char* lds, int wid, int lane) const {
        const int head = u.pn, q = lane >> 4, li = lane & 15;
#pragma unroll
        for (int ai = 0; ai < 2; ++ai) {
#pragma unroll
            for (int m = 0; m < 4; ++m)
#pragma unroll
                for (int bj = 0; bj < 2; ++bj) {
                    PG8_LAS unsigned char* dst = lds + (wr * 64 + m * 16 + fr) * TK_RS + (bj * 128 + wc * 32 + 8 * fq) * 4;
                    *(PG8_LAS pg8::f32x4*)dst = acc[ai][bj][m][0]; *(PG8_LAS pg8::f32x4*)(dst + 16) = acc[ai][bj][m][1];
                }
            __syncthreads();
#pragma unroll 1
            for (int it = 0; it < 4; it += 2) {
                const int rowa = 16 * wid + 4 * it + q, rowb = rowa + 4, ma = u.pm * 256 + ai * 128 + rowa, mb = ma + 4;
                const PG8_LAS float* sa = (const PG8_LAS float*)(lds + rowa * TK_RS); const PG8_LAS float* sb = (const PG8_LAS float*)(lds + rowb * TK_RS);
                float a1[8], a2[8], b1[8], b2[8];
#pragma unroll
                for (int j = 0; j < 8; ++j) { a1[j] = sa[li + 16 * j]; a2[j] = sa[128 + li + 16 * j]; b1[j] = sb[li + 16 * j]; b2[j] = sb[128 + li + 16 * j]; }
                const float ra = ffn_rstd(SS, ma), rb = ffn_rstd(SS, mb);
                int ea, eb; float ga, gb;
                topk_core(a1, a2, ra, li, lane, ea, ga);
                topk_core(b1, b2, rb, li, lane, eb, gb);
                IDX[(size_t)ma * 128 + head * 16 + li] = ea; GATE[(size_t)ma * 128 + head * 16 + li] = ga;
                IDX[(size_t)mb * 128 + head * 16 + li] = eb; GATE[(size_t)mb * 128 + head * 16 + li] = gb;
            }
            __syncthreads();
        }
    }
};
struct OneUnit {
    pg8::Unit u;
    __device__ __forceinline__ bool next(int i, pg8::Unit& o) const { if (i) return false; o = u; return true; }
    __device__ __forceinline__ void a_ready(const pg8::Unit&) const {}
    __device__ __forceinline__ void done(const pg8::Unit&) const {}
};

__device__ __forceinline__ float gelu_erf(float x) { return 0.5f * x * (1.f + erff(x * 0.70710678118654752f)); }
typedef float f32x2 __attribute__((ext_vector_type(2)));
__device__ __forceinline__ void cvt16_fp8(const v4u& w, f32x2 (&f)[8]) {
    f[0] = __builtin_amdgcn_cvt_pk_f32_fp8((int)w.x, false); f[1] = __builtin_amdgcn_cvt_pk_f32_fp8((int)w.x, true);
    f[2] = __builtin_amdgcn_cvt_pk_f32_fp8((int)w.y, false); f[3] = __builtin_amdgcn_cvt_pk_f32_fp8((int)w.y, true);
    f[4] = __builtin_amdgcn_cvt_pk_f32_fp8((int)w.z, false); f[5] = __builtin_amdgcn_cvt_pk_f32_fp8((int)w.z, true);
    f[6] = __builtin_amdgcn_cvt_pk_f32_fp8((int)w.w, false); f[7] = __builtin_amdgcn_cvt_pk_f32_fp8((int)w.w, true);
}
__device__ __forceinline__ float grp8_sum(float v) {
    v += __builtin_bit_cast(float, dpp_u<0xB1>(__builtin_bit_cast(unsigned, v)));
    v += __builtin_bit_cast(float, dpp_u<0x4E>(__builtin_bit_cast(unsigned, v)));
    v += __builtin_bit_cast(float, dpp_u<0x141>(__builtin_bit_cast(unsigned, v)));
    return v;
}
typedef int i32x4 __attribute__((ext_vector_type(4)));
template <int PAT> __device__ __forceinline__ float swz_f(float v) { return __builtin_bit_cast(float, __builtin_amdgcn_ds_swizzle(__builtin_bit_cast(int, v), PAT)); }
__device__ __forceinline__ void peer_u_token(const v4u (&ur)[16], const f32x2 (&xv)[8], bf16* dst, int c8) {
    float d[16];
#pragma unroll
    for (int i = 0; i < 16; ++i) {
        f32x2 f[8]; cvt16_fp8(ur[i], f);
        f32x2 s2 = f[0] * xv[0];
#pragma unroll
        for (int q = 1; q < 8; ++q) s2 += f[q] * xv[q];
        d[i] = s2.x + s2.y;
    }
    const bool b0 = (c8 & 1) != 0, b1 = (c8 & 2) != 0, b2 = (c8 & 4) != 0;
    float e8[8], e4[4], e2[2];
#pragma unroll
    for (int i = 0; i < 8; ++i) { const float keep = b0 ? d[2 * i + 1] : d[2 * i], send = b0 ? d[2 * i] : d[2 * i + 1];
        e8[i] = keep + __builtin_bit_cast(float, dpp_u<0xB1>(__builtin_bit_cast(unsigned, send))); }
#pragma unroll
    for (int i = 0; i < 4; ++i) { const float keep = b1 ? e8[2 * i + 1] : e8[2 * i], send = b1 ? e8[2 * i] : e8[2 * i + 1];
        e4[i] = keep + __builtin_bit_cast(float, dpp_u<0x4E>(__builtin_bit_cast(unsigned, send))); }
#pragma unroll
    for (int i = 0; i < 2; ++i) { const float keep = b2 ? e4[2 * i + 1] : e4[2 * i], send = b2 ? e4[2 * i] : e4[2 * i + 1];
        e2[i] = keep + swz_f<0x1F | (4 << 10)>(send); }
    dst[c8] = (bf16)f2bf(e2[0]); dst[c8 + 8] = (bf16)f2bf(e2[1]);
}
__device__ __forceinline__ void peer_u(const P& p, int wave, int lane) {
    const int j = blockIdx.x & 7, nchunk = gridDim.x >> 3, chunk = blockIdx.x >> 3, stride = nchunk * 8;
    const int g = lane >> 3, c8 = lane & 7;
    const bf16* HN = (const bf16*)p.out + 128 * j + 16 * c8; const int* IDX = (const int*)(p.ws + WS_IDX) + 16 * g;
    const unsigned char* US = p.ws + WS_U8 + (size_t)j * NEXP * 128 + 16 * c8;
    bf16* PART = (bf16*)(p.ws + WS_PART) + (size_t)j * T_ * 128 + 16 * g;
    const int m0 = chunk * 8 + wave, ntok = (T_ - m0 + stride - 1) / stride;
#define PU_CLAMP(k) (m0 + ((k) < ntok ? (k) : ntok - 1) * stride)
#define PU_ROWS(ur, ei) _Pragma("unroll") for (int i = 0; i < 16; ++i) ur[i] = *(const v4u*)(US + (size_t)ei[i >> 2][i & 3] * 128)
#define PU_L1(ei, h0, h1, mm) do { _Pragma("unroll") for (int q = 0; q < 4; ++q) ei[q] = *(const i32x4*)(IDX + (size_t)(mm) * 128 + 4 * q); \
        h0 = *(const v4u*)(HN + (size_t)(mm) * 1024); h1 = *(const v4u*)(HN + (size_t)(mm) * 1024 + 8); } while (0)
#define PU_X(xv, h0, h1) do { float f_[8]; unpack8(h0, f_); _Pragma("unroll") for (int i = 0; i < 4; ++i) xv[i] = (f32x2){f_[2 * i], f_[2 * i + 1]}; \
        unpack8(h1, f_); _Pragma("unroll") for (int i = 0; i < 4; ++i) xv[4 + i] = (f32x2){f_[2 * i], f_[2 * i + 1]}; } while (0)
    i32x4 ei[4]; v4u hA0, hA1, hB0, hB1; v4u urA[16], urB[16]; f32x2 xv[8];
    PU_L1(ei, hA0, hA1, m0);
    PU_ROWS(urA, ei);
    PU_L1(ei, hB0, hB1, PU_CLAMP(1));
    for (int k = 0; k < ntok; k += 2) {
        PU_ROWS(urB, ei);
        PU_X(xv, hA0, hA1);
        PU_L1(ei, hA0, hA1, PU_CLAMP(k + 2));
        peer_u_token(urA, xv, PART + (size_t)(m0 + k * stride) * 128, c8);
        if (k + 1 < ntok) {
            PU_ROWS(urA, ei);
            PU_X(xv, hB0, hB1);
            PU_L1(ei, hB0, hB1, PU_CLAMP(k + 3));
            peer_u_token(urB, xv, PART + (size_t)(m0 + (k + 1) * stride) * 128, c8);
        }
    }
#undef PU_CLAMP
#undef PU_ROWS
#undef PU_L1
#undef PU_X
}
__device__ __forceinline__ void peer_c(const P& p, int wave, int lane) {
    const int gw = blockIdx.x * NWAVES + wave, NGW = gridDim.x * NWAVES;
    const int* IDX = (const int*)(p.ws + WS_IDX); const float* GATE = (const float*)(p.ws + WS_GATE); const bf16* PART = (const bf16*)(p.ws + WS_PART);
    const float* USC = (const float*)(p.ws + WS_USC); const float* VSC = (const float*)(p.ws + WS_VSC); float* COEF = (float*)(p.ws + WS_COEF); const float* SS = (const float*)(p.ws + WS_SS);
    for (int m0 = gw * 2; m0 < T_; m0 += NGW * 2) {
        float s[2][2], rs[2], g[2][2]; int e[2][2];
#pragma unroll
        for (int u = 0; u < 2; ++u) {
            const int m = m0 + u;
            rs[u] = ffn_rstd(SS, m);
            s[u][0] = 0.f; s[u][1] = 0.f;
#pragma unroll
            for (int jj = 0; jj < 8; ++jj) { s[u][0] += bf2f(PART[((size_t)jj * T_ + m) * 128 + lane]); s[u][1] += bf2f(PART[((size_t)jj * T_ + m) * 128 + 64 + lane]); }
            e[u][0] = IDX[(size_t)m * 128 + lane]; e[u][1] = IDX[(size_t)m * 128 + 64 + lane];
            g[u][0] = GATE[(size_t)m * 128 + lane]; g[u][1] = GATE[(size_t)m * 128 + 64 + lane];
        }
        float us[2][2], vs[2][2];
#pragma unroll
        for (int u = 0; u < 2; ++u)
#pragma unroll
            for (int k = 0; k < 2; ++k) { us[u][k] = USC[e[u][k]]; vs[u][k] = VSC[e[u][k]]; }
#pragma unroll
        for (int u = 0; u < 2; ++u)
#pragma unroll
            for (int k = 0; k < 2; ++k) COEF[(size_t)(m0 + u) * 128 + 64 * k + lane] = g[u][k] * gelu_erf(s[u][k] * rs[u] * us[u][k]) * vs[u][k];
    }
}
struct PvPre { i32x4 ei[4]; float c0, c1; };
__device__ __forceinline__ void pv_level1(PvPre& q, const int* IDXg, const float* COEFg, int m, int c8) {
#pragma unroll
    for (int k = 0; k < 4; ++k) q.ei[k] = *(const i32x4*)(IDXg + (size_t)m * 128 + 4 * k);
    q.c0 = COEFg[(size_t)m * 128 + c8]; q.c1 = COEFg[(size_t)m * 128 + c8 + 8];
}
__device__ __forceinline__ void peer_v_token(const v4u (&vr)[16], float coef0, float coef1, const bf16* H, bf16* out, float* ssq, bool b3, bool b4, bool b5, int lane) {
    f32x2 acc[8];
#pragma unroll
    for (int i = 0; i < 8; ++i) acc[i] = (f32x2){0.f, 0.f};
#define PV_STEP(I) do { const float cs_ = ((I) >> 3) ? coef1 : coef0; \
        const float cu_ = swz_f<0x18 | (((I) & 7) << 5)>(cs_);     \
        const f32x2 c2_ = (f32x2){cu_, cu_}; f32x2 f_[8]; cvt16_fp8(vr[I], f_); \
        _Pragma("unroll") for (int q = 0; q < 8; ++q) acc[q] += c2_ * f_[q]; } while (0)
    PV_STEP(0); PV_STEP(1); PV_STEP(2); PV_STEP(3); PV_STEP(4); PV_STEP(5); PV_STEP(6); PV_STEP(7);
    PV_STEP(8); PV_STEP(9); PV_STEP(10); PV_STEP(11); PV_STEP(12); PV_STEP(13); PV_STEP(14); PV_STEP(15);
#undef PV_STEP
    f32x2 a1[4], a2[2], a3;
#pragma unroll
    for (int i = 0; i < 4; ++i) { const f32x2 keep = b5 ? acc[2 * i + 1] : acc[2 * i], send = b5 ? acc[2 * i] : acc[2 * i + 1];
        a1[i] = keep + (f32x2){__shfl_xor(send.x, 32), __shfl_xor(send.y, 32)}; }
#pragma unroll
    for (int i = 0; i < 2; ++i) { const f32x2 keep = b4 ? a1[2 * i + 1] : a1[2 * i], send = b4 ? a1[2 * i] : a1[2 * i + 1];
        a2[i] = keep + (f32x2){swz_f<0x1F | (16 << 10)>(send.x), swz_f<0x1F | (16 << 10)>(send.y)}; }
    { const f32x2 keep = b3 ? a2[1] : a2[0], send = b3 ? a2[0] : a2[1]; a3 = keep + (f32x2){swz_f<0x1F | (8 << 10)>(send.x), swz_f<0x1F | (8 << 10)>(send.y)}; }
    const unsigned hb = *(const unsigned*)H; const f32x2 hv = (f32x2){bflo(hb), bfhi(hb)};
    const f32x2 y = hv + a3;
    *(unsigned*)out = pk2(y.x, y.y);
    const float ss = wave_sum(y.x * y.x + y.y * y.y);
    if (lane == 0) *ssq = ss;
}
__device__ __forceinline__ void peer_v(const P& p, int wave, int lane) {
    const int j = blockIdx.x & 7, nchunk = gridDim.x >> 3, chunk = blockIdx.x >> 3, stride = nchunk * 8;
    const int g = lane >> 3, c8 = lane & 7;
    const bool b5 = (lane & 32) != 0, b4 = (lane & 16) != 0, b3 = (lane & 8) != 0;
    const int pi = 4 * (b3 ? 1 : 0) + 2 * (b4 ? 1 : 0) + (b5 ? 1 : 0);
    const size_t colo = 128 * j + 16 * c8 + 2 * pi;
    const bf16* H = (const bf16*)(p.ws + WS_H) + colo; bf16* OUT = (bf16*)(p.ws + WS_YB) + colo;
    const int* IDXg = (const int*)(p.ws + WS_IDX) + 16 * g; const float* COEFg = (const float*)(p.ws + WS_COEF) + 16 * g;
    const unsigned char* VS = p.ws + WS_V8 + (size_t)j * NEXP * 128 + 16 * c8;
    float* SSQ = (float*)(p.ws + WS_SSQ) + (size_t)j * T_;
    const int m0 = chunk * 8 + wave, ntok = (T_ - m0 + stride - 1) / stride;
#define PV_CLAMP(k) (m0 + ((k) < ntok ? (k) : ntok - 1) * stride)
#define PV_ROWS(vr, q) _Pragma("unroll") for (int i = 0; i < 16; ++i) vr[i] = *(const v4u*)(VS + (size_t)q.ei[i >> 2][i & 3] * 128)
    PvPre q; v4u vrA[16], vrB[16];
    pv_level1(q, IDXg, COEFg, m0, c8);
    PV_ROWS(vrA, q);
    float cA0 = q.c0, cA1 = q.c1, cB0, cB1;
    pv_level1(q, IDXg, COEFg, PV_CLAMP(1), c8);
    for (int k = 0; k < ntok; k += 2) {
        PV_ROWS(vrB, q); cB0 = q.c0; cB1 = q.c1;
        pv_level1(q, IDXg, COEFg, PV_CLAMP(k + 2), c8);
        { const size_t mm = (size_t)(m0 + k * stride); peer_v_token(vrA, cA0, cA1, H + mm * 1024, OUT + mm * 1024, SSQ + mm, b3, b4, b5, lane); }
        if (k + 1 < ntok) {
            PV_ROWS(vrA, q); cA0 = q.c0; cA1 = q.c1;
            pv_level1(q, IDXg, COEFg, PV_CLAMP(k + 3), c8);
            { const size_t mm = (size_t)(m0 + (k + 1) * stride); peer_v_token(vrB, cB0, cB1, H + mm * 1024, OUT + mm * 1024, SSQ + mm, b3, b4, b5, lane); }
        }
    }
#undef PV_CLAMP
#undef PV_ROWS
}
__device__ __forceinline__ void peer_f(const P& p, int wave, int lane) {
    const int gw = blockIdx.x * NWAVES + wave, NGW = gridDim.x * NWAVES;
    const float* SSQ = (const float*)(p.ws + WS_SSQ);
    for (int m = gw; m < T_; m += NGW) {
        float ss = 0.f;
#pragma unroll
        for (int jj = 0; jj < 8; ++jj) ss += SSQ[(size_t)jj * T_ + m];
        const float rstd = frsq(ss * (1.f / 1024.f) + EPS);
        f32x4* o = (f32x4*)(p.out + (size_t)m * 1024) + lane; const f32x4* wr = (const f32x4*)p.norm_final_w + lane;
        const v2u* yb = (const v2u*)((const bf16*)(p.ws + WS_YB) + (size_t)m * 1024) + lane;
#pragma unroll
        for (int q = 0; q < 4; ++q) { const v2u yv = yb[64 * q]; const f32x4 w = wr[64 * q];
            o[64 * q] = (f32x4){bflo(yv.x) * rstd * w.x, bfhi(yv.x) * rstd * w.y, bflo(yv.y) * rstd * w.z, bfhi(yv.y) * rstd * w.w}; }
    }
}

constexpr int N_PHASES = 12;
struct Args { P p; int ph_lo, ph_hi; };
__global__ void __launch_bounds__(NTHR, 2) fwd_kernel(Args args) {
    extern __shared__ __attribute__((aligned(16))) unsigned char lds_raw[];
    LAS unsigned char* lds = (LAS unsigned char*)lds_raw;
    const P& p = args.p;
    const int tid = threadIdx.x, lane = tid & 63, wave = __builtin_amdgcn_readfirstlane(tid >> 6);
    volatile LAS unsigned* MISC = (volatile LAS unsigned*)(lds + MISC_OFF);
    for (int u = tid; u < (LDS_BYTES - LDSCTL_OFF) / 4; u += NTHR) ((LAS unsigned*)(lds + LDSCTL_OFF))[u] = 0u;
    __syncthreads();
    XcdBarrier bar; bar.bar = (unsigned*)(p.ws + WS_CTL) + CW_BAR; bar.x = 0; bar.st = nullptr;
#if !MK_PER_PHASE
    bar = xcd_barrier_post((unsigned*)(p.ws + WS_CTL) + CW_BAR, MISC + 8);
#endif
    const int lo = args.ph_lo, hi = args.ph_hi;
#define IN(k) (lo <= (k) && (k) < hi)
#ifndef PROBE_WAIT_LO
#define PROBE_WAIT_LO -1
#define PROBE_WAIT_HI -1
#endif
    volatile LAS unsigned long long* STAMP = (volatile LAS unsigned long long*)(lds + MISC_OFF + 256);
#define SEAM(k) do { if (IN(k) && IN((k) + 1)) xcd_barrier(bar); if (PROBE_WAIT_LO >= 0 && blockIdx.x == 0 && tid == 0) { STAMP[(k) + 1] = __builtin_amdgcn_s_memrealtime(); \
        if ((k) + 1 == N_PHASES - 1) { const unsigned long long d_ = STAMP[PROBE_WAIT_HI < 0 ? 0 : PROBE_WAIT_HI] - STAMP[PROBE_WAIT_LO < 0 ? 0 : PROBE_WAIT_LO]; \
            __hip_atomic_store((unsigned*)(p.ws + WS_CTL) + CW_Q + 256, (unsigned)d_ | 1u, __ATOMIC_RELAXED, __HIP_MEMORY_SCOPE_AGENT); } } } while (0)
    if (PROBE_WAIT_LO >= 0 && blockIdx.x == 0 && tid == 0) STAMP[0] = __builtin_amdgcn_s_memrealtime();

#ifndef PROBE_REP
#define PROBE_REP -1
#endif
#define REP(k) ((PROBE_REP == (k)) ? 2 : 1)
    if (IN(0)) {
#pragma unroll 1
        for (int r = 0; r < REP(0); ++r) p0_prologue(p, lds, wave, lane); } SEAM(0);
    if (IN(1)) {
#pragma unroll 1
      for (int r = 0; r < REP(1); ++r) {
        EpiProj e{(bf16*)(p.ws + WS_SBQKV), (bf16*)(p.ws + WS_VT), (bf16*)(p.ws + WS_MLQK), (bf16*)(p.ws + WS_MLV), (bf16*)(p.ws + WS_MLO), (bf16*)(p.ws + WS_GATES)};
        gemm<EpiProj>(lds, (const bf16*)(p.ws + WS_XN), (const bf16*)(p.ws + WS_W1T), T_, NPROJ, 1024, e); }
    } SEAM(1);
    if (IN(2)) { p2_conv(p, tid); } SEAM(2);
    if (IN(3)) {
        for (int it = blockIdx.x; it < 64; it += gridDim.x) mlstm_item(p, lds, it, tid, wave, lane);
        unsigned* qctr = (unsigned*)(p.ws + WS_CTL) + CW_Q;
#ifdef PROBE_P3SPLIT
        xcd_barrier(bar); if (blockIdx.x == 0 && tid == 0) STAMP[20] = __builtin_amdgcn_s_memrealtime();
#endif
        for (;;) {
            if (tid == 0) MISC[12] = __hip_atomic_fetch_add(qctr, 1u, __ATOMIC_RELAXED, __HIP_MEMORY_SCOPE_AGENT);
            __syncthreads();
            const unsigned it = MISC[12];
            __syncthreads();
            if (it >= 1024u) break;
            sba_item(p, (int)it, wave, lane);
        }
#ifdef PROBE_P3SPLIT
        xcd_barrier(bar); if (blockIdx.x == 0 && tid == 0) STAMP[21] = __builtin_amdgcn_s_memrealtime();
#endif
        for (;;) {
            if (tid == 0) MISC[12] = __hip_atomic_fetch_add(qctr + 128, 1u, __ATOMIC_RELAXED, __HIP_MEMORY_SCOPE_AGENT);
            __syncthreads();
            const unsigned it = MISC[12];
            __syncthreads();
            if (it >= (unsigned)N_FILL) break;
            fill_item(p, (int)it, wave, lane);
        }
    } SEAM(3);
    if (IN(4)) { p3_yml(p, wave, lane); } SEAM(4);
    if (IN(5)) {
        pg8::Gemm g{(const bf16*)p.out, (const bf16*)(p.ws + WS_WSBT), T_, 1024, 1024}; pg8::StaticOrder S; S.init(T_, 1024, (int)gridDim.x, (int)blockIdx.x);
        EpiMerge1 e{(bf16*)(p.ws + WS_MERGED), (const bf16*)(p.ws + WS_GATES)};
        pg8::gemm_phase<EpiMerge1, pg8::StaticOrder, true, true, true>(lds, g, S, e);
    } SEAM(5);
    if (IN(6)) {
        pg8::Gemm g{(const bf16*)(p.ws + WS_MERGED), (const bf16*)(p.ws + WS_WOUTT), T_, 1024, 1024}; pg8::StaticOrder S; S.init(T_, 1024, (int)gridDim.x, (int)blockIdx.x);
        EpiHW e{(bf16*)(p.ws + WS_H), p.x, (bf16*)p.out  , p.norm_ffn_w, (float*)(p.ws + WS_SS)};
        pg8::gemm_phase<EpiHW, pg8::StaticOrder, true, true>(lds, g, S, e);
    } SEAM(6);
    if (IN(7)) {
        pg8::Gemm g{(const bf16*)p.out, (const bf16*)(p.ws + WS_WCT), T_, 2048, 1024}; pg8::StaticOrder S; S.init(T_, 2048, (int)gridDim.x, (int)blockIdx.x);
        EpiTopk e{(int*)(p.ws + WS_IDX), (float*)(p.ws + WS_GATE), (const float*)(p.ws + WS_SS)};
#pragma unroll 1
        for (int i = 0;; ++i) { OneUnit s1; if (!S.next(i, s1.u)) break; pg8::gemm_phase<EpiTopk, OneUnit, false, true>(lds, g, s1, e); }
    } SEAM(7);
    if (IN(8)) { peer_u(p, wave, lane); } SEAM(8);
    if (IN(9)) { peer_c(p, wave, lane); } SEAM(9);
    if (IN(10)) { peer_v(p, wave, lane); } SEAM(10);
    if (IN(11)) { peer_f(p, wave, lane); }
    if (PROBE_WAIT_LO >= 0 && tid == 0) {
        unsigned* pw = (unsigned*)(p.ws + WS_CTL) + CW_Q + 256;
        unsigned dt = 0u;
        for (unsigned sp = 0; sp < (1u << 22); ++sp) { dt = __hip_atomic_load(pw, __ATOMIC_RELAXED, __HIP_MEMORY_SCOPE_AGENT); if (dt) break; __builtin_amdgcn_s_sleep(8); }
        const unsigned long long tend = __builtin_amdgcn_s_memrealtime();
        while (__builtin_amdgcn_s_memrealtime() - tend < (unsigned long long)dt) __builtin_amdgcn_s_sleep(8);
    }
#undef IN
#undef SEAM
}

extern "C" void kernel_launch(void* const* d_in, const int* in_sizes, int n_in, void* d_out, int out_size, void* d_ws, size_t ws_size, hipStream_t stream) {
    static int grid = 0;
    if (grid == 0) {
        if (n_in != 18 || in_sizes[0] != T_ * D_ || out_size != T_ * D_ || ws_size < WS_END) {
            fprintf(stderr, "kernel_launch: unexpected problem (n_in %d, in0 %d, out %d, ws %zu); nothing launched\n", n_in, n_in > 0 ? in_sizes[0] : -1, out_size, ws_size); grid = -1; return; }
        int dev = 0, cus = 0, per_cu = 0;
        if (hipGetDevice(&dev) != hipSuccess || hipDeviceGetAttribute(&cus, hipDeviceAttributeMultiprocessorCount, dev) != hipSuccess) { grid = -1; return; }
        if (hipFuncSetAttribute((const void*)fwd_kernel, hipFuncAttributeMaxDynamicSharedMemorySize, LDS_BYTES) != hipSuccess) { fprintf(stderr, "kernel_launch: hipFuncSetAttribute failed\n"); grid = -1; return; }
        if (hipOccupancyMaxActiveBlocksPerMultiprocessor(&per_cu, (const void*)fwd_kernel, NTHR, LDS_BYTES) != hipSuccess || per_cu < 1)
            fprintf(stderr, "kernel_launch: note: occupancy query reports %d workgroups per CU\n", per_cu);
        (void)hipGetLastError();
        grid = cus;
    }
    if (grid < 0) return;
    if (hipMemsetAsync((char*)d_ws + WS_CTL, 0, CTL_ZERO_BYTES, stream) != hipSuccess) { fprintf(stderr, "kernel_launch: memset failed\n"); return; }
    Args a{};
    const float** pp = (const float**)&a.p;
    for (int i = 0; i < 18; ++i) pp[i] = (const float*)d_in[i];
    a.p.out = (float*)d_out; a.p.ws = (unsigned char*)d_ws;
#if MK_PER_PHASE
    for (int ph = 0; ph < N_PHASES; ++ph) {
        a.ph_lo = ph; a.ph_hi = ph + 1;
        hipLaunchKernelGGL(fwd_kernel, dim3(grid), dim3(NTHR), LDS_BYTES, stream, a);
    }
#else
    a.ph_lo = 0; a.ph_hi = N_PHASES;
    hipLaunchKernelGGL(fwd_kernel, dim3(grid), dim3(NTHR), LDS_BYTES, stream, a);
#endif
    const hipError_t le = hipPeekAtLastError();
    if (le != hipSuccess) fprintf(stderr, "kernel_launch: launch failed: %s\n", hipGetErrorName(le));
}
```

```cpp
#include <hip/hip_runtime.h>
#include <cstdio>
#include <cstdint>
namespace pg8 {
#define PG8_LAS __attribute__((address_space(3)))
typedef unsigned short bf16_t;
typedef short bf16x8 __attribute__((ext_vector_type(8)));
typedef float f32x4 __attribute__((ext_vector_type(4)));
typedef unsigned u32x4 __attribute__((ext_vector_type(4)));
constexpr int BM = 256, BK = 64, HALF = 128, HTB = HALF * BK * 2  , STAGE_BYTES = 8 * HTB, NXCD = 8, WGM = 8;

__host__ __device__ __forceinline__ int lds_byte(int r, int c) { const int st = (r >> 4) * 2 + (c >> 5), rr = r & 15, cc = c & 31, ob = rr * 64 + cc * 2; return st * 1024 + (ob ^ (((ob >> 9) & 1) << 5)); }
__host__ __device__ __forceinline__ void stage_rc(int b, int& R, int& C) { const int st = b / 1024, sb = b % 1024, swz = sb ^ (((sb >> 9) & 1) << 5); R = (st >> 1) * 16 + swz / 64; C = (st & 1) * 32 + (swz % 64) / 2; }
__host__ __device__ __forceinline__ int perm32(int rho) { const int n = rho >> 4, i = rho & 15; return 8 * (i >> 2) + 4 * n + (i & 3); }

struct Unit { int pm, pn; };
struct Gemm { const bf16_t* A; const bf16_t* Bt; int M, N, K; };

struct StaticOrder {
    int nM, nN, nwg, G, c;
    __host__ __device__ void init(int M, int N, int G_, int c_) { nM = M / BM; nN = N / BM; nwg = nM * nN; G = G_; c = c_; }
    __host__ __device__ bool next(int i, Unit& u) const {
        const long L = (long)i * G + c; if (L >= nwg) return false;
        int wgid = (int)L; { const int q = nwg / NXCD, r = nwg % NXCD, xcd = wgid % NXCD, off = wgid / NXCD; wgid = (xcd < r ? xcd * (q + 1) : r * (q + 1) + (xcd - r) * q) + off; }
        const int nig = WGM * nN, gid = wgid / nig, fm = gid * WGM, gsz = (nM - fm) < WGM ? (nM - fm) : WGM;
        u.pm = fm + ((wgid % nig) % gsz); u.pn = (wgid % nig) / gsz; return true;
    }
    __device__ __forceinline__ void a_ready(const Unit&) const {}
    __device__ __forceinline__ void done(const Unit&) const {}
};

__device__ __forceinline__ unsigned cvt_pk_bf16(float lo, float hi) { unsigned r; asm volatile("v_cvt_pk_bf16_f32 %0, %1, %2" : "=v"(r) : "v"(lo), "v"(hi)); return r; }
template <class Epi, class Sched, bool ALIGN_EPI = false, bool SP2 = false, bool MID = false  >
__device__ __forceinline__ void gemm_phase(PG8_LAS unsigned char* lds, const Gemm g, const Sched& S, const Epi& E) {
    const int tid = threadIdx.x, wid = __builtin_amdgcn_readfirstlane(tid >> 6), lane = tid & 63, wr = wid >> 2, wc = wid & 3, fr = lane & 15, fq = lane >> 4;
    const int K = g.K, nt = K / BK;
    unsigned voffA[2], voffB[2];
#pragma unroll
    for (int i = 0; i < 2; ++i) { int R, C; stage_rc(tid * 16 + i * 8192, R, C); const int Rb = Epi::PERM ? ((R & ~31) + perm32(R & 31)) : R;
        voffA[i] = (unsigned)(R * K + C) * 2u; voffB[i] = (unsigned)(Rb * K + C) * 2u; }
    const size_t kstep = (size_t)(BK * 2);
    const size_t hstep = (size_t)HALF * K * 2;
    const size_t tstep = 2 * hstep;
    const unsigned ldsw = (unsigned)wid * 1024u;
    const int aoff = lds_byte(wr * 64 + fr, fq * 8), boff = lds_byte(wc * 32 + fr, fq * 8);
#define PG8_SA(b, h) (((b) * 2 + (h)) * HTB)
#define PG8_SB(b, h) ((4 + (b) * 2 + (h)) * HTB)
#define PG8_STAGE(bufoff, gbase, voff) do { _Pragma("unroll") for (int _i = 0; _i < 2; ++_i) \
        __builtin_amdgcn_global_load_lds((const unsigned*)((const char*)(gbase) + (voff)[_i]), (PG8_LAS unsigned*)(lds + (bufoff) + ldsw + _i * 8192), 16, 0, 0); } while (0)
#define PG8_LDA(dst, b, h) do { _Pragma("unroll") for (int m = 0; m < 4; ++m) _Pragma("unroll") for (int k = 0; k < 2; ++k) dst[m][k] = *(const PG8_LAS bf16x8*)(lds + PG8_SA(b, h) + aoff + m * 2048 + k * 1024); } while (0)
#define PG8_LDB(dst, b, h) do { _Pragma("unroll") for (int n = 0; n < 2; ++n) _Pragma("unroll") for (int k = 0; k < 2; ++k) dst[n][k] = *(const PG8_LAS bf16x8*)(lds + PG8_SB(b, h) + boff + n * 2048 + k * 1024); } while (0)
#define PG8_MMA(ai, bj, At, Bt) do { __builtin_amdgcn_s_setprio(1); _Pragma("unroll") for (int m = 0; m < 4; ++m) _Pragma("unroll") for (int n = 0; n < 2; ++n) _Pragma("unroll") for (int k = 0; k < 2; ++k) \
        acc[ai][bj][m][n] = __builtin_amdgcn_mfma_f32_16x16x32_bf16(Bt[n][k], At[m][k], acc[ai][bj][m][n], 0, 0, 0); __builtin_amdgcn_s_setprio(0); } while (0)
#define PG8_WAIT_V(n) asm volatile("s_waitcnt vmcnt(" #n ")" ::: "memory")
#define PG8_WAIT_L(n) asm volatile("s_waitcnt lgkmcnt(" #n ")" ::: "memory")
#define PG8_BAR __builtin_amdgcn_s_barrier()
#define PG8_SCHED __builtin_amdgcn_sched_barrier(0)
    Unit cur, nxt; int ui = 0;
    if (!S.next(0, cur)) return;
    f32x4 acc[2][2][4][2];
#pragma unroll
    for (int a = 0; a < 2; ++a)
#pragma unroll
        for (int b = 0; b < 2; ++b)
#pragma unroll
            for (int m = 0; m < 4; ++m)
#pragma unroll
                for (int n = 0; n < 2; ++n) acc[a][b][m][n] = (f32x4){0.f, 0.f, 0.f, 0.f};
    bf16x8 At[4][2], B0[2][2], B1[2][2];
    const char* cA = (const char*)g.A + (size_t)cur.pm * tstep; const char* cB = (const char*)g.Bt + (size_t)cur.pn * tstep;
    S.a_ready(cur);
    if constexpr (SP2) {
        PG8_STAGE(PG8_SB(0, 0), cB, voffB); PG8_STAGE(PG8_SB(0, 1), cB + hstep, voffB); PG8_STAGE(PG8_SA(0, 0), cA, voffA); PG8_STAGE(PG8_SA(0, 1), cA + hstep, voffA);
        if (wr == 1) PG8_BAR;
        PG8_WAIT_V(2); PG8_BAR;
        PG8_STAGE(PG8_SB(1, 0), cB + kstep, voffB); PG8_STAGE(PG8_SA(1, 0), cA + kstep, voffA); PG8_STAGE(PG8_SB(1, 1), cB + hstep + kstep, voffB);
        PG8_WAIT_V(6); PG8_BAR;
    } else {
        PG8_STAGE(PG8_SB(0, 0), cB, voffB); PG8_STAGE(PG8_SA(0, 0), cA, voffA); PG8_STAGE(PG8_SB(0, 1), cB + hstep, voffB); PG8_STAGE(PG8_SA(0, 1), cA + hstep, voffA);
        if (wr == 1) PG8_BAR;
        PG8_WAIT_V(4); PG8_BAR;
        PG8_STAGE(PG8_SB(1, 0), cB + kstep, voffB); PG8_STAGE(PG8_SA(1, 0), cA + kstep, voffA); PG8_STAGE(PG8_SB(1, 1), cB + hstep + kstep, voffB);
        PG8_WAIT_V(6); PG8_BAR;
    }
    for (;;) {
        const bool has_next = S.next(ui + 1, nxt);
        const char* nA = has_next ? (const char*)g.A + (size_t)nxt.pm * tstep : cA; const char* nB = has_next ? (const char*)g.Bt + (size_t)nxt.pn * tstep : cB;
        for (int t = 0; t < nt; t += 2) {
            if constexpr (MID) { if (t == (nt >> 1)) E.mid(acc, cur, wr, wc, fr, fq); }
            const bool last = (t == nt - 2);
            const char* a1 = cA + (size_t)(t + 1) * kstep;
            const char* a2 = last ? nA : cA + (size_t)(t + 2) * kstep; const char* b2 = last ? nB : cB + (size_t)(t + 2) * kstep;
            const char* a3 = a2 + kstep; const char* b3 = b2 + kstep;
            if (last && has_next) S.a_ready(nxt);
            if constexpr (SP2) {
            PG8_LDB(B0, 0, 0); PG8_LDB(B1, 0, 1); PG8_SCHED; PG8_LDA(At, 0, 0); PG8_STAGE(PG8_SA(1, 1), a1 + hstep, voffA);
            PG8_WAIT_V(8); PG8_WAIT_L(0); PG8_BAR; PG8_MMA(0, 0, At, B0); PG8_MMA(0, 1, At, B1); PG8_BAR; PG8_SCHED;
            PG8_LDA(At, 0, 1); PG8_STAGE(PG8_SB(0, 0), b2, voffB); PG8_STAGE(PG8_SB(0, 1), b2 + hstep, voffB); PG8_STAGE(PG8_SA(0, 0), a2, voffA);
            PG8_WAIT_V(8); PG8_WAIT_L(0); PG8_BAR; PG8_MMA(1, 0, At, B0); PG8_MMA(1, 1, At, B1); PG8_BAR; PG8_SCHED;
            PG8_LDB(B0, 1, 0); PG8_LDB(B1, 1, 1); PG8_SCHED; PG8_LDA(At, 1, 0); PG8_STAGE(PG8_SA(0, 1), a2 + hstep, voffA);
            PG8_WAIT_V(8); PG8_WAIT_L(0); PG8_BAR; PG8_MMA(0, 0, At, B0); PG8_MMA(0, 1, At, B1); PG8_BAR; PG8_SCHED;
            PG8_LDA(At, 1, 1); PG8_STAGE(PG8_SB(1, 0), b3, voffB); PG8_STAGE(PG8_SB(1, 1), b3 + hstep, voffB); PG8_STAGE(PG8_SA(1, 0), a3, voffA);
            PG8_WAIT_V(8); PG8_WAIT_L(0); PG8_BAR; PG8_MMA(1, 0, At, B0); PG8_MMA(1, 1, At, B1); PG8_BAR; PG8_SCHED;
            } else {
            PG8_LDB(B0, 0, 0); PG8_SCHED; PG8_LDA(At, 0, 0); PG8_STAGE(PG8_SA(1, 1), a1 + hstep, voffA);
            PG8_WAIT_L(8); PG8_BAR; PG8_WAIT_L(0); PG8_MMA(0, 0, At, B0); PG8_BAR; PG8_SCHED;
            PG8_LDB(B1, 0, 1); PG8_STAGE(PG8_SB(0, 0), b2, voffB);
            PG8_BAR; PG8_WAIT_L(0); PG8_MMA(0, 1, At, B1); PG8_BAR;
            PG8_LDA(At, 0, 1); PG8_STAGE(PG8_SA(0, 0), a2, voffA);
            PG8_BAR; PG8_WAIT_L(0); PG8_MMA(1, 0, At, B0); PG8_BAR; PG8_SCHED;
            PG8_STAGE(PG8_SB(0, 1), b2 + hstep, voffB);
            PG8_WAIT_V(6); PG8_BAR; PG8_MMA(1, 1, At, B1); PG8_BAR;
            PG8_LDB(B0, 1, 0); PG8_SCHED; PG8_LDA(At, 1, 0); PG8_STAGE(PG8_SA(0, 1), a2 + hstep, voffA);
            PG8_WAIT_L(8); PG8_BAR; PG8_WAIT_L(0); PG8_MMA(0, 0, At, B0); PG8_BAR; PG8_SCHED;
            PG8_LDB(B1, 1, 1); PG8_STAGE(PG8_SB(1, 0), b3, voffB);
            PG8_BAR; PG8_WAIT_L(0); PG8_MMA(0, 1, At, B1); PG8_BAR;
            PG8_LDA(At, 1, 1); PG8_STAGE(PG8_SA(1, 0), a3, voffA);
            PG8_BAR; PG8_WAIT_L(0); PG8_MMA(1, 0, At, B0); PG8_BAR; PG8_SCHED;
            PG8_STAGE(PG8_SB(1, 1), b3 + hstep, voffB);
            PG8_WAIT_V(6); PG8_BAR; PG8_MMA(1, 1, At, B1); PG8_BAR;
            }
        }
        if constexpr (ALIGN_EPI) { if (wr == 0) PG8_BAR; }
        if constexpr (!Epi::AFTER_DRAIN) { E(acc, cur, wr, wc, fr, fq); S.done(cur); }
        if (!has_next) break;
#pragma unroll
        for (int a = 0; a < 2; ++a)
#pragma unroll
            for (int b = 0; b < 2; ++b)
#pragma unroll
                for (int m = 0; m < 4; ++m)
#pragma unroll
                    for (int n = 0; n < 2; ++n) acc[a][b][m][n] = (f32x4){0.f, 0.f, 0.f, 0.f};
        cur = nxt; cA = nA; cB = nB; ++ui;
        if constexpr (ALIGN_EPI) { if (wr == 1) PG8_BAR; }
    }
    PG8_WAIT_V(0);
    if constexpr (!ALIGN_EPI) { if (wr == 0) PG8_BAR; }
    PG8_BAR;
    if constexpr (Epi::AFTER_DRAIN) { E.fused(acc, cur, wr, wc, fr, fq, lds, wid, lane); S.done(cur); }
#undef PG8_SA
#undef PG8_SB
#undef PG8_STAGE
#undef PG8_LDA
#undef PG8_LDB
#undef PG8_MMA
#undef PG8_WAIT_V
#undef PG8_WAIT_L
#undef PG8_BAR
#undef PG8_SCHED
}
}

#ifndef MK_PER_PHASE
#define MK_PER_PHASE 0
#endif
#ifndef USE_PG8
#define USE_PG8 1
#endif
constexpr int NWAVES = 8, NTHR = 512;

constexpr int B_ = 16, S_ = 2048, D_ = 1024, T_ = B_ * S_;
constexpr int INC = 5640, NPROJ = 5632;
constexpr int NEXP = 16384;
constexpr float EPS = 1e-6f;

constexpr size_t MiB = 1u << 20;
constexpr size_t WS_CTL = 0, CTL_ZERO_BYTES = 1 * MiB;
constexpr size_t WS_W1T = 2 * MiB, WS_WSBT = 13 * MiB, WS_WMLT = 14 * MiB, WS_WOUTT = 15 * MiB, WS_WCT = 17 * MiB, WS_IFG = 21 * MiB;
constexpr size_t WS_U8 = 24 * MiB, WS_V8 = 40 * MiB, WS_USC = 22 * MiB, WS_VSC = 23 * MiB;
constexpr size_t WS_XN = 88 * MiB, WS_QC = 88 * MiB, WS_KC = 120 * MiB;
constexpr size_t WS_SBQKV = 152 * MiB  , WS_VT = 216 * MiB  , WS_MLQK = 248 * MiB, WS_MLV = 312 * MiB, WS_MLO = 344 * MiB, WS_GATES = 376 * MiB;
constexpr size_t WS_MERGED = 216 * MiB, WS_H = 88 * MiB, WS_HN = 216 * MiB, WS_IDX = 280 * MiB, WS_GATE = 296 * MiB, WS_SC = 312 * MiB;
constexpr size_t WS_PART = 312 * MiB  , WS_SSQ = 504 * MiB  , WS_COEF = 56 * MiB  , WS_YB = 152 * MiB  , WS_HN8 = 440 * MiB  , WS_XS = 505 * MiB  , WS_SS = 506 * MiB  ;
constexpr size_t WS_END = 508 * MiB;
constexpr int CW_BAR = 4096, CW_Q = 8192;

constexpr int RING_OFF = 0, RING_BYTES = 135168;
constexpr int LDSCTL_OFF = RING_BYTES, MISC_OFF = LDSCTL_OFF + 320;
constexpr int LDS_BYTES = 147456;

#define GAS __attribute__((address_space(1)))
#define LAS __attribute__((address_space(3)))
typedef unsigned short bf16;
typedef unsigned v4u __attribute__((ext_vector_type(4)));
typedef unsigned v2u __attribute__((ext_vector_type(2)));
typedef float f32x4 __attribute__((ext_vector_type(4)));
#define LDS_WAIT() asm volatile("s_waitcnt lgkmcnt(0)" ::: "memory")
#define VM_WAIT() asm volatile("s_waitcnt vmcnt(0)" ::: "memory")
typedef float f32x2_t __attribute__((ext_vector_type(2))); typedef __bf16 bf16x2_t __attribute__((ext_vector_type(2)));
__device__ __forceinline__ unsigned cvtpk(float lo, float hi) { f32x2_t v = {lo, hi}; bf16x2_t b = __builtin_convertvector(v, bf16x2_t); return __builtin_bit_cast(unsigned, b); }
__device__ __forceinline__ unsigned f2bf(float f) { return cvtpk(f, f) & 0xffffu; }
__device__ __forceinline__ unsigned pk2(float lo, float hi) { return cvtpk(lo, hi); }
__device__ __forceinline__ float bflo(unsigned u) { return __builtin_bit_cast(float, u << 16); }
__device__ __forceinline__ float bfhi(unsigned u) { return __builtin_bit_cast(float, u & 0xffff0000u); }
__device__ __forceinline__ float bf2f(bf16 b) { return __builtin_bit_cast(float, (unsigned)b << 16); }
__device__ __forceinline__ float fexp(float x) { return __builtin_amdgcn_exp2f(x * 1.4426950408889634f); }
__device__ __forceinline__ float flog(float x) { return __builtin_amdgcn_logf(x) * 0.6931471805599453f; }
__device__ __forceinline__ float frcp(float x) { return __builtin_amdgcn_rcpf(x); }
__device__ __forceinline__ float frsq(float x) { return __builtin_amdgcn_rsqf(x); }
__device__ __forceinline__ float sigmoidf_(float x) { return frcp(1.f + fexp(-x)); }
__device__ __forceinline__ float wave_sum(float v) {
#pragma unroll
    for (int o = 1; o < 64; o <<= 1) v += __shfl_xor(v, o);
    return v;
}
__device__ __forceinline__ unsigned wave_max_u(unsigned v) {
#pragma unroll
    for (int o = 1; o < 64; o <<= 1) { const unsigned w = (unsigned)__shfl_xor((int)v, o); v = v > w ? v : w; }
    return v;
}
struct F8 { float v[8]; };
__device__ __forceinline__ void unpack8(const v4u& u, float (&f)[8]) {
    f[0] = bflo(u.x); f[1] = bfhi(u.x); f[2] = bflo(u.y); f[3] = bfhi(u.y); f[4] = bflo(u.z); f[5] = bfhi(u.z); f[6] = bflo(u.w); f[7] = bfhi(u.w);
}
__device__ __forceinline__ v4u pack8(const float (&f)[8]) { v4u o; o.x = pk2(f[0], f[1]); o.y = pk2(f[2], f[3]); o.z = pk2(f[4], f[5]); o.w = pk2(f[6], f[7]); return o; }

#define XB_TMO      128
#define XB_XCNT(j)  (256  + 64 * (j))
#define XB_XSUB(j)  (1280 + 64 * (j))
#define XB_XGEN(j)  (2304 + 64 * (j))
#define XB_TOP      3328
#define XB_TOPGEN   3392
#define XCD_BAR_WORDS 3456
#define XB_SPIN_CAP (1u << 24)

__device__ __forceinline__ unsigned xb_ld(unsigned* p)              { return __hip_atomic_load(p, __ATOMIC_RELAXED, __HIP_MEMORY_SCOPE_AGENT); }
__device__ __forceinline__ unsigned xb_add(unsigned* p, unsigned v) { return __hip_atomic_fetch_add(p, v, __ATOMIC_RELAXED, __HIP_MEMORY_SCOPE_AGENT); }
__device__ __forceinline__ unsigned xb_xcc_id() { return (unsigned)__builtin_amdgcn_s_getreg((3 << 11) | 20) & 0xFu; }
#define XB_SPIN(cond, bar) do { unsigned _sp = 0; while (cond) { __builtin_amdgcn_s_sleep(1); \
    if ((++_sp & 255u) == 0u) { if (xb_ld(&(bar)[XB_TMO])) break; if (_sp > XB_SPIN_CAP) { atomicAdd(&(bar)[XB_TMO], 1u); break; } } } } while (0)

struct XcdBarrier {
    unsigned* bar; unsigned x;
    volatile LAS unsigned* st;
};

__device__ __forceinline__ XcdBarrier xcd_barrier_post(unsigned* bar, volatile LAS unsigned* st) {
    XcdBarrier b; b.bar = bar; b.x = xb_xcc_id(); b.st = st;
    if (threadIdx.x == 0) (void)xb_add(&bar[XB_XCNT(b.x)], 1u);
    return b;
}
__device__ __forceinline__ void xcd_barrier_complete(unsigned* bar, unsigned x, unsigned& nloc, unsigned& nx) {
    const unsigned G = gridDim.x * gridDim.y * gridDim.z;
    unsigned sum, cnt, mine, sp = 0u;
    for (;;) {
        sum = 0u; cnt = 0u; mine = 0u;
#pragma unroll
        for (unsigned j = 0; j < 16; ++j) { const unsigned c = xb_ld(&bar[XB_XCNT(j)]); sum += c; cnt += (c > 0u) ? 1u : 0u; mine = (j == x) ? c : mine; }
        if (sum == G) break;
        __builtin_amdgcn_s_sleep(1);
        if ((++sp & 255u) == 0u) { if (xb_ld(&bar[XB_TMO])) break; if (sp > XB_SPIN_CAP) { atomicAdd(&bar[XB_TMO], 1u); break; } }
    }
    nloc = mine > 0u ? mine : 1u; nx = cnt > 0u ? cnt : 1u;
}

__device__ __forceinline__ void xcd_barrier(const XcdBarrier& b) {
    asm volatile("s_waitcnt vmcnt(0)" ::: "memory");
    __syncthreads();
    if (threadIdx.x == 0) {
        unsigned* bar = b.bar;
        __builtin_amdgcn_s_waitcnt(0);
        unsigned nloc = b.st[0], nx = b.st[1];
        if (nloc == 0u) { xcd_barrier_complete(bar, b.x, nloc, nx); b.st[0] = nloc; b.st[1] = nx; }
        const unsigned old = xb_add(&bar[XB_XSUB(b.x)], 1u);
        const unsigned gen = old / nloc;
        if (old + 1u == (gen + 1u) * nloc) {
            __builtin_amdgcn_fence(__ATOMIC_RELEASE, "agent");
            asm volatile("s_waitcnt vmcnt(0)" ::: "memory");
            const unsigned og = xb_add(&bar[XB_TOP], 1u);
            const unsigned tg = og / nx;
            if (og + 1u == (tg + 1u) * nx) xb_add(&bar[XB_TOPGEN], 1u);
            else XB_SPIN(xb_ld(&bar[XB_TOPGEN]) == tg, bar);
            __builtin_amdgcn_fence(__ATOMIC_ACQUIRE, "agent");
            xb_add(&bar[XB_XGEN(b.x)], 1u);
            asm volatile("s_waitcnt vmcnt(0)" ::: "memory");
        } else {
            XB_SPIN(xb_ld(&bar[XB_XGEN(b.x)]) == gen, bar);
            __builtin_amdgcn_fence(__ATOMIC_ACQUIRE, "agent");
            asm volatile("s_waitcnt vmcnt(0)" ::: "memory");
        }
    }
    __syncthreads();
}

struct EpiProj {
    bf16 *sbqk, *vt, *mlqk, *mlv, *mlo, *gates;
    __device__ __forceinline__ void operator()(int row, int col, const F8& a) const {
        bf16* dst;
        if (col < 1024) dst = sbqk + (size_t)row * 1024 + col;
        else if (col < 1536) {
            const int c = col - 1024, hh = c >> 6, d = c & 63, b = row >> 11, sq = row & 2047;
            bf16* vp = vt + ((size_t)(b * 8 + hh) * 64 + d) * 2048 + sq;
#pragma unroll
            for (int i = 0; i < 8; ++i) vp[(size_t)i * 2048] = (bf16)f2bf(a.v[i]);
            return;
        }
        else if (col < 2560) dst = mlqk + (size_t)row * 1024 + (col - 1536);
        else if (col < 3072) dst = mlv + (size_t)row * 512 + (col - 2560);
        else if (col < 3584) dst = mlo + (size_t)row * 512 + (col - 3072);
        else {
            unsigned q[8];
#pragma unroll
            for (int i = 0; i < 8; ++i) { const float sg = sigmoidf_(a.v[i]) * 255.f + 0.5f; q[i] = (unsigned)fminf(fmaxf(sg, 1.f), 255.f); }
            *(v2u*)((unsigned char*)gates + (size_t)row * 2048 + (col - 3584)) = (v2u){q[0] | (q[1] << 8) | (q[2] << 16) | (q[3] << 24), q[4] | (q[5] << 8) | (q[6] << 16) | (q[7] << 24)};
            return;
        }
        *(v4u*)dst = pack8(a.v);
    }
};
struct EpiMergeA {
    bf16* merged; const bf16* gates;
    __device__ __forceinline__ void operator()(int row, int col, const F8& a) const {
        float g[8], o[8]; unpack8(*(const v4u*)(gates + (size_t)row * 2048 + col), g);
#pragma unroll
        for (int i = 0; i < 8; ++i) o[i] = sigmoidf_(g[i]) * a.v[i];
        *(v4u*)(merged + (size_t)row * 1024 + col) = pack8(o);
    }
};
struct EpiMergeB {
    bf16* merged; const bf16* gates;
    __device__ __forceinline__ void operator()(int row, int col, const F8& a) const {
        float g[8], o[8]; unpack8(*(const v4u*)(gates + (size_t)row * 2048 + 1024 + col), g);
        unpack8(*(const v4u*)(merged + (size_t)row * 1024 + col), o);
#pragma unroll
        for (int i = 0; i < 8; ++i) o[i] += sigmoidf_(g[i]) * a.v[i];
        *(v4u*)(merged + (size_t)row * 1024 + col) = pack8(o);
    }
};
struct EpiH {
    float* h; const float* x;
    __device__ __forceinline__ void operator()(int row, int col, const F8& a) const {
        const f32x4 x0 = *(const f32x4*)(x + (size_t)row * 1024 + col), x1 = *(const f32x4*)(x + (size_t)row * 1024 + col + 4);
        *(f32x4*)(h + (size_t)row * 1024 + col) = (f32x4){x0.x + a.v[0], x0.y + a.v[1], x0.z + a.v[2], x0.w + a.v[3]};
        *(f32x4*)(h + (size_t)row * 1024 + col + 4) = (f32x4){x1.x + a.v[4], x1.y + a.v[5], x1.z + a.v[6], x1.w + a.v[7]};
    }
};
struct EpiF32 {
    float* o; int ldc;
    __device__ __forceinline__ void operator()(int row, int col, const F8& a) const {
        *(f32x4*)(o + (size_t)row * ldc + col) = (f32x4){a.v[0], a.v[1], a.v[2], a.v[3]};
        *(f32x4*)(o + (size_t)row * ldc + col + 4) = (f32x4){a.v[4], a.v[5], a.v[6], a.v[7]};
    }
};

template <class E> struct EpiAdapt {
    static constexpr bool PERM = true, AFTER_DRAIN = false;
    E e;
    __device__ __forceinline__ void operator()(const pg8::f32x4 (&acc)[2][2][4][2], const pg8::Unit& u, int wr, int wc, int fr, int fq) const {
#pragma unroll
        for (int ai = 0; ai < 2; ++ai)
#pragma unroll
            for (int m = 0; m < 4; ++m) {
                const int row = u.pm * 256 + ai * 128 + wr * 64 + m * 16 + fr;
#pragma unroll
                for (int bj = 0; bj < 2; ++bj) {
                    const int col = u.pn * 256 + bj * 128 + wc * 32 + 8 * fq;
                    F8 a; const pg8::f32x4 v0 = acc[ai][bj][m][0], v1 = acc[ai][bj][m][1];
                    a.v[0] = v0[0]; a.v[1] = v0[1]; a.v[2] = v0[2]; a.v[3] = v0[3]; a.v[4] = v1[0]; a.v[5] = v1[1]; a.v[6] = v1[2]; a.v[7] = v1[3];
                    e(row, col, a);
                }
            }
    }
};

struct EpiMerge1 {
    static constexpr bool PERM = true, AFTER_DRAIN = false;
    bf16* merged; const unsigned char* gates;
    static __device__ __forceinline__ void ub8(const v2u& w, float (&f)[8]) {
        f[0] = (float)(w.x & 0xffu); f[1] = (float)((w.x >> 8) & 0xffu); f[2] = (float)((w.x >> 16) & 0xffu); f[3] = (float)(w.x >> 24);
        f[4] = (float)(w.y & 0xffu); f[5] = (float)((w.y >> 8) & 0xffu); f[6] = (float)((w.y >> 16) & 0xffu); f[7] = (float)(w.y >> 24);
    }
    __device__ __forceinline__ void mid(pg8::f32x4 (&acc)[2][2][4][2], const pg8::Unit& u, int wr, int wc, int fr, int fq) const {
#pragma unroll
        for (int ai = 0; ai < 2; ++ai)
#pragma unroll
            for (int m = 0; m < 4; ++m) {
                const int row = u.pm * 256 + ai * 128 + wr * 64 + m * 16 + fr;
#pragma unroll
                for (int bj = 0; bj < 2; ++bj) {
                    const int col = u.pn * 256 + bj * 128 + wc * 32 + 8 * fq;
                    float gs[8], gm[8]; ub8(*(const v2u*)(gates + (size_t)row * 2048 + col), gs); ub8(*(const v2u*)(gates + (size_t)row * 2048 + 1024 + col), gm);
#pragma unroll
                    for (int i = 0; i < 8; ++i) acc[ai][bj][m][i >> 2][i & 3] *= gs[i] * frcp(gm[i]);
                }
            }
    }
    __device__ __forceinline__ void operator()(const pg8::f32x4 (&acc)[2][2][4][2], const pg8::Unit& u, int wr, int wc, int fr, int fq) const {
#pragma unroll
        for (int ai = 0; ai < 2; ++ai)
#pragma unroll
            for (int m = 0; m < 4; ++m) {
                const int row = u.pm * 256 + ai * 128 + wr * 64 + m * 16 + fr;
#pragma unroll
                for (int bj = 0; bj < 2; ++bj) {
                    const int col = u.pn * 256 + bj * 128 + wc * 32 + 8 * fq;
                    float gm[8], o[8]; ub8(*(const v2u*)(gates + (size_t)row * 2048 + 1024 + col), gm);
#pragma unroll
                    for (int i = 0; i < 8; ++i) o[i] = gm[i] * (1.f / 255.f) * acc[ai][bj][m][i >> 2][i & 3];
                    *(v4u*)(merged + (size_t)row * 1024 + col) = pack8(o);
                }
            }
    }
};
struct EpiHW {
    static constexpr bool PERM = true, AFTER_DRAIN = false;
    bf16* h; const float* x; bf16* hw; const float* wffn; float* ss;
    __device__ __forceinline__ void operator()(const pg8::f32x4 (&acc)[2][2][4][2], const pg8::Unit& u, int wr, int wc, int fr, int fq) const {
#pragma unroll
        for (int ai = 0; ai < 2; ++ai)
#pragma unroll
            for (int m = 0; m < 4; ++m) {
                const int row = u.pm * 256 + ai * 128 + wr * 64 + m * 16 + fr;
                float sq = 0.f;
#pragma unroll
                for (int bj = 0; bj < 2; ++bj) {
                    const int col = u.pn * 256 + bj * 128 + wc * 32 + 8 * fq;
                    const size_t o = (size_t)row * 1024 + col;
                    const f32x4 x0 = *(const f32x4*)(x + o), x1 = *(const f32x4*)(x + o + 4);
                    const f32x4 w0 = *(const f32x4*)(wffn + col), w1 = *(const f32x4*)(wffn + col + 4);
                    const pg8::f32x4 v0 = acc[ai][bj][m][0], v1 = acc[ai][bj][m][1];
                    const f32x4 h0 = (f32x4){x0.x + v0[0], x0.y + v0[1], x0.z + v0[2], x0.w + v0[3]}, h1 = (f32x4){x1.x + v1[0], x1.y + v1[1], x1.z + v1[2], x1.w + v1[3]};
                    *(v4u*)(h + o) = (v4u){pk2(h0.x, h0.y), pk2(h0.z, h0.w), pk2(h1.x, h1.y), pk2(h1.z, h1.w)};
                    *(v4u*)(hw + o) = (v4u){pk2(h0.x * w0.x, h0.y * w0.y), pk2(h0.z * w0.z, h0.w * w0.w), pk2(h1.x * w1.x, h1.y * w1.y), pk2(h1.z * w1.z, h1.w * w1.w)};
                    sq += (h0.x * h0.x + h0.y * h0.y) + (h0.z * h0.z + h0.w * h0.w) + (h1.x * h1.x + h1.y * h1.y) + (h1.z * h1.z + h1.w * h1.w);
                }
                sq += __shfl_xor(sq, 16); sq += __shfl_xor(sq, 32);
                if (fq == 0) ss[(size_t)row * 16 + u.pn * 4 + wc] = sq;
            }
    }
};

template <class E>
__device__ __forceinline__ void simple_gemm(LAS unsigned char* lds, const bf16* A, const bf16* Bt, int M, int N, int K, const E& e) {
    LAS float* As = (LAS float*)lds;
    LAS float* Bs = As + 32 * 132;
    const int tid = threadIdx.x, ty = tid >> 4, tx = tid & 15;
    const int ntn = N / 128, ntiles = (M / 128) * ntn;
    for (int tile = blockIdx.x; tile < ntiles; tile += gridDim.x) {
        const int tm = tile / ntn, tn = tile % ntn;
        float acc[4][8];
#pragma unroll
        for (int i = 0; i < 4; ++i)
#pragma unroll
            for (int j = 0; j < 8; ++j) acc[i][j] = 0.f;
        for (int k0 = 0; k0 < K; k0 += 32) {
            {
                const int r = tid >> 2, kq = (tid & 3) * 8;
                float fa[8], fb[8];
                unpack8(*(const v4u*)(A + (size_t)(tm * 128 + r) * K + k0 + kq), fa);
                unpack8(*(const v4u*)(Bt + (size_t)(tn * 128 + r) * K + k0 + kq), fb);
#pragma unroll
                for (int i = 0; i < 8; ++i) { As[(kq + i) * 132 + r] = fa[i]; Bs[(kq + i) * 132 + r] = fb[i]; }
            }
            __syncthreads();
#pragma unroll 8
            for (int k = 0; k < 32; ++k) {
                const f32x4 a4 = *(const LAS f32x4*)(As + k * 132 + ty * 4);
                const f32x4 b0 = *(const LAS f32x4*)(Bs + k * 132 + tx * 8), b1 = *(const LAS f32x4*)(Bs + k * 132 + tx * 8 + 4);
                const float av[4] = {a4.x, a4.y, a4.z, a4.w};
                const float bv[8] = {b0.x, b0.y, b0.z, b0.w, b1.x, b1.y, b1.z, b1.w};
#pragma unroll
                for (int i = 0; i < 4; ++i)
#pragma unroll
                    for (int j = 0; j < 8; ++j) acc[i][j] += av[i] * bv[j];
            }
            __syncthreads();
        }
#pragma unroll
        for (int i = 0; i < 4; ++i) {
            F8 a;
#pragma unroll
            for (int j = 0; j < 8; ++j) a.v[j] = acc[i][j];
            e(tm * 128 + ty * 4 + i, tn * 128 + tx * 8, a);
        }
    }
}

template <class E>
__device__ __forceinline__ void gemm(LAS unsigned char* lds, const bf16* A, const bf16* Bt, int M, int N, int K, const E& e) {
#if USE_PG8
    pg8::Gemm g{A, Bt, M, N, K}; pg8::StaticOrder S; S.init(M, N, (int)gridDim.x, (int)blockIdx.x);
    EpiAdapt<E> ea{e};
    pg8::gemm_phase<EpiAdapt<E>, pg8::StaticOrder, true, true>(lds, g, S, ea);
#else
    simple_gemm<E>(lds, A, Bt, M, N, K, e);
#endif
}

__device__ __forceinline__ void transpose_item(const float* W, int ldw, int K, bf16* WT, int src_col0, int dst_row0, LAS float* scr, int kb, int lane) {
    const int k0 = 64 * kb;
#pragma unroll 8
    for (int i = 0; i < 32; ++i) { const int kk = 2 * i + (lane >> 5); scr[kk * 33 + (lane & 31)] = W[(size_t)(k0 + kk) * ldw + src_col0 + (lane & 31)]; }
    LDS_WAIT(); asm volatile("" ::: "memory");
    const int c = lane & 7;
#pragma unroll
    for (int j = 0; j < 4; ++j) { const int n = (lane >> 3) + 8 * j; const LAS float* s = scr + (8 * c) * 33 + n;
        v4u o; o.x = pk2(s[0 * 33], s[1 * 33]); o.y = pk2(s[2 * 33], s[3 * 33]); o.z = pk2(s[4 * 33], s[5 * 33]); o.w = pk2(s[6 * 33], s[7 * 33]);
        *(v4u*)(WT + (size_t)(dst_row0 + n) * K + k0 + 8 * c) = o; }
    LDS_WAIT(); asm volatile("" ::: "memory");
}

struct P {
    const float *x, *norm_mix_w, *w_in, *conv_w, *conv_b, *b_i, *b_f, *ml_norm_w, *w_sb, *w_ml, *w_out, *norm_ffn_w, *w_query, *keys1, *keys2, *peer_u, *peer_v, *norm_final_w;
    float* out; unsigned char* ws;
};

__device__ __forceinline__ void p0_prologue(const P& p, LAS unsigned char* lds, int wave, int lane) {
    LAS float* scr = (LAS float*)(lds + wave * 8448);
    const int gw = blockIdx.x * NWAVES + wave, NGW = gridDim.x * NWAVES;
    bf16* W1T = (bf16*)(p.ws + WS_W1T); bf16* WSBT = (bf16*)(p.ws + WS_WSBT); bf16* WMLT = (bf16*)(p.ws + WS_WMLT); bf16* WOUTT = (bf16*)(p.ws + WS_WOUTT); bf16* WCT = (bf16*)(p.ws + WS_WCT);
    constexpr int I_1 = 16 * 176, I_SB = 8 * 32, I_ML = 8 * 32, I_O = 16 * 32, NT = I_1 + I_SB + I_ML + I_O;
    for (int it = gw; it < NT; it += NGW) {
        int r = it;
        if (r < I_1) { const int kb = r / 176, nb = r % 176, n0 = nb * 32; transpose_item(p.w_in, INC, 1024, W1T, n0 < 3584 ? n0 : n0 + 8, n0, scr, kb, lane); continue; } r -= I_1;
        if (r < I_SB) { const int kb = r / 32, nb = r % 32; transpose_item(p.w_sb, 1024, 1024, WSBT, nb * 32, nb * 32, scr, kb, lane);             continue; } r -= I_SB;
        if (r < I_ML) { const int kb = r / 32, nb = r % 32; transpose_item(p.w_ml, 1024, 1024, WSBT + 512, nb * 32, nb * 32, scr, kb, lane); continue; } r -= I_ML;
        { const int kb = r / 32, nb = r % 32; transpose_item(p.w_out, 1024, 1024, WOUTT, nb * 32, nb * 32, scr, kb, lane); }
    }
    bf16* XN = (bf16*)(p.ws + WS_XN); float* IFG = (float*)(p.ws + WS_IFG);
    LAS float* WG = (LAS float*)(lds + 8 * 8448);
    __syncthreads();
    for (int i = threadIdx.x; i < 2048; i += NTHR) { const int k = i >> 1, hf = i & 1; *(LAS f32x4*)(WG + k * 8 + hf * 4) = *(const f32x4*)(p.w_in + (size_t)k * INC + 3584 + hf * 4); }
    __syncthreads();
    for (int m = gw; m < T_; m += NGW) {
        const f32x4* xr = (const f32x4*)(p.x + (size_t)m * 1024) + lane;
        const f32x4* wr = (const f32x4*)p.norm_mix_w + lane;
        f32x4 v[4]; float ss = 0.f;
#pragma unroll
        for (int j = 0; j < 4; ++j) { v[j] = xr[64 * j]; ss += (v[j].x * v[j].x + v[j].y * v[j].y) + (v[j].z * v[j].z + v[j].w * v[j].w); }
        const float rstd = frsq(wave_sum(ss) * (1.f / 1024.f) + EPS);
        float g[8];
#pragma unroll
        for (int i = 0; i < 8; ++i) g[i] = 0.f;
        v2u* o8 = (v2u*)(XN + (size_t)m * 1024) + lane;
#pragma unroll
        for (int j = 0; j < 4; ++j) {
            const f32x4 w = wr[64 * j];
            const float y[4] = {v[j].x * rstd * w.x, v[j].y * rstd * w.y, v[j].z * rstd * w.z, v[j].w * rstd * w.w};
            o8[64 * j] = (v2u){pk2(y[0], y[1]), pk2(y[2], y[3])};
#pragma unroll
            for (int q = 0; q < 4; ++q) {
                const int k = 256 * j + 4 * lane + q;
                const f32x4 w0 = *(const LAS f32x4*)(WG + k * 8), w1 = *(const LAS f32x4*)(WG + k * 8 + 4);
                g[0] += y[q] * w0.x; g[1] += y[q] * w0.y; g[2] += y[q] * w0.z; g[3] += y[q] * w0.w;
                g[4] += y[q] * w1.x; g[5] += y[q] * w1.y; g[6] += y[q] * w1.z; g[7] += y[q] * w1.w;
            }
        }
        {
            const bool b5 = (lane & 32) != 0, b4 = (lane & 16) != 0, b3 = (lane & 8) != 0;
            float e4[4], f2[2], gs;
#pragma unroll
            for (int i = 0; i < 4; ++i) { const float keep = b5 ? g[2 * i + 1] : g[2 * i], send = b5 ? g[2 * i] : g[2 * i + 1]; e4[i] = keep + __shfl_xor(send, 32); }
#pragma unroll
            for (int i = 0; i < 2; ++i) { const float keep = b4 ? e4[2 * i + 1] : e4[2 * i], send = b4 ? e4[2 * i] : e4[2 * i + 1]; f2[i] = keep + __shfl_xor(send, 16); }
            { const float keep = b3 ? f2[1] : f2[0], send = b3 ? f2[0] : f2[1]; gs = keep + __shfl_xor(send, 8); }
            gs += __shfl_xor(gs, 4); gs += __shfl_xor(gs, 2); gs += __shfl_xor(gs, 1);
            const int gi = 4 * (b3 ? 1 : 0) + 2 * (b4 ? 1 : 0) + (b5 ? 1 : 0);
            if ((lane & 7) == 0) IFG[(size_t)m * 8 + gi] = gs + (gi < 4 ? p.b_i[gi] : p.b_f[gi - 4]);
        }
    }
}

__device__ __forceinline__ void fill_wc(const P& p, int it, int lane) {
    bf16* WCT = (bf16*)(p.ws + WS_WCT);
    const int hhf = it >> 6, kb = (it >> 2) & 15, kq = it & 3, head = hhf >> 1, half = hhf & 1, k = kb * 64 + lane;
    const f32x4* wq = (const f32x4*)(p.w_query + (size_t)k * 2048 + head * 256 + half * 128);
    f32x4 wr[32];
#pragma unroll
    for (int i = 0; i < 32; ++i) wr[i] = wq[i];
    const float* kbase = (half ? p.keys2 : p.keys1) + ((size_t)head * 128 + kq * 32) * 128;
#pragma unroll 1
    for (int key = 0; key < 32; ++key) {
        const f32x4* kr = (const f32x4*)(kbase + (size_t)key * 128);
        float a0 = 0.f, a1 = 0.f;
#pragma unroll
        for (int i = 0; i < 32; i += 2) { const f32x4 b0 = kr[i], b1 = kr[i + 1];
            a0 += wr[i].x * b0.x + wr[i].y * b0.y + wr[i].z * b0.z + wr[i].w * b0.w;
            a1 += wr[i + 1].x * b1.x + wr[i + 1].y * b1.y + wr[i + 1].z * b1.z + wr[i + 1].w * b1.w; }
        WCT[(size_t)(hhf * 128 + kq * 32 + key) * 1024 + k] = (bf16)f2bf(a0 + a1);
    }
}
__device__ __forceinline__ void fill_tables(const P& p, int e, int lane) {
    unsigned char* U8 = p.ws + WS_U8; unsigned char* V8 = p.ws + WS_V8; float* USC = (float*)(p.ws + WS_USC); float* VSC = (float*)(p.ws + WS_VSC);
    f32x4 v[2][4]; float am[2] = {0.f, 0.f};
#pragma unroll
    for (int which = 0; which < 2; ++which) {
        const float* src = (which ? p.peer_v : p.peer_u) + (size_t)e * 1024 + 16 * lane;
#pragma unroll
        for (int j = 0; j < 4; ++j) v[which][j] = *(const f32x4*)(src + 4 * j);
    }
#pragma unroll
    for (int which = 0; which < 2; ++which)
#pragma unroll
        for (int j = 0; j < 4; ++j) am[which] = fmaxf(am[which], fmaxf(fmaxf(fabsf(v[which][j].x), fabsf(v[which][j].y)), fmaxf(fabsf(v[which][j].z), fabsf(v[which][j].w))));
#pragma unroll
    for (int o = 1; o < 64; o <<= 1) { am[0] = fmaxf(am[0], __shfl_xor(am[0], o)); am[1] = fmaxf(am[1], __shfl_xor(am[1], o)); }
#pragma unroll
    for (int which = 0; which < 2; ++which) {
        const float sc = am[which] > 0.f ? exp2f(floorf(log2f(448.f / am[which]))) : 1.f;
        unsigned w[4];
#pragma unroll
        for (int j = 0; j < 4; ++j) { int t = __builtin_amdgcn_cvt_pk_fp8_f32(v[which][j].x * sc, v[which][j].y * sc, 0, false); t = __builtin_amdgcn_cvt_pk_fp8_f32(v[which][j].z * sc, v[which][j].w * sc, t, true); w[j] = (unsigned)t; }
        *(v4u*)((which ? V8 : U8) + ((size_t)(lane >> 3) * NEXP + e) * 128 + 16 * (lane & 7)) = (v4u){w[0], w[1], w[2], w[3]};
        if (lane == 0) (which ? VSC : USC)[e] = 1.f / sc;
    }
}
constexpr int N_FILL = 128 + 1024;
__device__ __forceinline__ void fill_item(const P& p, int item, int wave, int lane) {
    if (item < 128) fill_wc(p, item * 8 + wave, lane);
    else { const int e0 = (item - 128) * 16 + wave * 2; fill_tables(p, e0, lane); fill_tables(p, e0 + 1, lane); }
}

typedef short bf16x8 __attribute__((ext_vector_type(8)));
typedef float f32x16 __attribute__((ext_vector_type(16)));
#define MFMA32(a, b, c) __builtin_amdgcn_mfma_f32_32x32x16_bf16((a), (b), (c), 0, 0, 0)
__device__ __forceinline__ int crow(int reg, int hh) { return (reg & 3) + 8 * (reg >> 2) + 4 * hh; }
template <int S> __device__ __forceinline__ bf16x8 pack_step(const f32x16& x) {
    v4u p; p.x = cvtpk(x[8 * S], x[8 * S + 1]); p.y = cvtpk(x[8 * S + 2], x[8 * S + 3]); p.z = cvtpk(x[8 * S + 4], x[8 * S + 5]); p.w = cvtpk(x[8 * S + 6], x[8 * S + 7]);
    return __builtin_bit_cast(bf16x8, p);
}
__device__ __forceinline__ bf16x8 frag2(const v2u& lo, const v2u& hi) { v4u p; p.x = lo.x; p.y = lo.y; p.z = hi.x; p.w = hi.y; return __builtin_bit_cast(bf16x8, p); }
__device__ __forceinline__ f32x16 zero16() { f32x16 z; for (int i = 0; i < 16; ++i) z[i] = 0.f; return z; }


__device__ __forceinline__ void p2_conv(const P& p, int tid) {
    const bf16* MLQK = (const bf16*)(p.ws + WS_MLQK); bf16* QC = (bf16*)(p.ws + WS_QC); bf16* KC = (bf16*)(p.ws + WS_KC);
    const int cg = tid & 127, ch0 = 8 * cg;
    float cw[4][8], cb[8];
#pragma unroll
    for (int i = 0; i < 8; ++i) { cb[i] = p.conv_b[ch0 + i];
#pragma unroll
        for (int j = 0; j < 4; ++j) cw[j][i] = p.conv_w[j * 1024 + ch0 + i]; }
    const float osc = cg >= 64 ? 0.08838834764831845f : 1.f;
    bf16* dst = (cg >= 64 ? KC : QC) + (cg & 63) * 8;
    for (int rg = blockIdx.x * 4 + (tid >> 7); rg < T_ / 4; rg += gridDim.x * 4) {
        const int tok = rg * 4, pos0 = tok & (S_ - 1);
        v4u xr[7];
#pragma unroll
        for (int k = 0; k < 7; ++k) xr[k] = (pos0 + k - 3 >= 0) ? *(const v4u*)(MLQK + (size_t)(tok + k - 3) * 1024 + ch0) : (v4u){0u, 0u, 0u, 0u};
#pragma unroll
        for (int tt = 0; tt < 4; ++tt) {
            float y[8];
#pragma unroll
            for (int i = 0; i < 8; ++i) y[i] = cb[i];
#pragma unroll
            for (int j = 0; j < 4; ++j) { float f[8]; unpack8(xr[tt + j], f);
#pragma unroll
                for (int i = 0; i < 8; ++i) y[i] += cw[j][i] * f[i]; }
#pragma unroll
            for (int i = 0; i < 8; ++i) y[i] = y[i] * sigmoidf_(y[i]) * osc;
            *(v4u*)(dst + (size_t)(tok + tt) * 512) = pack8(y);
        }
    }
}

constexpr int ML_QS = 0, ML_KS = 17408, ML_KWT = 34816, ML_VTL = 53248, ML_PS = 71680, ML_CT = 80896, ML_SCAL = 115712, ML_SSP = 118272, ML_QN = ML_SSP + 512, ML_F1 = ML_QN + 256, ML_F2 = ML_F1 + 256, ML_NV = ML_F2 + 256;
static_assert(ML_NV + 512 <= RING_BYTES, "mLSTM LDS map");
__device__ __forceinline__ void mlstm_scal(float ip, float fp, LAS float* sc, float& m_carry, int lane) {
    const float lf = fminf(fp, 0.f) - flog(1.f + fexp(-fabsf(fp)));
    float bc = lf;
#pragma unroll
    for (int o = 1; o < 64; o <<= 1) { const float t2 = __shfl_up(bc, o); if (lane >= o) bc += t2; }
    const float a = ip - bc; float pm = a;
#pragma unroll
    for (int o = 1; o < 64; o <<= 1) { const float t2 = __shfl_up(pm, o); if (lane >= o) pm = fmaxf(pm, t2); }
    const float M = fmaxf(m_carry, pm);
    const float M63 = __shfl(M, 63), bc63 = __shfl(bc, 63);
    sc[lane] = a; sc[64 + lane] = M; sc[128 + lane] = fexp(a - M63); sc[192 + lane] = fexp(m_carry - M); sc[256 + lane] = fexp(-(bc + M));
    m_carry = bc63 + M63;
}
__device__ __forceinline__ void mlstm_item(const P& p, LAS unsigned char* lds, int item, int tid, int wave, int lane) {
    const int b = item >> 2, h = item & 3;
    const int r = lane & 31, hh = lane >> 5, et = wave & 3, th = wave >> 2;
    const bf16* QC = (const bf16*)(p.ws + WS_QC); const bf16* KC = (const bf16*)(p.ws + WS_KC); const bf16* MLV = (const bf16*)(p.ws + WS_MLV); const float* IFG = (const float*)(p.ws + WS_IFG);
    bf16* HML = (bf16*)p.out + 512;
    LAS float* SCAL = (LAS float*)(lds + ML_SCAL); LAS float* SSP = (LAS float*)(lds + ML_SSP); LAS float* QN = (LAS float*)(lds + ML_QN);
    LAS float* F1 = (LAS float*)(lds + ML_F1); LAS float* F2 = (LAS float*)(lds + ML_F2); LAS float* NV = (LAS float*)(lds + ML_NV);
    const int cg = tid & 15, trow = tid >> 4, eg = cg, sl = trow;
    const size_t hq = (size_t)h * 128 + 8 * cg;
    for (int i = tid; i < (128 * 136 * 2) / 4; i += NTHR) ((LAS unsigned*)(lds + ML_CT))[i] = 0u;
    if (tid < 128) NV[tid] = 0.f;
    f32x16 accC[2]; accC[0] = zero16(); accC[1] = zero16();
    float m_carry = 0.f;
    if (wave == 3) { const size_t tk = (size_t)b * S_ + lane; mlstm_scal(IFG[tk * 8 + h], IFG[tk * 8 + 4 + h], SCAL, m_carry, lane); }
    v4u pq[2], pk[2], pv[2];
    {
        const size_t t0 = (size_t)b * S_;
#pragma unroll
        for (int u = 0; u < 2; ++u) { pq[u] = *(const v4u*)(QC + (t0 + trow + 32 * u) * 512 + hq); pk[u] = *(const v4u*)(KC + (t0 + trow + 32 * u) * 512 + hq); pv[u] = *(const v4u*)(MLV + (t0 + sl + 32 * u) * 512 + hq); }
    }
    float ipn = 0.f, fpn = 0.f;
    __syncthreads();
    for (int c = 0; c < 32; ++c) {
        const size_t tok0 = (size_t)b * S_ + c * 64;
        LAS float* sc = SCAL + (c & 1) * 320;
        {
#pragma unroll
            for (int u = 0; u < 2; ++u) {
                const int t = trow + 32 * u;
                *(LAS v4u*)(lds + ML_QS + t * 272 + cg * 16) = pq[u];
                *(LAS v4u*)(lds + ML_KS + t * 272 + cg * 16) = pk[u];
                float f[8]; unpack8(pk[u], f);
                const float wk = sc[128 + t];
#pragma unroll
                for (int i = 0; i < 8; ++i) *(LAS bf16*)(lds + ML_KWT + (8 * cg + i) * 144 + ((t ^ (8 * (cg & 7))) * 2)) = (bf16)f2bf(f[i] * wk);
                const unsigned vv[4] = {pv[u].x, pv[u].y, pv[u].z, pv[u].w};
#pragma unroll
                for (int i = 0; i < 4; ++i) {
                    *(LAS bf16*)(lds + ML_VTL + (8 * eg + 2 * i) * 144 + ((t ^ (8 * (eg & 7))) * 2)) = (bf16)(vv[i] & 0xffffu);
                    *(LAS bf16*)(lds + ML_VTL + (8 * eg + 2 * i + 1) * 144 + ((t ^ (8 * (eg & 7))) * 2)) = (bf16)(vv[i] >> 16);
                }
            }
            if (c + 1 < 32) {
                const size_t t1 = tok0 + 64;
#pragma unroll
                for (int u = 0; u < 2; ++u) { pq[u] = *(const v4u*)(QC + (t1 + trow + 32 * u) * 512 + hq); pk[u] = *(const v4u*)(KC + (t1 + trow + 32 * u) * 512 + hq); pv[u] = *(const v4u*)(MLV + (t1 + sl + 32 * u) * 512 + hq); }
                if (wave == 3) { ipn = IFG[(t1 + lane) * 8 + h]; fpn = IFG[(t1 + lane) * 8 + 4 + h]; }
            }
        }
        __syncthreads();
        f32x16 acc_inter = zero16();
        if (wave < 3) {
            const int tt = wave > 0 ? 1 : 0, st = wave == 2 ? 1 : 0;
            f32x16 zt = zero16();
#pragma unroll
            for (int ks = 0; ks < 8; ++ks) {
                const bf16x8 ka = *(const LAS bf16x8*)(lds + ML_KS + (32 * st + r) * 272 + 32 * ks + 16 * hh);
                const bf16x8 qb = *(const LAS bf16x8*)(lds + ML_QS + (32 * tt + r) * 272 + 32 * ks + 16 * hh);
                zt = MFMA32(ka, qb, zt);
            }
            const int t = 32 * tt + r; const float Mt = sc[64 + t];
            float ps = 0.f;
#pragma unroll
            for (int g = 0; g < 4; ++g) {
                const f32x4 av = *(const LAS f32x4*)(sc + 32 * st + 8 * g + 4 * hh);
                float pv[4];
#pragma unroll
                for (int q = 0; q < 4; ++q) { const int sidx = 32 * st + 8 * g + 4 * hh + q;
                    const float wgt = sidx <= t ? fexp(av[q] - Mt) : 0.f; pv[q] = zt[4 * g + q] * wgt; ps += pv[q]; }
                *(LAS v2u*)(lds + ML_PS + t * 144 + (32 * st + 8 * g + 4 * hh) * 2) = (v2u){cvtpk(pv[0], pv[1]), cvtpk(pv[2], pv[3])};
            }
            ps += __shfl_xor(ps, 32);
            if (hh == 0) { SSP[st * 64 + t] = ps; if (wave == 0) SSP[64 + t] = 0.f; }
        }
        if (wave == 3 && c + 1 < 32) mlstm_scal(ipn, fpn, SCAL + ((c + 1) & 1) * 320, m_carry, lane);
#pragma unroll
        for (int ks = 0; ks < 8; ++ks) {
            const bf16x8 qa = *(const LAS bf16x8*)(lds + ML_QS + (32 * th + r) * 272 + 32 * ks + 16 * hh);
            const bf16x8 cbf = *(const LAS bf16x8*)(lds + ML_CT + (32 * et + r) * 272 + 32 * ks + 16 * hh);
            acc_inter = MFMA32(qa, cbf, acc_inter);
        }
        {
            const int t = tid >> 3, part = tid & 7;
            float f[8], sum = 0.f;
            { const v4u tq = *(const LAS v4u*)(lds + ML_QS + t * 272 + part * 32); unpack8(tq, f); }
#pragma unroll
            for (int i = 0; i < 8; ++i) sum += f[i] * NV[16 * part + i];
            { const v4u tq = *(const LAS v4u*)(lds + ML_QS + t * 272 + part * 32 + 16); unpack8(tq, f); }
#pragma unroll
            for (int i = 0; i < 8; ++i) sum += f[i] * NV[16 * part + 8 + i];
            sum += __shfl_xor(sum, 1); sum += __shfl_xor(sum, 2); sum += __shfl_xor(sum, 4);
            if (part == 0) QN[t] = sum;
        }
        __syncthreads();
        f32x16 acc_intra = zero16();
#pragma unroll
        for (int ks = 0; ks < 4; ++ks) {
            if (ks < 2 || th == 1) {
                const bf16x8 pa = *(const LAS bf16x8*)(lds + ML_PS + (32 * th + r) * 144 + 32 * ks + 16 * hh);
                const bf16x8 vb = *(const LAS bf16x8*)(lds + ML_VTL + (32 * et + r) * 144 + 16 * ((2 * ks + hh) ^ (((32 * et + r) >> 3) & 7)));
                acc_intra = MFMA32(pa, vb, acc_intra);
            }
        }
        if (tid < 64) {
            const float wi = sc[192 + tid];
            const float den = SSP[tid] + SSP[64 + tid] + wi * QN[tid];
            const float f1 = frcp(fmaxf(fabsf(den), sc[256 + tid]));
            F1[tid] = f1; F2[tid] = wi * f1;
        }
        const float decay = sc[192 + 63];
#pragma unroll
        for (int dt = 0; dt < 2; ++dt) {
#pragma unroll
            for (int i = 0; i < 16; ++i) accC[dt][i] *= decay;
#pragma unroll
            for (int ks = 0; ks < 4; ++ks) {
                const bf16x8 ka = *(const LAS bf16x8*)(lds + ML_KWT + (64 * th + 32 * dt + r) * 144 + 16 * ((2 * ks + hh) ^ (((64 * th + 32 * dt + r) >> 3) & 7)));
                const bf16x8 vb = *(const LAS bf16x8*)(lds + ML_VTL + (32 * et + r) * 144 + 16 * ((2 * ks + hh) ^ (((32 * et + r) >> 3) & 7)));
                accC[dt] = MFMA32(ka, vb, accC[dt]);
            }
        }
        {
            const int d = tid >> 2, part = tid & 3;
            float f[8], sum = 0.f;
            { const v4u tq = *(const LAS v4u*)(lds + ML_KWT + d * 144 + part * 32); unpack8(tq, f); }
#pragma unroll
            for (int i = 0; i < 8; ++i) sum += f[i];
            { const v4u tq = *(const LAS v4u*)(lds + ML_KWT + d * 144 + part * 32 + 16); unpack8(tq, f); }
#pragma unroll
            for (int i = 0; i < 8; ++i) sum += f[i];
            sum += __shfl_xor(sum, 1); sum += __shfl_xor(sum, 2);
            if (part == 0) NV[d] = decay * NV[d] + sum;
        }
        __syncthreads();
        {
            bf16* hp = HML + (tok0 + 32 * th) * 1024 + h * 128 + 32 * et + r;
#pragma unroll
            for (int g = 0; g < 4; ++g) {
                const f32x4 f1v = *(const LAS f32x4*)(F1 + 32 * th + 8 * g + 4 * hh), f2v = *(const LAS f32x4*)(F2 + 32 * th + 8 * g + 4 * hh);
#pragma unroll
                for (int q = 0; q < 4; ++q) { const int tl = 8 * g + 4 * hh + q;
                    hp[(size_t)tl * 1024] = (bf16)f2bf(acc_intra[4 * g + q] * f1v[q] + acc_inter[4 * g + q] * f2v[q]); }
            }
#pragma unroll
            for (int dt = 0; dt < 2; ++dt)
#pragma unroll
                for (int g = 0; g < 4; ++g)
                    *(LAS v2u*)(lds + ML_CT + (32 * et + r) * 272 + (64 * th + 32 * dt + 8 * g + 4 * hh) * 2) = (v2u){cvtpk(accC[dt][4 * g], accC[dt][4 * g + 1]), cvtpk(accC[dt][4 * g + 2], accC[dt][4 * g + 3])};
        }
    }
    __syncthreads();
}

__device__ __forceinline__ void sba_wave_item(const bf16* __restrict__ QK, const bf16* __restrict__ VT, bf16* __restrict__ YSB, int b, int h, int qt, int lane) {
    const int r = lane & 31, hh = lane >> 5, t0 = qt * 32;
    const size_t rowbase = (size_t)b * S_;
    bf16x8 qf[4];
    {
        const bf16* qp = QK + (rowbase + t0 + r) * 1024 + h * 64 + 8 * hh;
#pragma unroll
        for (int ks = 0; ks < 4; ++ks) qf[ks] = *(const bf16x8*)(qp + 16 * ks);
    }
    bf16x8 tri[2];
#pragma unroll
    for (int s2 = 0; s2 < 2; ++s2)
#pragma unroll
        for (int j = 0; j < 8; ++j) { const int rho = 16 * s2 + 8 * (j >> 2) + 4 * hh + (j & 3); tri[s2][j] = (rho > r) ? (short)0x3F80 : (short)0; }
    f32x16 o0 = zero16(), o1 = zero16();
    float carry = 0.f;
    const bf16* kbase = QK + rowbase * 1024 + 512 + h * 64 + 8 * hh + (size_t)r * 1024;
    const bf16* vbase = VT + ((size_t)(b * 8 + h) * 64 + r) * 2048 + 4 * hh;
    bf16x8 kf[4]; v2u vl[2][2], vh[2][2];
#pragma unroll
    for (int ks = 0; ks < 4; ++ks) kf[ks] = *(const bf16x8*)(kbase + (size_t)t0 * 1024 + 16 * ks);
#pragma unroll
    for (int dt = 0; dt < 2; ++dt)
#pragma unroll
        for (int s2 = 0; s2 < 2; ++s2) { const bf16* vp = vbase + (size_t)dt * 32 * 2048 + t0 + 16 * s2; vl[dt][s2] = *(const v2u*)vp; vh[dt][s2] = *(const v2u*)(vp + 8); }
    for (int s0 = t0; s0 >= 0; s0 -= 32) {
        bf16x8 kn[4]; v2u vln[2][2], vhn[2][2];
        const int sn = s0 >= 32 ? s0 - 32 : 0;
#pragma unroll
        for (int ks = 0; ks < 4; ++ks) kn[ks] = *(const bf16x8*)(kbase + (size_t)sn * 1024 + 16 * ks);
#pragma unroll
        for (int dt = 0; dt < 2; ++dt)
#pragma unroll
            for (int s2 = 0; s2 < 2; ++s2) { const bf16* vp = vbase + (size_t)dt * 32 * 2048 + sn + 16 * s2; vln[dt][s2] = *(const v2u*)vp; vhn[dt][s2] = *(const v2u*)(vp + 8); }
        f32x16 z = zero16();
#pragma unroll
        for (int ks = 0; ks < 4; ++ks) z = MFMA32(kf[ks], qf[ks], z);
        const bool diag = (s0 == t0);
        f32x16 sp; float rs = 0.f;
#pragma unroll
        for (int i = 0; i < 16; ++i) {
            const float zz = z[i] * 0.125f;
            const bool valid = !diag || (crow(i, hh) < r);
            float spv = fmaxf(zz, 0.f) + flog(1.f + fexp(-fabsf(zz)));
            spv = valid ? spv : 0.f;
            sp[i] = spv; rs += spv; z[i] = zz - spv;
        }
        f32x16 suf = zero16();
        suf = MFMA32(tri[0], pack_step<0>(sp), suf);
        suf = MFMA32(tri[1], pack_step<1>(sp), suf);
        f32x16 w;
#pragma unroll
        for (int i = 0; i < 16; ++i) {
            const bool valid = !diag || (crow(i, hh) < r);
            const float lw = z[i] - suf[i] - carry;
            w[i] = valid ? fexp(lw) : 0.f;
        }
        rs += __shfl_xor(rs, 32);
        carry += rs;
        const bf16x8 pa0 = pack_step<0>(w), pa1 = pack_step<1>(w);
        o0 = MFMA32(pa0, frag2(vl[0][0], vh[0][0]), o0); o0 = MFMA32(pa1, frag2(vl[0][1], vh[0][1]), o0);
        o1 = MFMA32(pa0, frag2(vl[1][0], vh[1][0]), o1); o1 = MFMA32(pa1, frag2(vl[1][1], vh[1][1]), o1);
        if (__all(carry > 104.f)) break;
#pragma unroll
        for (int ks = 0; ks < 4; ++ks) kf[ks] = kn[ks];
#pragma unroll
        for (int dt = 0; dt < 2; ++dt)
#pragma unroll
            for (int s2 = 0; s2 < 2; ++s2) { vl[dt][s2] = vln[dt][s2]; vh[dt][s2] = vhn[dt][s2]; }
    }
    bf16* op = YSB + (rowbase + t0) * 1024 + h * 64 + r;
#pragma unroll
    for (int i = 0; i < 16; ++i) { const int t = crow(i, hh); op[(size_t)t * 1024] = (bf16)f2bf(o0[i]); op[(size_t)t * 1024 + 32] = (bf16)f2bf(o1[i]); }
}
__device__ __forceinline__ void sba_item(const P& p, int item, int wave, int lane) {
    const int bh = item >> 3, qb = item & 7, b = bh >> 3, h = bh & 7;
    sba_wave_item((const bf16*)(p.ws + WS_SBQKV), (const bf16*)(p.ws + WS_VT), (bf16*)p.out, b, h, qb * 8 + wave, lane);
}

__device__ __forceinline__ void p3_yml(const P& p, int wave, int lane) {
    const int gw = blockIdx.x * NWAVES + wave, NGW = gridDim.x * NWAVES;
    bf16* YML = (bf16*)p.out + 512; const bf16* MLO = (const bf16*)(p.ws + WS_MLO);
    for (int m = gw; m < T_; m += NGW) {
        float hv[8], ov[8], o[8];
        unpack8(*(const v4u*)(YML + (size_t)m * 1024 + lane * 8), hv); unpack8(*(const v4u*)(MLO + (size_t)m * 512 + lane * 8), ov);
        float ss = 0.f;
#pragma unroll
        for (int i = 0; i < 8; ++i) ss += hv[i] * hv[i];
        ss += __shfl_xor(ss, 1); ss += __shfl_xor(ss, 2); ss += __shfl_xor(ss, 4); ss += __shfl_xor(ss, 8);
        const float rstd = frsq(ss * (1.f / 128.f) + EPS);
        const f32x4 w0 = *(const f32x4*)(p.ml_norm_w + lane * 8), w1 = *(const f32x4*)(p.ml_norm_w + lane * 8 + 4);
        const float wv[8] = {w0.x, w0.y, w0.z, w0.w, w1.x, w1.y, w1.z, w1.w};
#pragma unroll
        for (int i = 0; i < 8; ++i) o[i] = sigmoidf_(ov[i]) * hv[i] * rstd * wv[i];
        *(v4u*)(YML + (size_t)m * 1024 + lane * 8) = pack8(o);
    }
}

__device__ __forceinline__ void p6_hn(const P& p, int wave, int lane) {
    const int gw = blockIdx.x * NWAVES + wave, NGW = gridDim.x * NWAVES;
    const float* H = (const float*)(p.ws + WS_H); bf16* HN = (bf16*)(p.ws + WS_HN);
    for (int m = gw; m < T_; m += NGW) {
        const f32x4* xr = (const f32x4*)(H + (size_t)m * 1024) + lane; const f32x4* wr = (const f32x4*)p.norm_ffn_w + lane;
        f32x4 v[4]; float ss = 0.f;
#pragma unroll
        for (int j = 0; j < 4; ++j) { v[j] = xr[64 * j]; ss += (v[j].x * v[j].x + v[j].y * v[j].y) + (v[j].z * v[j].z + v[j].w * v[j].w); }
        const float rstd = frsq(wave_sum(ss) * (1.f / 1024.f) + EPS);
        v2u* o8 = (v2u*)(HN + (size_t)m * 1024) + lane;
#pragma unroll
        for (int j = 0; j < 4; ++j) { const f32x4 w = wr[64 * j]; o8[64 * j] = (v2u){pk2(v[j].x * rstd * w.x, v[j].y * rstd * w.y), pk2(v[j].z * rstd * w.z, v[j].w * rstd * w.w)}; }
    }
}

__device__ __forceinline__ float ffn_rstd(const float* SS, int m) {
    const f32x4* q = (const f32x4*)(SS + (size_t)m * 16); const f32x4 a = q[0], b = q[1], c = q[2], d = q[3];
    const float t = ((a.x + a.y) + (a.z + a.w)) + ((b.x + b.y) + (b.z + b.w)) + ((c.x + c.y) + (c.z + c.w)) + ((d.x + d.y) + (d.z + d.w));
    return frsq(t * (1.f / 1024.f) + EPS);
}
__device__ __forceinline__ unsigned ord_key(float f) { const unsigned u = __builtin_bit_cast(unsigned, f); return (u & 0x80000000u) ? ~u : (u | 0x80000000u); }
__device__ __forceinline__ float ord_val(unsigned k) { const unsigned u = (k & 0x80000000u) ? (k & 0x7fffffffu) : ~k; return __builtin_bit_cast(float, u); }
template <int CTRL> __device__ __forceinline__ unsigned dpp_u(unsigned v) { return (unsigned)__builtin_amdgcn_update_dpp(0, (int)v, CTRL, 0xF, 0xF, true); }
__device__ __forceinline__ unsigned umax_(unsigned a, unsigned b) { return a > b ? a : b; }
__device__ __forceinline__ unsigned umin_(unsigned a, unsigned b) { return a < b ? a : b; }
__device__ __forceinline__ unsigned row_max_u(unsigned v) {
    v = umax_(v, dpp_u<0xB1>(v)); v = umax_(v, dpp_u<0x4E>(v)); v = umax_(v, dpp_u<0x141>(v)); v = umax_(v, dpp_u<0x140>(v)); return v;
}
__device__ __forceinline__ float row_sum_f(float v) {
    v += __builtin_bit_cast(float, dpp_u<0xB1>(__builtin_bit_cast(unsigned, v))); v += __builtin_bit_cast(float, dpp_u<0x4E>(__builtin_bit_cast(unsigned, v)));
    v += __builtin_bit_cast(float, dpp_u<0x141>(__builtin_bit_cast(unsigned, v))); v += __builtin_bit_cast(float, dpp_u<0x140>(__builtin_bit_cast(unsigned, v))); return v;
}
#define CE_(i, j) do { const unsigned _a = k[i], _b = k[j]; k[i] = umax_(_a, _b); k[j] = umin_(_a, _b); } while (0)
__device__ __forceinline__ unsigned row_top16(unsigned (&k)[8], unsigned (&top)[16], int li) {
    CE_(0, 1); CE_(2, 3); CE_(4, 5); CE_(6, 7); CE_(0, 2); CE_(1, 3); CE_(4, 6); CE_(5, 7); CE_(1, 2); CE_(5, 6);
    CE_(0, 4); CE_(1, 5); CE_(2, 6); CE_(3, 7); CE_(2, 4); CE_(3, 5); CE_(1, 2); CE_(3, 4); CE_(5, 6);
    unsigned mine = 0u;
#pragma unroll
    for (int n = 0; n < 16; ++n) {
        const unsigned m = row_max_u(k[0]);
        const bool hit = k[0] == m;
#pragma unroll
        for (int i = 0; i < 7; ++i) k[i] = hit ? k[i + 1] : k[i];
        k[7] = hit ? 0u : k[7];
        top[n] = m; mine = (li == n) ? m : mine;
    }
    return mine;
}
__device__ __forceinline__ void topk_core(const float (&s1)[8], const float (&s2)[8], float rstd, int li, int lane, int& e_out, float& g_out) {
    unsigned k[8], top1[16], top2[16];
#pragma unroll
    for (int j = 0; j < 8; ++j) k[j] = (ord_key(s1[j]) & ~0x7fu) | (unsigned)(127 - (li + 16 * j));
    const unsigned mine1 = row_top16(k, top1, li);
#pragma unroll
    for (int j = 0; j < 8; ++j) k[j] = (ord_key(s2[j]) & ~0x7fu) | (unsigned)(127 - (li + 16 * j));
    const unsigned mine2 = row_top16(k, top2, li);
    const float v2 = ord_val(mine2 & ~0x7fu);
    unsigned c[16];
#pragma unroll
    for (int j = 0; j < 16; ++j) {
        const float v1 = ord_val(top1[j] & ~0x7fu);
        const unsigned key = (ord_key(v1 + v2) & ~0xffu) | (unsigned)(255 - (16 * j + li));
        c[j] = ((j + 1) * (li + 1) <= 16) ? key : 0u;
    }
    unsigned tk = 0u, t0 = 0u;
#pragma unroll
    for (int n = 0; n < 16; ++n) {
        const unsigned mx = row_max_u(c[0]);
        const bool hit = c[0] == mx;
#pragma unroll
        for (int i = 0; i < 15; ++i) c[i] = hit ? c[i + 1] : c[i];
        c[15] = hit ? 0u : c[15];
        if (n == 0) t0 = mx;
        tk = (li == n) ? mx : tk;
    }
    const float sv = ord_val(tk & ~0xffu), s0 = ord_val(t0 & ~0xffu);
    const int cc = 255 - (int)(tk & 0xffu), a = (cc >> 4) & 15, bb = cc & 15;
    const int i1 = 127 - (int)((unsigned)__shfl((int)mine1, (lane & 48) + a) & 0x7fu), i2 = 127 - (int)((unsigned)__shfl((int)mine2, (lane & 48) + bb) & 0x7fu);
    const float pe = fexp((sv - s0) * rstd);
    const float den = row_sum_f(pe);
    e_out = i1 * 128 + i2; g_out = pe * frcp(den);
}
constexpr int TK_RS = 1040;
struct EpiTopk {
    static constexpr bool PERM = true, AFTER_DRAIN = true;
    int* IDX; float* GATE; const float* SS;
    __device__ __forceinline__ void fused(pg8::f32x4 (&acc)[2][2][4][2], const pg8::Unit& u, int wr, int wc, int fr, int fq, PG8_LAS unsigned char* lds, int wid, int lane) const {
        const int head = u.pn, q = lane >> 4, li = lane & 15;
#pragma unroll
        for (int ai = 0; ai < 2; ++ai) {
#pragma unroll
            for (int m = 0; m < 4; ++m)
#pragma unroll
                for (int bj = 0; bj < 2; ++bj) {
                    PG8_LAS unsigned char* dst = lds + (wr * 64 + m * 16 + fr) * TK_RS + (bj * 128 + wc * 32 + 8 * fq) * 4;
                    *(PG8_LAS pg8::f32x4*)dst = acc[ai][bj][m][0]; *(PG8_LAS pg8::f32x4*)(dst + 16) = acc[ai][bj][m][1];
                }
            __syncthreads();
#pragma unroll 1
            for (int it = 0; it < 4; it += 2) {
                const int rowa = 16 * wid + 4 * it + q, rowb = rowa + 4, ma = u.pm * 256 + ai * 128 + rowa, mb = ma + 4;
                const PG8_LAS float* sa = (const PG8_LAS float*)(lds + rowa * TK_RS); const PG8_LAS float* sb = (const PG8_LAS float*)(lds + rowb * TK_RS);
                float a1[8], a2[8], b1[8], b2[8];
#pragma unroll
                for (int j = 0; j < 8; ++j) { a1[j] = sa[li + 16 * j]; a2[j] = sa[128 + li + 16 * j]; b1[j] = sb[li + 16 * j]; b2[j] = sb[128 + li + 16 * j]; }
                const float ra = ffn_rstd(SS, ma), rb = ffn_rstd(SS, mb);
                int ea, eb; float ga, gb;
                topk_core(a1, a2, ra, li, lane, ea, ga);
                topk_core(b1, b2, rb, li, lane, eb, gb);
                IDX[(size_t)ma * 128 + head * 16 + li] = ea; GATE[(size_t)ma * 128 + head * 16 + li] = ga;
                IDX[(size_t)mb * 128 + head * 16 + li] = eb; GATE[(size_t)mb * 128 + head * 16 + li] = gb;
            }
            __syncthreads();
        }
    }
};
struct OneUnit {
    pg8::Unit u;
    __device__ __forceinline__ bool next(int i, pg8::Unit& o) const { if (i) return false; o = u; return true; }
    __device__ __forceinline__ void a_ready(const pg8::Unit&) const {}
    __device__ __forceinline__ void done(const pg8::Unit&) const {}
};

__device__ __forceinline__ float gelu_erf(float x) { return 0.5f * x * (1.f + erff(x * 0.70710678118654752f)); }
typedef float f32x2 __attribute__((ext_vector_type(2)));
__device__ __forceinline__ void cvt16_fp8(const v4u& w, f32x2 (&f)[8]) {
    f[0] = __builtin_amdgcn_cvt_pk_f32_fp8((int)w.x, false); f[1] = __builtin_amdgcn_cvt_pk_f32_fp8((int)w.x, true);
    f[2] = __builtin_amdgcn_cvt_pk_f32_fp8((int)w.y, false); f[3] = __builtin_amdgcn_cvt_pk_f32_fp8((int)w.y, true);
    f[4] = __builtin_amdgcn_cvt_pk_f32_fp8((int)w.z, false); f[5] = __builtin_amdgcn_cvt_pk_f32_fp8((int)w.z, true);
    f[6] = __builtin_amdgcn_cvt_pk_f32_fp8((int)w.w, false); f[7] = __builtin_amdgcn_cvt_pk_f32_fp8((int)w.w, true);
}
__device__ __forceinline__ float grp8_sum(float v) {
    v += __builtin_bit_cast(float, dpp_u<0xB1>(__builtin_bit_cast(unsigned, v)));
    v += __builtin_bit_cast(float, dpp_u<0x4E>(__builtin_bit_cast(unsigned, v)));
    v += __builtin_bit_cast(float, dpp_u<0x141>(__builtin_bit_cast(unsigned, v)));
    return v;
}
typedef int i32x4 __attribute__((ext_vector_type(4)));
template <int PAT> __device__ __forceinline__ float swz_f(float v) { return __builtin_bit_cast(float, __builtin_amdgcn_ds_swizzle(__builtin_bit_cast(int, v), PAT)); }
__device__ __forceinline__ void peer_u_token(const v4u (&ur)[16], const f32x2 (&xv)[8], bf16* dst, int c8) {
    float d[16];
#pragma unroll
    for (int i = 0; i < 16; ++i) {
        f32x2 f[8]; cvt16_fp8(ur[i], f);
        f32x2 s2 = f[0] * xv[0];
#pragma unroll
        for (int q = 1; q < 8; ++q) s2 += f[q] * xv[q];
        d[i] = s2.x + s2.y;
    }
    const bool b0 = (c8 & 1) != 0, b1 = (c8 & 2) != 0, b2 = (c8 & 4) != 0;
    float e8[8], e4[4], e2[2];
#pragma unroll
    for (int i = 0; i < 8; ++i) { const float keep = b0 ? d[2 * i + 1] : d[2 * i], send = b0 ? d[2 * i] : d[2 * i + 1];
        e8[i] = keep + __builtin_bit_cast(float, dpp_u<0xB1>(__builtin_bit_cast(unsigned, send))); }
#pragma unroll
    for (int i = 0; i < 4; ++i) { const float keep = b1 ? e8[2 * i + 1] : e8[2 * i], send = b1 ? e8[2 * i] : e8[2 * i + 1];
        e4[i] = keep + __builtin_bit_cast(float, dpp_u<0x4E>(__builtin_bit_cast(unsigned, send))); }
#pragma unroll
    for (int i = 0; i < 2; ++i) { const float keep = b2 ? e4[2 * i + 1] : e4[2 * i], send = b2 ? e4[2 * i] : e4[2 * i + 1];
        e2[i] = keep + swz_f<0x1F | (4 << 10)>(send); }
    dst[c8] = (bf16)f2bf(e2[0]); dst[c8 + 8] = (bf16)f2bf(e2[1]);
}
__device__ __forceinline__ void peer_u(const P& p, int wave, int lane) {
    const int j = blockIdx.x & 7, nchunk = gridDim.x >> 3, chunk = blockIdx.x >> 3, stride = nchunk * 8;
    const int g = lane >> 3, c8 = lane & 7;
    const bf16* HN = (const bf16*)p.out + 128 * j + 16 * c8; const int* IDX = (const int*)(p.ws + WS_IDX) + 16 * g;
    const unsigned char* US = p.ws + WS_U8 + (size_t)j * NEXP * 128 + 16 * c8;
    bf16* PART = (bf16*)(p.ws + WS_PART) + (size_t)j * T_ * 128 + 16 * g;
    const int m0 = chunk * 8 + wave, ntok = (T_ - m0 + stride - 1) / stride;
#define PU_CLAMP(k) (m0 + ((k) < ntok ? (k) : ntok - 1) * stride)
#define PU_ROWS(ur, ei) _Pragma("unroll") for (int i = 0; i < 16; ++i) ur[i] = *(const v4u*)(US + (size_t)ei[i >> 2][i & 3] * 128)
#define PU_L1(ei, h0, h1, mm) do { _Pragma("unroll") for (int q = 0; q < 4; ++q) ei[q] = *(const i32x4*)(IDX + (size_t)(mm) * 128 + 4 * q); \
        h0 = *(const v4u*)(HN + (size_t)(mm) * 1024); h1 = *(const v4u*)(HN + (size_t)(mm) * 1024 + 8); } while (0)
#define PU_X(xv, h0, h1) do { float f_[8]; unpack8(h0, f_); _Pragma("unroll") for (int i = 0; i < 4; ++i) xv[i] = (f32x2){f_[2 * i], f_[2 * i + 1]}; \
        unpack8(h1, f_); _Pragma("unroll") for (int i = 0; i < 4; ++i) xv[4 + i] = (f32x2){f_[2 * i], f_[2 * i + 1]}; } while (0)
    i32x4 ei[4]; v4u hA0, hA1, hB0, hB1; v4u urA[16], urB[16]; f32x2 xv[8];
    PU_L1(ei, hA0, hA1, m0);
    PU_ROWS(urA, ei);
    PU_L1(ei, hB0, hB1, PU_CLAMP(1));
    for (int k = 0; k < ntok; k += 2) {
        PU_ROWS(urB, ei);
        PU_X(xv, hA0, hA1);
        PU_L1(ei, hA0, hA1, PU_CLAMP(k + 2));
        peer_u_token(urA, xv, PART + (size_t)(m0 + k * stride) * 128, c8);
        if (k + 1 < ntok) {
            PU_ROWS(urA, ei);
            PU_X(xv, hB0, hB1);
            PU_L1(ei, hB0, hB1, PU_CLAMP(k + 3));
            peer_u_token(urB, xv, PART + (size_t)(m0 + (k + 1) * stride) * 128, c8);
        }
    }
#undef PU_CLAMP
#undef PU_ROWS
#undef PU_L1
#undef PU_X
}
__device__ __forceinline__ void peer_c(const P& p, int wave, int lane) {
    const int gw = blockIdx.x * NWAVES + wave, NGW = gridDim.x * NWAVES;
    const int* IDX = (const int*)(p.ws + WS_IDX); const float* GATE = (const float*)(p.ws + WS_GATE); const bf16* PART = (const bf16*)(p.ws + WS_PART);
    const float* USC = (const float*)(p.ws + WS_USC); const float* VSC = (const float*)(p.ws + WS_VSC); float* COEF = (float*)(p.ws + WS_COEF); const float* SS = (const float*)(p.ws + WS_SS);
    for (int m0 = gw * 2; m0 < T_; m0 += NGW * 2) {
        float s[2][2], rs[2], g[2][2]; int e[2][2];
#pragma unroll
        for (int u = 0; u < 2; ++u) {
            const int m = m0 + u;
            rs[u] = ffn_rstd(SS, m);
            s[u][0] = 0.f; s[u][1] = 0.f;
#pragma unroll
            for (int jj = 0; jj < 8; ++jj) { s[u][0] += bf2f(PART[((size_t)jj * T_ + m) * 128 + lane]); s[u][1] += bf2f(PART[((size_t)jj * T_ + m) * 128 + 64 + lane]); }
            e[u][0] = IDX[(size_t)m * 128 + lane]; e[u][1] = IDX[(size_t)m * 128 + 64 + lane];
            g[u][0] = GATE[(size_t)m * 128 + lane]; g[u][1] = GATE[(size_t)m * 128 + 64 + lane];
        }
        float us[2][2], vs[2][2];
#pragma unroll
        for (int u = 0; u < 2; ++u)
#pragma unroll
            for (int k = 0; k < 2; ++k) { us[u][k] = USC[e[u][k]]; vs[u][k] = VSC[e[u][k]]; }
#pragma unroll
        for (int u = 0; u < 2; ++u)
#pragma unroll
            for (int k = 0; k < 2; ++k) COEF[(size_t)(m0 + u) * 128 + 64 * k + lane] = g[u][k] * gelu_erf(s[u][k] * rs[u] * us[u][k]) * vs[u][k];
    }
}
struct PvPre { i32x4 ei[4]; float c0, c1; };
__device__ __forceinline__ void pv_level1(PvPre& q, const int* IDXg, const float* COEFg, int m, int c8) {
#pragma unroll
    for (int k = 0; k < 4; ++k) q.ei[k] = *(const i32x4*)(IDXg + (size_t)m * 128 + 4 * k);
    q.c0 = COEFg[(size_t)m * 128 + c8]; q.c1 = COEFg[(size_t)m * 128 + c8 + 8];
}
__device__ __forceinline__ void peer_v_token(const v4u (&vr)[16], float coef0, float coef1, const bf16* H, bf16* out, float* ssq, bool b3, bool b4, bool b5, int lane) {
    f32x2 acc[8];
#pragma unroll
    for (int i = 0; i < 8; ++i) acc[i] = (f32x2){0.f, 0.f};
#define PV_STEP(I) do { const float cs_ = ((I) >> 3) ? coef1 : coef0; \
        const float cu_ = swz_f<0x18 | (((I) & 7) << 5)>(cs_);     \
        const f32x2 c2_ = (f32x2){cu_, cu_}; f32x2 f_[8]; cvt16_fp8(vr[I], f_); \
        _Pragma("unroll") for (int q = 0; q < 8; ++q) acc[q] += c2_ * f_[q]; } while (0)
    PV_STEP(0); PV_STEP(1); PV_STEP(2); PV_STEP(3); PV_STEP(4); PV_STEP(5); PV_STEP(6); PV_STEP(7);
    PV_STEP(8); PV_STEP(9); PV_STEP(10); PV_STEP(11); PV_STEP(12); PV_STEP(13); PV_STEP(14); PV_STEP(15);
#undef PV_STEP
    f32x2 a1[4], a2[2], a3;
#pragma unroll
    for (int i = 0; i < 4; ++i) { const f32x2 keep = b5 ? acc[2 * i + 1] : acc[2 * i], send = b5 ? acc[2 * i] : acc[2 * i + 1];
        a1[i] = keep + (f32x2){__shfl_xor(send.x, 32), __shfl_xor(send.y, 32)}; }
#pragma unroll
    for (int i = 0; i < 2; ++i) { const f32x2 keep = b4 ? a1[2 * i + 1] : a1[2 * i], send = b4 ? a1[2 * i] : a1[2 * i + 1];
        a2[i] = keep + (f32x2){swz_f<0x1F | (16 << 10)>(send.x), swz_f<0x1F | (16 << 10)>(send.y)}; }
    { const f32x2 keep = b3 ? a2[1] : a2[0], send = b3 ? a2[0] : a2[1]; a3 = keep + (f32x2){swz_f<0x1F | (8 << 10)>(send.x), swz_f<0x1F | (8 << 10)>(send.y)}; }
    const unsigned hb = *(const unsigned*)H; const f32x2 hv = (f32x2){bflo(hb), bfhi(hb)};
    const f32x2 y = hv + a3;
    *(unsigned*)out = pk2(y.x, y.y);
    const float ss = wave_sum(y.x * y.x + y.y * y.y);
    if (lane == 0) *ssq = ss;
}
__device__ __forceinline__ void peer_v(const P& p, int wave, int lane) {
    const int j = blockIdx.x & 7, nchunk = gridDim.x >> 3, chunk = blockIdx.x >> 3, stride = nchunk * 8;
    const int g = lane >> 3, c8 = lane & 7;
    const bool b5 = (lane & 32) != 0, b4 = (lane & 16) != 0, b3 = (lane & 8) != 0;
    const int pi = 4 * (b3 ? 1 : 0) + 2 * (b4 ? 1 : 0) + (b5 ? 1 : 0);
    const size_t colo = 128 * j + 16 * c8 + 2 * pi;
    const bf16* H = (const bf16*)(p.ws + WS_H) + colo; bf16* OUT = (bf16*)(p.ws + WS_YB) + colo;
    const int* IDXg = (const int*)(p.ws + WS_IDX) + 16 * g; const float* COEFg = (const float*)(p.ws + WS_COEF) + 16 * g;
    const unsigned char* VS = p.ws + WS_V8 + (size_t)j * NEXP * 128 + 16 * c8;
    float* SSQ = (float*)(p.ws + WS_SSQ) + (size_t)j * T_;
    const int m0 = chunk * 8 + wave, ntok = (T_ - m0 + stride - 1) / stride;
#define PV_CLAMP(k) (m0 + ((k) < ntok ? (k) : ntok - 1) * stride)
#define PV_ROWS(vr, q) _Pragma("unroll") for (int i = 0; i < 16; ++i) vr[i] = *(const v4u*)(VS + (size_t)q.ei[i >> 2][i & 3] * 128)
    PvPre q; v4u vrA[16], vrB[16];
    pv_level1(q, IDXg, COEFg, m0, c8);
    PV_ROWS(vrA, q);
    float cA0 = q.c0, cA1 = q.c1, cB0, cB1;
    pv_level1(q, IDXg, COEFg, PV_CLAMP(1), c8);
    for (int k = 0; k < ntok; k += 2) {
        PV_ROWS(vrB, q); cB0 = q.c0; cB1 = q.c1;
        pv_level1(q, IDXg, COEFg, PV_CLAMP(k + 2), c8);
        { const size_t mm = (size_t)(m0 + k * stride); peer_v_token(vrA, cA0, cA1, H + mm * 1024, OUT + mm * 1024, SSQ + mm, b3, b4, b5, lane); }
        if (k + 1 < ntok) {
            PV_ROWS(vrA, q); cA0 = q.c0; cA1 = q.c1;
            pv_level1(q, IDXg, COEFg, PV_CLAMP(k + 3), c8);
            { const size_t mm = (size_t)(m0 + (k + 1) * stride); peer_v_token(vrB, cB0, cB1, H + mm * 1024, OUT + mm * 1024, SSQ + mm, b3, b4, b5, lane); }
        }
    }
#undef PV_CLAMP
#undef PV_ROWS
}
__device__ __forceinline__ void peer_f(const P& p, int wave, int lane) {
    const int gw = blockIdx.x * NWAVES + wave, NGW = gridDim.x * NWAVES;
    const float* SSQ = (const float*)(p.ws + WS_SSQ);
    for (int m = gw; m < T_; m += NGW) {
        float ss = 0.f;
#pragma unroll
        for (int jj = 0; jj < 8; ++jj) ss += SSQ[(size_t)jj * T_ + m];
        const float rstd = frsq(ss * (1.f / 1024.f) + EPS);
        f32x4* o = (f32x4*)(p.out + (size_t)m * 1024) + lane; const f32x4* wr = (const f32x4*)p.norm_final_w + lane;
        const v2u* yb = (const v2u*)((const bf16*)(p.ws + WS_YB) + (size_t)m * 1024) + lane;
#pragma unroll
        for (int q = 0; q < 4; ++q) { const v2u yv = yb[64 * q]; const f32x4 w = wr[64 * q];
            o[64 * q] = (f32x4){bflo(yv.x) * rstd * w.x, bfhi(yv.x) * rstd * w.y, bflo(yv.y) * rstd * w.z, bfhi(yv.y) * rstd * w.w}; }
    }
}

constexpr int N_PHASES = 12;
struct Args { P p; int ph_lo, ph_hi; };
__global__ void __launch_bounds__(NTHR, 2) fwd_kernel(Args args) {
    extern __shared__ __attribute__((aligned(16))) unsigned char lds_raw[];
    LAS unsigned char* lds = (LAS unsigned char*)lds_raw;
    const P& p = args.p;
    const int tid = threadIdx.x, lane = tid & 63, wave = __builtin_amdgcn_readfirstlane(tid >> 6);
    volatile LAS unsigned* MISC = (volatile LAS unsigned*)(lds + MISC_OFF);
    for (int u = tid; u < (LDS_BYTES - LDSCTL_OFF) / 4; u += NTHR) ((LAS unsigned*)(lds + LDSCTL_OFF))[u] = 0u;
    __syncthreads();
    XcdBarrier bar; bar.bar = (unsigned*)(p.ws + WS_CTL) + CW_BAR; bar.x = 0; bar.st = nullptr;
#if !MK_PER_PHASE
    bar = xcd_barrier_post((unsigned*)(p.ws + WS_CTL) + CW_BAR, MISC + 8);
#endif
    const int lo = args.ph_lo, hi = args.ph_hi;
#define IN(k) (lo <= (k) && (k) < hi)
#ifndef PROBE_WAIT_LO
#define PROBE_WAIT_LO -1
#define PROBE_WAIT_HI -1
#endif
    volatile LAS unsigned long long* STAMP = (volatile LAS unsigned long long*)(lds + MISC_OFF + 256);
#define SEAM(k) do { if (IN(k) && IN((k) + 1)) xcd_barrier(bar); if (PROBE_WAIT_LO >= 0 && blockIdx.x == 0 && tid == 0) { STAMP[(k) + 1] = __builtin_amdgcn_s_memrealtime(); \
        if ((k) + 1 == N_PHASES - 1) { const unsigned long long d_ = STAMP[PROBE_WAIT_HI < 0 ? 0 : PROBE_WAIT_HI] - STAMP[PROBE_WAIT_LO < 0 ? 0 : PROBE_WAIT_LO]; \
            __hip_atomic_store((unsigned*)(p.ws + WS_CTL) + CW_Q + 256, (unsigned)d_ | 1u, __ATOMIC_RELAXED, __HIP_MEMORY_SCOPE_AGENT); } } } while (0)
    if (PROBE_WAIT_LO >= 0 && blockIdx.x == 0 && tid == 0) STAMP[0] = __builtin_amdgcn_s_memrealtime();

#ifndef PROBE_REP
#define PROBE_REP -1
#endif
#define REP(k) ((PROBE_REP == (k)) ? 2 : 1)
    if (IN(0)) {
#pragma unroll 1
        for (int r = 0; r < REP(0); ++r) p0_prologue(p, lds, wave, lane); } SEAM(0);
    if (IN(1)) {
#pragma unroll 1
      for (int r = 0; r < REP(1); ++r) {
        EpiProj e{(bf16*)(p.ws + WS_SBQKV), (bf16*)(p.ws + WS_VT), (bf16*)(p.ws + WS_MLQK), (bf16*)(p.ws + WS_MLV), (bf16*)(p.ws + WS_MLO), (bf16*)(p.ws + WS_GATES)};
        gemm<EpiProj>(lds, (const bf16*)(p.ws + WS_XN), (const bf16*)(p.ws + WS_W1T), T_, NPROJ, 1024, e); }
    } SEAM(1);
    if (IN(2)) { p2_conv(p, tid); } SEAM(2);
    if (IN(3)) {
        for (int it = blockIdx.x; it < 64; it += gridDim.x) mlstm_item(p, lds, it, tid, wave, lane);
        unsigned* qctr = (unsigned*)(p.ws + WS_CTL) + CW_Q;
#ifdef PROBE_P3SPLIT
        xcd_barrier(bar); if (blockIdx.x == 0 && tid == 0) STAMP[20] = __builtin_amdgcn_s_memrealtime();
#endif
        for (;;) {
            if (tid == 0) MISC[12] = __hip_atomic_fetch_add(qctr, 1u, __ATOMIC_RELAXED, __HIP_MEMORY_SCOPE_AGENT);
            __syncthreads();
            const unsigned it = MISC[12];
            __syncthreads();
            if (it >= 1024u) break;
            sba_item(p, (int)it, wave, lane);
        }
#ifdef PROBE_P3SPLIT
        xcd_barrier(bar); if (blockIdx.x == 0 && tid == 0) STAMP[21] = __builtin_amdgcn_s_memrealtime();
#endif
        for (;;) {
            if (tid == 0) MISC[12] = __hip_atomic_fetch_add(qctr + 128, 1u, __ATOMIC_RELAXED, __HIP_MEMORY_SCOPE_AGENT);
            __syncthreads();
            const unsigned it = MISC[12];
            __syncthreads();
            if (it >= (unsigned)N_FILL) break;
            fill_item(p, (int)it, wave, lane);
        }
    } SEAM(3);
    if (IN(4)) { p3_yml(p, wave, lane); } SEAM(4);
    if (IN(5)) {
        pg8::Gemm g{(const bf16*)p.out, (const bf16*)(p.ws + WS_WSBT), T_, 1024, 1024}; pg8::StaticOrder S; S.init(T_, 1024, (int)gridDim.x, (int)blockIdx.x);
        EpiMerge1 e{(bf16*)(p.ws + WS_MERGED), (const unsigned char*)(p.ws + WS_GATES)};
        pg8::gemm_phase<EpiMerge1, pg8::StaticOrder, true, true, true>(lds, g, S, e);
    } SEAM(5);
    if (IN(6)) {
        pg8::Gemm g{(const bf16*)(p.ws + WS_MERGED), (const bf16*)(p.ws + WS_WOUTT), T_, 1024, 1024}; pg8::StaticOrder S; S.init(T_, 1024, (int)gridDim.x, (int)blockIdx.x);
        EpiHW e{(bf16*)(p.ws + WS_H), p.x, (bf16*)p.out  , p.norm_ffn_w, (float*)(p.ws + WS_SS)};
        pg8::gemm_phase<EpiHW, pg8::StaticOrder, true, true>(lds, g, S, e);
    } SEAM(6);
    if (IN(7)) {
        pg8::Gemm g{(const bf16*)p.out, (const bf16*)(p.ws + WS_WCT), T_, 2048, 1024}; pg8::StaticOrder S; S.init(T_, 2048, (int)gridDim.x, (int)blockIdx.x);
        EpiTopk e{(int*)(p.ws + WS_IDX), (float*)(p.ws + WS_GATE), (const float*)(p.ws + WS_SS)};
#pragma unroll 1
        for (int i = 0;; ++i) { OneUnit s1; if (!S.next(i, s1.u)) break; pg8::gemm_phase<EpiTopk, OneUnit, false, true>(lds, g, s1, e); }
    } SEAM(7);
    if (IN(8)) { peer_u(p, wave, lane); } SEAM(8);
    if (IN(9)) { peer_c(p, wave, lane); } SEAM(9);
    if (IN(10)) { peer_v(p, wave, lane); } SEAM(10);
    if (IN(11)) { peer_f(p, wave, lane); }
    if (PROBE_WAIT_LO >= 0 && tid == 0) {
        unsigned* pw = (unsigned*)(p.ws + WS_CTL) + CW_Q + 256;
        unsigned dt = 0u;
        for (unsigned sp = 0; sp < (1u << 22); ++sp) { dt = __hip_atomic_load(pw, __ATOMIC_RELAXED, __HIP_MEMORY_SCOPE_AGENT); if (dt) break; __builtin_amdgcn_s_sleep(8); }
        const unsigned long long tend = __builtin_amdgcn_s_memrealtime();
        while (__builtin_amdgcn_s_memrealtime() - tend < (unsigned long long)dt) __builtin_amdgcn_s_sleep(8);
    }
#undef IN
#undef SEAM
}

extern "C" void kernel_launch(void* const* d_in, const int* in_sizes, int n_in, void* d_out, int out_size, void* d_ws, size_t ws_size, hipStream_t stream) {
    static int grid = 0;
    if (grid == 0) {
        if (n_in != 18 || in_sizes[0] != T_ * D_ || out_size != T_ * D_ || ws_size < WS_END) {
            fprintf(stderr, "kernel_launch: unexpected problem (n_in %d, in0 %d, out %d, ws %zu); nothing launched\n", n_in, n_in > 0 ? in_sizes[0] : -1, out_size, ws_size); grid = -1; return; }
        int dev = 0, cus = 0, per_cu = 0;
        if (hipGetDevice(&dev) != hipSuccess || hipDeviceGetAttribute(&cus, hipDeviceAttributeMultiprocessorCount, dev) != hipSuccess) { grid = -1; return; }
        if (hipFuncSetAttribute((const void*)fwd_kernel, hipFuncAttributeMaxDynamicSharedMemorySize, LDS_BYTES) != hipSuccess) { fprintf(stderr, "kernel_launch: hipFuncSetAttribute failed\n"); grid = -1; return; }
        if (hipOccupancyMaxActiveBlocksPerMultiprocessor(&per_cu, (const void*)fwd_kernel, NTHR, LDS_BYTES) != hipSuccess || per_cu < 1)
            fprintf(stderr, "kernel_launch: note: occupancy query reports %d workgroups per CU\n", per_cu);
        (void)hipGetLastError();
        grid = cus;
    }
    if (grid < 0) return;
    if (hipMemsetAsync((char*)d_ws + WS_CTL, 0, CTL_ZERO_BYTES, stream) != hipSuccess) { fprintf(stderr, "kernel_launch: memset failed\n"); return; }
    Args a{};
    const float** pp = (const float**)&a.p;
    for (int i = 0; i < 18; ++i) pp[i] = (const float*)d_in[i];
    a.p.out = (float*)d_out; a.p.ws = (unsigned char*)d_ws;
#if MK_PER_PHASE
    for (int ph = 0; ph < N_PHASES; ++ph) {
        a.ph_lo = ph; a.ph_hi = ph + 1;
        hipLaunchKernelGGL(fwd_kernel, dim3(grid), dim3(NTHR), LDS_BYTES, stream, a);
    }
#else
    a.ph_lo = 0; a.ph_hi = N_PHASES;
    hipLaunchKernelGGL(fwd_kernel, dim3(grid), dim3(NTHR), LDS_BYTES, stream, a);
#endif
    const hipError_t le = hipPeekAtLastError();
    if (le != hipSuccess) fprintf(stderr, "kernel_launch: launch failed: %s\n", hipGetErrorName(le));
}
```

```cpp
#include <hip/hip_runtime.h>
#include <cstdio>
#include <cstdint>
namespace pg8 {
#define PG8_LAS __attribute__((address_space(3)))
typedef unsigned short bf16_t;
typedef short bf16x8 __attribute__((ext_vector_type(8)));
typedef float f32x4 __attribute__((ext_vector_type(4)));
typedef unsigned u32x4 __attribute__((ext_vector_type(4)));
constexpr int BM = 256, BK = 64, HALF = 128, HTB = HALF * BK * 2  , STAGE_BYTES = 8 * HTB, NXCD = 8, WGM = 8;

__host__ __device__ __forceinline__ int lds_byte(int r, int c) { const int st = (r >> 4) * 2 + (c >> 5), rr = r & 15, cc = c & 31, ob = rr * 64 + cc * 2; return st * 1024 + (ob ^ (((ob >> 9) & 1) << 5)); }
__host__ __device__ __forceinline__ void stage_rc(int b, int& R, int& C) { const int st = b / 1024, sb = b % 1024, swz = sb ^ (((sb >> 9) & 1) << 5); R = (st >> 1) * 16 + swz / 64; C = (st & 1) * 32 + (swz % 64) / 2; }
__host__ __device__ __forceinline__ int perm32(int rho) { const int n = rho >> 4, i = rho & 15; return 8 * (i >> 2) + 4 * n + (i & 3); }

struct Unit { int pm, pn; };
struct Gemm { const bf16_t* A; const bf16_t* Bt; int M, N, K; };

struct StaticOrder {
    int nM, nN, nwg, G, c;
    __host__ __device__ void init(int M, int N, int G_, int c_) { nM = M / BM; nN = N / BM; nwg = nM * nN; G = G_; c = c_; }
    __host__ __device__ bool next(int i, Unit& u) const {
        const long L = (long)i * G + c; if (L >= nwg) return false;
        int wgid = (int)L; { const int q = nwg / NXCD, r = nwg % NXCD, xcd = wgid % NXCD, off = wgid / NXCD; wgid = (xcd < r ? xcd * (q + 1) : r * (q + 1) + (xcd - r) * q) + off; }
        const int nig = WGM * nN, gid = wgid / nig, fm = gid * WGM, gsz = (nM - fm) < WGM ? (nM - fm) : WGM;
        u.pm = fm + ((wgid % nig) % gsz); u.pn = (wgid % nig) / gsz; return true;
    }
    __device__ __forceinline__ void a_ready(const Unit&) const {}
    __device__ __forceinline__ void done(const Unit&) const {}
};

__device__ __forceinline__ unsigned cvt_pk_bf16(float lo, float hi) { unsigned r; asm volatile("v_cvt_pk_bf16_f32 %0, %1, %2" : "=v"(r) : "v"(lo), "v"(hi)); return r; }
template <class Epi, class Sched, bool ALIGN_EPI = false, bool SP2 = false, bool MID = false  >
__device__ __forceinline__ void gemm_phase(PG8_LAS unsigned char* lds, const Gemm g, const Sched& S, const Epi& E) {
    const int tid = threadIdx.x, wid = __builtin_amdgcn_readfirstlane(tid >> 6), lane = tid & 63, wr = wid >> 2, wc = wid & 3, fr = lane & 15, fq = lane >> 4;
    const int K = g.K, nt = K / BK;
    unsigned voffA[2], voffB[2];
#pragma unroll
    for (int i = 0; i < 2; ++i) { int R, C; stage_rc(tid * 16 + i * 8192, R, C); const int Rb = Epi::PERM ? ((R & ~31) + perm32(R & 31)) : R;
        voffA[i] = (unsigned)(R * K + C) * 2u; voffB[i] = (unsigned)(Rb * K + C) * 2u; }
    const size_t kstep = (size_t)(BK * 2);
    const size_t hstep = (size_t)HALF * K * 2;
    const size_t tstep = 2 * hstep;
    const unsigned ldsw = (unsigned)wid * 1024u;
    const int aoff = lds_byte(wr * 64 + fr, fq * 8), boff = lds_byte(wc * 32 + fr, fq * 8);
#define PG8_SA(b, h) (((b) * 2 + (h)) * HTB)
#define PG8_SB(b, h) ((4 + (b) * 2 + (h)) * HTB)
#define PG8_STAGE(bufoff, gbase, voff) do { _Pragma("unroll") for (int _i = 0; _i < 2; ++_i) \
        __builtin_amdgcn_global_load_lds((const unsigned*)((const char*)(gbase) + (voff)[_i]), (PG8_LAS unsigned*)(lds + (bufoff) + ldsw + _i * 8192), 16, 0, 0); } while (0)
#define PG8_LDA(dst, b, h) do { _Pragma("unroll") for (int m = 0; m < 4; ++m) _Pragma("unroll") for (int k = 0; k < 2; ++k) dst[m][k] = *(const PG8_LAS bf16x8*)(lds + PG8_SA(b, h) + aoff + m * 2048 + k * 1024); } while (0)
#define PG8_LDB(dst, b, h) do { _Pragma("unroll") for (int n = 0; n < 2; ++n) _Pragma("unroll") for (int k = 0; k < 2; ++k) dst[n][k] = *(const PG8_LAS bf16x8*)(lds + PG8_SB(b, h) + boff + n * 2048 + k * 1024); } while (0)
#define PG8_MMA(ai, bj, At, Bt) do { __builtin_amdgcn_s_setprio(1); _Pragma("unroll") for (int m = 0; m < 4; ++m) _Pragma("unroll") for (int n = 0; n < 2; ++n) _Pragma("unroll") for (int k = 0; k < 2; ++k) \
        acc[ai][bj][m][n] = __builtin_amdgcn_mfma_f32_16x16x32_bf16(Bt[n][k], At[m][k], acc[ai][bj][m][n], 0, 0, 0); __builtin_amdgcn_s_setprio(0); } while (0)
#define PG8_WAIT_V(n) asm volatile("s_waitcnt vmcnt(" #n ")" ::: "memory")
#define PG8_WAIT_L(n) asm volatile("s_waitcnt lgkmcnt(" #n ")" ::: "memory")
#define PG8_BAR __builtin_amdgcn_s_barrier()
#define PG8_SCHED __builtin_amdgcn_sched_barrier(0)
    Unit cur, nxt; int ui = 0;
    if (!S.next(0, cur)) return;
    f32x4 acc[2][2][4][2];
#pragma unroll
    for (int a = 0; a < 2; ++a)
#pragma unroll
        for (int b = 0; b < 2; ++b)
#pragma unroll
            for (int m = 0; m < 4; ++m)
#pragma unroll
                for (int n = 0; n < 2; ++n) acc[a][b][m][n] = (f32x4){0.f, 0.f, 0.f, 0.f};
    bf16x8 At[4][2], B0[2][2], B1[2][2];
    const char* cA = (const char*)g.A + (size_t)cur.pm * tstep; const char* cB = (const char*)g.Bt + (size_t)cur.pn * tstep;
    S.a_ready(cur);
    if constexpr (SP2) {
        PG8_STAGE(PG8_SB(0, 0), cB, voffB); PG8_STAGE(PG8_SB(0, 1), cB + hstep, voffB); PG8_STAGE(PG8_SA(0, 0), cA, voffA); PG8_STAGE(PG8_SA(0, 1), cA + hstep, voffA);
        if (wr == 1) PG8_BAR;
        PG8_WAIT_V(2); PG8_BAR;
        PG8_STAGE(PG8_SB(1, 0), cB + kstep, voffB); PG8_STAGE(PG8_SA(1, 0), cA + kstep, voffA); PG8_STAGE(PG8_SB(1, 1), cB + hstep + kstep, voffB);
        PG8_WAIT_V(6); PG8_BAR;
    } else {
        PG8_STAGE(PG8_SB(0, 0), cB, voffB); PG8_STAGE(PG8_SA(0, 0), cA, voffA); PG8_STAGE(PG8_SB(0, 1), cB + hstep, voffB); PG8_STAGE(PG8_SA(0, 1), cA + hstep, voffA);
        if (wr == 1) PG8_BAR;
        PG8_WAIT_V(4); PG8_BAR;
        PG8_STAGE(PG8_SB(1, 0), cB + kstep, voffB); PG8_STAGE(PG8_SA(1, 0), cA + kstep, voffA); PG8_STAGE(PG8_SB(1, 1), cB + hstep + kstep, voffB);
        PG8_WAIT_V(6); PG8_BAR;
    }
    for (;;) {
        const bool has_next = S.next(ui + 1, nxt);
        const char* nA = has_next ? (const char*)g.A + (size_t)nxt.pm * tstep : cA; const char* nB = has_next ? (const char*)g.Bt + (size_t)nxt.pn * tstep : cB;
        for (int t = 0; t < nt; t += 2) {
            if constexpr (MID) { if (t == (nt >> 1)) E.mid(acc, cur, wr, wc, fr, fq); }
            const bool last = (t == nt - 2);
            const char* a1 = cA + (size_t)(t + 1) * kstep;
            const char* a2 = last ? nA : cA + (size_t)(t + 2) * kstep; const char* b2 = last ? nB : cB + (size_t)(t + 2) * kstep;
            const char* a3 = a2 + kstep; const char* b3 = b2 + kstep;
            if (last && has_next) S.a_ready(nxt);
            if constexpr (SP2) {
            PG8_LDB(B0, 0, 0); PG8_LDB(B1, 0, 1); PG8_SCHED; PG8_LDA(At, 0, 0); PG8_STAGE(PG8_SA(1, 1), a1 + hstep, voffA);
            PG8_WAIT_V(8); PG8_WAIT_L(0); PG8_BAR; PG8_MMA(0, 0, At, B0); PG8_MMA(0, 1, At, B1); PG8_BAR; PG8_SCHED;
            PG8_LDA(At, 0, 1); PG8_STAGE(PG8_SB(0, 0), b2, voffB); PG8_STAGE(PG8_SB(0, 1), b2 + hstep, voffB); PG8_STAGE(PG8_SA(0, 0), a2, voffA);
            PG8_WAIT_V(8); PG8_WAIT_L(0); PG8_BAR; PG8_MMA(1, 0, At, B0); PG8_MMA(1, 1, At, B1); PG8_BAR; PG8_SCHED;
            PG8_LDB(B0, 1, 0); PG8_LDB(B1, 1, 1); PG8_SCHED; PG8_LDA(At, 1, 0); PG8_STAGE(PG8_SA(0, 1), a2 + hstep, voffA);
            PG8_WAIT_V(8); PG8_WAIT_L(0); PG8_BAR; PG8_MMA(0, 0, At, B0); PG8_MMA(0, 1, At, B1); PG8_BAR; PG8_SCHED;
            PG8_LDA(At, 1, 1); PG8_STAGE(PG8_SB(1, 0), b3, voffB); PG8_STAGE(PG8_SB(1, 1), b3 + hstep, voffB); PG8_STAGE(PG8_SA(1, 0), a3, voffA);
            PG8_WAIT_V(8); PG8_WAIT_L(0); PG8_BAR; PG8_MMA(1, 0, At, B0); PG8_MMA(1, 1, At, B1); PG8_BAR; PG8_SCHED;
            } else {
            PG8_LDB(B0, 0, 0); PG8_SCHED; PG8_LDA(At, 0, 0); PG8_STAGE(PG8_SA(1, 1), a1 + hstep, voffA);
            PG8_WAIT_L(8); PG8_BAR; PG8_WAIT_L(0); PG8_MMA(0, 0, At, B0); PG8_BAR; PG8_SCHED;
            PG8_LDB(B1, 0, 1); PG8_STAGE(PG8_SB(0, 0), b2, voffB);
            PG8_BAR; PG8_WAIT_L(0); PG8_MMA(0, 1, At, B1); PG8_BAR;
            PG8_LDA(At, 0, 1); PG8_STAGE(PG8_SA(0, 0), a2, voffA);
            PG8_BAR; PG8_WAIT_L(0); PG8_MMA(1, 0, At, B0); PG8_BAR; PG8_SCHED;
            PG8_STAGE(PG8_SB(0, 1), b2 + hstep, voffB);
            PG8_WAIT_V(6); PG8_BAR; PG8_MMA(1, 1, At, B1); PG8_BAR;
            PG8_LDB(B0, 1, 0); PG8_SCHED; PG8_LDA(At, 1, 0); PG8_STAGE(PG8_SA(0, 1), a2 + hstep, voffA);
            PG8_WAIT_L(8); PG8_BAR; PG8_WAIT_L(0); PG8_MMA(0, 0, At, B0); PG8_BAR; PG8_SCHED;
            PG8_LDB(B1, 1, 1); PG8_STAGE(PG8_SB(1, 0), b3, voffB);
            PG8_BAR; PG8_WAIT_L(0); PG8_MMA(0, 1, At, B1); PG8_BAR;
            PG8_LDA(At, 1, 1); PG8_STAGE(PG8_SA(1, 0), a3, voffA);
            PG8_BAR; PG8_WAIT_L(0); PG8_MMA(1, 0, At, B0); PG8_BAR; PG8_SCHED;
            PG8_STAGE(PG8_SB(1, 1), b3 + hstep, voffB);
            PG8_WAIT_V(6); PG8_BAR; PG8_MMA(1, 1, At, B1); PG8_BAR;
            }
        }
        if constexpr (ALIGN_EPI) { if (wr == 0) PG8_BAR; }
        if constexpr (!Epi::AFTER_DRAIN) { E(acc, cur, wr, wc, fr, fq); S.done(cur); }
        if (!has_next) break;
#pragma unroll
        for (int a = 0; a < 2; ++a)
#pragma unroll
            for (int b = 0; b < 2; ++b)
#pragma unroll
                for (int m = 0; m < 4; ++m)
#pragma unroll
                    for (int n = 0; n < 2; ++n) acc[a][b][m][n] = (f32x4){0.f, 0.f, 0.f, 0.f};
        cur = nxt; cA = nA; cB = nB; ++ui;
        if constexpr (ALIGN_EPI) { if (wr == 1) PG8_BAR; }
    }
    PG8_WAIT_V(0);
    if constexpr (!ALIGN_EPI) { if (wr == 0) PG8_BAR; }
    PG8_BAR;
    if constexpr (Epi::AFTER_DRAIN) { E.fused(acc, cur, wr, wc, fr, fq, lds, wid, lane); S.done(cur); }
#undef PG8_SA
#undef PG8_SB
#undef PG8_STAGE
#undef PG8_LDA
#undef PG8_LDB
#undef PG8_MMA
#undef PG8_WAIT_V
#undef PG8_WAIT_L
#undef PG8_BAR
#undef PG8_SCHED
}
}

#ifndef MK_PER_PHASE
#define MK_PER_PHASE 0
#endif
#ifndef USE_PG8
#define USE_PG8 1
#endif
constexpr int NWAVES = 8, NTHR = 512;

constexpr int B_ = 16, S_ = 2048, D_ = 1024, T_ = B_ * S_;
constexpr int INC = 5640, NPROJ = 5632;
constexpr int NEXP = 16384;
constexpr float EPS = 1e-6f;

constexpr size_t MiB = 1u << 20;
constexpr size_t WS_CTL = 0, CTL_ZERO_BYTES = 1 * MiB;
constexpr size_t WS_W1T = 2 * MiB, WS_WSBT = 13 * MiB, WS_WMLT = 14 * MiB, WS_WOUTT = 15 * MiB, WS_WCT = 17 * MiB, WS_IFG = 21 * MiB;
constexpr size_t WS_U8 = 24 * MiB, WS_V8 = 40 * MiB, WS_USC = 22 * MiB, WS_VSC = 23 * MiB;
constexpr size_t WS_XN = 88 * MiB, WS_QC = 88 * MiB, WS_KC = 120 * MiB;
constexpr size_t WS_SBQKV = 152 * MiB  , WS_VT = 216 * MiB  , WS_MLQK = 248 * MiB, WS_MLV = 312 * MiB, WS_MLO = 344 * MiB, WS_GATES = 376 * MiB;
constexpr size_t WS_MERGED = 216 * MiB, WS_H = 88 * MiB, WS_HN = 216 * MiB, WS_IDX = 280 * MiB, WS_GATE = 296 * MiB, WS_SC = 312 * MiB;
constexpr size_t WS_PART = 312 * MiB  , WS_SSQ = 504 * MiB  , WS_COEF = 56 * MiB  , WS_YB = 152 * MiB  , WS_HN8 = 440 * MiB  , WS_XS = 505 * MiB  , WS_SS = 506 * MiB  ;
constexpr size_t WS_END = 508 * MiB;
constexpr int CW_BAR = 4096, CW_Q = 8192;

constexpr int RING_OFF = 0, RING_BYTES = 135168;
constexpr int LDSCTL_OFF = RING_BYTES, MISC_OFF = LDSCTL_OFF + 320;
constexpr int LDS_BYTES = 147456;

#define GAS __attribute__((address_space(1)))
#define LAS __attribute__((address_space(3)))
typedef unsigned short bf16;
typedef unsigned v4u __attribute__((ext_vector_type(4)));
typedef unsigned v2u __attribute__((ext_vector_type(2)));
typedef float f32x4 __attribute__((ext_vector_type(4)));
#define LDS_WAIT() asm volatile("s_waitcnt lgkmcnt(0)" ::: "memory")
#define VM_WAIT() asm volatile("s_waitcnt vmcnt(0)" ::: "memory")
typedef float f32x2_t __attribute__((ext_vector_type(2))); typedef __bf16 bf16x2_t __attribute__((ext_vector_type(2)));
__device__ __forceinline__ unsigned cvtpk(float lo, float hi) { f32x2_t v = {lo, hi}; bf16x2_t b = __builtin_convertvector(v, bf16x2_t); return __builtin_bit_cast(unsigned, b); }
__device__ __forceinline__ unsigned f2bf(float f) { return cvtpk(f, f) & 0xffffu; }
__device__ __forceinline__ unsigned pk2(float lo, float hi) { return cvtpk(lo, hi); }
__device__ __forceinline__ float bflo(unsigned u) { return __builtin_bit_cast(float, u << 16); }
__device__ __forceinline__ float bfhi(unsigned u) { return __builtin_bit_cast(float, u & 0xffff0000u); }
__device__ __forceinline__ float bf2f(bf16 b) { return __builtin_bit_cast(float, (unsigned)b << 16); }
__device__ __forceinline__ float fexp(float x) { return __builtin_amdgcn_exp2f(x * 1.4426950408889634f); }
__device__ __forceinline__ float flog(float x) { return __builtin_amdgcn_logf(x) * 0.6931471805599453f; }
__device__ __forceinline__ float frcp(float x) { return __builtin_amdgcn_rcpf(x); }
__device__ __forceinline__ float frsq(float x) { return __builtin_amdgcn_rsqf(x); }
__device__ __forceinline__ float sigmoidf_(float x) { return frcp(1.f + fexp(-x)); }
__device__ __forceinline__ float wave_sum(float v) {
#pragma unroll
    for (int o = 1; o < 64; o <<= 1) v += __shfl_xor(v, o);
    return v;
}
__device__ __forceinline__ unsigned wave_max_u(unsigned v) {
#pragma unroll
    for (int o = 1; o < 64; o <<= 1) { const unsigned w = (unsigned)__shfl_xor((int)v, o); v = v > w ? v : w; }
    return v;
}
struct F8 { float v[8]; };
__device__ __forceinline__ void unpack8(const v4u& u, float (&f)[8]) {
    f[0] = bflo(u.x); f[1] = bfhi(u.x); f[2] = bflo(u.y); f[3] = bfhi(u.y); f[4] = bflo(u.z); f[5] = bfhi(u.z); f[6] = bflo(u.w); f[7] = bfhi(u.w);
}
__device__ __forceinline__ v4u pack8(const float (&f)[8]) { v4u o; o.x = pk2(f[0], f[1]); o.y = pk2(f[2], f[3]); o.z = pk2(f[4], f[5]); o.w = pk2(f[6], f[7]); return o; }

#define XB_TMO      128
#define XB_XCNT(j)  (256  + 64 * (j))
#define XB_XSUB(j)  (1280 + 64 * (j))
#define XB_XGEN(j)  (2304 + 64 * (j))
#define XB_TOP      3328
#define XB_TOPGEN   3392
#define XCD_BAR_WORDS 3456
#define XB_SPIN_CAP (1u << 24)

__device__ __forceinline__ unsigned xb_ld(unsigned* p)              { return __hip_atomic_load(p, __ATOMIC_RELAXED, __HIP_MEMORY_SCOPE_AGENT); }
__device__ __forceinline__ unsigned xb_add(unsigned* p, unsigned v) { return __hip_atomic_fetch_add(p, v, __ATOMIC_RELAXED, __HIP_MEMORY_SCOPE_AGENT); }
__device__ __forceinline__ unsigned xb_xcc_id() { return (unsigned)__builtin_amdgcn_s_getreg((3 << 11) | 20) & 0xFu; }
#define XB_SPIN(cond, bar) do { unsigned _sp = 0; while (cond) { __builtin_amdgcn_s_sleep(1); \
    if ((++_sp & 255u) == 0u) { if (xb_ld(&(bar)[XB_TMO])) break; if (_sp > XB_SPIN_CAP) { atomicAdd(&(bar)[XB_TMO], 1u); break; } } } } while (0)

struct XcdBarrier {
    unsigned* bar; unsigned x;
    volatile LAS unsigned* st;
};

__device__ __forceinline__ XcdBarrier xcd_barrier_post(unsigned* bar, volatile LAS unsigned* st) {
    XcdBarrier b; b.bar = bar; b.x = xb_xcc_id(); b.st = st;
    if (threadIdx.x == 0) (void)xb_add(&bar[XB_XCNT(b.x)], 1u);
    return b;
}
__device__ __forceinline__ void xcd_barrier_complete(unsigned* bar, unsigned x, unsigned& nloc, unsigned& nx) {
    const unsigned G = gridDim.x * gridDim.y * gridDim.z;
    unsigned sum, cnt, mine, sp = 0u;
    for (;;) {
        sum = 0u; cnt = 0u; mine = 0u;
#pragma unroll
        for (unsigned j = 0; j < 16; ++j) { const unsigned c = xb_ld(&bar[XB_XCNT(j)]); sum += c; cnt += (c > 0u) ? 1u : 0u; mine = (j == x) ? c : mine; }
        if (sum == G) break;
        __builtin_amdgcn_s_sleep(1);
        if ((++sp & 255u) == 0u) { if (xb_ld(&bar[XB_TMO])) break; if (sp > XB_SPIN_CAP) { atomicAdd(&bar[XB_TMO], 1u); break; } }
    }
    nloc = mine > 0u ? mine : 1u; nx = cnt > 0u ? cnt : 1u;
}

__device__ __forceinline__ void xcd_barrier(const XcdBarrier& b) {
    asm volatile("s_waitcnt vmcnt(0)" ::: "memory");
    __syncthreads();
    if (threadIdx.x == 0) {
        unsigned* bar = b.bar;
        __builtin_amdgcn_s_waitcnt(0);
        unsigned nloc = b.st[0], nx = b.st[1];
        if (nloc == 0u) { xcd_barrier_complete(bar, b.x, nloc, nx); b.st[0] = nloc; b.st[1] = nx; }
        const unsigned old = xb_add(&bar[XB_XSUB(b.x)], 1u);
        const unsigned gen = old / nloc;
        if (old + 1u == (gen + 1u) * nloc) {
            __builtin_amdgcn_fence(__ATOMIC_RELEASE, "agent");
            asm volatile("s_waitcnt vmcnt(0)" ::: "memory");
            const unsigned og = xb_add(&bar[XB_TOP], 1u);
            const unsigned tg = og / nx;
            if (og + 1u == (tg + 1u) * nx) xb_add(&bar[XB_TOPGEN], 1u);
            else XB_SPIN(xb_ld(&bar[XB_TOPGEN]) == tg, bar);
            __builtin_amdgcn_fence(__ATOMIC_ACQUIRE, "agent");
            xb_add(&bar[XB_XGEN(b.x)], 1u);
            asm volatile("s_waitcnt vmcnt(0)" ::: "memory");
        } else {
            XB_SPIN(xb_ld(&bar[XB_XGEN(b.x)]) == gen, bar);
            __builtin_amdgcn_fence(__ATOMIC_ACQUIRE, "agent");
            asm volatile("s_waitcnt vmcnt(0)" ::: "memory");
        }
    }
    __syncthreads();
}

struct EpiProj {
    bf16 *sbqk, *vt, *mlqk, *mlv, *mlo, *gates;
    __device__ __forceinline__ void operator()(int row, int col, const F8& a) const {
        bf16* dst;
        if (col < 1024) dst = sbqk + (size_t)row * 1024 + col;
        else if (col < 1536) {
            const int c = col - 1024, hh = c >> 6, d = c & 63, b = row >> 11, sq = row & 2047;
            bf16* vp = vt + ((size_t)(b * 8 + hh) * 64 + d) * 2048 + sq;
#pragma unroll
            for (int i = 0; i < 8; ++i) vp[(size_t)i * 2048] = (bf16)f2bf(a.v[i]);
            return;
        }
        else if (col < 2560) dst = mlqk + (size_t)row * 1024 + (col - 1536);
        else if (col < 3072) dst = mlv + (size_t)row * 512 + (col - 2560);
        else if (col < 3584) dst = mlo + (size_t)row * 512 + (col - 3072);
        else {
            unsigned q[8];
#pragma unroll
            for (int i = 0; i < 8; ++i) { const float sg = sigmoidf_(a.v[i]) * 255.f + 0.5f; q[i] = (unsigned)fminf(fmaxf(sg, 1.f), 255.f); }
            *(v2u*)((unsigned char*)gates + (size_t)row * 2048 + (col - 3584)) = (v2u){q[0] | (q[1] << 8) | (q[2] << 16) | (q[3] << 24), q[4] | (q[5] << 8) | (q[6] << 16) | (q[7] << 24)};
            return;
        }
        *(v4u*)dst = pack8(a.v);
    }
};
struct EpiMergeA {
    bf16* merged; const bf16* gates;
    __device__ __forceinline__ void operator()(int row, int col, const F8& a) const {
        float g[8], o[8]; unpack8(*(const v4u*)(gates + (size_t)row * 2048 + col), g);
#pragma unroll
        for (int i = 0; i < 8; ++i) o[i] = sigmoidf_(g[i]) * a.v[i];
        *(v4u*)(merged + (size_t)row * 1024 + col) = pack8(o);
    }
};
struct EpiMergeB {
    bf16* merged; const bf16* gates;
    __device__ __forceinline__ void operator()(int row, int col, const F8& a) const {
        float g[8], o[8]; unpack8(*(const v4u*)(gates + (size_t)row * 2048 + 1024 + col), g);
        unpack8(*(const v4u*)(merged + (size_t)row * 1024 + col), o);
#pragma unroll
        for (int i = 0; i < 8; ++i) o[i] += sigmoidf_(g[i]) * a.v[i];
        *(v4u*)(merged + (size_t)row * 1024 + col) = pack8(o);
    }
};
struct EpiH {
    float* h; const float* x;
    __device__ __forceinline__ void operator()(int row, int col, const F8& a) const {
        const f32x4 x0 = *(const f32x4*)(x + (size_t)row * 1024 + col), x1 = *(const f32x4*)(x + (size_t)row * 1024 + col + 4);
        *(f32x4*)(h + (size_t)row * 1024 + col) = (f32x4){x0.x + a.v[0], x0.y + a.v[1], x0.z + a.v[2], x0.w + a.v[3]};
        *(f32x4*)(h + (size_t)row * 1024 + col + 4) = (f32x4){x1.x + a.v[4], x1.y + a.v[5], x1.z + a.v[6], x1.w + a.v[7]};
    }
};
struct EpiF32 {
    float* o; int ldc;
    __device__ __forceinline__ void operator()(int row, int col, const F8& a) const {
        *(f32x4*)(o + (size_t)row * ldc + col) = (f32x4){a.v[0], a.v[1], a.v[2], a.v[3]};
        *(f32x4*)(o + (size_t)row * ldc + col + 4) = (f32x4){a.v[4], a.v[5], a.v[6], a.v[7]};
    }
};

template <class E> struct EpiAdapt {
    static constexpr bool PERM = true, AFTER_DRAIN = false;
    E e;
    __device__ __forceinline__ void operator()(const pg8::f32x4 (&acc)[2][2][4][2], const pg8::Unit& u, int wr, int wc, int fr, int fq) const {
#pragma unroll
        for (int ai = 0; ai < 2; ++ai)
#pragma unroll
            for (int m = 0; m < 4; ++m) {
                const int row = u.pm * 256 + ai * 128 + wr * 64 + m * 16 + fr;
#pragma unroll
                for (int bj = 0; bj < 2; ++bj) {
                    const int col = u.pn * 256 + bj * 128 + wc * 32 + 8 * fq;
                    F8 a; const pg8::f32x4 v0 = acc[ai][bj][m][0], v1 = acc[ai][bj][m][1];
                    a.v[0] = v0[0]; a.v[1] = v0[1]; a.v[2] = v0[2]; a.v[3] = v0[3]; a.v[4] = v1[0]; a.v[5] = v1[1]; a.v[6] = v1[2]; a.v[7] = v1[3];
                    e(row, col, a);
                }
            }
    }
};

struct EpiMerge1 {
    static constexpr bool PERM = true, AFTER_DRAIN = false;
    bf16* merged; const unsigned char* gates;
    static __device__ __forceinline__ void ub8(const v2u& w, float (&f)[8]) {
        f[0] = (float)(w.x & 0xffu); f[1] = (float)((w.x >> 8) & 0xffu); f[2] = (float)((w.x >> 16) & 0xffu); f[3] = (float)(w.x >> 24);
        f[4] = (float)(w.y & 0xffu); f[5] = (float)((w.y >> 8) & 0xffu); f[6] = (float)((w.y >> 16) & 0xffu); f[7] = (float)(w.y >> 24);
    }
    __device__ __forceinline__ void mid(pg8::f32x4 (&acc)[2][2][4][2], const pg8::Unit& u, int wr, int wc, int fr, int fq) const {
#pragma unroll
        for (int ai = 0; ai < 2; ++ai)
#pragma unroll
            for (int m = 0; m < 4; ++m) {
                const int row = u.pm * 256 + ai * 128 + wr * 64 + m * 16 + fr;
#pragma unroll
                for (int bj = 0; bj < 2; ++bj) {
                    const int col = u.pn * 256 + bj * 128 + wc * 32 + 8 * fq;
                    float gs[8], gm[8]; ub8(*(const v2u*)(gates + (size_t)row * 2048 + col), gs); ub8(*(const v2u*)(gates + (size_t)row * 2048 + 1024 + col), gm);
#pragma unroll
                    for (int i = 0; i < 8; ++i) acc[ai][bj][m][i >> 2][i & 3] *= gs[i] * frcp(gm[i]);
                }
            }
    }
    __device__ __forceinline__ void operator()(const pg8::f32x4 (&acc)[2][2][4][2], const pg8::Unit& u, int wr, int wc, int fr, int fq) const {
#pragma unroll
        for (int ai = 0; ai < 2; ++ai)
#pragma unroll
            for (int m = 0; m < 4; ++m) {
                const int row = u.pm * 256 + ai * 128 + wr * 64 + m * 16 + fr;
#pragma unroll
                for (int bj = 0; bj < 2; ++bj) {
                    const int col = u.pn * 256 + bj * 128 + wc * 32 + 8 * fq;
                    float gm[8], o[8]; ub8(*(const v2u*)(gates + (size_t)row * 2048 + 1024 + col), gm);
#pragma unroll
                    for (int i = 0; i < 8; ++i) o[i] = gm[i] * (1.f / 255.f) * acc[ai][bj][m][i >> 2][i & 3];
                    *(v4u*)(merged + (size_t)row * 1024 + col) = pack8(o);
                }
            }
    }
};
struct EpiHW {
    static constexpr bool PERM = true, AFTER_DRAIN = false;
    bf16* h; const float* x; bf16* hw; const float* wffn; float* ss;
    __device__ __forceinline__ void operator()(const pg8::f32x4 (&acc)[2][2][4][2], const pg8::Unit& u, int wr, int wc, int fr, int fq) const {
#pragma unroll
        for (int ai = 0; ai < 2; ++ai)
#pragma unroll
            for (int m = 0; m < 4; ++m) {
                const int row = u.pm * 256 + ai * 128 + wr * 64 + m * 16 + fr;
                float sq = 0.f;
#pragma unroll
                for (int bj = 0; bj < 2; ++bj) {
                    const int col = u.pn * 256 + bj * 128 + wc * 32 + 8 * fq;
                    const size_t o = (size_t)row * 1024 + col;
                    const f32x4 x0 = *(const f32x4*)(x + o), x1 = *(const f32x4*)(x + o + 4);
                    const f32x4 w0 = *(const f32x4*)(wffn + col), w1 = *(const f32x4*)(wffn + col + 4);
                    const pg8::f32x4 v0 = acc[ai][bj][m][0], v1 = acc[ai][bj][m][1];
                    const f32x4 h0 = (f32x4){x0.x + v0[0], x0.y + v0[1], x0.z + v0[2], x0.w + v0[3]}, h1 = (f32x4){x1.x + v1[0], x1.y + v1[1], x1.z + v1[2], x1.w + v1[3]};
                    *(v4u*)(h + o) = (v4u){pk2(h0.x, h0.y), pk2(h0.z, h0.w), pk2(h1.x, h1.y), pk2(h1.z, h1.w)};
                    *(v4u*)(hw + o) = (v4u){pk2(h0.x * w0.x, h0.y * w0.y), pk2(h0.z * w0.z, h0.w * w0.w), pk2(h1.x * w1.x, h1.y * w1.y), pk2(h1.z * w1.z, h1.w * w1.w)};
                    sq += (h0.x * h0.x + h0.y * h0.y) + (h0.z * h0.z + h0.w * h0.w) + (h1.x * h1.x + h1.y * h1.y) + (h1.z * h1.z + h1.w * h1.w);
                }
                sq += __shfl_xor(sq, 16); sq += __shfl_xor(sq, 32);
                if (fq == 0) ss[(size_t)row * 16 + u.pn * 4 + wc] = sq;
            }
    }
};

template <class E>
__device__ __forceinline__ void simple_gemm(LAS unsigned char* lds, const bf16* A, const bf16* Bt, int M, int N, int K, const E& e) {
    LAS float* As = (LAS float*)lds;
    LAS float* Bs = As + 32 * 132;
    const int tid = threadIdx.x, ty = tid >> 4, tx = tid & 15;
    const int ntn = N / 128, ntiles = (M / 128) * ntn;
    for (int tile = blockIdx.x; tile < ntiles; tile += gridDim.x) {
        const int tm = tile / ntn, tn = tile % ntn;
        float acc[4][8];
#pragma unroll
        for (int i = 0; i < 4; ++i)
#pragma unroll
            for (int j = 0; j < 8; ++j) acc[i][j] = 0.f;
        for (int k0 = 0; k0 < K; k0 += 32) {
            {
                const int r = tid >> 2, kq = (tid & 3) * 8;
                float fa[8], fb[8];
                unpack8(*(const v4u*)(A + (size_t)(tm * 128 + r) * K + k0 + kq), fa);
                unpack8(*(const v4u*)(Bt + (size_t)(tn * 128 + r) * K + k0 + kq), fb);
#pragma unroll
                for (int i = 0; i < 8; ++i) { As[(kq + i) * 132 + r] = fa[i]; Bs[(kq + i) * 132 + r] = fb[i]; }
            }
            __syncthreads();
#pragma unroll 8
            for (int k = 0; k < 32; ++k) {
                const f32x4 a4 = *(const LAS f32x4*)(As + k * 132 + ty * 4);
                const f32x4 b0 = *(const LAS f32x4*)(Bs + k * 132 + tx * 8), b1 = *(const LAS f32x4*)(Bs + k * 132 + tx * 8 + 4);
                const float av[4] = {a4.x, a4.y, a4.z, a4.w};
                const float bv[8] = {b0.x, b0.y, b0.z, b0.w, b1.x, b1.y, b1.z, b1.w};
#pragma unroll
                for (int i = 0; i < 4; ++i)
#pragma unroll
                    for (int j = 0; j < 8; ++j) acc[i][j] += av[i] * bv[j];
            }
            __syncthreads();
        }
#pragma unroll
        for (int i = 0; i < 4; ++i) {
            F8 a;
#pragma unroll
            for (int j = 0; j < 8; ++j) a.v[j] = acc[i][j];
            e(tm * 128 + ty * 4 + i, tn * 128 + tx * 8, a);
        }
    }
}

template <class E>
__device__ __forceinline__ void gemm(LAS unsigned char* lds, const bf16* A, const bf16* Bt, int M, int N, int K, const E& e) {
#if USE_PG8
    pg8::Gemm g{A, Bt, M, N, K}; pg8::StaticOrder S; S.init(M, N, (int)gridDim.x, (int)blockIdx.x);
    EpiAdapt<E> ea{e};
    pg8::gemm_phase<EpiAdapt<E>, pg8::StaticOrder, true, true>(lds, g, S, ea);
#else
    simple_gemm<E>(lds, A, Bt, M, N, K, e);
#endif
}

__device__ __forceinline__ void transpose_item(const float* W, int ldw, int K, bf16* WT, int src_col0, int dst_row0, LAS float* scr, int kb, int lane) {
    const int k0 = 64 * kb;
#pragma unroll 8
    for (int i = 0; i < 32; ++i) { const int kk = 2 * i + (lane >> 5); scr[kk * 33 + (lane & 31)] = W[(size_t)(k0 + kk) * ldw + src_col0 + (lane & 31)]; }
    LDS_WAIT(); asm volatile("" ::: "memory");
    const int c = lane & 7;
#pragma unroll
    for (int j = 0; j < 4; ++j) { const int n = (lane >> 3) + 8 * j; const LAS float* s = scr + (8 * c) * 33 + n;
        v4u o; o.x = pk2(s[0 * 33], s[1 * 33]); o.y = pk2(s[2 * 33], s[3 * 33]); o.z = pk2(s[4 * 33], s[5 * 33]); o.w = pk2(s[6 * 33], s[7 * 33]);
        *(v4u*)(WT + (size_t)(dst_row0 + n) * K + k0 + 8 * c) = o; }
    LDS_WAIT(); asm volatile("" ::: "memory");
}

struct P {
    const float *x, *norm_mix_w, *w_in, *conv_w, *conv_b, *b_i, *b_f, *ml_norm_w, *w_sb, *w_ml, *w_out, *norm_ffn_w, *w_query, *keys1, *keys2, *peer_u, *peer_v, *norm_final_w;
    float* out; unsigned char* ws;
};

__device__ __forceinline__ void p0_prologue(const P& p, LAS unsigned char* lds, int wave, int lane) {
    LAS float* scr = (LAS float*)(lds + wave * 8448);
    const int gw = blockIdx.x * NWAVES + wave, NGW = gridDim.x * NWAVES;
    bf16* W1T = (bf16*)(p.ws + WS_W1T); bf16* WSBT = (bf16*)(p.ws + WS_WSBT); bf16* WMLT = (bf16*)(p.ws + WS_WMLT); bf16* WOUTT = (bf16*)(p.ws + WS_WOUTT); bf16* WCT = (bf16*)(p.ws + WS_WCT);
    constexpr int I_1 = 16 * 176, I_SB = 8 * 32, I_ML = 8 * 32, I_O = 16 * 32, NT = I_1 + I_SB + I_ML + I_O;
    for (int it = gw; it < NT; it += NGW) {
        int r = it;
        if (r < I_1) { const int kb = r / 176, nb = r % 176, n0 = nb * 32; transpose_item(p.w_in, INC, 1024, W1T, n0 < 3584 ? n0 : n0 + 8, n0, scr, kb, lane); continue; } r -= I_1;
        if (r < I_SB) { const int kb = r / 32, nb = r % 32; transpose_item(p.w_sb, 1024, 1024, WSBT, nb * 32, nb * 32, scr, kb, lane);             continue; } r -= I_SB;
        if (r < I_ML) { const int kb = r / 32, nb = r % 32; transpose_item(p.w_ml, 1024, 1024, WSBT + 512, nb * 32, nb * 32, scr, kb, lane); continue; } r -= I_ML;
        { const int kb = r / 32, nb = r % 32; transpose_item(p.w_out, 1024, 1024, WOUTT, nb * 32, nb * 32, scr, kb, lane); }
    }
    bf16* XN = (bf16*)(p.ws + WS_XN); float* IFG = (float*)(p.ws + WS_IFG);
    LAS float* WG = (LAS float*)(lds + 8 * 8448);
    __syncthreads();
    for (int i = threadIdx.x; i < 2048; i += NTHR) { const int k = i >> 1, hf = i & 1; *(LAS f32x4*)(WG + k * 8 + hf * 4) = *(const f32x4*)(p.w_in + (size_t)k * INC + 3584 + hf * 4); }
    __syncthreads();
    for (int m = gw; m < T_; m += NGW) {
        const f32x4* xr = (const f32x4*)(p.x + (size_t)m * 1024) + lane;
        const f32x4* wr = (const f32x4*)p.norm_mix_w + lane;
        f32x4 v[4]; float ss = 0.f;
#pragma unroll
        for (int j = 0; j < 4; ++j) { v[j] = xr[64 * j]; ss += (v[j].x * v[j].x + v[j].y * v[j].y) + (v[j].z * v[j].z + v[j].w * v[j].w); }
        const float rstd = frsq(wave_sum(ss) * (1.f / 1024.f) + EPS);
        float g[8];
#pragma unroll
        for (int i = 0; i < 8; ++i) g[i] = 0.f;
        v2u* o8 = (v2u*)(XN + (size_t)m * 1024) + lane;
#pragma unroll
        for (int j = 0; j < 4; ++j) {
            const f32x4 w = wr[64 * j];
            const float y[4] = {v[j].x * rstd * w.x, v[j].y * rstd * w.y, v[j].z * rstd * w.z, v[j].w * rstd * w.w};
            o8[64 * j] = (v2u){pk2(y[0], y[1]), pk2(y[2], y[3])};
#pragma unroll
            for (int q = 0; q < 4; ++q) {
                const int k = 256 * j + 4 * lane + q;
                const f32x4 w0 = *(const LAS f32x4*)(WG + k * 8), w1 = *(const LAS f32x4*)(WG + k * 8 + 4);
                g[0] += y[q] * w0.x; g[1] += y[q] * w0.y; g[2] += y[q] * w0.z; g[3] += y[q] * w0.w;
                g[4] += y[q] * w1.x; g[5] += y[q] * w1.y; g[6] += y[q] * w1.z; g[7] += y[q] * w1.w;
            }
        }
        {
            const bool b5 = (lane & 32) != 0, b4 = (lane & 16) != 0, b3 = (lane & 8) != 0;
            float e4[4], f2[2], gs;
#pragma unroll
            for (int i = 0; i < 4; ++i) { const float keep = b5 ? g[2 * i + 1] : g[2 * i], send = b5 ? g[2 * i] : g[2 * i + 1]; e4[i] = keep + __shfl_xor(send, 32); }
#pragma unroll
            for (int i = 0; i < 2; ++i) { const float keep = b4 ? e4[2 * i + 1] : e4[2 * i], send = b4 ? e4[2 * i] : e4[2 * i + 1]; f2[i] = keep + __shfl_xor(send, 16); }
            { const float keep = b3 ? f2[1] : f2[0], send = b3 ? f2[0] : f2[1]; gs = keep + __shfl_xor(send, 8); }
            gs += __shfl_xor(gs, 4); gs += __shfl_xor(gs, 2); gs += __shfl_xor(gs, 1);
            const int gi = 4 * (b3 ? 1 : 0) + 2 * (b4 ? 1 : 0) + (b5 ? 1 : 0);
            if ((lane & 7) == 0) IFG[(size_t)m * 8 + gi] = gs + (gi < 4 ? p.b_i[gi] : p.b_f[gi - 4]);
        }
    }
}

__device__ __forceinline__ void fill_wc(const P& p, int it, int lane) {
    bf16* WCT = (bf16*)(p.ws + WS_WCT);
    const int hhf = it >> 6, kb = (it >> 2) & 15, kq = it & 3, head = hhf >> 1, half = hhf & 1, k = kb * 64 + lane;
    const f32x4* wq = (const f32x4*)(p.w_query + (size_t)k * 2048 + head * 256 + half * 128);
    f32x4 wr[32];
#pragma unroll
    for (int i = 0; i < 32; ++i) wr[i] = wq[i];
    const float* kbase = (half ? p.keys2 : p.keys1) + ((size_t)head * 128 + kq * 32) * 128;
#pragma unroll 1
    for (int key = 0; key < 32; ++key) {
        const f32x4* kr = (const f32x4*)(kbase + (size_t)key * 128);
        float a0 = 0.f, a1 = 0.f;
#pragma unroll
        for (int i = 0; i < 32; i += 2) { const f32x4 b0 = kr[i], b1 = kr[i + 1];
            a0 += wr[i].x * b0.x + wr[i].y * b0.y + wr[i].z * b0.z + wr[i].w * b0.w;
            a1 += wr[i + 1].x * b1.x + wr[i + 1].y * b1.y + wr[i + 1].z * b1.z + wr[i + 1].w * b1.w; }
        WCT[(size_t)(hhf * 128 + kq * 32 + key) * 1024 + k] = (bf16)f2bf(a0 + a1);
    }
}
__device__ __forceinline__ void fill_tables(const P& p, int e, int lane) {
    unsigned char* U8 = p.ws + WS_U8; unsigned char* V8 = p.ws + WS_V8; float* USC = (float*)(p.ws + WS_USC); float* VSC = (float*)(p.ws + WS_VSC);
    f32x4 v[2][4]; float am[2] = {0.f, 0.f};
#pragma unroll
    for (int which = 0; which < 2; ++which) {
        const float* src = (which ? p.peer_v : p.peer_u) + (size_t)e * 1024 + 16 * lane;
#pragma unroll
        for (int j = 0; j < 4; ++j) v[which][j] = *(const f32x4*)(src + 4 * j);
    }
#pragma unroll
    for (int which = 0; which < 2; ++which)
#pragma unroll
        for (int j = 0; j < 4; ++j) am[which] = fmaxf(am[which], fmaxf(fmaxf(fabsf(v[which][j].x), fabsf(v[which][j].y)), fmaxf(fabsf(v[which][j].z), fabsf(v[which][j].w))));
#pragma unroll
    for (int o = 1; o < 64; o <<= 1) { am[0] = fmaxf(am[0], __shfl_xor(am[0], o)); am[1] = fmaxf(am[1], __shfl_xor(am[1], o)); }
#pragma unroll
    for (int which = 0; which < 2; ++which) {
        const float sc = am[which] > 0.f ? exp2f(floorf(log2f(448.f / am[which]))) : 1.f;
        unsigned w[4];
#pragma unroll
        for (int j = 0; j < 4; ++j) { int t = __builtin_amdgcn_cvt_pk_fp8_f32(v[which][j].x * sc, v[which][j].y * sc, 0, false); t = __builtin_amdgcn_cvt_pk_fp8_f32(v[which][j].z * sc, v[which][j].w * sc, t, true); w[j] = (unsigned)t; }
        *(v4u*)((which ? V8 : U8) + ((size_t)(lane >> 3) * NEXP + e) * 128 + 16 * (lane & 7)) = (v4u){w[0], w[1], w[2], w[3]};
        if (lane == 0) (which ? VSC : USC)[e] = 1.f / sc;
    }
}
constexpr int N_FILL = 128 + 1024;
__device__ __forceinline__ void fill_item(const P& p, int item, int wave, int lane) {
    if (item < 128) fill_wc(p, item * 8 + wave, lane);
    else { const int e0 = (item - 128) * 16 + wave * 2; fill_tables(p, e0, lane); fill_tables(p, e0 + 1, lane); }
}

typedef short bf16x8 __attribute__((ext_vector_type(8)));
typedef float f32x16 __attribute__((ext_vector_type(16)));
#define MFMA32(a, b, c) __builtin_amdgcn_mfma_f32_32x32x16_bf16((a), (b), (c), 0, 0, 0)
__device__ __forceinline__ int crow(int reg, int hh) { return (reg & 3) + 8 * (reg >> 2) + 4 * hh; }
template <int S> __device__ __forceinline__ bf16x8 pack_step(const f32x16& x) {
    v4u p; p.x = cvtpk(x[8 * S], x[8 * S + 1]); p.y = cvtpk(x[8 * S + 2], x[8 * S + 3]); p.z = cvtpk(x[8 * S + 4], x[8 * S + 5]); p.w = cvtpk(x[8 * S + 6], x[8 * S + 7]);
    return __builtin_bit_cast(bf16x8, p);
}
__device__ __forceinline__ bf16x8 frag2(const v2u& lo, const v2u& hi) { v4u p; p.x = lo.x; p.y = lo.y; p.z = hi.x; p.w = hi.y; return __builtin_bit_cast(bf16x8, p); }
__device__ __forceinline__ f32x16 zero16() { f32x16 z; for (int i = 0; i < 16; ++i) z[i] = 0.f; return z; }


__device__ __forceinline__ void p2_conv(const P& p, int tid) {
    const bf16* MLQK = (const bf16*)(p.ws + WS_MLQK); bf16* QC = (bf16*)(p.ws + WS_QC); bf16* KC = (bf16*)(p.ws + WS_KC);
    const int cg = tid & 127, ch0 = 8 * cg;
    float cw[4][8], cb[8];
#pragma unroll
    for (int i = 0; i < 8; ++i) { cb[i] = p.conv_b[ch0 + i];
#pragma unroll
        for (int j = 0; j < 4; ++j) cw[j][i] = p.conv_w[j * 1024 + ch0 + i]; }
    const float osc = cg >= 64 ? 0.08838834764831845f : 1.f;
    bf16* dst = (cg >= 64 ? KC : QC) + (cg & 63) * 8;
    for (int rg = blockIdx.x * 4 + (tid >> 7); rg < T_ / 4; rg += gridDim.x * 4) {
        const int tok = rg * 4, pos0 = tok & (S_ - 1);
        v4u xr[7];
#pragma unroll
        for (int k = 0; k < 7; ++k) xr[k] = (pos0 + k - 3 >= 0) ? *(const v4u*)(MLQK + (size_t)(tok + k - 3) * 1024 + ch0) : (v4u){0u, 0u, 0u, 0u};
#pragma unroll
        for (int tt = 0; tt < 4; ++tt) {
            float y[8];
#pragma unroll
            for (int i = 0; i < 8; ++i) y[i] = cb[i];
#pragma unroll
            for (int j = 0; j < 4; ++j) { float f[8]; unpack8(xr[tt + j], f);
#pragma unroll
                for (int i = 0; i < 8; ++i) y[i] += cw[j][i] * f[i]; }
#pragma unroll
            for (int i = 0; i < 8; ++i) y[i] = y[i] * sigmoidf_(y[i]) * osc;
            *(v4u*)(dst + (size_t)(tok + tt) * 512) = pack8(y);
        }
    }
}

constexpr int ML_QS = 0, ML_KS = 17408, ML_KWT = 34816, ML_VTL = 53248, ML_PS = 71680, ML_CT = 80896, ML_SCAL = 115712, ML_SSP = 118272, ML_QN = ML_SSP + 512, ML_F1 = ML_QN + 256, ML_F2 = ML_F1 + 256, ML_NV = ML_F2 + 256;
static_assert(ML_NV + 512 <= RING_BYTES, "mLSTM LDS map");
__device__ __forceinline__ void mlstm_scal(float ip, float fp, LAS float* sc, float& m_carry, int lane) {
    const float lf = fminf(fp, 0.f) - flog(1.f + fexp(-fabsf(fp)));
    float bc = lf;
#pragma unroll
    for (int o = 1; o < 64; o <<= 1) { const float t2 = __shfl_up(bc, o); if (lane >= o) bc += t2; }
    const float a = ip - bc; float pm = a;
#pragma unroll
    for (int o = 1; o < 64; o <<= 1) { const float t2 = __shfl_up(pm, o); if (lane >= o) pm = fmaxf(pm, t2); }
    const float M = fmaxf(m_carry, pm);
    const float M63 = __shfl(M, 63), bc63 = __shfl(bc, 63);
    sc[lane] = a; sc[64 + lane] = M; sc[128 + lane] = fexp(a - M63); sc[192 + lane] = fexp(m_carry - M); sc[256 + lane] = fexp(-(bc + M));
    m_carry = bc63 + M63;
}
__device__ __forceinline__ void mlstm_item(const P& p, LAS unsigned char* lds, int item, int tid, int wave, int lane) {
    const int b = item >> 2, h = item & 3;
    const int r = lane & 31, hh = lane >> 5, et = wave & 3, th = wave >> 2;
    const bf16* QC = (const bf16*)(p.ws + WS_QC); const bf16* KC = (const bf16*)(p.ws + WS_KC); const bf16* MLV = (const bf16*)(p.ws + WS_MLV); const float* IFG = (const float*)(p.ws + WS_IFG);
    bf16* HML = (bf16*)p.out + 512;
    LAS float* SCAL = (LAS float*)(lds + ML_SCAL); LAS float* SSP = (LAS float*)(lds + ML_SSP); LAS float* QN = (LAS float*)(lds + ML_QN);
    LAS float* F1 = (LAS float*)(lds + ML_F1); LAS float* F2 = (LAS float*)(lds + ML_F2); LAS float* NV = (LAS float*)(lds + ML_NV);
    const int cg = tid & 15, trow = tid >> 4, eg = cg, sl = trow;
    const size_t hq = (size_t)h * 128 + 8 * cg;
    for (int i = tid; i < (128 * 136 * 2) / 4; i += NTHR) ((LAS unsigned*)(lds + ML_CT))[i] = 0u;
    if (tid < 128) NV[tid] = 0.f;
    f32x16 accC[2]; accC[0] = zero16(); accC[1] = zero16();
    float m_carry = 0.f;
    if (wave == 3) { const size_t tk = (size_t)b * S_ + lane; mlstm_scal(IFG[tk * 8 + h], IFG[tk * 8 + 4 + h], SCAL, m_carry, lane); }
    v4u pq[2], pk[2], pv[2];
    {
        const size_t t0 = (size_t)b * S_;
#pragma unroll
        for (int u = 0; u < 2; ++u) { pq[u] = *(const v4u*)(QC + (t0 + trow + 32 * u) * 512 + hq); pk[u] = *(const v4u*)(KC + (t0 + trow + 32 * u) * 512 + hq); pv[u] = *(const v4u*)(MLV + (t0 + sl + 32 * u) * 512 + hq); }
    }
    float ipn = 0.f, fpn = 0.f;
    __syncthreads();
    for (int c = 0; c < 32; ++c) {
        const size_t tok0 = (size_t)b * S_ + c * 64;
        LAS float* sc = SCAL + (c & 1) * 320;
        {
#pragma unroll
            for (int u = 0; u < 2; ++u) {
                const int t = trow + 32 * u;
                *(LAS v4u*)(lds + ML_QS + t * 272 + cg * 16) = pq[u];
                *(LAS v4u*)(lds + ML_KS + t * 272 + cg * 16) = pk[u];
                float f[8]; unpack8(pk[u], f);
                const float wk = sc[128 + t];
#pragma unroll
                for (int i = 0; i < 8; ++i) *(LAS bf16*)(lds + ML_KWT + (8 * cg + i) * 144 + ((t ^ (8 * (cg & 7))) * 2)) = (bf16)f2bf(f[i] * wk);
                const unsigned vv[4] = {pv[u].x, pv[u].y, pv[u].z, pv[u].w};
#pragma unroll
                for (int i = 0; i < 4; ++i) {
                    *(LAS bf16*)(lds + ML_VTL + (8 * eg + 2 * i) * 144 + ((t ^ (8 * (eg & 7))) * 2)) = (bf16)(vv[i] & 0xffffu);
                    *(LAS bf16*)(lds + ML_VTL + (8 * eg + 2 * i + 1) * 144 + ((t ^ (8 * (eg & 7))) * 2)) = (bf16)(vv[i] >> 16);
                }
            }
            if (c + 1 < 32) {
                const size_t t1 = tok0 + 64;
#pragma unroll
                for (int u = 0; u < 2; ++u) { pq[u] = *(const v4u*)(QC + (t1 + trow + 32 * u) * 512 + hq); pk[u] = *(const v4u*)(KC + (t1 + trow + 32 * u) * 512 + hq); pv[u] = *(const v4u*)(MLV + (t1 + sl + 32 * u) * 512 + hq); }
                if (wave == 3) { ipn = IFG[(t1 + lane) * 8 + h]; fpn = IFG[(t1 + lane) * 8 + 4 + h]; }
            }
        }
        __syncthreads();
        f32x16 acc_inter = zero16();
        if (wave < 3) {
            const int tt = wave > 0 ? 1 : 0, st = wave == 2 ? 1 : 0;
            f32x16 zt = zero16();
#pragma unroll
            for (int ks = 0; ks < 8; ++ks) {
                const bf16x8 ka = *(const LAS bf16x8*)(lds + ML_KS + (32 * st + r) * 272 + 32 * ks + 16 * hh);
                const bf16x8 qb = *(const LAS bf16x8*)(lds + ML_QS + (32 * tt + r) * 272 + 32 * ks + 16 * hh);
                zt = MFMA32(ka, qb, zt);
            }
            const int t = 32 * tt + r; const float Mt = sc[64 + t];
            float ps = 0.f;
#pragma unroll
            for (int g = 0; g < 4; ++g) {
                const f32x4 av = *(const LAS f32x4*)(sc + 32 * st + 8 * g + 4 * hh);
                float pv[4];
#pragma unroll
                for (int q = 0; q < 4; ++q) { const int sidx = 32 * st + 8 * g + 4 * hh + q;
                    const float wgt = sidx <= t ? fexp(av[q] - Mt) : 0.f; pv[q] = zt[4 * g + q] * wgt; ps += pv[q]; }
                *(LAS v2u*)(lds + ML_PS + t * 144 + (32 * st + 8 * g + 4 * hh) * 2) = (v2u){cvtpk(pv[0], pv[1]), cvtpk(pv[2], pv[3])};
            }
            ps += __shfl_xor(ps, 32);
            if (hh == 0) { SSP[st * 64 + t] = ps; if (wave == 0) SSP[64 + t] = 0.f; }
        }
        if (wave == 3 && c + 1 < 32) mlstm_scal(ipn, fpn, SCAL + ((c + 1) & 1) * 320, m_carry, lane);
#pragma unroll
        for (int ks = 0; ks < 8; ++ks) {
            const bf16x8 qa = *(const LAS bf16x8*)(lds + ML_QS + (32 * th + r) * 272 + 32 * ks + 16 * hh);
            const bf16x8 cbf = *(const LAS bf16x8*)(lds + ML_CT + (32 * et + r) * 272 + 32 * ks + 16 * hh);
            acc_inter = MFMA32(qa, cbf, acc_inter);
        }
        {
            const int t = tid >> 3, part = tid & 7;
            float f[8], sum = 0.f;
            { const v4u tq = *(const LAS v4u*)(lds + ML_QS + t * 272 + part * 32); unpack8(tq, f); }
#pragma unroll
            for (int i = 0; i < 8; ++i) sum += f[i] * NV[16 * part + i];
            { const v4u tq = *(const LAS v4u*)(lds + ML_QS + t * 272 + part * 32 + 16); unpack8(tq, f); }
#pragma unroll
            for (int i = 0; i < 8; ++i) sum += f[i] * NV[16 * part + 8 + i];
            sum += __shfl_xor(sum, 1); sum += __shfl_xor(sum, 2); sum += __shfl_xor(sum, 4);
            if (part == 0) QN[t] = sum;
        }
        __syncthreads();
        f32x16 acc_intra = zero16();
#pragma unroll
        for (int ks = 0; ks < 4; ++ks) {
            if (ks < 2 || th == 1) {
                const bf16x8 pa = *(const LAS bf16x8*)(lds + ML_PS + (32 * th + r) * 144 + 32 * ks + 16 * hh);
                const bf16x8 vb = *(const LAS bf16x8*)(lds + ML_VTL + (32 * et + r) * 144 + 16 * ((2 * ks + hh) ^ (((32 * et + r) >> 3) & 7)));
                acc_intra = MFMA32(pa, vb, acc_intra);
            }
        }
        if (tid < 64) {
            const float wi = sc[192 + tid];
            const float den = SSP[tid] + SSP[64 + tid] + wi * QN[tid];
            const float f1 = frcp(fmaxf(fabsf(den), sc[256 + tid]));
            F1[tid] = f1; F2[tid] = wi * f1;
        }
        const float decay = sc[192 + 63];
#pragma unroll
        for (int dt = 0; dt < 2; ++dt) {
#pragma unroll
            for (int i = 0; i < 16; ++i) accC[dt][i] *= decay;
#pragma unroll
            for (int ks = 0; ks < 4; ++ks) {
                const bf16x8 ka = *(const LAS bf16x8*)(lds + ML_KWT + (64 * th + 32 * dt + r) * 144 + 16 * ((2 * ks + hh) ^ (((64 * th + 32 * dt + r) >> 3) & 7)));
                const bf16x8 vb = *(const LAS bf16x8*)(lds + ML_VTL + (32 * et + r) * 144 + 16 * ((2 * ks + hh) ^ (((32 * et + r) >> 3) & 7)));
                accC[dt] = MFMA32(ka, vb, accC[dt]);
            }
        }
        {
            const int d = tid >> 2, part = tid & 3;
            float f[8], sum = 0.f;
            { const v4u tq = *(const LAS v4u*)(lds + ML_KWT + d * 144 + part * 32); unpack8(tq, f); }
#pragma unroll
            for (int i = 0; i < 8; ++i) sum += f[i];
            { const v4u tq = *(const LAS v4u*)(lds + ML_KWT + d * 144 + part * 32 + 16); unpack8(tq, f); }
#pragma unroll
            for (int i = 0; i < 8; ++i) sum += f[i];
            sum += __shfl_xor(sum, 1); sum += __shfl_xor(sum, 2);
            if (part == 0) NV[d] = decay * NV[d] + sum;
        }
        __syncthreads();
        {
            bf16* hp = HML + (tok0 + 32 * th) * 1024 + h * 128 + 32 * et + r;
#pragma unroll
            for (int g = 0; g < 4; ++g) {
                const f32x4 f1v = *(const LAS f32x4*)(F1 + 32 * th + 8 * g + 4 * hh), f2v = *(const LAS f32x4*)(F2 + 32 * th + 8 * g + 4 * hh);
#pragma unroll
                for (int q = 0; q < 4; ++q) { const int tl = 8 * g + 4 * hh + q;
                    hp[(size_t)tl * 1024] = (bf16)f2bf(acc_intra[4 * g + q] * f1v[q] + acc_inter[4 * g + q] * f2v[q]); }
            }
#pragma unroll
            for (int dt = 0; dt < 2; ++dt)
#pragma unroll
                for (int g = 0; g < 4; ++g)
                    *(LAS v2u*)(lds + ML_CT + (32 * et + r) * 272 + (64 * th + 32 * dt + 8 * g + 4 * hh) * 2) = (v2u){cvtpk(accC[dt][4 * g], accC[dt][4 * g + 1]), cvtpk(accC[dt][4 * g + 2], accC[dt][4 * g + 3])};
        }
    }
    __syncthreads();
}

__device__ __forceinline__ void sba_wave_item(const bf16* __restrict__ QK, const bf16* __restrict__ VT, bf16* __restrict__ YSB, int b, int h, int qt, int lane) {
    const int r = lane & 31, hh = lane >> 5, t0 = qt * 32;
    const size_t rowbase = (size_t)b * S_;
    bf16x8 qf[4];
    {
        const bf16* qp = QK + (rowbase + t0 + r) * 1024 + h * 64 + 8 * hh;
#pragma unroll
        for (int ks = 0; ks < 4; ++ks) qf[ks] = *(const bf16x8*)(qp + 16 * ks);
    }
    bf16x8 tri[2];
#pragma unroll
    for (int s2 = 0; s2 < 2; ++s2)
#pragma unroll
        for (int j = 0; j < 8; ++j) { const int rho = 16 * s2 + 8 * (j >> 2) + 4 * hh + (j & 3); tri[s2][j] = (rho > r) ? (short)0x3F80 : (short)0; }
    f32x16 o0 = zero16(), o1 = zero16();
    float carry = 0.f;
    const bf16* kbase = QK + rowbase * 1024 + 512 + h * 64 + 8 * hh + (size_t)r * 1024;
    const bf16* vbase = VT + ((size_t)(b * 8 + h) * 64 + r) * 2048 + 4 * hh;
    bf16x8 kf[4]; v2u vl[2][2], vh[2][2];
#pragma unroll
    for (int ks = 0; ks < 4; ++ks) kf[ks] = *(const bf16x8*)(kbase + (size_t)t0 * 1024 + 16 * ks);
#pragma unroll
    for (int dt = 0; dt < 2; ++dt)
#pragma unroll
        for (int s2 = 0; s2 < 2; ++s2) { const bf16* vp = vbase + (size_t)dt * 32 * 2048 + t0 + 16 * s2; vl[dt][s2] = *(const v2u*)vp; vh[dt][s2] = *(const v2u*)(vp + 8); }
    for (int s0 = t0; s0 >= 0; s0 -= 32) {
        bf16x8 kn[4]; v2u vln[2][2], vhn[2][2];
        const int sn = s0 >= 32 ? s0 - 32 : 0;
#pragma unroll
        for (int ks = 0; ks < 4; ++ks) kn[ks] = *(const bf16x8*)(kbase + (size_t)sn * 1024 + 16 * ks);
#pragma unroll
        for (int dt = 0; dt < 2; ++dt)
#pragma unroll
            for (int s2 = 0; s2 < 2; ++s2) { const bf16* vp = vbase + (size_t)dt * 32 * 2048 + sn + 16 * s2; vln[dt][s2] = *(const v2u*)vp; vhn[dt][s2] = *(const v2u*)(vp + 8); }
        f32x16 z = zero16();
#pragma unroll
        for (int ks = 0; ks < 4; ++ks) z = MFMA32(kf[ks], qf[ks], z);
        const bool diag = (s0 == t0);
        f32x16 sp; float rs = 0.f;
#pragma unroll
        for (int i = 0; i < 16; ++i) {
            const float zz = z[i] * 0.125f;
            const bool valid = !diag || (crow(i, hh) < r);
            float spv = fmaxf(zz, 0.f) + flog(1.f + fexp(-fabsf(zz)));
            spv = valid ? spv : 0.f;
            sp[i] = spv; rs += spv; z[i] = zz - spv;
        }
        f32x16 suf = zero16();
        suf = MFMA32(tri[0], pack_step<0>(sp), suf);
        suf = MFMA32(tri[1], pack_step<1>(sp), suf);
        f32x16 w;
#pragma unroll
        for (int i = 0; i < 16; ++i) {
            const bool valid = !diag || (crow(i, hh) < r);
            const float lw = z[i] - suf[i] - carry;
            w[i] = valid ? fexp(lw) : 0.f;
        }
        rs += __shfl_xor(rs, 32);
        carry += rs;
        const bf16x8 pa0 = pack_step<0>(w), pa1 = pack_step<1>(w);
        o0 = MFMA32(pa0, frag2(vl[0][0], vh[0][0]), o0); o0 = MFMA32(pa1, frag2(vl[0][1], vh[0][1]), o0);
        o1 = MFMA32(pa0, frag2(vl[1][0], vh[1][0]), o1); o1 = MFMA32(pa1, frag2(vl[1][1], vh[1][1]), o1);
        if (__all(carry > 104.f)) break;
#pragma unroll
        for (int ks = 0; ks < 4; ++ks) kf[ks] = kn[ks];
#pragma unroll
        for (int dt = 0; dt < 2; ++dt)
#pragma unroll
            for (int s2 = 0; s2 < 2; ++s2) { vl[dt][s2] = vln[dt][s2]; vh[dt][s2] = vhn[dt][s2]; }
    }
    bf16* op = YSB + (rowbase + t0) * 1024 + h * 64 + r;
#pragma unroll
    for (int i = 0; i < 16; ++i) { const int t = crow(i, hh); op[(size_t)t * 1024] = (bf16)f2bf(o0[i]); op[(size_t)t * 1024 + 32] = (bf16)f2bf(o1[i]); }
}
__device__ __forceinline__ void sba_item(const P& p, int item, int wave, int lane) {
    const int bh = item >> 3, qb = item & 7, b = bh >> 3, h = bh & 7;
    sba_wave_item((const bf16*)(p.ws + WS_SBQKV), (const bf16*)(p.ws + WS_VT), (bf16*)p.out, b, h, qb * 8 + wave, lane);
}

__device__ __forceinline__ void p3_yml(const P& p, int wave, int lane) {
    const int gw = blockIdx.x * NWAVES + wave, NGW = gridDim.x * NWAVES;
    bf16* YML = (bf16*)p.out + 512; const bf16* MLO = (const bf16*)(p.ws + WS_MLO);
    for (int m = gw; m < T_; m += NGW) {
        float hv[8], ov[8], o[8];
        unpack8(*(const v4u*)(YML + (size_t)m * 1024 + lane * 8), hv); unpack8(*(const v4u*)(MLO + (size_t)m * 512 + lane * 8), ov);
        float ss = 0.f;
#pragma unroll
        for (int i = 0; i < 8; ++i) ss += hv[i] * hv[i];
        ss += __shfl_xor(ss, 1); ss += __shfl_xor(ss, 2); ss += __shfl_xor(ss, 4); ss += __shfl_xor(ss, 8);
        const float rstd = frsq(ss * (1.f / 128.f) + EPS);
        const f32x4 w0 = *(const f32x4*)(p.ml_norm_w + lane * 8), w1 = *(const f32x4*)(p.ml_norm_w + lane * 8 + 4);
        const float wv[8] = {w0.x, w0.y, w0.z, w0.w, w1.x, w1.y, w1.z, w1.w};
#pragma unroll
        for (int i = 0; i < 8; ++i) o[i] = sigmoidf_(ov[i]) * hv[i] * rstd * wv[i];
        *(v4u*)(YML + (size_t)m * 1024 + lane * 8) = pack8(o);
    }
}

__device__ __forceinline__ void p6_hn(const P& p, int wave, int lane) {
    const int gw = blockIdx.x * NWAVES + wave, NGW = gridDim.x * NWAVES;
    const float* H = (const float*)(p.ws + WS_H); bf16* HN = (bf16*)(p.ws + WS_HN);
    for (int m = gw; m < T_; m += NGW) {
        const f32x4* xr = (const f32x4*)(H + (size_t)m * 1024) + lane; const f32x4* wr = (const f32x4*)p.norm_ffn_w + lane;
        f32x4 v[4]; float ss = 0.f;
#pragma unroll
        for (int j = 0; j < 4; ++j) { v[j] = xr[64 * j]; ss += (v[j].x * v[j].x + v[j].y * v[j].y) + (v[j].z * v[j].z + v[j].w * v[j].w); }
        const float rstd = frsq(wave_sum(ss) * (1.f / 1024.f) + EPS);
        v2u* o8 = (v2u*)(HN + (size_t)m * 1024) + lane;
#pragma unroll
        for (int j = 0; j < 4; ++j) { const f32x4 w = wr[64 * j]; o8[64 * j] = (v2u){pk2(v[j].x * rstd * w.x, v[j].y * rstd * w.y), pk2(v[j].z * rstd * w.z, v[j].w * rstd * w.w)}; }
    }
}

__device__ __forceinline__ float ffn_rstd(const float* SS, int m) {
    const f32x4* q = (const f32x4*)(SS + (size_t)m * 16); const f32x4 a = q[0], b = q[1], c = q[2], d = q[3];
    const float t = ((a.x + a.y) + (a.z + a.w)) + ((b.x + b.y) + (b.z + b.w)) + ((c.x + c.y) + (c.z + c.w)) + ((d.x + d.y) + (d.z + d.w));
    return frsq(t * (1.f / 1024.f) + EPS);
}
__device__ __forceinline__ unsigned ord_key(float f) { const unsigned u = __builtin_bit_cast(unsigned, f); return (u & 0x80000000u) ? ~u : (u | 0x80000000u); }
__device__ __forceinline__ float ord_val(unsigned k) { const unsigned u = (k & 0x80000000u) ? (k & 0x7fffffffu) : ~k; return __builtin_bit_cast(float, u); }
template <int CTRL> __device__ __forceinline__ unsigned dpp_u(unsigned v) { return (unsigned)__builtin_amdgcn_update_dpp(0, (int)v, CTRL, 0xF, 0xF, true); }
__device__ __forceinline__ unsigned umax_(unsigned a, unsigned b) { return a > b ? a : b; }
__device__ __forceinline__ unsigned umin_(unsigned a, unsigned b) { return a < b ? a : b; }
__device__ __forceinline__ unsigned row_max_u(unsigned v) {
    v = umax_(v, dpp_u<0xB1>(v)); v = umax_(v, dpp_u<0x4E>(v)); v = umax_(v, dpp_u<0x141>(v)); v = umax_(v, dpp_u<0x140>(v)); return v;
}
__device__ __forceinline__ float row_sum_f(float v) {
    v += __builtin_bit_cast(float, dpp_u<0xB1>(__builtin_bit_cast(unsigned, v))); v += __builtin_bit_cast(float, dpp_u<0x4E>(__builtin_bit_cast(unsigned, v)));
    v += __builtin_bit_cast(float, dpp_u<0x141>(__builtin_bit_cast(unsigned, v))); v += __builtin_bit_cast(float, dpp_u<0x140>(__builtin_bit_cast(unsigned, v))); return v;
}
#define CE_(i, j) do { const unsigned _a = k[i], _b = k[j]; k[i] = umax_(_a, _b); k[j] = umin_(_a, _b); } while (0)
__device__ __forceinline__ unsigned row_top16(unsigned (&k)[8], unsigned (&top)[16], int li) {
    CE_(0, 1); CE_(2, 3); CE_(4, 5); CE_(6, 7); CE_(0, 2); CE_(1, 3); CE_(4, 6); CE_(5, 7); CE_(1, 2); CE_(5, 6);
    CE_(0, 4); CE_(1, 5); CE_(2, 6); CE_(3, 7); CE_(2, 4); CE_(3, 5); CE_(1, 2); CE_(3, 4); CE_(5, 6);
    unsigned mine = 0u;
#pragma unroll
    for (int n = 0; n < 16; ++n) {
        const unsigned m = row_max_u(k[0]);
        const bool hit = k[0] == m;
#pragma unroll
        for (int i = 0; i < 7; ++i) k[i] = hit ? k[i + 1] : k[i];
        k[7] = hit ? 0u : k[7];
        top[n] = m; mine = (li == n) ? m : mine;
    }
    return mine;
}
__device__ __forceinline__ void topk_core(const float (&s1)[8], const float (&s2)[8], float rstd, int li, int lane, int& e_out, float& g_out) {
    unsigned k[8], top1[16], top2[16];
#pragma unroll
    for (int j = 0; j < 8; ++j) k[j] = (ord_key(s1[j]) & ~0x7fu) | (unsigned)(127 - (li + 16 * j));
    const unsigned mine1 = row_top16(k, top1, li);
#pragma unroll
    for (int j = 0; j < 8; ++j) k[j] = (ord_key(s2[j]) & ~0x7fu) | (unsigned)(127 - (li + 16 * j));
    const unsigned mine2 = row_top16(k, top2, li);
    const float v2 = ord_val(mine2 & ~0x7fu);
    unsigned c[16];
#pragma unroll
    for (int j = 0; j < 16; ++j) {
        const float v1 = ord_val(top1[j] & ~0x7fu);
        const unsigned key = (ord_key(v1 + v2) & ~0xffu) | (unsigned)(255 - (16 * j + li));
        c[j] = ((j + 1) * (li + 1) <= 16) ? key : 0u;
    }
    unsigned tk = 0u, t0 = 0u;
#pragma unroll
    for (int n = 0; n < 16; ++n) {
        const unsigned mx = row_max_u(c[0]);
        const bool hit = c[0] == mx;
#pragma unroll
        for (int i = 0; i < 15; ++i) c[i] = hit ? c[i + 1] : c[i];
        c[15] = hit ? 0u : c[15];
        if (n == 0) t0 = mx;
        tk = (li == n) ? mx : tk;
    }
    const float sv = ord_val(tk & ~0xffu), s0 = ord_val(t0 & ~0xffu);
    const int cc = 255 - (int)(tk & 0xffu), a = (cc >> 4) & 15, bb = cc & 15;
    const int i1 = 127 - (int)((unsigned)__shfl((int)mine1, (lane & 48) + a) & 0x7fu), i2 = 127 - (int)((unsigned)__shfl((int)mine2, (lane & 48) + bb) & 0x7fu);
    const float pe = fexp((sv - s0) * rstd);
    const float den = row_sum_f(pe);
    e_out = i1 * 128 + i2; g_out = pe * frcp(den);
}
constexpr int TK_RS = 1040;
struct EpiTopk {
    static constexpr bool PERM = true, AFTER_DRAIN = true;
    int* IDX; float* GATE; const float* SS;
    __device__ __forceinline__ void fused(pg8::f32x4 (&acc)[2][2][4][2], const pg8::Unit& u, int wr, int wc, int fr, int fq, PG8_LAS unsigned char* lds, int wid, int lane) const {
        const int head = u.pn, q = lane >> 4, li = lane & 15;
#pragma unroll
        for (int ai = 0; ai < 2; ++ai) {
#pragma unroll
            for (int m = 0; m < 4; ++m)
#pragma unroll
                for (int bj = 0; bj < 2; ++bj) {
                    PG8_LAS unsigned char* dst = lds + (wr * 64 + m * 16 + fr) * TK_RS + (bj * 128 + wc * 32 + 8 * fq) * 4;
                    *(PG8_LAS pg8::f32x4*)dst = acc[ai][bj][m][0]; *(PG8_LAS pg8::f32x4*)(dst + 16) = acc[ai][bj][m][1];
                }
            __syncthreads();
#pragma unroll 1
            for (int it = 0; it < 4; it += 2) {
                const int rowa = 16 * wid + 4 * it + q, rowb = rowa + 4, ma = u.pm * 256 + ai * 128 + rowa, mb = ma + 4;
                const PG8_LAS float* sa = (const PG8_LAS float*)(lds + rowa * TK_RS); const PG8_LAS float* sb = (const PG8_LAS float*)(lds + rowb * TK_RS);
                float a1[8], a2[8], b1[8], b2[8];
#pragma unroll
                for (int j = 0; j < 8; ++j) { a1[j] = sa[li + 16 * j]; a2[j] = sa[128 + li + 16 * j]; b1[j] = sb[li + 16 * j]; b2[j] = sb[128 + li + 16 * j]; }
                const float ra = ffn_rstd(SS, ma), rb = ffn_rstd(SS, mb);
                int ea, eb; float ga, gb;
                topk_core(a1, a2, ra, li, lane, ea, ga);
                topk_core(b1, b2, rb, li, lane, eb, gb);
                IDX[(size_t)ma * 128 + head * 16 + li] = ea; GATE[(size_t)ma * 128 + head * 16 + li] = ga;
                IDX[(size_t)mb * 128 + head * 16 + li] = eb; GATE[(size_t)mb * 128 + head * 16 + li] = gb;
            }
            __syncthreads();
        }
    }
};
struct OneUnit {
    pg8::Unit u;
    __device__ __forceinline__ bool next(int i, pg8::Unit& o) const { if (i) return false; o = u; return true; }
    __device__ __forceinline__ void a_ready(const pg8::Unit&) const {}
    __device__ __forceinline__ void done(const pg8::Unit&) const {}
};

__device__ __forceinline__ float gelu_erf(float x) { return 0.5f * x * (1.f + erff(x * 0.70710678118654752f)); }
typedef float f32x2 __attribute__((ext_vector_type(2)));
__device__ __forceinline__ void cvt16_fp8(const v4u& w, f32x2 (&f)[8]) {
    f[0] = __builtin_amdgcn_cvt_pk_f32_fp8((int)w.x, false); f[1] = __builtin_amdgcn_cvt_pk_f32_fp8((int)w.x, true);
    f[2] = __builtin_amdgcn_cvt_pk_f32_fp8((int)w.y, false); f[3] = __builtin_amdgcn_cvt_pk_f32_fp8((int)w.y, true);
    f[4] = __builtin_amdgcn_cvt_pk_f32_fp8((int)w.z, false); f[5] = __builtin_amdgcn_cvt_pk_f32_fp8((int)w.z, true);
    f[6] = __builtin_amdgcn_cvt_pk_f32_fp8((int)w.w, false); f[7] = __builtin_amdgcn_cvt_pk_f32_fp8((int)w.w, true);
}
__device__ __forceinline__ float grp8_sum(float v) {
    v += __builtin_bit_cast(float, dpp_u<0xB1>(__builtin_bit_cast(unsigned, v)));
    v += __builtin_bit_cast(float, dpp_u<0x4E>(__builtin_bit_cast(unsigned, v)));
    v += __builtin_bit_cast(float, dpp_u<0x141>(__builtin_bit_cast(unsigned, v)));
    return v;
}
typedef int i32x4 __attribute__((ext_vector_type(4)));
template <int PAT> __device__ __forceinline__ float swz_f(float v) { return __builtin_bit_cast(float, __builtin_amdgcn_ds_swizzle(__builtin_bit_cast(int, v), PAT)); }
__device__ __forceinline__ void peer_u_token(const v4u (&ur)[16], const f32x2 (&xv)[8], bf16* dst, int c8) {
    float d[16];
#pragma unroll
    for (int i = 0; i < 16; ++i) {
        f32x2 f[8]; cvt16_fp8(ur[i], f);
        f32x2 s2 = f[0] * xv[0];
#pragma unroll
        for (int q = 1; q < 8; ++q) s2 += f[q] * xv[q];
        d[i] = s2.x + s2.y;
    }
    const bool b0 = (c8 & 1) != 0, b1 = (c8 & 2) != 0, b2 = (c8 & 4) != 0;
    float e8[8], e4[4], e2[2];
#pragma unroll
    for (int i = 0; i < 8; ++i) { const float keep = b0 ? d[2 * i + 1] : d[2 * i], send = b0 ? d[2 * i] : d[2 * i + 1];
        e8[i] = keep + __builtin_bit_cast(float, dpp_u<0xB1>(__builtin_bit_cast(unsigned, send))); }
#pragma unroll
    for (int i = 0; i < 4; ++i) { const float keep = b1 ? e8[2 * i + 1] : e8[2 * i], send = b1 ? e8[2 * i] : e8[2 * i + 1];
        e4[i] = keep + __builtin_bit_cast(float, dpp_u<0x4E>(__builtin_bit_cast(unsigned, send))); }
#pragma unroll
    for (int i = 0; i < 2; ++i) { const float keep = b2 ? e4[2 * i + 1] : e4[2 * i], send = b2 ? e4[2 * i] : e4[2 * i + 1];
        e2[i] = keep + swz_f<0x1F | (4 << 10)>(send); }
    dst[c8] = (bf16)f2bf(e2[0]); dst[c8 + 8] = (bf16)f2bf(e2[1]);
}
__device__ __forceinline__ void peer_u(const P& p, int wave, int lane) {
    const int j = blockIdx.x & 7, nchunk = gridDim.x >> 3, chunk = blockIdx.x >> 3, stride = nchunk * 8;
    const int g = lane >> 3, c8 = lane & 7;
    const bf16* HN = (const bf16*)p.out + 128 * j + 16 * c8; const int* IDX = (const int*)(p.ws + WS_IDX) + 16 * g;
    const unsigned char* US = p.ws + WS_U8 + (size_t)j * NEXP * 128 + 16 * c8;
    bf16* PART = (bf16*)(p.ws + WS_PART) + (size_t)j * T_ * 128 + 16 * g;
    const int m0 = chunk * 8 + wave, ntok = (T_ - m0 + stride - 1) / stride;
#define PU_CLAMP(k) (m0 + ((k) < ntok ? (k) : ntok - 1) * stride)
#define PU_ROWS(ur, ei) _Pragma("unroll") for (int i = 0; i < 16; ++i) ur[i] = *(const v4u*)(US + (size_t)ei[i >> 2][i & 3] * 128)
#define PU_L1(ei, h0, h1, mm) do { _Pragma("unroll") for (int q = 0; q < 4; ++q) ei[q] = *(const i32x4*)(IDX + (size_t)(mm) * 128 + 4 * q); \
        h0 = *(const v4u*)(HN + (size_t)(mm) * 1024); h1 = *(const v4u*)(HN + (size_t)(mm) * 1024 + 8); } while (0)
#define PU_X(xv, h0, h1) do { float f_[8]; unpack8(h0, f_); _Pragma("unroll") for (int i = 0; i < 4; ++i) xv[i] = (f32x2){f_[2 * i], f_[2 * i + 1]}; \
        unpack8(h1, f_); _Pragma("unroll") for (int i = 0; i < 4; ++i) xv[4 + i] = (f32x2){f_[2 * i], f_[2 * i + 1]}; } while (0)
    i32x4 ei[4]; v4u hA0, hA1, hB0, hB1; v4u urA[16], urB[16]; f32x2 xv[8];
    PU_L1(ei, hA0, hA1, m0);
    PU_ROWS(urA, ei);
    PU_L1(ei, hB0, hB1, PU_CLAMP(1));
    for (int k = 0; k < ntok; k += 2) {
        PU_ROWS(urB, ei);
        PU_X(xv, hA0, hA1);
        PU_L1(ei, hA0, hA1, PU_CLAMP(k + 2));
        peer_u_token(urA, xv, PART + (size_t)(m0 + k * stride) * 128, c8);
        if (k + 1 < ntok) {
            PU_ROWS(urA, ei);
            PU_X(xv, hB0, hB1);
            PU_L1(ei, hB0, hB1, PU_CLAMP(k + 3));
            peer_u_token(urB, xv, PART + (size_t)(m0 + (k + 1) * stride) * 128, c8);
        }
    }
#undef PU_CLAMP
#undef PU_ROWS
#undef PU_L1
#undef PU_X
}
__device__ __forceinline__ void peer_c(const P& p, int wave, int lane) {
    const int gw = blockIdx.x * NWAVES + wave, NGW = gridDim.x * NWAVES;
    const int* IDX = (const int*)(p.ws + WS_IDX); const float* GATE = (const float*)(p.ws + WS_GATE); const bf16* PART = (const bf16*)(p.ws + WS_PART);
    const float* USC = (const float*)(p.ws + WS_USC); const float* VSC = (const float*)(p.ws + WS_VSC); float* COEF = (float*)(p.ws + WS_COEF); const float* SS = (const float*)(p.ws + WS_SS);
    for (int m0 = gw * 2; m0 < T_; m0 += NGW * 2) {
        float s[2][2], rs[2], g[2][2]; int e[2][2];
#pragma unroll
        for (int u = 0; u < 2; ++u) {
            const int m = m0 + u;
            rs[u] = ffn_rstd(SS, m);
            s[u][0] = 0.f; s[u][1] = 0.f;
#pragma unroll
            for (int jj = 0; jj < 8; ++jj) { s[u][0] += bf2f(PART[((size_t)jj * T_ + m) * 128 + lane]); s[u][1] += bf2f(PART[((size_t)jj * T_ + m) * 128 + 64 + lane]); }
            e[u][0] = IDX[(size_t)m * 128 + lane]; e[u][1] = IDX[(size_t)m * 128 + 64 + lane];
            g[u][0] = GATE[(size_t)m * 128 + lane]; g[u][1] = GATE[(size_t)m * 128 + 64 + lane];
        }
        float us[2][2], vs[2][2];
#pragma unroll
        for (int u = 0; u < 2; ++u)
#pragma unroll
            for (int k = 0; k < 2; ++k) { us[u][k] = USC[e[u][k]]; vs[u][k] = VSC[e[u][k]]; }
#pragma unroll
        for (int u = 0; u < 2; ++u)
#pragma unroll
            for (int k = 0; k < 2; ++k) COEF[(size_t)(m0 + u) * 128 + 64 * k + lane] = g[u][k] * gelu_erf(s[u][k] * rs[u] * us[u][k]) * vs[u][k];
    }
}
struct PvPre { i32x4 ei[4]; f32x4 cf[4]; };
__device__ __forceinline__ void pv_level1(PvPre& q, const int* IDXg, const float* COEFg, int m, int c8) {
#pragma unroll
    for (int k = 0; k < 4; ++k) { q.ei[k] = *(const i32x4*)(IDXg + (size_t)m * 128 + 4 * k); q.cf[k] = *(const f32x4*)(COEFg + (size_t)m * 128 + 4 * k); }
}
__device__ __forceinline__ void peer_v_token(const v4u (&vr)[16], const f32x4 (&cf)[4], const bf16* H, bf16* out, bool b3, bool b4, bool b5) {
    f32x2 acc[8];
#pragma unroll
    for (int i = 0; i < 8; ++i) acc[i] = (f32x2){0.f, 0.f};
#pragma unroll
    for (int I = 0; I < 16; ++I) {
        const float cu = cf[I >> 2][I & 3];
        const f32x2 c2 = (f32x2){cu, cu}; f32x2 f[8]; cvt16_fp8(vr[I], f);
#pragma unroll
        for (int q = 0; q < 8; ++q) acc[q] += c2 * f[q];
    }
    f32x2 a1[4], a2[2], a3;
#pragma unroll
    for (int i = 0; i < 4; ++i) { const f32x2 keep = b5 ? acc[2 * i + 1] : acc[2 * i], send = b5 ? acc[2 * i] : acc[2 * i + 1];
        a1[i] = keep + (f32x2){__shfl_xor(send.x, 32), __shfl_xor(send.y, 32)}; }
#pragma unroll
    for (int i = 0; i < 2; ++i) { const f32x2 keep = b4 ? a1[2 * i + 1] : a1[2 * i], send = b4 ? a1[2 * i] : a1[2 * i + 1];
        a2[i] = keep + (f32x2){swz_f<0x1F | (16 << 10)>(send.x), swz_f<0x1F | (16 << 10)>(send.y)}; }
    { const f32x2 keep = b3 ? a2[1] : a2[0], send = b3 ? a2[0] : a2[1]; a3 = keep + (f32x2){swz_f<0x1F | (8 << 10)>(send.x), swz_f<0x1F | (8 << 10)>(send.y)}; }
    const unsigned hb = *(const unsigned*)H; const f32x2 hv = (f32x2){bflo(hb), bfhi(hb)};
    const f32x2 y = hv + a3;
    *(unsigned*)out = pk2(y.x, y.y);
}
__device__ __forceinline__ void peer_v(const P& p, int wave, int lane) {
    const int j = blockIdx.x & 7, nchunk = gridDim.x >> 3, chunk = blockIdx.x >> 3, stride = nchunk * 8;
    const int g = lane >> 3, c8 = lane & 7;
    const bool b5 = (lane & 32) != 0, b4 = (lane & 16) != 0, b3 = (lane & 8) != 0;
    const int pi = 4 * (b3 ? 1 : 0) + 2 * (b4 ? 1 : 0) + (b5 ? 1 : 0);
    const size_t colo = 128 * j + 16 * c8 + 2 * pi;
    const bf16* H = (const bf16*)(p.ws + WS_H) + colo; bf16* OUT = (bf16*)(p.ws + WS_YB) + colo;
    const int* IDXg = (const int*)(p.ws + WS_IDX) + 16 * g; const float* COEFg = (const float*)(p.ws + WS_COEF) + 16 * g;
    const unsigned char* VS = p.ws + WS_V8 + (size_t)j * NEXP * 128 + 16 * c8;
    const int m0 = chunk * 8 + wave, ntok = (T_ - m0 + stride - 1) / stride;
#define PV_CLAMP(k) (m0 + ((k) < ntok ? (k) : ntok - 1) * stride)
#define PV_ROWS(vr, q) _Pragma("unroll") for (int i = 0; i < 16; ++i) vr[i] = *(const v4u*)(VS + (size_t)q.ei[i >> 2][i & 3] * 128)
    PvPre q; v4u vrA[16], vrB[16]; f32x4 cA[4], cB[4];
    pv_level1(q, IDXg, COEFg, m0, c8);
    PV_ROWS(vrA, q);
#pragma unroll
    for (int k = 0; k < 4; ++k) cA[k] = q.cf[k];
    pv_level1(q, IDXg, COEFg, PV_CLAMP(1), c8);
    for (int k = 0; k < ntok; k += 2) {
        PV_ROWS(vrB, q);
#pragma unroll
        for (int kk = 0; kk < 4; ++kk) cB[kk] = q.cf[kk];
        pv_level1(q, IDXg, COEFg, PV_CLAMP(k + 2), c8);
        { const size_t mm = (size_t)(m0 + k * stride); peer_v_token(vrA, cA, H + mm * 1024, OUT + mm * 1024, b3, b4, b5); }
        if (k + 1 < ntok) {
            PV_ROWS(vrA, q);
#pragma unroll
            for (int kk = 0; kk < 4; ++kk) cA[kk] = q.cf[kk];
            pv_level1(q, IDXg, COEFg, PV_CLAMP(k + 3), c8);
            { const size_t mm = (size_t)(m0 + (k + 1) * stride); peer_v_token(vrB, cB, H + mm * 1024, OUT + mm * 1024, b3, b4, b5); }
        }
    }
#undef PV_CLAMP
#undef PV_ROWS
}
__device__ __forceinline__ void peer_f(const P& p, int wave, int lane) {
    const int gw = blockIdx.x * NWAVES + wave, NGW = gridDim.x * NWAVES;
    for (int m = gw; m < T_; m += NGW) {
        const v2u* yb = (const v2u*)((const bf16*)(p.ws + WS_YB) + (size_t)m * 1024) + lane;
        v2u yv[4]; float ss = 0.f;
#pragma unroll
        for (int q = 0; q < 4; ++q) { yv[q] = yb[64 * q]; const float a = bflo(yv[q].x), b = bfhi(yv[q].x), c = bflo(yv[q].y), d = bfhi(yv[q].y); ss += (a * a + b * b) + (c * c + d * d); }
        const float rstd = frsq(wave_sum(ss) * (1.f / 1024.f) + EPS);
        f32x4* o = (f32x4*)(p.out + (size_t)m * 1024) + lane; const f32x4* wr = (const f32x4*)p.norm_final_w + lane;
#pragma unroll
        for (int q = 0; q < 4; ++q) { const f32x4 w = wr[64 * q];
            o[64 * q] = (f32x4){bflo(yv[q].x) * rstd * w.x, bfhi(yv[q].x) * rstd * w.y, bflo(yv[q].y) * rstd * w.z, bfhi(yv[q].y) * rstd * w.w}; }
    }
}

constexpr int N_PHASES = 12;
struct Args { P p; int ph_lo, ph_hi; };
__global__ void __launch_bounds__(NTHR, 2) fwd_kernel(Args args) {
    extern __shared__ __attribute__((aligned(16))) unsigned char lds_raw[];
    LAS unsigned char* lds = (LAS unsigned char*)lds_raw;
    const P& p = args.p;
    const int tid = threadIdx.x, lane = tid & 63, wave = __builtin_amdgcn_readfirstlane(tid >> 6);
    volatile LAS unsigned* MISC = (volatile LAS unsigned*)(lds + MISC_OFF);
    for (int u = tid; u < (LDS_BYTES - LDSCTL_OFF) / 4; u += NTHR) ((LAS unsigned*)(lds + LDSCTL_OFF))[u] = 0u;
    __syncthreads();
    XcdBarrier bar; bar.bar = (unsigned*)(p.ws + WS_CTL) + CW_BAR; bar.x = 0; bar.st = nullptr;
#if !MK_PER_PHASE
    bar = xcd_barrier_post((unsigned*)(p.ws + WS_CTL) + CW_BAR, MISC + 8);
#endif
    const int lo = args.ph_lo, hi = args.ph_hi;
#define IN(k) (lo <= (k) && (k) < hi)
#ifndef PROBE_WAIT_LO
#define PROBE_WAIT_LO -1
#define PROBE_WAIT_HI -1
#endif
    volatile LAS unsigned long long* STAMP = (volatile LAS unsigned long long*)(lds + MISC_OFF + 256);
#define SEAM(k) do { if (IN(k) && IN((k) + 1)) xcd_barrier(bar); if (PROBE_WAIT_LO >= 0 && blockIdx.x == 0 && tid == 0) { STAMP[(k) + 1] = __builtin_amdgcn_s_memrealtime(); \
        if ((k) + 1 == N_PHASES - 1) { const unsigned long long d_ = STAMP[PROBE_WAIT_HI < 0 ? 0 : PROBE_WAIT_HI] - STAMP[PROBE_WAIT_LO < 0 ? 0 : PROBE_WAIT_LO]; \
            __hip_atomic_store((unsigned*)(p.ws + WS_CTL) + CW_Q + 256, (unsigned)d_ | 1u, __ATOMIC_RELAXED, __HIP_MEMORY_SCOPE_AGENT); } } } while (0)
    if (PROBE_WAIT_LO >= 0 && blockIdx.x == 0 && tid == 0) STAMP[0] = __builtin_amdgcn_s_memrealtime();

#ifndef PROBE_REP
#define PROBE_REP -1
#endif
#define REP(k) ((PROBE_REP == (k)) ? 2 : 1)
    if (IN(0)) {
#pragma unroll 1
        for (int r = 0; r < REP(0); ++r) p0_prologue(p, lds, wave, lane); } SEAM(0);
    if (IN(1)) {
#pragma unroll 1
      for (int r = 0; r < REP(1); ++r) {
        EpiProj e{(bf16*)(p.ws + WS_SBQKV), (bf16*)(p.ws + WS_VT), (bf16*)(p.ws + WS_MLQK), (bf16*)(p.ws + WS_MLV), (bf16*)(p.ws + WS_MLO), (bf16*)(p.ws + WS_GATES)};
        gemm<EpiProj>(lds, (const bf16*)(p.ws + WS_XN), (const bf16*)(p.ws + WS_W1T), T_, NPROJ, 1024, e); }
    } SEAM(1);
    if (IN(2)) { p2_conv(p, tid); } SEAM(2);
    if (IN(3)) {
        for (int it = blockIdx.x; it < 64; it += gridDim.x) mlstm_item(p, lds, it, tid, wave, lane);
        unsigned* qctr = (unsigned*)(p.ws + WS_CTL) + CW_Q;
#ifdef PROBE_P3SPLIT
        xcd_barrier(bar); if (blockIdx.x == 0 && tid == 0) STAMP[20] = __builtin_amdgcn_s_memrealtime();
#endif
        for (;;) {
            if (tid == 0) MISC[12] = __hip_atomic_fetch_add(qctr, 1u, __ATOMIC_RELAXED, __HIP_MEMORY_SCOPE_AGENT);
            __syncthreads();
            const unsigned it = MISC[12];
            __syncthreads();
            if (it >= 1024u) break;
            sba_item(p, (int)it, wave, lane);
        }
#ifdef PROBE_P3SPLIT
        xcd_barrier(bar); if (blockIdx.x == 0 && tid == 0) STAMP[21] = __builtin_amdgcn_s_memrealtime();
#endif
        for (;;) {
            if (tid == 0) MISC[12] = __hip_atomic_fetch_add(qctr + 128, 1u, __ATOMIC_RELAXED, __HIP_MEMORY_SCOPE_AGENT);
            __syncthreads();
            const unsigned it = MISC[12];
            __syncthreads();
            if (it >= (unsigned)N_FILL) break;
            fill_item(p, (int)it, wave, lane);
        }
    } SEAM(3);
    if (IN(4)) { p3_yml(p, wave, lane); } SEAM(4);
    if (IN(5)) {
        pg8::Gemm g{(const bf16*)p.out, (const bf16*)(p.ws + WS_WSBT), T_, 1024, 1024}; pg8::StaticOrder S; S.init(T_, 1024, (int)gridDim.x, (int)blockIdx.x);
        EpiMerge1 e{(bf16*)(p.ws + WS_MERGED), (const unsigned char*)(p.ws + WS_GATES)};
        pg8::gemm_phase<EpiMerge1, pg8::StaticOrder, true, true, true>(lds, g, S, e);
    } SEAM(5);
    if (IN(6)) {
        pg8::Gemm g{(const bf16*)(p.ws + WS_MERGED), (const bf16*)(p.ws + WS_WOUTT), T_, 1024, 1024}; pg8::StaticOrder S; S.init(T_, 1024, (int)gridDim.x, (int)blockIdx.x);
        EpiHW e{(bf16*)(p.ws + WS_H), p.x, (bf16*)p.out  , p.norm_ffn_w, (float*)(p.ws + WS_SS)};
        pg8::gemm_phase<EpiHW, pg8::StaticOrder, true, true>(lds, g, S, e);
    } SEAM(6);
    if (IN(7)) {
        pg8::Gemm g{(const bf16*)p.out, (const bf16*)(p.ws + WS_WCT), T_, 2048, 1024}; pg8::StaticOrder S; S.init(T_, 2048, (int)gridDim.x, (int)blockIdx.x);
        EpiTopk e{(int*)(p.ws + WS_IDX), (float*)(p.ws + WS_GATE), (const float*)(p.ws + WS_SS)};
#pragma unroll 1
        for (int i = 0;; ++i) { OneUnit s1; if (!S.next(i, s1.u)) break; pg8::gemm_phase<EpiTopk, OneUnit, false, true>(lds, g, s1, e); }
    } SEAM(7);
    if (IN(8)) { peer_u(p, wave, lane); } SEAM(8);
    if (IN(9)) { peer_c(p, wave, lane); } SEAM(9);
    if (IN(10)) { peer_v(p, wave, lane); } SEAM(10);
    if (IN(11)) { peer_f(p, wave, lane); }
    if (PROBE_WAIT_LO >= 0 && tid == 0) {
        unsigned* pw = (unsigned*)(p.ws + WS_CTL) + CW_Q + 256;
        unsigned dt = 0u;
        for (unsigned sp = 0; sp < (1u << 22); ++sp) { dt = __hip_atomic_load(pw, __ATOMIC_RELAXED, __HIP_MEMORY_SCOPE_AGENT); if (dt) break; __builtin_amdgcn_s_sleep(8); }
        const unsigned long long tend = __builtin_amdgcn_s_memrealtime();
        while (__builtin_amdgcn_s_memrealtime() - tend < (unsigned long long)dt) __builtin_amdgcn_s_sleep(8);
    }
#undef IN
#undef SEAM
}

extern "C" void kernel_launch(void* const* d_in, const int* in_sizes, int n_in, void* d_out, int out_size, void* d_ws, size_t ws_size, hipStream_t stream) {
    static int grid = 0;
    if (grid == 0) {
        if (n_in != 18 || in_sizes[0] != T_ * D_ || out_size != T_ * D_ || ws_size < WS_END) {
            fprintf(stderr, "kernel_launch: unexpected problem (n_in %d, in0 %d, out %d, ws %zu); nothing launched\n", n_in, n_in > 0 ? in_sizes[0] : -1, out_size, ws_size); grid = -1; return; }
        int dev = 0, cus = 0, per_cu = 0;
        if (hipGetDevice(&dev) != hipSuccess || hipDeviceGetAttribute(&cus, hipDeviceAttributeMultiprocessorCount, dev) != hipSuccess) { grid = -1; return; }
        if (hipFuncSetAttribute((const void*)fwd_kernel, hipFuncAttributeMaxDynamicSharedMemorySize, LDS_BYTES) != hipSuccess) { fprintf(stderr, "kernel_launch: hipFuncSetAttribute failed\n"); grid = -1; return; }
        if (hipOccupancyMaxActiveBlocksPerMultiprocessor(&per_cu, (const void*)fwd_kernel, NTHR, LDS_BYTES) != hipSuccess || per_cu < 1)
            fprintf(stderr, "kernel_launch: note: occupancy query reports %d workgroups per CU\n", per_cu);
        (void)hipGetLastError();
        grid = cus;
    }
    if (grid < 0) return;
    if (hipMemsetAsync((char*)d_ws + WS_CTL, 0, CTL_ZERO_BYTES, stream) != hipSuccess) { fprintf(stderr, "kernel_launch: memset failed\n"); return; }
    Args a{};
    const float** pp = (const float**)&a.p;
    for (int i = 0; i < 18; ++i) pp[i] = (const float*)d_in[i];
    a.p.out = (float*)d_out; a.p.ws = (unsigned char*)d_ws;
#if MK_PER_PHASE
    for (int ph = 0; ph < N_PHASES; ++ph) {
        a.ph_lo = ph; a.ph_hi = ph + 1;
        hipLaunchKernelGGL(fwd_kernel, dim3(grid), dim3(NTHR), LDS_BYTES, stream, a);
    }
#else
    a.ph_lo = 0; a.ph_hi = N_PHASES;
    hipLaunchKernelGGL(fwd_kernel, dim3(grid), dim3(NTHR), LDS_BYTES, stream, a);
#endif
    const hipError_t le = hipPeekAtLastError();
    if (le != hipSuccess) fprintf(stderr, "kernel_launch: launch failed: %s\n", hipGetErrorName(le));
}
```

```cpp
#include <hip/hip_runtime.h>
#include <cstdio>
#include <cstdint>
namespace pg8 {
#define PG8_LAS __attribute__((address_space(3)))
typedef unsigned short bf16_t;
typedef short bf16x8 __attribute__((ext_vector_type(8)));
typedef float f32x4 __attribute__((ext_vector_type(4)));
typedef unsigned u32x4 __attribute__((ext_vector_type(4)));
constexpr int BM = 256, BK = 64, HALF = 128, HTB = HALF * BK * 2  , STAGE_BYTES = 8 * HTB, NXCD = 8, WGM = 8;

__host__ __device__ __forceinline__ int lds_byte(int r, int c) { const int st = (r >> 4) * 2 + (c >> 5), rr = r & 15, cc = c & 31, ob = rr * 64 + cc * 2; return st * 1024 + (ob ^ (((ob >> 9) & 1) << 5)); }
__host__ __device__ __forceinline__ void stage_rc(int b, int& R, int& C) { const int st = b / 1024, sb = b % 1024, swz = sb ^ (((sb >> 9) & 1) << 5); R = (st >> 1) * 16 + swz / 64; C = (st & 1) * 32 + (swz % 64) / 2; }
__host__ __device__ __forceinline__ int perm32(int rho) { const int n = rho >> 4, i = rho & 15; return 8 * (i >> 2) + 4 * n + (i & 3); }

struct Unit { int pm, pn; };
struct Gemm { const bf16_t* A; const bf16_t* Bt; int M, N, K; };

struct StaticOrder {
    int nM, nN, nwg, G, c;
    __host__ __device__ void init(int M, int N, int G_, int c_) { nM = M / BM; nN = N / BM; nwg = nM * nN; G = G_; c = c_; }
    __host__ __device__ bool next(int i, Unit& u) const {
        const long L = (long)i * G + c; if (L >= nwg) return false;
        int wgid = (int)L; { const int q = nwg / NXCD, r = nwg % NXCD, xcd = wgid % NXCD, off = wgid / NXCD; wgid = (xcd < r ? xcd * (q + 1) : r * (q + 1) + (xcd - r) * q) + off; }
        const int nig = WGM * nN, gid = wgid / nig, fm = gid * WGM, gsz = (nM - fm) < WGM ? (nM - fm) : WGM;
        u.pm = fm + ((wgid % nig) % gsz); u.pn = (wgid % nig) / gsz; return true;
    }
    __device__ __forceinline__ void a_ready(const Unit&) const {}
    __device__ __forceinline__ void done(const Unit&) const {}
};

__device__ __forceinline__ unsigned cvt_pk_bf16(float lo, float hi) { unsigned r; asm volatile("v_cvt_pk_bf16_f32 %0, %1, %2" : "=v"(r) : "v"(lo), "v"(hi)); return r; }
template <class Epi, class Sched, bool ALIGN_EPI = false, bool SP2 = false, bool MID = false  >
__device__ __forceinline__ void gemm_phase(PG8_LAS unsigned char* lds, const Gemm g, const Sched& S, const Epi& E) {
    const int tid = threadIdx.x, wid = __builtin_amdgcn_readfirstlane(tid >> 6), lane = tid & 63, wr = wid >> 2, wc = wid & 3, fr = lane & 15, fq = lane >> 4;
    const int K = g.K, nt = K / BK;
    unsigned voffA[2], voffB[2];
#pragma unroll
    for (int i = 0; i < 2; ++i) { int R, C; stage_rc(tid * 16 + i * 8192, R, C); const int Rb = Epi::PERM ? ((R & ~31) + perm32(R & 31)) : R;
        voffA[i] = (unsigned)(R * K + C) * 2u; voffB[i] = (unsigned)(Rb * K + C) * 2u; }
    const size_t kstep = (size_t)(BK * 2);
    const size_t hstep = (size_t)HALF * K * 2;
    const size_t tstep = 2 * hstep;
    const unsigned ldsw = (unsigned)wid * 1024u;
    const int aoff = lds_byte(wr * 64 + fr, fq * 8), boff = lds_byte(wc * 32 + fr, fq * 8);
#define PG8_SA(b, h) (((b) * 2 + (h)) * HTB)
#define PG8_SB(b, h) ((4 + (b) * 2 + (h)) * HTB)
#define PG8_STAGE(bufoff, gbase, voff) do { _Pragma("unroll") for (int _i = 0; _i < 2; ++_i) \
        __builtin_amdgcn_global_load_lds((const unsigned*)((const char*)(gbase) + (voff)[_i]), (PG8_LAS unsigned*)(lds + (bufoff) + ldsw + _i * 8192), 16, 0, 0); } while (0)
#define PG8_LDA(dst, b, h) do { _Pragma("unroll") for (int m = 0; m < 4; ++m) _Pragma("unroll") for (int k = 0; k < 2; ++k) dst[m][k] = *(const PG8_LAS bf16x8*)(lds + PG8_SA(b, h) + aoff + m * 2048 + k * 1024); } while (0)
#define PG8_LDB(dst, b, h) do { _Pragma("unroll") for (int n = 0; n < 2; ++n) _Pragma("unroll") for (int k = 0; k < 2; ++k) dst[n][k] = *(const PG8_LAS bf16x8*)(lds + PG8_SB(b, h) + boff + n * 2048 + k * 1024); } while (0)
#define PG8_MMA(ai, bj, At, Bt) do { __builtin_amdgcn_s_setprio(1); _Pragma("unroll") for (int m = 0; m < 4; ++m) _Pragma("unroll") for (int n = 0; n < 2; ++n) _Pragma("unroll") for (int k = 0; k < 2; ++k) \
        acc[ai][bj][m][n] = __builtin_amdgcn_mfma_f32_16x16x32_bf16(Bt[n][k], At[m][k], acc[ai][bj][m][n], 0, 0, 0); __builtin_amdgcn_s_setprio(0); } while (0)
#define PG8_WAIT_V(n) asm volatile("s_waitcnt vmcnt(" #n ")" ::: "memory")
#define PG8_WAIT_L(n) asm volatile("s_waitcnt lgkmcnt(" #n ")" ::: "memory")
#define PG8_BAR __builtin_amdgcn_s_barrier()
#define PG8_SCHED __builtin_amdgcn_sched_barrier(0)
    Unit cur, nxt; int ui = 0;
    if (!S.next(0, cur)) return;
    f32x4 acc[2][2][4][2];
#pragma unroll
    for (int a = 0; a < 2; ++a)
#pragma unroll
        for (int b = 0; b < 2; ++b)
#pragma unroll
            for (int m = 0; m < 4; ++m)
#pragma unroll
                for (int n = 0; n < 2; ++n) acc[a][b][m][n] = (f32x4){0.f, 0.f, 0.f, 0.f};
    bf16x8 At[4][2], B0[2][2], B1[2][2];
    const char* cA = (const char*)g.A + (size_t)cur.pm * tstep; const char* cB = (const char*)g.Bt + (size_t)cur.pn * tstep;
    S.a_ready(cur);
    if constexpr (SP2) {
        PG8_STAGE(PG8_SB(0, 0), cB, voffB); PG8_STAGE(PG8_SB(0, 1), cB + hstep, voffB); PG8_STAGE(PG8_SA(0, 0), cA, voffA); PG8_STAGE(PG8_SA(0, 1), cA + hstep, voffA);
        if (wr == 1) PG8_BAR;
        PG8_WAIT_V(2); PG8_BAR;
        PG8_STAGE(PG8_SB(1, 0), cB + kstep, voffB); PG8_STAGE(PG8_SA(1, 0), cA + kstep, voffA); PG8_STAGE(PG8_SB(1, 1), cB + hstep + kstep, voffB);
        PG8_WAIT_V(6); PG8_BAR;
    } else {
        PG8_STAGE(PG8_SB(0, 0), cB, voffB); PG8_STAGE(PG8_SA(0, 0), cA, voffA); PG8_STAGE(PG8_SB(0, 1), cB + hstep, voffB); PG8_STAGE(PG8_SA(0, 1), cA + hstep, voffA);
        if (wr == 1) PG8_BAR;
        PG8_WAIT_V(4); PG8_BAR;
        PG8_STAGE(PG8_SB(1, 0), cB + kstep, voffB); PG8_STAGE(PG8_SA(1, 0), cA + kstep, voffA); PG8_STAGE(PG8_SB(1, 1), cB + hstep + kstep, voffB);
        PG8_WAIT_V(6); PG8_BAR;
    }
    for (;;) {
        const bool has_next = S.next(ui + 1, nxt);
        const char* nA = has_next ? (const char*)g.A + (size_t)nxt.pm * tstep : cA; const char* nB = has_next ? (const char*)g.Bt + (size_t)nxt.pn * tstep : cB;
        for (int t = 0; t < nt; t += 2) {
            if constexpr (MID) { if (t == (nt >> 1)) E.mid(acc, cur, wr, wc, fr, fq); }
            const bool last = (t == nt - 2);
            const char* a1 = cA + (size_t)(t + 1) * kstep;
            const char* a2 = last ? nA : cA + (size_t)(t + 2) * kstep; const char* b2 = last ? nB : cB + (size_t)(t + 2) * kstep;
            const char* a3 = a2 + kstep; const char* b3 = b2 + kstep;
            if (last && has_next) S.a_ready(nxt);
            if constexpr (SP2) {
            PG8_LDB(B0, 0, 0); PG8_LDB(B1, 0, 1); PG8_SCHED; PG8_LDA(At, 0, 0); PG8_STAGE(PG8_SA(1, 1), a1 + hstep, voffA);
            PG8_WAIT_V(8); PG8_WAIT_L(0); PG8_BAR; PG8_MMA(0, 0, At, B0); PG8_MMA(0, 1, At, B1); PG8_BAR; PG8_SCHED;
            PG8_LDA(At, 0, 1); PG8_STAGE(PG8_SB(0, 0), b2, voffB); PG8_STAGE(PG8_SB(0, 1), b2 + hstep, voffB); PG8_STAGE(PG8_SA(0, 0), a2, voffA);
            PG8_WAIT_V(8); PG8_WAIT_L(0); PG8_BAR; PG8_MMA(1, 0, At, B0); PG8_MMA(1, 1, At, B1); PG8_BAR; PG8_SCHED;
            PG8_LDB(B0, 1, 0); PG8_LDB(B1, 1, 1); PG8_SCHED; PG8_LDA(At, 1, 0); PG8_STAGE(PG8_SA(0, 1), a2 + hstep, voffA);
            PG8_WAIT_V(8); PG8_WAIT_L(0); PG8_BAR; PG8_MMA(0, 0, At, B0); PG8_MMA(0, 1, At, B1); PG8_BAR; PG8_SCHED;
            PG8_LDA(At, 1, 1); PG8_STAGE(PG8_SB(1, 0), b3, voffB); PG8_STAGE(PG8_SB(1, 1), b3 + hstep, voffB); PG8_STAGE(PG8_SA(1, 0), a3, voffA);
            PG8_WAIT_V(8); PG8_WAIT_L(0); PG8_BAR; PG8_MMA(1, 0, At, B0); PG8_MMA(1, 1, At, B1); PG8_BAR; PG8_SCHED;
            } else {
            PG8_LDB(B0, 0, 0); PG8_SCHED; PG8_LDA(At, 0, 0); PG8_STAGE(PG8_SA(1, 1), a1 + hstep, voffA);
            PG8_WAIT_L(8); PG8_BAR; PG8_WAIT_L(0); PG8_MMA(0, 0, At, B0); PG8_BAR; PG8_SCHED;
            PG8_LDB(B1, 0, 1); PG8_STAGE(PG8_SB(0, 0), b2, voffB);
            PG8_BAR; PG8_WAIT_L(0); PG8_MMA(0, 1, At, B1); PG8_BAR;
            PG8_LDA(At, 0, 1); PG8_STAGE(PG8_SA(0, 0), a2, voffA);
            PG8_BAR; PG8_WAIT_L(0); PG8_MMA(1, 0, At, B0); PG8_BAR; PG8_SCHED;
            PG8_STAGE(PG8_SB(0, 1), b2 + hstep, voffB);
            PG8_WAIT_V(6); PG8_BAR; PG8_MMA(1, 1, At, B1); PG8_BAR;
            PG8_LDB(B0, 1, 0); PG8_SCHED; PG8_LDA(At, 1, 0); PG8_STAGE(PG8_SA(0, 1), a2 + hstep, voffA);
            PG8_WAIT_L(8); PG8_BAR; PG8_WAIT_L(0); PG8_MMA(0, 0, At, B0); PG8_BAR; PG8_SCHED;
            PG8_LDB(B1, 1, 1); PG8_STAGE(PG8_SB(1, 0), b3, voffB);
            PG8_BAR; PG8_WAIT_L(0); PG8_MMA(0, 1, At, B1); PG8_BAR;
            PG8_LDA(At, 1, 1); PG8_STAGE(PG8_SA(1, 0), a3, voffA);
            PG8_BAR; PG8_WAIT_L(0); PG8_MMA(1, 0, At, B0); PG8_BAR; PG8_SCHED;
            PG8_STAGE(PG8_SB(1, 1), b3 + hstep, voffB);
            PG8_WAIT_V(6); PG8_BAR; PG8_MMA(1, 1, At, B1); PG8_BAR;
            }
        }
        if constexpr (ALIGN_EPI) { if (wr == 0) PG8_BAR; }
        if constexpr (!Epi::AFTER_DRAIN) { E(acc, cur, wr, wc, fr, fq); S.done(cur); }
        if (!has_next) break;
#pragma unroll
        for (int a = 0; a < 2; ++a)
#pragma unroll
            for (int b = 0; b < 2; ++b)
#pragma unroll
                for (int m = 0; m < 4; ++m)
#pragma unroll
                    for (int n = 0; n < 2; ++n) acc[a][b][m][n] = (f32x4){0.f, 0.f, 0.f, 0.f};
        cur = nxt; cA = nA; cB = nB; ++ui;
        if constexpr (ALIGN_EPI) { if (wr == 1) PG8_BAR; }
    }
    PG8_WAIT_V(0);
    if constexpr (!ALIGN_EPI) { if (wr == 0) PG8_BAR; }
    PG8_BAR;
    if constexpr (Epi::AFTER_DRAIN) { E.fused(acc, cur, wr, wc, fr, fq, lds, wid, lane); S.done(cur); }
#undef PG8_SA
#undef PG8_SB
#undef PG8_STAGE
#undef PG8_LDA
#undef PG8_LDB
#undef PG8_MMA
#undef PG8_WAIT_V
#undef PG8_WAIT_L
#undef PG8_BAR
#undef PG8_SCHED
}
}

#ifndef MK_PER_PHASE
#define MK_PER_PHASE 0
#endif
#ifndef USE_PG8
#define USE_PG8 1
#endif
constexpr int NWAVES = 8, NTHR = 512;

constexpr int B_ = 16, S_ = 2048, D_ = 1024, T_ = B_ * S_;
constexpr int INC = 5640, NPROJ = 5632;
constexpr int NEXP = 16384;
constexpr float EPS = 1e-6f;

constexpr size_t MiB = 1u << 20;
constexpr size_t WS_CTL = 0, CTL_ZERO_BYTES = 1 * MiB;
constexpr size_t WS_W1T = 2 * MiB, WS_WSBT = 13 * MiB, WS_WMLT = 14 * MiB, WS_WOUTT = 15 * MiB, WS_WCT = 17 * MiB, WS_IFG = 21 * MiB;
constexpr size_t WS_U8 = 24 * MiB, WS_V8 = 40 * MiB, WS_USC = 22 * MiB, WS_VSC = 23 * MiB;
constexpr size_t WS_XN = 88 * MiB, WS_QC = 88 * MiB, WS_KC = 120 * MiB;
constexpr size_t WS_SBQKV = 152 * MiB  , WS_VT = 216 * MiB  , WS_MLQK = 248 * MiB, WS_MLV = 312 * MiB, WS_MLO = 344 * MiB, WS_GATES = 376 * MiB;
constexpr size_t WS_MERGED = 216 * MiB, WS_H = 88 * MiB, WS_HN = 216 * MiB, WS_IDX = 280 * MiB, WS_GATE = 296 * MiB, WS_SC = 312 * MiB;
constexpr size_t WS_PART = 312 * MiB  , WS_SSQ = 504 * MiB  , WS_COEF = 56 * MiB  , WS_YB = 152 * MiB  , WS_HN8 = 440 * MiB  , WS_XS = 505 * MiB  , WS_SS = 506 * MiB  ;
constexpr size_t WS_END = 508 * MiB;
constexpr int CW_BAR = 4096, CW_Q = 8192;

constexpr int RING_OFF = 0, RING_BYTES = 135168;
constexpr int LDSCTL_OFF = RING_BYTES, MISC_OFF = LDSCTL_OFF + 320;
constexpr int LDS_BYTES = 147456;

#define GAS __attribute__((address_space(1)))
#define LAS __attribute__((address_space(3)))
typedef unsigned short bf16;
typedef unsigned v4u __attribute__((ext_vector_type(4)));
typedef unsigned v2u __attribute__((ext_vector_type(2)));
typedef float f32x4 __attribute__((ext_vector_type(4)));
#define LDS_WAIT() asm volatile("s_waitcnt lgkmcnt(0)" ::: "memory")
#define VM_WAIT() asm volatile("s_waitcnt vmcnt(0)" ::: "memory")
typedef float f32x2_t __attribute__((ext_vector_type(2))); typedef __bf16 bf16x2_t __attribute__((ext_vector_type(2)));
__device__ __forceinline__ unsigned cvtpk(float lo, float hi) { f32x2_t v = {lo, hi}; bf16x2_t b = __builtin_convertvector(v, bf16x2_t); return __builtin_bit_cast(unsigned, b); }
__device__ __forceinline__ unsigned f2bf(float f) { return cvtpk(f, f) & 0xffffu; }
__device__ __forceinline__ unsigned pk2(float lo, float hi) { return cvtpk(lo, hi); }
__device__ __forceinline__ float bflo(unsigned u) { return __builtin_bit_cast(float, u << 16); }
__device__ __forceinline__ float bfhi(unsigned u) { return __builtin_bit_cast(float, u & 0xffff0000u); }
__device__ __forceinline__ float bf2f(bf16 b) { return __builtin_bit_cast(float, (unsigned)b << 16); }
__device__ __forceinline__ float fexp(float x) { return __builtin_amdgcn_exp2f(x * 1.4426950408889634f); }
__device__ __forceinline__ float flog(float x) { return __builtin_amdgcn_logf(x) * 0.6931471805599453f; }
__device__ __forceinline__ float frcp(float x) { return __builtin_amdgcn_rcpf(x); }
__device__ __forceinline__ float frsq(float x) { return __builtin_amdgcn_rsqf(x); }
__device__ __forceinline__ float sigmoidf_(float x) { return frcp(1.f + fexp(-x)); }
__device__ __forceinline__ float wave_sum(float v) {
#pragma unroll
    for (int o = 1; o < 64; o <<= 1) v += __shfl_xor(v, o);
    return v;
}
__device__ __forceinline__ unsigned wave_max_u(unsigned v) {
#pragma unroll
    for (int o = 1; o < 64; o <<= 1) { const unsigned w = (unsigned)__shfl_xor((int)v, o); v = v > w ? v : w; }
    return v;
}
struct F8 { float v[8]; };
__device__ __forceinline__ void unpack8(const v4u& u, float (&f)[8]) {
    f[0] = bflo(u.x); f[1] = bfhi(u.x); f[2] = bflo(u.y); f[3] = bfhi(u.y); f[4] = bflo(u.z); f[5] = bfhi(u.z); f[6] = bflo(u.w); f[7] = bfhi(u.w);
}
__device__ __forceinline__ v4u pack8(const float (&f)[8]) { v4u o; o.x = pk2(f[0], f[1]); o.y = pk2(f[2], f[3]); o.z = pk2(f[4], f[5]); o.w = pk2(f[6], f[7]); return o; }

#define XB_TMO      128
#define XB_XCNT(j)  (256  + 64 * (j))
#define XB_XSUB(j)  (1280 + 64 * (j))
#define XB_XGEN(j)  (2304 + 64 * (j))
#define XB_TOP      3328
#define XB_TOPGEN   3392
#define XCD_BAR_WORDS 3456
#define XB_SPIN_CAP (1u << 24)

__device__ __forceinline__ unsigned xb_ld(unsigned* p)              { return __hip_atomic_load(p, __ATOMIC_RELAXED, __HIP_MEMORY_SCOPE_AGENT); }
__device__ __forceinline__ unsigned xb_add(unsigned* p, unsigned v) { return __hip_atomic_fetch_add(p, v, __ATOMIC_RELAXED, __HIP_MEMORY_SCOPE_AGENT); }
__device__ __forceinline__ unsigned xb_xcc_id() { return (unsigned)__builtin_amdgcn_s_getreg((3 << 11) | 20) & 0xFu; }
#define XB_SPIN(cond, bar) do { unsigned _sp = 0; while (cond) { __builtin_amdgcn_s_sleep(1); \
    if ((++_sp & 255u) == 0u) { if (xb_ld(&(bar)[XB_TMO])) break; if (_sp > XB_SPIN_CAP) { atomicAdd(&(bar)[XB_TMO], 1u); break; } } } } while (0)

struct XcdBarrier {
    unsigned* bar; unsigned x;
    volatile LAS unsigned* st;
};

__device__ __forceinline__ XcdBarrier xcd_barrier_post(unsigned* bar, volatile LAS unsigned* st) {
    XcdBarrier b; b.bar = bar; b.x = xb_xcc_id(); b.st = st;
    if (threadIdx.x == 0) (void)xb_add(&bar[XB_XCNT(b.x)], 1u);
    return b;
}
__device__ __forceinline__ void xcd_barrier_complete(unsigned* bar, unsigned x, unsigned& nloc, unsigned& nx) {
    const unsigned G = gridDim.x * gridDim.y * gridDim.z;
    unsigned sum, cnt, mine, sp = 0u;
    for (;;) {
        sum = 0u; cnt = 0u; mine = 0u;
#pragma unroll
        for (unsigned j = 0; j < 16; ++j) { const unsigned c = xb_ld(&bar[XB_XCNT(j)]); sum += c; cnt += (c > 0u) ? 1u : 0u; mine = (j == x) ? c : mine; }
        if (sum == G) break;
        __builtin_amdgcn_s_sleep(1);
        if ((++sp & 255u) == 0u) { if (xb_ld(&bar[XB_TMO])) break; if (sp > XB_SPIN_CAP) { atomicAdd(&bar[XB_TMO], 1u); break; } }
    }
    nloc = mine > 0u ? mine : 1u; nx = cnt > 0u ? cnt : 1u;
}

__device__ __forceinline__ void xcd_barrier(const XcdBarrier& b) {
    asm volatile("s_waitcnt vmcnt(0)" ::: "memory");
    __syncthreads();
    if (threadIdx.x == 0) {
        unsigned* bar = b.bar;
        __builtin_amdgcn_s_waitcnt(0);
        unsigned nloc = b.st[0], nx = b.st[1];
        if (nloc == 0u) { xcd_barrier_complete(bar, b.x, nloc, nx); b.st[0] = nloc; b.st[1] = nx; }
        const unsigned old = xb_add(&bar[XB_XSUB(b.x)], 1u);
        const unsigned gen = old / nloc;
        if (old + 1u == (gen + 1u) * nloc) {
            __builtin_amdgcn_fence(__ATOMIC_RELEASE, "agent");
            asm volatile("s_waitcnt vmcnt(0)" ::: "memory");
            const unsigned og = xb_add(&bar[XB_TOP], 1u);
            const unsigned tg = og / nx;
            if (og + 1u == (tg + 1u) * nx) xb_add(&bar[XB_TOPGEN], 1u);
            else XB_SPIN(xb_ld(&bar[XB_TOPGEN]) == tg, bar);
            __builtin_amdgcn_fence(__ATOMIC_ACQUIRE, "agent");
            xb_add(&bar[XB_XGEN(b.x)], 1u);
            asm volatile("s_waitcnt vmcnt(0)" ::: "memory");
        } else {
            XB_SPIN(xb_ld(&bar[XB_XGEN(b.x)]) == gen, bar);
            __builtin_amdgcn_fence(__ATOMIC_ACQUIRE, "agent");
            asm volatile("s_waitcnt vmcnt(0)" ::: "memory");
        }
    }
    __syncthreads();
}

struct EpiProj {
    bf16 *sbqk, *vt, *mlqk, *mlv, *mlo, *gates;
    __device__ __forceinline__ void operator()(int row, int col, const F8& a) const {
        bf16* dst;
        if (col < 1024) dst = sbqk + (size_t)row * 1024 + col;
        else if (col < 1536) {
            const int c = col - 1024, hh = c >> 6, d = c & 63, b = row >> 11, sq = row & 2047;
            bf16* vp = vt + ((size_t)(b * 8 + hh) * 64 + d) * 2048 + sq;
#pragma unroll
            for (int i = 0; i < 8; ++i) vp[(size_t)i * 2048] = (bf16)f2bf(a.v[i]);
            return;
        }
        else if (col < 2560) dst = mlqk + (size_t)row * 1024 + (col - 1536);
        else if (col < 3072) dst = mlv + (size_t)row * 512 + (col - 2560);
        else if (col < 3584) dst = mlo + (size_t)row * 512 + (col - 3072);
        else {
            unsigned q[8];
#pragma unroll
            for (int i = 0; i < 8; ++i) { const float sg = sigmoidf_(a.v[i]) * 255.f + 0.5f; q[i] = (unsigned)fminf(fmaxf(sg, 1.f), 255.f); }
            *(v2u*)((unsigned char*)gates + (size_t)row * 2048 + (col - 3584)) = (v2u){q[0] | (q[1] << 8) | (q[2] << 16) | (q[3] << 24), q[4] | (q[5] << 8) | (q[6] << 16) | (q[7] << 24)};
            return;
        }
        *(v4u*)dst = pack8(a.v);
    }
};
struct EpiMergeA {
    bf16* merged; const bf16* gates;
    __device__ __forceinline__ void operator()(int row, int col, const F8& a) const {
        float g[8], o[8]; unpack8(*(const v4u*)(gates + (size_t)row * 2048 + col), g);
#pragma unroll
        for (int i = 0; i < 8; ++i) o[i] = sigmoidf_(g[i]) * a.v[i];
        *(v4u*)(merged + (size_t)row * 1024 + col) = pack8(o);
    }
};
struct EpiMergeB {
    bf16* merged; const bf16* gates;
    __device__ __forceinline__ void operator()(int row, int col, const F8& a) const {
        float g[8], o[8]; unpack8(*(const v4u*)(gates + (size_t)row * 2048 + 1024 + col), g);
        unpack8(*(const v4u*)(merged + (size_t)row * 1024 + col), o);
#pragma unroll
        for (int i = 0; i < 8; ++i) o[i] += sigmoidf_(g[i]) * a.v[i];
        *(v4u*)(merged + (size_t)row * 1024 + col) = pack8(o);
    }
};
struct EpiH {
    float* h; const float* x;
    __device__ __forceinline__ void operator()(int row, int col, const F8& a) const {
        const f32x4 x0 = *(const f32x4*)(x + (size_t)row * 1024 + col), x1 = *(const f32x4*)(x + (size_t)row * 1024 + col + 4);
        *(f32x4*)(h + (size_t)row * 1024 + col) = (f32x4){x0.x + a.v[0], x0.y + a.v[1], x0.z + a.v[2], x0.w + a.v[3]};
        *(f32x4*)(h + (size_t)row * 1024 + col + 4) = (f32x4){x1.x + a.v[4], x1.y + a.v[5], x1.z + a.v[6], x1.w + a.v[7]};
    }
};
struct EpiF32 {
    float* o; int ldc;
    __device__ __forceinline__ void operator()(int row, int col, const F8& a) const {
        *(f32x4*)(o + (size_t)row * ldc + col) = (f32x4){a.v[0], a.v[1], a.v[2], a.v[3]};
        *(f32x4*)(o + (size_t)row * ldc + col + 4) = (f32x4){a.v[4], a.v[5], a.v[6], a.v[7]};
    }
};

template <class E> struct EpiAdapt {
    static constexpr bool PERM = true, AFTER_DRAIN = false;
    E e;
    __device__ __forceinline__ void operator()(const pg8::f32x4 (&acc)[2][2][4][2], const pg8::Unit& u, int wr, int wc, int fr, int fq) const {
#pragma unroll
        for (int ai = 0; ai < 2; ++ai)
#pragma unroll
            for (int m = 0; m < 4; ++m) {
                const int row = u.pm * 256 + ai * 128 + wr * 64 + m * 16 + fr;
#pragma unroll
                for (int bj = 0; bj < 2; ++bj) {
                    const int col = u.pn * 256 + bj * 128 + wc * 32 + 8 * fq;
                    F8 a; const pg8::f32x4 v0 = acc[ai][bj][m][0], v1 = acc[ai][bj][m][1];
                    a.v[0] = v0[0]; a.v[1] = v0[1]; a.v[2] = v0[2]; a.v[3] = v0[3]; a.v[4] = v1[0]; a.v[5] = v1[1]; a.v[6] = v1[2]; a.v[7] = v1[3];
                    e(row, col, a);
                }
            }
    }
};

struct EpiMerge1 {
    static constexpr bool PERM = true, AFTER_DRAIN = false;
    bf16* merged; const unsigned char* gates;
    static __device__ __forceinline__ void ub8(const v2u& w, float (&f)[8]) {
        f[0] = (float)(w.x & 0xffu); f[1] = (float)((w.x >> 8) & 0xffu); f[2] = (float)((w.x >> 16) & 0xffu); f[3] = (float)(w.x >> 24);
        f[4] = (float)(w.y & 0xffu); f[5] = (float)((w.y >> 8) & 0xffu); f[6] = (float)((w.y >> 16) & 0xffu); f[7] = (float)(w.y >> 24);
    }
    __device__ __forceinline__ void mid(pg8::f32x4 (&acc)[2][2][4][2], const pg8::Unit& u, int wr, int wc, int fr, int fq) const {
#pragma unroll
        for (int ai = 0; ai < 2; ++ai)
#pragma unroll
            for (int m = 0; m < 4; ++m) {
                const int row = u.pm * 256 + ai * 128 + wr * 64 + m * 16 + fr;
#pragma unroll
                for (int bj = 0; bj < 2; ++bj) {
                    const int col = u.pn * 256 + bj * 128 + wc * 32 + 8 * fq;
                    float gs[8], gm[8]; ub8(*(const v2u*)(gates + (size_t)row * 2048 + col), gs); ub8(*(const v2u*)(gates + (size_t)row * 2048 + 1024 + col), gm);
#pragma unroll
                    for (int i = 0; i < 8; ++i) acc[ai][bj][m][i >> 2][i & 3] *= gs[i] * frcp(gm[i]);
                }
            }
    }
    __device__ __forceinline__ void operator()(const pg8::f32x4 (&acc)[2][2][4][2], const pg8::Unit& u, int wr, int wc, int fr, int fq) const {
#pragma unroll
        for (int ai = 0; ai < 2; ++ai)
#pragma unroll
            for (int m = 0; m < 4; ++m) {
                const int row = u.pm * 256 + ai * 128 + wr * 64 + m * 16 + fr;
#pragma unroll
                for (int bj = 0; bj < 2; ++bj) {
                    const int col = u.pn * 256 + bj * 128 + wc * 32 + 8 * fq;
                    float gm[8], o[8]; ub8(*(const v2u*)(gates + (size_t)row * 2048 + 1024 + col), gm);
#pragma unroll
                    for (int i = 0; i < 8; ++i) o[i] = gm[i] * (1.f / 255.f) * acc[ai][bj][m][i >> 2][i & 3];
                    *(v4u*)(merged + (size_t)row * 1024 + col) = pack8(o);
                }
            }
    }
};
struct EpiHW {
    static constexpr bool PERM = true, AFTER_DRAIN = false;
    bf16* h; const float* x; bf16* hw; const float* wffn; float* ss;
    __device__ __forceinline__ void operator()(const pg8::f32x4 (&acc)[2][2][4][2], const pg8::Unit& u, int wr, int wc, int fr, int fq) const {
#pragma unroll
        for (int ai = 0; ai < 2; ++ai)
#pragma unroll
            for (int m = 0; m < 4; ++m) {
                const int row = u.pm * 256 + ai * 128 + wr * 64 + m * 16 + fr;
                float sq = 0.f;
#pragma unroll
                for (int bj = 0; bj < 2; ++bj) {
                    const int col = u.pn * 256 + bj * 128 + wc * 32 + 8 * fq;
                    const size_t o = (size_t)row * 1024 + col;
                    const f32x4 x0 = *(const f32x4*)(x + o), x1 = *(const f32x4*)(x + o + 4);
                    const f32x4 w0 = *(const f32x4*)(wffn + col), w1 = *(const f32x4*)(wffn + col + 4);
                    const pg8::f32x4 v0 = acc[ai][bj][m][0], v1 = acc[ai][bj][m][1];
                    const f32x4 h0 = (f32x4){x0.x + v0[0], x0.y + v0[1], x0.z + v0[2], x0.w + v0[3]}, h1 = (f32x4){x1.x + v1[0], x1.y + v1[1], x1.z + v1[2], x1.w + v1[3]};
                    *(v4u*)(h + o) = (v4u){pk2(h0.x, h0.y), pk2(h0.z, h0.w), pk2(h1.x, h1.y), pk2(h1.z, h1.w)};
                    *(v4u*)(hw + o) = (v4u){pk2(h0.x * w0.x, h0.y * w0.y), pk2(h0.z * w0.z, h0.w * w0.w), pk2(h1.x * w1.x, h1.y * w1.y), pk2(h1.z * w1.z, h1.w * w1.w)};
                    sq += (h0.x * h0.x + h0.y * h0.y) + (h0.z * h0.z + h0.w * h0.w) + (h1.x * h1.x + h1.y * h1.y) + (h1.z * h1.z + h1.w * h1.w);
                }
                sq += __shfl_xor(sq, 16); sq += __shfl_xor(sq, 32);
                if (fq == 0) ss[(size_t)row * 16 + u.pn * 4 + wc] = sq;
            }
    }
};

template <class E>
__device__ __forceinline__ void simple_gemm(LAS unsigned char* lds, const bf16* A, const bf16* Bt, int M, int N, int K, const E& e) {
    LAS float* As = (LAS float*)lds;
    LAS float* Bs = As + 32 * 132;
    const int tid = threadIdx.x, ty = tid >> 4, tx = tid & 15;
    const int ntn = N / 128, ntiles = (M / 128) * ntn;
    for (int tile = blockIdx.x; tile < ntiles; tile += gridDim.x) {
        const int tm = tile / ntn, tn = tile % ntn;
        float acc[4][8];
#pragma unroll
        for (int i = 0; i < 4; ++i)
#pragma unroll
            for (int j = 0; j < 8; ++j) acc[i][j] = 0.f;
        for (int k0 = 0; k0 < K; k0 += 32) {
            {
                const int r = tid >> 2, kq = (tid & 3) * 8;
                float fa[8], fb[8];
                unpack8(*(const v4u*)(A + (size_t)(tm * 128 + r) * K + k0 + kq), fa);
                unpack8(*(const v4u*)(Bt + (size_t)(tn * 128 + r) * K + k0 + kq), fb);
#pragma unroll
                for (int i = 0; i < 8; ++i) { As[(kq + i) * 132 + r] = fa[i]; Bs[(kq + i) * 132 + r] = fb[i]; }
            }
            __syncthreads();
#pragma unroll 8
            for (int k = 0; k < 32; ++k) {
                const f32x4 a4 = *(const LAS f32x4*)(As + k * 132 + ty * 4);
                const f32x4 b0 = *(const LAS f32x4*)(Bs + k * 132 + tx * 8), b1 = *(const LAS f32x4*)(Bs + k * 132 + tx * 8 + 4);
                const float av[4] = {a4.x, a4.y, a4.z, a4.w};
                const float bv[8] = {b0.x, b0.y, b0.z, b0.w, b1.x, b1.y, b1.z, b1.w};
#pragma unroll
                for (int i = 0; i < 4; ++i)
#pragma unroll
                    for (int j = 0; j < 8; ++j) acc[i][j] += av[i] * bv[j];
            }
            __syncthreads();
        }
#pragma unroll
        for (int i = 0; i < 4; ++i) {
            F8 a;
#pragma unroll
            for (int j = 0; j < 8; ++j) a.v[j] = acc[i][j];
            e(tm * 128 + ty * 4 + i, tn * 128 + tx * 8, a);
        }
    }
}

template <class E>
__device__ __forceinline__ void gemm(LAS unsigned char* lds, const bf16* A, const bf16* Bt, int M, int N, int K, const E& e) {
#if USE_PG8
    pg8::Gemm g{A, Bt, M, N, K}; pg8::StaticOrder S; S.init(M, N, (int)gridDim.x, (int)blockIdx.x);
    EpiAdapt<E> ea{e};
    pg8::gemm_phase<EpiAdapt<E>, pg8::StaticOrder, true, true>(lds, g, S, ea);
#else
    simple_gemm<E>(lds, A, Bt, M, N, K, e);
#endif
}

__device__ __forceinline__ void transpose_item(const float* W, int ldw, int K, bf16* WT, int src_col0, int dst_row0, LAS float* scr, int kb, int lane) {
    const int k0 = 64 * kb;
#pragma unroll 8
    for (int i = 0; i < 32; ++i) { const int kk = 2 * i + (lane >> 5); scr[kk * 33 + (lane & 31)] = W[(size_t)(k0 + kk) * ldw + src_col0 + (lane & 31)]; }
    LDS_WAIT(); asm volatile("" ::: "memory");
    const int c = lane & 7;
#pragma unroll
    for (int j = 0; j < 4; ++j) { const int n = (lane >> 3) + 8 * j; const LAS float* s = scr + (8 * c) * 33 + n;
        v4u o; o.x = pk2(s[0 * 33], s[1 * 33]); o.y = pk2(s[2 * 33], s[3 * 33]); o.z = pk2(s[4 * 33], s[5 * 33]); o.w = pk2(s[6 * 33], s[7 * 33]);
        *(v4u*)(WT + (size_t)(dst_row0 + n) * K + k0 + 8 * c) = o; }
    LDS_WAIT(); asm volatile("" ::: "memory");
}

struct P {
    const float *x, *norm_mix_w, *w_in, *conv_w, *conv_b, *b_i, *b_f, *ml_norm_w, *w_sb, *w_ml, *w_out, *norm_ffn_w, *w_query, *keys1, *keys2, *peer_u, *peer_v, *norm_final_w;
    float* out; unsigned char* ws;
};

__device__ __forceinline__ void p0_prologue(const P& p, LAS unsigned char* lds, int wave, int lane) {
    LAS float* scr = (LAS float*)(lds + wave * 8448);
    const int gw = blockIdx.x * NWAVES + wave, NGW = gridDim.x * NWAVES;
    bf16* W1T = (bf16*)(p.ws + WS_W1T); bf16* WSBT = (bf16*)(p.ws + WS_WSBT); bf16* WMLT = (bf16*)(p.ws + WS_WMLT); bf16* WOUTT = (bf16*)(p.ws + WS_WOUTT); bf16* WCT = (bf16*)(p.ws + WS_WCT);
    constexpr int I_1 = 16 * 176, I_SB = 8 * 32, I_ML = 8 * 32, I_O = 16 * 32, NT = I_1 + I_SB + I_ML + I_O;
    for (int it = gw; it < NT; it += NGW) {
        int r = it;
        if (r < I_1) { const int kb = r / 176, nb = r % 176, n0 = nb * 32; transpose_item(p.w_in, INC, 1024, W1T, n0 < 3584 ? n0 : n0 + 8, n0, scr, kb, lane); continue; } r -= I_1;
        if (r < I_SB) { const int kb = r / 32, nb = r % 32; transpose_item(p.w_sb, 1024, 1024, WSBT, nb * 32, nb * 32, scr, kb, lane);             continue; } r -= I_SB;
        if (r < I_ML) { const int kb = r / 32, nb = r % 32; transpose_item(p.w_ml, 1024, 1024, WSBT + 512, nb * 32, nb * 32, scr, kb, lane); continue; } r -= I_ML;
        { const int kb = r / 32, nb = r % 32; transpose_item(p.w_out, 1024, 1024, WOUTT, nb * 32, nb * 32, scr, kb, lane); }
    }
    bf16* XN = (bf16*)(p.ws + WS_XN); float* IFG = (float*)(p.ws + WS_IFG);
    LAS float* WG = (LAS float*)(lds + 8 * 8448);
    __syncthreads();
    for (int i = threadIdx.x; i < 2048; i += NTHR) { const int k = i >> 1, hf = i & 1; *(LAS f32x4*)(WG + k * 8 + hf * 4) = *(const f32x4*)(p.w_in + (size_t)k * INC + 3584 + hf * 4); }
    __syncthreads();
    for (int m0 = gw * 2; m0 < T_; m0 += NGW * 2) {
        const f32x4* wr = (const f32x4*)p.norm_mix_w + lane;
        f32x4 v[2][4]; float ss[2] = {0.f, 0.f};
#pragma unroll
        for (int u = 0; u < 2; ++u) { const f32x4* xr = (const f32x4*)(p.x + (size_t)(m0 + u) * 1024) + lane;
#pragma unroll
            for (int j = 0; j < 4; ++j) v[u][j] = xr[64 * j]; }
#pragma unroll
        for (int u = 0; u < 2; ++u)
#pragma unroll
            for (int j = 0; j < 4; ++j) ss[u] += (v[u][j].x * v[u][j].x + v[u][j].y * v[u][j].y) + (v[u][j].z * v[u][j].z + v[u][j].w * v[u][j].w);
#pragma unroll
        for (int o = 1; o < 64; o <<= 1) { ss[0] += __shfl_xor(ss[0], o); ss[1] += __shfl_xor(ss[1], o); }
#pragma unroll
        for (int u = 0; u < 2; ++u) {
            const int m = m0 + u;
            const float rstd = frsq(ss[u] * (1.f / 1024.f) + EPS);
            float g[8];
#pragma unroll
            for (int i = 0; i < 8; ++i) g[i] = 0.f;
            v2u* o8 = (v2u*)(XN + (size_t)m * 1024) + lane;
#pragma unroll
            for (int j = 0; j < 4; ++j) {
                const f32x4 w = wr[64 * j];
                const float y[4] = {v[u][j].x * rstd * w.x, v[u][j].y * rstd * w.y, v[u][j].z * rstd * w.z, v[u][j].w * rstd * w.w};
                o8[64 * j] = (v2u){pk2(y[0], y[1]), pk2(y[2], y[3])};
#pragma unroll
                for (int q = 0; q < 4; ++q) {
                    const int k = 256 * j + 4 * lane + q;
                    const f32x4 w0 = *(const LAS f32x4*)(WG + k * 8), w1 = *(const LAS f32x4*)(WG + k * 8 + 4);
                    g[0] += y[q] * w0.x; g[1] += y[q] * w0.y; g[2] += y[q] * w0.z; g[3] += y[q] * w0.w;
                    g[4] += y[q] * w1.x; g[5] += y[q] * w1.y; g[6] += y[q] * w1.z; g[7] += y[q] * w1.w;
                }
            }
            {
                const bool b5 = (lane & 32) != 0, b4 = (lane & 16) != 0, b3 = (lane & 8) != 0;
                float e4[4], f2[2], gs;
#pragma unroll
                for (int i = 0; i < 4; ++i) { const float keep = b5 ? g[2 * i + 1] : g[2 * i], send = b5 ? g[2 * i] : g[2 * i + 1]; e4[i] = keep + __shfl_xor(send, 32); }
#pragma unroll
                for (int i = 0; i < 2; ++i) { const float keep = b4 ? e4[2 * i + 1] : e4[2 * i], send = b4 ? e4[2 * i] : e4[2 * i + 1]; f2[i] = keep + __shfl_xor(send, 16); }
                { const float keep = b3 ? f2[1] : f2[0], send = b3 ? f2[0] : f2[1]; gs = keep + __shfl_xor(send, 8); }
                gs += __shfl_xor(gs, 4); gs += __shfl_xor(gs, 2); gs += __shfl_xor(gs, 1);
                const int gi = 4 * (b3 ? 1 : 0) + 2 * (b4 ? 1 : 0) + (b5 ? 1 : 0);
                if ((lane & 7) == 0) IFG[(size_t)m * 8 + gi] = gs + (gi < 4 ? p.b_i[gi] : p.b_f[gi - 4]);
            }
        }
    }
}

__device__ __forceinline__ void fill_wc(const P& p, int it, int lane) {
    bf16* WCT = (bf16*)(p.ws + WS_WCT);
    const int hhf = it >> 6, kb = (it >> 2) & 15, kq = it & 3, head = hhf >> 1, half = hhf & 1, k = kb * 64 + lane;
    const f32x4* wq = (const f32x4*)(p.w_query + (size_t)k * 2048 + head * 256 + half * 128);
    f32x4 wr[32];
#pragma unroll
    for (int i = 0; i < 32; ++i) wr[i] = wq[i];
    const float* kbase = (half ? p.keys2 : p.keys1) + ((size_t)head * 128 + kq * 32) * 128;
#pragma unroll 1
    for (int key = 0; key < 32; ++key) {
        const f32x4* kr = (const f32x4*)(kbase + (size_t)key * 128);
        float a0 = 0.f, a1 = 0.f;
#pragma unroll
        for (int i = 0; i < 32; i += 2) { const f32x4 b0 = kr[i], b1 = kr[i + 1];
            a0 += wr[i].x * b0.x + wr[i].y * b0.y + wr[i].z * b0.z + wr[i].w * b0.w;
            a1 += wr[i + 1].x * b1.x + wr[i + 1].y * b1.y + wr[i + 1].z * b1.z + wr[i + 1].w * b1.w; }
        WCT[(size_t)(hhf * 128 + kq * 32 + key) * 1024 + k] = (bf16)f2bf(a0 + a1);
    }
}
__device__ __forceinline__ void fill_tables(const P& p, int e, int lane) {
    unsigned char* U8 = p.ws + WS_U8; unsigned char* V8 = p.ws + WS_V8; float* USC = (float*)(p.ws + WS_USC); float* VSC = (float*)(p.ws + WS_VSC);
    f32x4 v[2][4]; float am[2] = {0.f, 0.f};
#pragma unroll
    for (int which = 0; which < 2; ++which) {
        const float* src = (which ? p.peer_v : p.peer_u) + (size_t)e * 1024 + 16 * lane;
#pragma unroll
        for (int j = 0; j < 4; ++j) v[which][j] = *(const f32x4*)(src + 4 * j);
    }
#pragma unroll
    for (int which = 0; which < 2; ++which)
#pragma unroll
        for (int j = 0; j < 4; ++j) am[which] = fmaxf(am[which], fmaxf(fmaxf(fabsf(v[which][j].x), fabsf(v[which][j].y)), fmaxf(fabsf(v[which][j].z), fabsf(v[which][j].w))));
#pragma unroll
    for (int o = 1; o < 64; o <<= 1) { am[0] = fmaxf(am[0], __shfl_xor(am[0], o)); am[1] = fmaxf(am[1], __shfl_xor(am[1], o)); }
#pragma unroll
    for (int which = 0; which < 2; ++which) {
        const float sc = am[which] > 0.f ? exp2f(floorf(log2f(448.f / am[which]))) : 1.f;
        unsigned w[4];
#pragma unroll
        for (int j = 0; j < 4; ++j) { int t = __builtin_amdgcn_cvt_pk_fp8_f32(v[which][j].x * sc, v[which][j].y * sc, 0, false); t = __builtin_amdgcn_cvt_pk_fp8_f32(v[which][j].z * sc, v[which][j].w * sc, t, true); w[j] = (unsigned)t; }
        *(v4u*)((which ? V8 : U8) + ((size_t)(lane >> 3) * NEXP + e) * 128 + 16 * (lane & 7)) = (v4u){w[0], w[1], w[2], w[3]};
        if (lane == 0) (which ? VSC : USC)[e] = 1.f / sc;
    }
}
constexpr int N_FILL = 128 + 1024;
__device__ __forceinline__ void fill_item(const P& p, int item, int wave, int lane) {
    if (item < 128) fill_wc(p, item * 8 + wave, lane);
    else { const int e0 = (item - 128) * 16 + wave * 2; fill_tables(p, e0, lane); fill_tables(p, e0 + 1, lane); }
}

typedef short bf16x8 __attribute__((ext_vector_type(8)));
typedef float f32x16 __attribute__((ext_vector_type(16)));
#define MFMA32(a, b, c) __builtin_amdgcn_mfma_f32_32x32x16_bf16((a), (b), (c), 0, 0, 0)
__device__ __forceinline__ int crow(int reg, int hh) { return (reg & 3) + 8 * (reg >> 2) + 4 * hh; }
template <int S> __device__ __forceinline__ bf16x8 pack_step(const f32x16& x) {
    v4u p; p.x = cvtpk(x[8 * S], x[8 * S + 1]); p.y = cvtpk(x[8 * S + 2], x[8 * S + 3]); p.z = cvtpk(x[8 * S + 4], x[8 * S + 5]); p.w = cvtpk(x[8 * S + 6], x[8 * S + 7]);
    return __builtin_bit_cast(bf16x8, p);
}
__device__ __forceinline__ bf16x8 frag2(const v2u& lo, const v2u& hi) { v4u p; p.x = lo.x; p.y = lo.y; p.z = hi.x; p.w = hi.y; return __builtin_bit_cast(bf16x8, p); }
__device__ __forceinline__ f32x16 zero16() { f32x16 z; for (int i = 0; i < 16; ++i) z[i] = 0.f; return z; }


__device__ __forceinline__ void p2_conv(const P& p, int tid) {
    const bf16* MLQK = (const bf16*)(p.ws + WS_MLQK); bf16* QC = (bf16*)(p.ws + WS_QC); bf16* KC = (bf16*)(p.ws + WS_KC);
    const int cg = tid & 127, ch0 = 8 * cg;
    float cw[4][8], cb[8];
#pragma unroll
    for (int i = 0; i < 8; ++i) { cb[i] = p.conv_b[ch0 + i];
#pragma unroll
        for (int j = 0; j < 4; ++j) cw[j][i] = p.conv_w[j * 1024 + ch0 + i]; }
    const float osc = cg >= 64 ? 0.08838834764831845f : 1.f;
    bf16* dst = (cg >= 64 ? KC : QC) + (cg & 63) * 8;
    for (int rg = blockIdx.x * 4 + (tid >> 7); rg < T_ / 4; rg += gridDim.x * 4) {
        const int tok = rg * 4, pos0 = tok & (S_ - 1);
        v4u xr[7];
#pragma unroll
        for (int k = 0; k < 7; ++k) xr[k] = (pos0 + k - 3 >= 0) ? *(const v4u*)(MLQK + (size_t)(tok + k - 3) * 1024 + ch0) : (v4u){0u, 0u, 0u, 0u};
#pragma unroll
        for (int tt = 0; tt < 4; ++tt) {
            float y[8];
#pragma unroll
            for (int i = 0; i < 8; ++i) y[i] = cb[i];
#pragma unroll
            for (int j = 0; j < 4; ++j) { float f[8]; unpack8(xr[tt + j], f);
#pragma unroll
                for (int i = 0; i < 8; ++i) y[i] += cw[j][i] * f[i]; }
#pragma unroll
            for (int i = 0; i < 8; ++i) y[i] = y[i] * sigmoidf_(y[i]) * osc;
            *(v4u*)(dst + (size_t)(tok + tt) * 512) = pack8(y);
        }
    }
}

constexpr int ML_QS = 0, ML_KS = 17408, ML_KWT = 34816, ML_VTL = 53248, ML_PS = 71680, ML_CT = 80896, ML_SCAL = 115712, ML_SSP = 118272, ML_QN = ML_SSP + 512, ML_F1 = ML_QN + 256, ML_F2 = ML_F1 + 256, ML_NV = ML_F2 + 256;
static_assert(ML_NV + 512 <= RING_BYTES, "mLSTM LDS map");
__device__ __forceinline__ void mlstm_scal(float ip, float fp, LAS float* sc, float& m_carry, int lane) {
    const float lf = fminf(fp, 0.f) - flog(1.f + fexp(-fabsf(fp)));
    float bc = lf;
#pragma unroll
    for (int o = 1; o < 64; o <<= 1) { const float t2 = __shfl_up(bc, o); if (lane >= o) bc += t2; }
    const float a = ip - bc; float pm = a;
#pragma unroll
    for (int o = 1; o < 64; o <<= 1) { const float t2 = __shfl_up(pm, o); if (lane >= o) pm = fmaxf(pm, t2); }
    const float M = fmaxf(m_carry, pm);
    const float M63 = __shfl(M, 63), bc63 = __shfl(bc, 63);
    sc[lane] = a; sc[64 + lane] = M; sc[128 + lane] = fexp(a - M63); sc[192 + lane] = fexp(m_carry - M); sc[256 + lane] = fexp(-(bc + M));
    m_carry = bc63 + M63;
}
__device__ __forceinline__ void mlstm_item(const P& p, LAS unsigned char* lds, int item, int tid, int wave, int lane) {
    const int b = item >> 2, h = item & 3;
    const int r = lane & 31, hh = lane >> 5, et = wave & 3, th = wave >> 2;
    const bf16* QC = (const bf16*)(p.ws + WS_QC); const bf16* KC = (const bf16*)(p.ws + WS_KC); const bf16* MLV = (const bf16*)(p.ws + WS_MLV); const float* IFG = (const float*)(p.ws + WS_IFG);
    bf16* HML = (bf16*)p.out + 512;
    LAS float* SCAL = (LAS float*)(lds + ML_SCAL); LAS float* SSP = (LAS float*)(lds + ML_SSP); LAS float* QN = (LAS float*)(lds + ML_QN);
    LAS float* F1 = (LAS float*)(lds + ML_F1); LAS float* F2 = (LAS float*)(lds + ML_F2); LAS float* NV = (LAS float*)(lds + ML_NV);
    const int cg = tid & 15, trow = tid >> 4, eg = cg, sl = trow;
    const size_t hq = (size_t)h * 128 + 8 * cg;
    for (int i = tid; i < (128 * 136 * 2) / 4; i += NTHR) ((LAS unsigned*)(lds + ML_CT))[i] = 0u;
    if (tid < 128) NV[tid] = 0.f;
    f32x16 accC[2]; accC[0] = zero16(); accC[1] = zero16();
    float m_carry = 0.f;
    if (wave == 3) { const size_t tk = (size_t)b * S_ + lane; mlstm_scal(IFG[tk * 8 + h], IFG[tk * 8 + 4 + h], SCAL, m_carry, lane); }
    v4u pq[2], pk[2], pv[2];
    {
        const size_t t0 = (size_t)b * S_;
#pragma unroll
        for (int u = 0; u < 2; ++u) { pq[u] = *(const v4u*)(QC + (t0 + trow + 32 * u) * 512 + hq); pk[u] = *(const v4u*)(KC + (t0 + trow + 32 * u) * 512 + hq); pv[u] = *(const v4u*)(MLV + (t0 + sl + 32 * u) * 512 + hq); }
    }
    float ipn = 0.f, fpn = 0.f;
    __syncthreads();
    for (int c = 0; c < 32; ++c) {
        const size_t tok0 = (size_t)b * S_ + c * 64;
        LAS float* sc = SCAL + (c & 1) * 320;
        {
#pragma unroll
            for (int u = 0; u < 2; ++u) {
                const int t = trow + 32 * u;
                *(LAS v4u*)(lds + ML_QS + t * 272 + cg * 16) = pq[u];
                *(LAS v4u*)(lds + ML_KS + t * 272 + cg * 16) = pk[u];
                float f[8]; unpack8(pk[u], f);
                const float wk = sc[128 + t];
#pragma unroll
                for (int i = 0; i < 8; ++i) *(LAS bf16*)(lds + ML_KWT + (8 * cg + i) * 144 + ((t ^ (8 * (cg & 7))) * 2)) = (bf16)f2bf(f[i] * wk);
                const unsigned vv[4] = {pv[u].x, pv[u].y, pv[u].z, pv[u].w};
#pragma unroll
                for (int i = 0; i < 4; ++i) {
                    *(LAS bf16*)(lds + ML_VTL + (8 * eg + 2 * i) * 144 + ((t ^ (8 * (eg & 7))) * 2)) = (bf16)(vv[i] & 0xffffu);
                    *(LAS bf16*)(lds + ML_VTL + (8 * eg + 2 * i + 1) * 144 + ((t ^ (8 * (eg & 7))) * 2)) = (bf16)(vv[i] >> 16);
                }
            }
            if (c + 1 < 32) {
                const size_t t1 = tok0 + 64;
#pragma unroll
                for (int u = 0; u < 2; ++u) { pq[u] = *(const v4u*)(QC + (t1 + trow + 32 * u) * 512 + hq); pk[u] = *(const v4u*)(KC + (t1 + trow + 32 * u) * 512 + hq); pv[u] = *(const v4u*)(MLV + (t1 + sl + 32 * u) * 512 + hq); }
                if (wave == 3) { ipn = IFG[(t1 + lane) * 8 + h]; fpn = IFG[(t1 + lane) * 8 + 4 + h]; }
            }
        }
        __syncthreads();
        f32x16 acc_inter = zero16();
        if (wave < 3) {
            const int tt = wave > 0 ? 1 : 0, st = wave == 2 ? 1 : 0;
            f32x16 zt = zero16();
#pragma unroll
            for (int ks = 0; ks < 8; ++ks) {
                const bf16x8 ka = *(const LAS bf16x8*)(lds + ML_KS + (32 * st + r) * 272 + 32 * ks + 16 * hh);
                const bf16x8 qb = *(const LAS bf16x8*)(lds + ML_QS + (32 * tt + r) * 272 + 32 * ks + 16 * hh);
                zt = MFMA32(ka, qb, zt);
            }
            const int t = 32 * tt + r; const float Mt = sc[64 + t];
            float ps = 0.f;
#pragma unroll
            for (int g = 0; g < 4; ++g) {
                const f32x4 av = *(const LAS f32x4*)(sc + 32 * st + 8 * g + 4 * hh);
                float pv[4];
#pragma unroll
                for (int q = 0; q < 4; ++q) { const int sidx = 32 * st + 8 * g + 4 * hh + q;
                    const float wgt = sidx <= t ? fexp(av[q] - Mt) : 0.f; pv[q] = zt[4 * g + q] * wgt; ps += pv[q]; }
                *(LAS v2u*)(lds + ML_PS + t * 144 + (32 * st + 8 * g + 4 * hh) * 2) = (v2u){cvtpk(pv[0], pv[1]), cvtpk(pv[2], pv[3])};
            }
            ps += __shfl_xor(ps, 32);
            if (hh == 0) { SSP[st * 64 + t] = ps; if (wave == 0) SSP[64 + t] = 0.f; }
        }
        if (wave == 3 && c + 1 < 32) mlstm_scal(ipn, fpn, SCAL + ((c + 1) & 1) * 320, m_carry, lane);
#pragma unroll
        for (int ks = 0; ks < 8; ++ks) {
            const bf16x8 qa = *(const LAS bf16x8*)(lds + ML_QS + (32 * th + r) * 272 + 32 * ks + 16 * hh);
            const bf16x8 cbf = *(const LAS bf16x8*)(lds + ML_CT + (32 * et + r) * 272 + 32 * ks + 16 * hh);
            acc_inter = MFMA32(qa, cbf, acc_inter);
        }
        {
            const int t = tid >> 3, part = tid & 7;
            float f[8], sum = 0.f;
            { const v4u tq = *(const LAS v4u*)(lds + ML_QS + t * 272 + part * 32); unpack8(tq, f); }
#pragma unroll
            for (int i = 0; i < 8; ++i) sum += f[i] * NV[16 * part + i];
            { const v4u tq = *(const LAS v4u*)(lds + ML_QS + t * 272 + part * 32 + 16); unpack8(tq, f); }
#pragma unroll
            for (int i = 0; i < 8; ++i) sum += f[i] * NV[16 * part + 8 + i];
            sum += __shfl_xor(sum, 1); sum += __shfl_xor(sum, 2); sum += __shfl_xor(sum, 4);
            if (part == 0) QN[t] = sum;
        }
        __syncthreads();
        f32x16 acc_intra = zero16();
#pragma unroll
        for (int ks = 0; ks < 4; ++ks) {
            if (ks < 2 || th == 1) {
                const bf16x8 pa = *(const LAS bf16x8*)(lds + ML_PS + (32 * th + r) * 144 + 32 * ks + 16 * hh);
                const bf16x8 vb = *(const LAS bf16x8*)(lds + ML_VTL + (32 * et + r) * 144 + 16 * ((2 * ks + hh) ^ (((32 * et + r) >> 3) & 7)));
                acc_intra = MFMA32(pa, vb, acc_intra);
            }
        }
        if (tid < 64) {
            const float wi = sc[192 + tid];
            const float den = SSP[tid] + SSP[64 + tid] + wi * QN[tid];
            const float f1 = frcp(fmaxf(fabsf(den), sc[256 + tid]));
            F1[tid] = f1; F2[tid] = wi * f1;
        }
        const float decay = sc[192 + 63];
#pragma unroll
        for (int dt = 0; dt < 2; ++dt) {
#pragma unroll
            for (int i = 0; i < 16; ++i) accC[dt][i] *= decay;
#pragma unroll
            for (int ks = 0; ks < 4; ++ks) {
                const bf16x8 ka = *(const LAS bf16x8*)(lds + ML_KWT + (64 * th + 32 * dt + r) * 144 + 16 * ((2 * ks + hh) ^ (((64 * th + 32 * dt + r) >> 3) & 7)));
                const bf16x8 vb = *(const LAS bf16x8*)(lds + ML_VTL + (32 * et + r) * 144 + 16 * ((2 * ks + hh) ^ (((32 * et + r) >> 3) & 7)));
                accC[dt] = MFMA32(ka, vb, accC[dt]);
            }
        }
        {
            const int d = tid >> 2, part = tid & 3;
            float f[8], sum = 0.f;
            { const v4u tq = *(const LAS v4u*)(lds + ML_KWT + d * 144 + part * 32); unpack8(tq, f); }
#pragma unroll
            for (int i = 0; i < 8; ++i) sum += f[i];
            { const v4u tq = *(const LAS v4u*)(lds + ML_KWT + d * 144 + part * 32 + 16); unpack8(tq, f); }
#pragma unroll
            for (int i = 0; i < 8; ++i) sum += f[i];
            sum += __shfl_xor(sum, 1); sum += __shfl_xor(sum, 2);
            if (part == 0) NV[d] = decay * NV[d] + sum;
        }
        __syncthreads();
        {
            bf16* hp = HML + (tok0 + 32 * th) * 1024 + h * 128 + 32 * et + r;
#pragma unroll
            for (int g = 0; g < 4; ++g) {
                const f32x4 f1v = *(const LAS f32x4*)(F1 + 32 * th + 8 * g + 4 * hh), f2v = *(const LAS f32x4*)(F2 + 32 * th + 8 * g + 4 * hh);
#pragma unroll
                for (int q = 0; q < 4; ++q) { const int tl = 8 * g + 4 * hh + q;
                    hp[(size_t)tl * 1024] = (bf16)f2bf(acc_intra[4 * g + q] * f1v[q] + acc_inter[4 * g + q] * f2v[q]); }
            }
#pragma unroll
            for (int dt = 0; dt < 2; ++dt)
#pragma unroll
                for (int g = 0; g < 4; ++g)
                    *(LAS v2u*)(lds + ML_CT + (32 * et + r) * 272 + (64 * th + 32 * dt + 8 * g + 4 * hh) * 2) = (v2u){cvtpk(accC[dt][4 * g], accC[dt][4 * g + 1]), cvtpk(accC[dt][4 * g + 2], accC[dt][4 * g + 3])};
        }
    }
    __syncthreads();
}

__device__ __forceinline__ void sba_wave_item(const bf16* __restrict__ QK, const bf16* __restrict__ VT, bf16* __restrict__ YSB, int b, int h, int qt, int lane) {
    const int r = lane & 31, hh = lane >> 5, t0 = qt * 32;
    const size_t rowbase = (size_t)b * S_;
    bf16x8 qf[4];
    {
        const bf16* qp = QK + (rowbase + t0 + r) * 1024 + h * 64 + 8 * hh;
#pragma unroll
        for (int ks = 0; ks < 4; ++ks) qf[ks] = *(const bf16x8*)(qp + 16 * ks);
    }
    bf16x8 tri[2];
#pragma unroll
    for (int s2 = 0; s2 < 2; ++s2)
#pragma unroll
        for (int j = 0; j < 8; ++j) { const int rho = 16 * s2 + 8 * (j >> 2) + 4 * hh + (j & 3); tri[s2][j] = (rho > r) ? (short)0x3F80 : (short)0; }
    f32x16 o0 = zero16(), o1 = zero16();
    float carry = 0.f;
    const bf16* kbase = QK + rowbase * 1024 + 512 + h * 64 + 8 * hh + (size_t)r * 1024;
    const bf16* vbase = VT + ((size_t)(b * 8 + h) * 64 + r) * 2048 + 4 * hh;
    bf16x8 kf[4]; v2u vl[2][2], vh[2][2];
#pragma unroll
    for (int ks = 0; ks < 4; ++ks) kf[ks] = *(const bf16x8*)(kbase + (size_t)t0 * 1024 + 16 * ks);
#pragma unroll
    for (int dt = 0; dt < 2; ++dt)
#pragma unroll
        for (int s2 = 0; s2 < 2; ++s2) { const bf16* vp = vbase + (size_t)dt * 32 * 2048 + t0 + 16 * s2; vl[dt][s2] = *(const v2u*)vp; vh[dt][s2] = *(const v2u*)(vp + 8); }
    for (int s0 = t0; s0 >= 0; s0 -= 32) {
        bf16x8 kn[4]; v2u vln[2][2], vhn[2][2];
        const int sn = s0 >= 32 ? s0 - 32 : 0;
#pragma unroll
        for (int ks = 0; ks < 4; ++ks) kn[ks] = *(const bf16x8*)(kbase + (size_t)sn * 1024 + 16 * ks);
#pragma unroll
        for (int dt = 0; dt < 2; ++dt)
#pragma unroll
            for (int s2 = 0; s2 < 2; ++s2) { const bf16* vp = vbase + (size_t)dt * 32 * 2048 + sn + 16 * s2; vln[dt][s2] = *(const v2u*)vp; vhn[dt][s2] = *(const v2u*)(vp + 8); }
        f32x16 z = zero16();
#pragma unroll
        for (int ks = 0; ks < 4; ++ks) z = MFMA32(kf[ks], qf[ks], z);
        const bool diag = (s0 == t0);
        f32x16 sp; float rs = 0.f;
#pragma unroll
        for (int i = 0; i < 16; ++i) {
            const float zz = z[i] * 0.125f;
            const bool valid = !diag || (crow(i, hh) < r);
            float spv = fmaxf(zz, 0.f) + flog(1.f + fexp(-fabsf(zz)));
            spv = valid ? spv : 0.f;
            sp[i] = spv; rs += spv; z[i] = zz - spv;
        }
        f32x16 suf = zero16();
        suf = MFMA32(tri[0], pack_step<0>(sp), suf);
        suf = MFMA32(tri[1], pack_step<1>(sp), suf);
        f32x16 w;
#pragma unroll
        for (int i = 0; i < 16; ++i) {
            const bool valid = !diag || (crow(i, hh) < r);
            const float lw = z[i] - suf[i] - carry;
            w[i] = valid ? fexp(lw) : 0.f;
        }
        rs += __shfl_xor(rs, 32);
        carry += rs;
        const bf16x8 pa0 = pack_step<0>(w), pa1 = pack_step<1>(w);
        o0 = MFMA32(pa0, frag2(vl[0][0], vh[0][0]), o0); o0 = MFMA32(pa1, frag2(vl[0][1], vh[0][1]), o0);
        o1 = MFMA32(pa0, frag2(vl[1][0], vh[1][0]), o1); o1 = MFMA32(pa1, frag2(vl[1][1], vh[1][1]), o1);
        if (__all(carry > 104.f)) break;
#pragma unroll
        for (int ks = 0; ks < 4; ++ks) kf[ks] = kn[ks];
#pragma unroll
        for (int dt = 0; dt < 2; ++dt)
#pragma unroll
            for (int s2 = 0; s2 < 2; ++s2) { vl[dt][s2] = vln[dt][s2]; vh[dt][s2] = vhn[dt][s2]; }
    }
    bf16* op = YSB + (rowbase + t0) * 1024 + h * 64 + r;
#pragma unroll
    for (int i = 0; i < 16; ++i) { const int t = crow(i, hh); op[(size_t)t * 1024] = (bf16)f2bf(o0[i]); op[(size_t)t * 1024 + 32] = (bf16)f2bf(o1[i]); }
}
__device__ __forceinline__ void sba_item(const P& p, int item, int wave, int lane) {
    const int bh = item >> 3, qb = item & 7, b = bh >> 3, h = bh & 7;
    sba_wave_item((const bf16*)(p.ws + WS_SBQKV), (const bf16*)(p.ws + WS_VT), (bf16*)p.out, b, h, qb * 8 + wave, lane);
}

__device__ __forceinline__ void p3_yml(const P& p, int wave, int lane) {
    const int gw = blockIdx.x * NWAVES + wave, NGW = gridDim.x * NWAVES;
    bf16* YML = (bf16*)p.out + 512; const bf16* MLO = (const bf16*)(p.ws + WS_MLO);
    for (int m = gw; m < T_; m += NGW) {
        float hv[8], ov[8], o[8];
        unpack8(*(const v4u*)(YML + (size_t)m * 1024 + lane * 8), hv); unpack8(*(const v4u*)(MLO + (size_t)m * 512 + lane * 8), ov);
        float ss = 0.f;
#pragma unroll
        for (int i = 0; i < 8; ++i) ss += hv[i] * hv[i];
        ss += __shfl_xor(ss, 1); ss += __shfl_xor(ss, 2); ss += __shfl_xor(ss, 4); ss += __shfl_xor(ss, 8);
        const float rstd = frsq(ss * (1.f / 128.f) + EPS);
        const f32x4 w0 = *(const f32x4*)(p.ml_norm_w + lane * 8), w1 = *(const f32x4*)(p.ml_norm_w + lane * 8 + 4);
        const float wv[8] = {w0.x, w0.y, w0.z, w0.w, w1.x, w1.y, w1.z, w1.w};
#pragma unroll
        for (int i = 0; i < 8; ++i) o[i] = sigmoidf_(ov[i]) * hv[i] * rstd * wv[i];
        *(v4u*)(YML + (size_t)m * 1024 + lane * 8) = pack8(o);
    }
}

__device__ __forceinline__ void p6_hn(const P& p, int wave, int lane) {
    const int gw = blockIdx.x * NWAVES + wave, NGW = gridDim.x * NWAVES;
    const float* H = (const float*)(p.ws + WS_H); bf16* HN = (bf16*)(p.ws + WS_HN);
    for (int m = gw; m < T_; m += NGW) {
        const f32x4* xr = (const f32x4*)(H + (size_t)m * 1024) + lane; const f32x4* wr = (const f32x4*)p.norm_ffn_w + lane;
        f32x4 v[4]; float ss = 0.f;
#pragma unroll
        for (int j = 0; j < 4; ++j) { v[j] = xr[64 * j]; ss += (v[j].x * v[j].x + v[j].y * v[j].y) + (v[j].z * v[j].z + v[j].w * v[j].w); }
        const float rstd = frsq(wave_sum(ss) * (1.f / 1024.f) + EPS);
        v2u* o8 = (v2u*)(HN + (size_t)m * 1024) + lane;
#pragma unroll
        for (int j = 0; j < 4; ++j) { const f32x4 w = wr[64 * j]; o8[64 * j] = (v2u){pk2(v[j].x * rstd * w.x, v[j].y * rstd * w.y), pk2(v[j].z * rstd * w.z, v[j].w * rstd * w.w)}; }
    }
}

__device__ __forceinline__ float ffn_rstd(const float* SS, int m) {
    const f32x4* q = (const f32x4*)(SS + (size_t)m * 16); const f32x4 a = q[0], b = q[1], c = q[2], d = q[3];
    const float t = ((a.x + a.y) + (a.z + a.w)) + ((b.x + b.y) + (b.z + b.w)) + ((c.x + c.y) + (c.z + c.w)) + ((d.x + d.y) + (d.z + d.w));
    return frsq(t * (1.f / 1024.f) + EPS);
}
__device__ __forceinline__ unsigned ord_key(float f) { const unsigned u = __builtin_bit_cast(unsigned, f); return (u & 0x80000000u) ? ~u : (u | 0x80000000u); }
__device__ __forceinline__ float ord_val(unsigned k) { const unsigned u = (k & 0x80000000u) ? (k & 0x7fffffffu) : ~k; return __builtin_bit_cast(float, u); }
template <int CTRL> __device__ __forceinline__ unsigned dpp_u(unsigned v) { return (unsigned)__builtin_amdgcn_update_dpp(0, (int)v, CTRL, 0xF, 0xF, true); }
__device__ __forceinline__ unsigned umax_(unsigned a, unsigned b) { return a > b ? a : b; }
__device__ __forceinline__ unsigned umin_(unsigned a, unsigned b) { return a < b ? a : b; }
__device__ __forceinline__ unsigned row_max_u(unsigned v) {
    v = umax_(v, dpp_u<0xB1>(v)); v = umax_(v, dpp_u<0x4E>(v)); v = umax_(v, dpp_u<0x141>(v)); v = umax_(v, dpp_u<0x140>(v)); return v;
}
__device__ __forceinline__ float row_sum_f(float v) {
    v += __builtin_bit_cast(float, dpp_u<0xB1>(__builtin_bit_cast(unsigned, v))); v += __builtin_bit_cast(float, dpp_u<0x4E>(__builtin_bit_cast(unsigned, v)));
    v += __builtin_bit_cast(float, dpp_u<0x141>(__builtin_bit_cast(unsigned, v))); v += __builtin_bit_cast(float, dpp_u<0x140>(__builtin_bit_cast(unsigned, v))); return v;
}
#define CE_(i, j) do { const unsigned _a = k[i], _b = k[j]; k[i] = umax_(_a, _b); k[j] = umin_(_a, _b); } while (0)
__device__ __forceinline__ unsigned row_top16(unsigned (&k)[8], unsigned (&top)[16], int li) {
    CE_(0, 1); CE_(2, 3); CE_(4, 5); CE_(6, 7); CE_(0, 2); CE_(1, 3); CE_(4, 6); CE_(5, 7); CE_(1, 2); CE_(5, 6);
    CE_(0, 4); CE_(1, 5); CE_(2, 6); CE_(3, 7); CE_(2, 4); CE_(3, 5); CE_(1, 2); CE_(3, 4); CE_(5, 6);
    unsigned mine = 0u;
#pragma unroll
    for (int n = 0; n < 16; ++n) {
        const unsigned m = row_max_u(k[0]);
        const bool hit = k[0] == m;
#pragma unroll
        for (int i = 0; i < 7; ++i) k[i] = hit ? k[i + 1] : k[i];
        k[7] = hit ? 0u : k[7];
        top[n] = m; mine = (li == n) ? m : mine;
    }
    return mine;
}
__device__ __forceinline__ void topk_core(const float (&s1)[8], const float (&s2)[8], float rstd, int li, int lane, int& e_out, float& g_out) {
    unsigned k[8], top1[16], top2[16];
#pragma unroll
    for (int j = 0; j < 8; ++j) k[j] = (ord_key(s1[j]) & ~0x7fu) | (unsigned)(127 - (li + 16 * j));
    const unsigned mine1 = row_top16(k, top1, li);
#pragma unroll
    for (int j = 0; j < 8; ++j) k[j] = (ord_key(s2[j]) & ~0x7fu) | (unsigned)(127 - (li + 16 * j));
    const unsigned mine2 = row_top16(k, top2, li);
    const float v2 = ord_val(mine2 & ~0x7fu);
    unsigned c[16];
#pragma unroll
    for (int j = 0; j < 16; ++j) {
        const float v1 = ord_val(top1[j] & ~0x7fu);
        const unsigned key = (ord_key(v1 + v2) & ~0xffu) | (unsigned)(255 - (16 * j + li));
        c[j] = ((j + 1) * (li + 1) <= 16) ? key : 0u;
    }
    unsigned tk = 0u, t0 = 0u;
#pragma unroll
    for (int n = 0; n < 16; ++n) {
        const unsigned mx = row_max_u(c[0]);
        const bool hit = c[0] == mx;
#pragma unroll
        for (int i = 0; i < 15; ++i) c[i] = hit ? c[i + 1] : c[i];
        c[15] = hit ? 0u : c[15];
        if (n == 0) t0 = mx;
        tk = (li == n) ? mx : tk;
    }
    const float sv = ord_val(tk & ~0xffu), s0 = ord_val(t0 & ~0xffu);
    const int cc = 255 - (int)(tk & 0xffu), a = (cc >> 4) & 15, bb = cc & 15;
    const int i1 = 127 - (int)((unsigned)__shfl((int)mine1, (lane & 48) + a) & 0x7fu), i2 = 127 - (int)((unsigned)__shfl((int)mine2, (lane & 48) + bb) & 0x7fu);
    const float pe = fexp((sv - s0) * rstd);
    const float den = row_sum_f(pe);
    e_out = i1 * 128 + i2; g_out = pe * frcp(den);
}
constexpr int TK_RS = 1040;
struct EpiTopk {
    static constexpr bool PERM = true, AFTER_DRAIN = true;
    int* IDX; float* GATE; const float* SS;
    __device__ __forceinline__ void fused(pg8::f32x4 (&acc)[2][2][4][2], const pg8::Unit& u, int wr, int wc, int fr, int fq, PG8_LAS unsigned char* lds, int wid, int lane) const {
        const int head = u.pn, q = lane >> 4, li = lane & 15;
#pragma unroll
        for (int ai = 0; ai < 2; ++ai) {
#pragma unroll
            for (int m = 0; m < 4; ++m)
#pragma unroll
                for (int bj = 0; bj < 2; ++bj) {
                    PG8_LAS unsigned char* dst = lds + (wr * 64 + m * 16 + fr) * TK_RS + (bj * 128 + wc * 32 + 8 * fq) * 4;
                    *(PG8_LAS pg8::f32x4*)dst = acc[ai][bj][m][0]; *(PG8_LAS pg8::f32x4*)(dst + 16) = acc[ai][bj][m][1];
                }
            __syncthreads();
#pragma unroll 1
            for (int it = 0; it < 4; it += 2) {
                const int rowa = 16 * wid + 4 * it + q, rowb = rowa + 4, ma = u.pm * 256 + ai * 128 + rowa, mb = ma + 4;
                const PG8_LAS float* sa = (const PG8_LAS float*)(lds + rowa * TK_RS); const PG8_LAS float* sb = (const PG8_LAS float*)(lds + rowb * TK_RS);
                float a1[8], a2[8], b1[8], b2[8];
#pragma unroll
                for (int j = 0; j < 8; ++j) { a1[j] = sa[li + 16 * j]; a2[j] = sa[128 + li + 16 * j]; b1[j] = sb[li + 16 * j]; b2[j] = sb[128 + li + 16 * j]; }
                const float ra = ffn_rstd(SS, ma), rb = ffn_rstd(SS, mb);
                int ea, eb; float ga, gb;
                topk_core(a1, a2, ra, li, lane, ea, ga);
                topk_core(b1, b2, rb, li, lane, eb, gb);
                IDX[(size_t)ma * 128 + head * 16 + li] = ea; GATE[(size_t)ma * 128 + head * 16 + li] = ga;
                IDX[(size_t)mb * 128 + head * 16 + li] = eb; GATE[(size_t)mb * 128 + head * 16 + li] = gb;
            }
            __syncthreads();
        }
    }
};
struct OneUnit {
    pg8::Unit u;
    __device__ __forceinline__ bool next(int i, pg8::Unit& o) const { if (i) return false; o = u; return true; }
    __device__ __forceinline__ void a_ready(const pg8::Unit&) const {}
    __device__ __forceinline__ void done(const pg8::Unit&) const {}
};

__device__ __forceinline__ float gelu_erf(float x) { return 0.5f * x * (1.f + erff(x * 0.70710678118654752f)); }
typedef float f32x2 __attribute__((ext_vector_type(2)));
__device__ __forceinline__ void cvt16_fp8(const v4u& w, f32x2 (&f)[8]) {
    f[0] = __builtin_amdgcn_cvt_pk_f32_fp8((int)w.x, false); f[1] = __builtin_amdgcn_cvt_pk_f32_fp8((int)w.x, true);
    f[2] = __builtin_amdgcn_cvt_pk_f32_fp8((int)w.y, false); f[3] = __builtin_amdgcn_cvt_pk_f32_fp8((int)w.y, true);
    f[4] = __builtin_amdgcn_cvt_pk_f32_fp8((int)w.z, false); f[5] = __builtin_amdgcn_cvt_pk_f32_fp8((int)w.z, true);
    f[6] = __builtin_amdgcn_cvt_pk_f32_fp8((int)w.w, false); f[7] = __builtin_amdgcn_cvt_pk_f32_fp8((int)w.w, true);
}
__device__ __forceinline__ float grp8_sum(float v) {
    v += __builtin_bit_cast(float, dpp_u<0xB1>(__builtin_bit_cast(unsigned, v)));
    v += __builtin_bit_cast(float, dpp_u<0x4E>(__builtin_bit_cast(unsigned, v)));
    v += __builtin_bit_cast(float, dpp_u<0x141>(__builtin_bit_cast(unsigned, v)));
    return v;
}
typedef int i32x4 __attribute__((ext_vector_type(4)));
template <int PAT> __device__ __forceinline__ float swz_f(float v) { return __builtin_bit_cast(float, __builtin_amdgcn_ds_swizzle(__builtin_bit_cast(int, v), PAT)); }
__device__ __forceinline__ void peer_u_token(const v4u (&ur)[16], const f32x2 (&xv)[8], bf16* dst, int c8) {
    float d[16];
#pragma unroll
    for (int i = 0; i < 16; ++i) {
        f32x2 f[8]; cvt16_fp8(ur[i], f);
        f32x2 s2 = f[0] * xv[0];
#pragma unroll
        for (int q = 1; q < 8; ++q) s2 += f[q] * xv[q];
        d[i] = s2.x + s2.y;
    }
    const bool b0 = (c8 & 1) != 0, b1 = (c8 & 2) != 0, b2 = (c8 & 4) != 0;
    float e8[8], e4[4], e2[2];
#pragma unroll
    for (int i = 0; i < 8; ++i) { const float keep = b0 ? d[2 * i + 1] : d[2 * i], send = b0 ? d[2 * i] : d[2 * i + 1];
        e8[i] = keep + __builtin_bit_cast(float, dpp_u<0xB1>(__builtin_bit_cast(unsigned, send))); }
#pragma unroll
    for (int i = 0; i < 4; ++i) { const float keep = b1 ? e8[2 * i + 1] : e8[2 * i], send = b1 ? e8[2 * i] : e8[2 * i + 1];
        e4[i] = keep + __builtin_bit_cast(float, dpp_u<0x4E>(__builtin_bit_cast(unsigned, send))); }
#pragma unroll
    for (int i = 0; i < 2; ++i) { const float keep = b2 ? e4[2 * i + 1] : e4[2 * i], send = b2 ? e4[2 * i] : e4[2 * i + 1];
        e2[i] = keep + swz_f<0x1F | (4 << 10)>(send); }
    dst[c8] = (bf16)f2bf(e2[0]); dst[c8 + 8] = (bf16)f2bf(e2[1]);
}
__device__ __forceinline__ void peer_u(const P& p, int wave, int lane) {
    const int j = blockIdx.x & 7, nchunk = gridDim.x >> 3, chunk = blockIdx.x >> 3, stride = nchunk * 8;
    const int g = lane >> 3, c8 = lane & 7;
    const bf16* HN = (const bf16*)p.out + 128 * j + 16 * c8; const int* IDX = (const int*)(p.ws + WS_IDX) + 16 * g;
    const unsigned char* US = p.ws + WS_U8 + (size_t)j * NEXP * 128 + 16 * c8;
    bf16* PART = (bf16*)(p.ws + WS_PART) + (size_t)j * T_ * 128 + 16 * g;
    const int m0 = chunk * 8 + wave, ntok = (T_ - m0 + stride - 1) / stride;
#define PU_CLAMP(k) (m0 + ((k) < ntok ? (k) : ntok - 1) * stride)
#define PU_ROWS(ur, ei) _Pragma("unroll") for (int i = 0; i < 16; ++i) ur[i] = *(const v4u*)(US + (size_t)ei[i >> 2][i & 3] * 128)
#define PU_L1(ei, h0, h1, mm) do { _Pragma("unroll") for (int q = 0; q < 4; ++q) ei[q] = *(const i32x4*)(IDX + (size_t)(mm) * 128 + 4 * q); \
        h0 = *(const v4u*)(HN + (size_t)(mm) * 1024); h1 = *(const v4u*)(HN + (size_t)(mm) * 1024 + 8); } while (0)
#define PU_X(xv, h0, h1) do { float f_[8]; unpack8(h0, f_); _Pragma("unroll") for (int i = 0; i < 4; ++i) xv[i] = (f32x2){f_[2 * i], f_[2 * i + 1]}; \
        unpack8(h1, f_); _Pragma("unroll") for (int i = 0; i < 4; ++i) xv[4 + i] = (f32x2){f_[2 * i], f_[2 * i + 1]}; } while (0)
    i32x4 ei[4]; v4u hA0, hA1, hB0, hB1; v4u urA[16], urB[16]; f32x2 xv[8];
    PU_L1(ei, hA0, hA1, m0);
    PU_ROWS(urA, ei);
    PU_L1(ei, hB0, hB1, PU_CLAMP(1));
    for (int k = 0; k < ntok; k += 2) {
        PU_ROWS(urB, ei);
        PU_X(xv, hA0, hA1);
        PU_L1(ei, hA0, hA1, PU_CLAMP(k + 2));
        peer_u_token(urA, xv, PART + (size_t)(m0 + k * stride) * 128, c8);
        if (k + 1 < ntok) {
            PU_ROWS(urA, ei);
            PU_X(xv, hB0, hB1);
            PU_L1(ei, hB0, hB1, PU_CLAMP(k + 3));
            peer_u_token(urB, xv, PART + (size_t)(m0 + (k + 1) * stride) * 128, c8);
        }
    }
#undef PU_CLAMP
#undef PU_ROWS
#undef PU_L1
#undef PU_X
}
__device__ __forceinline__ void peer_c(const P& p, int wave, int lane) {
    const int gw = blockIdx.x * NWAVES + wave, NGW = gridDim.x * NWAVES;
    const int* IDX = (const int*)(p.ws + WS_IDX); const float* GATE = (const float*)(p.ws + WS_GATE); const bf16* PART = (const bf16*)(p.ws + WS_PART);
    const float* USC = (const float*)(p.ws + WS_USC); const float* VSC = (const float*)(p.ws + WS_VSC); float* COEF = (float*)(p.ws + WS_COEF); const float* SS = (const float*)(p.ws + WS_SS);
    for (int m0 = gw * 2; m0 < T_; m0 += NGW * 2) {
        float s[2][2], rs[2], g[2][2]; int e[2][2];
#pragma unroll
        for (int u = 0; u < 2; ++u) {
            const int m = m0 + u;
            rs[u] = ffn_rstd(SS, m);
            s[u][0] = 0.f; s[u][1] = 0.f;
#pragma unroll
            for (int jj = 0; jj < 8; ++jj) { s[u][0] += bf2f(PART[((size_t)jj * T_ + m) * 128 + lane]); s[u][1] += bf2f(PART[((size_t)jj * T_ + m) * 128 + 64 + lane]); }
            e[u][0] = IDX[(size_t)m * 128 + lane]; e[u][1] = IDX[(size_t)m * 128 + 64 + lane];
            g[u][0] = GATE[(size_t)m * 128 + lane]; g[u][1] = GATE[(size_t)m * 128 + 64 + lane];
        }
        float us[2][2], vs[2][2];
#pragma unroll
        for (int u = 0; u < 2; ++u)
#pragma unroll
            for (int k = 0; k < 2; ++k) { us[u][k] = USC[e[u][k]]; vs[u][k] = VSC[e[u][k]]; }
#pragma unroll
        for (int u = 0; u < 2; ++u)
#pragma unroll
            for (int k = 0; k < 2; ++k) COEF[(size_t)(m0 + u) * 128 + 64 * k + lane] = g[u][k] * gelu_erf(s[u][k] * rs[u] * us[u][k]) * vs[u][k];
    }
}
struct PvPre { i32x4 ei[4]; f32x4 cf[4]; };
__device__ __forceinline__ void pv_level1(PvPre& q, const int* IDXg, const float* COEFg, int m, int c8) {
#pragma unroll
    for (int k = 0; k < 4; ++k) { q.ei[k] = *(const i32x4*)(IDXg + (size_t)m * 128 + 4 * k); q.cf[k] = *(const f32x4*)(COEFg + (size_t)m * 128 + 4 * k); }
}
__device__ __forceinline__ void peer_v_token(const v4u (&vr)[16], const f32x4 (&cf)[4], const bf16* H, bf16* out, bool b3, bool b4, bool b5) {
    f32x2 acc[8];
#pragma unroll
    for (int i = 0; i < 8; ++i) acc[i] = (f32x2){0.f, 0.f};
#pragma unroll
    for (int I = 0; I < 16; ++I) {
        const float cu = cf[I >> 2][I & 3];
        const f32x2 c2 = (f32x2){cu, cu}; f32x2 f[8]; cvt16_fp8(vr[I], f);
#pragma unroll
        for (int q = 0; q < 8; ++q) acc[q] += c2 * f[q];
    }
    f32x2 a1[4], a2[2], a3;
#pragma unroll
    for (int i = 0; i < 4; ++i) { const f32x2 keep = b5 ? acc[2 * i + 1] : acc[2 * i], send = b5 ? acc[2 * i] : acc[2 * i + 1];
        a1[i] = keep + (f32x2){__shfl_xor(send.x, 32), __shfl_xor(send.y, 32)}; }
#pragma unroll
    for (int i = 0; i < 2; ++i) { const f32x2 keep = b4 ? a1[2 * i + 1] : a1[2 * i], send = b4 ? a1[2 * i] : a1[2 * i + 1];
        a2[i] = keep + (f32x2){swz_f<0x1F | (16 << 10)>(send.x), swz_f<0x1F | (16 << 10)>(send.y)}; }
    { const f32x2 keep = b3 ? a2[1] : a2[0], send = b3 ? a2[0] : a2[1]; a3 = keep + (f32x2){swz_f<0x1F | (8 << 10)>(send.x), swz_f<0x1F | (8 << 10)>(send.y)}; }
    const unsigned hb = *(const unsigned*)H; const f32x2 hv = (f32x2){bflo(hb), bfhi(hb)};
    const f32x2 y = hv + a3;
    *(unsigned*)out = pk2(y.x, y.y);
}
__device__ __forceinline__ void peer_v(const P& p, int wave, int lane) {
    const int j = blockIdx.x & 7, nchunk = gridDim.x >> 3, chunk = blockIdx.x >> 3, stride = nchunk * 8;
    const int g = lane >> 3, c8 = lane & 7;
    const bool b5 = (lane & 32) != 0, b4 = (lane & 16) != 0, b3 = (lane & 8) != 0;
    const int pi = 4 * (b3 ? 1 : 0) + 2 * (b4 ? 1 : 0) + (b5 ? 1 : 0);
    const size_t colo = 128 * j + 16 * c8 + 2 * pi;
    const bf16* H = (const bf16*)(p.ws + WS_H) + colo; bf16* OUT = (bf16*)(p.ws + WS_YB) + colo;
    const int* IDXg = (const int*)(p.ws + WS_IDX) + 16 * g; const float* COEFg = (const float*)(p.ws + WS_COEF) + 16 * g;
    const unsigned char* VS = p.ws + WS_V8 + (size_t)j * NEXP * 128 + 16 * c8;
    const int m0 = chunk * 8 + wave, ntok = (T_ - m0 + stride - 1) / stride;
#define PV_CLAMP(k) (m0 + ((k) < ntok ? (k) : ntok - 1) * stride)
#define PV_ROWS(vr, q) _Pragma("unroll") for (int i = 0; i < 16; ++i) vr[i] = *(const v4u*)(VS + (size_t)q.ei[i >> 2][i & 3] * 128)
    PvPre q; v4u vrA[16], vrB[16]; f32x4 cA[4], cB[4];
    pv_level1(q, IDXg, COEFg, m0, c8);
    PV_ROWS(vrA, q);
#pragma unroll
    for (int k = 0; k < 4; ++k) cA[k] = q.cf[k];
    pv_level1(q, IDXg, COEFg, PV_CLAMP(1), c8);
    for (int k = 0; k < ntok; k += 2) {
        PV_ROWS(vrB, q);
#pragma unroll
        for (int kk = 0; kk < 4; ++kk) cB[kk] = q.cf[kk];
        pv_level1(q, IDXg, COEFg, PV_CLAMP(k + 2), c8);
        { const size_t mm = (size_t)(m0 + k * stride); peer_v_token(vrA, cA, H + mm * 1024, OUT + mm * 1024, b3, b4, b5); }
        if (k + 1 < ntok) {
            PV_ROWS(vrA, q);
#pragma unroll
            for (int kk = 0; kk < 4; ++kk) cA[kk] = q.cf[kk];
            pv_level1(q, IDXg, COEFg, PV_CLAMP(k + 3), c8);
            { const size_t mm = (size_t)(m0 + (k + 1) * stride); peer_v_token(vrB, cB, H + mm * 1024, OUT + mm * 1024, b3, b4, b5); }
        }
    }
#undef PV_CLAMP
#undef PV_ROWS
}
__device__ __forceinline__ void peer_f(const P& p, int wave, int lane) {
    const int gw = blockIdx.x * NWAVES + wave, NGW = gridDim.x * NWAVES;
    for (int m = gw; m < T_; m += NGW) {
        const v2u* yb = (const v2u*)((const bf16*)(p.ws + WS_YB) + (size_t)m * 1024) + lane;
        v2u yv[4]; float ss = 0.f;
#pragma unroll
        for (int q = 0; q < 4; ++q) { yv[q] = yb[64 * q]; const float a = bflo(yv[q].x), b = bfhi(yv[q].x), c = bflo(yv[q].y), d = bfhi(yv[q].y); ss += (a * a + b * b) + (c * c + d * d); }
        const float rstd = frsq(wave_sum(ss) * (1.f / 1024.f) + EPS);
        f32x4* o = (f32x4*)(p.out + (size_t)m * 1024) + lane; const f32x4* wr = (const f32x4*)p.norm_final_w + lane;
#pragma unroll
        for (int q = 0; q < 4; ++q) { const f32x4 w = wr[64 * q];
            o[64 * q] = (f32x4){bflo(yv[q].x) * rstd * w.x, bfhi(yv[q].x) * rstd * w.y, bflo(yv[q].y) * rstd * w.z, bfhi(yv[q].y) * rstd * w.w}; }
    }
}

constexpr int N_PHASES = 12;
struct Args { P p; int ph_lo, ph_hi; };
__global__ void __launch_bounds__(NTHR, 2) fwd_kernel(Args args) {
    extern __shared__ __attribute__((aligned(16))) unsigned char lds_raw[];
    LAS unsigned char* lds = (LAS unsigned char*)lds_raw;
    const P& p = args.p;
    const int tid = threadIdx.x, lane = tid & 63, wave = __builtin_amdgcn_readfirstlane(tid >> 6);
    volatile LAS unsigned* MISC = (volatile LAS unsigned*)(lds + MISC_OFF);
    for (int u = tid; u < (LDS_BYTES - LDSCTL_OFF) / 4; u += NTHR) ((LAS unsigned*)(lds + LDSCTL_OFF))[u] = 0u;
    __syncthreads();
    XcdBarrier bar; bar.bar = (unsigned*)(p.ws + WS_CTL) + CW_BAR; bar.x = 0; bar.st = nullptr;
#if !MK_PER_PHASE
    bar = xcd_barrier_post((unsigned*)(p.ws + WS_CTL) + CW_BAR, MISC + 8);
#endif
    const int lo = args.ph_lo, hi = args.ph_hi;
#define IN(k) (lo <= (k) && (k) < hi)
#ifndef PROBE_WAIT_LO
#define PROBE_WAIT_LO -1
#define PROBE_WAIT_HI -1
#endif
    volatile LAS unsigned long long* STAMP = (volatile LAS unsigned long long*)(lds + MISC_OFF + 256);
#define SEAM(k) do { if (IN(k) && IN((k) + 1)) xcd_barrier(bar); if (PROBE_WAIT_LO >= 0 && blockIdx.x == 0 && tid == 0) { STAMP[(k) + 1] = __builtin_amdgcn_s_memrealtime(); \
        if ((k) + 1 == N_PHASES - 1) { const unsigned long long d_ = STAMP[PROBE_WAIT_HI < 0 ? 0 : PROBE_WAIT_HI] - STAMP[PROBE_WAIT_LO < 0 ? 0 : PROBE_WAIT_LO]; \
            __hip_atomic_store((unsigned*)(p.ws + WS_CTL) + CW_Q + 256, (unsigned)d_ | 1u, __ATOMIC_RELAXED, __HIP_MEMORY_SCOPE_AGENT); } } } while (0)
    if (PROBE_WAIT_LO >= 0 && blockIdx.x == 0 && tid == 0) STAMP[0] = __builtin_amdgcn_s_memrealtime();

#ifndef PROBE_REP
#define PROBE_REP -1
#endif
#define REP(k) ((PROBE_REP == (k)) ? 2 : 1)
    if (IN(0)) {
#pragma unroll 1
        for (int r = 0; r < REP(0); ++r) p0_prologue(p, lds, wave, lane); } SEAM(0);
    if (IN(1)) {
#pragma unroll 1
      for (int r = 0; r < REP(1); ++r) {
        EpiProj e{(bf16*)(p.ws + WS_SBQKV), (bf16*)(p.ws + WS_VT), (bf16*)(p.ws + WS_MLQK), (bf16*)(p.ws + WS_MLV), (bf16*)(p.ws + WS_MLO), (bf16*)(p.ws + WS_GATES)};
        gemm<EpiProj>(lds, (const bf16*)(p.ws + WS_XN), (const bf16*)(p.ws + WS_W1T), T_, NPROJ, 1024, e); }
    } SEAM(1);
    if (IN(2)) { p2_conv(p, tid); } SEAM(2);
    if (IN(3)) {
        for (int it = blockIdx.x; it < 64; it += gridDim.x) mlstm_item(p, lds, it, tid, wave, lane);
        unsigned* qctr = (unsigned*)(p.ws + WS_CTL) + CW_Q;
#ifdef PROBE_P3SPLIT
        xcd_barrier(bar); if (blockIdx.x == 0 && tid == 0) STAMP[20] = __builtin_amdgcn_s_memrealtime();
#endif
        for (;;) {
            if (tid == 0) MISC[12] = __hip_atomic_fetch_add(qctr, 1u, __ATOMIC_RELAXED, __HIP_MEMORY_SCOPE_AGENT);
            __syncthreads();
            const unsigned it = MISC[12];
            __syncthreads();
            if (it >= 1024u) break;
            sba_item(p, (int)it, wave, lane);
        }
#ifdef PROBE_P3SPLIT
        xcd_barrier(bar); if (blockIdx.x == 0 && tid == 0) STAMP[21] = __builtin_amdgcn_s_memrealtime();
#endif
        for (;;) {
            if (tid == 0) MISC[12] = __hip_atomic_fetch_add(qctr + 128, 1u, __ATOMIC_RELAXED, __HIP_MEMORY_SCOPE_AGENT);
            __syncthreads();
            const unsigned it = MISC[12];
            __syncthreads();
            if (it >= (unsigned)N_FILL) break;
            fill_item(p, (int)it, wave, lane);
        }
    } SEAM(3);
    if (IN(4)) { p3_yml(p, wave, lane); } SEAM(4);
    if (IN(5)) {
        pg8::Gemm g{(const bf16*)p.out, (const bf16*)(p.ws + WS_WSBT), T_, 1024, 1024}; pg8::StaticOrder S; S.init(T_, 1024, (int)gridDim.x, (int)blockIdx.x);
        EpiMerge1 e{(bf16*)(p.ws + WS_MERGED), (const unsigned char*)(p.ws + WS_GATES)};
        pg8::gemm_phase<EpiMerge1, pg8::StaticOrder, true, true, true>(lds, g, S, e);
    } SEAM(5);
    if (IN(6)) {
        pg8::Gemm g{(const bf16*)(p.ws + WS_MERGED), (const bf16*)(p.ws + WS_WOUTT), T_, 1024, 1024}; pg8::StaticOrder S; S.init(T_, 1024, (int)gridDim.x, (int)blockIdx.x);
        EpiHW e{(bf16*)(p.ws + WS_H), p.x, (bf16*)p.out  , p.norm_ffn_w, (float*)(p.ws + WS_SS)};
        pg8::gemm_phase<EpiHW, pg8::StaticOrder, true, true>(lds, g, S, e);
    } SEAM(6);
    if (IN(7)) {
        pg8::Gemm g{(const bf16*)p.out, (const bf16*)(p.ws + WS_WCT), T_, 2048, 1024}; pg8::StaticOrder S; S.init(T_, 2048, (int)gridDim.x, (int)blockIdx.x);
        EpiTopk e{(int*)(p.ws + WS_IDX), (float*)(p.ws + WS_GATE), (const float*)(p.ws + WS_SS)};
#pragma unroll 1
        for (int i = 0;; ++i) { OneUnit s1; if (!S.next(i, s1.u)) break; pg8::gemm_phase<EpiTopk, OneUnit, false, true>(lds, g, s1, e); }
    } SEAM(7);
    if (IN(8)) { peer_u(p, wave, lane); } SEAM(8);
    if (IN(9)) { peer_c(p, wave, lane); } SEAM(9);
    if (IN(10)) { peer_v(p, wave, lane); } SEAM(10);
    if (IN(11)) { peer_f(p, wave, lane); }
    if (PROBE_WAIT_LO >= 0 && tid == 0) {
        unsigned* pw = (unsigned*)(p.ws + WS_CTL) + CW_Q + 256;
        unsigned dt = 0u;
        for (unsigned sp = 0; sp < (1u << 22); ++sp) { dt = __hip_atomic_load(pw, __ATOMIC_RELAXED, __HIP_MEMORY_SCOPE_AGENT); if (dt) break; __builtin_amdgcn_s_sleep(8); }
        const unsigned long long tend = __builtin_amdgcn_s_memrealtime();
        while (__builtin_amdgcn_s_memrealtime() - tend < (unsigned long long)dt) __builtin_amdgcn_s_sleep(8);
    }
#undef IN
#undef SEAM
}

extern "C" void kernel_launch(void* const* d_in, const int* in_sizes, int n_in, void* d_out, int out_size, void* d_ws, size_t ws_size, hipStream_t stream) {
    static int grid = 0;
    if (grid == 0) {
        if (n_in != 18 || in_sizes[0] != T_ * D_ || out_size != T_ * D_ || ws_size < WS_END) {
            fprintf(stderr, "kernel_launch: unexpected problem (n_in %d, in0 %d, out %d, ws %zu); nothing launched\n", n_in, n_in > 0 ? in_sizes[0] : -1, out_size, ws_size); grid = -1; return; }
        int dev = 0, cus = 0, per_cu = 0;
        if (hipGetDevice(&dev) != hipSuccess || hipDeviceGetAttribute(&cus, hipDeviceAttributeMultiprocessorCount, dev) != hipSuccess) { grid = -1; return; }
        if (hipFuncSetAttribute((const void*)fwd_kernel, hipFuncAttributeMaxDynamicSharedMemorySize, LDS_BYTES) != hipSuccess) { fprintf(stderr, "kernel_launch: hipFuncSetAttribute failed\n"); grid = -1; return; }
        if (hipOccupancyMaxActiveBlocksPerMultiprocessor(&per_cu, (const void*)fwd_kernel, NTHR, LDS_BYTES) != hipSuccess || per_cu < 1)
            fprintf(stderr, "kernel_launch: note: occupancy query reports %d workgroups per CU\n", per_cu);
        (void)hipGetLastError();
        grid = cus;
    }
    if (grid < 0) return;
    if (hipMemsetAsync((char*)d_ws + WS_CTL, 0, CTL_ZERO_BYTES, stream) != hipSuccess) { fprintf(stderr, "kernel_launch: memset failed\n"); return; }
    Args a{};
    const float** pp = (const float**)&a.p;
    for (int i = 0; i < 18; ++i) pp[i] = (const float*)d_in[i];
    a.p.out = (float*)d_out; a.p.ws = (unsigned char*)d_ws;
#if MK_PER_PHASE
    for (int ph = 0; ph < N_PHASES; ++ph) {
        a.ph_lo = ph; a.ph_hi = ph + 1;
        hipLaunchKernelGGL(fwd_kernel, dim3(grid), dim3(NTHR), LDS_BYTES, stream, a);
    }
#else
    a.ph_lo = 0; a.ph_hi = N_PHASES;
    hipLaunchKernelGGL(fwd_kernel, dim3(grid), dim3(NTHR), LDS_BYTES, stream, a);
#endif
    const hipError_t le = hipPeekAtLastError();
    if (le != hipSuccess) fprintf(stderr, "kernel_launch: launch failed: %s\n", hipGetErrorName(le));
}
```

```cpp
#include <hip/hip_runtime.h>
#include <cstdio>
#include <cstdint>
namespace pg8 {
#define PG8_LAS __attribute__((address_space(3)))
typedef unsigned short bf16_t;
typedef short bf16x8 __attribute__((ext_vector_type(8)));
typedef float f32x4 __attribute__((ext_vector_type(4)));
typedef unsigned u32x4 __attribute__((ext_vector_type(4)));
constexpr int BM = 256, BK = 64, HALF = 128, HTB = HALF * BK * 2  , STAGE_BYTES = 8 * HTB, NXCD = 8, WGM = 8;

__host__ __device__ __forceinline__ int lds_byte(int r, int c) { const int st = (r >> 4) * 2 + (c >> 5), rr = r & 15, cc = c & 31, ob = rr * 64 + cc * 2; return st * 1024 + (ob ^ (((ob >> 9) & 1) << 5)); }
__host__ __device__ __forceinline__ void stage_rc(int b, int& R, int& C) { const int st = b / 1024, sb = b % 1024, swz = sb ^ (((sb >> 9) & 1) << 5); R = (st >> 1) * 16 + swz / 64; C = (st & 1) * 32 + (swz % 64) / 2; }
__host__ __device__ __forceinline__ int perm32(int rho) { const int n = rho >> 4, i = rho & 15; return 8 * (i >> 2) + 4 * n + (i & 3); }

struct Unit { int pm, pn; };
struct Gemm { const bf16_t* A; const bf16_t* Bt; int M, N, K; };

struct StaticOrder {
    int nM, nN, nwg, G, c;
    __host__ __device__ void init(int M, int N, int G_, int c_) { nM = M / BM; nN = N / BM; nwg = nM * nN; G = G_; c = c_; }
    __host__ __device__ bool next(int i, Unit& u) const {
        const long L = (long)i * G + c; if (L >= nwg) return false;
        int wgid = (int)L; { const int q = nwg / NXCD, r = nwg % NXCD, xcd = wgid % NXCD, off = wgid / NXCD; wgid = (xcd < r ? xcd * (q + 1) : r * (q + 1) + (xcd - r) * q) + off; }
        const int nig = WGM * nN, gid = wgid / nig, fm = gid * WGM, gsz = (nM - fm) < WGM ? (nM - fm) : WGM;
        u.pm = fm + ((wgid % nig) % gsz); u.pn = (wgid % nig) / gsz; return true;
    }
    __device__ __forceinline__ void a_ready(const Unit&) const {}
    __device__ __forceinline__ void done(const Unit&) const {}
};

__device__ __forceinline__ unsigned cvt_pk_bf16(float lo, float hi) { unsigned r; asm volatile("v_cvt_pk_bf16_f32 %0, %1, %2" : "=v"(r) : "v"(lo), "v"(hi)); return r; }
template <class Epi, class Sched, bool ALIGN_EPI = false, bool SP2 = false, bool MID = false  >
__device__ __forceinline__ void gemm_phase(PG8_LAS unsigned char* lds, const Gemm g, const Sched& S, const Epi& E) {
    const int tid = threadIdx.x, wid = __builtin_amdgcn_readfirstlane(tid >> 6), lane = tid & 63, wr = wid >> 2, wc = wid & 3, fr = lane & 15, fq = lane >> 4;
    const int K = g.K, nt = K / BK;
    unsigned voffA[2], voffB[2];
#pragma unroll
    for (int i = 0; i < 2; ++i) { int R, C; stage_rc(tid * 16 + i * 8192, R, C); const int Rb = Epi::PERM ? ((R & ~31) + perm32(R & 31)) : R;
        voffA[i] = (unsigned)(R * K + C) * 2u; voffB[i] = (unsigned)(Rb * K + C) * 2u; }
    const size_t kstep = (size_t)(BK * 2);
    const size_t hstep = (size_t)HALF * K * 2;
    const size_t tstep = 2 * hstep;
    const unsigned ldsw = (unsigned)wid * 1024u;
    const int aoff = lds_byte(wr * 64 + fr, fq * 8), boff = lds_byte(wc * 32 + fr, fq * 8);
#define PG8_SA(b, h) (((b) * 2 + (h)) * HTB)
#define PG8_SB(b, h) ((4 + (b) * 2 + (h)) * HTB)
#define PG8_STAGE(bufoff, gbase, voff) do { _Pragma("unroll") for (int _i = 0; _i < 2; ++_i) \
        __builtin_amdgcn_global_load_lds((const unsigned*)((const char*)(gbase) + (voff)[_i]), (PG8_LAS unsigned*)(lds + (bufoff) + ldsw + _i * 8192), 16, 0, 0); } while (0)
#define PG8_LDA(dst, b, h) do { _Pragma("unroll") for (int m = 0; m < 4; ++m) _Pragma("unroll") for (int k = 0; k < 2; ++k) dst[m][k] = *(const PG8_LAS bf16x8*)(lds + PG8_SA(b, h) + aoff + m * 2048 + k * 1024); } while (0)
#define PG8_LDB(dst, b, h) do { _Pragma("unroll") for (int n = 0; n < 2; ++n) _Pragma("unroll") for (int k = 0; k < 2; ++k) dst[n][k] = *(const PG8_LAS bf16x8*)(lds + PG8_SB(b, h) + boff + n * 2048 + k * 1024); } while (0)
#define PG8_MMA(ai, bj, At, Bt) do { __builtin_amdgcn_s_setprio(1); _Pragma("unroll") for (int m = 0; m < 4; ++m) _Pragma("unroll") for (int n = 0; n < 2; ++n) _Pragma("unroll") for (int k = 0; k < 2; ++k) \
        acc[ai][bj][m][n] = __builtin_amdgcn_mfma_f32_16x16x32_bf16(Bt[n][k], At[m][k], acc[ai][bj][m][n], 0, 0, 0); __builtin_amdgcn_s_setprio(0); } while (0)
#define PG8_WAIT_V(n) asm volatile("s_waitcnt vmcnt(" #n ")" ::: "memory")
#define PG8_WAIT_L(n) asm volatile("s_waitcnt lgkmcnt(" #n ")" ::: "memory")
#define PG8_BAR __builtin_amdgcn_s_barrier()
#define PG8_SCHED __builtin_amdgcn_sched_barrier(0)
    Unit cur, nxt; int ui = 0;
    if (!S.next(0, cur)) return;
    f32x4 acc[2][2][4][2];
#pragma unroll
    for (int a = 0; a < 2; ++a)
#pragma unroll
        for (int b = 0; b < 2; ++b)
#pragma unroll
            for (int m = 0; m < 4; ++m)
#pragma unroll
                for (int n = 0; n < 2; ++n) acc[a][b][m][n] = (f32x4){0.f, 0.f, 0.f, 0.f};
    bf16x8 At[4][2], B0[2][2], B1[2][2];
    const char* cA = (const char*)g.A + (size_t)cur.pm * tstep; const char* cB = (const char*)g.Bt + (size_t)cur.pn * tstep;
    S.a_ready(cur);
    if constexpr (SP2) {
        PG8_STAGE(PG8_SB(0, 0), cB, voffB); PG8_STAGE(PG8_SB(0, 1), cB + hstep, voffB); PG8_STAGE(PG8_SA(0, 0), cA, voffA); PG8_STAGE(PG8_SA(0, 1), cA + hstep, voffA);
        if (wr == 1) PG8_BAR;
        PG8_WAIT_V(2); PG8_BAR;
        PG8_STAGE(PG8_SB(1, 0), cB + kstep, voffB); PG8_STAGE(PG8_SA(1, 0), cA + kstep, voffA); PG8_STAGE(PG8_SB(1, 1), cB + hstep + kstep, voffB);
        PG8_WAIT_V(6); PG8_BAR;
    } else {
        PG8_STAGE(PG8_SB(0, 0), cB, voffB); PG8_STAGE(PG8_SA(0, 0), cA, voffA); PG8_STAGE(PG8_SB(0, 1), cB + hstep, voffB); PG8_STAGE(PG8_SA(0, 1), cA + hstep, voffA);
        if (wr == 1) PG8_BAR;
        PG8_WAIT_V(4); PG8_BAR;
        PG8_STAGE(PG8_SB(1, 0), cB + kstep, voffB); PG8_STAGE(PG8_SA(1, 0), cA + kstep, voffA); PG8_STAGE(PG8_SB(1, 1), cB + hstep + kstep, voffB);
        PG8_WAIT_V(6); PG8_BAR;
    }
    for (;;) {
        const bool has_next = S.next(ui + 1, nxt);
        const char* nA = has_next ? (const char*)g.A + (size_t)nxt.pm * tstep : cA; const char* nB = has_next ? (const char*)g.Bt + (size_t)nxt.pn * tstep : cB;
        for (int t = 0; t < nt; t += 2) {
            if constexpr (MID) { if (t == (nt >> 1)) E.mid(acc, cur, wr, wc, fr, fq); }
            const bool last = (t == nt - 2);
            const char* a1 = cA + (size_t)(t + 1) * kstep;
            const char* a2 = last ? nA : cA + (size_t)(t + 2) * kstep; const char* b2 = last ? nB : cB + (size_t)(t + 2) * kstep;
            const char* a3 = a2 + kstep; const char* b3 = b2 + kstep;
            if (last && has_next) S.a_ready(nxt);
            if constexpr (SP2) {
            PG8_LDB(B0, 0, 0); PG8_LDB(B1, 0, 1); PG8_SCHED; PG8_LDA(At, 0, 0); PG8_STAGE(PG8_SA(1, 1), a1 + hstep, voffA);
            PG8_WAIT_V(8); PG8_WAIT_L(0); PG8_BAR; PG8_MMA(0, 0, At, B0); PG8_MMA(0, 1, At, B1); PG8_BAR; PG8_SCHED;
            PG8_LDA(At, 0, 1); PG8_STAGE(PG8_SB(0, 0), b2, voffB); PG8_STAGE(PG8_SB(0, 1), b2 + hstep, voffB); PG8_STAGE(PG8_SA(0, 0), a2, voffA);
            PG8_WAIT_V(8); PG8_WAIT_L(0); PG8_BAR; PG8_MMA(1, 0, At, B0); PG8_MMA(1, 1, At, B1); PG8_BAR; PG8_SCHED;
            PG8_LDB(B0, 1, 0); PG8_LDB(B1, 1, 1); PG8_SCHED; PG8_LDA(At, 1, 0); PG8_STAGE(PG8_SA(0, 1), a2 + hstep, voffA);
            PG8_WAIT_V(8); PG8_WAIT_L(0); PG8_BAR; PG8_MMA(0, 0, At, B0); PG8_MMA(0, 1, At, B1); PG8_BAR; PG8_SCHED;
            PG8_LDA(At, 1, 1); PG8_STAGE(PG8_SB(1, 0), b3, voffB); PG8_STAGE(PG8_SB(1, 1), b3 + hstep, voffB); PG8_STAGE(PG8_SA(1, 0), a3, voffA);
            PG8_WAIT_V(8); PG8_WAIT_L(0); PG8_BAR; PG8_MMA(1, 0, At, B0); PG8_MMA(1, 1, At, B1); PG8_BAR; PG8_SCHED;
            } else {
            PG8_LDB(B0, 0, 0); PG8_SCHED; PG8_LDA(At, 0, 0); PG8_STAGE(PG8_SA(1, 1), a1 + hstep, voffA);
            PG8_WAIT_L(8); PG8_BAR; PG8_WAIT_L(0); PG8_MMA(0, 0, At, B0); PG8_BAR; PG8_SCHED;
            PG8_LDB(B1, 0, 1); PG8_STAGE(PG8_SB(0, 0), b2, voffB);
            PG8_BAR; PG8_WAIT_L(0); PG8_MMA(0, 1, At, B1); PG8_BAR;
            PG8_LDA(At, 0, 1); PG8_STAGE(PG8_SA(0, 0), a2, voffA);
            PG8_BAR; PG8_WAIT_L(0); PG8_MMA(1, 0, At, B0); PG8_BAR; PG8_SCHED;
            PG8_STAGE(PG8_SB(0, 1), b2 + hstep, voffB);
            PG8_WAIT_V(6); PG8_BAR; PG8_MMA(1, 1, At, B1); PG8_BAR;
            PG8_LDB(B0, 1, 0); PG8_SCHED; PG8_LDA(At, 1, 0); PG8_STAGE(PG8_SA(0, 1), a2 + hstep, voffA);
            PG8_WAIT_L(8); PG8_BAR; PG8_WAIT_L(0); PG8_MMA(0, 0, At, B0); PG8_BAR; PG8_SCHED;
            PG8_LDB(B1, 1, 1); PG8_STAGE(PG8_SB(1, 0), b3, voffB);
            PG8_BAR; PG8_WAIT_L(0); PG8_MMA(0, 1, At, B1); PG8_BAR;
            PG8_LDA(At, 1, 1); PG8_STAGE(PG8_SA(1, 0), a3, voffA);
            PG8_BAR; PG8_WAIT_L(0); PG8_MMA(1, 0, At, B0); PG8_BAR; PG8_SCHED;
            PG8_STAGE(PG8_SB(1, 1), b3 + hstep, voffB);
            PG8_WAIT_V(6); PG8_BAR; PG8_MMA(1, 1, At, B1); PG8_BAR;
            }
        }
        if constexpr (ALIGN_EPI) { if (wr == 0) PG8_BAR; }
        if constexpr (!Epi::AFTER_DRAIN) { E(acc, cur, wr, wc, fr, fq); S.done(cur); }
        if (!has_next) break;
#pragma unroll
        for (int a = 0; a < 2; ++a)
#pragma unroll
            for (int b = 0; b < 2; ++b)
#pragma unroll
                for (int m = 0; m < 4; ++m)
#pragma unroll
                    for (int n = 0; n < 2; ++n) acc[a][b][m][n] = (f32x4){0.f, 0.f, 0.f, 0.f};
        cur = nxt; cA = nA; cB = nB; ++ui;
        if constexpr (ALIGN_EPI) { if (wr == 1) PG8_BAR; }
    }
    PG8_WAIT_V(0);
    if constexpr (!ALIGN_EPI) { if (wr == 0) PG8_BAR; }
    PG8_BAR;
    if constexpr (Epi::AFTER_DRAIN) { E.fused(acc, cur, wr, wc, fr, fq, lds, wid, lane); S.done(cur); }
#undef PG8_SA
#undef PG8_SB
#undef PG8_STAGE
#undef PG8_LDA
#undef PG8_LDB
#undef PG8_MMA
#undef PG8_WAIT_V
#undef PG8_WAIT_L
#undef PG8_BAR
#undef PG8_SCHED
}
}

#ifndef MK_PER_PHASE
#define MK_PER_PHASE 0
#endif
#ifndef USE_PG8
#define USE_PG8 1
#endif
constexpr int NWAVES = 8, NTHR = 512;

constexpr int B_ = 16, S_ = 2048, D_ = 1024, T_ = B_ * S_;
constexpr int INC = 5640, NPROJ = 5632;
constexpr int NEXP = 16384;
constexpr float EPS = 1e-6f;

constexpr size_t MiB = 1u << 20;
constexpr size_t WS_CTL = 0, CTL_ZERO_BYTES = 1 * MiB;
constexpr size_t WS_W1T = 2 * MiB, WS_WSBT = 13 * MiB, WS_WMLT = 14 * MiB, WS_WOUTT = 15 * MiB, WS_WCT = 17 * MiB, WS_IFG = 21 * MiB;
constexpr size_t WS_U8 = 24 * MiB, WS_V8 = 40 * MiB, WS_USC = 22 * MiB, WS_VSC = 23 * MiB;
constexpr size_t WS_XN = 88 * MiB, WS_QC = 88 * MiB, WS_KC = 120 * MiB;
constexpr size_t WS_SBQKV = 152 * MiB  , WS_VT = 216 * MiB  , WS_MLQK = 248 * MiB, WS_MLV = 312 * MiB, WS_MLO = 344 * MiB, WS_GATES = 376 * MiB;
constexpr size_t WS_MERGED = 216 * MiB, WS_H = 88 * MiB, WS_HN = 216 * MiB, WS_IDX = 280 * MiB, WS_GATE = 296 * MiB, WS_SC = 312 * MiB;
constexpr size_t WS_PART = 312 * MiB  , WS_SSQ = 504 * MiB  , WS_COEF = 56 * MiB  , WS_YB = 152 * MiB  , WS_HN8 = 440 * MiB  , WS_XS = 505 * MiB  , WS_SS = 506 * MiB  ;
constexpr size_t WS_END = 508 * MiB;
constexpr int CW_BAR = 4096, CW_Q = 8192;

constexpr int RING_OFF = 0, RING_BYTES = 135168;
constexpr int LDSCTL_OFF = RING_BYTES, MISC_OFF = LDSCTL_OFF + 320;
constexpr int LDS_BYTES = 147456;

#define GAS __attribute__((address_space(1)))
#define LAS __attribute__((address_space(3)))
typedef unsigned short bf16;
typedef unsigned v4u __attribute__((ext_vector_type(4)));
typedef unsigned v2u __attribute__((ext_vector_type(2)));
typedef float f32x4 __attribute__((ext_vector_type(4)));
#define LDS_WAIT() asm volatile("s_waitcnt lgkmcnt(0)" ::: "memory")
#define VM_WAIT() asm volatile("s_waitcnt vmcnt(0)" ::: "memory")
typedef float f32x2_t __attribute__((ext_vector_type(2))); typedef __bf16 bf16x2_t __attribute__((ext_vector_type(2)));
__device__ __forceinline__ unsigned cvtpk(float lo, float hi) { f32x2_t v = {lo, hi}; bf16x2_t b = __builtin_convertvector(v, bf16x2_t); return __builtin_bit_cast(unsigned, b); }
__device__ __forceinline__ unsigned f2bf(float f) { return cvtpk(f, f) & 0xffffu; }
__device__ __forceinline__ unsigned pk2(float lo, float hi) { return cvtpk(lo, hi); }
__device__ __forceinline__ float bflo(unsigned u) { return __builtin_bit_cast(float, u << 16); }
__device__ __forceinline__ float bfhi(unsigned u) { return __builtin_bit_cast(float, u & 0xffff0000u); }
__device__ __forceinline__ float bf2f(bf16 b) { return __builtin_bit_cast(float, (unsigned)b << 16); }
__device__ __forceinline__ float fexp(float x) { return __builtin_amdgcn_exp2f(x * 1.4426950408889634f); }
__device__ __forceinline__ float flog(float x) { return __builtin_amdgcn_logf(x) * 0.6931471805599453f; }
__device__ __forceinline__ float frcp(float x) { return __builtin_amdgcn_rcpf(x); }
__device__ __forceinline__ float frsq(float x) { return __builtin_amdgcn_rsqf(x); }
__device__ __forceinline__ float sigmoidf_(float x) { return frcp(1.f + fexp(-x)); }
__device__ __forceinline__ float wave_sum(float v) {
#pragma unroll
    for (int o = 1; o < 64; o <<= 1) v += __shfl_xor(v, o);
    return v;
}
__device__ __forceinline__ unsigned wave_max_u(unsigned v) {
#pragma unroll
    for (int o = 1; o < 64; o <<= 1) { const unsigned w = (unsigned)__shfl_xor((int)v, o); v = v > w ? v : w; }
    return v;
}
struct F8 { float v[8]; };
__device__ __forceinline__ void unpack8(const v4u& u, float (&f)[8]) {
    f[0] = bflo(u.x); f[1] = bfhi(u.x); f[2] = bflo(u.y); f[3] = bfhi(u.y); f[4] = bflo(u.z); f[5] = bfhi(u.z); f[6] = bflo(u.w); f[7] = bfhi(u.w);
}
__device__ __forceinline__ v4u pack8(const float (&f)[8]) { v4u o; o.x = pk2(f[0], f[1]); o.y = pk2(f[2], f[3]); o.z = pk2(f[4], f[5]); o.w = pk2(f[6], f[7]); return o; }

#define XB_TMO      128
#define XB_XCNT(j)  (256  + 64 * (j))
#define XB_XSUB(j)  (1280 + 64 * (j))
#define XB_XGEN(j)  (2304 + 64 * (j))
#define XB_TOP      3328
#define XB_TOPGEN   3392
#define XCD_BAR_WORDS 3456
#define XB_SPIN_CAP (1u << 24)

__device__ __forceinline__ unsigned xb_ld(unsigned* p)              { return __hip_atomic_load(p, __ATOMIC_RELAXED, __HIP_MEMORY_SCOPE_AGENT); }
__device__ __forceinline__ unsigned xb_add(unsigned* p, unsigned v) { return __hip_atomic_fetch_add(p, v, __ATOMIC_RELAXED, __HIP_MEMORY_SCOPE_AGENT); }
__device__ __forceinline__ unsigned xb_xcc_id() { return (unsigned)__builtin_amdgcn_s_getreg((3 << 11) | 20) & 0xFu; }
#define XB_SPIN(cond, bar) do { unsigned _sp = 0; while (cond) { __builtin_amdgcn_s_sleep(1); \
    if ((++_sp & 255u) == 0u) { if (xb_ld(&(bar)[XB_TMO])) break; if (_sp > XB_SPIN_CAP) { atomicAdd(&(bar)[XB_TMO], 1u); break; } } } } while (0)

struct XcdBarrier {
    unsigned* bar; unsigned x;
    volatile LAS unsigned* st;
};

__device__ __forceinline__ XcdBarrier xcd_barrier_post(unsigned* bar, volatile LAS unsigned* st) {
    XcdBarrier b; b.bar = bar; b.x = xb_xcc_id(); b.st = st;
    if (threadIdx.x == 0) (void)xb_add(&bar[XB_XCNT(b.x)], 1u);
    return b;
}
__device__ __forceinline__ void xcd_barrier_complete(unsigned* bar, unsigned x, unsigned& nloc, unsigned& nx) {
    const unsigned G = gridDim.x * gridDim.y * gridDim.z;
    unsigned sum, cnt, mine, sp = 0u;
    for (;;) {
        sum = 0u; cnt = 0u; mine = 0u;
#pragma unroll
        for (unsigned j = 0; j < 16; ++j) { const unsigned c = xb_ld(&bar[XB_XCNT(j)]); sum += c; cnt += (c > 0u) ? 1u : 0u; mine = (j == x) ? c : mine; }
        if (sum == G) break;
        __builtin_amdgcn_s_sleep(1);
        if ((++sp & 255u) == 0u) { if (xb_ld(&bar[XB_TMO])) break; if (sp > XB_SPIN_CAP) { atomicAdd(&bar[XB_TMO], 1u); break; } }
    }
    nloc = mine > 0u ? mine : 1u; nx = cnt > 0u ? cnt : 1u;
}

__device__ __forceinline__ void xcd_barrier(const XcdBarrier& b) {
    asm volatile("s_waitcnt vmcnt(0)" ::: "memory");
    __syncthreads();
    if (threadIdx.x == 0) {
        unsigned* bar = b.bar;
        __builtin_amdgcn_s_waitcnt(0);
        unsigned nloc = b.st[0], nx = b.st[1];
        if (nloc == 0u) { xcd_barrier_complete(bar, b.x, nloc, nx); b.st[0] = nloc; b.st[1] = nx; }
        const unsigned old = xb_add(&bar[XB_XSUB(b.x)], 1u);
        const unsigned gen = old / nloc;
        if (old + 1u == (gen + 1u) * nloc) {
            __builtin_amdgcn_fence(__ATOMIC_RELEASE, "agent");
            asm volatile("s_waitcnt vmcnt(0)" ::: "memory");
            const unsigned og = xb_add(&bar[XB_TOP], 1u);
            const unsigned tg = og / nx;
            if (og + 1u == (tg + 1u) * nx) xb_add(&bar[XB_TOPGEN], 1u);
            else XB_SPIN(xb_ld(&bar[XB_TOPGEN]) == tg, bar);
            __builtin_amdgcn_fence(__ATOMIC_ACQUIRE, "agent");
            xb_add(&bar[XB_XGEN(b.x)], 1u);
            asm volatile("s_waitcnt vmcnt(0)" ::: "memory");
        } else {
            XB_SPIN(xb_ld(&bar[XB_XGEN(b.x)]) == gen, bar);
            __builtin_amdgcn_fence(__ATOMIC_ACQUIRE, "agent");
            asm volatile("s_waitcnt vmcnt(0)" ::: "memory");
        }
    }
    __syncthreads();
}

struct EpiProj {
    bf16 *sbqk, *vt, *mlqk, *mlv, *mlo, *gates;
    __device__ __forceinline__ void operator()(int row, int col, const F8& a) const {
        bf16* dst;
        if (col < 1024) dst = sbqk + (size_t)row * 1024 + col;
        else if (col < 1536) {
            const int c = col - 1024, hh = c >> 6, d = c & 63, b = row >> 11, sq = row & 2047;
            bf16* vp = vt + ((size_t)(b * 8 + hh) * 64 + d) * 2048 + sq;
#pragma unroll
            for (int i = 0; i < 8; ++i) vp[(size_t)i * 2048] = (bf16)f2bf(a.v[i]);
            return;
        }
        else if (col < 2560) dst = mlqk + (size_t)row * 1024 + (col - 1536);
        else if (col < 3072) dst = mlv + (size_t)row * 512 + (col - 2560);
        else if (col < 3584) dst = mlo + (size_t)row * 512 + (col - 3072);
        else {
            unsigned q[8];
#pragma unroll
            for (int i = 0; i < 8; ++i) { const float sg = sigmoidf_(a.v[i]) * 255.f + 0.5f; q[i] = (unsigned)fminf(fmaxf(sg, 1.f), 255.f); }
            *(v2u*)((unsigned char*)gates + (size_t)row * 2048 + (col - 3584)) = (v2u){q[0] | (q[1] << 8) | (q[2] << 16) | (q[3] << 24), q[4] | (q[5] << 8) | (q[6] << 16) | (q[7] << 24)};
            return;
        }
        *(v4u*)dst = pack8(a.v);
    }
};
struct EpiMergeA {
    bf16* merged; const bf16* gates;
    __device__ __forceinline__ void operator()(int row, int col, const F8& a) const {
        float g[8], o[8]; unpack8(*(const v4u*)(gates + (size_t)row * 2048 + col), g);
#pragma unroll
        for (int i = 0; i < 8; ++i) o[i] = sigmoidf_(g[i]) * a.v[i];
        *(v4u*)(merged + (size_t)row * 1024 + col) = pack8(o);
    }
};
struct EpiMergeB {
    bf16* merged; const bf16* gates;
    __device__ __forceinline__ void operator()(int row, int col, const F8& a) const {
        float g[8], o[8]; unpack8(*(const v4u*)(gates + (size_t)row * 2048 + 1024 + col), g);
        unpack8(*(const v4u*)(merged + (size_t)row * 1024 + col), o);
#pragma unroll
        for (int i = 0; i < 8; ++i) o[i] += sigmoidf_(g[i]) * a.v[i];
        *(v4u*)(merged + (size_t)row * 1024 + col) = pack8(o);
    }
};
struct EpiH {
    float* h; const float* x;
    __device__ __forceinline__ void operator()(int row, int col, const F8& a) const {
        const f32x4 x0 = *(const f32x4*)(x + (size_t)row * 1024 + col), x1 = *(const f32x4*)(x + (size_t)row * 1024 + col + 4);
        *(f32x4*)(h + (size_t)row * 1024 + col) = (f32x4){x0.x + a.v[0], x0.y + a.v[1], x0.z + a.v[2], x0.w + a.v[3]};
        *(f32x4*)(h + (size_t)row * 1024 + col + 4) = (f32x4){x1.x + a.v[4], x1.y + a.v[5], x1.z + a.v[6], x1.w + a.v[7]};
    }
};
struct EpiF32 {
    float* o; int ldc;
    __device__ __forceinline__ void operator()(int row, int col, const F8& a) const {
        *(f32x4*)(o + (size_t)row * ldc + col) = (f32x4){a.v[0], a.v[1], a.v[2], a.v[3]};
        *(f32x4*)(o + (size_t)row * ldc + col + 4) = (f32x4){a.v[4], a.v[5], a.v[6], a.v[7]};
    }
};

template <class E> struct EpiAdapt {
    static constexpr bool PERM = true, AFTER_DRAIN = false;
    E e;
    __device__ __forceinline__ void operator()(const pg8::f32x4 (&acc)[2][2][4][2], const pg8::Unit& u, int wr, int wc, int fr, int fq) const {
#pragma unroll
        for (int ai = 0; ai < 2; ++ai)
#pragma unroll
            for (int m = 0; m < 4; ++m) {
                const int row = u.pm * 256 + ai * 128 + wr * 64 + m * 16 + fr;
#pragma unroll
                for (int bj = 0; bj < 2; ++bj) {
                    const int col = u.pn * 256 + bj * 128 + wc * 32 + 8 * fq;
                    F8 a; const pg8::f32x4 v0 = acc[ai][bj][m][0], v1 = acc[ai][bj][m][1];
                    a.v[0] = v0[0]; a.v[1] = v0[1]; a.v[2] = v0[2]; a.v[3] = v0[3]; a.v[4] = v1[0]; a.v[5] = v1[1]; a.v[6] = v1[2]; a.v[7] = v1[3];
                    e(row, col, a);
                }
            }
    }
};

struct EpiMerge1 {
    static constexpr bool PERM = true, AFTER_DRAIN = false;
    bf16* merged; const unsigned char* gates;
    static __device__ __forceinline__ void ub8(const v2u& w, float (&f)[8]) {
        f[0] = (float)(w.x & 0xffu); f[1] = (float)((w.x >> 8) & 0xffu); f[2] = (float)((w.x >> 16) & 0xffu); f[3] = (float)(w.x >> 24);
        f[4] = (float)(w.y & 0xffu); f[5] = (float)((w.y >> 8) & 0xffu); f[6] = (float)((w.y >> 16) & 0xffu); f[7] = (float)(w.y >> 24);
    }
    __device__ __forceinline__ void mid(pg8::f32x4 (&acc)[2][2][4][2], const pg8::Unit& u, int wr, int wc, int fr, int fq) const {
#pragma unroll
        for (int ai = 0; ai < 2; ++ai)
#pragma unroll
            for (int m = 0; m < 4; ++m) {
                const int row = u.pm * 256 + ai * 128 + wr * 64 + m * 16 + fr;
#pragma unroll
                for (int bj = 0; bj < 2; ++bj) {
                    const int col = u.pn * 256 + bj * 128 + wc * 32 + 8 * fq;
                    float gs[8], gm[8]; ub8(*(const v2u*)(gates + (size_t)row * 2048 + col), gs); ub8(*(const v2u*)(gates + (size_t)row * 2048 + 1024 + col), gm);
#pragma unroll
                    for (int i = 0; i < 8; ++i) acc[ai][bj][m][i >> 2][i & 3] *= gs[i] * frcp(gm[i]);
                }
            }
    }
    __device__ __forceinline__ void operator()(const pg8::f32x4 (&acc)[2][2][4][2], const pg8::Unit& u, int wr, int wc, int fr, int fq) const {
#pragma unroll
        for (int ai = 0; ai < 2; ++ai)
#pragma unroll
            for (int m = 0; m < 4; ++m) {
                const int row = u.pm * 256 + ai * 128 + wr * 64 + m * 16 + fr;
#pragma unroll
                for (int bj = 0; bj < 2; ++bj) {
                    const int col = u.pn * 256 + bj * 128 + wc * 32 + 8 * fq;
                    float gm[8], o[8]; ub8(*(const v2u*)(gates + (size_t)row * 2048 + 1024 + col), gm);
#pragma unroll
                    for (int i = 0; i < 8; ++i) o[i] = gm[i] * (1.f / 255.f) * acc[ai][bj][m][i >> 2][i & 3];
                    *(v4u*)(merged + (size_t)row * 1024 + col) = pack8(o);
                }
            }
    }
};
struct EpiHW {
    static constexpr bool PERM = true, AFTER_DRAIN = false;
    bf16* h; const float* x; bf16* hw; const float* wffn; float* ss;
    __device__ __forceinline__ void operator()(const pg8::f32x4 (&acc)[2][2][4][2], const pg8::Unit& u, int wr, int wc, int fr, int fq) const {
#pragma unroll
        for (int ai = 0; ai < 2; ++ai)
#pragma unroll
            for (int m = 0; m < 4; ++m) {
                const int row = u.pm * 256 + ai * 128 + wr * 64 + m * 16 + fr;
                float sq = 0.f;
#pragma unroll
                for (int bj = 0; bj < 2; ++bj) {
                    const int col = u.pn * 256 + bj * 128 + wc * 32 + 8 * fq;
                    const size_t o = (size_t)row * 1024 + col;
                    const f32x4 x0 = *(const f32x4*)(x + o), x1 = *(const f32x4*)(x + o + 4);
                    const f32x4 w0 = *(const f32x4*)(wffn + col), w1 = *(const f32x4*)(wffn + col + 4);
                    const pg8::f32x4 v0 = acc[ai][bj][m][0], v1 = acc[ai][bj][m][1];
                    const f32x4 h0 = (f32x4){x0.x + v0[0], x0.y + v0[1], x0.z + v0[2], x0.w + v0[3]}, h1 = (f32x4){x1.x + v1[0], x1.y + v1[1], x1.z + v1[2], x1.w + v1[3]};
                    *(v4u*)(h + o) = (v4u){pk2(h0.x, h0.y), pk2(h0.z, h0.w), pk2(h1.x, h1.y), pk2(h1.z, h1.w)};
                    *(v4u*)(hw + o) = (v4u){pk2(h0.x * w0.x, h0.y * w0.y), pk2(h0.z * w0.z, h0.w * w0.w), pk2(h1.x * w1.x, h1.y * w1.y), pk2(h1.z * w1.z, h1.w * w1.w)};
                    sq += (h0.x * h0.x + h0.y * h0.y) + (h0.z * h0.z + h0.w * h0.w) + (h1.x * h1.x + h1.y * h1.y) + (h1.z * h1.z + h1.w * h1.w);
                }
                sq += __shfl_xor(sq, 16); sq += __shfl_xor(sq, 32);
                if (fq == 0) ss[(size_t)row * 16 + u.pn * 4 + wc] = sq;
            }
    }
};

template <class E>
__device__ __forceinline__ void simple_gemm(LAS unsigned char* lds, const bf16* A, const bf16* Bt, int M, int N, int K, const E& e) {
    LAS float* As = (LAS float*)lds;
    LAS float* Bs = As + 32 * 132;
    const int tid = threadIdx.x, ty = tid >> 4, tx = tid & 15;
    const int ntn = N / 128, ntiles = (M / 128) * ntn;
    for (int tile = blockIdx.x; tile < ntiles; tile += gridDim.x) {
        const int tm = tile / ntn, tn = tile % ntn;
        float acc[4][8];
#pragma unroll
        for (int i = 0; i < 4; ++i)
#pragma unroll
            for (int j = 0; j < 8; ++j) acc[i][j] = 0.f;
        for (int k0 = 0; k0 < K; k0 += 32) {
            {
                const int r = tid >> 2, kq = (tid & 3) * 8;
                float fa[8], fb[8];
                unpack8(*(const v4u*)(A + (size_t)(tm * 128 + r) * K + k0 + kq), fa);
                unpack8(*(const v4u*)(Bt + (size_t)(tn * 128 + r) * K + k0 + kq), fb);
#pragma unroll
                for (int i = 0; i < 8; ++i) { As[(kq + i) * 132 + r] = fa[i]; Bs[(kq + i) * 132 + r] = fb[i]; }
            }
            __syncthreads();
#pragma unroll 8
            for (int k = 0; k < 32; ++k) {
                const f32x4 a4 = *(const LAS f32x4*)(As + k * 132 + ty * 4);
                const f32x4 b0 = *(const LAS f32x4*)(Bs + k * 132 + tx * 8), b1 = *(const LAS f32x4*)(Bs + k * 132 + tx * 8 + 4);
                const float av[4] = {a4.x, a4.y, a4.z, a4.w};
                const float bv[8] = {b0.x, b0.y, b0.z, b0.w, b1.x, b1.y, b1.z, b1.w};
#pragma unroll
                for (int i = 0; i < 4; ++i)
#pragma unroll
                    for (int j = 0; j < 8; ++j) acc[i][j] += av[i] * bv[j];
            }
            __syncthreads();
        }
#pragma unroll
        for (int i = 0; i < 4; ++i) {
            F8 a;
#pragma unroll
            for (int j = 0; j < 8; ++j) a.v[j] = acc[i][j];
            e(tm * 128 + ty * 4 + i, tn * 128 + tx * 8, a);
        }
    }
}

template <class E>
__device__ __forceinline__ void gemm(LAS unsigned char* lds, const bf16* A, const bf16* Bt, int M, int N, int K, const E& e) {
#if USE_PG8
    pg8::Gemm g{A, Bt, M, N, K}; pg8::StaticOrder S; S.init(M, N, (int)gridDim.x, (int)blockIdx.x);
    EpiAdapt<E> ea{e};
    pg8::gemm_phase<EpiAdapt<E>, pg8::StaticOrder, true, true>(lds, g, S, ea);
#else
    simple_gemm<E>(lds, A, Bt, M, N, K, e);
#endif
}

__device__ __forceinline__ void transpose_item(const float* W, int ldw, int K, bf16* WT, int src_col0, int dst_row0, LAS float* scr, int kb, int lane) {
    const int k0 = 64 * kb;
#pragma unroll 8
    for (int i = 0; i < 32; ++i) { const int kk = 2 * i + (lane >> 5); scr[kk * 33 + (lane & 31)] = W[(size_t)(k0 + kk) * ldw + src_col0 + (lane & 31)]; }
    LDS_WAIT(); asm volatile("" ::: "memory");
    const int c = lane & 7;
#pragma unroll
    for (int j = 0; j < 4; ++j) { const int n = (lane >> 3) + 8 * j; const LAS float* s = scr + (8 * c) * 33 + n;
        v4u o; o.x = pk2(s[0 * 33], s[1 * 33]); o.y = pk2(s[2 * 33], s[3 * 33]); o.z = pk2(s[4 * 33], s[5 * 33]); o.w = pk2(s[6 * 33], s[7 * 33]);
        *(v4u*)(WT + (size_t)(dst_row0 + n) * K + k0 + 8 * c) = o; }
    LDS_WAIT(); asm volatile("" ::: "memory");
}

struct P {
    const float *x, *norm_mix_w, *w_in, *conv_w, *conv_b, *b_i, *b_f, *ml_norm_w, *w_sb, *w_ml, *w_out, *norm_ffn_w, *w_query, *keys1, *keys2, *peer_u, *peer_v, *norm_final_w;
    float* out; unsigned char* ws;
};

__device__ __forceinline__ void p0_prologue(const P& p, LAS unsigned char* lds, int wave, int lane) {
    LAS float* scr = (LAS float*)(lds + wave * 8448);
    const int gw = blockIdx.x * NWAVES + wave, NGW = gridDim.x * NWAVES;
    bf16* W1T = (bf16*)(p.ws + WS_W1T); bf16* WSBT = (bf16*)(p.ws + WS_WSBT); bf16* WMLT = (bf16*)(p.ws + WS_WMLT); bf16* WOUTT = (bf16*)(p.ws + WS_WOUTT); bf16* WCT = (bf16*)(p.ws + WS_WCT);
    constexpr int I_1 = 16 * 176, I_SB = 8 * 32, I_ML = 8 * 32, I_O = 16 * 32, NT = I_1 + I_SB + I_ML + I_O;
    for (int it = gw; it < NT; it += NGW) {
        int r = it;
        if (r < I_1) { const int kb = r / 176, nb = r % 176, n0 = nb * 32; transpose_item(p.w_in, INC, 1024, W1T, n0 < 3584 ? n0 : n0 + 8, n0, scr, kb, lane); continue; } r -= I_1;
        if (r < I_SB) { const int kb = r / 32, nb = r % 32; transpose_item(p.w_sb, 1024, 1024, WSBT, nb * 32, nb * 32, scr, kb, lane);             continue; } r -= I_SB;
        if (r < I_ML) { const int kb = r / 32, nb = r % 32; transpose_item(p.w_ml, 1024, 1024, WSBT + 512, nb * 32, nb * 32, scr, kb, lane); continue; } r -= I_ML;
        { const int kb = r / 32, nb = r % 32; transpose_item(p.w_out, 1024, 1024, WOUTT, nb * 32, nb * 32, scr, kb, lane); }
    }
    bf16* XN = (bf16*)(p.ws + WS_XN); float* IFG = (float*)(p.ws + WS_IFG);
    LAS float* WG = (LAS float*)(lds + 8 * 8448);
    __syncthreads();
    for (int i = threadIdx.x; i < 2048; i += NTHR) { const int k = i >> 1, hf = i & 1; *(LAS f32x4*)(WG + k * 8 + hf * 4) = *(const f32x4*)(p.w_in + (size_t)k * INC + 3584 + hf * 4); }
    __syncthreads();
    for (int m0 = gw * 2; m0 < T_; m0 += NGW * 2) {
        const f32x4* wr = (const f32x4*)p.norm_mix_w + lane;
        f32x4 v[2][4]; float ss[2] = {0.f, 0.f};
#pragma unroll
        for (int u = 0; u < 2; ++u) { const f32x4* xr = (const f32x4*)(p.x + (size_t)(m0 + u) * 1024) + lane;
#pragma unroll
            for (int j = 0; j < 4; ++j) v[u][j] = xr[64 * j]; }
#pragma unroll
        for (int u = 0; u < 2; ++u)
#pragma unroll
            for (int j = 0; j < 4; ++j) ss[u] += (v[u][j].x * v[u][j].x + v[u][j].y * v[u][j].y) + (v[u][j].z * v[u][j].z + v[u][j].w * v[u][j].w);
#pragma unroll
        for (int o = 1; o < 64; o <<= 1) { ss[0] += __shfl_xor(ss[0], o); ss[1] += __shfl_xor(ss[1], o); }
#pragma unroll
        for (int u = 0; u < 2; ++u) {
            const int m = m0 + u;
            const float rstd = frsq(ss[u] * (1.f / 1024.f) + EPS);
            float g[8];
#pragma unroll
            for (int i = 0; i < 8; ++i) g[i] = 0.f;
            v2u* o8 = (v2u*)(XN + (size_t)m * 1024) + lane;
#pragma unroll
            for (int j = 0; j < 4; ++j) {
                const f32x4 w = wr[64 * j];
                const float y[4] = {v[u][j].x * rstd * w.x, v[u][j].y * rstd * w.y, v[u][j].z * rstd * w.z, v[u][j].w * rstd * w.w};
                o8[64 * j] = (v2u){pk2(y[0], y[1]), pk2(y[2], y[3])};
#pragma unroll
                for (int q = 0; q < 4; ++q) {
                    const int k = 256 * j + 4 * lane + q;
                    const f32x4 w0 = *(const LAS f32x4*)(WG + k * 8), w1 = *(const LAS f32x4*)(WG + k * 8 + 4);
                    g[0] += y[q] * w0.x; g[1] += y[q] * w0.y; g[2] += y[q] * w0.z; g[3] += y[q] * w0.w;
                    g[4] += y[q] * w1.x; g[5] += y[q] * w1.y; g[6] += y[q] * w1.z; g[7] += y[q] * w1.w;
                }
            }
            {
                const bool b5 = (lane & 32) != 0, b4 = (lane & 16) != 0, b3 = (lane & 8) != 0;
                float e4[4], f2[2], gs;
#pragma unroll
                for (int i = 0; i < 4; ++i) { const float keep = b5 ? g[2 * i + 1] : g[2 * i], send = b5 ? g[2 * i] : g[2 * i + 1]; e4[i] = keep + __shfl_xor(send, 32); }
#pragma unroll
                for (int i = 0; i < 2; ++i) { const float keep = b4 ? e4[2 * i + 1] : e4[2 * i], send = b4 ? e4[2 * i] : e4[2 * i + 1]; f2[i] = keep + __shfl_xor(send, 16); }
                { const float keep = b3 ? f2[1] : f2[0], send = b3 ? f2[0] : f2[1]; gs = keep + __shfl_xor(send, 8); }
                gs += __shfl_xor(gs, 4); gs += __shfl_xor(gs, 2); gs += __shfl_xor(gs, 1);
                const int gi = 4 * (b3 ? 1 : 0) + 2 * (b4 ? 1 : 0) + (b5 ? 1 : 0);
                if ((lane & 7) == 0) IFG[(size_t)m * 8 + gi] = gs + (gi < 4 ? p.b_i[gi] : p.b_f[gi - 4]);
            }
        }
    }
}

__device__ __forceinline__ void fill_wc(const P& p, int it, int lane) {
    bf16* WCT = (bf16*)(p.ws + WS_WCT);
    const int hhf = it >> 6, kb = (it >> 2) & 15, kq = it & 3, head = hhf >> 1, half = hhf & 1, k = kb * 64 + lane;
    const f32x4* wq = (const f32x4*)(p.w_query + (size_t)k * 2048 + head * 256 + half * 128);
    f32x4 wr[32];
#pragma unroll
    for (int i = 0; i < 32; ++i) wr[i] = wq[i];
    const float* kbase = (half ? p.keys2 : p.keys1) + ((size_t)head * 128 + kq * 32) * 128;
#pragma unroll 1
    for (int key = 0; key < 32; ++key) {
        const f32x4* kr = (const f32x4*)(kbase + (size_t)key * 128);
        float a0 = 0.f, a1 = 0.f;
#pragma unroll
        for (int i = 0; i < 32; i += 2) { const f32x4 b0 = kr[i], b1 = kr[i + 1];
            a0 += wr[i].x * b0.x + wr[i].y * b0.y + wr[i].z * b0.z + wr[i].w * b0.w;
            a1 += wr[i + 1].x * b1.x + wr[i + 1].y * b1.y + wr[i + 1].z * b1.z + wr[i + 1].w * b1.w; }
        WCT[(size_t)(hhf * 128 + kq * 32 + key) * 1024 + k] = (bf16)f2bf(a0 + a1);
    }
}
__device__ __forceinline__ void fill_tables(const P& p, int e, int lane) {
    unsigned char* U8 = p.ws + WS_U8; unsigned char* V8 = p.ws + WS_V8; float* USC = (float*)(p.ws + WS_USC); float* VSC = (float*)(p.ws + WS_VSC);
    f32x4 v[2][4]; float am[2] = {0.f, 0.f};
#pragma unroll
    for (int which = 0; which < 2; ++which) {
        const float* src = (which ? p.peer_v : p.peer_u) + (size_t)e * 1024 + 16 * lane;
#pragma unroll
        for (int j = 0; j < 4; ++j) v[which][j] = *(const f32x4*)(src + 4 * j);
    }
#pragma unroll
    for (int which = 0; which < 2; ++which)
#pragma unroll
        for (int j = 0; j < 4; ++j) am[which] = fmaxf(am[which], fmaxf(fmaxf(fabsf(v[which][j].x), fabsf(v[which][j].y)), fmaxf(fabsf(v[which][j].z), fabsf(v[which][j].w))));
#pragma unroll
    for (int o = 1; o < 64; o <<= 1) { am[0] = fmaxf(am[0], __shfl_xor(am[0], o)); am[1] = fmaxf(am[1], __shfl_xor(am[1], o)); }
#pragma unroll
    for (int which = 0; which < 2; ++which) {
        const float sc = am[which] > 0.f ? exp2f(floorf(log2f(448.f / am[which]))) : 1.f;
        unsigned w[4];
#pragma unroll
        for (int j = 0; j < 4; ++j) { int t = __builtin_amdgcn_cvt_pk_fp8_f32(v[which][j].x * sc, v[which][j].y * sc, 0, false); t = __builtin_amdgcn_cvt_pk_fp8_f32(v[which][j].z * sc, v[which][j].w * sc, t, true); w[j] = (unsigned)t; }
        *(v4u*)((which ? V8 : U8) + ((size_t)(lane >> 3) * NEXP + e) * 128 + 16 * (lane & 7)) = (v4u){w[0], w[1], w[2], w[3]};
        if (lane == 0) (which ? VSC : USC)[e] = 1.f / sc;
    }
}
constexpr int N_FILL = 128 + 1024;
__device__ __forceinline__ void fill_item(const P& p, int item, int wave, int lane) {
    if (item < 128) fill_wc(p, item * 8 + wave, lane);
    else { const int e0 = (item - 128) * 16 + wave * 2; fill_tables(p, e0, lane); fill_tables(p, e0 + 1, lane); }
}

typedef short bf16x8 __attribute__((ext_vector_type(8)));
typedef float f32x16 __attribute__((ext_vector_type(16)));
#define MFMA32(a, b, c) __builtin_amdgcn_mfma_f32_32x32x16_bf16((a), (b), (c), 0, 0, 0)
__device__ __forceinline__ int crow(int reg, int hh) { return (reg & 3) + 8 * (reg >> 2) + 4 * hh; }
template <int S> __device__ __forceinline__ bf16x8 pack_step(const f32x16& x) {
    v4u p; p.x = cvtpk(x[8 * S], x[8 * S + 1]); p.y = cvtpk(x[8 * S + 2], x[8 * S + 3]); p.z = cvtpk(x[8 * S + 4], x[8 * S + 5]); p.w = cvtpk(x[8 * S + 6], x[8 * S + 7]);
    return __builtin_bit_cast(bf16x8, p);
}
__device__ __forceinline__ bf16x8 frag2(const v2u& lo, const v2u& hi) { v4u p; p.x = lo.x; p.y = lo.y; p.z = hi.x; p.w = hi.y; return __builtin_bit_cast(bf16x8, p); }
__device__ __forceinline__ f32x16 zero16() { f32x16 z; for (int i = 0; i < 16; ++i) z[i] = 0.f; return z; }


__device__ __forceinline__ void p2_conv(const P& p, int tid) {
    const bf16* MLQK = (const bf16*)(p.ws + WS_MLQK); bf16* QC = (bf16*)(p.ws + WS_QC); bf16* KC = (bf16*)(p.ws + WS_KC);
    const int cg = tid & 127, ch0 = 8 * cg;
    float cw[4][8], cb[8];
#pragma unroll
    for (int i = 0; i < 8; ++i) { cb[i] = p.conv_b[ch0 + i];
#pragma unroll
        for (int j = 0; j < 4; ++j) cw[j][i] = p.conv_w[j * 1024 + ch0 + i]; }
    const float osc = cg >= 64 ? 0.08838834764831845f : 1.f;
    bf16* dst = (cg >= 64 ? KC : QC) + (cg & 63) * 8;
    for (int rg = blockIdx.x * 4 + (tid >> 7); rg < T_ / 4; rg += gridDim.x * 4) {
        const int tok = rg * 4, pos0 = tok & (S_ - 1);
        v4u xr[7];
#pragma unroll
        for (int k = 0; k < 7; ++k) xr[k] = (pos0 + k - 3 >= 0) ? *(const v4u*)(MLQK + (size_t)(tok + k - 3) * 1024 + ch0) : (v4u){0u, 0u, 0u, 0u};
#pragma unroll
        for (int tt = 0; tt < 4; ++tt) {
            float y[8];
#pragma unroll
            for (int i = 0; i < 8; ++i) y[i] = cb[i];
#pragma unroll
            for (int j = 0; j < 4; ++j) { float f[8]; unpack8(xr[tt + j], f);
#pragma unroll
                for (int i = 0; i < 8; ++i) y[i] += cw[j][i] * f[i]; }
#pragma unroll
            for (int i = 0; i < 8; ++i) y[i] = y[i] * sigmoidf_(y[i]) * osc;
            *(v4u*)(dst + (size_t)(tok + tt) * 512) = pack8(y);
        }
    }
}

constexpr int ML_QS = 0, ML_KS = 17408, ML_KWT = 34816, ML_VTL = 53248, ML_PS = 71680, ML_CT = 80896, ML_SCAL = 115712, ML_SSP = 118272, ML_QN = ML_SSP + 512, ML_F1 = ML_QN + 256, ML_F2 = ML_F1 + 256, ML_NV = ML_F2 + 256;
static_assert(ML_NV + 512 <= RING_BYTES, "mLSTM LDS map");
__device__ __forceinline__ void mlstm_scal(float ip, float fp, LAS float* sc, float& m_carry, int lane) {
    const float lf = fminf(fp, 0.f) - flog(1.f + fexp(-fabsf(fp)));
    float bc = lf;
#pragma unroll
    for (int o = 1; o < 64; o <<= 1) { const float t2 = __shfl_up(bc, o); if (lane >= o) bc += t2; }
    const float a = ip - bc; float pm = a;
#pragma unroll
    for (int o = 1; o < 64; o <<= 1) { const float t2 = __shfl_up(pm, o); if (lane >= o) pm = fmaxf(pm, t2); }
    const float M = fmaxf(m_carry, pm);
    const float M63 = __shfl(M, 63), bc63 = __shfl(bc, 63);
    sc[lane] = a; sc[64 + lane] = M; sc[128 + lane] = fexp(a - M63); sc[192 + lane] = fexp(m_carry - M); sc[256 + lane] = fexp(-(bc + M));
    m_carry = bc63 + M63;
}
__device__ __forceinline__ void mlstm_item(const P& p, LAS unsigned char* lds, int item, int tid, int wave, int lane) {
    const int b = item >> 2, h = item & 3;
    const int r = lane & 31, hh = lane >> 5, et = wave & 3, th = wave >> 2;
    const bf16* QC = (const bf16*)(p.ws + WS_QC); const bf16* KC = (const bf16*)(p.ws + WS_KC); const bf16* MLV = (const bf16*)(p.ws + WS_MLV); const float* IFG = (const float*)(p.ws + WS_IFG);
    bf16* HML = (bf16*)p.out + 512;
    LAS float* SCAL = (LAS float*)(lds + ML_SCAL); LAS float* SSP = (LAS float*)(lds + ML_SSP); LAS float* QN = (LAS float*)(lds + ML_QN);
    LAS float* F1 = (LAS float*)(lds + ML_F1); LAS float* F2 = (LAS float*)(lds + ML_F2); LAS float* NV = (LAS float*)(lds + ML_NV);
    const int cg = tid & 15, trow = tid >> 4, eg = cg, sl = trow;
    const size_t hq = (size_t)h * 128 + 8 * cg;
    for (int i = tid; i < (128 * 136 * 2) / 4; i += NTHR) ((LAS unsigned*)(lds + ML_CT))[i] = 0u;
    if (tid < 128) NV[tid] = 0.f;
    f32x16 accC[2]; accC[0] = zero16(); accC[1] = zero16();
    float m_carry = 0.f;
    if (wave == 3) { const size_t tk = (size_t)b * S_ + lane; mlstm_scal(IFG[tk * 8 + h], IFG[tk * 8 + 4 + h], SCAL, m_carry, lane); }
    v4u pq[2], pk[2], pv[2];
    {
        const size_t t0 = (size_t)b * S_;
#pragma unroll
        for (int u = 0; u < 2; ++u) { pq[u] = *(const v4u*)(QC + (t0 + trow + 32 * u) * 512 + hq); pk[u] = *(const v4u*)(KC + (t0 + trow + 32 * u) * 512 + hq); pv[u] = *(const v4u*)(MLV + (t0 + sl + 32 * u) * 512 + hq); }
    }
    float ipn = 0.f, fpn = 0.f;
    __syncthreads();
    for (int c = 0; c < 32; ++c) {
        const size_t tok0 = (size_t)b * S_ + c * 64;
        LAS float* sc = SCAL + (c & 1) * 320;
        {
#pragma unroll
            for (int u = 0; u < 2; ++u) {
                const int t = trow + 32 * u;
                *(LAS v4u*)(lds + ML_QS + t * 272 + cg * 16) = pq[u];
                *(LAS v4u*)(lds + ML_KS + t * 272 + cg * 16) = pk[u];
                float f[8]; unpack8(pk[u], f);
                const float wk = sc[128 + t];
#pragma unroll
                for (int i = 0; i < 8; ++i) *(LAS bf16*)(lds + ML_KWT + (8 * cg + i) * 144 + ((t ^ (8 * (cg & 7))) * 2)) = (bf16)f2bf(f[i] * wk);
                const unsigned vv[4] = {pv[u].x, pv[u].y, pv[u].z, pv[u].w};
#pragma unroll
                for (int i = 0; i < 4; ++i) {
                    *(LAS bf16*)(lds + ML_VTL + (8 * eg + 2 * i) * 144 + ((t ^ (8 * (eg & 7))) * 2)) = (bf16)(vv[i] & 0xffffu);
                    *(LAS bf16*)(lds + ML_VTL + (8 * eg + 2 * i + 1) * 144 + ((t ^ (8 * (eg & 7))) * 2)) = (bf16)(vv[i] >> 16);
                }
            }
            if (c + 1 < 32) {
                const size_t t1 = tok0 + 64;
#pragma unroll
                for (int u = 0; u < 2; ++u) { pq[u] = *(const v4u*)(QC + (t1 + trow + 32 * u) * 512 + hq); pk[u] = *(const v4u*)(KC + (t1 + trow + 32 * u) * 512 + hq); pv[u] = *(const v4u*)(MLV + (t1 + sl + 32 * u) * 512 + hq); }
                if (wave == 3) { ipn = IFG[(t1 + lane) * 8 + h]; fpn = IFG[(t1 + lane) * 8 + 4 + h]; }
            }
        }
        __syncthreads();
        f32x16 acc_inter = zero16();
        if (wave < 3) {
            const int tt = wave > 0 ? 1 : 0, st = wave == 2 ? 1 : 0;
            f32x16 zt = zero16();
#pragma unroll
            for (int ks = 0; ks < 8; ++ks) {
                const bf16x8 ka = *(const LAS bf16x8*)(lds + ML_KS + (32 * st + r) * 272 + 32 * ks + 16 * hh);
                const bf16x8 qb = *(const LAS bf16x8*)(lds + ML_QS + (32 * tt + r) * 272 + 32 * ks + 16 * hh);
                zt = MFMA32(ka, qb, zt);
            }
            const int t = 32 * tt + r; const float Mt = sc[64 + t];
            float ps = 0.f;
#pragma unroll
            for (int g = 0; g < 4; ++g) {
                const f32x4 av = *(const LAS f32x4*)(sc + 32 * st + 8 * g + 4 * hh);
                float pv[4];
#pragma unroll
                for (int q = 0; q < 4; ++q) { const int sidx = 32 * st + 8 * g + 4 * hh + q;
                    const float wgt = sidx <= t ? fexp(av[q] - Mt) : 0.f; pv[q] = zt[4 * g + q] * wgt; ps += pv[q]; }
                *(LAS v2u*)(lds + ML_PS + t * 144 + (32 * st + 8 * g + 4 * hh) * 2) = (v2u){cvtpk(pv[0], pv[1]), cvtpk(pv[2], pv[3])};
            }
            ps += __shfl_xor(ps, 32);
            if (hh == 0) { SSP[st * 64 + t] = ps; if (wave == 0) SSP[64 + t] = 0.f; }
        }
        if (wave == 3 && c + 1 < 32) mlstm_scal(ipn, fpn, SCAL + ((c + 1) & 1) * 320, m_carry, lane);
#pragma unroll
        for (int ks = 0; ks < 8; ++ks) {
            const bf16x8 qa = *(const LAS bf16x8*)(lds + ML_QS + (32 * th + r) * 272 + 32 * ks + 16 * hh);
            const bf16x8 cbf = *(const LAS bf16x8*)(lds + ML_CT + (32 * et + r) * 272 + 32 * ks + 16 * hh);
            acc_inter = MFMA32(qa, cbf, acc_inter);
        }
        {
            const int t = tid >> 3, part = tid & 7;
            float f[8], sum = 0.f;
            { const v4u tq = *(const LAS v4u*)(lds + ML_QS + t * 272 + part * 32); unpack8(tq, f); }
#pragma unroll
            for (int i = 0; i < 8; ++i) sum += f[i] * NV[16 * part + i];
            { const v4u tq = *(const LAS v4u*)(lds + ML_QS + t * 272 + part * 32 + 16); unpack8(tq, f); }
#pragma unroll
            for (int i = 0; i < 8; ++i) sum += f[i] * NV[16 * part + 8 + i];
            sum += __shfl_xor(sum, 1); sum += __shfl_xor(sum, 2); sum += __shfl_xor(sum, 4);
            if (part == 0) QN[t] = sum;
        }
        __syncthreads();
        f32x16 acc_intra = zero16();
#pragma unroll
        for (int ks = 0; ks < 4; ++ks) {
            if (ks < 2 || th == 1) {
                const bf16x8 pa = *(const LAS bf16x8*)(lds + ML_PS + (32 * th + r) * 144 + 32 * ks + 16 * hh);
                const bf16x8 vb = *(const LAS bf16x8*)(lds + ML_VTL + (32 * et + r) * 144 + 16 * ((2 * ks + hh) ^ (((32 * et + r) >> 3) & 7)));
                acc_intra = MFMA32(pa, vb, acc_intra);
            }
        }
        if (tid < 64) {
            const float wi = sc[192 + tid];
            const float den = SSP[tid] + SSP[64 + tid] + wi * QN[tid];
            const float f1 = frcp(fmaxf(fabsf(den), sc[256 + tid]));
            F1[tid] = f1; F2[tid] = wi * f1;
        }
        const float decay = sc[192 + 63];
#pragma unroll
        for (int dt = 0; dt < 2; ++dt) {
#pragma unroll
            for (int i = 0; i < 16; ++i) accC[dt][i] *= decay;
#pragma unroll
            for (int ks = 0; ks < 4; ++ks) {
                const bf16x8 ka = *(const LAS bf16x8*)(lds + ML_KWT + (64 * th + 32 * dt + r) * 144 + 16 * ((2 * ks + hh) ^ (((64 * th + 32 * dt + r) >> 3) & 7)));
                const bf16x8 vb = *(const LAS bf16x8*)(lds + ML_VTL + (32 * et + r) * 144 + 16 * ((2 * ks + hh) ^ (((32 * et + r) >> 3) & 7)));
                accC[dt] = MFMA32(ka, vb, accC[dt]);
            }
        }
        {
            const int d = tid >> 2, part = tid & 3;
            float f[8], sum = 0.f;
            { const v4u tq = *(const LAS v4u*)(lds + ML_KWT + d * 144 + part * 32); unpack8(tq, f); }
#pragma unroll
            for (int i = 0; i < 8; ++i) sum += f[i];
            { const v4u tq = *(const LAS v4u*)(lds + ML_KWT + d * 144 + part * 32 + 16); unpack8(tq, f); }
#pragma unroll
            for (int i = 0; i < 8; ++i) sum += f[i];
            sum += __shfl_xor(sum, 1); sum += __shfl_xor(sum, 2);
            if (part == 0) NV[d] = decay * NV[d] + sum;
        }
        __syncthreads();
        {
            bf16* hp = HML + (tok0 + 32 * th) * 1024 + h * 128 + 32 * et + r;
#pragma unroll
            for (int g = 0; g < 4; ++g) {
                const f32x4 f1v = *(const LAS f32x4*)(F1 + 32 * th + 8 * g + 4 * hh), f2v = *(const LAS f32x4*)(F2 + 32 * th + 8 * g + 4 * hh);
#pragma unroll
                for (int q = 0; q < 4; ++q) { const int tl = 8 * g + 4 * hh + q;
                    hp[(size_t)tl * 1024] = (bf16)f2bf(acc_intra[4 * g + q] * f1v[q] + acc_inter[4 * g + q] * f2v[q]); }
            }
#pragma unroll
            for (int dt = 0; dt < 2; ++dt)
#pragma unroll
                for (int g = 0; g < 4; ++g)
                    *(LAS v2u*)(lds + ML_CT + (32 * et + r) * 272 + (64 * th + 32 * dt + 8 * g + 4 * hh) * 2) = (v2u){cvtpk(accC[dt][4 * g], accC[dt][4 * g + 1]), cvtpk(accC[dt][4 * g + 2], accC[dt][4 * g + 3])};
        }
    }
    __syncthreads();
}

constexpr int SBW_KS = 144, SBW_VS = 80, SBW_VOFF = 32 * SBW_KS, SBW_BYTES = SBW_VOFF + 64 * SBW_VS;
static_assert(8 * SBW_BYTES <= RING_BYTES, "SBA per-wave LDS slices");
__device__ __forceinline__ void sba_wave_item(const bf16* __restrict__ QK, const bf16* __restrict__ VT, bf16* __restrict__ YSB, LAS unsigned char* wl, int b, int h, int qt, int lane) {
    const int r = lane & 31, hh = lane >> 5, t0 = qt * 32;
    const size_t rowbase = (size_t)b * S_;
    bf16x8 qf[4];
    {
        const bf16* qp = QK + (rowbase + t0 + r) * 1024 + h * 64 + 8 * hh;
#pragma unroll
        for (int ks = 0; ks < 4; ++ks) qf[ks] = *(const bf16x8*)(qp + 16 * ks);
    }
    bf16x8 tri[2];
#pragma unroll
    for (int s2 = 0; s2 < 2; ++s2)
#pragma unroll
        for (int j = 0; j < 8; ++j) { const int rho = 16 * s2 + 8 * (j >> 2) + 4 * hh + (j & 3); tri[s2][j] = (rho > r) ? (short)0x3F80 : (short)0; }
    f32x16 o0 = zero16(), o1 = zero16();
    float carry = 0.f;
    const bf16* kg = QK + (rowbase + (lane >> 3)) * 1024 + 512 + h * 64 + 8 * (lane & 7);
    const bf16* vg = VT + ((size_t)(b * 8 + h) * 64 + (lane >> 2)) * 2048 + 8 * (lane & 3);
    LAS unsigned char* kw = wl + (lane >> 3) * SBW_KS + 16 * (lane & 7);
    LAS unsigned char* vw = wl + SBW_VOFF + (lane >> 2) * SBW_VS + 16 * (lane & 3);
    const LAS unsigned char* kr = wl + r * SBW_KS + 16 * hh;
    const LAS unsigned char* vr = wl + SBW_VOFF + r * SBW_VS + 8 * hh;
    v4u kt[4], vt[4];
#pragma unroll
    for (int i = 0; i < 4; ++i) { kt[i] = *(const v4u*)(kg + (size_t)(t0 + 8 * i) * 1024); vt[i] = *(const v4u*)(vg + (size_t)(16 * i) * 2048 + t0); }
    for (int s0 = t0; s0 >= 0; s0 -= 32) {
#pragma unroll
        for (int i = 0; i < 4; ++i) { *(LAS v4u*)(kw + 8 * i * SBW_KS) = kt[i]; *(LAS v4u*)(vw + 16 * i * SBW_VS) = vt[i]; }
        const int sn = s0 >= 32 ? s0 - 32 : 0;
#pragma unroll
        for (int i = 0; i < 4; ++i) { kt[i] = *(const v4u*)(kg + (size_t)(sn + 8 * i) * 1024); vt[i] = *(const v4u*)(vg + (size_t)(16 * i) * 2048 + sn); }
        bf16x8 kf[4]; v2u vl[2][2], vh[2][2];
#pragma unroll
        for (int ks = 0; ks < 4; ++ks) kf[ks] = *(const LAS bf16x8*)(kr + 32 * ks);
#pragma unroll
        for (int dt = 0; dt < 2; ++dt)
#pragma unroll
            for (int s2 = 0; s2 < 2; ++s2) { const LAS unsigned char* vp = vr + dt * 32 * SBW_VS + 32 * s2; vl[dt][s2] = *(const LAS v2u*)vp; vh[dt][s2] = *(const LAS v2u*)(vp + 16); }
        f32x16 z = zero16();
#pragma unroll
        for (int ks = 0; ks < 4; ++ks) z = MFMA32(kf[ks], qf[ks], z);
        const bool diag = (s0 == t0);
        f32x16 sp; float rs = 0.f;
#pragma unroll
        for (int i = 0; i < 16; ++i) {
            const float zz = z[i] * 0.125f;
            const bool valid = !diag || (crow(i, hh) < r);
            float spv = fmaxf(zz, 0.f) + flog(1.f + fexp(-fabsf(zz)));
            spv = valid ? spv : 0.f;
            sp[i] = spv; rs += spv; z[i] = zz - spv;
        }
        f32x16 suf = zero16();
        suf = MFMA32(tri[0], pack_step<0>(sp), suf);
        suf = MFMA32(tri[1], pack_step<1>(sp), suf);
        f32x16 w;
#pragma unroll
        for (int i = 0; i < 16; ++i) {
            const bool valid = !diag || (crow(i, hh) < r);
            const float lw = z[i] - suf[i] - carry;
            w[i] = valid ? fexp(lw) : 0.f;
        }
        rs += __shfl_xor(rs, 32);
        carry += rs;
        const bf16x8 pa0 = pack_step<0>(w), pa1 = pack_step<1>(w);
        o0 = MFMA32(pa0, frag2(vl[0][0], vh[0][0]), o0); o0 = MFMA32(pa1, frag2(vl[0][1], vh[0][1]), o0);
        o1 = MFMA32(pa0, frag2(vl[1][0], vh[1][0]), o1); o1 = MFMA32(pa1, frag2(vl[1][1], vh[1][1]), o1);
        if (__all(carry > 104.f)) break;
    }
    bf16* op = YSB + (rowbase + t0) * 1024 + h * 64 + r;
#pragma unroll
    for (int i = 0; i < 16; ++i) { const int t = crow(i, hh); op[(size_t)t * 1024] = (bf16)f2bf(o0[i]); op[(size_t)t * 1024 + 32] = (bf16)f2bf(o1[i]); }
}
__device__ __forceinline__ void sba_item(const P& p, LAS unsigned char* lds, int item, int wave, int lane) {
    const int bh = item >> 3, qb = item & 7, b = bh >> 3, h = bh & 7;
    sba_wave_item((const bf16*)(p.ws + WS_SBQKV), (const bf16*)(p.ws + WS_VT), (bf16*)p.out, lds + wave * SBW_BYTES, b, h, qb * 8 + wave, lane);
}

__device__ __forceinline__ void p3_yml(const P& p, int wave, int lane) {
    const int gw = blockIdx.x * NWAVES + wave, NGW = gridDim.x * NWAVES;
    bf16* YML = (bf16*)p.out + 512; const bf16* MLO = (const bf16*)(p.ws + WS_MLO);
    for (int m = gw; m < T_; m += NGW) {
        float hv[8], ov[8], o[8];
        unpack8(*(const v4u*)(YML + (size_t)m * 1024 + lane * 8), hv); unpack8(*(const v4u*)(MLO + (size_t)m * 512 + lane * 8), ov);
        float ss = 0.f;
#pragma unroll
        for (int i = 0; i < 8; ++i) ss += hv[i] * hv[i];
        ss += __shfl_xor(ss, 1); ss += __shfl_xor(ss, 2); ss += __shfl_xor(ss, 4); ss += __shfl_xor(ss, 8);
        const float rstd = frsq(ss * (1.f / 128.f) + EPS);
        const f32x4 w0 = *(const f32x4*)(p.ml_norm_w + lane * 8), w1 = *(const f32x4*)(p.ml_norm_w + lane * 8 + 4);
        const float wv[8] = {w0.x, w0.y, w0.z, w0.w, w1.x, w1.y, w1.z, w1.w};
#pragma unroll
        for (int i = 0; i < 8; ++i) o[i] = sigmoidf_(ov[i]) * hv[i] * rstd * wv[i];
        *(v4u*)(YML + (size_t)m * 1024 + lane * 8) = pack8(o);
    }
}

__device__ __forceinline__ void p6_hn(const P& p, int wave, int lane) {
    const int gw = blockIdx.x * NWAVES + wave, NGW = gridDim.x * NWAVES;
    const float* H = (const float*)(p.ws + WS_H); bf16* HN = (bf16*)(p.ws + WS_HN);
    for (int m = gw; m < T_; m += NGW) {
        const f32x4* xr = (const f32x4*)(H + (size_t)m * 1024) + lane; const f32x4* wr = (const f32x4*)p.norm_ffn_w + lane;
        f32x4 v[4]; float ss = 0.f;
#pragma unroll
        for (int j = 0; j < 4; ++j) { v[j] = xr[64 * j]; ss += (v[j].x * v[j].x + v[j].y * v[j].y) + (v[j].z * v[j].z + v[j].w * v[j].w); }
        const float rstd = frsq(wave_sum(ss) * (1.f / 1024.f) + EPS);
        v2u* o8 = (v2u*)(HN + (size_t)m * 1024) + lane;
#pragma unroll
        for (int j = 0; j < 4; ++j) { const f32x4 w = wr[64 * j]; o8[64 * j] = (v2u){pk2(v[j].x * rstd * w.x, v[j].y * rstd * w.y), pk2(v[j].z * rstd * w.z, v[j].w * rstd * w.w)}; }
    }
}

__device__ __forceinline__ float ffn_rstd(const float* SS, int m) {
    const f32x4* q = (const f32x4*)(SS + (size_t)m * 16); const f32x4 a = q[0], b = q[1], c = q[2], d = q[3];
    const float t = ((a.x + a.y) + (a.z + a.w)) + ((b.x + b.y) + (b.z + b.w)) + ((c.x + c.y) + (c.z + c.w)) + ((d.x + d.y) + (d.z + d.w));
    return frsq(t * (1.f / 1024.f) + EPS);
}
__device__ __forceinline__ unsigned ord_key(float f) { const unsigned u = __builtin_bit_cast(unsigned, f); return (u & 0x80000000u) ? ~u : (u | 0x80000000u); }
__device__ __forceinline__ float ord_val(unsigned k) { const unsigned u = (k & 0x80000000u) ? (k & 0x7fffffffu) : ~k; return __builtin_bit_cast(float, u); }
template <int CTRL> __device__ __forceinline__ unsigned dpp_u(unsigned v) { return (unsigned)__builtin_amdgcn_update_dpp(0, (int)v, CTRL, 0xF, 0xF, true); }
__device__ __forceinline__ unsigned umax_(unsigned a, unsigned b) { return a > b ? a : b; }
__device__ __forceinline__ unsigned umin_(unsigned a, unsigned b) { return a < b ? a : b; }
__device__ __forceinline__ unsigned row_max_u(unsigned v) {
    v = umax_(v, dpp_u<0xB1>(v)); v = umax_(v, dpp_u<0x4E>(v)); v = umax_(v, dpp_u<0x141>(v)); v = umax_(v, dpp_u<0x140>(v)); return v;
}
__device__ __forceinline__ float row_sum_f(float v) {
    v += __builtin_bit_cast(float, dpp_u<0xB1>(__builtin_bit_cast(unsigned, v))); v += __builtin_bit_cast(float, dpp_u<0x4E>(__builtin_bit_cast(unsigned, v)));
    v += __builtin_bit_cast(float, dpp_u<0x141>(__builtin_bit_cast(unsigned, v))); v += __builtin_bit_cast(float, dpp_u<0x140>(__builtin_bit_cast(unsigned, v))); return v;
}
#define CE_(i, j) do { const unsigned _a = k[i], _b = k[j]; k[i] = umax_(_a, _b); k[j] = umin_(_a, _b); } while (0)
__device__ __forceinline__ unsigned row_top16(unsigned (&k)[8], unsigned (&top)[16], int li) {
    CE_(0, 1); CE_(2, 3); CE_(4, 5); CE_(6, 7); CE_(0, 2); CE_(1, 3); CE_(4, 6); CE_(5, 7); CE_(1, 2); CE_(5, 6);
    CE_(0, 4); CE_(1, 5); CE_(2, 6); CE_(3, 7); CE_(2, 4); CE_(3, 5); CE_(1, 2); CE_(3, 4); CE_(5, 6);
    unsigned mine = 0u;
#pragma unroll
    for (int n = 0; n < 16; ++n) {
        const unsigned m = row_max_u(k[0]);
        const bool hit = k[0] == m;
#pragma unroll
        for (int i = 0; i < 7; ++i) k[i] = hit ? k[i + 1] : k[i];
        k[7] = hit ? 0u : k[7];
        top[n] = m; mine = (li == n) ? m : mine;
    }
    return mine;
}
__device__ __forceinline__ void topk_core(const float (&s1)[8], const float (&s2)[8], float rstd, int li, int lane, int& e_out, float& g_out) {
    unsigned k[8], top1[16], top2[16];
#pragma unroll
    for (int j = 0; j < 8; ++j) k[j] = (ord_key(s1[j]) & ~0x7fu) | (unsigned)(127 - (li + 16 * j));
    const unsigned mine1 = row_top16(k, top1, li);
#pragma unroll
    for (int j = 0; j < 8; ++j) k[j] = (ord_key(s2[j]) & ~0x7fu) | (unsigned)(127 - (li + 16 * j));
    const unsigned mine2 = row_top16(k, top2, li);
    const float v2 = ord_val(mine2 & ~0x7fu);
    unsigned c[16];
#pragma unroll
    for (int j = 0; j < 16; ++j) {
        const float v1 = ord_val(top1[j] & ~0x7fu);
        const unsigned key = (ord_key(v1 + v2) & ~0xffu) | (unsigned)(255 - (16 * j + li));
        c[j] = ((j + 1) * (li + 1) <= 16) ? key : 0u;
    }
    unsigned tk = 0u, t0 = 0u;
#pragma unroll
    for (int n = 0; n < 16; ++n) {
        const unsigned mx = row_max_u(c[0]);
        const bool hit = c[0] == mx;
#pragma unroll
        for (int i = 0; i < 15; ++i) c[i] = hit ? c[i + 1] : c[i];
        c[15] = hit ? 0u : c[15];
        if (n == 0) t0 = mx;
        tk = (li == n) ? mx : tk;
    }
    const float sv = ord_val(tk & ~0xffu), s0 = ord_val(t0 & ~0xffu);
    const int cc = 255 - (int)(tk & 0xffu), a = (cc >> 4) & 15, bb = cc & 15;
    const int i1 = 127 - (int)((unsigned)__shfl((int)mine1, (lane & 48) + a) & 0x7fu), i2 = 127 - (int)((unsigned)__shfl((int)mine2, (lane & 48) + bb) & 0x7fu);
    const float pe = fexp((sv - s0) * rstd);
    const float den = row_sum_f(pe);
    e_out = i1 * 128 + i2; g_out = pe * frcp(den);
}
constexpr int TK_RS = 1040;
struct EpiTopk {
    static constexpr bool PERM = true, AFTER_DRAIN = true;
    int* IDX; float* GATE; const float* SS;
    __device__ __forceinline__ void fused(pg8::f32x4 (&acc)[2][2][4][2], const pg8::Unit& u, int wr, int wc, int fr, int fq, PG8_LAS unsigned char* lds, int wid, int lane) const {
        const int head = u.pn, q = lane >> 4, li = lane & 15;
#pragma unroll
        for (int ai = 0; ai < 2; ++ai) {
#pragma unroll
            for (int m = 0; m < 4; ++m)
#pragma unroll
                for (int bj = 0; bj < 2; ++bj) {
                    PG8_LAS unsigned char* dst = lds + (wr * 64 + m * 16 + fr) * TK_RS + (bj * 128 + wc * 32 + 8 * fq) * 4;
                    *(PG8_LAS pg8::f32x4*)dst = acc[ai][bj][m][0]; *(PG8_LAS pg8::f32x4*)(dst + 16) = acc[ai][bj][m][1];
                }
            __syncthreads();
#pragma unroll 1
            for (int it = 0; it < 4; it += 2) {
                const int rowa = 16 * wid + 4 * it + q, rowb = rowa + 4, ma = u.pm * 256 + ai * 128 + rowa, mb = ma + 4;
                const PG8_LAS float* sa = (const PG8_LAS float*)(lds + rowa * TK_RS); const PG8_LAS float* sb = (const PG8_LAS float*)(lds + rowb * TK_RS);
                float a1[8], a2[8], b1[8], b2[8];
#pragma unroll
                for (int j = 0; j < 8; ++j) { a1[j] = sa[li + 16 * j]; a2[j] = sa[128 + li + 16 * j]; b1[j] = sb[li + 16 * j]; b2[j] = sb[128 + li + 16 * j]; }
                const float ra = ffn_rstd(SS, ma), rb = ffn_rstd(SS, mb);
                int ea, eb; float ga, gb;
                topk_core(a1, a2, ra, li, lane, ea, ga);
                topk_core(b1, b2, rb, li, lane, eb, gb);
                IDX[(size_t)ma * 128 + head * 16 + li] = ea; GATE[(size_t)ma * 128 + head * 16 + li] = ga;
                IDX[(size_t)mb * 128 + head * 16 + li] = eb; GATE[(size_t)mb * 128 + head * 16 + li] = gb;
            }
            __syncthreads();
        }
    }
};
struct OneUnit {
    pg8::Unit u;
    __device__ __forceinline__ bool next(int i, pg8::Unit& o) const { if (i) return false; o = u; return true; }
    __device__ __forceinline__ void a_ready(const pg8::Unit&) const {}
    __device__ __forceinline__ void done(const pg8::Unit&) const {}
};

__device__ __forceinline__ float gelu_erf(float x) { return 0.5f * x * (1.f + erff(x * 0.70710678118654752f)); }
typedef float f32x2 __attribute__((ext_vector_type(2)));
__device__ __forceinline__ void cvt16_fp8(const v4u& w, f32x2 (&f)[8]) {
    f[0] = __builtin_amdgcn_cvt_pk_f32_fp8((int)w.x, false); f[1] = __builtin_amdgcn_cvt_pk_f32_fp8((int)w.x, true);
    f[2] = __builtin_amdgcn_cvt_pk_f32_fp8((int)w.y, false); f[3] = __builtin_amdgcn_cvt_pk_f32_fp8((int)w.y, true);
    f[4] = __builtin_amdgcn_cvt_pk_f32_fp8((int)w.z, false); f[5] = __builtin_amdgcn_cvt_pk_f32_fp8((int)w.z, true);
    f[6] = __builtin_amdgcn_cvt_pk_f32_fp8((int)w.w, false); f[7] = __builtin_amdgcn_cvt_pk_f32_fp8((int)w.w, true);
}
__device__ __forceinline__ float grp8_sum(float v) {
    v += __builtin_bit_cast(float, dpp_u<0xB1>(__builtin_bit_cast(unsigned, v)));
    v += __builtin_bit_cast(float, dpp_u<0x4E>(__builtin_bit_cast(unsigned, v)));
    v += __builtin_bit_cast(float, dpp_u<0x141>(__builtin_bit_cast(unsigned, v)));
    return v;
}
typedef int i32x4 __attribute__((ext_vector_type(4)));
template <int PAT> __device__ __forceinline__ float swz_f(float v) { return __builtin_bit_cast(float, __builtin_amdgcn_ds_swizzle(__builtin_bit_cast(int, v), PAT)); }
__device__ __forceinline__ void peer_u_token(const v4u (&ur)[16], const f32x2 (&xv)[8], bf16* dst, int c8) {
    float d[16];
#pragma unroll
    for (int i = 0; i < 16; ++i) {
        f32x2 f[8]; cvt16_fp8(ur[i], f);
        f32x2 s2 = f[0] * xv[0];
#pragma unroll
        for (int q = 1; q < 8; ++q) s2 += f[q] * xv[q];
        d[i] = s2.x + s2.y;
    }
    const bool b0 = (c8 & 1) != 0, b1 = (c8 & 2) != 0, b2 = (c8 & 4) != 0;
    float e8[8], e4[4], e2[2];
#pragma unroll
    for (int i = 0; i < 8; ++i) { const float keep = b0 ? d[2 * i + 1] : d[2 * i], send = b0 ? d[2 * i] : d[2 * i + 1];
        e8[i] = keep + __builtin_bit_cast(float, dpp_u<0xB1>(__builtin_bit_cast(unsigned, send))); }
#pragma unroll
    for (int i = 0; i < 4; ++i) { const float keep = b1 ? e8[2 * i + 1] : e8[2 * i], send = b1 ? e8[2 * i] : e8[2 * i + 1];
        e4[i] = keep + __builtin_bit_cast(float, dpp_u<0x4E>(__builtin_bit_cast(unsigned, send))); }
#pragma unroll
    for (int i = 0; i < 2; ++i) { const float keep = b2 ? e4[2 * i + 1] : e4[2 * i], send = b2 ? e4[2 * i] : e4[2 * i + 1];
        e2[i] = keep + swz_f<0x1F | (4 << 10)>(send); }
    dst[c8] = (bf16)f2bf(e2[0]); dst[c8 + 8] = (bf16)f2bf(e2[1]);
}
__device__ __forceinline__ void peer_u(const P& p, int wave, int lane) {
    const int j = blockIdx.x & 7, nchunk = gridDim.x >> 3, chunk = blockIdx.x >> 3, stride = nchunk * 8;
    const int g = lane >> 3, c8 = lane & 7;
    const bf16* HN = (const bf16*)p.out + 128 * j + 16 * c8; const int* IDX = (const int*)(p.ws + WS_IDX) + 16 * g;
    const unsigned char* US = p.ws + WS_U8 + (size_t)j * NEXP * 128 + 16 * c8;
    bf16* PART = (bf16*)(p.ws + WS_PART) + (size_t)j * T_ * 128 + 16 * g;
    const int m0 = chunk * 8 + wave, ntok = (T_ - m0 + stride - 1) / stride;
#define PU_CLAMP(k) (m0 + ((k) < ntok ? (k) : ntok - 1) * stride)
#define PU_ROWS(ur, ei) _Pragma("unroll") for (int i = 0; i < 16; ++i) ur[i] = *(const v4u*)(US + (size_t)ei[i >> 2][i & 3] * 128)
#define PU_L1(ei, h0, h1, mm) do { _Pragma("unroll") for (int q = 0; q < 4; ++q) ei[q] = *(const i32x4*)(IDX + (size_t)(mm) * 128 + 4 * q); \
        h0 = *(const v4u*)(HN + (size_t)(mm) * 1024); h1 = *(const v4u*)(HN + (size_t)(mm) * 1024 + 8); } while (0)
#define PU_X(xv, h0, h1) do { float f_[8]; unpack8(h0, f_); _Pragma("unroll") for (int i = 0; i < 4; ++i) xv[i] = (f32x2){f_[2 * i], f_[2 * i + 1]}; \
        unpack8(h1, f_); _Pragma("unroll") for (int i = 0; i < 4; ++i) xv[4 + i] = (f32x2){f_[2 * i], f_[2 * i + 1]}; } while (0)
    i32x4 ei[4]; v4u hA0, hA1, hB0, hB1; v4u urA[16], urB[16]; f32x2 xv[8];
    PU_L1(ei, hA0, hA1, m0);
    PU_ROWS(urA, ei);
    PU_L1(ei, hB0, hB1, PU_CLAMP(1));
    for (int k = 0; k < ntok; k += 2) {
        PU_ROWS(urB, ei);
        PU_X(xv, hA0, hA1);
        PU_L1(ei, hA0, hA1, PU_CLAMP(k + 2));
        peer_u_token(urA, xv, PART + (size_t)(m0 + k * stride) * 128, c8);
        if (k + 1 < ntok) {
            PU_ROWS(urA, ei);
            PU_X(xv, hB0, hB1);
            PU_L1(ei, hB0, hB1, PU_CLAMP(k + 3));
            peer_u_token(urB, xv, PART + (size_t)(m0 + (k + 1) * stride) * 128, c8);
        }
    }
#undef PU_CLAMP
#undef PU_ROWS
#undef PU_L1
#undef PU_X
}
__device__ __forceinline__ void peer_c(const P& p, int wave, int lane) {
    const int gw = blockIdx.x * NWAVES + wave, NGW = gridDim.x * NWAVES;
    const int* IDX = (const int*)(p.ws + WS_IDX); const float* GATE = (const float*)(p.ws + WS_GATE); const bf16* PART = (const bf16*)(p.ws + WS_PART);
    const float* USC = (const float*)(p.ws + WS_USC); const float* VSC = (const float*)(p.ws + WS_VSC); float* COEF = (float*)(p.ws + WS_COEF); const float* SS = (const float*)(p.ws + WS_SS);
    for (int m0 = gw * 2; m0 < T_; m0 += NGW * 2) {
        float s[2][2], rs[2], g[2][2]; int e[2][2];
#pragma unroll
        for (int u = 0; u < 2; ++u) {
            const int m = m0 + u;
            rs[u] = ffn_rstd(SS, m);
            s[u][0] = 0.f; s[u][1] = 0.f;
#pragma unroll
            for (int jj = 0; jj < 8; ++jj) { s[u][0] += bf2f(PART[((size_t)jj * T_ + m) * 128 + lane]); s[u][1] += bf2f(PART[((size_t)jj * T_ + m) * 128 + 64 + lane]); }
            e[u][0] = IDX[(size_t)m * 128 + lane]; e[u][1] = IDX[(size_t)m * 128 + 64 + lane];
            g[u][0] = GATE[(size_t)m * 128 + lane]; g[u][1] = GATE[(size_t)m * 128 + 64 + lane];
        }
        float us[2][2], vs[2][2];
#pragma unroll
        for (int u = 0; u < 2; ++u)
#pragma unroll
            for (int k = 0; k < 2; ++k) { us[u][k] = USC[e[u][k]]; vs[u][k] = VSC[e[u][k]]; }
#pragma unroll
        for (int u = 0; u < 2; ++u)
#pragma unroll
            for (int k = 0; k < 2; ++k) COEF[(size_t)(m0 + u) * 128 + 64 * k + lane] = g[u][k] * gelu_erf(s[u][k] * rs[u] * us[u][k]) * vs[u][k];
    }
}
struct PvPre { i32x4 ei[4]; f32x4 cf[4]; };
__device__ __forceinline__ void pv_level1(PvPre& q, const int* IDXg, const float* COEFg, int m, int c8) {
#pragma unroll
    for (int k = 0; k < 4; ++k) { q.ei[k] = *(const i32x4*)(IDXg + (size_t)m * 128 + 4 * k); q.cf[k] = *(const f32x4*)(COEFg + (size_t)m * 128 + 4 * k); }
}
__device__ __forceinline__ void peer_v_token(const v4u (&vr)[16], const f32x4 (&cf)[4], const bf16* H, bf16* out, bool b3, bool b4, bool b5) {
    f32x2 acc[8];
#pragma unroll
    for (int i = 0; i < 8; ++i) acc[i] = (f32x2){0.f, 0.f};
#pragma unroll
    for (int I = 0; I < 16; ++I) {
        const float cu = cf[I >> 2][I & 3];
        const f32x2 c2 = (f32x2){cu, cu}; f32x2 f[8]; cvt16_fp8(vr[I], f);
#pragma unroll
        for (int q = 0; q < 8; ++q) acc[q] += c2 * f[q];
    }
    f32x2 a1[4], a2[2], a3;
#pragma unroll
    for (int i = 0; i < 4; ++i) { const f32x2 keep = b5 ? acc[2 * i + 1] : acc[2 * i], send = b5 ? acc[2 * i] : acc[2 * i + 1];
        a1[i] = keep + (f32x2){__shfl_xor(send.x, 32), __shfl_xor(send.y, 32)}; }
#pragma unroll
    for (int i = 0; i < 2; ++i) { const f32x2 keep = b4 ? a1[2 * i + 1] : a1[2 * i], send = b4 ? a1[2 * i] : a1[2 * i + 1];
        a2[i] = keep + (f32x2){swz_f<0x1F | (16 << 10)>(send.x), swz_f<0x1F | (16 << 10)>(send.y)}; }
    { const f32x2 keep = b3 ? a2[1] : a2[0], send = b3 ? a2[0] : a2[1]; a3 = keep + (f32x2){swz_f<0x1F | (8 << 10)>(send.x), swz_f<0x1F | (8 << 10)>(send.y)}; }
    const unsigned hb = *(const unsigned*)H; const f32x2 hv = (f32x2){bflo(hb), bfhi(hb)};
    const f32x2 y = hv + a3;
    *(unsigned*)out = pk2(y.x, y.y);
}
__device__ __forceinline__ void peer_v(const P& p, int wave, int lane) {
    const int j = blockIdx.x & 7, nchunk = gridDim.x >> 3, chunk = blockIdx.x >> 3, stride = nchunk * 8;
    const int g = lane >> 3, c8 = lane & 7;
    const bool b5 = (lane & 32) != 0, b4 = (lane & 16) != 0, b3 = (lane & 8) != 0;
    const int pi = 4 * (b3 ? 1 : 0) + 2 * (b4 ? 1 : 0) + (b5 ? 1 : 0);
    const size_t colo = 128 * j + 16 * c8 + 2 * pi;
    const bf16* H = (const bf16*)(p.ws + WS_H) + colo; bf16* OUT = (bf16*)(p.ws + WS_YB) + colo;
    const int* IDXg = (const int*)(p.ws + WS_IDX) + 16 * g; const float* COEFg = (const float*)(p.ws + WS_COEF) + 16 * g;
    const unsigned char* VS = p.ws + WS_V8 + (size_t)j * NEXP * 128 + 16 * c8;
    const int m0 = chunk * 8 + wave, ntok = (T_ - m0 + stride - 1) / stride;
#define PV_CLAMP(k) (m0 + ((k) < ntok ? (k) : ntok - 1) * stride)
#define PV_ROWS(vr, q) _Pragma("unroll") for (int i = 0; i < 16; ++i) vr[i] = *(const v4u*)(VS + (size_t)q.ei[i >> 2][i & 3] * 128)
    PvPre q; v4u vrA[16], vrB[16]; f32x4 cA[4], cB[4];
    pv_level1(q, IDXg, COEFg, m0, c8);
    PV_ROWS(vrA, q);
#pragma unroll
    for (int k = 0; k < 4; ++k) cA[k] = q.cf[k];
    pv_level1(q, IDXg, COEFg, PV_CLAMP(1), c8);
    for (int k = 0; k < ntok; k += 2) {
        PV_ROWS(vrB, q);
#pragma unroll
        for (int kk = 0; kk < 4; ++kk) cB[kk] = q.cf[kk];
        pv_level1(q, IDXg, COEFg, PV_CLAMP(k + 2), c8);
        { const size_t mm = (size_t)(m0 + k * stride); peer_v_token(vrA, cA, H + mm * 1024, OUT + mm * 1024, b3, b4, b5); }
        if (k + 1 < ntok) {
            PV_ROWS(vrA, q);
#pragma unroll
            for (int kk = 0; kk < 4; ++kk) cA[kk] = q.cf[kk];
            pv_level1(q, IDXg, COEFg, PV_CLAMP(k + 3), c8);
            { const size_t mm = (size_t)(m0 + (k + 1) * stride); peer_v_token(vrB, cB, H + mm * 1024, OUT + mm * 1024, b3, b4, b5); }
        }
    }
#undef PV_CLAMP
#undef PV_ROWS
}
__device__ __forceinline__ void peer_f(const P& p, int wave, int lane) {
    const int gw = blockIdx.x * NWAVES + wave, NGW = gridDim.x * NWAVES;
    for (int m = gw; m < T_; m += NGW) {
        const v2u* yb = (const v2u*)((const bf16*)(p.ws + WS_YB) + (size_t)m * 1024) + lane;
        v2u yv[4]; float ss = 0.f;
#pragma unroll
        for (int q = 0; q < 4; ++q) { yv[q] = yb[64 * q]; const float a = bflo(yv[q].x), b = bfhi(yv[q].x), c = bflo(yv[q].y), d = bfhi(yv[q].y); ss += (a * a + b * b) + (c * c + d * d); }
        const float rstd = frsq(wave_sum(ss) * (1.f / 1024.f) + EPS);
        f32x4* o = (f32x4*)(p.out + (size_t)m * 1024) + lane; const f32x4* wr = (const f32x4*)p.norm_final_w + lane;
#pragma unroll
        for (int q = 0; q < 4; ++q) { const f32x4 w = wr[64 * q];
            o[64 * q] = (f32x4){bflo(yv[q].x) * rstd * w.x, bfhi(yv[q].x) * rstd * w.y, bflo(yv[q].y) * rstd * w.z, bfhi(yv[q].y) * rstd * w.w}; }
    }
}

constexpr int N_PHASES = 12;
struct Args { P p; int ph_lo, ph_hi; };
__global__ void __launch_bounds__(NTHR, 2) fwd_kernel(Args args) {
    extern __shared__ __attribute__((aligned(16))) unsigned char lds_raw[];
    LAS unsigned char* lds = (LAS unsigned char*)lds_raw;
    const P& p = args.p;
    const int tid = threadIdx.x, lane = tid & 63, wave = __builtin_amdgcn_readfirstlane(tid >> 6);
    volatile LAS unsigned* MISC = (volatile LAS unsigned*)(lds + MISC_OFF);
    for (int u = tid; u < (LDS_BYTES - LDSCTL_OFF) / 4; u += NTHR) ((LAS unsigned*)(lds + LDSCTL_OFF))[u] = 0u;
    __syncthreads();
    XcdBarrier bar; bar.bar = (unsigned*)(p.ws + WS_CTL) + CW_BAR; bar.x = 0; bar.st = nullptr;
#if !MK_PER_PHASE
    bar = xcd_barrier_post((unsigned*)(p.ws + WS_CTL) + CW_BAR, MISC + 8);
#endif
    const int lo = args.ph_lo, hi = args.ph_hi;
#define IN(k) (lo <= (k) && (k) < hi)
#ifndef PROBE_WAIT_LO
#define PROBE_WAIT_LO -1
#define PROBE_WAIT_HI -1
#endif
    volatile LAS unsigned long long* STAMP = (volatile LAS unsigned long long*)(lds + MISC_OFF + 256);
#define SEAM(k) do { if (IN(k) && IN((k) + 1)) xcd_barrier(bar); if (PROBE_WAIT_LO >= 0 && blockIdx.x == 0 && tid == 0) { STAMP[(k) + 1] = __builtin_amdgcn_s_memrealtime(); \
        if ((k) + 1 == N_PHASES - 1) { const unsigned long long d_ = STAMP[PROBE_WAIT_HI < 0 ? 0 : PROBE_WAIT_HI] - STAMP[PROBE_WAIT_LO < 0 ? 0 : PROBE_WAIT_LO]; \
            __hip_atomic_store((unsigned*)(p.ws + WS_CTL) + CW_Q + 256, (unsigned)d_ | 1u, __ATOMIC_RELAXED, __HIP_MEMORY_SCOPE_AGENT); } } } while (0)
    if (PROBE_WAIT_LO >= 0 && blockIdx.x == 0 && tid == 0) STAMP[0] = __builtin_amdgcn_s_memrealtime();

#ifndef PROBE_REP
#define PROBE_REP -1
#endif
#define REP(k) ((PROBE_REP == (k)) ? 2 : 1)
    if (IN(0)) {
#pragma unroll 1
        for (int r = 0; r < REP(0); ++r) p0_prologue(p, lds, wave, lane); } SEAM(0);
    if (IN(1)) {
#pragma unroll 1
      for (int r = 0; r < REP(1); ++r) {
        EpiProj e{(bf16*)(p.ws + WS_SBQKV), (bf16*)(p.ws + WS_VT), (bf16*)(p.ws + WS_MLQK), (bf16*)(p.ws + WS_MLV), (bf16*)(p.ws + WS_MLO), (bf16*)(p.ws + WS_GATES)};
        gemm<EpiProj>(lds, (const bf16*)(p.ws + WS_XN), (const bf16*)(p.ws + WS_W1T), T_, NPROJ, 1024, e); }
    } SEAM(1);
    if (IN(2)) { p2_conv(p, tid); } SEAM(2);
    if (IN(3)) {
        for (int it = blockIdx.x; it < 64; it += gridDim.x) mlstm_item(p, lds, it, tid, wave, lane);
        unsigned* qctr = (unsigned*)(p.ws + WS_CTL) + CW_Q;
#ifdef PROBE_P3SPLIT
        xcd_barrier(bar); if (blockIdx.x == 0 && tid == 0) STAMP[20] = __builtin_amdgcn_s_memrealtime();
#endif
        for (;;) {
            if (tid == 0) MISC[12] = __hip_atomic_fetch_add(qctr, 1u, __ATOMIC_RELAXED, __HIP_MEMORY_SCOPE_AGENT);
            __syncthreads();
            const unsigned it = MISC[12];
            __syncthreads();
            if (it >= 1024u) break;
            sba_item(p, lds, (int)it, wave, lane);
        }
#ifdef PROBE_P3SPLIT
        xcd_barrier(bar); if (blockIdx.x == 0 && tid == 0) STAMP[21] = __builtin_amdgcn_s_memrealtime();
#endif
        for (;;) {
            if (tid == 0) MISC[12] = __hip_atomic_fetch_add(qctr + 128, 1u, __ATOMIC_RELAXED, __HIP_MEMORY_SCOPE_AGENT);
            __syncthreads();
            const unsigned it = MISC[12];
            __syncthreads();
            if (it >= (unsigned)N_FILL) break;
            fill_item(p, (int)it, wave, lane);
        }
    } SEAM(3);
    if (IN(4)) { p3_yml(p, wave, lane); } SEAM(4);
    if (IN(5)) {
        pg8::Gemm g{(const bf16*)p.out, (const bf16*)(p.ws + WS_WSBT), T_, 1024, 1024}; pg8::StaticOrder S; S.init(T_, 1024, (int)gridDim.x, (int)blockIdx.x);
        EpiMerge1 e{(bf16*)(p.ws + WS_MERGED), (const unsigned char*)(p.ws + WS_GATES)};
        pg8::gemm_phase<EpiMerge1, pg8::StaticOrder, true, true, true>(lds, g, S, e);
    } SEAM(5);
    if (IN(6)) {
        pg8::Gemm g{(const bf16*)(p.ws + WS_MERGED), (const bf16*)(p.ws + WS_WOUTT), T_, 1024, 1024}; pg8::StaticOrder S; S.init(T_, 1024, (int)gridDim.x, (int)blockIdx.x);
        EpiHW e{(bf16*)(p.ws + WS_H), p.x, (bf16*)p.out  , p.norm_ffn_w, (float*)(p.ws + WS_SS)};
        pg8::gemm_phase<EpiHW, pg8::StaticOrder, true, true>(lds, g, S, e);
    } SEAM(6);
    if (IN(7)) {
        pg8::Gemm g{(const bf16*)p.out, (const bf16*)(p.ws + WS_WCT), T_, 2048, 1024}; pg8::StaticOrder S; S.init(T_, 2048, (int)gridDim.x, (int)blockIdx.x);
        EpiTopk e{(int*)(p.ws + WS_IDX), (float*)(p.ws + WS_GATE), (const float*)(p.ws + WS_SS)};
#pragma unroll 1
        for (int i = 0;; ++i) { OneUnit s1; if (!S.next(i, s1.u)) break; pg8::gemm_phase<EpiTopk, OneUnit, false, true>(lds, g, s1, e); }
    } SEAM(7);
    if (IN(8)) { peer_u(p, wave, lane); } SEAM(8);
    if (IN(9)) { peer_c(p, wave, lane); } SEAM(9);
    if (IN(10)) { peer_v(p, wave, lane); } SEAM(10);
    if (IN(11)) { peer_f(p, wave, lane); }
    if (PROBE_WAIT_LO >= 0 && tid == 0) {
        unsigned* pw = (unsigned*)(p.ws + WS_CTL) + CW_Q + 256;
        unsigned dt = 0u;
        for (unsigned sp = 0; sp < (1u << 22); ++sp) { dt = __hip_atomic_load(pw, __ATOMIC_RELAXED, __HIP_MEMORY_SCOPE_AGENT); if (dt) break; __builtin_amdgcn_s_sleep(8); }
        const unsigned long long tend = __builtin_amdgcn_s_memrealtime();
        while (__builtin_amdgcn_s_memrealtime() - tend < (unsigned long long)dt) __builtin_amdgcn_s_sleep(8);
    }
#undef IN
#undef SEAM
}

extern "C" void kernel_launch(void* const* d_in, const int* in_sizes, int n_in, void* d_out, int out_size, void* d_ws, size_t ws_size, hipStream_t stream) {
    static int grid = 0;
    if (grid == 0) {
        if (n_in != 18 || in_sizes[0] != T_ * D_ || out_size != T_ * D_ || ws_size < WS_END) {
            fprintf(stderr, "kernel_launch: unexpected problem (n_in %d, in0 %d, out %d, ws %zu); nothing launched\n", n_in, n_in > 0 ? in_sizes[0] : -1, out_size, ws_size); grid = -1; return; }
        int dev = 0, cus = 0, per_cu = 0;
        if (hipGetDevice(&dev) != hipSuccess || hipDeviceGetAttribute(&cus, hipDeviceAttributeMultiprocessorCount, dev) != hipSuccess) { grid = -1; return; }
        if (hipFuncSetAttribute((const void*)fwd_kernel, hipFuncAttributeMaxDynamicSharedMemorySize, LDS_BYTES) != hipSuccess) { fprintf(stderr, "kernel_launch: hipFuncSetAttribute failed\n"); grid = -1; return; }
        if (hipOccupancyMaxActiveBlocksPerMultiprocessor(&per_cu, (const void*)fwd_kernel, NTHR, LDS_BYTES) != hipSuccess || per_cu < 1)
            fprintf(stderr, "kernel_launch: note: occupancy query reports %d workgroups per CU\n", per_cu);
        (void)hipGetLastError();
        grid = cus;
    }
    if (grid < 0) return;
    if (hipMemsetAsync((char*)d_ws + WS_CTL, 0, CTL_ZERO_BYTES, stream) != hipSuccess) { fprintf(stderr, "kernel_launch: memset failed\n"); return; }
    Args a{};
    const float** pp = (const float**)&a.p;
    for (int i = 0; i < 18; ++i) pp[i] = (const float*)d_in[i];
    a.p.out = (float*)d_out; a.p.ws = (unsigned char*)d_ws;
#if MK_PER_PHASE
    for (int ph = 0; ph < N_PHASES; ++ph) {
        a.ph_lo = ph; a.ph_hi = ph + 1;
        hipLaunchKernelGGL(fwd_kernel, dim3(grid), dim3(NTHR), LDS_BYTES, stream, a);
    }
#else
    a.ph_lo = 0; a.ph_hi = N_PHASES;
    hipLaunchKernelGGL(fwd_kernel, dim3(grid), dim3(NTHR), LDS_BYTES, stream, a);
#endif
    const hipError_t le = hipPeekAtLastError();
    if (le != hipSuccess) fprintf(stderr, "kernel_launch: launch failed: %s\n", hipGetErrorName(le));
}
```

```cpp
#include <hip/hip_runtime.h>
#include <cstdio>
#include <cstdint>
namespace pg8 {
#define PG8_LAS __attribute__((address_space(3)))
typedef unsigned short bf16_t;
typedef short bf16x8 __attribute__((ext_vector_type(8)));
typedef float f32x4 __attribute__((ext_vector_type(4)));
typedef unsigned u32x4 __attribute__((ext_vector_type(4)));
constexpr int BM = 256, BK = 64, HALF = 128, HTB = HALF * BK * 2  , STAGE_BYTES = 8 * HTB, NXCD = 8, WGM = 8;

__host__ __device__ __forceinline__ int lds_byte(int r, int c) { const int st = (r >> 4) * 2 + (c >> 5), rr = r & 15, cc = c & 31, ob = rr * 64 + cc * 2; return st * 1024 + (ob ^ (((ob >> 9) & 1) << 5)); }
__host__ __device__ __forceinline__ void stage_rc(int b, int& R, int& C) { const int st = b / 1024, sb = b % 1024, swz = sb ^ (((sb >> 9) & 1) << 5); R = (st >> 1) * 16 + swz / 64; C = (st & 1) * 32 + (swz % 64) / 2; }
__host__ __device__ __forceinline__ int perm32(int rho) { const int n = rho >> 4, i = rho & 15; return 8 * (i >> 2) + 4 * n + (i & 3); }

struct Unit { int pm, pn; };
struct Gemm { const bf16_t* A; const bf16_t* Bt; int M, N, K; };

struct StaticOrder {
    int nM, nN, nwg, G, c;
    __host__ __device__ void init(int M, int N, int G_, int c_) { nM = M / BM; nN = N / BM; nwg = nM * nN; G = G_; c = c_; }
    __host__ __device__ bool next(int i, Unit& u) const {
        const long L = (long)i * G + c; if (L >= nwg) return false;
        int wgid = (int)L; { const int q = nwg / NXCD, r = nwg % NXCD, xcd = wgid % NXCD, off = wgid / NXCD; wgid = (xcd < r ? xcd * (q + 1) : r * (q + 1) + (xcd - r) * q) + off; }
        const int nig = WGM * nN, gid = wgid / nig, fm = gid * WGM, gsz = (nM - fm) < WGM ? (nM - fm) : WGM;
        u.pm = fm + ((wgid % nig) % gsz); u.pn = (wgid % nig) / gsz; return true;
    }
    __device__ __forceinline__ void a_ready(const Unit&) const {}
    __device__ __forceinline__ void done(const Unit&) const {}
};

__device__ __forceinline__ unsigned cvt_pk_bf16(float lo, float hi) { unsigned r; asm volatile("v_cvt_pk_bf16_f32 %0, %1, %2" : "=v"(r) : "v"(lo), "v"(hi)); return r; }
template <class Epi, class Sched, bool ALIGN_EPI = false, bool SP2 = false, bool MID = false  >
__device__ __forceinline__ void gemm_phase(PG8_LAS unsigned char* lds, const Gemm g, const Sched& S, const Epi& E) {
    const int tid = threadIdx.x, wid = __builtin_amdgcn_readfirstlane(tid >> 6), lane = tid & 63, wr = wid >> 2, wc = wid & 3, fr = lane & 15, fq = lane >> 4;
    const int K = g.K, nt = K / BK;
    unsigned voffA[2], voffB[2];
#pragma unroll
    for (int i = 0; i < 2; ++i) { int R, C; stage_rc(tid * 16 + i * 8192, R, C); const int Rb = Epi::PERM ? ((R & ~31) + perm32(R & 31)) : R;
        voffA[i] = (unsigned)(R * K + C) * 2u; voffB[i] = (unsigned)(Rb * K + C) * 2u; }
    const size_t kstep = (size_t)(BK * 2);
    const size_t hstep = (size_t)HALF * K * 2;
    const size_t tstep = 2 * hstep;
    const unsigned ldsw = (unsigned)wid * 1024u;
    const int aoff = lds_byte(wr * 64 + fr, fq * 8), boff = lds_byte(wc * 32 + fr, fq * 8);
#define PG8_SA(b, h) (((b) * 2 + (h)) * HTB)
#define PG8_SB(b, h) ((4 + (b) * 2 + (h)) * HTB)
#define PG8_STAGE(bufoff, gbase, voff) do { _Pragma("unroll") for (int _i = 0; _i < 2; ++_i) \
        __builtin_amdgcn_global_load_lds((const unsigned*)((const char*)(gbase) + (voff)[_i]), (PG8_LAS unsigned*)(lds + (bufoff) + ldsw + _i * 8192), 16, 0, 0); } while (0)
#define PG8_LDA(dst, b, h) do { _Pragma("unroll") for (int m = 0; m < 4; ++m) _Pragma("unroll") for (int k = 0; k < 2; ++k) dst[m][k] = *(const PG8_LAS bf16x8*)(lds + PG8_SA(b, h) + aoff + m * 2048 + k * 1024); } while (0)
#define PG8_LDB(dst, b, h) do { _Pragma("unroll") for (int n = 0; n < 2; ++n) _Pragma("unroll") for (int k = 0; k < 2; ++k) dst[n][k] = *(const PG8_LAS bf16x8*)(lds + PG8_SB(b, h) + boff + n * 2048 + k * 1024); } while (0)
#define PG8_MMA(ai, bj, At, Bt) do { __builtin_amdgcn_s_setprio(1); _Pragma("unroll") for (int m = 0; m < 4; ++m) _Pragma("unroll") for (int n = 0; n < 2; ++n) _Pragma("unroll") for (int k = 0; k < 2; ++k) \
        acc[ai][bj][m][n] = __builtin_amdgcn_mfma_f32_16x16x32_bf16(Bt[n][k], At[m][k], acc[ai][bj][m][n], 0, 0, 0); __builtin_amdgcn_s_setprio(0); } while (0)
#define PG8_WAIT_V(n) asm volatile("s_waitcnt vmcnt(" #n ")" ::: "memory")
#define PG8_WAIT_L(n) asm volatile("s_waitcnt lgkmcnt(" #n ")" ::: "memory")
#define PG8_BAR __builtin_amdgcn_s_barrier()
#define PG8_SCHED __builtin_amdgcn_sched_barrier(0)
    Unit cur, nxt; int ui = 0;
    if (!S.next(0, cur)) return;
    f32x4 acc[2][2][4][2];
#pragma unroll
    for (int a = 0; a < 2; ++a)
#pragma unroll
        for (int b = 0; b < 2; ++b)
#pragma unroll
            for (int m = 0; m < 4; ++m)
#pragma unroll
                for (int n = 0; n < 2; ++n) acc[a][b][m][n] = (f32x4){0.f, 0.f, 0.f, 0.f};
    bf16x8 At[4][2], B0[2][2], B1[2][2];
    const char* cA = (const char*)g.A + (size_t)cur.pm * tstep; const char* cB = (const char*)g.Bt + (size_t)cur.pn * tstep;
    S.a_ready(cur);
    if constexpr (SP2) {
        PG8_STAGE(PG8_SB(0, 0), cB, voffB); PG8_STAGE(PG8_SB(0, 1), cB + hstep, voffB); PG8_STAGE(PG8_SA(0, 0), cA, voffA); PG8_STAGE(PG8_SA(0, 1), cA + hstep, voffA);
        if (wr == 1) PG8_BAR;
        PG8_WAIT_V(2); PG8_BAR;
        PG8_STAGE(PG8_SB(1, 0), cB + kstep, voffB); PG8_STAGE(PG8_SA(1, 0), cA + kstep, voffA); PG8_STAGE(PG8_SB(1, 1), cB + hstep + kstep, voffB);
        PG8_WAIT_V(6); PG8_BAR;
    } else {
        PG8_STAGE(PG8_SB(0, 0), cB, voffB); PG8_STAGE(PG8_SA(0, 0), cA, voffA); PG8_STAGE(PG8_SB(0, 1), cB + hstep, voffB); PG8_STAGE(PG8_SA(0, 1), cA + hstep, voffA);
        if (wr == 1) PG8_BAR;
        PG8_WAIT_V(4); PG8_BAR;
        PG8_STAGE(PG8_SB(1, 0), cB + kstep, voffB); PG8_STAGE(PG8_SA(1, 0), cA + kstep, voffA); PG8_STAGE(PG8_SB(1, 1), cB + hstep + kstep, voffB);
        PG8_WAIT_V(6); PG8_BAR;
    }
    for (;;) {
        const bool has_next = S.next(ui + 1, nxt);
        const char* nA = has_next ? (const char*)g.A + (size_t)nxt.pm * tstep : cA; const char* nB = has_next ? (const char*)g.Bt + (size_t)nxt.pn * tstep : cB;
        for (int t = 0; t < nt; t += 2) {
            if constexpr (MID) { if (t == (nt >> 1)) E.mid(acc, cur, wr, wc, fr, fq); }
            const bool last = (t == nt - 2);
            const char* a1 = cA + (size_t)(t + 1) * kstep;
            const char* a2 = last ? nA : cA + (size_t)(t + 2) * kstep; const char* b2 = last ? nB : cB + (size_t)(t + 2) * kstep;
            const char* a3 = a2 + kstep; const char* b3 = b2 + kstep;
            if (last && has_next) S.a_ready(nxt);
            if constexpr (SP2) {
            PG8_LDB(B0, 0, 0); PG8_LDB(B1, 0, 1); PG8_SCHED; PG8_LDA(At, 0, 0); PG8_STAGE(PG8_SA(1, 1), a1 + hstep, voffA);
            PG8_WAIT_V(8); PG8_WAIT_L(0); PG8_BAR; PG8_MMA(0, 0, At, B0); PG8_MMA(0, 1, At, B1); PG8_BAR; PG8_SCHED;
            PG8_LDA(At, 0, 1); PG8_STAGE(PG8_SB(0, 0), b2, voffB); PG8_STAGE(PG8_SB(0, 1), b2 + hstep, voffB); PG8_STAGE(PG8_SA(0, 0), a2, voffA);
            PG8_WAIT_V(8); PG8_WAIT_L(0); PG8_BAR; PG8_MMA(1, 0, At, B0); PG8_MMA(1, 1, At, B1); PG8_BAR; PG8_SCHED;
            PG8_LDB(B0, 1, 0); PG8_LDB(B1, 1, 1); PG8_SCHED; PG8_LDA(At, 1, 0); PG8_STAGE(PG8_SA(0, 1), a2 + hstep, voffA);
            PG8_WAIT_V(8); PG8_WAIT_L(0); PG8_BAR; PG8_MMA(0, 0, At, B0); PG8_MMA(0, 1, At, B1); PG8_BAR; PG8_SCHED;
            PG8_LDA(At, 1, 1); PG8_STAGE(PG8_SB(1, 0), b3, voffB); PG8_STAGE(PG8_SB(1, 1), b3 + hstep, voffB); PG8_STAGE(PG8_SA(1, 0), a3, voffA);
            PG8_WAIT_V(8); PG8_WAIT_L(0); PG8_BAR; PG8_MMA(1, 0, At, B0); PG8_MMA(1, 1, At, B1); PG8_BAR; PG8_SCHED;
            } else {
            PG8_LDB(B0, 0, 0); PG8_SCHED; PG8_LDA(At, 0, 0); PG8_STAGE(PG8_SA(1, 1), a1 + hstep, voffA);
            PG8_WAIT_L(8); PG8_BAR; PG8_WAIT_L(0); PG8_MMA(0, 0, At, B0); PG8_BAR; PG8_SCHED;
            PG8_LDB(B1, 0, 1); PG8_STAGE(PG8_SB(0, 0), b2, voffB);
            PG8_BAR; PG8_WAIT_L(0); PG8_MMA(0, 1, At, B1); PG8_BAR;
            PG8_LDA(At, 0, 1); PG8_STAGE(PG8_SA(0, 0), a2, voffA);
            PG8_BAR; PG8_WAIT_L(0); PG8_MMA(1, 0, At, B0); PG8_BAR; PG8_SCHED;
            PG8_STAGE(PG8_SB(0, 1), b2 + hstep, voffB);
            PG8_WAIT_V(6); PG8_BAR; PG8_MMA(1, 1, At, B1); PG8_BAR;
            PG8_LDB(B0, 1, 0); PG8_SCHED; PG8_LDA(At, 1, 0); PG8_STAGE(PG8_SA(0, 1), a2 + hstep, voffA);
            PG8_WAIT_L(8); PG8_BAR; PG8_WAIT_L(0); PG8_MMA(0, 0, At, B0); PG8_BAR; PG8_SCHED;
            PG8_LDB(B1, 1, 1); PG8_STAGE(PG8_SB(1, 0), b3, voffB);
            PG8_BAR; PG8_WAIT_L(0); PG8_MMA(0, 1, At, B1); PG8_BAR;
            PG8_LDA(At, 1, 1); PG8_STAGE(PG8_SA(1, 0), a3, voffA);
            PG8_BAR; PG8_WAIT_L(0); PG8_MMA(1, 0, At, B0); PG8_BAR; PG8_SCHED;
            PG8_STAGE(PG8_SB(1, 1), b3 + hstep, voffB);
            PG8_WAIT_V(6); PG8_BAR; PG8_MMA(1, 1, At, B1); PG8_BAR;
            }
        }
        if constexpr (ALIGN_EPI) { if (wr == 0) PG8_BAR; }
        if constexpr (!Epi::AFTER_DRAIN) { E(acc, cur, wr, wc, fr, fq); S.done(cur); }
        if (!has_next) break;
#pragma unroll
        for (int a = 0; a < 2; ++a)
#pragma unroll
            for (int b = 0; b < 2; ++b)
#pragma unroll
                for (int m = 0; m < 4; ++m)
#pragma unroll
                    for (int n = 0; n < 2; ++n) acc[a][b][m][n] = (f32x4){0.f, 0.f, 0.f, 0.f};
        cur = nxt; cA = nA; cB = nB; ++ui;
        if constexpr (ALIGN_EPI) { if (wr == 1) PG8_BAR; }
    }
    PG8_WAIT_V(0);
    if constexpr (!ALIGN_EPI) { if (wr == 0) PG8_BAR; }
    PG8_BAR;
    if constexpr (Epi::AFTER_DRAIN) { E.fused(acc, cur, wr, wc, fr, fq, lds, wid, lane); S.done(cur); }
#undef PG8_SA
#undef PG8_SB
#undef PG8_STAGE
#undef PG8_LDA
#undef PG8_LDB
#undef PG8_MMA
#undef PG8_WAIT_V
#undef PG8_WAIT_L
#undef PG8_BAR
#undef PG8_SCHED
}
}

#ifndef MK_PER_PHASE
#define MK_PER_PHASE 0
#endif
#ifndef USE_PG8
#define USE_PG8 1
#endif
constexpr int NWAVES = 8, NTHR = 512;

constexpr int B_ = 16, S_ = 2048, D_ = 1024, T_ = B_ * S_;
constexpr int INC = 5640, NPROJ = 5632;
constexpr int NEXP = 16384;
constexpr float EPS = 1e-6f;

constexpr size_t MiB = 1u << 20;
constexpr size_t WS_CTL = 0, CTL_ZERO_BYTES = 1 * MiB;
constexpr size_t WS_W1T = 2 * MiB, WS_WSBT = 13 * MiB, WS_WMLT = 14 * MiB, WS_WOUTT = 15 * MiB, WS_WCT = 17 * MiB, WS_IFG = 21 * MiB;
constexpr size_t WS_U8 = 24 * MiB, WS_V8 = 40 * MiB, WS_USC = 22 * MiB, WS_VSC = 23 * MiB;
constexpr size_t WS_XN = 88 * MiB, WS_QC = 88 * MiB, WS_KC = 120 * MiB;
constexpr size_t WS_SBQKV = 152 * MiB  , WS_VT = 216 * MiB  , WS_MLQK = 248 * MiB, WS_MLV = 312 * MiB, WS_MLO = 344 * MiB, WS_GATES = 376 * MiB;
constexpr size_t WS_MERGED = 216 * MiB, WS_H = 88 * MiB, WS_HN = 216 * MiB, WS_IDX = 280 * MiB, WS_GATE = 296 * MiB, WS_SC = 312 * MiB;
constexpr size_t WS_PART = 312 * MiB  , WS_SSQ = 504 * MiB  , WS_COEF = 56 * MiB  , WS_YB = 152 * MiB  , WS_HN8 = 440 * MiB  , WS_XS = 505 * MiB  , WS_SS = 506 * MiB  ;
constexpr size_t WS_END = 508 * MiB;
constexpr int CW_BAR = 4096, CW_Q = 8192;

constexpr int RING_OFF = 0, RING_BYTES = 135168;
constexpr int LDSCTL_OFF = RING_BYTES, MISC_OFF = LDSCTL_OFF + 320;
constexpr int LDS_BYTES = 147456;

#define GAS __attribute__((address_space(1)))
#define LAS __attribute__((address_space(3)))
typedef unsigned short bf16;
typedef unsigned v4u __attribute__((ext_vector_type(4)));
typedef unsigned v2u __attribute__((ext_vector_type(2)));
typedef float f32x4 __attribute__((ext_vector_type(4)));
#define LDS_WAIT() asm volatile("s_waitcnt lgkmcnt(0)" ::: "memory")
#define VM_WAIT() asm volatile("s_waitcnt vmcnt(0)" ::: "memory")
typedef float f32x2_t __attribute__((ext_vector_type(2))); typedef __bf16 bf16x2_t __attribute__((ext_vector_type(2)));
__device__ __forceinline__ unsigned cvtpk(float lo, float hi) { f32x2_t v = {lo, hi}; bf16x2_t b = __builtin_convertvector(v, bf16x2_t); return __builtin_bit_cast(unsigned, b); }
__device__ __forceinline__ unsigned f2bf(float f) { return cvtpk(f, f) & 0xffffu; }
__device__ __forceinline__ unsigned pk2(float lo, float hi) { return cvtpk(lo, hi); }
__device__ __forceinline__ float bflo(unsigned u) { return __builtin_bit_cast(float, u << 16); }
__device__ __forceinline__ float bfhi(unsigned u) { return __builtin_bit_cast(float, u & 0xffff0000u); }
__device__ __forceinline__ float bf2f(bf16 b) { return __builtin_bit_cast(float, (unsigned)b << 16); }
__device__ __forceinline__ float fexp(float x) { return __builtin_amdgcn_exp2f(x * 1.4426950408889634f); }
__device__ __forceinline__ float flog(float x) { return __builtin_amdgcn_logf(x) * 0.6931471805599453f; }
__device__ __forceinline__ float frcp(float x) { return __builtin_amdgcn_rcpf(x); }
__device__ __forceinline__ float frsq(float x) { return __builtin_amdgcn_rsqf(x); }
__device__ __forceinline__ float sigmoidf_(float x) { return frcp(1.f + fexp(-x)); }
__device__ __forceinline__ float wave_sum(float v) {
#pragma unroll
    for (int o = 1; o < 64; o <<= 1) v += __shfl_xor(v, o);
    return v;
}
__device__ __forceinline__ unsigned wave_max_u(unsigned v) {
#pragma unroll
    for (int o = 1; o < 64; o <<= 1) { const unsigned w = (unsigned)__shfl_xor((int)v, o); v = v > w ? v : w; }
    return v;
}
struct F8 { float v[8]; };
__device__ __forceinline__ void unpack8(const v4u& u, float (&f)[8]) {
    f[0] = bflo(u.x); f[1] = bfhi(u.x); f[2] = bflo(u.y); f[3] = bfhi(u.y); f[4] = bflo(u.z); f[5] = bfhi(u.z); f[6] = bflo(u.w); f[7] = bfhi(u.w);
}
__device__ __forceinline__ v4u pack8(const float (&f)[8]) { v4u o; o.x = pk2(f[0], f[1]); o.y = pk2(f[2], f[3]); o.z = pk2(f[4], f[5]); o.w = pk2(f[6], f[7]); return o; }

#define XB_TMO      128
#define XB_XCNT(j)  (256  + 64 * (j))
#define XB_XSUB(j)  (1280 + 64 * (j))
#define XB_XGEN(j)  (2304 + 64 * (j))
#define XB_TOP      3328
#define XB_TOPGEN   3392
#define XCD_BAR_WORDS 3456
#define XB_SPIN_CAP (1u << 24)

__device__ __forceinline__ unsigned xb_ld(unsigned* p)              { return __hip_atomic_load(p, __ATOMIC_RELAXED, __HIP_MEMORY_SCOPE_AGENT); }
__device__ __forceinline__ unsigned xb_add(unsigned* p, unsigned v) { return __hip_atomic_fetch_add(p, v, __ATOMIC_RELAXED, __HIP_MEMORY_SCOPE_AGENT); }
__device__ __forceinline__ unsigned xb_xcc_id() { return (unsigned)__builtin_amdgcn_s_getreg((3 << 11) | 20) & 0xFu; }
#define XB_SPIN(cond, bar) do { unsigned _sp = 0; while (cond) { __builtin_amdgcn_s_sleep(1); \
    if ((++_sp & 255u) == 0u) { if (xb_ld(&(bar)[XB_TMO])) break; if (_sp > XB_SPIN_CAP) { atomicAdd(&(bar)[XB_TMO], 1u); break; } } } } while (0)

struct XcdBarrier {
    unsigned* bar; unsigned x;
    volatile LAS unsigned* st;
};

__device__ __forceinline__ XcdBarrier xcd_barrier_post(unsigned* bar, volatile LAS unsigned* st) {
    XcdBarrier b; b.bar = bar; b.x = xb_xcc_id(); b.st = st;
    if (threadIdx.x == 0) (void)xb_add(&bar[XB_XCNT(b.x)], 1u);
    return b;
}
__device__ __forceinline__ void xcd_barrier_complete(unsigned* bar, unsigned x, unsigned& nloc, unsigned& nx) {
    const unsigned G = gridDim.x * gridDim.y * gridDim.z;
    unsigned sum, cnt, mine, sp = 0u;
    for (;;) {
        sum = 0u; cnt = 0u; mine = 0u;
#pragma unroll
        for (unsigned j = 0; j < 16; ++j) { const unsigned c = xb_ld(&bar[XB_XCNT(j)]); sum += c; cnt += (c > 0u) ? 1u : 0u; mine = (j == x) ? c : mine; }
        if (sum == G) break;
        __builtin_amdgcn_s_sleep(1);
        if ((++sp & 255u) == 0u) { if (xb_ld(&bar[XB_TMO])) break; if (sp > XB_SPIN_CAP) { atomicAdd(&bar[XB_TMO], 1u); break; } }
    }
    nloc = mine > 0u ? mine : 1u; nx = cnt > 0u ? cnt : 1u;
}

__device__ __forceinline__ void xcd_barrier(const XcdBarrier& b) {
    asm volatile("s_waitcnt vmcnt(0)" ::: "memory");
    __syncthreads();
    if (threadIdx.x == 0) {
        unsigned* bar = b.bar;
        __builtin_amdgcn_s_waitcnt(0);
        unsigned nloc = b.st[0], nx = b.st[1];
        if (nloc == 0u) { xcd_barrier_complete(bar, b.x, nloc, nx); b.st[0] = nloc; b.st[1] = nx; }
        const unsigned old = xb_add(&bar[XB_XSUB(b.x)], 1u);
        const unsigned gen = old / nloc;
        if (old + 1u == (gen + 1u) * nloc) {
            __builtin_amdgcn_fence(__ATOMIC_RELEASE, "agent");
            asm volatile("s_waitcnt vmcnt(0)" ::: "memory");
            const unsigned og = xb_add(&bar[XB_TOP], 1u);
            const unsigned tg = og / nx;
            if (og + 1u == (tg + 1u) * nx) xb_add(&bar[XB_TOPGEN], 1u);
            else XB_SPIN(xb_ld(&bar[XB_TOPGEN]) == tg, bar);
            __builtin_amdgcn_fence(__ATOMIC_ACQUIRE, "agent");
            xb_add(&bar[XB_XGEN(b.x)], 1u);
            asm volatile("s_waitcnt vmcnt(0)" ::: "memory");
        } else {
            XB_SPIN(xb_ld(&bar[XB_XGEN(b.x)]) == gen, bar);
            __builtin_amdgcn_fence(__ATOMIC_ACQUIRE, "agent");
            asm volatile("s_waitcnt vmcnt(0)" ::: "memory");
        }
    }
    __syncthreads();
}

struct EpiProj {
    bf16 *sbqk, *vt, *mlqk, *mlv, *mlo, *gates;
    __device__ __forceinline__ void operator()(int row, int col, const F8& a) const {
        bf16* dst;
        if (col < 1024) dst = sbqk + (size_t)row * 1024 + col;
        else if (col < 1536) {
            const int c = col - 1024, hh = c >> 6, d = c & 63, b = row >> 11, sq = row & 2047;
            bf16* vp = vt + ((size_t)(b * 8 + hh) * 64 + d) * 2048 + sq;
#pragma unroll
            for (int i = 0; i < 8; ++i) vp[(size_t)i * 2048] = (bf16)f2bf(a.v[i]);
            return;
        }
        else if (col < 2560) dst = mlqk + (size_t)row * 1024 + (col - 1536);
        else if (col < 3072) dst = mlv + (size_t)row * 512 + (col - 2560);
        else if (col < 3584) dst = mlo + (size_t)row * 512 + (col - 3072);
        else {
            unsigned q[8];
#pragma unroll
            for (int i = 0; i < 8; ++i) { const float sg = sigmoidf_(a.v[i]) * 255.f + 0.5f; q[i] = (unsigned)fminf(fmaxf(sg, 1.f), 255.f); }
            *(v2u*)((unsigned char*)gates + (size_t)row * 2048 + (col - 3584)) = (v2u){q[0] | (q[1] << 8) | (q[2] << 16) | (q[3] << 24), q[4] | (q[5] << 8) | (q[6] << 16) | (q[7] << 24)};
            return;
        }
        *(v4u*)dst = pack8(a.v);
    }
};
struct EpiMergeA {
    bf16* merged; const bf16* gates;
    __device__ __forceinline__ void operator()(int row, int col, const F8& a) const {
        float g[8], o[8]; unpack8(*(const v4u*)(gates + (size_t)row * 2048 + col), g);
#pragma unroll
        for (int i = 0; i < 8; ++i) o[i] = sigmoidf_(g[i]) * a.v[i];
        *(v4u*)(merged + (size_t)row * 1024 + col) = pack8(o);
    }
};
struct EpiMergeB {
    bf16* merged; const bf16* gates;
    __device__ __forceinline__ void operator()(int row, int col, const F8& a) const {
        float g[8], o[8]; unpack8(*(const v4u*)(gates + (size_t)row * 2048 + 1024 + col), g);
        unpack8(*(const v4u*)(merged + (size_t)row * 1024 + col), o);
#pragma unroll
        for (int i = 0; i < 8; ++i) o[i] += sigmoidf_(g[i]) * a.v[i];
        *(v4u*)(merged + (size_t)row * 1024 + col) = pack8(o);
    }
};
struct EpiH {
    float* h; const float* x;
    __device__ __forceinline__ void operator()(int row, int col, const F8& a) const {
        const f32x4 x0 = *(const f32x4*)(x + (size_t)row * 1024 + col), x1 = *(const f32x4*)(x + (size_t)row * 1024 + col + 4);
        *(f32x4*)(h + (size_t)row * 1024 + col) = (f32x4){x0.x + a.v[0], x0.y + a.v[1], x0.z + a.v[2], x0.w + a.v[3]};
        *(f32x4*)(h + (size_t)row * 1024 + col + 4) = (f32x4){x1.x + a.v[4], x1.y + a.v[5], x1.z + a.v[6], x1.w + a.v[7]};
    }
};
struct EpiF32 {
    float* o; int ldc;
    __device__ __forceinline__ void operator()(int row, int col, const F8& a) const {
        *(f32x4*)(o + (size_t)row * ldc + col) = (f32x4){a.v[0], a.v[1], a.v[2], a.v[3]};
        *(f32x4*)(o + (size_t)row * ldc + col + 4) = (f32x4){a.v[4], a.v[5], a.v[6], a.v[7]};
    }
};

template <class E> struct EpiAdapt {
    static constexpr bool PERM = true, AFTER_DRAIN = false;
    E e;
    __device__ __forceinline__ void operator()(const pg8::f32x4 (&acc)[2][2][4][2], const pg8::Unit& u, int wr, int wc, int fr, int fq) const {
#pragma unroll
        for (int ai = 0; ai < 2; ++ai)
#pragma unroll
            for (int m = 0; m < 4; ++m) {
                const int row = u.pm * 256 + ai * 128 + wr * 64 + m * 16 + fr;
#pragma unroll
                for (int bj = 0; bj < 2; ++bj) {
                    const int col = u.pn * 256 + bj * 128 + wc * 32 + 8 * fq;
                    F8 a; const pg8::f32x4 v0 = acc[ai][bj][m][0], v1 = acc[ai][bj][m][1];
                    a.v[0] = v0[0]; a.v[1] = v0[1]; a.v[2] = v0[2]; a.v[3] = v0[3]; a.v[4] = v1[0]; a.v[5] = v1[1]; a.v[6] = v1[2]; a.v[7] = v1[3];
                    e(row, col, a);
                }
            }
    }
};

struct EpiMerge1 {
    static constexpr bool PERM = true, AFTER_DRAIN = false;
    bf16* merged; const unsigned char* gates;
    static __device__ __forceinline__ void ub8(const v2u& w, float (&f)[8]) {
        f[0] = (float)(w.x & 0xffu); f[1] = (float)((w.x >> 8) & 0xffu); f[2] = (float)((w.x >> 16) & 0xffu); f[3] = (float)(w.x >> 24);
        f[4] = (float)(w.y & 0xffu); f[5] = (float)((w.y >> 8) & 0xffu); f[6] = (float)((w.y >> 16) & 0xffu); f[7] = (float)(w.y >> 24);
    }
    __device__ __forceinline__ void mid(pg8::f32x4 (&acc)[2][2][4][2], const pg8::Unit& u, int wr, int wc, int fr, int fq) const {
#pragma unroll
        for (int ai = 0; ai < 2; ++ai)
#pragma unroll
            for (int m = 0; m < 4; ++m) {
                const int row = u.pm * 256 + ai * 128 + wr * 64 + m * 16 + fr;
#pragma unroll
                for (int bj = 0; bj < 2; ++bj) {
                    const int col = u.pn * 256 + bj * 128 + wc * 32 + 8 * fq;
                    float gs[8], gm[8]; ub8(*(const v2u*)(gates + (size_t)row * 2048 + col), gs); ub8(*(const v2u*)(gates + (size_t)row * 2048 + 1024 + col), gm);
#pragma unroll
                    for (int i = 0; i < 8; ++i) acc[ai][bj][m][i >> 2][i & 3] *= gs[i] * frcp(gm[i]);
                }
            }
    }
    __device__ __forceinline__ void operator()(const pg8::f32x4 (&acc)[2][2][4][2], const pg8::Unit& u, int wr, int wc, int fr, int fq) const {
#pragma unroll
        for (int ai = 0; ai < 2; ++ai)
#pragma unroll
            for (int m = 0; m < 4; ++m) {
                const int row = u.pm * 256 + ai * 128 + wr * 64 + m * 16 + fr;
#pragma unroll
                for (int bj = 0; bj < 2; ++bj) {
                    const int col = u.pn * 256 + bj * 128 + wc * 32 + 8 * fq;
                    float gm[8], o[8]; ub8(*(const v2u*)(gates + (size_t)row * 2048 + 1024 + col), gm);
#pragma unroll
                    for (int i = 0; i < 8; ++i) o[i] = gm[i] * (1.f / 255.f) * acc[ai][bj][m][i >> 2][i & 3];
                    *(v4u*)(merged + (size_t)row * 1024 + col) = pack8(o);
                }
            }
    }
};
struct EpiHW {
    static constexpr bool PERM = true, AFTER_DRAIN = false;
    bf16* h; const float* x; bf16* hw; const float* wffn; float* ss;
    __device__ __forceinline__ void operator()(const pg8::f32x4 (&acc)[2][2][4][2], const pg8::Unit& u, int wr, int wc, int fr, int fq) const {
#pragma unroll
        for (int ai = 0; ai < 2; ++ai)
#pragma unroll
            for (int m = 0; m < 4; ++m) {
                const int row = u.pm * 256 + ai * 128 + wr * 64 + m * 16 + fr;
                float sq = 0.f;
#pragma unroll
                for (int bj = 0; bj < 2; ++bj) {
                    const int col = u.pn * 256 + bj * 128 + wc * 32 + 8 * fq;
                    const size_t o = (size_t)row * 1024 + col;
                    const f32x4 x0 = *(const f32x4*)(x + o), x1 = *(const f32x4*)(x + o + 4);
                    const f32x4 w0 = *(const f32x4*)(wffn + col), w1 = *(const f32x4*)(wffn + col + 4);
                    const pg8::f32x4 v0 = acc[ai][bj][m][0], v1 = acc[ai][bj][m][1];
                    const f32x4 h0 = (f32x4){x0.x + v0[0], x0.y + v0[1], x0.z + v0[2], x0.w + v0[3]}, h1 = (f32x4){x1.x + v1[0], x1.y + v1[1], x1.z + v1[2], x1.w + v1[3]};
                    *(v4u*)(h + o) = (v4u){pk2(h0.x, h0.y), pk2(h0.z, h0.w), pk2(h1.x, h1.y), pk2(h1.z, h1.w)};
                    *(v4u*)(hw + o) = (v4u){pk2(h0.x * w0.x, h0.y * w0.y), pk2(h0.z * w0.z, h0.w * w0.w), pk2(h1.x * w1.x, h1.y * w1.y), pk2(h1.z * w1.z, h1.w * w1.w)};
                    sq += (h0.x * h0.x + h0.y * h0.y) + (h0.z * h0.z + h0.w * h0.w) + (h1.x * h1.x + h1.y * h1.y) + (h1.z * h1.z + h1.w * h1.w);
                }
                sq += __shfl_xor(sq, 16); sq += __shfl_xor(sq, 32);
                if (fq == 0) ss[(size_t)row * 16 + u.pn * 4 + wc] = sq;
            }
    }
};

template <class E>
__device__ __forceinline__ void simple_gemm(LAS unsigned char* lds, const bf16* A, const bf16* Bt, int M, int N, int K, const E& e) {
    LAS float* As = (LAS float*)lds;
    LAS float* Bs = As + 32 * 132;
    const int tid = threadIdx.x, ty = tid >> 4, tx = tid & 15;
    const int ntn = N / 128, ntiles = (M / 128) * ntn;
    for (int tile = blockIdx.x; tile < ntiles; tile += gridDim.x) {
        const int tm = tile / ntn, tn = tile % ntn;
        float acc[4][8];
#pragma unroll
        for (int i = 0; i < 4; ++i)
#pragma unroll
            for (int j = 0; j < 8; ++j) acc[i][j] = 0.f;
        for (int k0 = 0; k0 < K; k0 += 32) {
            {
                const int r = tid >> 2, kq = (tid & 3) * 8;
                float fa[8], fb[8];
                unpack8(*(const v4u*)(A + (size_t)(tm * 128 + r) * K + k0 + kq), fa);
                unpack8(*(const v4u*)(Bt + (size_t)(tn * 128 + r) * K + k0 + kq), fb);
#pragma unroll
                for (int i = 0; i < 8; ++i) { As[(kq + i) * 132 + r] = fa[i]; Bs[(kq + i) * 132 + r] = fb[i]; }
            }
            __syncthreads();
#pragma unroll 8
            for (int k = 0; k < 32; ++k) {
                const f32x4 a4 = *(const LAS f32x4*)(As + k * 132 + ty * 4);
                const f32x4 b0 = *(const LAS f32x4*)(Bs + k * 132 + tx * 8), b1 = *(const LAS f32x4*)(Bs + k * 132 + tx * 8 + 4);
                const float av[4] = {a4.x, a4.y, a4.z, a4.w};
                const float bv[8] = {b0.x, b0.y, b0.z, b0.w, b1.x, b1.y, b1.z, b1.w};
#pragma unroll
                for (int i = 0; i < 4; ++i)
#pragma unroll
                    for (int j = 0; j < 8; ++j) acc[i][j] += av[i] * bv[j];
            }
            __syncthreads();
        }
#pragma unroll
        for (int i = 0; i < 4; ++i) {
            F8 a;
#pragma unroll
            for (int j = 0; j < 8; ++j) a.v[j] = acc[i][j];
            e(tm * 128 + ty * 4 + i, tn * 128 + tx * 8, a);
        }
    }
}

template <class E>
__device__ __forceinline__ void gemm(LAS unsigned char* lds, const bf16* A, const bf16* Bt, int M, int N, int K, const E& e) {
#if USE_PG8
    pg8::Gemm g{A, Bt, M, N, K}; pg8::StaticOrder S; S.init(M, N, (int)gridDim.x, (int)blockIdx.x);
    EpiAdapt<E> ea{e};
    pg8::gemm_phase<EpiAdapt<E>, pg8::StaticOrder, true, true>(lds, g, S, ea);
#else
    simple_gemm<E>(lds, A, Bt, M, N, K, e);
#endif
}

__device__ __forceinline__ void transpose_item(const float* W, int ldw, int K, bf16* WT, int src_col0, int dst_row0, LAS float* scr, int kb, int lane) {
    const int k0 = 64 * kb;
#pragma unroll 8
    for (int i = 0; i < 32; ++i) { const int kk = 2 * i + (lane >> 5); scr[kk * 33 + (lane & 31)] = W[(size_t)(k0 + kk) * ldw + src_col0 + (lane & 31)]; }
    LDS_WAIT(); asm volatile("" ::: "memory");
    const int c = lane & 7;
#pragma unroll
    for (int j = 0; j < 4; ++j) { const int n = (lane >> 3) + 8 * j; const LAS float* s = scr + (8 * c) * 33 + n;
        v4u o; o.x = pk2(s[0 * 33], s[1 * 33]); o.y = pk2(s[2 * 33], s[3 * 33]); o.z = pk2(s[4 * 33], s[5 * 33]); o.w = pk2(s[6 * 33], s[7 * 33]);
        *(v4u*)(WT + (size_t)(dst_row0 + n) * K + k0 + 8 * c) = o; }
    LDS_WAIT(); asm volatile("" ::: "memory");
}

struct P {
    const float *x, *norm_mix_w, *w_in, *conv_w, *conv_b, *b_i, *b_f, *ml_norm_w, *w_sb, *w_ml, *w_out, *norm_ffn_w, *w_query, *keys1, *keys2, *peer_u, *peer_v, *norm_final_w;
    float* out; unsigned char* ws;
};

__device__ __forceinline__ void p0_prologue(const P& p, LAS unsigned char* lds, int wave, int lane) {
    LAS float* scr = (LAS float*)(lds + wave * 8448);
    const int gw = blockIdx.x * NWAVES + wave, NGW = gridDim.x * NWAVES;
    bf16* W1T = (bf16*)(p.ws + WS_W1T); bf16* WSBT = (bf16*)(p.ws + WS_WSBT); bf16* WMLT = (bf16*)(p.ws + WS_WMLT); bf16* WOUTT = (bf16*)(p.ws + WS_WOUTT); bf16* WCT = (bf16*)(p.ws + WS_WCT);
    constexpr int I_1 = 16 * 176, I_SB = 8 * 32, I_ML = 8 * 32, I_O = 16 * 32, NT = I_1 + I_SB + I_ML + I_O;
    for (int it = gw; it < NT; it += NGW) {
        int r = it;
        if (r < I_1) { const int kb = r / 176, nb = r % 176, n0 = nb * 32; transpose_item(p.w_in, INC, 1024, W1T, n0 < 3584 ? n0 : n0 + 8, n0, scr, kb, lane); continue; } r -= I_1;
        if (r < I_SB) { const int kb = r / 32, nb = r % 32; transpose_item(p.w_sb, 1024, 1024, WSBT, nb * 32, nb * 32, scr, kb, lane);             continue; } r -= I_SB;
        if (r < I_ML) { const int kb = r / 32, nb = r % 32; transpose_item(p.w_ml, 1024, 1024, WSBT + 512, nb * 32, nb * 32, scr, kb, lane); continue; } r -= I_ML;
        { const int kb = r / 32, nb = r % 32; transpose_item(p.w_out, 1024, 1024, WOUTT, nb * 32, nb * 32, scr, kb, lane); }
    }
    bf16* XN = (bf16*)(p.ws + WS_XN); float* IFG = (float*)(p.ws + WS_IFG);
    LAS float* WG = (LAS float*)(lds + 8 * 8448);
    __syncthreads();
    for (int i = threadIdx.x; i < 2048; i += NTHR) { const int k = i >> 1, hf = i & 1; *(LAS f32x4*)(WG + k * 8 + hf * 4) = *(const f32x4*)(p.w_in + (size_t)k * INC + 3584 + hf * 4); }
    __syncthreads();
    for (int m0 = gw * 2; m0 < T_; m0 += NGW * 2) {
        const f32x4* wr = (const f32x4*)p.norm_mix_w + lane;
        f32x4 v[2][4]; float ss[2] = {0.f, 0.f};
#pragma unroll
        for (int u = 0; u < 2; ++u) { const f32x4* xr = (const f32x4*)(p.x + (size_t)(m0 + u) * 1024) + lane;
#pragma unroll
            for (int j = 0; j < 4; ++j) v[u][j] = xr[64 * j]; }
#pragma unroll
        for (int u = 0; u < 2; ++u)
#pragma unroll
            for (int j = 0; j < 4; ++j) ss[u] += (v[u][j].x * v[u][j].x + v[u][j].y * v[u][j].y) + (v[u][j].z * v[u][j].z + v[u][j].w * v[u][j].w);
#pragma unroll
        for (int o = 1; o < 64; o <<= 1) { ss[0] += __shfl_xor(ss[0], o); ss[1] += __shfl_xor(ss[1], o); }
#pragma unroll
        for (int u = 0; u < 2; ++u) {
            const int m = m0 + u;
            const float rstd = frsq(ss[u] * (1.f / 1024.f) + EPS);
            float g[8];
#pragma unroll
            for (int i = 0; i < 8; ++i) g[i] = 0.f;
            v2u* o8 = (v2u*)(XN + (size_t)m * 1024) + lane;
#pragma unroll
            for (int j = 0; j < 4; ++j) {
                const f32x4 w = wr[64 * j];
                const float y[4] = {v[u][j].x * rstd * w.x, v[u][j].y * rstd * w.y, v[u][j].z * rstd * w.z, v[u][j].w * rstd * w.w};
                o8[64 * j] = (v2u){pk2(y[0], y[1]), pk2(y[2], y[3])};
#pragma unroll
                for (int q = 0; q < 4; ++q) {
                    const int k = 256 * j + 4 * lane + q;
                    const f32x4 w0 = *(const LAS f32x4*)(WG + k * 8), w1 = *(const LAS f32x4*)(WG + k * 8 + 4);
                    g[0] += y[q] * w0.x; g[1] += y[q] * w0.y; g[2] += y[q] * w0.z; g[3] += y[q] * w0.w;
                    g[4] += y[q] * w1.x; g[5] += y[q] * w1.y; g[6] += y[q] * w1.z; g[7] += y[q] * w1.w;
                }
            }
            {
                const bool b5 = (lane & 32) != 0, b4 = (lane & 16) != 0, b3 = (lane & 8) != 0;
                float e4[4], f2[2], gs;
#pragma unroll
                for (int i = 0; i < 4; ++i) { const float keep = b5 ? g[2 * i + 1] : g[2 * i], send = b5 ? g[2 * i] : g[2 * i + 1]; e4[i] = keep + __shfl_xor(send, 32); }
#pragma unroll
                for (int i = 0; i < 2; ++i) { const float keep = b4 ? e4[2 * i + 1] : e4[2 * i], send = b4 ? e4[2 * i] : e4[2 * i + 1]; f2[i] = keep + __shfl_xor(send, 16); }
                { const float keep = b3 ? f2[1] : f2[0], send = b3 ? f2[0] : f2[1]; gs = keep + __shfl_xor(send, 8); }
                gs += __shfl_xor(gs, 4); gs += __shfl_xor(gs, 2); gs += __shfl_xor(gs, 1);
                const int gi = 4 * (b3 ? 1 : 0) + 2 * (b4 ? 1 : 0) + (b5 ? 1 : 0);
                if ((lane & 7) == 0) IFG[(size_t)m * 8 + gi] = gs + (gi < 4 ? p.b_i[gi] : p.b_f[gi - 4]);
            }
        }
    }
}

__device__ __forceinline__ void fill_wc(const P& p, int it, int lane) {
    bf16* WCT = (bf16*)(p.ws + WS_WCT);
    const int hhf = it >> 6, kb = (it >> 2) & 15, kq = it & 3, head = hhf >> 1, half = hhf & 1, k = kb * 64 + lane;
    const f32x4* wq = (const f32x4*)(p.w_query + (size_t)k * 2048 + head * 256 + half * 128);
    f32x4 wr[32];
#pragma unroll
    for (int i = 0; i < 32; ++i) wr[i] = wq[i];
    const float* kbase = (half ? p.keys2 : p.keys1) + ((size_t)head * 128 + kq * 32) * 128;
#pragma unroll 1
    for (int key = 0; key < 32; ++key) {
        const f32x4* kr = (const f32x4*)(kbase + (size_t)key * 128);
        float a0 = 0.f, a1 = 0.f;
#pragma unroll
        for (int i = 0; i < 32; i += 2) { const f32x4 b0 = kr[i], b1 = kr[i + 1];
            a0 += wr[i].x * b0.x + wr[i].y * b0.y + wr[i].z * b0.z + wr[i].w * b0.w;
            a1 += wr[i + 1].x * b1.x + wr[i + 1].y * b1.y + wr[i + 1].z * b1.z + wr[i + 1].w * b1.w; }
        WCT[(size_t)(hhf * 128 + kq * 32 + key) * 1024 + k] = (bf16)f2bf(a0 + a1);
    }
}
__device__ __forceinline__ void fill_tables(const P& p, int e, int lane) {
    unsigned char* U8 = p.ws + WS_U8; unsigned char* V8 = p.ws + WS_V8; float* USC = (float*)(p.ws + WS_USC); float* VSC = (float*)(p.ws + WS_VSC);
    f32x4 v[2][4]; float am[2] = {0.f, 0.f};
#pragma unroll
    for (int which = 0; which < 2; ++which) {
        const float* src = (which ? p.peer_v : p.peer_u) + (size_t)e * 1024 + 16 * lane;
#pragma unroll
        for (int j = 0; j < 4; ++j) v[which][j] = *(const f32x4*)(src + 4 * j);
    }
#pragma unroll
    for (int which = 0; which < 2; ++which)
#pragma unroll
        for (int j = 0; j < 4; ++j) am[which] = fmaxf(am[which], fmaxf(fmaxf(fabsf(v[which][j].x), fabsf(v[which][j].y)), fmaxf(fabsf(v[which][j].z), fabsf(v[which][j].w))));
#pragma unroll
    for (int o = 1; o < 64; o <<= 1) { am[0] = fmaxf(am[0], __shfl_xor(am[0], o)); am[1] = fmaxf(am[1], __shfl_xor(am[1], o)); }
#pragma unroll
    for (int which = 0; which < 2; ++which) {
        const float sc = am[which] > 0.f ? exp2f(floorf(log2f(448.f / am[which]))) : 1.f;
        unsigned w[4];
#pragma unroll
        for (int j = 0; j < 4; ++j) { int t = __builtin_amdgcn_cvt_pk_fp8_f32(v[which][j].x * sc, v[which][j].y * sc, 0, false); t = __builtin_amdgcn_cvt_pk_fp8_f32(v[which][j].z * sc, v[which][j].w * sc, t, true); w[j] = (unsigned)t; }
        *(v4u*)((which ? V8 : U8) + ((size_t)(lane >> 3) * NEXP + e) * 128 + 16 * (lane & 7)) = (v4u){w[0], w[1], w[2], w[3]};
        if (lane == 0) (which ? VSC : USC)[e] = 1.f / sc;
    }
}
constexpr int N_FILL = 128 + 1024;
__device__ __forceinline__ void fill_item(const P& p, int item, int wave, int lane) {
    if (item < 128) fill_wc(p, item * 8 + wave, lane);
    else { const int e0 = (item - 128) * 16 + wave * 2; fill_tables(p, e0, lane); fill_tables(p, e0 + 1, lane); }
}

typedef short bf16x8 __attribute__((ext_vector_type(8)));
typedef float f32x16 __attribute__((ext_vector_type(16)));
#define MFMA32(a, b, c) __builtin_amdgcn_mfma_f32_32x32x16_bf16((a), (b), (c), 0, 0, 0)
__device__ __forceinline__ int crow(int reg, int hh) { return (reg & 3) + 8 * (reg >> 2) + 4 * hh; }
template <int S> __device__ __forceinline__ bf16x8 pack_step(const f32x16& x) {
    v4u p; p.x = cvtpk(x[8 * S], x[8 * S + 1]); p.y = cvtpk(x[8 * S + 2], x[8 * S + 3]); p.z = cvtpk(x[8 * S + 4], x[8 * S + 5]); p.w = cvtpk(x[8 * S + 6], x[8 * S + 7]);
    return __builtin_bit_cast(bf16x8, p);
}
__device__ __forceinline__ bf16x8 frag2(const v2u& lo, const v2u& hi) { v4u p; p.x = lo.x; p.y = lo.y; p.z = hi.x; p.w = hi.y; return __builtin_bit_cast(bf16x8, p); }
__device__ __forceinline__ f32x16 zero16() { f32x16 z; for (int i = 0; i < 16; ++i) z[i] = 0.f; return z; }


__device__ __forceinline__ void p2_conv(const P& p, int tid) {
    const bf16* MLQK = (const bf16*)(p.ws + WS_MLQK); bf16* QC = (bf16*)(p.ws + WS_QC); bf16* KC = (bf16*)(p.ws + WS_KC);
    const int cg = tid & 127, ch0 = 8 * cg;
    float cw[4][8], cb[8];
#pragma unroll
    for (int i = 0; i < 8; ++i) { cb[i] = p.conv_b[ch0 + i];
#pragma unroll
        for (int j = 0; j < 4; ++j) cw[j][i] = p.conv_w[j * 1024 + ch0 + i]; }
    const float osc = cg >= 64 ? 0.08838834764831845f : 1.f;
    bf16* dst = (cg >= 64 ? KC : QC) + (cg & 63) * 8;
    for (int rg = blockIdx.x * 4 + (tid >> 7); rg < T_ / 4; rg += gridDim.x * 4) {
        const int tok = rg * 4, pos0 = tok & (S_ - 1);
        v4u xr[7];
#pragma unroll
        for (int k = 0; k < 7; ++k) xr[k] = (pos0 + k - 3 >= 0) ? *(const v4u*)(MLQK + (size_t)(tok + k - 3) * 1024 + ch0) : (v4u){0u, 0u, 0u, 0u};
#pragma unroll
        for (int tt = 0; tt < 4; ++tt) {
            float y[8];
#pragma unroll
            for (int i = 0; i < 8; ++i) y[i] = cb[i];
#pragma unroll
            for (int j = 0; j < 4; ++j) { float f[8]; unpack8(xr[tt + j], f);
#pragma unroll
                for (int i = 0; i < 8; ++i) y[i] += cw[j][i] * f[i]; }
#pragma unroll
            for (int i = 0; i < 8; ++i) y[i] = y[i] * sigmoidf_(y[i]) * osc;
            *(v4u*)(dst + (size_t)(tok + tt) * 512) = pack8(y);
        }
    }
}

constexpr int ML_QS = 0, ML_KS = 17408, ML_KWT = 34816, ML_VTL = 53248, ML_PS = 71680, ML_CT = 80896, ML_SCAL = 115712, ML_SSP = 118272, ML_QN = ML_SSP + 512, ML_F1 = ML_QN + 256, ML_F2 = ML_F1 + 256, ML_NV = ML_F2 + 256;
static_assert(ML_NV + 512 <= RING_BYTES, "mLSTM LDS map");
__device__ __forceinline__ void mlstm_scal(float ip, float fp, LAS float* sc, float& m_carry, int lane) {
    const float lf = fminf(fp, 0.f) - flog(1.f + fexp(-fabsf(fp)));
    float bc = lf;
#pragma unroll
    for (int o = 1; o < 64; o <<= 1) { const float t2 = __shfl_up(bc, o); if (lane >= o) bc += t2; }
    const float a = ip - bc; float pm = a;
#pragma unroll
    for (int o = 1; o < 64; o <<= 1) { const float t2 = __shfl_up(pm, o); if (lane >= o) pm = fmaxf(pm, t2); }
    const float M = fmaxf(m_carry, pm);
    const float M63 = __shfl(M, 63), bc63 = __shfl(bc, 63);
    sc[lane] = a; sc[64 + lane] = M; sc[128 + lane] = fexp(a - M63); sc[192 + lane] = fexp(m_carry - M); sc[256 + lane] = fexp(-(bc + M));
    m_carry = bc63 + M63;
}
__device__ __forceinline__ void mlstm_item(const P& p, LAS unsigned char* lds, int item, int tid, int wave, int lane) {
    const int b = item >> 2, h = item & 3;
    const int r = lane & 31, hh = lane >> 5, et = wave & 3, th = wave >> 2;
    const bf16* QC = (const bf16*)(p.ws + WS_QC); const bf16* KC = (const bf16*)(p.ws + WS_KC); const bf16* MLV = (const bf16*)(p.ws + WS_MLV); const float* IFG = (const float*)(p.ws + WS_IFG);
    bf16* HML = (bf16*)p.out + 512;
    LAS float* SCAL = (LAS float*)(lds + ML_SCAL); LAS float* SSP = (LAS float*)(lds + ML_SSP); LAS float* QN = (LAS float*)(lds + ML_QN);
    LAS float* F1 = (LAS float*)(lds + ML_F1); LAS float* F2 = (LAS float*)(lds + ML_F2); LAS float* NV = (LAS float*)(lds + ML_NV);
    const int cg = tid & 15, trow = tid >> 4, eg = cg, sl = trow;
    const size_t hq = (size_t)h * 128 + 8 * cg;
    for (int i = tid; i < (128 * 136 * 2) / 4; i += NTHR) ((LAS unsigned*)(lds + ML_CT))[i] = 0u;
    if (tid < 128) NV[tid] = 0.f;
    f32x16 accC[2]; accC[0] = zero16(); accC[1] = zero16();
    float m_carry = 0.f;
    if (wave == 3) { const size_t tk = (size_t)b * S_ + lane; mlstm_scal(IFG[tk * 8 + h], IFG[tk * 8 + 4 + h], SCAL, m_carry, lane); }
    v4u pq[2], pk[2], pv[2];
    {
        const size_t t0 = (size_t)b * S_;
#pragma unroll
        for (int u = 0; u < 2; ++u) { pq[u] = *(const v4u*)(QC + (t0 + trow + 32 * u) * 512 + hq); pk[u] = *(const v4u*)(KC + (t0 + trow + 32 * u) * 512 + hq); pv[u] = *(const v4u*)(MLV + (t0 + sl + 32 * u) * 512 + hq); }
    }
    float ipn = 0.f, fpn = 0.f;
    __syncthreads();
    for (int c = 0; c < 32; ++c) {
        const size_t tok0 = (size_t)b * S_ + c * 64;
        LAS float* sc = SCAL + (c & 1) * 320;
        {
#pragma unroll
            for (int u = 0; u < 2; ++u) {
                const int t = trow + 32 * u;
                *(LAS v4u*)(lds + ML_QS + t * 272 + cg * 16) = pq[u];
                *(LAS v4u*)(lds + ML_KS + t * 272 + cg * 16) = pk[u];
                float f[8]; unpack8(pk[u], f);
                const float wk = sc[128 + t];
#pragma unroll
                for (int i = 0; i < 8; ++i) *(LAS bf16*)(lds + ML_KWT + (8 * cg + i) * 144 + ((t ^ (8 * (cg & 7))) * 2)) = (bf16)f2bf(f[i] * wk);
                const unsigned vv[4] = {pv[u].x, pv[u].y, pv[u].z, pv[u].w};
#pragma unroll
                for (int i = 0; i < 4; ++i) {
                    *(LAS bf16*)(lds + ML_VTL + (8 * eg + 2 * i) * 144 + ((t ^ (8 * (eg & 7))) * 2)) = (bf16)(vv[i] & 0xffffu);
                    *(LAS bf16*)(lds + ML_VTL + (8 * eg + 2 * i + 1) * 144 + ((t ^ (8 * (eg & 7))) * 2)) = (bf16)(vv[i] >> 16);
                }
            }
            if (c + 1 < 32) {
                const size_t t1 = tok0 + 64;
#pragma unroll
                for (int u = 0; u < 2; ++u) { pq[u] = *(const v4u*)(QC + (t1 + trow + 32 * u) * 512 + hq); pk[u] = *(const v4u*)(KC + (t1 + trow + 32 * u) * 512 + hq); pv[u] = *(const v4u*)(MLV + (t1 + sl + 32 * u) * 512 + hq); }
                if (wave == 3) { ipn = IFG[(t1 + lane) * 8 + h]; fpn = IFG[(t1 + lane) * 8 + 4 + h]; }
            }
        }
        __syncthreads();
        f32x16 acc_inter = zero16();
        if (wave < 3) {
            const int tt = wave > 0 ? 1 : 0, st = wave == 2 ? 1 : 0;
            f32x16 zt = zero16();
#pragma unroll
            for (int ks = 0; ks < 8; ++ks) {
                const bf16x8 ka = *(const LAS bf16x8*)(lds + ML_KS + (32 * st + r) * 272 + 32 * ks + 16 * hh);
                const bf16x8 qb = *(const LAS bf16x8*)(lds + ML_QS + (32 * tt + r) * 272 + 32 * ks + 16 * hh);
                zt = MFMA32(ka, qb, zt);
            }
            const int t = 32 * tt + r; const float Mt = sc[64 + t];
            float ps = 0.f;
#pragma unroll
            for (int g = 0; g < 4; ++g) {
                const f32x4 av = *(const LAS f32x4*)(sc + 32 * st + 8 * g + 4 * hh);
                float pv[4];
#pragma unroll
                for (int q = 0; q < 4; ++q) { const int sidx = 32 * st + 8 * g + 4 * hh + q;
                    const float wgt = sidx <= t ? fexp(av[q] - Mt) : 0.f; pv[q] = zt[4 * g + q] * wgt; ps += pv[q]; }
                *(LAS v2u*)(lds + ML_PS + t * 144 + (32 * st + 8 * g + 4 * hh) * 2) = (v2u){cvtpk(pv[0], pv[1]), cvtpk(pv[2], pv[3])};
            }
            ps += __shfl_xor(ps, 32);
            if (hh == 0) { SSP[st * 64 + t] = ps; if (wave == 0) SSP[64 + t] = 0.f; }
        }
        if (wave == 3 && c + 1 < 32) mlstm_scal(ipn, fpn, SCAL + ((c + 1) & 1) * 320, m_carry, lane);
#pragma unroll
        for (int ks = 0; ks < 8; ++ks) {
            const bf16x8 qa = *(const LAS bf16x8*)(lds + ML_QS + (32 * th + r) * 272 + 32 * ks + 16 * hh);
            const bf16x8 cbf = *(const LAS bf16x8*)(lds + ML_CT + (32 * et + r) * 272 + 32 * ks + 16 * hh);
            acc_inter = MFMA32(qa, cbf, acc_inter);
        }
        {
            const int t = tid >> 3, part = tid & 7;
            float f[8], sum = 0.f;
            { const v4u tq = *(const LAS v4u*)(lds + ML_QS + t * 272 + part * 32); unpack8(tq, f); }
#pragma unroll
            for (int i = 0; i < 8; ++i) sum += f[i] * NV[16 * part + i];
            { const v4u tq = *(const LAS v4u*)(lds + ML_QS + t * 272 + part * 32 + 16); unpack8(tq, f); }
#pragma unroll
            for (int i = 0; i < 8; ++i) sum += f[i] * NV[16 * part + 8 + i];
            sum += __shfl_xor(sum, 1); sum += __shfl_xor(sum, 2); sum += __shfl_xor(sum, 4);
            if (part == 0) QN[t] = sum;
        }
        __syncthreads();
        f32x16 acc_intra = zero16();
#pragma unroll
        for (int ks = 0; ks < 4; ++ks) {
            if (ks < 2 || th == 1) {
                const bf16x8 pa = *(const LAS bf16x8*)(lds + ML_PS + (32 * th + r) * 144 + 32 * ks + 16 * hh);
                const bf16x8 vb = *(const LAS bf16x8*)(lds + ML_VTL + (32 * et + r) * 144 + 16 * ((2 * ks + hh) ^ (((32 * et + r) >> 3) & 7)));
                acc_intra = MFMA32(pa, vb, acc_intra);
            }
        }
        if (tid < 64) {
            const float wi = sc[192 + tid];
            const float den = SSP[tid] + SSP[64 + tid] + wi * QN[tid];
            const float f1 = frcp(fmaxf(fabsf(den), sc[256 + tid]));
            F1[tid] = f1; F2[tid] = wi * f1;
        }
        const float decay = sc[192 + 63];
#pragma unroll
        for (int dt = 0; dt < 2; ++dt) {
#pragma unroll
            for (int i = 0; i < 16; ++i) accC[dt][i] *= decay;
#pragma unroll
            for (int ks = 0; ks < 4; ++ks) {
                const bf16x8 ka = *(const LAS bf16x8*)(lds + ML_KWT + (64 * th + 32 * dt + r) * 144 + 16 * ((2 * ks + hh) ^ (((64 * th + 32 * dt + r) >> 3) & 7)));
                const bf16x8 vb = *(const LAS bf16x8*)(lds + ML_VTL + (32 * et + r) * 144 + 16 * ((2 * ks + hh) ^ (((32 * et + r) >> 3) & 7)));
                accC[dt] = MFMA32(ka, vb, accC[dt]);
            }
        }
        {
            const int d = tid >> 2, part = tid & 3;
            float f[8], sum = 0.f;
            { const v4u tq = *(const LAS v4u*)(lds + ML_KWT + d * 144 + part * 32); unpack8(tq, f); }
#pragma unroll
            for (int i = 0; i < 8; ++i) sum += f[i];
            { const v4u tq = *(const LAS v4u*)(lds + ML_KWT + d * 144 + part * 32 + 16); unpack8(tq, f); }
#pragma unroll
            for (int i = 0; i < 8; ++i) sum += f[i];
            sum += __shfl_xor(sum, 1); sum += __shfl_xor(sum, 2);
            if (part == 0) NV[d] = decay * NV[d] + sum;
        }
        __syncthreads();
        {
            bf16* hp = HML + (tok0 + 32 * th) * 1024 + h * 128 + 32 * et + r;
#pragma unroll
            for (int g = 0; g < 4; ++g) {
                const f32x4 f1v = *(const LAS f32x4*)(F1 + 32 * th + 8 * g + 4 * hh), f2v = *(const LAS f32x4*)(F2 + 32 * th + 8 * g + 4 * hh);
#pragma unroll
                for (int q = 0; q < 4; ++q) { const int tl = 8 * g + 4 * hh + q;
                    hp[(size_t)tl * 1024] = (bf16)f2bf(acc_intra[4 * g + q] * f1v[q] + acc_inter[4 * g + q] * f2v[q]); }
            }
#pragma unroll
            for (int dt = 0; dt < 2; ++dt)
#pragma unroll
                for (int g = 0; g < 4; ++g)
                    *(LAS v2u*)(lds + ML_CT + (32 * et + r) * 272 + (64 * th + 32 * dt + 8 * g + 4 * hh) * 2) = (v2u){cvtpk(accC[dt][4 * g], accC[dt][4 * g + 1]), cvtpk(accC[dt][4 * g + 2], accC[dt][4 * g + 3])};
        }
    }
    __syncthreads();
}

constexpr int SBW_KS = 144, SBW_VS = 80, SBW_VOFF = 32 * SBW_KS, SBW_BYTES = SBW_VOFF + 64 * SBW_VS;
static_assert(8 * SBW_BYTES <= RING_BYTES, "SBA per-wave LDS slices");
__device__ __forceinline__ void sba_wave_item(const bf16* __restrict__ QK, const bf16* __restrict__ VT, bf16* __restrict__ YSB, LAS unsigned char* wl, int b, int h, int qt, int lane) {
    const int r = lane & 31, hh = lane >> 5, t0 = qt * 32;
    const size_t rowbase = (size_t)b * S_;
    bf16x8 qf[4];
    {
        const bf16* qp = QK + (rowbase + t0 + r) * 1024 + h * 64 + 8 * hh;
#pragma unroll
        for (int ks = 0; ks < 4; ++ks) qf[ks] = *(const bf16x8*)(qp + 16 * ks);
    }
    bf16x8 tri[2];
#pragma unroll
    for (int s2 = 0; s2 < 2; ++s2)
#pragma unroll
        for (int j = 0; j < 8; ++j) { const int rho = 16 * s2 + 8 * (j >> 2) + 4 * hh + (j & 3); tri[s2][j] = (rho > r) ? (short)0x3F80 : (short)0; }
    f32x16 o0 = zero16(), o1 = zero16();
    float carry = 0.f;
    const bf16* kg = QK + (rowbase + (lane >> 3)) * 1024 + 512 + h * 64 + 8 * (lane & 7);
    const bf16* vg = VT + ((size_t)(b * 8 + h) * 64 + (lane >> 2)) * 2048 + 8 * (lane & 3);
    LAS unsigned char* kw = wl + (lane >> 3) * SBW_KS + 16 * (lane & 7);
    LAS unsigned char* vw = wl + SBW_VOFF + (lane >> 2) * SBW_VS + 16 * (lane & 3);
    const LAS unsigned char* kr = wl + r * SBW_KS + 16 * hh;
    const LAS unsigned char* vr = wl + SBW_VOFF + r * SBW_VS + 8 * hh;
    v4u kt[4], vt[4];
#pragma unroll
    for (int i = 0; i < 4; ++i) { kt[i] = *(const v4u*)(kg + (size_t)(t0 + 8 * i) * 1024); vt[i] = *(const v4u*)(vg + (size_t)(16 * i) * 2048 + t0); }
    for (int s0 = t0; s0 >= 0; s0 -= 32) {
#pragma unroll
        for (int i = 0; i < 4; ++i) { *(LAS v4u*)(kw + 8 * i * SBW_KS) = kt[i]; *(LAS v4u*)(vw + 16 * i * SBW_VS) = vt[i]; }
        const int sn = s0 >= 32 ? s0 - 32 : 0;
#pragma unroll
        for (int i = 0; i < 4; ++i) { kt[i] = *(const v4u*)(kg + (size_t)(sn + 8 * i) * 1024); vt[i] = *(const v4u*)(vg + (size_t)(16 * i) * 2048 + sn); }
        bf16x8 kf[4]; v2u vl[2][2], vh[2][2];
#pragma unroll
        for (int ks = 0; ks < 4; ++ks) kf[ks] = *(const LAS bf16x8*)(kr + 32 * ks);
#pragma unroll
        for (int dt = 0; dt < 2; ++dt)
#pragma unroll
            for (int s2 = 0; s2 < 2; ++s2) { const LAS unsigned char* vp = vr + dt * 32 * SBW_VS + 32 * s2; vl[dt][s2] = *(const LAS v2u*)vp; vh[dt][s2] = *(const LAS v2u*)(vp + 16); }
        f32x16 z = zero16();
#pragma unroll
        for (int ks = 0; ks < 4; ++ks) z = MFMA32(kf[ks], qf[ks], z);
        const bool diag = (s0 == t0);
        f32x16 sp; float rs = 0.f;
#pragma unroll
        for (int i = 0; i < 16; ++i) {
            const float zz = z[i] * 0.125f;
            const bool valid = !diag || (crow(i, hh) < r);
            float spv = fmaxf(zz, 0.f) + flog(1.f + fexp(-fabsf(zz)));
            spv = valid ? spv : 0.f;
            sp[i] = spv; rs += spv; z[i] = zz - spv;
        }
        f32x16 suf = zero16();
        suf = MFMA32(tri[0], pack_step<0>(sp), suf);
        suf = MFMA32(tri[1], pack_step<1>(sp), suf);
        f32x16 w;
#pragma unroll
        for (int i = 0; i < 16; ++i) {
            const bool valid = !diag || (crow(i, hh) < r);
            const float lw = z[i] - suf[i] - carry;
            w[i] = valid ? fexp(lw) : 0.f;
        }
        rs += __shfl_xor(rs, 32);
        carry += rs;
        const bf16x8 pa0 = pack_step<0>(w), pa1 = pack_step<1>(w);
        o0 = MFMA32(pa0, frag2(vl[0][0], vh[0][0]), o0); o0 = MFMA32(pa1, frag2(vl[0][1], vh[0][1]), o0);
        o1 = MFMA32(pa0, frag2(vl[1][0], vh[1][0]), o1); o1 = MFMA32(pa1, frag2(vl[1][1], vh[1][1]), o1);
        if (__all(carry > 104.f)) break;
    }
    bf16* op = YSB + (rowbase + t0) * 1024 + h * 64 + r;
#pragma unroll
    for (int i = 0; i < 16; ++i) { const int t = crow(i, hh); op[(size_t)t * 1024] = (bf16)f2bf(o0[i]); op[(size_t)t * 1024 + 32] = (bf16)f2bf(o1[i]); }
}
__device__ __forceinline__ void sba_item(const P& p, LAS unsigned char* lds, int item, int wave, int lane) {
    const int bh = item >> 3, qb = item & 7, b = bh >> 3, h = bh & 7;
    sba_wave_item((const bf16*)(p.ws + WS_SBQKV), (const bf16*)(p.ws + WS_VT), (bf16*)p.out, lds + wave * SBW_BYTES, b, h, qb * 8 + wave, lane);
}

__device__ __forceinline__ void p3_yml(const P& p, int wave, int lane) {
    const int gw = blockIdx.x * NWAVES + wave, NGW = gridDim.x * NWAVES;
    bf16* YML = (bf16*)p.out + 512; const bf16* MLO = (const bf16*)(p.ws + WS_MLO);
    for (int m0 = gw * 4; m0 < T_; m0 += NGW * 4) {
        v4u hr[4], orr[4];
#pragma unroll
        for (int u = 0; u < 4; ++u) { hr[u] = *(const v4u*)(YML + (size_t)(m0 + u) * 1024 + lane * 8); orr[u] = *(const v4u*)(MLO + (size_t)(m0 + u) * 512 + lane * 8); }
        const f32x4 w0 = *(const f32x4*)(p.ml_norm_w + lane * 8), w1 = *(const f32x4*)(p.ml_norm_w + lane * 8 + 4);
        const float wv[8] = {w0.x, w0.y, w0.z, w0.w, w1.x, w1.y, w1.z, w1.w};
#pragma unroll
        for (int u = 0; u < 4; ++u) {
            float hv[8], ov[8], o[8];
            unpack8(hr[u], hv); unpack8(orr[u], ov);
            float ss = 0.f;
#pragma unroll
            for (int i = 0; i < 8; ++i) ss += hv[i] * hv[i];
            ss += __shfl_xor(ss, 1); ss += __shfl_xor(ss, 2); ss += __shfl_xor(ss, 4); ss += __shfl_xor(ss, 8);
            const float rstd = frsq(ss * (1.f / 128.f) + EPS);
#pragma unroll
            for (int i = 0; i < 8; ++i) o[i] = sigmoidf_(ov[i]) * hv[i] * rstd * wv[i];
            *(v4u*)(YML + (size_t)(m0 + u) * 1024 + lane * 8) = pack8(o);
        }
    }
}

__device__ __forceinline__ void p6_hn(const P& p, int wave, int lane) {
    const int gw = blockIdx.x * NWAVES + wave, NGW = gridDim.x * NWAVES;
    const float* H = (const float*)(p.ws + WS_H); bf16* HN = (bf16*)(p.ws + WS_HN);
    for (int m = gw; m < T_; m += NGW) {
        const f32x4* xr = (const f32x4*)(H + (size_t)m * 1024) + lane; const f32x4* wr = (const f32x4*)p.norm_ffn_w + lane;
        f32x4 v[4]; float ss = 0.f;
#pragma unroll
        for (int j = 0; j < 4; ++j) { v[j] = xr[64 * j]; ss += (v[j].x * v[j].x + v[j].y * v[j].y) + (v[j].z * v[j].z + v[j].w * v[j].w); }
        const float rstd = frsq(wave_sum(ss) * (1.f / 1024.f) + EPS);
        v2u* o8 = (v2u*)(HN + (size_t)m * 1024) + lane;
#pragma unroll
        for (int j = 0; j < 4; ++j) { const f32x4 w = wr[64 * j]; o8[64 * j] = (v2u){pk2(v[j].x * rstd * w.x, v[j].y * rstd * w.y), pk2(v[j].z * rstd * w.z, v[j].w * rstd * w.w)}; }
    }
}

__device__ __forceinline__ float ffn_rstd(const float* SS, int m) {
    const f32x4* q = (const f32x4*)(SS + (size_t)m * 16); const f32x4 a = q[0], b = q[1], c = q[2], d = q[3];
    const float t = ((a.x + a.y) + (a.z + a.w)) + ((b.x + b.y) + (b.z + b.w)) + ((c.x + c.y) + (c.z + c.w)) + ((d.x + d.y) + (d.z + d.w));
    return frsq(t * (1.f / 1024.f) + EPS);
}
__device__ __forceinline__ unsigned ord_key(float f) { const unsigned u = __builtin_bit_cast(unsigned, f); return (u & 0x80000000u) ? ~u : (u | 0x80000000u); }
__device__ __forceinline__ float ord_val(unsigned k) { const unsigned u = (k & 0x80000000u) ? (k & 0x7fffffffu) : ~k; return __builtin_bit_cast(float, u); }
template <int CTRL> __device__ __forceinline__ unsigned dpp_u(unsigned v) { return (unsigned)__builtin_amdgcn_update_dpp(0, (int)v, CTRL, 0xF, 0xF, true); }
__device__ __forceinline__ unsigned umax_(unsigned a, unsigned b) { return a > b ? a : b; }
__device__ __forceinline__ unsigned umin_(unsigned a, unsigned b) { return a < b ? a : b; }
__device__ __forceinline__ unsigned row_max_u(unsigned v) {
    v = umax_(v, dpp_u<0xB1>(v)); v = umax_(v, dpp_u<0x4E>(v)); v = umax_(v, dpp_u<0x141>(v)); v = umax_(v, dpp_u<0x140>(v)); return v;
}
__device__ __forceinline__ float row_sum_f(float v) {
    v += __builtin_bit_cast(float, dpp_u<0xB1>(__builtin_bit_cast(unsigned, v))); v += __builtin_bit_cast(float, dpp_u<0x4E>(__builtin_bit_cast(unsigned, v)));
    v += __builtin_bit_cast(float, dpp_u<0x141>(__builtin_bit_cast(unsigned, v))); v += __builtin_bit_cast(float, dpp_u<0x140>(__builtin_bit_cast(unsigned, v))); return v;
}
#define CE_(i, j) do { const unsigned _a = k[i], _b = k[j]; k[i] = umax_(_a, _b); k[j] = umin_(_a, _b); } while (0)
__device__ __forceinline__ unsigned row_top16(unsigned (&k)[8], unsigned (&top)[16], int li) {
    CE_(0, 1); CE_(2, 3); CE_(4, 5); CE_(6, 7); CE_(0, 2); CE_(1, 3); CE_(4, 6); CE_(5, 7); CE_(1, 2); CE_(5, 6);
    CE_(0, 4); CE_(1, 5); CE_(2, 6); CE_(3, 7); CE_(2, 4); CE_(3, 5); CE_(1, 2); CE_(3, 4); CE_(5, 6);
    unsigned mine = 0u;
#pragma unroll
    for (int n = 0; n < 16; ++n) {
        const unsigned m = row_max_u(k[0]);
        const bool hit = k[0] == m;
#pragma unroll
        for (int i = 0; i < 7; ++i) k[i] = hit ? k[i + 1] : k[i];
        k[7] = hit ? 0u : k[7];
        top[n] = m; mine = (li == n) ? m : mine;
    }
    return mine;
}
__device__ __forceinline__ void topk_core(const float (&s1)[8], const float (&s2)[8], float rstd, int li, int lane, int& e_out, float& g_out) {
    unsigned k[8], top1[16], top2[16];
#pragma unroll
    for (int j = 0; j < 8; ++j) k[j] = (ord_key(s1[j]) & ~0x7fu) | (unsigned)(127 - (li + 16 * j));
    const unsigned mine1 = row_top16(k, top1, li);
#pragma unroll
    for (int j = 0; j < 8; ++j) k[j] = (ord_key(s2[j]) & ~0x7fu) | (unsigned)(127 - (li + 16 * j));
    const unsigned mine2 = row_top16(k, top2, li);
    const float v2 = ord_val(mine2 & ~0x7fu);
    unsigned c[16];
#pragma unroll
    for (int j = 0; j < 16; ++j) {
        const float v1 = ord_val(top1[j] & ~0x7fu);
        const unsigned key = (ord_key(v1 + v2) & ~0xffu) | (unsigned)(255 - (16 * j + li));
        c[j] = ((j + 1) * (li + 1) <= 16) ? key : 0u;
    }
    unsigned tk = 0u, t0 = 0u;
#pragma unroll
    for (int n = 0; n < 16; ++n) {
        const unsigned mx = row_max_u(c[0]);
        const bool hit = c[0] == mx;
#pragma unroll
        for (int i = 0; i < 15; ++i) c[i] = hit ? c[i + 1] : c[i];
        c[15] = hit ? 0u : c[15];
        if (n == 0) t0 = mx;
        tk = (li == n) ? mx : tk;
    }
    const float sv = ord_val(tk & ~0xffu), s0 = ord_val(t0 & ~0xffu);
    const int cc = 255 - (int)(tk & 0xffu), a = (cc >> 4) & 15, bb = cc & 15;
    const int i1 = 127 - (int)((unsigned)__shfl((int)mine1, (lane & 48) + a) & 0x7fu), i2 = 127 - (int)((unsigned)__shfl((int)mine2, (lane & 48) + bb) & 0x7fu);
    const float pe = fexp((sv - s0) * rstd);
    const float den = row_sum_f(pe);
    e_out = i1 * 128 + i2; g_out = pe * frcp(den);
}
constexpr int TK_RS = 1040;
struct EpiTopk {
    static constexpr bool PERM = true, AFTER_DRAIN = true;
    int* IDX; float* GATE; const float* SS;
    __device__ __forceinline__ void fused(pg8::f32x4 (&acc)[2][2][4][2], const pg8::Unit& u, int wr, int wc, int fr, int fq, PG8_LAS unsigned char* lds, int wid, int lane) const {
        const int head = u.pn, q = lane >> 4, li = lane & 15;
#pragma unroll
        for (int ai = 0; ai < 2; ++ai) {
#pragma unroll
            for (int m = 0; m < 4; ++m)
#pragma unroll
                for (int bj = 0; bj < 2; ++bj) {
                    PG8_LAS unsigned char* dst = lds + (wr * 64 + m * 16 + fr) * TK_RS + (bj * 128 + wc * 32 + 8 * fq) * 4;
                    *(PG8_LAS pg8::f32x4*)dst = acc[ai][bj][m][0]; *(PG8_LAS pg8::f32x4*)(dst + 16) = acc[ai][bj][m][1];
                }
            __syncthreads();
#pragma unroll 1
            for (int it = 0; it < 4; it += 2) {
                const int rowa = 16 * wid + 4 * it + q, rowb = rowa + 4, ma = u.pm * 256 + ai * 128 + rowa, mb = ma + 4;
                const PG8_LAS float* sa = (const PG8_LAS float*)(lds + rowa * TK_RS); const PG8_LAS float* sb = (const PG8_LAS float*)(lds + rowb * TK_RS);
                float a1[8], a2[8], b1[8], b2[8];
#pragma unroll
                for (int j = 0; j < 8; ++j) { a1[j] = sa[li + 16 * j]; a2[j] = sa[128 + li + 16 * j]; b1[j] = sb[li + 16 * j]; b2[j] = sb[128 + li + 16 * j]; }
                const float ra = ffn_rstd(SS, ma), rb = ffn_rstd(SS, mb);
                int ea, eb; float ga, gb;
                topk_core(a1, a2, ra, li, lane, ea, ga);
                topk_core(b1, b2, rb, li, lane, eb, gb);
                IDX[(size_t)ma * 128 + head * 16 + li] = ea; GATE[(size_t)ma * 128 + head * 16 + li] = ga;
                IDX[(size_t)mb * 128 + head * 16 + li] = eb; GATE[(size_t)mb * 128 + head * 16 + li] = gb;
            }
            __syncthreads();
        }
    }
};
struct OneUnit {
    pg8::Unit u;
    __device__ __forceinline__ bool next(int i, pg8::Unit& o) const { if (i) return false; o = u; return true; }
    __device__ __forceinline__ void a_ready(const pg8::Unit&) const {}
    __device__ __forceinline__ void done(const pg8::Unit&) const {}
};

__device__ __forceinline__ float gelu_erf(float x) { return 0.5f * x * (1.f + erff(x * 0.70710678118654752f)); }
typedef float f32x2 __attribute__((ext_vector_type(2)));
__device__ __forceinline__ void cvt16_fp8(const v4u& w, f32x2 (&f)[8]) {
    f[0] = __builtin_amdgcn_cvt_pk_f32_fp8((int)w.x, false); f[1] = __builtin_amdgcn_cvt_pk_f32_fp8((int)w.x, true);
    f[2] = __builtin_amdgcn_cvt_pk_f32_fp8((int)w.y, false); f[3] = __builtin_amdgcn_cvt_pk_f32_fp8((int)w.y, true);
    f[4] = __builtin_amdgcn_cvt_pk_f32_fp8((int)w.z, false); f[5] = __builtin_amdgcn_cvt_pk_f32_fp8((int)w.z, true);
    f[6] = __builtin_amdgcn_cvt_pk_f32_fp8((int)w.w, false); f[7] = __builtin_amdgcn_cvt_pk_f32_fp8((int)w.w, true);
}
__device__ __forceinline__ float grp8_sum(float v) {
    v += __builtin_bit_cast(float, dpp_u<0xB1>(__builtin_bit_cast(unsigned, v)));
    v += __builtin_bit_cast(float, dpp_u<0x4E>(__builtin_bit_cast(unsigned, v)));
    v += __builtin_bit_cast(float, dpp_u<0x141>(__builtin_bit_cast(unsigned, v)));
    return v;
}
typedef int i32x4 __attribute__((ext_vector_type(4)));
template <int PAT> __device__ __forceinline__ float swz_f(float v) { return __builtin_bit_cast(float, __builtin_amdgcn_ds_swizzle(__builtin_bit_cast(int, v), PAT)); }
__device__ __forceinline__ void peer_u_token(const v4u (&ur)[16], const f32x2 (&xv)[8], bf16* dst, int c8) {
    float d[16];
#pragma unroll
    for (int i = 0; i < 16; ++i) {
        f32x2 f[8]; cvt16_fp8(ur[i], f);
        f32x2 s2 = f[0] * xv[0];
#pragma unroll
        for (int q = 1; q < 8; ++q) s2 += f[q] * xv[q];
        d[i] = s2.x + s2.y;
    }
    const bool b0 = (c8 & 1) != 0, b1 = (c8 & 2) != 0, b2 = (c8 & 4) != 0;
    float e8[8], e4[4], e2[2];
#pragma unroll
    for (int i = 0; i < 8; ++i) { const float keep = b0 ? d[2 * i + 1] : d[2 * i], send = b0 ? d[2 * i] : d[2 * i + 1];
        e8[i] = keep + __builtin_bit_cast(float, dpp_u<0xB1>(__builtin_bit_cast(unsigned, send))); }
#pragma unroll
    for (int i = 0; i < 4; ++i) { const float keep = b1 ? e8[2 * i + 1] : e8[2 * i], send = b1 ? e8[2 * i] : e8[2 * i + 1];
        e4[i] = keep + __builtin_bit_cast(float, dpp_u<0x4E>(__builtin_bit_cast(unsigned, send))); }
#pragma unroll
    for (int i = 0; i < 2; ++i) { const float keep = b2 ? e4[2 * i + 1] : e4[2 * i], send = b2 ? e4[2 * i] : e4[2 * i + 1];
        e2[i] = keep + swz_f<0x1F | (4 << 10)>(send); }
    dst[c8] = (bf16)f2bf(e2[0]); dst[c8 + 8] = (bf16)f2bf(e2[1]);
}
__device__ __forceinline__ void peer_u(const P& p, int wave, int lane) {
    const int j = blockIdx.x & 7, nchunk = gridDim.x >> 3, chunk = blockIdx.x >> 3, stride = nchunk * 8;
    const int g = lane >> 3, c8 = lane & 7;
    const bf16* HN = (const bf16*)p.out + 128 * j + 16 * c8; const int* IDX = (const int*)(p.ws + WS_IDX) + 16 * g;
    const unsigned char* US = p.ws + WS_U8 + (size_t)j * NEXP * 128 + 16 * c8;
    bf16* PART = (bf16*)(p.ws + WS_PART) + (size_t)j * T_ * 128 + 16 * g;
    const int m0 = chunk * 8 + wave, ntok = (T_ - m0 + stride - 1) / stride;
#define PU_CLAMP(k) (m0 + ((k) < ntok ? (k) : ntok - 1) * stride)
#define PU_ROWS(ur, ei) _Pragma("unroll") for (int i = 0; i < 16; ++i) ur[i] = *(const v4u*)(US + (size_t)ei[i >> 2][i & 3] * 128)
#define PU_L1(ei, h0, h1, mm) do { _Pragma("unroll") for (int q = 0; q < 4; ++q) ei[q] = *(const i32x4*)(IDX + (size_t)(mm) * 128 + 4 * q); \
        h0 = *(const v4u*)(HN + (size_t)(mm) * 1024); h1 = *(const v4u*)(HN + (size_t)(mm) * 1024 + 8); } while (0)
#define PU_X(xv, h0, h1) do { float f_[8]; unpack8(h0, f_); _Pragma("unroll") for (int i = 0; i < 4; ++i) xv[i] = (f32x2){f_[2 * i], f_[2 * i + 1]}; \
        unpack8(h1, f_); _Pragma("unroll") for (int i = 0; i < 4; ++i) xv[4 + i] = (f32x2){f_[2 * i], f_[2 * i + 1]}; } while (0)
    i32x4 ei[4]; v4u hA0, hA1, hB0, hB1; v4u urA[16], urB[16]; f32x2 xv[8];
    PU_L1(ei, hA0, hA1, m0);
    PU_ROWS(urA, ei);
    PU_L1(ei, hB0, hB1, PU_CLAMP(1));
    for (int k = 0; k < ntok; k += 2) {
        PU_ROWS(urB, ei);
        PU_X(xv, hA0, hA1);
        PU_L1(ei, hA0, hA1, PU_CLAMP(k + 2));
        peer_u_token(urA, xv, PART + (size_t)(m0 + k * stride) * 128, c8);
        if (k + 1 < ntok) {
            PU_ROWS(urA, ei);
            PU_X(xv, hB0, hB1);
            PU_L1(ei, hB0, hB1, PU_CLAMP(k + 3));
            peer_u_token(urB, xv, PART + (size_t)(m0 + (k + 1) * stride) * 128, c8);
        }
    }
#undef PU_CLAMP
#undef PU_ROWS
#undef PU_L1
#undef PU_X
}
__device__ __forceinline__ void peer_c(const P& p, int wave, int lane) {
    const int gw = blockIdx.x * NWAVES + wave, NGW = gridDim.x * NWAVES;
    const int* IDX = (const int*)(p.ws + WS_IDX); const float* GATE = (const float*)(p.ws + WS_GATE); const bf16* PART = (const bf16*)(p.ws + WS_PART);
    const float* USC = (const float*)(p.ws + WS_USC); const float* VSC = (const float*)(p.ws + WS_VSC); float* COEF = (float*)(p.ws + WS_COEF); const float* SS = (const float*)(p.ws + WS_SS);
    for (int m0 = gw * 4; m0 < T_; m0 += NGW * 4) {
        float s[4][2], rs[4], g[4][2]; int e[4][2];
#pragma unroll
        for (int u = 0; u < 4; ++u) {
            const int m = m0 + u;
            rs[u] = ffn_rstd(SS, m);
            s[u][0] = 0.f; s[u][1] = 0.f;
#pragma unroll
            for (int jj = 0; jj < 8; ++jj) { s[u][0] += bf2f(PART[((size_t)jj * T_ + m) * 128 + lane]); s[u][1] += bf2f(PART[((size_t)jj * T_ + m) * 128 + 64 + lane]); }
            e[u][0] = IDX[(size_t)m * 128 + lane]; e[u][1] = IDX[(size_t)m * 128 + 64 + lane];
            g[u][0] = GATE[(size_t)m * 128 + lane]; g[u][1] = GATE[(size_t)m * 128 + 64 + lane];
        }
        float us[4][2], vs[4][2];
#pragma unroll
        for (int u = 0; u < 4; ++u)
#pragma unroll
            for (int k = 0; k < 2; ++k) { us[u][k] = USC[e[u][k]]; vs[u][k] = VSC[e[u][k]]; }
#pragma unroll
        for (int u = 0; u < 4; ++u)
#pragma unroll
            for (int k = 0; k < 2; ++k) COEF[(size_t)(m0 + u) * 128 + 64 * k + lane] = g[u][k] * gelu_erf(s[u][k] * rs[u] * us[u][k]) * vs[u][k];
    }
}
struct PvPre { i32x4 ei[4]; f32x4 cf[4]; };
__device__ __forceinline__ void pv_level1(PvPre& q, const int* IDXg, const float* COEFg, int m, int c8) {
#pragma unroll
    for (int k = 0; k < 4; ++k) { q.ei[k] = *(const i32x4*)(IDXg + (size_t)m * 128 + 4 * k); q.cf[k] = *(const f32x4*)(COEFg + (size_t)m * 128 + 4 * k); }
}
__device__ __forceinline__ void peer_v_token(const v4u (&vr)[16], const f32x4 (&cf)[4], const bf16* H, bf16* out, bool b3, bool b4, bool b5) {
    f32x2 acc[8];
#pragma unroll
    for (int i = 0; i < 8; ++i) acc[i] = (f32x2){0.f, 0.f};
#pragma unroll
    for (int I = 0; I < 16; ++I) {
        const float cu = cf[I >> 2][I & 3];
        const f32x2 c2 = (f32x2){cu, cu}; f32x2 f[8]; cvt16_fp8(vr[I], f);
#pragma unroll
        for (int q = 0; q < 8; ++q) acc[q] += c2 * f[q];
    }
    f32x2 a1[4], a2[2], a3;
#pragma unroll
    for (int i = 0; i < 4; ++i) { const f32x2 keep = b5 ? acc[2 * i + 1] : acc[2 * i], send = b5 ? acc[2 * i] : acc[2 * i + 1];
        a1[i] = keep + (f32x2){__shfl_xor(send.x, 32), __shfl_xor(send.y, 32)}; }
#pragma unroll
    for (int i = 0; i < 2; ++i) { const f32x2 keep = b4 ? a1[2 * i + 1] : a1[2 * i], send = b4 ? a1[2 * i] : a1[2 * i + 1];
        a2[i] = keep + (f32x2){swz_f<0x1F | (16 << 10)>(send.x), swz_f<0x1F | (16 << 10)>(send.y)}; }
    { const f32x2 keep = b3 ? a2[1] : a2[0], send = b3 ? a2[0] : a2[1]; a3 = keep + (f32x2){swz_f<0x1F | (8 << 10)>(send.x), swz_f<0x1F | (8 << 10)>(send.y)}; }
    const unsigned hb = *(const unsigned*)H; const f32x2 hv = (f32x2){bflo(hb), bfhi(hb)};
    const f32x2 y = hv + a3;
    *(unsigned*)out = pk2(y.x, y.y);
}
__device__ __forceinline__ void peer_v(const P& p, int wave, int lane) {
    const int j = blockIdx.x & 7, nchunk = gridDim.x >> 3, chunk = blockIdx.x >> 3, stride = nchunk * 8;
    const int g = lane >> 3, c8 = lane & 7;
    const bool b5 = (lane & 32) != 0, b4 = (lane & 16) != 0, b3 = (lane & 8) != 0;
    const int pi = 4 * (b3 ? 1 : 0) + 2 * (b4 ? 1 : 0) + (b5 ? 1 : 0);
    const size_t colo = 128 * j + 16 * c8 + 2 * pi;
    const bf16* H = (const bf16*)(p.ws + WS_H) + colo; bf16* OUT = (bf16*)(p.ws + WS_YB) + colo;
    const int* IDXg = (const int*)(p.ws + WS_IDX) + 16 * g; const float* COEFg = (const float*)(p.ws + WS_COEF) + 16 * g;
    const unsigned char* VS = p.ws + WS_V8 + (size_t)j * NEXP * 128 + 16 * c8;
    const int m0 = chunk * 8 + wave, ntok = (T_ - m0 + stride - 1) / stride;
#define PV_CLAMP(k) (m0 + ((k) < ntok ? (k) : ntok - 1) * stride)
#define PV_ROWS(vr, q) _Pragma("unroll") for (int i = 0; i < 16; ++i) vr[i] = *(const v4u*)(VS + (size_t)q.ei[i >> 2][i & 3] * 128)
    PvPre q; v4u vrA[16], vrB[16]; f32x4 cA[4], cB[4];
    pv_level1(q, IDXg, COEFg, m0, c8);
    PV_ROWS(vrA, q);
#pragma unroll
    for (int k = 0; k < 4; ++k) cA[k] = q.cf[k];
    pv_level1(q, IDXg, COEFg, PV_CLAMP(1), c8);
    for (int k = 0; k < ntok; k += 2) {
        PV_ROWS(vrB, q);
#pragma unroll
        for (int kk = 0; kk < 4; ++kk) cB[kk] = q.cf[kk];
        pv_level1(q, IDXg, COEFg, PV_CLAMP(k + 2), c8);
        { const size_t mm = (size_t)(m0 + k * stride); peer_v_token(vrA, cA, H + mm * 1024, OUT + mm * 1024, b3, b4, b5); }
        if (k + 1 < ntok) {
            PV_ROWS(vrA, q);
#pragma unroll
            for (int kk = 0; kk < 4; ++kk) cA[kk] = q.cf[kk];
            pv_level1(q, IDXg, COEFg, PV_CLAMP(k + 3), c8);
            { const size_t mm = (size_t)(m0 + (k + 1) * stride); peer_v_token(vrB, cB, H + mm * 1024, OUT + mm * 1024, b3, b4, b5); }
        }
    }
#undef PV_CLAMP
#undef PV_ROWS
}
__device__ __forceinline__ void peer_f(const P& p, int wave, int lane) {
    const int gw = blockIdx.x * NWAVES + wave, NGW = gridDim.x * NWAVES;
    const f32x4* wr = (const f32x4*)p.norm_final_w + lane;
    for (int m0 = gw * 2; m0 < T_; m0 += NGW * 2) {
        v2u yv[2][4]; float ss[2] = {0.f, 0.f};
#pragma unroll
        for (int u = 0; u < 2; ++u) { const v2u* yb = (const v2u*)((const bf16*)(p.ws + WS_YB) + (size_t)(m0 + u) * 1024) + lane;
#pragma unroll
            for (int q = 0; q < 4; ++q) yv[u][q] = yb[64 * q]; }
#pragma unroll
        for (int u = 0; u < 2; ++u)
#pragma unroll
            for (int q = 0; q < 4; ++q) { const float a = bflo(yv[u][q].x), b = bfhi(yv[u][q].x), c = bflo(yv[u][q].y), d = bfhi(yv[u][q].y); ss[u] += (a * a + b * b) + (c * c + d * d); }
#pragma unroll
        for (int o = 1; o < 64; o <<= 1) { ss[0] += __shfl_xor(ss[0], o); ss[1] += __shfl_xor(ss[1], o); }
#pragma unroll
        for (int u = 0; u < 2; ++u) {
            const float rstd = frsq(ss[u] * (1.f / 1024.f) + EPS);
            f32x4* o = (f32x4*)(p.out + (size_t)(m0 + u) * 1024) + lane;
#pragma unroll
            for (int q = 0; q < 4; ++q) { const f32x4 w = wr[64 * q];
                o[64 * q] = (f32x4){bflo(yv[u][q].x) * rstd * w.x, bfhi(yv[u][q].x) * rstd * w.y, bflo(yv[u][q].y) * rstd * w.z, bfhi(yv[u][q].y) * rstd * w.w}; }
        }
    }
}

constexpr int N_PHASES = 12;
struct Args { P p; int ph_lo, ph_hi; };
__global__ void __launch_bounds__(NTHR, 2) fwd_kernel(Args args) {
    extern __shared__ __attribute__((aligned(16))) unsigned char lds_raw[];
    LAS unsigned char* lds = (LAS unsigned char*)lds_raw;
    const P& p = args.p;
    const int tid = threadIdx.x, lane = tid & 63, wave = __builtin_amdgcn_readfirstlane(tid >> 6);
    volatile LAS unsigned* MISC = (volatile LAS unsigned*)(lds + MISC_OFF);
    for (int u = tid; u < (LDS_BYTES - LDSCTL_OFF) / 4; u += NTHR) ((LAS unsigned*)(lds + LDSCTL_OFF))[u] = 0u;
    __syncthreads();
    XcdBarrier bar; bar.bar = (unsigned*)(p.ws + WS_CTL) + CW_BAR; bar.x = 0; bar.st = nullptr;
#if !MK_PER_PHASE
    bar = xcd_barrier_post((unsigned*)(p.ws + WS_CTL) + CW_BAR, MISC + 8);
#endif
    const int lo = args.ph_lo, hi = args.ph_hi;
#define IN(k) (lo <= (k) && (k) < hi)
#ifndef PROBE_WAIT_LO
#define PROBE_WAIT_LO -1
#define PROBE_WAIT_HI -1
#endif
    volatile LAS unsigned long long* STAMP = (volatile LAS unsigned long long*)(lds + MISC_OFF + 256);
#define SEAM(k) do { if (IN(k) && IN((k) + 1)) xcd_barrier(bar); if (PROBE_WAIT_LO >= 0 && blockIdx.x == 0 && tid == 0) { STAMP[(k) + 1] = __builtin_amdgcn_s_memrealtime(); \
        if ((k) + 1 == N_PHASES - 1) { const unsigned long long d_ = STAMP[PROBE_WAIT_HI < 0 ? 0 : PROBE_WAIT_HI] - STAMP[PROBE_WAIT_LO < 0 ? 0 : PROBE_WAIT_LO]; \
            __hip_atomic_store((unsigned*)(p.ws + WS_CTL) + CW_Q + 256, (unsigned)d_ | 1u, __ATOMIC_RELAXED, __HIP_MEMORY_SCOPE_AGENT); } } } while (0)
    if (PROBE_WAIT_LO >= 0 && blockIdx.x == 0 && tid == 0) STAMP[0] = __builtin_amdgcn_s_memrealtime();

#ifndef PROBE_REP
#define PROBE_REP -1
#endif
#define REP(k) ((PROBE_REP == (k)) ? 2 : 1)
    if (IN(0)) {
#pragma unroll 1
        for (int r = 0; r < REP(0); ++r) p0_prologue(p, lds, wave, lane); } SEAM(0);
    if (IN(1)) {
#pragma unroll 1
      for (int r = 0; r < REP(1); ++r) {
        EpiProj e{(bf16*)(p.ws + WS_SBQKV), (bf16*)(p.ws + WS_VT), (bf16*)(p.ws + WS_MLQK), (bf16*)(p.ws + WS_MLV), (bf16*)(p.ws + WS_MLO), (bf16*)(p.ws + WS_GATES)};
        gemm<EpiProj>(lds, (const bf16*)(p.ws + WS_XN), (const bf16*)(p.ws + WS_W1T), T_, NPROJ, 1024, e); }
    } SEAM(1);
    if (IN(2)) { p2_conv(p, tid); } SEAM(2);
    if (IN(3)) {
        for (int it = blockIdx.x; it < 64; it += gridDim.x) mlstm_item(p, lds, it, tid, wave, lane);
        unsigned* qctr = (unsigned*)(p.ws + WS_CTL) + CW_Q;
#ifdef PROBE_P3SPLIT
        xcd_barrier(bar); if (blockIdx.x == 0 && tid == 0) STAMP[20] = __builtin_amdgcn_s_memrealtime();
#endif
        for (;;) {
            if (tid == 0) MISC[12] = __hip_atomic_fetch_add(qctr, 1u, __ATOMIC_RELAXED, __HIP_MEMORY_SCOPE_AGENT);
            __syncthreads();
            const unsigned it = MISC[12];
            __syncthreads();
            if (it >= 1024u) break;
            sba_item(p, lds, (int)it, wave, lane);
        }
#ifdef PROBE_P3SPLIT
        xcd_barrier(bar); if (blockIdx.x == 0 && tid == 0) STAMP[21] = __builtin_amdgcn_s_memrealtime();
#endif
        for (;;) {
            if (tid == 0) MISC[12] = __hip_atomic_fetch_add(qctr + 128, 1u, __ATOMIC_RELAXED, __HIP_MEMORY_SCOPE_AGENT);
            __syncthreads();
            const unsigned it = MISC[12];
            __syncthreads();
            if (it >= (unsigned)N_FILL) break;
            fill_item(p, (int)it, wave, lane);
        }
    } SEAM(3);
    if (IN(4)) { p3_yml(p, wave, lane); } SEAM(4);
    if (IN(5)) {
        pg8::Gemm g{(const bf16*)p.out, (const bf16*)(p.ws + WS_WSBT), T_, 1024, 1024}; pg8::StaticOrder S; S.init(T_, 1024, (int)gridDim.x, (int)blockIdx.x);
        EpiMerge1 e{(bf16*)(p.ws + WS_MERGED), (const unsigned char*)(p.ws + WS_GATES)};
        pg8::gemm_phase<EpiMerge1, pg8::StaticOrder, true, true, true>(lds, g, S, e);
    } SEAM(5);
    if (IN(6)) {
        pg8::Gemm g{(const bf16*)(p.ws + WS_MERGED), (const bf16*)(p.ws + WS_WOUTT), T_, 1024, 1024}; pg8::StaticOrder S; S.init(T_, 1024, (int)gridDim.x, (int)blockIdx.x);
        EpiHW e{(bf16*)(p.ws + WS_H), p.x, (bf16*)p.out  , p.norm_ffn_w, (float*)(p.ws + WS_SS)};
        pg8::gemm_phase<EpiHW, pg8::StaticOrder, true, true>(lds, g, S, e);
    } SEAM(6);
    if (IN(7)) {
        pg8::Gemm g{(const bf16*)p.out, (const bf16*)(p.ws + WS_WCT), T_, 2048, 1024}; pg8::StaticOrder S; S.init(T_, 2048, (int)gridDim.x, (int)blockIdx.x);
        EpiTopk e{(int*)(p.ws + WS_IDX), (float*)(p.ws + WS_GATE), (const float*)(p.ws + WS_SS)};
#pragma unroll 1
        for (int i = 0;; ++i) { OneUnit s1; if (!S.next(i, s1.u)) break; pg8::gemm_phase<EpiTopk, OneUnit, false, true>(lds, g, s1, e); }
    } SEAM(7);
    if (IN(8)) { peer_u(p, wave, lane); } SEAM(8);
    if (IN(9)) { peer_c(p, wave, lane); } SEAM(9);
    if (IN(10)) { peer_v(p, wave, lane); } SEAM(10);
    if (IN(11)) { peer_f(p, wave, lane); }
    if (PROBE_WAIT_LO >= 0 && tid == 0) {
        unsigned* pw = (unsigned*)(p.ws + WS_CTL) + CW_Q + 256;
        unsigned dt = 0u;
        for (unsigned sp = 0; sp < (1u << 22); ++sp) { dt = __hip_atomic_load(pw, __ATOMIC_RELAXED, __HIP_MEMORY_SCOPE_AGENT); if (dt) break; __builtin_amdgcn_s_sleep(8); }
        const unsigned long long tend = __builtin_amdgcn_s_memrealtime();
        while (__builtin_amdgcn_s_memrealtime() - tend < (unsigned long long)dt) __builtin_amdgcn_s_sleep(8);
    }
#undef IN
#undef SEAM
}

extern "C" void kernel_launch(void* const* d_in, const int* in_sizes, int n_in, void* d_out, int out_size, void* d_ws, size_t ws_size, hipStream_t stream) {
    static int grid = 0;
    if (grid == 0) {
        if (n_in != 18 || in_sizes[0] != T_ * D_ || out_size != T_ * D_ || ws_size < WS_END) {
            fprintf(stderr, "kernel_launch: unexpected problem (n_in %d, in0 %d, out %d, ws %zu); nothing launched\n", n_in, n_in > 0 ? in_sizes[0] : -1, out_size, ws_size); grid = -1; return; }
        int dev = 0, cus = 0, per_cu = 0;
        if (hipGetDevice(&dev) != hipSuccess || hipDeviceGetAttribute(&cus, hipDeviceAttributeMultiprocessorCount, dev) != hipSuccess) { grid = -1; return; }
        if (hipFuncSetAttribute((const void*)fwd_kernel, hipFuncAttributeMaxDynamicSharedMemorySize, LDS_BYTES) != hipSuccess) { fprintf(stderr, "kernel_launch: hipFuncSetAttribute failed\n"); grid = -1; return; }
        if (hipOccupancyMaxActiveBlocksPerMultiprocessor(&per_cu, (const void*)fwd_kernel, NTHR, LDS_BYTES) != hipSuccess || per_cu < 1)
            fprintf(stderr, "kernel_launch: note: occupancy query reports %d workgroups per CU\n", per_cu);
        (void)hipGetLastError();
        grid = cus;
    }
    if (grid < 0) return;
    if (hipMemsetAsync((char*)d_ws + WS_CTL, 0, CTL_ZERO_BYTES, stream) != hipSuccess) { fprintf(stderr, "kernel_launch: memset failed\n"); return; }
    Args a{};
    const float** pp = (const float**)&a.p;
    for (int i = 0; i < 18; ++i) pp[i] = (const float*)d_in[i];
    a.p.out = (float*)d_out; a.p.ws = (unsigned char*)d_ws;
#if MK_PER_PHASE
    for (int ph = 0; ph < N_PHASES; ++ph) {
        a.ph_lo = ph; a.ph_hi = ph + 1;
        hipLaunchKernelGGL(fwd_kernel, dim3(grid), dim3(NTHR), LDS_BYTES, stream, a);
    }
#else
    a.ph_lo = 0; a.ph_hi = N_PHASES;
    hipLaunchKernelGGL(fwd_kernel, dim3(grid), dim3(NTHR), LDS_BYTES, stream, a);
#endif
    const hipError_t le = hipPeekAtLastError();
    if (le != hipSuccess) fprintf(stderr, "kernel_launch: launch failed: %s\n", hipGetErrorName(le));
}
```

```cpp
#include <hip/hip_runtime.h>
#include <cstdio>
#include <cstdint>
namespace pg8 {
#define PG8_LAS __attribute__((address_space(3)))
typedef unsigned short bf16_t;
typedef short bf16x8 __attribute__((ext_vector_type(8)));
typedef float f32x4 __attribute__((ext_vector_type(4)));
typedef unsigned u32x4 __attribute__((ext_vector_type(4)));
constexpr int BM = 256, BK = 64, HALF = 128, HTB = HALF * BK * 2  , STAGE_BYTES = 8 * HTB, NXCD = 8, WGM = 8;

__host__ __device__ __forceinline__ int lds_byte(int r, int c) { const int st = (r >> 4) * 2 + (c >> 5), rr = r & 15, cc = c & 31, ob = rr * 64 + cc * 2; return st * 1024 + (ob ^ (((ob >> 9) & 1) << 5)); }
__host__ __device__ __forceinline__ void stage_rc(int b, int& R, int& C) { const int st = b / 1024, sb = b % 1024, swz = sb ^ (((sb >> 9) & 1) << 5); R = (st >> 1) * 16 + swz / 64; C = (st & 1) * 32 + (swz % 64) / 2; }
__host__ __device__ __forceinline__ int perm32(int rho) { const int n = rho >> 4, i = rho & 15; return 8 * (i >> 2) + 4 * n + (i & 3); }

struct Unit { int pm, pn; };
struct Gemm { const bf16_t* A; const bf16_t* Bt; int M, N, K; };

struct StaticOrder {
    int nM, nN, nwg, G, c;
    __host__ __device__ void init(int M, int N, int G_, int c_) { nM = M / BM; nN = N / BM; nwg = nM * nN; G = G_; c = c_; }
    __host__ __device__ bool next(int i, Unit& u) const {
        const long L = (long)i * G + c; if (L >= nwg) return false;
        int wgid = (int)L; { const int q = nwg / NXCD, r = nwg % NXCD, xcd = wgid % NXCD, off = wgid / NXCD; wgid = (xcd < r ? xcd * (q + 1) : r * (q + 1) + (xcd - r) * q) + off; }
        const int nig = WGM * nN, gid = wgid / nig, fm = gid * WGM, gsz = (nM - fm) < WGM ? (nM - fm) : WGM;
        u.pm = fm + ((wgid % nig) % gsz); u.pn = (wgid % nig) / gsz; return true;
    }
    __device__ __forceinline__ void a_ready(const Unit&) const {}
    __device__ __forceinline__ void done(const Unit&) const {}
};

__device__ __forceinline__ unsigned cvt_pk_bf16(float lo, float hi) { unsigned r; asm volatile("v_cvt_pk_bf16_f32 %0, %1, %2" : "=v"(r) : "v"(lo), "v"(hi)); return r; }
template <class Epi, class Sched, bool ALIGN_EPI = false, bool SP2 = false, bool MID = false  >
__device__ __forceinline__ void gemm_phase(PG8_LAS unsigned char* lds, const Gemm g, const Sched& S, const Epi& E) {
    const int tid = threadIdx.x, wid = __builtin_amdgcn_readfirstlane(tid >> 6), lane = tid & 63, wr = wid >> 2, wc = wid & 3, fr = lane & 15, fq = lane >> 4;
    const int K = g.K, nt = K / BK;
    unsigned voffA[2], voffB[2];
#pragma unroll
    for (int i = 0; i < 2; ++i) { int R, C; stage_rc(tid * 16 + i * 8192, R, C); const int Rb = Epi::PERM ? ((R & ~31) + perm32(R & 31)) : R;
        voffA[i] = (unsigned)(R * K + C) * 2u; voffB[i] = (unsigned)(Rb * K + C) * 2u; }
    const size_t kstep = (size_t)(BK * 2);
    const size_t hstep = (size_t)HALF * K * 2;
    const size_t tstep = 2 * hstep;
    const unsigned ldsw = (unsigned)wid * 1024u;
    const int aoff = lds_byte(wr * 64 + fr, fq * 8), boff = lds_byte(wc * 32 + fr, fq * 8);
#define PG8_SA(b, h) (((b) * 2 + (h)) * HTB)
#define PG8_SB(b, h) ((4 + (b) * 2 + (h)) * HTB)
#define PG8_STAGE(bufoff, gbase, voff) do { _Pragma("unroll") for (int _i = 0; _i < 2; ++_i) \
        __builtin_amdgcn_global_load_lds((const unsigned*)((const char*)(gbase) + (voff)[_i]), (PG8_LAS unsigned*)(lds + (bufoff) + ldsw + _i * 8192), 16, 0, 0); } while (0)
#define PG8_LDA(dst, b, h) do { _Pragma("unroll") for (int m = 0; m < 4; ++m) _Pragma("unroll") for (int k = 0; k < 2; ++k) dst[m][k] = *(const PG8_LAS bf16x8*)(lds + PG8_SA(b, h) + aoff + m * 2048 + k * 1024); } while (0)
#define PG8_LDB(dst, b, h) do { _Pragma("unroll") for (int n = 0; n < 2; ++n) _Pragma("unroll") for (int k = 0; k < 2; ++k) dst[n][k] = *(const PG8_LAS bf16x8*)(lds + PG8_SB(b, h) + boff + n * 2048 + k * 1024); } while (0)
#define PG8_MMA(ai, bj, At, Bt) do { __builtin_amdgcn_s_setprio(1); _Pragma("unroll") for (int m = 0; m < 4; ++m) _Pragma("unroll") for (int n = 0; n < 2; ++n) _Pragma("unroll") for (int k = 0; k < 2; ++k) \
        acc[ai][bj][m][n] = __builtin_amdgcn_mfma_f32_16x16x32_bf16(Bt[n][k], At[m][k], acc[ai][bj][m][n], 0, 0, 0); __builtin_amdgcn_s_setprio(0); } while (0)
#define PG8_WAIT_V(n) asm volatile("s_waitcnt vmcnt(" #n ")" ::: "memory")
#define PG8_WAIT_L(n) asm volatile("s_waitcnt lgkmcnt(" #n ")" ::: "memory")
#define PG8_BAR __builtin_amdgcn_s_barrier()
#define PG8_SCHED __builtin_amdgcn_sched_barrier(0)
    Unit cur, nxt; int ui = 0;
    if (!S.next(0, cur)) return;
    f32x4 acc[2][2][4][2];
#pragma unroll
    for (int a = 0; a < 2; ++a)
#pragma unroll
        for (int b = 0; b < 2; ++b)
#pragma unroll
            for (int m = 0; m < 4; ++m)
#pragma unroll
                for (int n = 0; n < 2; ++n) acc[a][b][m][n] = (f32x4){0.f, 0.f, 0.f, 0.f};
    bf16x8 At[4][2], B0[2][2], B1[2][2];
    const char* cA = (const char*)g.A + (size_t)cur.pm * tstep; const char* cB = (const char*)g.Bt + (size_t)cur.pn * tstep;
    S.a_ready(cur);
    if constexpr (SP2) {
        PG8_STAGE(PG8_SB(0, 0), cB, voffB); PG8_STAGE(PG8_SB(0, 1), cB + hstep, voffB); PG8_STAGE(PG8_SA(0, 0), cA, voffA); PG8_STAGE(PG8_SA(0, 1), cA + hstep, voffA);
        if (wr == 1) PG8_BAR;
        PG8_WAIT_V(2); PG8_BAR;
        PG8_STAGE(PG8_SB(1, 0), cB + kstep, voffB); PG8_STAGE(PG8_SA(1, 0), cA + kstep, voffA); PG8_STAGE(PG8_SB(1, 1), cB + hstep + kstep, voffB);
        PG8_WAIT_V(6); PG8_BAR;
    } else {
        PG8_STAGE(PG8_SB(0, 0), cB, voffB); PG8_STAGE(PG8_SA(0, 0), cA, voffA); PG8_STAGE(PG8_SB(0, 1), cB + hstep, voffB); PG8_STAGE(PG8_SA(0, 1), cA + hstep, voffA);
        if (wr == 1) PG8_BAR;
        PG8_WAIT_V(4); PG8_BAR;
        PG8_STAGE(PG8_SB(1, 0), cB + kstep, voffB); PG8_STAGE(PG8_SA(1, 0), cA + kstep, voffA); PG8_STAGE(PG8_SB(1, 1), cB + hstep + kstep, voffB);
        PG8_WAIT_V(6); PG8_BAR;
    }
    for (;;) {
        const bool has_next = S.next(ui + 1, nxt);
        const char* nA = has_next ? (const char*)g.A + (size_t)nxt.pm * tstep : cA; const char* nB = has_next ? (const char*)g.Bt + (size_t)nxt.pn * tstep : cB;
        for (int t = 0; t < nt; t += 2) {
            if constexpr (MID) { if (t == (nt >> 1)) E.mid(acc, cur, wr, wc, fr, fq); }
            const bool last = (t == nt - 2);
            const char* a1 = cA + (size_t)(t + 1) * kstep;
            const char* a2 = last ? nA : cA + (size_t)(t + 2) * kstep; const char* b2 = last ? nB : cB + (size_t)(t + 2) * kstep;
            const char* a3 = a2 + kstep; const char* b3 = b2 + kstep;
            if (last && has_next) S.a_ready(nxt);
            if constexpr (SP2) {
            PG8_LDB(B0, 0, 0); PG8_LDB(B1, 0, 1); PG8_SCHED; PG8_LDA(At, 0, 0); PG8_STAGE(PG8_SA(1, 1), a1 + hstep, voffA);
            PG8_WAIT_V(8); PG8_WAIT_L(0); PG8_BAR; PG8_MMA(0, 0, At, B0); PG8_MMA(0, 1, At, B1); PG8_BAR; PG8_SCHED;
            PG8_LDA(At, 0, 1); PG8_STAGE(PG8_SB(0, 0), b2, voffB); PG8_STAGE(PG8_SB(0, 1), b2 + hstep, voffB); PG8_STAGE(PG8_SA(0, 0), a2, voffA);
            PG8_WAIT_V(8); PG8_WAIT_L(0); PG8_BAR; PG8_MMA(1, 0, At, B0); PG8_MMA(1, 1, At, B1); PG8_BAR; PG8_SCHED;
            PG8_LDB(B0, 1, 0); PG8_LDB(B1, 1, 1); PG8_SCHED; PG8_LDA(At, 1, 0); PG8_STAGE(PG8_SA(0, 1), a2 + hstep, voffA);
            PG8_WAIT_V(8); PG8_WAIT_L(0); PG8_BAR; PG8_MMA(0, 0, At, B0); PG8_MMA(0, 1, At, B1); PG8_BAR; PG8_SCHED;
            PG8_LDA(At, 1, 1); PG8_STAGE(PG8_SB(1, 0), b3, voffB); PG8_STAGE(PG8_SB(1, 1), b3 + hstep, voffB); PG8_STAGE(PG8_SA(1, 0), a3, voffA);
            PG8_WAIT_V(8); PG8_WAIT_L(0); PG8_BAR; PG8_MMA(1, 0, At, B0); PG8_MMA(1, 1, At, B1); PG8_BAR; PG8_SCHED;
            } else {
            PG8_LDB(B0, 0, 0); PG8_SCHED; PG8_LDA(At, 0, 0); PG8_STAGE(PG8_SA(1, 1), a1 + hstep, voffA);
            PG8_WAIT_L(8); PG8_BAR; PG8_WAIT_L(0); PG8_MMA(0, 0, At, B0); PG8_BAR; PG8_SCHED;
            PG8_LDB(B1, 0, 1); PG8_STAGE(PG8_SB(0, 0), b2, voffB);
            PG8_BAR; PG8_WAIT_L(0); PG8_MMA(0, 1, At, B1); PG8_BAR;
            PG8_LDA(At, 0, 1); PG8_STAGE(PG8_SA(0, 0), a2, voffA);
            PG8_BAR; PG8_WAIT_L(0); PG8_MMA(1, 0, At, B0); PG8_BAR; PG8_SCHED;
            PG8_STAGE(PG8_SB(0, 1), b2 + hstep, voffB);
            PG8_WAIT_V(6); PG8_BAR; PG8_MMA(1, 1, At, B1); PG8_BAR;
            PG8_LDB(B0, 1, 0); PG8_SCHED; PG8_LDA(At, 1, 0); PG8_STAGE(PG8_SA(0, 1), a2 + hstep, voffA);
            PG8_WAIT_L(8); PG8_BAR; PG8_WAIT_L(0); PG8_MMA(0, 0, At, B0); PG8_BAR; PG8_SCHED;
            PG8_LDB(B1, 1, 1); PG8_STAGE(PG8_SB(1, 0), b3, voffB);
            PG8_BAR; PG8_WAIT_L(0); PG8_MMA(0, 1, At, B1); PG8_BAR;
            PG8_LDA(At, 1, 1); PG8_STAGE(PG8_SA(1, 0), a3, voffA);
            PG8_BAR; PG8_WAIT_L(0); PG8_MMA(1, 0, At, B0); PG8_BAR; PG8_SCHED;
            PG8_STAGE(PG8_SB(1, 1), b3 + hstep, voffB);
            PG8_WAIT_V(6); PG8_BAR; PG8_MMA(1, 1, At, B1); PG8_BAR;
            }
        }
        if constexpr (ALIGN_EPI) { if (wr == 0) PG8_BAR; }
        if constexpr (!Epi::AFTER_DRAIN) { E(acc, cur, wr, wc, fr, fq); S.done(cur); }
        if (!has_next) break;
#pragma unroll
        for (int a = 0; a < 2; ++a)
#pragma unroll
            for (int b = 0; b < 2; ++b)
#pragma unroll
                for (int m = 0; m < 4; ++m)
#pragma unroll
                    for (int n = 0; n < 2; ++n) acc[a][b][m][n] = (f32x4){0.f, 0.f, 0.f, 0.f};
        cur = nxt; cA = nA; cB = nB; ++ui;
        if constexpr (ALIGN_EPI) { if (wr == 1) PG8_BAR; }
    }
    PG8_WAIT_V(0);
    if constexpr (!ALIGN_EPI) { if (wr == 0) PG8_BAR; }
    PG8_BAR;
    if constexpr (Epi::AFTER_DRAIN) { E.fused(acc, cur, wr, wc, fr, fq, lds, wid, lane); S.done(cur); }
#undef PG8_SA
#undef PG8_SB
#undef PG8_STAGE
#undef PG8_LDA
#undef PG8_LDB
#undef PG8_MMA
#undef PG8_WAIT_V
#undef PG8_WAIT_L
#undef PG8_BAR
#undef PG8_SCHED
}
}

#ifndef MK_PER_PHASE
#define MK_PER_PHASE 0
#endif
#ifndef USE_PG8
#define USE_PG8 1
#endif
constexpr int NWAVES = 8, NTHR = 512;

constexpr int B_ = 16, S_ = 2048, D_ = 1024, T_ = B_ * S_;
constexpr int INC = 5640, NPROJ = 5632;
constexpr int NEXP = 16384;
constexpr float EPS = 1e-6f;

constexpr size_t MiB = 1u << 20;
constexpr size_t WS_CTL = 0, CTL_ZERO_BYTES = 1 * MiB;
constexpr size_t WS_W1T = 2 * MiB, WS_WSBT = 13 * MiB, WS_WMLT = 14 * MiB, WS_WOUTT = 15 * MiB, WS_WCT = 17 * MiB, WS_IFG = 21 * MiB;
constexpr size_t WS_U8 = 24 * MiB, WS_V8 = 40 * MiB, WS_USC = 22 * MiB, WS_VSC = 23 * MiB;
constexpr size_t WS_XN = 88 * MiB, WS_QC = 88 * MiB, WS_KC = 120 * MiB;
constexpr size_t WS_SBQKV = 152 * MiB  , WS_VT = 216 * MiB  , WS_MLQK = 248 * MiB, WS_MLV = 312 * MiB, WS_MLO = 344 * MiB, WS_GATES = 376 * MiB;
constexpr size_t WS_MERGED = 216 * MiB, WS_H = 88 * MiB, WS_HN = 216 * MiB, WS_IDX = 280 * MiB, WS_GATE = 296 * MiB, WS_SC = 312 * MiB;
constexpr size_t WS_PART = 312 * MiB  , WS_SSQ = 504 * MiB  , WS_COEF = 56 * MiB  , WS_IDX16 = 72 * MiB  , WS_YB = 152 * MiB  , WS_HN8 = 440 * MiB  , WS_XS = 505 * MiB  , WS_SS = 506 * MiB  ;
constexpr size_t WS_END = 508 * MiB;
constexpr int CW_BAR = 4096, CW_Q = 8192;

constexpr int RING_OFF = 0, RING_BYTES = 135168;
constexpr int LDSCTL_OFF = RING_BYTES, MISC_OFF = LDSCTL_OFF + 320;
constexpr int LDS_BYTES = 147456;

#define GAS __attribute__((address_space(1)))
#define LAS __attribute__((address_space(3)))
typedef unsigned short bf16;
typedef unsigned v4u __attribute__((ext_vector_type(4)));
typedef unsigned v2u __attribute__((ext_vector_type(2)));
typedef float f32x4 __attribute__((ext_vector_type(4)));
#define LDS_WAIT() asm volatile("s_waitcnt lgkmcnt(0)" ::: "memory")
#define VM_WAIT() asm volatile("s_waitcnt vmcnt(0)" ::: "memory")
typedef float f32x2_t __attribute__((ext_vector_type(2))); typedef __bf16 bf16x2_t __attribute__((ext_vector_type(2)));
__device__ __forceinline__ unsigned cvtpk(float lo, float hi) { f32x2_t v = {lo, hi}; bf16x2_t b = __builtin_convertvector(v, bf16x2_t); return __builtin_bit_cast(unsigned, b); }
__device__ __forceinline__ unsigned f2bf(float f) { return cvtpk(f, f) & 0xffffu; }
__device__ __forceinline__ unsigned pk2(float lo, float hi) { return cvtpk(lo, hi); }
__device__ __forceinline__ float bflo(unsigned u) { return __builtin_bit_cast(float, u << 16); }
__device__ __forceinline__ float bfhi(unsigned u) { return __builtin_bit_cast(float, u & 0xffff0000u); }
__device__ __forceinline__ float bf2f(bf16 b) { return __builtin_bit_cast(float, (unsigned)b << 16); }
__device__ __forceinline__ float fexp(float x) { return __builtin_amdgcn_exp2f(x * 1.4426950408889634f); }
__device__ __forceinline__ float flog(float x) { return __builtin_amdgcn_logf(x) * 0.6931471805599453f; }
__device__ __forceinline__ float frcp(float x) { return __builtin_amdgcn_rcpf(x); }
__device__ __forceinline__ float frsq(float x) { return __builtin_amdgcn_rsqf(x); }
__device__ __forceinline__ float sigmoidf_(float x) { return frcp(1.f + fexp(-x)); }
__device__ __forceinline__ float wave_sum(float v) {
#pragma unroll
    for (int o = 1; o < 64; o <<= 1) v += __shfl_xor(v, o);
    return v;
}
__device__ __forceinline__ unsigned wave_max_u(unsigned v) {
#pragma unroll
    for (int o = 1; o < 64; o <<= 1) { const unsigned w = (unsigned)__shfl_xor((int)v, o); v = v > w ? v : w; }
    return v;
}
struct F8 { float v[8]; };
__device__ __forceinline__ void unpack8(const v4u& u, float (&f)[8]) {
    f[0] = bflo(u.x); f[1] = bfhi(u.x); f[2] = bflo(u.y); f[3] = bfhi(u.y); f[4] = bflo(u.z); f[5] = bfhi(u.z); f[6] = bflo(u.w); f[7] = bfhi(u.w);
}
__device__ __forceinline__ v4u pack8(const float (&f)[8]) { v4u o; o.x = pk2(f[0], f[1]); o.y = pk2(f[2], f[3]); o.z = pk2(f[4], f[5]); o.w = pk2(f[6], f[7]); return o; }

#define XB_TMO      128
#define XB_XCNT(j)  (256  + 64 * (j))
#define XB_XSUB(j)  (1280 + 64 * (j))
#define XB_XGEN(j)  (2304 + 64 * (j))
#define XB_TOP      3328
#define XB_TOPGEN   3392
#define XCD_BAR_WORDS 3456
#define XB_SPIN_CAP (1u << 24)

__device__ __forceinline__ unsigned xb_ld(unsigned* p)              { return __hip_atomic_load(p, __ATOMIC_RELAXED, __HIP_MEMORY_SCOPE_AGENT); }
__device__ __forceinline__ unsigned xb_add(unsigned* p, unsigned v) { return __hip_atomic_fetch_add(p, v, __ATOMIC_RELAXED, __HIP_MEMORY_SCOPE_AGENT); }
__device__ __forceinline__ unsigned xb_xcc_id() { return (unsigned)__builtin_amdgcn_s_getreg((3 << 11) | 20) & 0xFu; }
#define XB_SPIN(cond, bar) do { unsigned _sp = 0; while (cond) { __builtin_amdgcn_s_sleep(1); \
    if ((++_sp & 255u) == 0u) { if (xb_ld(&(bar)[XB_TMO])) break; if (_sp > XB_SPIN_CAP) { atomicAdd(&(bar)[XB_TMO], 1u); break; } } } } while (0)

struct XcdBarrier {
    unsigned* bar; unsigned x;
    volatile LAS unsigned* st;
};

__device__ __forceinline__ XcdBarrier xcd_barrier_post(unsigned* bar, volatile LAS unsigned* st) {
    XcdBarrier b; b.bar = bar; b.x = xb_xcc_id(); b.st = st;
    if (threadIdx.x == 0) (void)xb_add(&bar[XB_XCNT(b.x)], 1u);
    return b;
}
__device__ __forceinline__ void xcd_barrier_complete(unsigned* bar, unsigned x, unsigned& nloc, unsigned& nx) {
    const unsigned G = gridDim.x * gridDim.y * gridDim.z;
    unsigned sum, cnt, mine, sp = 0u;
    for (;;) {
        sum = 0u; cnt = 0u; mine = 0u;
#pragma unroll
        for (unsigned j = 0; j < 16; ++j) { const unsigned c = xb_ld(&bar[XB_XCNT(j)]); sum += c; cnt += (c > 0u) ? 1u : 0u; mine = (j == x) ? c : mine; }
        if (sum == G) break;
        __builtin_amdgcn_s_sleep(1);
        if ((++sp & 255u) == 0u) { if (xb_ld(&bar[XB_TMO])) break; if (sp > XB_SPIN_CAP) { atomicAdd(&bar[XB_TMO], 1u); break; } }
    }
    nloc = mine > 0u ? mine : 1u; nx = cnt > 0u ? cnt : 1u;
}

__device__ __forceinline__ void xcd_barrier(const XcdBarrier& b) {
    asm volatile("s_waitcnt vmcnt(0)" ::: "memory");
    __syncthreads();
    if (threadIdx.x == 0) {
        unsigned* bar = b.bar;
        __builtin_amdgcn_s_waitcnt(0);
        unsigned nloc = b.st[0], nx = b.st[1];
        if (nloc == 0u) { xcd_barrier_complete(bar, b.x, nloc, nx); b.st[0] = nloc; b.st[1] = nx; }
        const unsigned old = xb_add(&bar[XB_XSUB(b.x)], 1u);
        const unsigned gen = old / nloc;
        if (old + 1u == (gen + 1u) * nloc) {
            __builtin_amdgcn_fence(__ATOMIC_RELEASE, "agent");
            asm volatile("s_waitcnt vmcnt(0)" ::: "memory");
            const unsigned og = xb_add(&bar[XB_TOP], 1u);
            const unsigned tg = og / nx;
            if (og + 1u == (tg + 1u) * nx) xb_add(&bar[XB_TOPGEN], 1u);
            else XB_SPIN(xb_ld(&bar[XB_TOPGEN]) == tg, bar);
            __builtin_amdgcn_fence(__ATOMIC_ACQUIRE, "agent");
            xb_add(&bar[XB_XGEN(b.x)], 1u);
            asm volatile("s_waitcnt vmcnt(0)" ::: "memory");
        } else {
            XB_SPIN(xb_ld(&bar[XB_XGEN(b.x)]) == gen, bar);
            __builtin_amdgcn_fence(__ATOMIC_ACQUIRE, "agent");
            asm volatile("s_waitcnt vmcnt(0)" ::: "memory");
        }
    }
    __syncthreads();
}

struct EpiProj {
    bf16 *sbqk, *vt, *mlqk, *mlv, *mlo, *gates;
    __device__ __forceinline__ void operator()(int row, int col, const F8& a) const {
        bf16* dst;
        if (col < 1024) dst = sbqk + (size_t)row * 1024 + col;
        else if (col < 1536) {
            const int c = col - 1024, hh = c >> 6, d = c & 63, b = row >> 11, sq = row & 2047;
            bf16* vp = vt + ((size_t)(b * 8 + hh) * 64 + d) * 2048 + sq;
#pragma unroll
            for (int i = 0; i < 8; ++i) vp[(size_t)i * 2048] = (bf16)f2bf(a.v[i]);
            return;
        }
        else if (col < 2560) dst = mlqk + (size_t)row * 1024 + (col - 1536);
        else if (col < 3072) dst = mlv + (size_t)row * 512 + (col - 2560);
        else if (col < 3584) dst = mlo + (size_t)row * 512 + (col - 3072);
        else {
            unsigned q[8];
#pragma unroll
            for (int i = 0; i < 8; ++i) { const float sg = sigmoidf_(a.v[i]) * 255.f + 0.5f; q[i] = (unsigned)fminf(fmaxf(sg, 1.f), 255.f); }
            *(v2u*)((unsigned char*)gates + (size_t)row * 2048 + (col - 3584)) = (v2u){q[0] | (q[1] << 8) | (q[2] << 16) | (q[3] << 24), q[4] | (q[5] << 8) | (q[6] << 16) | (q[7] << 24)};
            return;
        }
        *(v4u*)dst = pack8(a.v);
    }
};
struct EpiMergeA {
    bf16* merged; const bf16* gates;
    __device__ __forceinline__ void operator()(int row, int col, const F8& a) const {
        float g[8], o[8]; unpack8(*(const v4u*)(gates + (size_t)row * 2048 + col), g);
#pragma unroll
        for (int i = 0; i < 8; ++i) o[i] = sigmoidf_(g[i]) * a.v[i];
        *(v4u*)(merged + (size_t)row * 1024 + col) = pack8(o);
    }
};
struct EpiMergeB {
    bf16* merged; const bf16* gates;
    __device__ __forceinline__ void operator()(int row, int col, const F8& a) const {
        float g[8], o[8]; unpack8(*(const v4u*)(gates + (size_t)row * 2048 + 1024 + col), g);
        unpack8(*(const v4u*)(merged + (size_t)row * 1024 + col), o);
#pragma unroll
        for (int i = 0; i < 8; ++i) o[i] += sigmoidf_(g[i]) * a.v[i];
        *(v4u*)(merged + (size_t)row * 1024 + col) = pack8(o);
    }
};
struct EpiH {
    float* h; const float* x;
    __device__ __forceinline__ void operator()(int row, int col, const F8& a) const {
        const f32x4 x0 = *(const f32x4*)(x + (size_t)row * 1024 + col), x1 = *(const f32x4*)(x + (size_t)row * 1024 + col + 4);
        *(f32x4*)(h + (size_t)row * 1024 + col) = (f32x4){x0.x + a.v[0], x0.y + a.v[1], x0.z + a.v[2], x0.w + a.v[3]};
        *(f32x4*)(h + (size_t)row * 1024 + col + 4) = (f32x4){x1.x + a.v[4], x1.y + a.v[5], x1.z + a.v[6], x1.w + a.v[7]};
    }
};
struct EpiF32 {
    float* o; int ldc;
    __device__ __forceinline__ void operator()(int row, int col, const F8& a) const {
        *(f32x4*)(o + (size_t)row * ldc + col) = (f32x4){a.v[0], a.v[1], a.v[2], a.v[3]};
        *(f32x4*)(o + (size_t)row * ldc + col + 4) = (f32x4){a.v[4], a.v[5], a.v[6], a.v[7]};
    }
};

template <class E> struct EpiAdapt {
    static constexpr bool PERM = true, AFTER_DRAIN = false;
    E e;
    __device__ __forceinline__ void operator()(const pg8::f32x4 (&acc)[2][2][4][2], const pg8::Unit& u, int wr, int wc, int fr, int fq) const {
#pragma unroll
        for (int ai = 0; ai < 2; ++ai)
#pragma unroll
            for (int m = 0; m < 4; ++m) {
                const int row = u.pm * 256 + ai * 128 + wr * 64 + m * 16 + fr;
#pragma unroll
                for (int bj = 0; bj < 2; ++bj) {
                    const int col = u.pn * 256 + bj * 128 + wc * 32 + 8 * fq;
                    F8 a; const pg8::f32x4 v0 = acc[ai][bj][m][0], v1 = acc[ai][bj][m][1];
                    a.v[0] = v0[0]; a.v[1] = v0[1]; a.v[2] = v0[2]; a.v[3] = v0[3]; a.v[4] = v1[0]; a.v[5] = v1[1]; a.v[6] = v1[2]; a.v[7] = v1[3];
                    e(row, col, a);
                }
            }
    }
};

struct EpiMerge1 {
    static constexpr bool PERM = true, AFTER_DRAIN = false;
    bf16* merged; const unsigned char* gates;
    static __device__ __forceinline__ void ub8(const v2u& w, float (&f)[8]) {
        f[0] = (float)(w.x & 0xffu); f[1] = (float)((w.x >> 8) & 0xffu); f[2] = (float)((w.x >> 16) & 0xffu); f[3] = (float)(w.x >> 24);
        f[4] = (float)(w.y & 0xffu); f[5] = (float)((w.y >> 8) & 0xffu); f[6] = (float)((w.y >> 16) & 0xffu); f[7] = (float)(w.y >> 24);
    }
    __device__ __forceinline__ void mid(pg8::f32x4 (&acc)[2][2][4][2], const pg8::Unit& u, int wr, int wc, int fr, int fq) const {
#pragma unroll
        for (int ai = 0; ai < 2; ++ai)
#pragma unroll
            for (int m = 0; m < 4; ++m) {
                const int row = u.pm * 256 + ai * 128 + wr * 64 + m * 16 + fr;
#pragma unroll
                for (int bj = 0; bj < 2; ++bj) {
                    const int col = u.pn * 256 + bj * 128 + wc * 32 + 8 * fq;
                    float gs[8], gm[8]; ub8(*(const v2u*)(gates + (size_t)row * 2048 + col), gs); ub8(*(const v2u*)(gates + (size_t)row * 2048 + 1024 + col), gm);
#pragma unroll
                    for (int i = 0; i < 8; ++i) acc[ai][bj][m][i >> 2][i & 3] *= gs[i] * frcp(gm[i]);
                }
            }
    }
    __device__ __forceinline__ void operator()(const pg8::f32x4 (&acc)[2][2][4][2], const pg8::Unit& u, int wr, int wc, int fr, int fq) const {
#pragma unroll
        for (int ai = 0; ai < 2; ++ai)
#pragma unroll
            for (int m = 0; m < 4; ++m) {
                const int row = u.pm * 256 + ai * 128 + wr * 64 + m * 16 + fr;
#pragma unroll
                for (int bj = 0; bj < 2; ++bj) {
                    const int col = u.pn * 256 + bj * 128 + wc * 32 + 8 * fq;
                    float gm[8], o[8]; ub8(*(const v2u*)(gates + (size_t)row * 2048 + 1024 + col), gm);
#pragma unroll
                    for (int i = 0; i < 8; ++i) o[i] = gm[i] * (1.f / 255.f) * acc[ai][bj][m][i >> 2][i & 3];
                    *(v4u*)(merged + (size_t)row * 1024 + col) = pack8(o);
                }
            }
    }
};
struct EpiHW {
    static constexpr bool PERM = true, AFTER_DRAIN = false;
    bf16* h; const float* x; bf16* hw; const float* wffn; float* ss;
    __device__ __forceinline__ void operator()(const pg8::f32x4 (&acc)[2][2][4][2], const pg8::Unit& u, int wr, int wc, int fr, int fq) const {
#pragma unroll
        for (int ai = 0; ai < 2; ++ai)
#pragma unroll
            for (int m = 0; m < 4; ++m) {
                const int row = u.pm * 256 + ai * 128 + wr * 64 + m * 16 + fr;
                float sq = 0.f;
#pragma unroll
                for (int bj = 0; bj < 2; ++bj) {
                    const int col = u.pn * 256 + bj * 128 + wc * 32 + 8 * fq;
                    const size_t o = (size_t)row * 1024 + col;
                    const f32x4 x0 = *(const f32x4*)(x + o), x1 = *(const f32x4*)(x + o + 4);
                    const f32x4 w0 = *(const f32x4*)(wffn + col), w1 = *(const f32x4*)(wffn + col + 4);
                    const pg8::f32x4 v0 = acc[ai][bj][m][0], v1 = acc[ai][bj][m][1];
                    const f32x4 h0 = (f32x4){x0.x + v0[0], x0.y + v0[1], x0.z + v0[2], x0.w + v0[3]}, h1 = (f32x4){x1.x + v1[0], x1.y + v1[1], x1.z + v1[2], x1.w + v1[3]};
                    *(v4u*)(h + o) = (v4u){pk2(h0.x, h0.y), pk2(h0.z, h0.w), pk2(h1.x, h1.y), pk2(h1.z, h1.w)};
                    *(v4u*)(hw + o) = (v4u){pk2(h0.x * w0.x, h0.y * w0.y), pk2(h0.z * w0.z, h0.w * w0.w), pk2(h1.x * w1.x, h1.y * w1.y), pk2(h1.z * w1.z, h1.w * w1.w)};
                    sq += (h0.x * h0.x + h0.y * h0.y) + (h0.z * h0.z + h0.w * h0.w) + (h1.x * h1.x + h1.y * h1.y) + (h1.z * h1.z + h1.w * h1.w);
                }
                sq += __shfl_xor(sq, 16); sq += __shfl_xor(sq, 32);
                if (fq == 0) ss[(size_t)row * 16 + u.pn * 4 + wc] = sq;
            }
    }
};

template <class E>
__device__ __forceinline__ void simple_gemm(LAS unsigned char* lds, const bf16* A, const bf16* Bt, int M, int N, int K, const E& e) {
    LAS float* As = (LAS float*)lds;
    LAS float* Bs = As + 32 * 132;
    const int tid = threadIdx.x, ty = tid >> 4, tx = tid & 15;
    const int ntn = N / 128, ntiles = (M / 128) * ntn;
    for (int tile = blockIdx.x; tile < ntiles; tile += gridDim.x) {
        const int tm = tile / ntn, tn = tile % ntn;
        float acc[4][8];
#pragma unroll
        for (int i = 0; i < 4; ++i)
#pragma unroll
            for (int j = 0; j < 8; ++j) acc[i][j] = 0.f;
        for (int k0 = 0; k0 < K; k0 += 32) {
            {
                const int r = tid >> 2, kq = (tid & 3) * 8;
                float fa[8], fb[8];
                unpack8(*(const v4u*)(A + (size_t)(tm * 128 + r) * K + k0 + kq), fa);
                unpack8(*(const v4u*)(Bt + (size_t)(tn * 128 + r) * K + k0 + kq), fb);
#pragma unroll
                for (int i = 0; i < 8; ++i) { As[(kq + i) * 132 + r] = fa[i]; Bs[(kq + i) * 132 + r] = fb[i]; }
            }
            __syncthreads();
#pragma unroll 8
            for (int k = 0; k < 32; ++k) {
                const f32x4 a4 = *(const LAS f32x4*)(As + k * 132 + ty * 4);
                const f32x4 b0 = *(const LAS f32x4*)(Bs + k * 132 + tx * 8), b1 = *(const LAS f32x4*)(Bs + k * 132 + tx * 8 + 4);
                const float av[4] = {a4.x, a4.y, a4.z, a4.w};
                const float bv[8] = {b0.x, b0.y, b0.z, b0.w, b1.x, b1.y, b1.z, b1.w};
#pragma unroll
                for (int i = 0; i < 4; ++i)
#pragma unroll
                    for (int j = 0; j < 8; ++j) acc[i][j] += av[i] * bv[j];
            }
            __syncthreads();
        }
#pragma unroll
        for (int i = 0; i < 4; ++i) {
            F8 a;
#pragma unroll
            for (int j = 0; j < 8; ++j) a.v[j] = acc[i][j];
            e(tm * 128 + ty * 4 + i, tn * 128 + tx * 8, a);
        }
    }
}

template <class E>
__device__ __forceinline__ void gemm(LAS unsigned char* lds, const bf16* A, const bf16* Bt, int M, int N, int K, const E& e) {
#if USE_PG8
    pg8::Gemm g{A, Bt, M, N, K}; pg8::StaticOrder S; S.init(M, N, (int)gridDim.x, (int)blockIdx.x);
    EpiAdapt<E> ea{e};
    pg8::gemm_phase<EpiAdapt<E>, pg8::StaticOrder, true, true>(lds, g, S, ea);
#else
    simple_gemm<E>(lds, A, Bt, M, N, K, e);
#endif
}

__device__ __forceinline__ void transpose_item(const float* W, int ldw, int K, bf16* WT, int src_col0, int dst_row0, LAS float* scr, int kb, int lane) {
    const int k0 = 64 * kb;
#pragma unroll 8
    for (int i = 0; i < 32; ++i) { const int kk = 2 * i + (lane >> 5); scr[kk * 33 + (lane & 31)] = W[(size_t)(k0 + kk) * ldw + src_col0 + (lane & 31)]; }
    LDS_WAIT(); asm volatile("" ::: "memory");
    const int c = lane & 7;
#pragma unroll
    for (int j = 0; j < 4; ++j) { const int n = (lane >> 3) + 8 * j; const LAS float* s = scr + (8 * c) * 33 + n;
        v4u o; o.x = pk2(s[0 * 33], s[1 * 33]); o.y = pk2(s[2 * 33], s[3 * 33]); o.z = pk2(s[4 * 33], s[5 * 33]); o.w = pk2(s[6 * 33], s[7 * 33]);
        *(v4u*)(WT + (size_t)(dst_row0 + n) * K + k0 + 8 * c) = o; }
    LDS_WAIT(); asm volatile("" ::: "memory");
}

struct P {
    const float *x, *norm_mix_w, *w_in, *conv_w, *conv_b, *b_i, *b_f, *ml_norm_w, *w_sb, *w_ml, *w_out, *norm_ffn_w, *w_query, *keys1, *keys2, *peer_u, *peer_v, *norm_final_w;
    float* out; unsigned char* ws;
};

__device__ __forceinline__ void p0_prologue(const P& p, LAS unsigned char* lds, int wave, int lane) {
    LAS float* scr = (LAS float*)(lds + wave * 8448);
    const int gw = blockIdx.x * NWAVES + wave, NGW = gridDim.x * NWAVES;
    bf16* W1T = (bf16*)(p.ws + WS_W1T); bf16* WSBT = (bf16*)(p.ws + WS_WSBT); bf16* WMLT = (bf16*)(p.ws + WS_WMLT); bf16* WOUTT = (bf16*)(p.ws + WS_WOUTT); bf16* WCT = (bf16*)(p.ws + WS_WCT);
    constexpr int I_1 = 16 * 176, I_SB = 8 * 32, I_ML = 8 * 32, I_O = 16 * 32, NT = I_1 + I_SB + I_ML + I_O;
    for (int it = gw; it < NT; it += NGW) {
        int r = it;
        if (r < I_1) { const int kb = r / 176, nb = r % 176, n0 = nb * 32; transpose_item(p.w_in, INC, 1024, W1T, n0 < 3584 ? n0 : n0 + 8, n0, scr, kb, lane); continue; } r -= I_1;
        if (r < I_SB) { const int kb = r / 32, nb = r % 32; transpose_item(p.w_sb, 1024, 1024, WSBT, nb * 32, nb * 32, scr, kb, lane);             continue; } r -= I_SB;
        if (r < I_ML) { const int kb = r / 32, nb = r % 32; transpose_item(p.w_ml, 1024, 1024, WSBT + 512, nb * 32, nb * 32, scr, kb, lane); continue; } r -= I_ML;
        { const int kb = r / 32, nb = r % 32; transpose_item(p.w_out, 1024, 1024, WOUTT, nb * 32, nb * 32, scr, kb, lane); }
    }
    bf16* XN = (bf16*)(p.ws + WS_XN); float* IFG = (float*)(p.ws + WS_IFG);
    LAS float* WG = (LAS float*)(lds + 8 * 8448);
    __syncthreads();
    for (int i = threadIdx.x; i < 2048; i += NTHR) { const int k = i >> 1, hf = i & 1; *(LAS f32x4*)(WG + k * 8 + hf * 4) = *(const f32x4*)(p.w_in + (size_t)k * INC + 3584 + hf * 4); }
    __syncthreads();
    for (int m0 = gw * 2; m0 < T_; m0 += NGW * 2) {
        const f32x4* wr = (const f32x4*)p.norm_mix_w + lane;
        f32x4 v[2][4]; float ss[2] = {0.f, 0.f};
#pragma unroll
        for (int u = 0; u < 2; ++u) { const f32x4* xr = (const f32x4*)(p.x + (size_t)(m0 + u) * 1024) + lane;
#pragma unroll
            for (int j = 0; j < 4; ++j) v[u][j] = xr[64 * j]; }
#pragma unroll
        for (int u = 0; u < 2; ++u)
#pragma unroll
            for (int j = 0; j < 4; ++j) ss[u] += (v[u][j].x * v[u][j].x + v[u][j].y * v[u][j].y) + (v[u][j].z * v[u][j].z + v[u][j].w * v[u][j].w);
#pragma unroll
        for (int o = 1; o < 64; o <<= 1) { ss[0] += __shfl_xor(ss[0], o); ss[1] += __shfl_xor(ss[1], o); }
#pragma unroll
        for (int u = 0; u < 2; ++u) {
            const int m = m0 + u;
            const float rstd = frsq(ss[u] * (1.f / 1024.f) + EPS);
            float g[8];
#pragma unroll
            for (int i = 0; i < 8; ++i) g[i] = 0.f;
            v2u* o8 = (v2u*)(XN + (size_t)m * 1024) + lane;
#pragma unroll
            for (int j = 0; j < 4; ++j) {
                const f32x4 w = wr[64 * j];
                const float y[4] = {v[u][j].x * rstd * w.x, v[u][j].y * rstd * w.y, v[u][j].z * rstd * w.z, v[u][j].w * rstd * w.w};
                o8[64 * j] = (v2u){pk2(y[0], y[1]), pk2(y[2], y[3])};
#pragma unroll
                for (int q = 0; q < 4; ++q) {
                    const int k = 256 * j + 4 * lane + q;
                    const f32x4 w0 = *(const LAS f32x4*)(WG + k * 8), w1 = *(const LAS f32x4*)(WG + k * 8 + 4);
                    g[0] += y[q] * w0.x; g[1] += y[q] * w0.y; g[2] += y[q] * w0.z; g[3] += y[q] * w0.w;
                    g[4] += y[q] * w1.x; g[5] += y[q] * w1.y; g[6] += y[q] * w1.z; g[7] += y[q] * w1.w;
                }
            }
            {
                const bool b5 = (lane & 32) != 0, b4 = (lane & 16) != 0, b3 = (lane & 8) != 0;
                float e4[4], f2[2], gs;
#pragma unroll
                for (int i = 0; i < 4; ++i) { const float keep = b5 ? g[2 * i + 1] : g[2 * i], send = b5 ? g[2 * i] : g[2 * i + 1]; e4[i] = keep + __shfl_xor(send, 32); }
#pragma unroll
                for (int i = 0; i < 2; ++i) { const float keep = b4 ? e4[2 * i + 1] : e4[2 * i], send = b4 ? e4[2 * i] : e4[2 * i + 1]; f2[i] = keep + __shfl_xor(send, 16); }
                { const float keep = b3 ? f2[1] : f2[0], send = b3 ? f2[0] : f2[1]; gs = keep + __shfl_xor(send, 8); }
                gs += __shfl_xor(gs, 4); gs += __shfl_xor(gs, 2); gs += __shfl_xor(gs, 1);
                const int gi = 4 * (b3 ? 1 : 0) + 2 * (b4 ? 1 : 0) + (b5 ? 1 : 0);
                if ((lane & 7) == 0) IFG[(size_t)m * 8 + gi] = gs + (gi < 4 ? p.b_i[gi] : p.b_f[gi - 4]);
            }
        }
    }
}

__device__ __forceinline__ void fill_wc(const P& p, int it, int lane) {
    bf16* WCT = (bf16*)(p.ws + WS_WCT);
    const int hhf = it >> 6, kb = (it >> 2) & 15, kq = it & 3, head = hhf >> 1, half = hhf & 1, k = kb * 64 + lane;
    const f32x4* wq = (const f32x4*)(p.w_query + (size_t)k * 2048 + head * 256 + half * 128);
    f32x4 wr[32];
#pragma unroll
    for (int i = 0; i < 32; ++i) wr[i] = wq[i];
    const float* kbase = (half ? p.keys2 : p.keys1) + ((size_t)head * 128 + kq * 32) * 128;
#pragma unroll 1
    for (int key = 0; key < 32; ++key) {
        const f32x4* kr = (const f32x4*)(kbase + (size_t)key * 128);
        float a0 = 0.f, a1 = 0.f;
#pragma unroll
        for (int i = 0; i < 32; i += 2) { const f32x4 b0 = kr[i], b1 = kr[i + 1];
            a0 += wr[i].x * b0.x + wr[i].y * b0.y + wr[i].z * b0.z + wr[i].w * b0.w;
            a1 += wr[i + 1].x * b1.x + wr[i + 1].y * b1.y + wr[i + 1].z * b1.z + wr[i + 1].w * b1.w; }
        WCT[(size_t)(hhf * 128 + kq * 32 + key) * 1024 + k] = (bf16)f2bf(a0 + a1);
    }
}
__device__ __forceinline__ void fill_tables(const P& p, int e, int lane) {
    unsigned char* U8 = p.ws + WS_U8; unsigned char* V8 = p.ws + WS_V8; float* USC = (float*)(p.ws + WS_USC); float* VSC = (float*)(p.ws + WS_VSC);
    f32x4 v[2][4]; float am[2] = {0.f, 0.f};
#pragma unroll
    for (int which = 0; which < 2; ++which) {
        const float* src = (which ? p.peer_v : p.peer_u) + (size_t)e * 1024 + 16 * lane;
#pragma unroll
        for (int j = 0; j < 4; ++j) v[which][j] = *(const f32x4*)(src + 4 * j);
    }
#pragma unroll
    for (int which = 0; which < 2; ++which)
#pragma unroll
        for (int j = 0; j < 4; ++j) am[which] = fmaxf(am[which], fmaxf(fmaxf(fabsf(v[which][j].x), fabsf(v[which][j].y)), fmaxf(fabsf(v[which][j].z), fabsf(v[which][j].w))));
#pragma unroll
    for (int o = 1; o < 64; o <<= 1) { am[0] = fmaxf(am[0], __shfl_xor(am[0], o)); am[1] = fmaxf(am[1], __shfl_xor(am[1], o)); }
#pragma unroll
    for (int which = 0; which < 2; ++which) {
        const float sc = am[which] > 0.f ? exp2f(floorf(log2f(448.f / am[which]))) : 1.f;
        unsigned w[4];
#pragma unroll
        for (int j = 0; j < 4; ++j) { int t = __builtin_amdgcn_cvt_pk_fp8_f32(v[which][j].x * sc, v[which][j].y * sc, 0, false); t = __builtin_amdgcn_cvt_pk_fp8_f32(v[which][j].z * sc, v[which][j].w * sc, t, true); w[j] = (unsigned)t; }
        *(v4u*)((which ? V8 : U8) + ((size_t)(lane >> 3) * NEXP + e) * 128 + 16 * (lane & 7)) = (v4u){w[0], w[1], w[2], w[3]};
        if (lane == 0) (which ? VSC : USC)[e] = 1.f / sc;
    }
}
constexpr int N_FILL = 128 + 1024;
__device__ __forceinline__ void fill_item(const P& p, int item, int wave, int lane) {
    if (item < 128) fill_wc(p, item * 8 + wave, lane);
    else { const int e0 = (item - 128) * 16 + wave * 2; fill_tables(p, e0, lane); fill_tables(p, e0 + 1, lane); }
}

typedef short bf16x8 __attribute__((ext_vector_type(8)));
typedef float f32x16 __attribute__((ext_vector_type(16)));
#define MFMA32(a, b, c) __builtin_amdgcn_mfma_f32_32x32x16_bf16((a), (b), (c), 0, 0, 0)
__device__ __forceinline__ int crow(int reg, int hh) { return (reg & 3) + 8 * (reg >> 2) + 4 * hh; }
template <int S> __device__ __forceinline__ bf16x8 pack_step(const f32x16& x) {
    v4u p; p.x = cvtpk(x[8 * S], x[8 * S + 1]); p.y = cvtpk(x[8 * S + 2], x[8 * S + 3]); p.z = cvtpk(x[8 * S + 4], x[8 * S + 5]); p.w = cvtpk(x[8 * S + 6], x[8 * S + 7]);
    return __builtin_bit_cast(bf16x8, p);
}
__device__ __forceinline__ bf16x8 frag2(const v2u& lo, const v2u& hi) { v4u p; p.x = lo.x; p.y = lo.y; p.z = hi.x; p.w = hi.y; return __builtin_bit_cast(bf16x8, p); }
__device__ __forceinline__ f32x16 zero16() { f32x16 z; for (int i = 0; i < 16; ++i) z[i] = 0.f; return z; }


__device__ __forceinline__ void p2_conv(const P& p, int tid) {
    const bf16* MLQK = (const bf16*)(p.ws + WS_MLQK); bf16* QC = (bf16*)(p.ws + WS_QC); bf16* KC = (bf16*)(p.ws + WS_KC);
    const int cg = tid & 127, ch0 = 8 * cg;
    float cw[4][8], cb[8];
#pragma unroll
    for (int i = 0; i < 8; ++i) { cb[i] = p.conv_b[ch0 + i];
#pragma unroll
        for (int j = 0; j < 4; ++j) cw[j][i] = p.conv_w[j * 1024 + ch0 + i]; }
    const float osc = cg >= 64 ? 0.08838834764831845f : 1.f;
    bf16* dst = (cg >= 64 ? KC : QC) + (cg & 63) * 8;
    for (int rg = blockIdx.x * 4 + (tid >> 7); rg < T_ / 4; rg += gridDim.x * 4) {
        const int tok = rg * 4, pos0 = tok & (S_ - 1);
        v4u xr[7];
#pragma unroll
        for (int k = 0; k < 7; ++k) xr[k] = (pos0 + k - 3 >= 0) ? *(const v4u*)(MLQK + (size_t)(tok + k - 3) * 1024 + ch0) : (v4u){0u, 0u, 0u, 0u};
#pragma unroll
        for (int tt = 0; tt < 4; ++tt) {
            float y[8];
#pragma unroll
            for (int i = 0; i < 8; ++i) y[i] = cb[i];
#pragma unroll
            for (int j = 0; j < 4; ++j) { float f[8]; unpack8(xr[tt + j], f);
#pragma unroll
                for (int i = 0; i < 8; ++i) y[i] += cw[j][i] * f[i]; }
#pragma unroll
            for (int i = 0; i < 8; ++i) y[i] = y[i] * sigmoidf_(y[i]) * osc;
            *(v4u*)(dst + (size_t)(tok + tt) * 512) = pack8(y);
        }
    }
}

constexpr int ML_QS = 0, ML_KS = 17408, ML_KWT = 34816, ML_VTL = 53248, ML_PS = 71680, ML_CT = 80896, ML_SCAL = 115712, ML_SSP = 118272, ML_QN = ML_SSP + 512, ML_F1 = ML_QN + 256, ML_F2 = ML_F1 + 256, ML_NV = ML_F2 + 256;
static_assert(ML_NV + 512 <= RING_BYTES, "mLSTM LDS map");
__device__ __forceinline__ void mlstm_scal(float ip, float fp, LAS float* sc, float& m_carry, int lane) {
    const float lf = fminf(fp, 0.f) - flog(1.f + fexp(-fabsf(fp)));
    float bc = lf;
#pragma unroll
    for (int o = 1; o < 64; o <<= 1) { const float t2 = __shfl_up(bc, o); if (lane >= o) bc += t2; }
    const float a = ip - bc; float pm = a;
#pragma unroll
    for (int o = 1; o < 64; o <<= 1) { const float t2 = __shfl_up(pm, o); if (lane >= o) pm = fmaxf(pm, t2); }
    const float M = fmaxf(m_carry, pm);
    const float M63 = __shfl(M, 63), bc63 = __shfl(bc, 63);
    sc[lane] = a; sc[64 + lane] = M; sc[128 + lane] = fexp(a - M63); sc[192 + lane] = fexp(m_carry - M); sc[256 + lane] = fexp(-(bc + M));
    m_carry = bc63 + M63;
}
__device__ __forceinline__ void mlstm_item(const P& p, LAS unsigned char* lds, int item, int tid, int wave, int lane) {
    const int b = item >> 2, h = item & 3;
    const int r = lane & 31, hh = lane >> 5, et = wave & 3, th = wave >> 2;
    const bf16* QC = (const bf16*)(p.ws + WS_QC); const bf16* KC = (const bf16*)(p.ws + WS_KC); const bf16* MLV = (const bf16*)(p.ws + WS_MLV); const float* IFG = (const float*)(p.ws + WS_IFG);
    bf16* HML = (bf16*)p.out + 512;
    LAS float* SCAL = (LAS float*)(lds + ML_SCAL); LAS float* SSP = (LAS float*)(lds + ML_SSP); LAS float* QN = (LAS float*)(lds + ML_QN);
    LAS float* F1 = (LAS float*)(lds + ML_F1); LAS float* F2 = (LAS float*)(lds + ML_F2); LAS float* NV = (LAS float*)(lds + ML_NV);
    const int cg = tid & 15, trow = tid >> 4, eg = cg, sl = trow;
    const size_t hq = (size_t)h * 128 + 8 * cg;
    for (int i = tid; i < (128 * 136 * 2) / 4; i += NTHR) ((LAS unsigned*)(lds + ML_CT))[i] = 0u;
    if (tid < 128) NV[tid] = 0.f;
    f32x16 accC[2]; accC[0] = zero16(); accC[1] = zero16();
    float m_carry = 0.f;
    if (wave == 3) { const size_t tk = (size_t)b * S_ + lane; mlstm_scal(IFG[tk * 8 + h], IFG[tk * 8 + 4 + h], SCAL, m_carry, lane); }
    v4u pq[2], pk[2], pv[2];
    {
        const size_t t0 = (size_t)b * S_;
#pragma unroll
        for (int u = 0; u < 2; ++u) { pq[u] = *(const v4u*)(QC + (t0 + trow + 32 * u) * 512 + hq); pk[u] = *(const v4u*)(KC + (t0 + trow + 32 * u) * 512 + hq); pv[u] = *(const v4u*)(MLV + (t0 + sl + 32 * u) * 512 + hq); }
    }
    float ipn = 0.f, fpn = 0.f;
    __syncthreads();
    for (int c = 0; c < 32; ++c) {
        const size_t tok0 = (size_t)b * S_ + c * 64;
        LAS float* sc = SCAL + (c & 1) * 320;
        {
#pragma unroll
            for (int u = 0; u < 2; ++u) {
                const int t = trow + 32 * u;
                *(LAS v4u*)(lds + ML_QS + t * 272 + cg * 16) = pq[u];
                *(LAS v4u*)(lds + ML_KS + t * 272 + cg * 16) = pk[u];
                float f[8]; unpack8(pk[u], f);
                const float wk = sc[128 + t];
#pragma unroll
                for (int i = 0; i < 8; ++i) *(LAS bf16*)(lds + ML_KWT + (8 * cg + i) * 144 + ((t ^ (8 * (cg & 7))) * 2)) = (bf16)f2bf(f[i] * wk);
                const unsigned vv[4] = {pv[u].x, pv[u].y, pv[u].z, pv[u].w};
#pragma unroll
                for (int i = 0; i < 4; ++i) {
                    *(LAS bf16*)(lds + ML_VTL + (8 * eg + 2 * i) * 144 + ((t ^ (8 * (eg & 7))) * 2)) = (bf16)(vv[i] & 0xffffu);
                    *(LAS bf16*)(lds + ML_VTL + (8 * eg + 2 * i + 1) * 144 + ((t ^ (8 * (eg & 7))) * 2)) = (bf16)(vv[i] >> 16);
                }
            }
            if (c + 1 < 32) {
                const size_t t1 = tok0 + 64;
#pragma unroll
                for (int u = 0; u < 2; ++u) { pq[u] = *(const v4u*)(QC + (t1 + trow + 32 * u) * 512 + hq); pk[u] = *(const v4u*)(KC + (t1 + trow + 32 * u) * 512 + hq); pv[u] = *(const v4u*)(MLV + (t1 + sl + 32 * u) * 512 + hq); }
                if (wave == 3) { ipn = IFG[(t1 + lane) * 8 + h]; fpn = IFG[(t1 + lane) * 8 + 4 + h]; }
            }
        }
        __syncthreads();
        f32x16 acc_inter = zero16();
        if (wave < 3) {
            const int tt = wave > 0 ? 1 : 0, st = wave == 2 ? 1 : 0;
            f32x16 zt = zero16();
#pragma unroll
            for (int ks = 0; ks < 8; ++ks) {
                const bf16x8 ka = *(const LAS bf16x8*)(lds + ML_KS + (32 * st + r) * 272 + 32 * ks + 16 * hh);
                const bf16x8 qb = *(const LAS bf16x8*)(lds + ML_QS + (32 * tt + r) * 272 + 32 * ks + 16 * hh);
                zt = MFMA32(ka, qb, zt);
            }
            const int t = 32 * tt + r; const float Mt = sc[64 + t];
            float ps = 0.f;
#pragma unroll
            for (int g = 0; g < 4; ++g) {
                const f32x4 av = *(const LAS f32x4*)(sc + 32 * st + 8 * g + 4 * hh);
                float pv[4];
#pragma unroll
                for (int q = 0; q < 4; ++q) { const int sidx = 32 * st + 8 * g + 4 * hh + q;
                    const float wgt = sidx <= t ? fexp(av[q] - Mt) : 0.f; pv[q] = zt[4 * g + q] * wgt; ps += pv[q]; }
                *(LAS v2u*)(lds + ML_PS + t * 144 + (32 * st + 8 * g + 4 * hh) * 2) = (v2u){cvtpk(pv[0], pv[1]), cvtpk(pv[2], pv[3])};
            }
            ps += __shfl_xor(ps, 32);
            if (hh == 0) { SSP[st * 64 + t] = ps; if (wave == 0) SSP[64 + t] = 0.f; }
        }
        if (wave == 3 && c + 1 < 32) mlstm_scal(ipn, fpn, SCAL + ((c + 1) & 1) * 320, m_carry, lane);
#pragma unroll
        for (int ks = 0; ks < 8; ++ks) {
            const bf16x8 qa = *(const LAS bf16x8*)(lds + ML_QS + (32 * th + r) * 272 + 32 * ks + 16 * hh);
            const bf16x8 cbf = *(const LAS bf16x8*)(lds + ML_CT + (32 * et + r) * 272 + 32 * ks + 16 * hh);
            acc_inter = MFMA32(qa, cbf, acc_inter);
        }
        {
            const int t = tid >> 3, part = tid & 7;
            float f[8], sum = 0.f;
            { const v4u tq = *(const LAS v4u*)(lds + ML_QS + t * 272 + part * 32); unpack8(tq, f); }
#pragma unroll
            for (int i = 0; i < 8; ++i) sum += f[i] * NV[16 * part + i];
            { const v4u tq = *(const LAS v4u*)(lds + ML_QS + t * 272 + part * 32 + 16); unpack8(tq, f); }
#pragma unroll
            for (int i = 0; i < 8; ++i) sum += f[i] * NV[16 * part + 8 + i];
            sum += __shfl_xor(sum, 1); sum += __shfl_xor(sum, 2); sum += __shfl_xor(sum, 4);
            if (part == 0) QN[t] = sum;
        }
        __syncthreads();
        f32x16 acc_intra = zero16();
#pragma unroll
        for (int ks = 0; ks < 4; ++ks) {
            if (ks < 2 || th == 1) {
                const bf16x8 pa = *(const LAS bf16x8*)(lds + ML_PS + (32 * th + r) * 144 + 32 * ks + 16 * hh);
                const bf16x8 vb = *(const LAS bf16x8*)(lds + ML_VTL + (32 * et + r) * 144 + 16 * ((2 * ks + hh) ^ (((32 * et + r) >> 3) & 7)));
                acc_intra = MFMA32(pa, vb, acc_intra);
            }
        }
        if (tid < 64) {
            const float wi = sc[192 + tid];
            const float den = SSP[tid] + SSP[64 + tid] + wi * QN[tid];
            const float f1 = frcp(fmaxf(fabsf(den), sc[256 + tid]));
            F1[tid] = f1; F2[tid] = wi * f1;
        }
        const float decay = sc[192 + 63];
#pragma unroll
        for (int dt = 0; dt < 2; ++dt) {
#pragma unroll
            for (int i = 0; i < 16; ++i) accC[dt][i] *= decay;
#pragma unroll
            for (int ks = 0; ks < 4; ++ks) {
                const bf16x8 ka = *(const LAS bf16x8*)(lds + ML_KWT + (64 * th + 32 * dt + r) * 144 + 16 * ((2 * ks + hh) ^ (((64 * th + 32 * dt + r) >> 3) & 7)));
                const bf16x8 vb = *(const LAS bf16x8*)(lds + ML_VTL + (32 * et + r) * 144 + 16 * ((2 * ks + hh) ^ (((32 * et + r) >> 3) & 7)));
                accC[dt] = MFMA32(ka, vb, accC[dt]);
            }
        }
        {
            const int d = tid >> 2, part = tid & 3;
            float f[8], sum = 0.f;
            { const v4u tq = *(const LAS v4u*)(lds + ML_KWT + d * 144 + part * 32); unpack8(tq, f); }
#pragma unroll
            for (int i = 0; i < 8; ++i) sum += f[i];
            { const v4u tq = *(const LAS v4u*)(lds + ML_KWT + d * 144 + part * 32 + 16); unpack8(tq, f); }
#pragma unroll
            for (int i = 0; i < 8; ++i) sum += f[i];
            sum += __shfl_xor(sum, 1); sum += __shfl_xor(sum, 2);
            if (part == 0) NV[d] = decay * NV[d] + sum;
        }
        __syncthreads();
        {
            bf16* hp = HML + (tok0 + 32 * th) * 1024 + h * 128 + 32 * et + r;
#pragma unroll
            for (int g = 0; g < 4; ++g) {
                const f32x4 f1v = *(const LAS f32x4*)(F1 + 32 * th + 8 * g + 4 * hh), f2v = *(const LAS f32x4*)(F2 + 32 * th + 8 * g + 4 * hh);
#pragma unroll
                for (int q = 0; q < 4; ++q) { const int tl = 8 * g + 4 * hh + q;
                    hp[(size_t)tl * 1024] = (bf16)f2bf(acc_intra[4 * g + q] * f1v[q] + acc_inter[4 * g + q] * f2v[q]); }
            }
#pragma unroll
            for (int dt = 0; dt < 2; ++dt)
#pragma unroll
                for (int g = 0; g < 4; ++g)
                    *(LAS v2u*)(lds + ML_CT + (32 * et + r) * 272 + (64 * th + 32 * dt + 8 * g + 4 * hh) * 2) = (v2u){cvtpk(accC[dt][4 * g], accC[dt][4 * g + 1]), cvtpk(accC[dt][4 * g + 2], accC[dt][4 * g + 3])};
        }
    }
    __syncthreads();
}

constexpr int SBW_KS = 144, SBW_VS = 80, SBW_VOFF = 32 * SBW_KS, SBW_BYTES = SBW_VOFF + 64 * SBW_VS;
static_assert(8 * SBW_BYTES <= RING_BYTES, "SBA per-wave LDS slices");
__device__ __forceinline__ void sba_wave_item(const bf16* __restrict__ QK, const bf16* __restrict__ VT, bf16* __restrict__ YSB, LAS unsigned char* wl, int b, int h, int qt, int lane) {
    const int r = lane & 31, hh = lane >> 5, t0 = qt * 32;
    const size_t rowbase = (size_t)b * S_;
    bf16x8 qf[4];
    {
        const bf16* qp = QK + (rowbase + t0 + r) * 1024 + h * 64 + 8 * hh;
#pragma unroll
        for (int ks = 0; ks < 4; ++ks) qf[ks] = *(const bf16x8*)(qp + 16 * ks);
    }
    bf16x8 tri[2];
#pragma unroll
    for (int s2 = 0; s2 < 2; ++s2)
#pragma unroll
        for (int j = 0; j < 8; ++j) { const int rho = 16 * s2 + 8 * (j >> 2) + 4 * hh + (j & 3); tri[s2][j] = (rho > r) ? (short)0x3F80 : (short)0; }
    f32x16 o0 = zero16(), o1 = zero16();
    float carry = 0.f;
    const bf16* kg = QK + (rowbase + (lane >> 3)) * 1024 + 512 + h * 64 + 8 * (lane & 7);
    const bf16* vg = VT + ((size_t)(b * 8 + h) * 64 + (lane >> 2)) * 2048 + 8 * (lane & 3);
    LAS unsigned char* kw = wl + (lane >> 3) * SBW_KS + 16 * (lane & 7);
    LAS unsigned char* vw = wl + SBW_VOFF + (lane >> 2) * SBW_VS + 16 * (lane & 3);
    const LAS unsigned char* kr = wl + r * SBW_KS + 16 * hh;
    const LAS unsigned char* vr = wl + SBW_VOFF + r * SBW_VS + 8 * hh;
    v4u kt[4], vt[4];
#pragma unroll
    for (int i = 0; i < 4; ++i) { kt[i] = *(const v4u*)(kg + (size_t)(t0 + 8 * i) * 1024); vt[i] = *(const v4u*)(vg + (size_t)(16 * i) * 2048 + t0); }
    for (int s0 = t0; s0 >= 0; s0 -= 32) {
#pragma unroll
        for (int i = 0; i < 4; ++i) { *(LAS v4u*)(kw + 8 * i * SBW_KS) = kt[i]; *(LAS v4u*)(vw + 16 * i * SBW_VS) = vt[i]; }
        const int sn = s0 >= 32 ? s0 - 32 : 0;
#pragma unroll
        for (int i = 0; i < 4; ++i) { kt[i] = *(const v4u*)(kg + (size_t)(sn + 8 * i) * 1024); vt[i] = *(const v4u*)(vg + (size_t)(16 * i) * 2048 + sn); }
        bf16x8 kf[4]; v2u vl[2][2], vh[2][2];
#pragma unroll
        for (int ks = 0; ks < 4; ++ks) kf[ks] = *(const LAS bf16x8*)(kr + 32 * ks);
#pragma unroll
        for (int dt = 0; dt < 2; ++dt)
#pragma unroll
            for (int s2 = 0; s2 < 2; ++s2) { const LAS unsigned char* vp = vr + dt * 32 * SBW_VS + 32 * s2; vl[dt][s2] = *(const LAS v2u*)vp; vh[dt][s2] = *(const LAS v2u*)(vp + 16); }
        f32x16 z = zero16();
#pragma unroll
        for (int ks = 0; ks < 4; ++ks) z = MFMA32(kf[ks], qf[ks], z);
        const bool diag = (s0 == t0);
        f32x16 sp; float rs = 0.f;
#pragma unroll
        for (int i = 0; i < 16; ++i) {
            const float zz = z[i] * 0.125f;
            const bool valid = !diag || (crow(i, hh) < r);
            float spv = fmaxf(zz, 0.f) + flog(1.f + fexp(-fabsf(zz)));
            spv = valid ? spv : 0.f;
            sp[i] = spv; rs += spv; z[i] = zz - spv;
        }
        f32x16 suf = zero16();
        suf = MFMA32(tri[0], pack_step<0>(sp), suf);
        suf = MFMA32(tri[1], pack_step<1>(sp), suf);
        f32x16 w;
#pragma unroll
        for (int i = 0; i < 16; ++i) {
            const bool valid = !diag || (crow(i, hh) < r);
            const float lw = z[i] - suf[i] - carry;
            w[i] = valid ? fexp(lw) : 0.f;
        }
        rs += __shfl_xor(rs, 32);
        carry += rs;
        const bf16x8 pa0 = pack_step<0>(w), pa1 = pack_step<1>(w);
        o0 = MFMA32(pa0, frag2(vl[0][0], vh[0][0]), o0); o0 = MFMA32(pa1, frag2(vl[0][1], vh[0][1]), o0);
        o1 = MFMA32(pa0, frag2(vl[1][0], vh[1][0]), o1); o1 = MFMA32(pa1, frag2(vl[1][1], vh[1][1]), o1);
        if (__all(carry > 104.f)) break;
    }
    bf16* op = YSB + (rowbase + t0) * 1024 + h * 64 + r;
#pragma unroll
    for (int i = 0; i < 16; ++i) { const int t = crow(i, hh); op[(size_t)t * 1024] = (bf16)f2bf(o0[i]); op[(size_t)t * 1024 + 32] = (bf16)f2bf(o1[i]); }
}
__device__ __forceinline__ void sba_item(const P& p, LAS unsigned char* lds, int item, int wave, int lane) {
    const int bh = item >> 3, qb = item & 7, b = bh >> 3, h = bh & 7;
    sba_wave_item((const bf16*)(p.ws + WS_SBQKV), (const bf16*)(p.ws + WS_VT), (bf16*)p.out, lds + wave * SBW_BYTES, b, h, qb * 8 + wave, lane);
}

__device__ __forceinline__ void p3_yml(const P& p, int wave, int lane) {
    const int gw = blockIdx.x * NWAVES + wave, NGW = gridDim.x * NWAVES;
    bf16* YML = (bf16*)p.out + 512; const bf16* MLO = (const bf16*)(p.ws + WS_MLO);
    for (int m0 = gw * 4; m0 < T_; m0 += NGW * 4) {
        v4u hr[4], orr[4];
#pragma unroll
        for (int u = 0; u < 4; ++u) { hr[u] = *(const v4u*)(YML + (size_t)(m0 + u) * 1024 + lane * 8); orr[u] = *(const v4u*)(MLO + (size_t)(m0 + u) * 512 + lane * 8); }
        const f32x4 w0 = *(const f32x4*)(p.ml_norm_w + lane * 8), w1 = *(const f32x4*)(p.ml_norm_w + lane * 8 + 4);
        const float wv[8] = {w0.x, w0.y, w0.z, w0.w, w1.x, w1.y, w1.z, w1.w};
#pragma unroll
        for (int u = 0; u < 4; ++u) {
            float hv[8], ov[8], o[8];
            unpack8(hr[u], hv); unpack8(orr[u], ov);
            float ss = 0.f;
#pragma unroll
            for (int i = 0; i < 8; ++i) ss += hv[i] * hv[i];
            ss += __shfl_xor(ss, 1); ss += __shfl_xor(ss, 2); ss += __shfl_xor(ss, 4); ss += __shfl_xor(ss, 8);
            const float rstd = frsq(ss * (1.f / 128.f) + EPS);
#pragma unroll
            for (int i = 0; i < 8; ++i) o[i] = sigmoidf_(ov[i]) * hv[i] * rstd * wv[i];
            *(v4u*)(YML + (size_t)(m0 + u) * 1024 + lane * 8) = pack8(o);
        }
    }
}

__device__ __forceinline__ void p6_hn(const P& p, int wave, int lane) {
    const int gw = blockIdx.x * NWAVES + wave, NGW = gridDim.x * NWAVES;
    const float* H = (const float*)(p.ws + WS_H); bf16* HN = (bf16*)(p.ws + WS_HN);
    for (int m = gw; m < T_; m += NGW) {
        const f32x4* xr = (const f32x4*)(H + (size_t)m * 1024) + lane; const f32x4* wr = (const f32x4*)p.norm_ffn_w + lane;
        f32x4 v[4]; float ss = 0.f;
#pragma unroll
        for (int j = 0; j < 4; ++j) { v[j] = xr[64 * j]; ss += (v[j].x * v[j].x + v[j].y * v[j].y) + (v[j].z * v[j].z + v[j].w * v[j].w); }
        const float rstd = frsq(wave_sum(ss) * (1.f / 1024.f) + EPS);
        v2u* o8 = (v2u*)(HN + (size_t)m * 1024) + lane;
#pragma unroll
        for (int j = 0; j < 4; ++j) { const f32x4 w = wr[64 * j]; o8[64 * j] = (v2u){pk2(v[j].x * rstd * w.x, v[j].y * rstd * w.y), pk2(v[j].z * rstd * w.z, v[j].w * rstd * w.w)}; }
    }
}

__device__ __forceinline__ float ffn_rstd(const float* SS, int m) {
    const f32x4* q = (const f32x4*)(SS + (size_t)m * 16); const f32x4 a = q[0], b = q[1], c = q[2], d = q[3];
    const float t = ((a.x + a.y) + (a.z + a.w)) + ((b.x + b.y) + (b.z + b.w)) + ((c.x + c.y) + (c.z + c.w)) + ((d.x + d.y) + (d.z + d.w));
    return frsq(t * (1.f / 1024.f) + EPS);
}
__device__ __forceinline__ unsigned ord_key(float f) { const unsigned u = __builtin_bit_cast(unsigned, f); return (u & 0x80000000u) ? ~u : (u | 0x80000000u); }
__device__ __forceinline__ float ord_val(unsigned k) { const unsigned u = (k & 0x80000000u) ? (k & 0x7fffffffu) : ~k; return __builtin_bit_cast(float, u); }
template <int CTRL> __device__ __forceinline__ unsigned dpp_u(unsigned v) { return (unsigned)__builtin_amdgcn_update_dpp(0, (int)v, CTRL, 0xF, 0xF, true); }
__device__ __forceinline__ unsigned umax_(unsigned a, unsigned b) { return a > b ? a : b; }
__device__ __forceinline__ unsigned umin_(unsigned a, unsigned b) { return a < b ? a : b; }
__device__ __forceinline__ unsigned row_max_u(unsigned v) {
    v = umax_(v, dpp_u<0xB1>(v)); v = umax_(v, dpp_u<0x4E>(v)); v = umax_(v, dpp_u<0x141>(v)); v = umax_(v, dpp_u<0x140>(v)); return v;
}
__device__ __forceinline__ float row_sum_f(float v) {
    v += __builtin_bit_cast(float, dpp_u<0xB1>(__builtin_bit_cast(unsigned, v))); v += __builtin_bit_cast(float, dpp_u<0x4E>(__builtin_bit_cast(unsigned, v)));
    v += __builtin_bit_cast(float, dpp_u<0x141>(__builtin_bit_cast(unsigned, v))); v += __builtin_bit_cast(float, dpp_u<0x140>(__builtin_bit_cast(unsigned, v))); return v;
}
#define CE_(i, j) do { const unsigned _a = k[i], _b = k[j]; k[i] = umax_(_a, _b); k[j] = umin_(_a, _b); } while (0)
__device__ __forceinline__ unsigned row_top16(unsigned (&k)[8], unsigned (&top)[16], int li) {
    CE_(0, 1); CE_(2, 3); CE_(4, 5); CE_(6, 7); CE_(0, 2); CE_(1, 3); CE_(4, 6); CE_(5, 7); CE_(1, 2); CE_(5, 6);
    CE_(0, 4); CE_(1, 5); CE_(2, 6); CE_(3, 7); CE_(2, 4); CE_(3, 5); CE_(1, 2); CE_(3, 4); CE_(5, 6);
    unsigned mine = 0u;
#pragma unroll
    for (int n = 0; n < 16; ++n) {
        const unsigned m = row_max_u(k[0]);
        const bool hit = k[0] == m;
#pragma unroll
        for (int i = 0; i < 7; ++i) k[i] = hit ? k[i + 1] : k[i];
        k[7] = hit ? 0u : k[7];
        top[n] = m; mine = (li == n) ? m : mine;
    }
    return mine;
}
__device__ __forceinline__ void topk_core(const float (&s1)[8], const float (&s2)[8], float rstd, int li, int lane, int& e_out, float& g_out) {
    unsigned k[8], top1[16], top2[16];
#pragma unroll
    for (int j = 0; j < 8; ++j) k[j] = (ord_key(s1[j]) & ~0x7fu) | (unsigned)(127 - (li + 16 * j));
    const unsigned mine1 = row_top16(k, top1, li);
#pragma unroll
    for (int j = 0; j < 8; ++j) k[j] = (ord_key(s2[j]) & ~0x7fu) | (unsigned)(127 - (li + 16 * j));
    const unsigned mine2 = row_top16(k, top2, li);
    const float v2 = ord_val(mine2 & ~0x7fu);
    unsigned c[16];
#pragma unroll
    for (int j = 0; j < 16; ++j) {
        const float v1 = ord_val(top1[j] & ~0x7fu);
        const unsigned key = (ord_key(v1 + v2) & ~0xffu) | (unsigned)(255 - (16 * j + li));
        c[j] = ((j + 1) * (li + 1) <= 16) ? key : 0u;
    }
    unsigned tk = 0u, t0 = 0u;
#pragma unroll
    for (int n = 0; n < 16; ++n) {
        const unsigned mx = row_max_u(c[0]);
        const bool hit = c[0] == mx;
#pragma unroll
        for (int i = 0; i < 15; ++i) c[i] = hit ? c[i + 1] : c[i];
        c[15] = hit ? 0u : c[15];
        if (n == 0) t0 = mx;
        tk = (li == n) ? mx : tk;
    }
    const float sv = ord_val(tk & ~0xffu), s0 = ord_val(t0 & ~0xffu);
    const int cc = 255 - (int)(tk & 0xffu), a = (cc >> 4) & 15, bb = cc & 15;
    const int i1 = 127 - (int)((unsigned)__shfl((int)mine1, (lane & 48) + a) & 0x7fu), i2 = 127 - (int)((unsigned)__shfl((int)mine2, (lane & 48) + bb) & 0x7fu);
    const float pe = fexp((sv - s0) * rstd);
    const float den = row_sum_f(pe);
    e_out = i1 * 128 + i2; g_out = pe * frcp(den);
}
constexpr int TK_RS = 1040;
struct EpiTopk {
    static constexpr bool PERM = true, AFTER_DRAIN = true;
    int* IDX; float* GATE; const float* SS; unsigned short* IDX16;
    __device__ __forceinline__ void fused(pg8::f32x4 (&acc)[2][2][4][2], const pg8::Unit& u, int wr, int wc, int fr, int fq, PG8_LAS unsigned char* lds, int wid, int lane) const {
        const int head = u.pn, q = lane >> 4, li = lane & 15;
#pragma unroll
        for (int ai = 0; ai < 2; ++ai) {
#pragma unroll
            for (int m = 0; m < 4; ++m)
#pragma unroll
                for (int bj = 0; bj < 2; ++bj) {
                    PG8_LAS unsigned char* dst = lds + (wr * 64 + m * 16 + fr) * TK_RS + (bj * 128 + wc * 32 + 8 * fq) * 4;
                    *(PG8_LAS pg8::f32x4*)dst = acc[ai][bj][m][0]; *(PG8_LAS pg8::f32x4*)(dst + 16) = acc[ai][bj][m][1];
                }
            __syncthreads();
#pragma unroll 1
            for (int it = 0; it < 4; it += 2) {
                const int rowa = 16 * wid + 4 * it + q, rowb = rowa + 4, ma = u.pm * 256 + ai * 128 + rowa, mb = ma + 4;
                const PG8_LAS float* sa = (const PG8_LAS float*)(lds + rowa * TK_RS); const PG8_LAS float* sb = (const PG8_LAS float*)(lds + rowb * TK_RS);
                float a1[8], a2[8], b1[8], b2[8];
#pragma unroll
                for (int j = 0; j < 8; ++j) { a1[j] = sa[li + 16 * j]; a2[j] = sa[128 + li + 16 * j]; b1[j] = sb[li + 16 * j]; b2[j] = sb[128 + li + 16 * j]; }
                const float ra = ffn_rstd(SS, ma), rb = ffn_rstd(SS, mb);
                int ea, eb; float ga, gb;
                topk_core(a1, a2, ra, li, lane, ea, ga);
                topk_core(b1, b2, rb, li, lane, eb, gb);
                IDX[(size_t)ma * 128 + head * 16 + li] = ea; GATE[(size_t)ma * 128 + head * 16 + li] = ga; IDX16[(size_t)ma * 128 + head * 16 + li] = (unsigned short)ea;
                IDX[(size_t)mb * 128 + head * 16 + li] = eb; GATE[(size_t)mb * 128 + head * 16 + li] = gb; IDX16[(size_t)mb * 128 + head * 16 + li] = (unsigned short)eb;
            }
            __syncthreads();
        }
    }
};
struct OneUnit {
    pg8::Unit u;
    __device__ __forceinline__ bool next(int i, pg8::Unit& o) const { if (i) return false; o = u; return true; }
    __device__ __forceinline__ void a_ready(const pg8::Unit&) const {}
    __device__ __forceinline__ void done(const pg8::Unit&) const {}
};

__device__ __forceinline__ float gelu_erf(float x) { return 0.5f * x * (1.f + erff(x * 0.70710678118654752f)); }
typedef float f32x2 __attribute__((ext_vector_type(2)));
__device__ __forceinline__ void cvt16_fp8(const v4u& w, f32x2 (&f)[8]) {
    f[0] = __builtin_amdgcn_cvt_pk_f32_fp8((int)w.x, false); f[1] = __builtin_amdgcn_cvt_pk_f32_fp8((int)w.x, true);
    f[2] = __builtin_amdgcn_cvt_pk_f32_fp8((int)w.y, false); f[3] = __builtin_amdgcn_cvt_pk_f32_fp8((int)w.y, true);
    f[4] = __builtin_amdgcn_cvt_pk_f32_fp8((int)w.z, false); f[5] = __builtin_amdgcn_cvt_pk_f32_fp8((int)w.z, true);
    f[6] = __builtin_amdgcn_cvt_pk_f32_fp8((int)w.w, false); f[7] = __builtin_amdgcn_cvt_pk_f32_fp8((int)w.w, true);
}
__device__ __forceinline__ float grp8_sum(float v) {
    v += __builtin_bit_cast(float, dpp_u<0xB1>(__builtin_bit_cast(unsigned, v)));
    v += __builtin_bit_cast(float, dpp_u<0x4E>(__builtin_bit_cast(unsigned, v)));
    v += __builtin_bit_cast(float, dpp_u<0x141>(__builtin_bit_cast(unsigned, v)));
    return v;
}
typedef int i32x4 __attribute__((ext_vector_type(4)));
template <int PAT> __device__ __forceinline__ float swz_f(float v) { return __builtin_bit_cast(float, __builtin_amdgcn_ds_swizzle(__builtin_bit_cast(int, v), PAT)); }
__device__ __forceinline__ void peer_u_token(const v4u (&ur)[16], const f32x2 (&xv)[8], bf16* dst, int c8) {
    float d[16];
#pragma unroll
    for (int i = 0; i < 16; ++i) {
        f32x2 f[8]; cvt16_fp8(ur[i], f);
        f32x2 s2 = f[0] * xv[0];
#pragma unroll
        for (int q = 1; q < 8; ++q) s2 += f[q] * xv[q];
        d[i] = s2.x + s2.y;
    }
    const bool b0 = (c8 & 1) != 0, b1 = (c8 & 2) != 0, b2 = (c8 & 4) != 0;
    float e8[8], e4[4], e2[2];
#pragma unroll
    for (int i = 0; i < 8; ++i) { const float keep = b0 ? d[2 * i + 1] : d[2 * i], send = b0 ? d[2 * i] : d[2 * i + 1];
        e8[i] = keep + __builtin_bit_cast(float, dpp_u<0xB1>(__builtin_bit_cast(unsigned, send))); }
#pragma unroll
    for (int i = 0; i < 4; ++i) { const float keep = b1 ? e8[2 * i + 1] : e8[2 * i], send = b1 ? e8[2 * i] : e8[2 * i + 1];
        e4[i] = keep + __builtin_bit_cast(float, dpp_u<0x4E>(__builtin_bit_cast(unsigned, send))); }
#pragma unroll
    for (int i = 0; i < 2; ++i) { const float keep = b2 ? e4[2 * i + 1] : e4[2 * i], send = b2 ? e4[2 * i] : e4[2 * i + 1];
        e2[i] = keep + swz_f<0x1F | (4 << 10)>(send); }
    dst[c8] = (bf16)f2bf(e2[0]); dst[c8 + 8] = (bf16)f2bf(e2[1]);
}
__device__ __forceinline__ void peer_u(const P& p, int wave, int lane) {
    const int j = blockIdx.x & 7, nchunk = gridDim.x >> 3, chunk = blockIdx.x >> 3, stride = nchunk * 8;
    const int g = lane >> 3, c8 = lane & 7;
    const bf16* HN = (const bf16*)p.out + 128 * j + 16 * c8; const unsigned short* IDX = (const unsigned short*)(p.ws + WS_IDX16) + 16 * g;
    const unsigned char* US = p.ws + WS_U8 + (size_t)j * NEXP * 128 + 16 * c8;
    bf16* PART = (bf16*)(p.ws + WS_PART) + (size_t)j * T_ * 128 + 16 * g;
    const int m0 = chunk * 8 + wave, ntok = (T_ - m0 + stride - 1) / stride;
#define PU_CLAMP(k) (m0 + ((k) < ntok ? (k) : ntok - 1) * stride)
#define PU_IDX(ei, i) ((((i) & 1) ? (ei[(i) >> 3][((i) >> 1) & 3] >> 16) : (ei[(i) >> 3][((i) >> 1) & 3] & 0xffffu)))
#define PU_ROWS(ur, ei) _Pragma("unroll") for (int i = 0; i < 16; ++i) ur[i] = *(const v4u*)(US + (size_t)PU_IDX(ei, i) * 128)
#define PU_L1(ei, h0, h1, mm) do { _Pragma("unroll") for (int q = 0; q < 2; ++q) ei[q] = *(const v4u*)(IDX + (size_t)(mm) * 128 + 8 * q); \
        h0 = *(const v4u*)(HN + (size_t)(mm) * 1024); h1 = *(const v4u*)(HN + (size_t)(mm) * 1024 + 8); } while (0)
#define PU_X(xv, h0, h1) do { float f_[8]; unpack8(h0, f_); _Pragma("unroll") for (int i = 0; i < 4; ++i) xv[i] = (f32x2){f_[2 * i], f_[2 * i + 1]}; \
        unpack8(h1, f_); _Pragma("unroll") for (int i = 0; i < 4; ++i) xv[4 + i] = (f32x2){f_[2 * i], f_[2 * i + 1]}; } while (0)
    v4u ei[2]; v4u hA0, hA1, hB0, hB1; v4u urA[16], urB[16]; f32x2 xv[8];
    PU_L1(ei, hA0, hA1, m0);
    PU_ROWS(urA, ei);
    PU_L1(ei, hB0, hB1, PU_CLAMP(1));
    for (int k = 0; k < ntok; k += 2) {
        PU_ROWS(urB, ei);
        PU_X(xv, hA0, hA1);
        PU_L1(ei, hA0, hA1, PU_CLAMP(k + 2));
        peer_u_token(urA, xv, PART + (size_t)(m0 + k * stride) * 128, c8);
        if (k + 1 < ntok) {
            PU_ROWS(urA, ei);
            PU_X(xv, hB0, hB1);
            PU_L1(ei, hB0, hB1, PU_CLAMP(k + 3));
            peer_u_token(urB, xv, PART + (size_t)(m0 + (k + 1) * stride) * 128, c8);
        }
    }
#undef PU_CLAMP
#undef PU_ROWS
#undef PU_IDX
#undef PU_L1
#undef PU_X
}
__device__ __forceinline__ void peer_c(const P& p, int wave, int lane) {
    const int gw = blockIdx.x * NWAVES + wave, NGW = gridDim.x * NWAVES;
    const int* IDX = (const int*)(p.ws + WS_IDX); const float* GATE = (const float*)(p.ws + WS_GATE); const bf16* PART = (const bf16*)(p.ws + WS_PART);
    const float* USC = (const float*)(p.ws + WS_USC); const float* VSC = (const float*)(p.ws + WS_VSC); float* COEF = (float*)(p.ws + WS_COEF); const float* SS = (const float*)(p.ws + WS_SS);
    for (int m0 = gw * 4; m0 < T_; m0 += NGW * 4) {
        float s[4][2], rs[4], g[4][2]; int e[4][2];
#pragma unroll
        for (int u = 0; u < 4; ++u) {
            const int m = m0 + u;
            rs[u] = ffn_rstd(SS, m);
            s[u][0] = 0.f; s[u][1] = 0.f;
#pragma unroll
            for (int jj = 0; jj < 8; ++jj) { s[u][0] += bf2f(PART[((size_t)jj * T_ + m) * 128 + lane]); s[u][1] += bf2f(PART[((size_t)jj * T_ + m) * 128 + 64 + lane]); }
            e[u][0] = IDX[(size_t)m * 128 + lane]; e[u][1] = IDX[(size_t)m * 128 + 64 + lane];
            g[u][0] = GATE[(size_t)m * 128 + lane]; g[u][1] = GATE[(size_t)m * 128 + 64 + lane];
        }
        float us[4][2], vs[4][2];
#pragma unroll
        for (int u = 0; u < 4; ++u)
#pragma unroll
            for (int k = 0; k < 2; ++k) { us[u][k] = USC[e[u][k]]; vs[u][k] = VSC[e[u][k]]; }
#pragma unroll
        for (int u = 0; u < 4; ++u)
#pragma unroll
            for (int k = 0; k < 2; ++k) ((unsigned*)COEF)[(size_t)(m0 + u) * 128 + 64 * k + lane] = (f2bf(g[u][k] * gelu_erf(s[u][k] * rs[u] * us[u][k]) * vs[u][k]) << 16) | (unsigned)e[u][k];
    }
}
struct PvPre { v4u pk[4]; };
__device__ __forceinline__ void pv_level1(PvPre& q, const unsigned* PKg, int m) {
#pragma unroll
    for (int k = 0; k < 4; ++k) q.pk[k] = *(const v4u*)(PKg + (size_t)m * 128 + 4 * k);
}
__device__ __forceinline__ void peer_v_token(const v4u (&vr)[16], const v4u (&cf)[4], const bf16* H, bf16* out, bool b3, bool b4, bool b5) {
    f32x2 acc[8];
#pragma unroll
    for (int i = 0; i < 8; ++i) acc[i] = (f32x2){0.f, 0.f};
#pragma unroll
    for (int I = 0; I < 16; ++I) {
        const float cu = bfhi(cf[I >> 2][I & 3]);
        const f32x2 c2 = (f32x2){cu, cu}; f32x2 f[8]; cvt16_fp8(vr[I], f);
#pragma unroll
        for (int q = 0; q < 8; ++q) acc[q] += c2 * f[q];
    }
    f32x2 a1[4], a2[2], a3;
#pragma unroll
    for (int i = 0; i < 4; ++i) { const f32x2 keep = b5 ? acc[2 * i + 1] : acc[2 * i], send = b5 ? acc[2 * i] : acc[2 * i + 1];
        a1[i] = keep + (f32x2){__shfl_xor(send.x, 32), __shfl_xor(send.y, 32)}; }
#pragma unroll
    for (int i = 0; i < 2; ++i) { const f32x2 keep = b4 ? a1[2 * i + 1] : a1[2 * i], send = b4 ? a1[2 * i] : a1[2 * i + 1];
        a2[i] = keep + (f32x2){swz_f<0x1F | (16 << 10)>(send.x), swz_f<0x1F | (16 << 10)>(send.y)}; }
    { const f32x2 keep = b3 ? a2[1] : a2[0], send = b3 ? a2[0] : a2[1]; a3 = keep + (f32x2){swz_f<0x1F | (8 << 10)>(send.x), swz_f<0x1F | (8 << 10)>(send.y)}; }
    const unsigned hb = *(const unsigned*)H; const f32x2 hv = (f32x2){bflo(hb), bfhi(hb)};
    const f32x2 y = hv + a3;
    *(unsigned*)out = pk2(y.x, y.y);
}
__device__ __forceinline__ void peer_v(const P& p, int wave, int lane) {
    const int j = blockIdx.x & 7, nchunk = gridDim.x >> 3, chunk = blockIdx.x >> 3, stride = nchunk * 8;
    const int g = lane >> 3, c8 = lane & 7;
    const bool b5 = (lane & 32) != 0, b4 = (lane & 16) != 0, b3 = (lane & 8) != 0;
    const int pi = 4 * (b3 ? 1 : 0) + 2 * (b4 ? 1 : 0) + (b5 ? 1 : 0);
    const size_t colo = 128 * j + 16 * c8 + 2 * pi;
    const bf16* H = (const bf16*)(p.ws + WS_H) + colo; bf16* OUT = (bf16*)(p.ws + WS_YB) + colo;
    const unsigned* PKg = (const unsigned*)(p.ws + WS_COEF) + 16 * g;
    const unsigned char* VS = p.ws + WS_V8 + (size_t)j * NEXP * 128 + 16 * c8;
    const int m0 = chunk * 8 + wave, ntok = (T_ - m0 + stride - 1) / stride;
#define PV_CLAMP(k) (m0 + ((k) < ntok ? (k) : ntok - 1) * stride)
#define PV_ROWS(vr, q) _Pragma("unroll") for (int i = 0; i < 16; ++i) vr[i] = *(const v4u*)(VS + (size_t)(q.pk[i >> 2][i & 3] & 0xffffu) * 128)
    PvPre q; v4u vrA[16], vrB[16]; v4u cA[4], cB[4];
    pv_level1(q, PKg, m0);
    PV_ROWS(vrA, q);
#pragma unroll
    for (int k = 0; k < 4; ++k) cA[k] = q.pk[k];
    pv_level1(q, PKg, PV_CLAMP(1));
    for (int k = 0; k < ntok; k += 2) {
        PV_ROWS(vrB, q);
#pragma unroll
        for (int kk = 0; kk < 4; ++kk) cB[kk] = q.pk[kk];
        pv_level1(q, PKg, PV_CLAMP(k + 2));
        { const size_t mm = (size_t)(m0 + k * stride); peer_v_token(vrA, cA, H + mm * 1024, OUT + mm * 1024, b3, b4, b5); }
        if (k + 1 < ntok) {
            PV_ROWS(vrA, q);
#pragma unroll
            for (int kk = 0; kk < 4; ++kk) cA[kk] = q.pk[kk];
            pv_level1(q, PKg, PV_CLAMP(k + 3));
            { const size_t mm = (size_t)(m0 + (k + 1) * stride); peer_v_token(vrB, cB, H + mm * 1024, OUT + mm * 1024, b3, b4, b5); }
        }
    }
#undef PV_CLAMP
#undef PV_ROWS
}
__device__ __forceinline__ void peer_f(const P& p, int wave, int lane) {
    const int gw = blockIdx.x * NWAVES + wave, NGW = gridDim.x * NWAVES;
    const f32x4* wr = (const f32x4*)p.norm_final_w + lane;
    for (int m0 = gw * 2; m0 < T_; m0 += NGW * 2) {
        v2u yv[2][4]; float ss[2] = {0.f, 0.f};
#pragma unroll
        for (int u = 0; u < 2; ++u) { const v2u* yb = (const v2u*)((const bf16*)(p.ws + WS_YB) + (size_t)(m0 + u) * 1024) + lane;
#pragma unroll
            for (int q = 0; q < 4; ++q) yv[u][q] = yb[64 * q]; }
#pragma unroll
        for (int u = 0; u < 2; ++u)
#pragma unroll
            for (int q = 0; q < 4; ++q) { const float a = bflo(yv[u][q].x), b = bfhi(yv[u][q].x), c = bflo(yv[u][q].y), d = bfhi(yv[u][q].y); ss[u] += (a * a + b * b) + (c * c + d * d); }
#pragma unroll
        for (int o = 1; o < 64; o <<= 1) { ss[0] += __shfl_xor(ss[0], o); ss[1] += __shfl_xor(ss[1], o); }
#pragma unroll
        for (int u = 0; u < 2; ++u) {
            const float rstd = frsq(ss[u] * (1.f / 1024.f) + EPS);
            f32x4* o = (f32x4*)(p.out + (size_t)(m0 + u) * 1024) + lane;
#pragma unroll
            for (int q = 0; q < 4; ++q) { const f32x4 w = wr[64 * q];
                o[64 * q] = (f32x4){bflo(yv[u][q].x) * rstd * w.x, bfhi(yv[u][q].x) * rstd * w.y, bflo(yv[u][q].y) * rstd * w.z, bfhi(yv[u][q].y) * rstd * w.w}; }
        }
    }
}

constexpr int N_PHASES = 12;
struct Args { P p; int ph_lo, ph_hi; };
__global__ void __launch_bounds__(NTHR, 2) fwd_kernel(Args args) {
    extern __shared__ __attribute__((aligned(16))) unsigned char lds_raw[];
    LAS unsigned char* lds = (LAS unsigned char*)lds_raw;
    const P& p = args.p;
    const int tid = threadIdx.x, lane = tid & 63, wave = __builtin_amdgcn_readfirstlane(tid >> 6);
    volatile LAS unsigned* MISC = (volatile LAS unsigned*)(lds + MISC_OFF);
    for (int u = tid; u < (LDS_BYTES - LDSCTL_OFF) / 4; u += NTHR) ((LAS unsigned*)(lds + LDSCTL_OFF))[u] = 0u;
    __syncthreads();
    XcdBarrier bar; bar.bar = (unsigned*)(p.ws + WS_CTL) + CW_BAR; bar.x = 0; bar.st = nullptr;
#if !MK_PER_PHASE
    bar = xcd_barrier_post((unsigned*)(p.ws + WS_CTL) + CW_BAR, MISC + 8);
#endif
    const int lo = args.ph_lo, hi = args.ph_hi;
#define IN(k) (lo <= (k) && (k) < hi)
#ifndef PROBE_WAIT_LO
#define PROBE_WAIT_LO -1
#define PROBE_WAIT_HI -1
#endif
    volatile LAS unsigned long long* STAMP = (volatile LAS unsigned long long*)(lds + MISC_OFF + 256);
#define SEAM(k) do { if (IN(k) && IN((k) + 1)) xcd_barrier(bar); if (PROBE_WAIT_LO >= 0 && blockIdx.x == 0 && tid == 0) { STAMP[(k) + 1] = __builtin_amdgcn_s_memrealtime(); \
        if ((k) + 1 == N_PHASES - 1) { const unsigned long long d_ = STAMP[PROBE_WAIT_HI < 0 ? 0 : PROBE_WAIT_HI] - STAMP[PROBE_WAIT_LO < 0 ? 0 : PROBE_WAIT_LO]; \
            __hip_atomic_store((unsigned*)(p.ws + WS_CTL) + CW_Q + 256, (unsigned)d_ | 1u, __ATOMIC_RELAXED, __HIP_MEMORY_SCOPE_AGENT); } } } while (0)
    if (PROBE_WAIT_LO >= 0 && blockIdx.x == 0 && tid == 0) STAMP[0] = __builtin_amdgcn_s_memrealtime();

#ifndef PROBE_REP
#define PROBE_REP -1
#endif
#define REP(k) ((PROBE_REP == (k)) ? 2 : 1)
    if (IN(0)) {
#pragma unroll 1
        for (int r = 0; r < REP(0); ++r) p0_prologue(p, lds, wave, lane); } SEAM(0);
    if (IN(1)) {
#pragma unroll 1
      for (int r = 0; r < REP(1); ++r) {
        EpiProj e{(bf16*)(p.ws + WS_SBQKV), (bf16*)(p.ws + WS_VT), (bf16*)(p.ws + WS_MLQK), (bf16*)(p.ws + WS_MLV), (bf16*)(p.ws + WS_MLO), (bf16*)(p.ws + WS_GATES)};
        gemm<EpiProj>(lds, (const bf16*)(p.ws + WS_XN), (const bf16*)(p.ws + WS_W1T), T_, NPROJ, 1024, e); }
    } SEAM(1);
    if (IN(2)) { p2_conv(p, tid); } SEAM(2);
    if (IN(3)) {
        for (int it = blockIdx.x; it < 64; it += gridDim.x) mlstm_item(p, lds, it, tid, wave, lane);
        unsigned* qctr = (unsigned*)(p.ws + WS_CTL) + CW_Q;
#ifdef PROBE_P3SPLIT
        xcd_barrier(bar); if (blockIdx.x == 0 && tid == 0) STAMP[20] = __builtin_amdgcn_s_memrealtime();
#endif
        for (;;) {
            if (tid == 0) MISC[12] = __hip_atomic_fetch_add(qctr, 1u, __ATOMIC_RELAXED, __HIP_MEMORY_SCOPE_AGENT);
            __syncthreads();
            const unsigned it = MISC[12];
            __syncthreads();
            if (it >= 1024u) break;
            sba_item(p, lds, (int)it, wave, lane);
        }
#ifdef PROBE_P3SPLIT
        xcd_barrier(bar); if (blockIdx.x == 0 && tid == 0) STAMP[21] = __builtin_amdgcn_s_memrealtime();
#endif
        for (;;) {
            if (tid == 0) MISC[12] = __hip_atomic_fetch_add(qctr + 128, 1u, __ATOMIC_RELAXED, __HIP_MEMORY_SCOPE_AGENT);
            __syncthreads();
            const unsigned it = MISC[12];
            __syncthreads();
            if (it >= (unsigned)N_FILL) break;
            fill_item(p, (int)it, wave, lane);
        }
    } SEAM(3);
    if (IN(4)) { p3_yml(p, wave, lane); } SEAM(4);
    if (IN(5)) {
        pg8::Gemm g{(const bf16*)p.out, (const bf16*)(p.ws + WS_WSBT), T_, 1024, 1024}; pg8::StaticOrder S; S.init(T_, 1024, (int)gridDim.x, (int)blockIdx.x);
        EpiMerge1 e{(bf16*)(p.ws + WS_MERGED), (const unsigned char*)(p.ws + WS_GATES)};
        pg8::gemm_phase<EpiMerge1, pg8::StaticOrder, true, true, true>(lds, g, S, e);
    } SEAM(5);
    if (IN(6)) {
        pg8::Gemm g{(const bf16*)(p.ws + WS_MERGED), (const bf16*)(p.ws + WS_WOUTT), T_, 1024, 1024}; pg8::StaticOrder S; S.init(T_, 1024, (int)gridDim.x, (int)blockIdx.x);
        EpiHW e{(bf16*)(p.ws + WS_H), p.x, (bf16*)p.out  , p.norm_ffn_w, (float*)(p.ws + WS_SS)};
        pg8::gemm_phase<EpiHW, pg8::StaticOrder, true, true>(lds, g, S, e);
    } SEAM(6);
    if (IN(7)) {
        pg8::Gemm g{(const bf16*)p.out, (const bf16*)(p.ws + WS_WCT), T_, 2048, 1024}; pg8::StaticOrder S; S.init(T_, 2048, (int)gridDim.x, (int)blockIdx.x);
        EpiTopk e{(int*)(p.ws + WS_IDX), (float*)(p.ws + WS_GATE), (const float*)(p.ws + WS_SS), (unsigned short*)(p.ws + WS_IDX16)};
#pragma unroll 1
        for (int i = 0;; ++i) { OneUnit s1; if (!S.next(i, s1.u)) break; pg8::gemm_phase<EpiTopk, OneUnit, false, true>(lds, g, s1, e); }
    } SEAM(7);
    if (IN(8)) { peer_u(p, wave, lane); } SEAM(8);
    if (IN(9)) { peer_c(p, wave, lane); } SEAM(9);
    if (IN(10)) { peer_v(p, wave, lane); } SEAM(10);
    if (IN(11)) { peer_f(p, wave, lane); }
    if (PROBE_WAIT_LO >= 0 && tid == 0) {
        unsigned* pw = (unsigned*)(p.ws + WS_CTL) + CW_Q + 256;
        unsigned dt = 0u;
        for (unsigned sp = 0; sp < (1u << 22); ++sp) { dt = __hip_atomic_load(pw, __ATOMIC_RELAXED, __HIP_MEMORY_SCOPE_AGENT); if (dt) break; __builtin_amdgcn_s_sleep(8); }
        const unsigned long long tend = __builtin_amdgcn_s_memrealtime();
        while (__builtin_amdgcn_s_memrealtime() - tend < (unsigned long long)dt) __builtin_amdgcn_s_sleep(8);
    }
#undef IN
#undef SEAM
}

extern "C" void kernel_launch(void* const* d_in, const int* in_sizes, int n_in, void* d_out, int out_size, void* d_ws, size_t ws_size, hipStream_t stream) {
    static int grid = 0;
    if (grid == 0) {
        if (n_in != 18 || in_sizes[0] != T_ * D_ || out_size != T_ * D_ || ws_size < WS_END) {
            fprintf(stderr, "kernel_launch: unexpected problem (n_in %d, in0 %d, out %d, ws %zu); nothing launched\n", n_in, n_in > 0 ? in_sizes[0] : -1, out_size, ws_size); grid = -1; return; }
        int dev = 0, cus = 0, per_cu = 0;
        if (hipGetDevice(&dev) != hipSuccess || hipDeviceGetAttribute(&cus, hipDeviceAttributeMultiprocessorCount, dev) != hipSuccess) { grid = -1; return; }
        if (hipFuncSetAttribute((const void*)fwd_kernel, hipFuncAttributeMaxDynamicSharedMemorySize, LDS_BYTES) != hipSuccess) { fprintf(stderr, "kernel_launch: hipFuncSetAttribute failed\n"); grid = -1; return; }
        if (hipOccupancyMaxActiveBlocksPerMultiprocessor(&per_cu, (const void*)fwd_kernel, NTHR, LDS_BYTES) != hipSuccess || per_cu < 1)
            fprintf(stderr, "kernel_launch: note: occupancy query reports %d workgroups per CU\n", per_cu);
        (void)hipGetLastError();
        grid = cus;
    }
    if (grid < 0) return;
    if (hipMemsetAsync((char*)d_ws + WS_CTL, 0, CTL_ZERO_BYTES, stream) != hipSuccess) { fprintf(stderr, "kernel_launch: memset failed\n"); return; }
    Args a{};
    const float** pp = (const float**)&a.p;
    for (int i = 0; i < 18; ++i) pp[i] = (const float*)d_in[i];
    a.p.out = (float*)d_out; a.p.ws = (unsigned char*)d_ws;
#if MK_PER_PHASE
    for (int ph = 0; ph < N_PHASES; ++ph) {
        a.ph_lo = ph; a.ph_hi = ph + 1;
        hipLaunchKernelGGL(fwd_kernel, dim3(grid), dim3(NTHR), LDS_BYTES, stream, a);
    }
#else
    a.ph_lo = 0; a.ph_hi = N_PHASES;
    hipLaunchKernelGGL(fwd_kernel, dim3(grid), dim3(NTHR), LDS_BYTES, stream, a);
#endif
    const hipError_t le = hipPeekAtLastError();
    if (le != hipSuccess) fprintf(stderr, "kernel_launch: launch failed: %s\n", hipGetErrorName(le));
}
```
